# Optimizing an MI355X kernel written in HIP

```python
import jax, jax.numpy as jnp
from jax import lax
import numpy as np

D_MODEL = 2048
BATCH = 8
SEQ = 2048
DEPTH = 4

GRID_W = 64
CTX_LEN = 256
EPS = 1e-6

CONV_W = 4
CONV_LEFT = 2

LRU_WIDTH = D_MODEL // 2
LRU_BLOCKS = 16
LRU_BLOCK = LRU_WIDTH // LRU_BLOCKS
LRU_C = 8.0

HEAD_DIM = 128
ATT_HEADS = D_MODEL // 256
ATT_KV_HEADS = 2
ATT_GROUP = ATT_HEADS // ATT_KV_HEADS
ATT_WIDTH = ATT_HEADS * HEAD_DIM
KV_WIDTH = ATT_KV_HEADS * HEAD_DIM
WINDOW = 128
ATT_BLOCK = 128
ROPE_THETA = 10000.0

SSD_WIDTH = D_MODEL // 2
SSD_HEAD_DIM = 64
SSD_HEADS = SSD_WIDTH // SSD_HEAD_DIM
SSD_GROUPS = 2
SSD_HPG = SSD_HEADS // SSD_GROUPS
SSD_STATE = 128
SSD_CHUNK = 128
SSD_BC = SSD_GROUPS * SSD_STATE
SSD_CONV_CH = SSD_WIDTH + 2 * SSD_BC

MIX_WIDTH = LRU_WIDTH + ATT_WIDTH + SSD_WIDTH
IN_SIZES = (LRU_WIDTH, LRU_WIDTH, ATT_WIDTH, KV_WIDTH, KV_WIDTH, ATT_WIDTH, SSD_CONV_CH, SSD_WIDTH, SSD_HEADS)
IN_WIDTH = sum(IN_SIZES)

kernel_name = "hybrid_lru_swa_ssd_dit_prefix"


def rmsnorm(x, w):
    xf = x.astype(jnp.float32)
    y = xf * lax.rsqrt(jnp.mean(xf * xf, axis=-1, keepdims=True) + EPS)
    return (y * w.astype(jnp.float32)).astype(x.dtype)


def modulation(cond, ada_w, ada_b):
    m = jax.nn.silu(cond) @ ada_w + ada_b
    return jnp.split(m, 3, axis=-1)


def split_cols(p):
    idx, acc = [], 0
    for s in IN_SIZES[:-1]:
        acc += s
        idx.append(acc)
    return jnp.split(p, idx, axis=-1)


def dwconv_centred(x, w, b):
    ch = x.shape[-1]
    y = lax.conv_general_dilated(x, w[:, None, :], window_strides=(1,),
                                 padding=[(CONV_LEFT, CONV_W - 1 - CONV_LEFT)],
                                 dimension_numbers=('NWC', 'WIO', 'NWC'),
                                 feature_group_count=ch)
    return y + b


def maybe_flip(t, rev):
    return jnp.flip(t, axis=1) if rev else t


def rope_2d(n_lat):
    rows = n_lat // GRID_W
    row = jnp.repeat(jnp.arange(rows), GRID_W).astype(jnp.float32)
    col = jnp.tile(jnp.arange(GRID_W), rows).astype(jnp.float32)
    n_freq = HEAD_DIM // 4
    inv = ROPE_THETA ** (-jnp.arange(n_freq, dtype=jnp.float32) / n_freq)
    ang = jnp.concatenate([row[:, None] * inv, col[:, None] * inv], axis=-1)
    return jnp.cos(ang), jnp.sin(ang)


def apply_rope(x, cos, sin):
    x1, x2 = jnp.split(x, 2, axis=-1)
    c = cos[None, :, None, :].astype(x.dtype)
    s = sin[None, :, None, :].astype(x.dtype)
    return jnp.concatenate([x1 * c - x2 * s, x1 * s + x2 * c], axis=-1)


def linear_scan(a, b, reverse):
    def combine(l, r):
        al, bl = l
        ar, br = r
        return al * ar, ar * bl + br
    _, h = lax.associative_scan(combine, (a, b), axis=1, reverse=reverse)
    return h


def rglru_scan(xc, w_a, b_a, w_x, b_x, lam, h0, reverse):
    bsz, L, W = xc.shape
    xf = xc.astype(jnp.float32)
    xb = xf.reshape(bsz, L, LRU_BLOCKS, LRU_BLOCK)
    r = jax.nn.sigmoid(jnp.einsum('blhi,hij->blhj', xb, w_a.astype(jnp.float32)).reshape(bsz, L, W) + b_a)
    i = jax.nn.sigmoid(jnp.einsum('blhi,hij->blhj', xb, w_x.astype(jnp.float32)).reshape(bsz, L, W) + b_x)
    log_a = -LRU_C * r * jax.nn.softplus(-lam.astype(jnp.float32))
    a = jnp.exp(log_a)
    b = jnp.sqrt(-jnp.expm1(2.0 * log_a)) * (i * xf)
    first = L - 1 if reverse else 0
    b = b.at[:, first].add(a[:, first] * h0)
    h = linear_scan(a, b, reverse)
    h_last = h[:, 0] if reverse else h[:, -1]
    return h, h_last


def rglru_mixer(xc, xl, conv_w, conv_b, ga_w, ga_b, gx_w, gx_b, lam):
    xc = dwconv_centred(xc, conv_w, conv_b)
    xl = dwconv_centred(xl, conv_w, conv_b)
    bsz = xl.shape[0]
    outs_c, outs_l = [], []
    for d, rev in enumerate((False, True)):
        h0 = jnp.zeros((bsz, LRU_WIDTH), jnp.float32)
        h_c, hc_last = rglru_scan(xc, ga_w[d], ga_b[d], gx_w[d], gx_b[d], lam[d], h0, rev)
        h_l, _ = rglru_scan(xl, ga_w[d], ga_b[d], gx_w[d], gx_b[d], lam[d], hc_last, rev)
        outs_c.append(h_c)
        outs_l.append(h_l)
    return (outs_c[0] + outs_c[1]).astype(xc.dtype), (outs_l[0] + outs_l[1]).astype(xl.dtype)


def window_attention(qc, kc, vc, ql, kl, vl, sink):
    bsz, S = ql.shape[:2]
    C = kc.shape[1]
    nb = S // ATT_BLOCK
    scale = HEAD_DIM ** -0.5
    sink_f = sink.astype(jnp.float32).reshape(ATT_KV_HEADS, ATT_GROUP)
    qb = ql.reshape(bsz, nb, ATT_BLOCK, ATT_KV_HEADS, ATT_GROUP, HEAD_DIM)
    pad = ((0, 0), (ATT_BLOCK, ATT_BLOCK), (0, 0), (0, 0))
    kp = jnp.pad(kl, pad).reshape(bsz, nb + 2, ATT_BLOCK, ATT_KV_HEADS, HEAD_DIM)
    vp = jnp.pad(vl, pad).reshape(bsz, nb + 2, ATT_BLOCK, ATT_KV_HEADS, HEAD_DIM)
    kb = jnp.concatenate([kp[:, :-2], kp[:, 1:-1], kp[:, 2:]], axis=2)
    vb = jnp.concatenate([vp[:, :-2], vp[:, 1:-1], vp[:, 2:]], axis=2)
    s_lat = jnp.einsum('bnqkgd,bnjkd->bnkgqj', qb, kb).astype(jnp.float32) * scale
    s_ctx = jnp.einsum('bnqkgd,bckd->bnkgqc', qb, kc).astype(jnp.float32) * scale
    qpos = jnp.arange(nb)[:, None] * ATT_BLOCK + jnp.arange(ATT_BLOCK)[None]
    kpos = jnp.arange(nb)[:, None] * ATT_BLOCK - ATT_BLOCK + jnp.arange(3 * ATT_BLOCK)[None]
    rel = qpos[:, :, None] - kpos[:, None, :]
    valid = (jnp.abs(rel) <= WINDOW) & (kpos[:, None, :] >= 0) & (kpos[:, None, :] < S)
    s_lat = jnp.where(valid[None, :, None, None], s_lat, -jnp.inf)
    sink_l = jnp.broadcast_to(sink_f[None, None, :, :, None, None], s_lat.shape[:-1] + (1,))
    p = jax.nn.softmax(jnp.concatenate([s_lat, s_ctx, sink_l], axis=-1), axis=-1)
    nk = 3 * ATT_BLOCK
    p_lat = p[..., :nk].astype(vl.dtype)
    p_ctx = p[..., nk:nk + C].astype(vl.dtype)
    o_l = jnp.einsum('bnkgqj,bnjkd->bnqkgd', p_lat, vb) + jnp.einsum('bnkgqc,bckd->bnqkgd', p_ctx, vc)
    o_l = o_l.reshape(bsz, S, ATT_WIDTH)
    qcg = qc.reshape(bsz, C, ATT_KV_HEADS, ATT_GROUP, HEAD_DIM)
    s_cc = jnp.einsum('bqkgd,bckd->bkgqc', qcg, kc).astype(jnp.float32) * scale
    sink_c = jnp.broadcast_to(sink_f[None, :, :, None, None], s_cc.shape[:-1] + (1,))
    pc = jax.nn.softmax(jnp.concatenate([s_cc, sink_c], axis=-1), axis=-1)[..., :C].astype(vc.dtype)
    o_c = jnp.einsum('bkgqc,bckd->bqkgd', pc, vc).reshape(bsz, C, ATT_WIDTH)
    return o_c, o_l


def ssd_chunked(x, dt, A, Bm, Cm, h0):
    bsz, L = x.shape[:2]
    Q = SSD_CHUNK
    nc = L // Q
    G, R = SSD_GROUPS, SSD_HPG
    x = x.astype(jnp.float32).reshape(bsz, nc, Q, G, R, SSD_HEAD_DIM)
    dt = dt.reshape(bsz, nc, Q, G, R)
    Bm = Bm.astype(jnp.float32).reshape(bsz, nc, Q, G, SSD_STATE)
    Cm = Cm.astype(jnp.float32).reshape(bsz, nc, Q, G, SSD_STATE)
    Acs = jnp.cumsum(dt * A.reshape(G, R), axis=2)
    A_last = Acs[:, :, -1]
    seg = Acs[:, :, :, None] - Acs[:, :, None, :]
    tril = jnp.tril(jnp.ones((Q, Q), bool))[:, :, None, None]
    decay = jnp.exp(jnp.where(tril, seg, -jnp.inf))
    CB = jnp.einsum('bcign,bcjgn->bcijg', Cm, Bm)
    Wm = CB[..., None] * decay * dt[:, :, None]
    y_diag = jnp.einsum('bcijgr,bcjgrp->bcigrp', Wm, x)
    w_state = jnp.exp(A_last[:, :, None] - Acs) * dt
    states = jnp.einsum('bcjgn,bcjgrp->bcgrpn', Bm, x * w_state[..., None])
    def step(h, inp):
        dec, st = inp
        return jnp.exp(dec)[..., None, None] * h + st, h
    h_final, h_in = lax.scan(step, h0, (jnp.moveaxis(A_last, 1, 0), jnp.moveaxis(states, 1, 0)))
    h_in = jnp.moveaxis(h_in, 0, 1)
    y_off = jnp.einsum('bcign,bcgrpn->bcigrp', Cm, h_in) * jnp.exp(Acs)[..., None]
    y = (y_diag + y_off).reshape(bsz, L, SSD_HEADS, SSD_HEAD_DIM)
    return y, h_final


def ssd_prep(xbc, conv_w, conv_b):
    xbc = jax.nn.silu(dwconv_centred(xbc, conv_w, conv_b))
    xs, Bm, Cm = jnp.split(xbc, [SSD_WIDTH, SSD_WIDTH + SSD_BC], axis=-1)
    bsz, L = xs.shape[:2]
    return (xs.reshape(bsz, L, SSD_HEADS, SSD_HEAD_DIM),
            Bm.reshape(bsz, L, SSD_GROUPS, SSD_STATE),
            Cm.reshape(bsz, L, SSD_GROUPS, SSD_STATE))


def ssd_mixer(xbc_c, z_c, dt_c, xbc_l, z_l, dt_l, conv_w, conv_b, dt_bias, A_log, D_skip, norm_w):
    xc, Bc, Cc = ssd_prep(xbc_c, conv_w, conv_b)
    xl, Bl, Cl = ssd_prep(xbc_l, conv_w, conv_b)
    bsz = xl.shape[0]
    Df = D_skip.astype(jnp.float32)[:, None]
    y_c = Df * xc.astype(jnp.float32)
    y_l = Df * xl.astype(jnp.float32)
    for d, rev in enumerate((False, True)):
        A = -jnp.exp(A_log[d].astype(jnp.float32))
        dtc = jax.nn.softplus(dt_c.astype(jnp.float32) + dt_bias[d])
        dtl = jax.nn.softplus(dt_l.astype(jnp.float32) + dt_bias[d])
        h0 = jnp.zeros((bsz, SSD_GROUPS, SSD_HPG, SSD_HEAD_DIM, SSD_STATE), jnp.float32)
        yc_d, hc = ssd_chunked(maybe_flip(xc, rev), maybe_flip(dtc, rev), A,
                               maybe_flip(Bc, rev), maybe_flip(Cc, rev), h0)
        yl_d, _ = ssd_chunked(maybe_flip(xl, rev), maybe_flip(dtl, rev), A,
                              maybe_flip(Bl, rev), maybe_flip(Cl, rev), hc)
        y_c = y_c + maybe_flip(yc_d, rev)
        y_l = y_l + maybe_flip(yl_d, rev)
    y_c = y_c.reshape(bsz, -1, SSD_WIDTH).astype(xbc_c.dtype)
    y_l = y_l.reshape(bsz, -1, SSD_WIDTH).astype(xbc_l.dtype)
    return rmsnorm(y_c * jax.nn.silu(z_c), norm_w), rmsnorm(y_l * jax.nn.silu(z_l), norm_w)


def hybrid_layer(ctx_h, x, c, c_ctx, cos, sin, update_ctx,
                 norm_w, ada_w, ada_b, w_in,
                 lru_conv_w, lru_conv_b, lru_ga_w, lru_ga_b, lru_gx_w, lru_gx_b, lru_lambda,
                 att_q_norm, att_k_norm, att_sink,
                 ssd_conv_w, ssd_conv_b, ssd_dt_bias, ssd_A_log, ssd_D, ssd_norm_w, w_out):
    bsz, S = x.shape[:2]
    C = ctx_h.shape[1]
    shift_l, scale_l, gate_l = modulation(c, ada_w, ada_b)
    shift_c, scale_c, gate_c = modulation(c_ctx, ada_w, ada_b)
    u_l = rmsnorm(x, norm_w) * (1.0 + scale_l[:, None]) + shift_l[:, None]
    u_c = rmsnorm(ctx_h, norm_w) * (1.0 + scale_c) + shift_c
    lx_c, lg_c, q_c, k_c, v_c, ag_c, xbc_c, z_c, dt_c = split_cols(u_c @ w_in)
    lx_l, lg_l, q_l, k_l, v_l, ag_l, xbc_l, z_l, dt_l = split_cols(u_l @ w_in)
    lru_c, lru_l = rglru_mixer(lx_c, lx_l, lru_conv_w, lru_conv_b, lru_ga_w, lru_ga_b,
                               lru_gx_w, lru_gx_b, lru_lambda)
    qc = rmsnorm(q_c.reshape(bsz, C, ATT_HEADS, HEAD_DIM), att_q_norm)
    kc = rmsnorm(k_c.reshape(bsz, C, ATT_KV_HEADS, HEAD_DIM), att_k_norm)
    vc = v_c.reshape(bsz, C, ATT_KV_HEADS, HEAD_DIM)
    ql = apply_rope(rmsnorm(q_l.reshape(bsz, S, ATT_HEADS, HEAD_DIM), att_q_norm), cos, sin)
    kl = apply_rope(rmsnorm(k_l.reshape(bsz, S, ATT_KV_HEADS, HEAD_DIM), att_k_norm), cos, sin)
    vl = v_l.reshape(bsz, S, ATT_KV_HEADS, HEAD_DIM)
    att_c, att_l = window_attention(qc, kc, vc, ql, kl, vl, att_sink)
    ssd_c, ssd_l = ssd_mixer(xbc_c, z_c, dt_c, xbc_l, z_l, dt_l, ssd_conv_w, ssd_conv_b,
                             ssd_dt_bias, ssd_A_log, ssd_D, ssd_norm_w)
    mix_l = jnp.concatenate([lru_l * jax.nn.silu(lg_l), att_l * jax.nn.silu(ag_l), ssd_l], axis=-1)
    x_new = x + gate_l[:, None] * (mix_l @ w_out)
    if update_ctx:
        mix_c = jnp.concatenate([lru_c * jax.nn.silu(lg_c), att_c * jax.nn.silu(ag_c), ssd_c], axis=-1)
        ctx_h = ctx_h + gate_c * (mix_c @ w_out)
    return ctx_h, x_new


def setup_inputs(seed: int = 0) -> dict:
    key = jax.random.key(seed)
    ks = jax.random.split(key, 28)
    f32 = jnp.float32
    nrm = lambda k, shape, s: jax.random.normal(k, shape, f32) * s
    a0 = jax.random.uniform(ks[14], (DEPTH, 2, LRU_WIDTH), f32, 0.9, 0.999)
    s_gate = a0 ** (1.0 / LRU_C)
    lru_lambda = jnp.log(s_gate) - jnp.log1p(-s_gate)
    dt0 = jnp.exp(jax.random.uniform(ks[19], (DEPTH, 2, SSD_HEADS), f32, np.log(1e-3), np.log(1e-1)))
    ssd_dt_bias = dt0 + jnp.log(-jnp.expm1(-dt0))
    ssd_A_log = jnp.log(jax.random.uniform(ks[20], (DEPTH, 2, SSD_HEADS), f32, 1.0, 16.0))
    return {
        'x': nrm(ks[0], (BATCH, SEQ, D_MODEL), 1.0),
        'c': nrm(ks[1], (BATCH, D_MODEL), 1.0),
        'ctx': nrm(ks[2], (BATCH, CTX_LEN, D_MODEL), 1.0),
        'c_ctx': nrm(ks[3], (D_MODEL,), 1.0),
        'norm_w': 1.0 + nrm(ks[4], (DEPTH, D_MODEL), 0.02),
        'ada_w': nrm(ks[5], (DEPTH, D_MODEL, 3 * D_MODEL), 0.5 * D_MODEL ** -0.5),
        'ada_b': nrm(ks[6], (DEPTH, 3 * D_MODEL), 0.01),
        'w_in': nrm(ks[7], (DEPTH, D_MODEL, IN_WIDTH), D_MODEL ** -0.5),
        'lru_conv_w': nrm(ks[8], (DEPTH, CONV_W, LRU_WIDTH), CONV_W ** -0.5),
        'lru_conv_b': nrm(ks[9], (DEPTH, LRU_WIDTH), 0.01),
        'lru_ga_w': nrm(ks[10], (DEPTH, 2, LRU_BLOCKS, LRU_BLOCK, LRU_BLOCK), LRU_BLOCK ** -0.5),
        'lru_ga_b': nrm(ks[11], (DEPTH, 2, LRU_WIDTH), 0.01),
        'lru_gx_w': nrm(ks[12], (DEPTH, 2, LRU_BLOCKS, LRU_BLOCK, LRU_BLOCK), LRU_BLOCK ** -0.5),
        'lru_gx_b': nrm(ks[13], (DEPTH, 2, LRU_WIDTH), 0.01),
        'lru_lambda': lru_lambda,
        'att_q_norm': 1.0 + nrm(ks[15], (DEPTH, HEAD_DIM), 0.02),
        'att_k_norm': 1.0 + nrm(ks[16], (DEPTH, HEAD_DIM), 0.02),
        'att_sink': nrm(ks[17], (DEPTH, ATT_HEADS), 0.5),
        'ssd_conv_w': nrm(ks[18], (DEPTH, CONV_W, SSD_CONV_CH), CONV_W ** -0.5),
        'ssd_conv_b': nrm(ks[21], (DEPTH, SSD_CONV_CH), 0.01),
        'ssd_dt_bias': ssd_dt_bias,
        'ssd_A_log': ssd_A_log,
        'ssd_D': 1.0 + nrm(ks[22], (DEPTH, SSD_HEADS), 0.1),
        'ssd_norm_w': 1.0 + nrm(ks[23], (DEPTH, SSD_WIDTH), 0.02),
        'w_out': nrm(ks[24], (DEPTH, MIX_WIDTH, D_MODEL), MIX_WIDTH ** -0.5),
    }


def reference(x, c, ctx, c_ctx, norm_w, ada_w, ada_b, w_in,
              lru_conv_w, lru_conv_b, lru_ga_w, lru_ga_b, lru_gx_w, lru_gx_b, lru_lambda,
              att_q_norm, att_k_norm, att_sink,
              ssd_conv_w, ssd_conv_b, ssd_dt_bias, ssd_A_log, ssd_D, ssd_norm_w, w_out):
    cos, sin = rope_2d(x.shape[1])
    ctx_h = ctx
    for l in range(DEPTH):
        ctx_h, x = hybrid_layer(
            ctx_h, x, c, c_ctx, cos, sin, l < DEPTH - 1,
            norm_w[l], ada_w[l], ada_b[l], w_in[l],
            lru_conv_w[l], lru_conv_b[l], lru_ga_w[l], lru_ga_b[l], lru_gx_w[l], lru_gx_b[l], lru_lambda[l],
            att_q_norm[l], att_k_norm[l], att_sink[l],
            ssd_conv_w[l], ssd_conv_b[l], ssd_dt_bias[l], ssd_A_log[l], ssd_D[l], ssd_norm_w[l], w_out[l])
    return x
```

```cpp
#include <hip/hip_runtime.h>
#include <hip/hip_cooperative_groups.h>
#include <cstdio>
#include <cstdint>
namespace cg = cooperative_groups;

__device__ __forceinline__ int tidx() { int t = (int)threadIdx.x; asm volatile("" : "+v"(t)); return t; }

namespace pg8 {
#define PG8_LAS __attribute__((address_space(3)))
typedef unsigned short bf16_t;
typedef short bf16x8 __attribute__((ext_vector_type(8)));
typedef float f32x4 __attribute__((ext_vector_type(4)));
typedef unsigned u32x4 __attribute__((ext_vector_type(4)));
constexpr int BM = 256, BK = 64, HALF = 128, HTB = HALF * BK * 2  , STAGE_BYTES = 8 * HTB, NXCD = 8, WGM = 8;

__host__ __device__ __forceinline__ int lds_byte(int r, int c) { const int st = (r >> 4) * 2 + (c >> 5), rr = r & 15, cc = c & 31, ob = rr * 64 + cc * 2; return st * 1024 + (ob ^ (((ob >> 9) & 1) << 5)); }
__host__ __device__ __forceinline__ void stage_rc(int b, int& R, int& C) { const int st = b / 1024, sb = b % 1024, swz = sb ^ (((sb >> 9) & 1) << 5); R = (st >> 1) * 16 + swz / 64; C = (st & 1) * 32 + (swz % 64) / 2; }
__host__ __device__ __forceinline__ int perm32(int rho) { const int n = rho >> 4, i = rho & 15; return 8 * (i >> 2) + 4 * n + (i & 3); }

struct Unit { int pm, pn; };
struct Gemm { const bf16_t* A; const bf16_t* Bt; int M, N, K; };

struct Order {
    int nM, nN, nwg, G, c, skipctx;
    __device__ void init(int nM_, int nN_, int G_, int c_, int skip_) { nM = nM_; nN = nN_; nwg = nM * nN; G = G_; c = c_; skipctx = skip_; }
    __device__ bool next(int i, Unit& u) const {
        const long L = (long)i * G + c; if (L >= nwg) return false;
        int wgid = (int)L; { const int q = nwg / NXCD, r = nwg % NXCD, xcd = wgid % NXCD, off = wgid / NXCD; wgid = (xcd < r ? xcd * (q + 1) : r * (q + 1) + (xcd - r) * q) + off; }
        const int nig = WGM * nN, gid = wgid / nig, fm = gid * WGM, gsz = (nM - fm) < WGM ? (nM - fm) : WGM;
        int pm = fm + ((wgid % nig) % gsz); u.pn = (wgid % nig) / gsz;
        if (skipctx) pm = (pm >> 3) * 9 + 1 + (pm & 7);
        u.pm = pm; return true;
    }
    __device__ __forceinline__ void a_ready(const Unit&) const {}
    __device__ __forceinline__ void done(const Unit&) const {}
};
typedef __bf16 bf16x2_t __attribute__((ext_vector_type(2)));
typedef float f32x2_t __attribute__((ext_vector_type(2)));
__device__ __forceinline__ unsigned cvt_pk_bf16(float lo, float hi) { f32x2_t v = {lo, hi}; bf16x2_t b = __builtin_convertvector(v, bf16x2_t); return __builtin_bit_cast(unsigned, b); }

template <class Epi, class Sched>
__device__ __forceinline__ void gemm_phase(PG8_LAS unsigned char* lds, const Gemm g, const Sched& S, const Epi& E) {
    const int tid = tidx(), wid = __builtin_amdgcn_readfirstlane(tid >> 6), lane = tid & 63, wr = wid >> 2, wc = wid & 3, fr = lane & 15, fq = lane >> 4;
    const int K = g.K, nt = K / BK;
    unsigned voffA[2], voffB[2];
#pragma unroll
    for (int i = 0; i < 2; ++i) { int R, C; stage_rc(tid * 16 + i * 8192, R, C); const int Rb = Epi::PERM ? ((R & ~31) + perm32(R & 31)) : R;
        voffA[i] = (unsigned)(R * K + C) * 2u; voffB[i] = (unsigned)(Rb * K + C) * 2u; }
    const size_t kstep = (size_t)(BK * 2);
    const size_t hstep = (size_t)HALF * K * 2;
    const size_t tstep = 2 * hstep;
    const unsigned ldsw = (unsigned)wid * 1024u;
    const int aoff = lds_byte(wr * 64 + fr, fq * 8), boff = lds_byte(wc * 32 + fr, fq * 8);
#define PG8_SA(b, h) (((b) * 2 + (h)) * HTB)
#define PG8_SB(b, h) ((4 + (b) * 2 + (h)) * HTB)
#define PG8_STAGE(bufoff, gbase, voff) do { _Pragma("unroll") for (int _i = 0; _i < 2; ++_i) \
        __builtin_amdgcn_global_load_lds((const unsigned*)((const char*)(gbase) + (voff)[_i]), (PG8_LAS unsigned*)(lds + (bufoff) + ldsw + _i * 8192), 16, 0, 0); } while (0)
#define PG8_LDA(dst, b, h) do { _Pragma("unroll") for (int m = 0; m < 4; ++m) _Pragma("unroll") for (int k = 0; k < 2; ++k) dst[m][k] = *(const PG8_LAS bf16x8*)(lds + PG8_SA(b, h) + aoff + m * 2048 + k * 1024); } while (0)
#define PG8_LDB(dst, b, h) do { _Pragma("unroll") for (int n = 0; n < 2; ++n) _Pragma("unroll") for (int k = 0; k < 2; ++k) dst[n][k] = *(const PG8_LAS bf16x8*)(lds + PG8_SB(b, h) + boff + n * 2048 + k * 1024); } while (0)
#define PG8_MMA(ai, bj, At, Bt) do { __builtin_amdgcn_s_setprio(1); _Pragma("unroll") for (int m = 0; m < 4; ++m) _Pragma("unroll") for (int n = 0; n < 2; ++n) _Pragma("unroll") for (int k = 0; k < 2; ++k) \
        acc[ai][bj][m][n] = __builtin_amdgcn_mfma_f32_16x16x32_bf16(Bt[n][k], At[m][k], acc[ai][bj][m][n], 0, 0, 0); __builtin_amdgcn_s_setprio(0); } while (0)
#define PG8_WAIT_V(n) asm volatile("s_waitcnt vmcnt(" #n ")" ::: "memory")
#define PG8_WAIT_L(n) asm volatile("s_waitcnt lgkmcnt(" #n ")" ::: "memory")
#define PG8_BAR __builtin_amdgcn_s_barrier()
#define PG8_SCHED __builtin_amdgcn_sched_barrier(0)
    Unit cur, nxt; int ui = 0;
    if (!S.next(0, cur)) return;
    f32x4 acc[2][2][4][2];
#pragma unroll
    for (int a = 0; a < 2; ++a)
#pragma unroll
        for (int b = 0; b < 2; ++b)
#pragma unroll
            for (int m = 0; m < 4; ++m)
#pragma unroll
                for (int n = 0; n < 2; ++n) acc[a][b][m][n] = (f32x4){0.f, 0.f, 0.f, 0.f};
    bf16x8 At[4][2], B0[2][2], B1[2][2];
    const char* cA = (const char*)g.A + (size_t)cur.pm * tstep; const char* cB = (const char*)g.Bt + (size_t)cur.pn * tstep;
    S.a_ready(cur);
    PG8_STAGE(PG8_SB(0, 0), cB, voffB); PG8_STAGE(PG8_SA(0, 0), cA, voffA); PG8_STAGE(PG8_SB(0, 1), cB + hstep, voffB); PG8_STAGE(PG8_SA(0, 1), cA + hstep, voffA);
    if (wr == 1) PG8_BAR;
    PG8_WAIT_V(4); PG8_BAR;
    PG8_STAGE(PG8_SB(1, 0), cB + kstep, voffB); PG8_STAGE(PG8_SA(1, 0), cA + kstep, voffA); PG8_STAGE(PG8_SB(1, 1), cB + hstep + kstep, voffB);
    PG8_WAIT_V(6); PG8_BAR;
    for (;;) {
        const bool has_next = S.next(ui + 1, nxt);
        const char* nA = has_next ? (const char*)g.A + (size_t)nxt.pm * tstep : cA; const char* nB = has_next ? (const char*)g.Bt + (size_t)nxt.pn * tstep : cB;
        for (int t = 0; t < nt; t += 2) {
            const bool last = (t == nt - 2);
            const char* a1 = cA + (size_t)(t + 1) * kstep;
            const char* a2 = last ? nA : cA + (size_t)(t + 2) * kstep; const char* b2 = last ? nB : cB + (size_t)(t + 2) * kstep;
            const char* a3 = a2 + kstep; const char* b3 = b2 + kstep;
            if (last && has_next) S.a_ready(nxt);
            PG8_LDB(B0, 0, 0); PG8_SCHED; PG8_LDA(At, 0, 0); PG8_STAGE(PG8_SA(1, 1), a1 + hstep, voffA);
            PG8_WAIT_L(8); PG8_BAR; PG8_WAIT_L(0); PG8_MMA(0, 0, At, B0); PG8_BAR; PG8_SCHED;
            PG8_LDB(B1, 0, 1); PG8_STAGE(PG8_SB(0, 0), b2, voffB);
            PG8_BAR; PG8_WAIT_L(0); PG8_MMA(0, 1, At, B1); PG8_BAR;
            PG8_LDA(At, 0, 1); PG8_STAGE(PG8_SA(0, 0), a2, voffA);
            PG8_BAR; PG8_WAIT_L(0); PG8_MMA(1, 0, At, B0); PG8_BAR; PG8_SCHED;
            PG8_STAGE(PG8_SB(0, 1), b2 + hstep, voffB);
            PG8_WAIT_V(6); PG8_BAR; PG8_MMA(1, 1, At, B1); PG8_BAR;
            PG8_LDB(B0, 1, 0); PG8_SCHED; PG8_LDA(At, 1, 0); PG8_STAGE(PG8_SA(0, 1), a2 + hstep, voffA);
            PG8_WAIT_L(8); PG8_BAR; PG8_WAIT_L(0); PG8_MMA(0, 0, At, B0); PG8_BAR; PG8_SCHED;
            PG8_LDB(B1, 1, 1); PG8_STAGE(PG8_SB(1, 0), b3, voffB);
            PG8_BAR; PG8_WAIT_L(0); PG8_MMA(0, 1, At, B1); PG8_BAR;
            PG8_LDA(At, 1, 1); PG8_STAGE(PG8_SA(1, 0), a3, voffA);
            PG8_BAR; PG8_WAIT_L(0); PG8_MMA(1, 0, At, B0); PG8_BAR; PG8_SCHED;
            PG8_STAGE(PG8_SB(1, 1), b3 + hstep, voffB);
            PG8_WAIT_V(6); PG8_BAR; PG8_MMA(1, 1, At, B1); PG8_BAR;
        }
        if constexpr (!Epi::AFTER_DRAIN) { E(acc, cur, wr, wc, fr, fq); S.done(cur); }
        if (!has_next) break;
#pragma unroll
        for (int a = 0; a < 2; ++a)
#pragma unroll
            for (int b = 0; b < 2; ++b)
#pragma unroll
                for (int m = 0; m < 4; ++m)
#pragma unroll
                    for (int n = 0; n < 2; ++n) acc[a][b][m][n] = (f32x4){0.f, 0.f, 0.f, 0.f};
        cur = nxt; cA = nA; cB = nB; ++ui;
    }
    PG8_WAIT_V(0);
    if (wr == 0) PG8_BAR;
    PG8_BAR;
    if constexpr (Epi::AFTER_DRAIN) { E.fused(acc, cur, wr, wc, fr, fq, lds, wid, lane); S.done(cur); }
#undef PG8_SA
#undef PG8_SB
#undef PG8_STAGE
#undef PG8_LDA
#undef PG8_LDB
#undef PG8_MMA
#undef PG8_WAIT_V
#undef PG8_WAIT_L
#undef PG8_BAR
#undef PG8_SCHED
}
}

using pg8::bf16_t; using pg8::bf16x8; using pg8::f32x4; using pg8::cvt_pk_bf16;
typedef float f32x16 __attribute__((ext_vector_type(16)));
typedef float f32x8 __attribute__((ext_vector_type(8)));
typedef unsigned u32x2 __attribute__((ext_vector_type(2)));
typedef unsigned u32x4 __attribute__((ext_vector_type(4)));

constexpr int DM = 2048, TPB = 2304, NTOK = 18432, LDP = 7424, MIXW = 3072, NCH = 18;
constexpr int C_LX = 0, C_LG = 1024, C_Q = 2048, C_K = 3072, C_V = 3328, C_AG = 3584, C_XBC = 4608, C_Z = 6144, C_DT = 7168;
constexpr size_t SZ_WTIN = (size_t)4 * 7424 * 2048 * 2, SZ_WTOUT = (size_t)4 * 2048 * 3072 * 2, SZ_MOD = (size_t)4 * 9 * 6144 * 4, SZ_U = (size_t)NTOK * 2048 * 2,
                 SZ_P = (size_t)NTOK * LDP * 2, SZ_MIX = (size_t)NTOK * MIXW * 2, SZ_XB = (size_t)NTOK * 2048 * 4, SZ_ST = (size_t)8 * 2 * 18 * 16 * 8192 * 2,
                 SZ_AL = (size_t)8 * 2 * 18 * 16 * 4, SZ_SUM = (size_t)8 * 2 * 18 * 1024 * 4;
constexpr size_t OFF_WTIN = 0, OFF_WTOUT = OFF_WTIN + SZ_WTIN, OFF_MOD = OFF_WTOUT + SZ_WTOUT, OFF_U = OFF_MOD + SZ_MOD, OFF_P = OFF_U + SZ_U, OFF_MIX = OFF_P + SZ_P,
                 OFF_XB = OFF_MIX + SZ_MIX, OFF_ST = OFF_XB + SZ_XB, OFF_AL = OFF_ST + SZ_ST, OFF_SUMA = OFF_AL + SZ_AL, OFF_SUMB = OFF_SUMA + SZ_SUM, WS_END = OFF_SUMB + SZ_SUM;
constexpr int LDS_BYTES = 131072;

struct Params {
    const float *x, *c, *ctx, *c_ctx, *norm_w, *ada_w, *ada_b, *w_in, *lru_conv_w, *lru_conv_b, *lru_ga_w, *lru_ga_b, *lru_gx_w, *lru_gx_b, *lru_lambda,
        *att_q_norm, *att_k_norm, *att_sink, *ssd_conv_w, *ssd_conv_b, *ssd_dt_bias, *ssd_A_log, *ssd_D, *ssd_norm_w, *w_out;
    float* out;
    unsigned char* ws;
};
#define WS_WTIN(p) ((bf16_t*)((p).ws + OFF_WTIN))
#define WS_WTOUT(p) ((bf16_t*)((p).ws + OFF_WTOUT))
#define WS_MOD(p) ((float*)((p).ws + OFF_MOD))
#define WS_U(p) ((bf16_t*)((p).ws + OFF_U))
#define WS_P(p) ((bf16_t*)((p).ws + OFF_P))
#define WS_MIX(p) ((bf16_t*)((p).ws + OFF_MIX))
#define WS_XB(p) ((float*)((p).ws + OFF_XB))
#define WS_ST(p) ((bf16_t*)((p).ws + OFF_ST))
#define WS_AL(p) ((float*)((p).ws + OFF_AL))
#define WS_SUMA(p) ((float*)((p).ws + OFF_SUMA))
#define WS_SUMB(p) ((float*)((p).ws + OFF_SUMB))

__device__ __forceinline__ float bf2f(bf16_t v) { return __uint_as_float(((unsigned)v) << 16); }
__device__ __forceinline__ bf16_t f2bf(float f) { return (bf16_t)(cvt_pk_bf16(f, 0.f) & 0xffffu); }
__device__ __forceinline__ float siluf(float v) { return v / (1.f + __expf(-v)); }
__device__ __forceinline__ float sigmf(float v) { return 1.f / (1.f + __expf(-v)); }
__device__ __forceinline__ float softplusf(float v) { return v > 20.f ? v : log1pf(__expf(v)); }
__device__ __forceinline__ float wave_sum(float v) {
#pragma unroll
    for (int o = 1; o < 64; o <<= 1) v += __shfl_xor(v, o);
    return v;
}
__device__ __forceinline__ f32x8 unpack8(const u32x4 w) {
    f32x8 f;
    f[0] = __uint_as_float(w.x << 16); f[1] = __uint_as_float(w.x & 0xffff0000u); f[2] = __uint_as_float(w.y << 16); f[3] = __uint_as_float(w.y & 0xffff0000u);
    f[4] = __uint_as_float(w.z << 16); f[5] = __uint_as_float(w.z & 0xffff0000u); f[6] = __uint_as_float(w.w << 16); f[7] = __uint_as_float(w.w & 0xffff0000u);
    return f;
}
__device__ __forceinline__ u32x4 pack8(const f32x8 f) { u32x4 w; w.x = cvt_pk_bf16(f[0], f[1]); w.y = cvt_pk_bf16(f[2], f[3]); w.z = cvt_pk_bf16(f[4], f[5]); w.w = cvt_pk_bf16(f[6], f[7]); return w; }
__device__ __forceinline__ int chunk_at(int d, int pos) { return d == 0 ? pos : (pos < 2 ? 1 - pos : 19 - pos); }
__device__ __forceinline__ int pos_of(int d, int c) { return d == 0 ? c : (c < 2 ? 1 - c : 19 - c); }
__device__ __forceinline__ int rowmap32(int reg, int lane) { return (reg & 3) + 8 * (reg >> 2) + 4 * (lane >> 5); }

template <int K> __device__ __forceinline__ void mm32(f32x16& acc, const bf16_t* A, int lda, const bf16_t* B, int ldb, int lane) {
    const bf16_t* pa = A + (lane & 31) * lda + 8 * (lane >> 5);
    const bf16_t* pb = B + (lane & 31) * ldb + 8 * (lane >> 5);
#pragma unroll
    for (int k = 0; k < K; k += 16) {
        const bf16x8 a = *(const bf16x8*)(pa + k);
        const bf16x8 b = *(const bf16x8*)(pb + k);
        acc = __builtin_amdgcn_mfma_f32_32x32x16_bf16(a, b, acc, 0, 0, 0);
    }
}

template <int NC, bool SILU, bool TRANS>
__device__ __forceinline__ void stage_conv_tile(bf16_t* dst, int ld, const bf16_t* Pb, int t0, int col0, const float* cw, int CS, const float* cb, int tid) {
    constexpr int CG = NC / 8;
    const int lo = t0 < 256 ? 0 : 256, hi = t0 < 256 ? 256 : TPB;
    for (int idx = tid; idx < 128 * CG; idx += 512) {
        int cgi, tl;
        if (TRANS) { tl = idx & 127; cgi = idx >> 7; } else { cgi = idx % CG; tl = idx / CG; }
        const int t = t0 + tl;
        const f32x4 b0 = *(const f32x4*)(cb + cgi * 8), b1 = *(const f32x4*)(cb + cgi * 8 + 4);
        f32x8 acc; acc[0] = b0.x; acc[1] = b0.y; acc[2] = b0.z; acc[3] = b0.w; acc[4] = b1.x; acc[5] = b1.y; acc[6] = b1.z; acc[7] = b1.w;
#pragma unroll
        for (int k = 0; k < 4; ++k) {
            const int tt = t - 2 + k;
            if (tt >= lo && tt < hi) {
                const f32x8 v = unpack8(*(const u32x4*)(Pb + (size_t)tt * LDP + col0 + cgi * 8));
                const f32x4 w0 = *(const f32x4*)(cw + k * CS + cgi * 8), w1 = *(const f32x4*)(cw + k * CS + cgi * 8 + 4);
                acc[0] += w0.x * v[0]; acc[1] += w0.y * v[1]; acc[2] += w0.z * v[2]; acc[3] += w0.w * v[3];
                acc[4] += w1.x * v[4]; acc[5] += w1.y * v[5]; acc[6] += w1.z * v[6]; acc[7] += w1.w * v[7];
            }
        }
        if (SILU) {
#pragma unroll
            for (int e = 0; e < 8; ++e) acc[e] = siluf(acc[e]);
        }
        if (TRANS) {
#pragma unroll
            for (int e = 0; e < 8; ++e) dst[(cgi * 8 + e) * ld + tl] = f2bf(acc[e]);
        } else {
            *(u32x4*)(dst + tl * ld + cgi * 8) = pack8(acc);
        }
    }
}

__device__ __forceinline__ void transpose_item(const float* W, int K, int N, int nblk, bf16_t* WT, float* scr, int item, int lane) {
    const int kb = item / nblk, nb = item % nblk, k0 = 64 * kb, n0 = 32 * nb;
    const int n = n0 + (lane & 31);
#pragma unroll 8
    for (int i = 0; i < 32; ++i) { const int kk = 2 * i + (lane >> 5); scr[kk * 33 + (lane & 31)] = (n < N) ? W[(size_t)(k0 + kk) * N + n] : 0.f; }
    asm volatile("s_waitcnt lgkmcnt(0)" ::: "memory");
    const int c = lane & 7;
#pragma unroll
    for (int j = 0; j < 4; ++j) {
        const int nn = (lane >> 3) + 8 * j; const float* s = scr + (8 * c) * 33 + nn;
        u32x4 o; o.x = cvt_pk_bf16(s[0 * 33], s[1 * 33]); o.y = cvt_pk_bf16(s[2 * 33], s[3 * 33]); o.z = cvt_pk_bf16(s[4 * 33], s[5 * 33]); o.w = cvt_pk_bf16(s[6 * 33], s[7 * 33]);
        *(u32x4*)(WT + (size_t)(n0 + nn) * K + k0 + 8 * c) = o;
    }
    asm volatile("s_waitcnt lgkmcnt(0)" ::: "memory");
}

__device__ __forceinline__ void phase0(const Params& p, unsigned char* shm, int G) {
    const int tid = tidx(), lane = tid & 63, wave = tid >> 6;
    float* sf = (float*)shm;
    float* MOD = WS_MOD(p);
    for (int item = blockIdx.x; item < 96; item += G) {
        const int l = item / 24, cgp = item % 24;
        __syncthreads();
        for (int idx = tid; idx < 9 * 2048; idx += 512) { const int r = idx >> 11, k = idx & 2047; const float v = r < 8 ? p.c[r * 2048 + k] : p.c_ctx[k]; sf[idx] = siluf(v); }
        __syncthreads();
        f32x4 acc[9];
#pragma unroll
        for (int r = 0; r < 9; ++r) acc[r] = (f32x4){0.f, 0.f, 0.f, 0.f};
        const float* wp = p.ada_w + ((size_t)l * 2048 + wave * 256) * 6144 + cgp * 256 + lane * 4;
#pragma unroll 4
        for (int kk = 0; kk < 256; ++kk) {
            const f32x4 wv = *(const f32x4*)(wp + (size_t)kk * 6144);
            const int k = wave * 256 + kk;
#pragma unroll
            for (int r = 0; r < 9; ++r) { const float s = sf[r * 2048 + k]; acc[r] += wv * s; }
        }
        __syncthreads();
#pragma unroll
        for (int r = 0; r < 9; ++r) *(f32x4*)(sf + (wave * 9 + r) * 256 + lane * 4) = acc[r];
        __syncthreads();
        for (int idx = tid; idx < 9 * 256; idx += 512) {
            const int r = idx >> 8, col = idx & 255; float s = p.ada_b[l * 6144 + cgp * 256 + col];
#pragma unroll
            for (int w = 0; w < 8; ++w) s += sf[(w * 9 + r) * 256 + col];
            MOD[(size_t)(l * 9 + r) * 6144 + cgp * 256 + col] = s;
        }
    }
    __syncthreads();
    float* scr = sf + wave * (64 * 33);
    const int gw = blockIdx.x * 8 + wave, NGW = G * 8;
    constexpr int I_IN = 32 * 232, I_OUT = 48 * 64;
    for (int it = gw; it < 4 * (I_IN + I_OUT); it += NGW) {
        if (it < 4 * I_IN) { const int l = it / I_IN, r = it % I_IN; transpose_item(p.w_in + (size_t)l * 2048 * 7184, 2048, 7184, 232, WS_WTIN(p) + (size_t)l * 7424 * 2048, scr, r, lane); }
        else { const int it2 = it - 4 * I_IN, l = it2 / I_OUT, r = it2 % I_OUT; transpose_item(p.w_out + (size_t)l * 3072 * 2048, 3072, 2048, 64, WS_WTOUT(p) + (size_t)l * 2048 * 3072, scr, r, lane); }
    }
}

__device__ __forceinline__ const float* xrow_src(const Params& p, int l, int row) {
    const int b = row / TPB, t = row % TPB;
    if (l == 0) return t < 256 ? p.ctx + ((size_t)b * 256 + t) * DM : p.x + ((size_t)b * 2048 + (t - 256)) * DM;
    return WS_XB(p) + (size_t)row * DM;
}
__device__ __forceinline__ void norm_phase(const Params& p, int l, int G) {
    const int lane = tidx() & 63, wave = tidx() >> 6;
    bf16_t* U = WS_U(p);
    for (int row = blockIdx.x * 8 + wave; row < NTOK; row += G * 8) {
        const int b = row / TPB, t = row % TPB;
        const float* src = xrow_src(p, l, row);
        const float* md = WS_MOD(p) + (size_t)(l * 9 + (t < 256 ? 8 : b)) * 6144;
        f32x4 v[8]; float ss = 0.f;
#pragma unroll
        for (int j = 0; j < 8; ++j) { v[j] = *(const f32x4*)(src + 4 * lane + 256 * j); ss += v[j].x * v[j].x + v[j].y * v[j].y + v[j].z * v[j].z + v[j].w * v[j].w; }
        ss = wave_sum(ss);
        const float rstd = rsqrtf(ss * (1.f / 2048.f) + 1e-6f);
#pragma unroll
        for (int j = 0; j < 8; ++j) {
            const int col = 4 * lane + 256 * j;
            const f32x4 nw = *(const f32x4*)(p.norm_w + l * 2048 + col), sh = *(const f32x4*)(md + col), sc = *(const f32x4*)(md + 2048 + col);
            const f32x4 y = v[j] * rstd * nw * (sc + 1.f) + sh;
            u32x2 w; w.x = cvt_pk_bf16(y.x, y.y); w.y = cvt_pk_bf16(y.z, y.w);
            *(u32x2*)(U + (size_t)row * DM + col) = w;
        }
    }
}

struct EpiG1 {
    static constexpr bool PERM = false, AFTER_DRAIN = false;
    bf16_t* P;
    __device__ __forceinline__ void operator()(const f32x4 (&acc)[2][2][4][2], const pg8::Unit& u, int wr, int wc, int fr, int fq) const {
        const int row0 = u.pm * 256 + wr * 64 + fr, col0 = u.pn * 256 + wc * 32 + 4 * fq;
#pragma unroll
        for (int ai = 0; ai < 2; ++ai)
#pragma unroll
            for (int m = 0; m < 4; ++m) { bf16_t* rowp = P + (size_t)(row0 + ai * 128 + m * 16) * LDP + col0;
#pragma unroll
                for (int bj = 0; bj < 2; ++bj)
#pragma unroll
                    for (int n = 0; n < 2; ++n) { const f32x4 v = acc[ai][bj][m][n]; u32x2 w; w.x = cvt_pk_bf16(v.x, v.y); w.y = cvt_pk_bf16(v.z, v.w); *(u32x2*)(rowp + bj * 128 + n * 16) = w; } }
    }
};
struct EpiG2 {
    static constexpr bool PERM = false, AFTER_DRAIN = false;
    Params p; int l;
    __device__ __forceinline__ void operator()(const f32x4 (&acc)[2][2][4][2], const pg8::Unit& u, int wr, int wc, int fr, int fq) const {
        const int row0 = u.pm * 256 + wr * 64 + fr, col0 = u.pn * 256 + wc * 32 + 4 * fq;
#pragma unroll
        for (int ai = 0; ai < 2; ++ai)
#pragma unroll
            for (int m = 0; m < 4; ++m) {
                const int row = row0 + ai * 128 + m * 16, b = row / TPB, t = row % TPB;
                if (l == 3 && t < 256) continue;
                const float* xo = xrow_src(p, l, row);
                float* dst = (l == 3) ? p.out + ((size_t)b * 2048 + (t - 256)) * DM : WS_XB(p) + (size_t)row * DM;
                const float* gt = WS_MOD(p) + (size_t)(l * 9 + (t < 256 ? 8 : b)) * 6144 + 4096;
#pragma unroll
                for (int bj = 0; bj < 2; ++bj)
#pragma unroll
                    for (int n = 0; n < 2; ++n) { const int col = col0 + bj * 128 + n * 16; const f32x4 xv = *(const f32x4*)(xo + col), g = *(const f32x4*)(gt + col); *(f32x4*)(dst + col) = xv + g * acc[ai][bj][m][n]; }
            }
    }
};

__device__ __forceinline__ void qkprep_row(const Params& p, int l, int row, int lane) {
    const int t = row % TPB;
    bf16_t* rp = WS_P(p) + (size_t)row * LDP;
    float cs = 1.f, sn = 0.f;
    if (t >= 256) {
        const int s = t - 256, rr = s >> 6, cc = s & 63, f = lane & 31;
        const float inv = exp2f(-(float)f * (13.287712379549449f / 32.f));
        const float ang = (float)(lane < 32 ? rr : cc) * inv;
        cs = __cosf(ang); sn = __sinf(ang);
    }
#pragma unroll
    for (int slot = 0; slot < 10; ++slot) {
        const int col = slot < 8 ? C_Q + slot * 128 : C_K + (slot - 8) * 128;
        const float* w = slot < 8 ? p.att_q_norm + l * 128 : p.att_k_norm + l * 128;
        const float v1 = bf2f(rp[col + lane]), v2 = bf2f(rp[col + 64 + lane]);
        const float ss = wave_sum(v1 * v1 + v2 * v2);
        const float rstd = rsqrtf(ss * (1.f / 128.f) + 1e-6f);
        const float y1 = v1 * rstd * w[lane], y2 = v2 * rstd * w[64 + lane];
        float o1 = y1 * cs - y2 * sn, o2 = y1 * sn + y2 * cs;
        if (slot < 8) { o1 *= 0.08838834764831845f; o2 *= 0.08838834764831845f; }
        rp[col + lane] = f2bf(o1); rp[col + 64 + lane] = f2bf(o2);
    }
}

template <bool FINAL, int D>
__device__ __forceinline__ void lru_dir(const Params& p, int l, int b, int c, int j, unsigned char* shm, float (&hacc)[16]) {
    const int tid = tidx(), lane = tid & 63, wave = tid >> 6, ch = tid & 63, seg = tid >> 6;
    bf16_t* sX = (bf16_t*)shm; bf16_t* sWa = (bf16_t*)(shm + 18432); bf16_t* sWx = (bf16_t*)(shm + 27648);
    float* sA = (float*)(shm + 36864); float* sB = (float*)(shm + 69632); float* sSA = (float*)(shm + 102400); float* sSB = (float*)(shm + 104448);
    const float* ga = p.lru_ga_w + (size_t)((l * 2 + D) * 16 + j) * 4096; const float* gx = p.lru_gx_w + (size_t)((l * 2 + D) * 16 + j) * 4096;
    for (int idx = tid; idx < 4096; idx += 512) { const int i = idx >> 6, o = idx & 63; sWa[o * 72 + i] = f2bf(ga[idx]); sWx[o * 72 + i] = f2bf(gx[idx]); }
    __syncthreads();
    {
        const int mi = wave & 3, nj = wave >> 2;
        f32x16 aa, ax;
#pragma unroll
        for (int r = 0; r < 16; ++r) { aa[r] = 0.f; ax[r] = 0.f; }
        mm32<64>(aa, sX + mi * 32 * 72, 72, sWa + nj * 32 * 72, 72, lane);
        mm32<64>(ax, sX + mi * 32 * 72, 72, sWx + nj * 32 * 72, 72, lane);
        const int cl = nj * 32 + (lane & 31), cgl = j * 64 + cl;
        const float ba = p.lru_ga_b[(l * 2 + D) * 1024 + cgl], bx = p.lru_gx_b[(l * 2 + D) * 1024 + cgl], sp = softplusf(-p.lru_lambda[(l * 2 + D) * 1024 + cgl]);
#pragma unroll
        for (int r = 0; r < 16; ++r) {
            const int tl = mi * 32 + rowmap32(r, lane);
            const float rg = sigmf(aa[r] + ba), ig = sigmf(ax[r] + bx);
            const float la = -8.f * rg * sp;
            const float a = __expf(la), mult = sqrtf(fmaxf(1.f - __expf(2.f * la), 0.f));
            const float xv = bf2f(sX[tl * 72 + cl]);
            sA[tl * 64 + cl] = a; sB[tl * 64 + cl] = mult * ig * xv;
        }
    }
    __syncthreads();
    {
        float A = 1.f, Bc = 0.f;
#pragma unroll
        for (int q = 0; q < 16; ++q) { const int tl = seg * 16 + (D == 0 ? q : 15 - q); const float a = sA[tl * 64 + ch], bb = sB[tl * 64 + ch]; A = a * A; Bc = a * Bc + bb; }
        sSA[seg * 64 + ch] = A; sSB[seg * 64 + ch] = Bc;
    }
    __syncthreads();
    if (!FINAL) {
        if (tid < 64) {
            float At = 1.f, Bt = 0.f;
#pragma unroll
            for (int s = 0; s < 8; ++s) { const int sg = D == 0 ? s : 7 - s; const float a = sSA[sg * 64 + ch], bb = sSB[sg * 64 + ch]; At = a * At; Bt = a * Bt + bb; }
            const size_t idx = (size_t)((b * 2 + D) * 18 + c) * 1024 + j * 64 + ch;
            WS_SUMA(p)[idx] = At; WS_SUMB(p)[idx] = Bt;
        }
    } else {
        float h = 0.f;
        const int pos = pos_of(D, c);
        for (int q = 0; q < pos; ++q) { const int cc = chunk_at(D, q); const size_t idx = (size_t)((b * 2 + D) * 18 + cc) * 1024 + j * 64 + ch; h = WS_SUMA(p)[idx] * h + WS_SUMB(p)[idx]; }
        const int nseg = D == 0 ? seg : 7 - seg;
        for (int s = 0; s < nseg; ++s) { const int sg = D == 0 ? s : 7 - s; h = sSA[sg * 64 + ch] * h + sSB[sg * 64 + ch]; }
#pragma unroll
        for (int q = 0; q < 16; ++q) { const int qq = D == 0 ? q : 15 - q; const int tl = seg * 16 + qq; h = sA[tl * 64 + ch] * h + sB[tl * 64 + ch]; hacc[qq] += h; }
    }
}
template <bool FINAL>
__device__ __forceinline__ void lru_item(const Params& p, int l, int item, unsigned char* shm) {
    const int tid = tidx(), ch = tid & 63, seg = tid >> 6;
    const int j = item & 15, bc = item >> 4, c = bc % NCH, b = bc / NCH, t0 = c * 128;
    const bf16_t* Pb = WS_P(p) + (size_t)b * TPB * LDP;
    __syncthreads();
    stage_conv_tile<64, false, false>((bf16_t*)shm, 72, Pb, t0, C_LX + j * 64, p.lru_conv_w + l * 4 * 1024 + j * 64, 1024, p.lru_conv_b + l * 1024 + j * 64, tid);
    float hacc[16];
#pragma unroll
    for (int q = 0; q < 16; ++q) hacc[q] = 0.f;
    lru_dir<FINAL, 0>(p, l, b, c, j, shm, hacc);
    lru_dir<FINAL, 1>(p, l, b, c, j, shm, hacc);
    if (FINAL) {
#pragma unroll
        for (int q = 0; q < 16; ++q) {
            const size_t tok = (size_t)b * TPB + t0 + seg * 16 + q;
            const float lg = bf2f(WS_P(p)[tok * LDP + C_LG + j * 64 + ch]);
            WS_MIX(p)[tok * MIXW + j * 64 + ch] = f2bf(hacc[q] * siluf(lg));
        }
    }
}

__device__ __forceinline__ void ssd_dt_acs(const Params& p, int l, int b, int c, int g, float* sDt, float* sAcs, float* sAl, bool write_al) {
    const int tid = tidx();
    for (int idx = tid; idx < 128 * 16; idx += 512) {
        const int jj = idx >> 4, col = idx & 15, hh = col >> 1, d = col & 1;
        const float dtp = bf2f(WS_P(p)[((size_t)b * TPB + c * 128 + jj) * LDP + C_DT + g * 8 + hh]);
        sDt[idx] = softplusf(dtp + p.ssd_dt_bias[(l * 2 + d) * 16 + g * 8 + hh]);
    }
    __syncthreads();
    if (tid < 16) {
        const int hh = tid >> 1, d = tid & 1;
        const float A = -__expf(p.ssd_A_log[(l * 2 + d) * 16 + g * 8 + hh]);
        float run = 0.f;
        if (d == 0) { for (int jj = 0; jj < 128; ++jj) { run += sDt[jj * 16 + tid] * A; sAcs[jj * 16 + tid] = run; } }
        else { for (int jj = 127; jj >= 0; --jj) { run += sDt[jj * 16 + tid] * A; sAcs[jj * 16 + tid] = run; } }
        sAl[tid] = run;
        if (write_al) WS_AL(p)[((b * 2 + d) * 18 + c) * 16 + g * 8 + hh] = run;
    }
    __syncthreads();
}
__device__ __forceinline__ void ssd_states_item(const Params& p, int l, int item, unsigned char* shm) {
    const int tid = tidx(), lane = tid & 63, wave = tid >> 6;
    const int g = item & 1, bc = item >> 1, c = bc % NCH, b = bc / NCH, t0 = c * 128;
    const bf16_t* Pb = WS_P(p) + (size_t)b * TPB * LDP;
    bf16_t* sBT = (bf16_t*)shm; bf16_t* sXT = (bf16_t*)(shm + 34816); bf16_t* sXw = (bf16_t*)(shm + 52224);
    float* sDt = (float*)(shm + 87040); float* sAcs = (float*)(shm + 95232); float* sAl = (float*)(shm + 103424);
    __syncthreads();
    ssd_dt_acs(p, l, b, c, g, sDt, sAcs, sAl, true);
    stage_conv_tile<128, true, true>(sBT, 136, Pb, t0, C_XBC + 1024 + g * 128, p.ssd_conv_w + l * 4 * 1536 + 1024 + g * 128, 1536, p.ssd_conv_b + l * 1536 + 1024 + g * 128, tid);
    for (int hh = 0; hh < 8; ++hh) {
        const int h = g * 8 + hh;
        __syncthreads();
        stage_conv_tile<64, true, true>(sXT, 136, Pb, t0, C_XBC + h * 64, p.ssd_conv_w + l * 4 * 1536 + h * 64, 1536, p.ssd_conv_b + l * 1536 + h * 64, tid);
        __syncthreads();
        for (int idx = tid; idx < 64 * 16; idx += 512) {
            const int pp = idx >> 4, j8 = (idx & 15) * 8;
            const f32x8 xv = unpack8(*(const u32x4*)(sXT + pp * 136 + j8));
#pragma unroll
            for (int d = 0; d < 2; ++d) {
                const int col = hh * 2 + d; const float al = sAl[col];
                f32x8 o;
#pragma unroll
                for (int e = 0; e < 8; ++e) o[e] = xv[e] * __expf(al - sAcs[(j8 + e) * 16 + col]) * sDt[(j8 + e) * 16 + col];
                *(u32x4*)(sXw + d * 8704 + pp * 136 + j8) = pack8(o);
            }
        }
        __syncthreads();
        const int mi = wave & 1, nj = wave >> 1;
#pragma unroll
        for (int d = 0; d < 2; ++d) {
            f32x16 acc;
#pragma unroll
            for (int r = 0; r < 16; ++r) acc[r] = 0.f;
            mm32<128>(acc, sXw + d * 8704 + mi * 32 * 136, 136, sBT + nj * 32 * 136, 136, lane);
            bf16_t* base = WS_ST(p) + ((size_t)((b * 2 + d) * 18 + c) * 16 + h) * 8192;
#pragma unroll
            for (int r = 0; r < 16; ++r) base[(mi * 32 + rowmap32(r, lane)) * 128 + nj * 32 + (lane & 31)] = f2bf(acc[r]);
        }
    }
}
__device__ __forceinline__ void ssd_recur_item(const Params& p, int item) {
    const int tid = tidx();
    const int d = item & 1, h = (item >> 1) & 15, b = item >> 5;
    f32x8 h0, h1;
#pragma unroll
    for (int e = 0; e < 8; ++e) { h0[e] = 0.f; h1[e] = 0.f; }
    for (int pos = 0; pos < NCH; ++pos) {
        const int c = chunk_at(d, pos);
        bf16_t* ptr = WS_ST(p) + ((size_t)((b * 2 + d) * 18 + c) * 16 + h) * 8192 + tid * 16;
        const f32x8 s0 = unpack8(*(const u32x4*)ptr), s1 = unpack8(*(const u32x4*)(ptr + 8));
        const float e = __expf(WS_AL(p)[((b * 2 + d) * 18 + c) * 16 + h]);
        *(u32x4*)ptr = pack8(h0); *(u32x4*)(ptr + 8) = pack8(h1);
        h0 = h0 * e + s0; h1 = h1 * e + s1;
    }
}
__device__ __forceinline__ void ssd_final_item(const Params& p, int l, int item, unsigned char* shm) {
    const int tid = tidx(), lane = tid & 63, wave = tid >> 6;
    const int g = item & 1, bc = item >> 1, c = bc % NCH, b = bc / NCH, t0 = c * 128;
    const bf16_t* Pb = WS_P(p) + (size_t)b * TPB * LDP;
    bf16_t* sC = (bf16_t*)shm; bf16_t* sBW = (bf16_t*)(shm + 34816); bf16_t* sXT = (bf16_t*)(shm + 69632); bf16_t* sH = (bf16_t*)(shm + 87040);
    float* sDt = (float*)(shm + 104448); float* sAcs = (float*)(shm + 112640); float* sAl = (float*)(shm + 120832);
    __syncthreads();
    ssd_dt_acs(p, l, b, c, g, sDt, sAcs, sAl, false);
    stage_conv_tile<128, true, false>(sC, 136, Pb, t0, C_XBC + 1280 + g * 128, p.ssd_conv_w + l * 4 * 1536 + 1280 + g * 128, 1536, p.ssd_conv_b + l * 1536 + 1280 + g * 128, tid);
    stage_conv_tile<128, true, false>(sBW, 136, Pb, t0, C_XBC + 1024 + g * 128, p.ssd_conv_w + l * 4 * 1536 + 1024 + g * 128, 1536, p.ssd_conv_b + l * 1536 + 1024 + g * 128, tid);
    __syncthreads();
    const int cmi = wave >> 1, cnj0 = (wave & 1) * 2;
    f32x16 cb0, cb1;
#pragma unroll
    for (int r = 0; r < 16; ++r) { cb0[r] = 0.f; cb1[r] = 0.f; }
    mm32<128>(cb0, sC + cmi * 32 * 136, 136, sBW + cnj0 * 32 * 136, 136, lane);
    mm32<128>(cb1, sC + cmi * 32 * 136, 136, sBW + (cnj0 + 1) * 32 * 136, 136, lane);
    const int ymi = wave & 3, ynj = wave >> 2;
#pragma unroll 1
    for (int hh = 0; hh < 8; ++hh) {
        const int h = g * 8 + hh;
        __syncthreads();
        stage_conv_tile<64, true, true>(sXT, 136, Pb, t0, C_XBC + h * 64, p.ssd_conv_w + l * 4 * 1536 + h * 64, 1536, p.ssd_conv_b + l * 1536 + h * 64, tid);
        f32x16 yacc;
#pragma unroll
        for (int r = 0; r < 16; ++r) yacc[r] = 0.f;
#pragma unroll 1
        for (int d = 0; d < 2; ++d) {
            const int col = hh * 2 + d;
            if (d == 1) __syncthreads();
#pragma unroll
            for (int tt = 0; tt < 2; ++tt) {
                const int jg = (cnj0 + tt) * 32 + (lane & 31);
                const float acj = sAcs[jg * 16 + col], dtj = sDt[jg * 16 + col];
#pragma unroll
                for (int r = 0; r < 16; ++r) {
                    const int ig = cmi * 32 + rowmap32(r, lane);
                    const bool valid = d == 0 ? (jg <= ig) : (jg >= ig);
                    const float cbv = tt == 0 ? cb0[r] : cb1[r];
                    const float val = valid ? cbv * __expf(sAcs[ig * 16 + col] - acj) * dtj : 0.f;
                    sBW[ig * 136 + jg] = f2bf(val);
                }
            }
            {
                const bf16_t* hp = WS_ST(p) + ((size_t)((b * 2 + d) * 18 + c) * 16 + h) * 8192 + tid * 16;
                const int pp = tid >> 3, n0 = (tid & 7) * 16;
                *(u32x4*)(sH + pp * 136 + n0) = *(const u32x4*)hp; *(u32x4*)(sH + pp * 136 + n0 + 8) = *(const u32x4*)(hp + 8);
            }
            __syncthreads();
            f32x16 ad, ao;
#pragma unroll
            for (int r = 0; r < 16; ++r) { ad[r] = 0.f; ao[r] = 0.f; }
            mm32<128>(ad, sBW + ymi * 32 * 136, 136, sXT + ynj * 32 * 136, 136, lane);
            mm32<128>(ao, sC + ymi * 32 * 136, 136, sH + ynj * 32 * 136, 136, lane);
#pragma unroll
            for (int r = 0; r < 16; ++r) { const int ig = ymi * 32 + rowmap32(r, lane); yacc[r] += ad[r] + __expf(sAcs[ig * 16 + col]) * ao[r]; }
        }
        const float Dh = p.ssd_D[l * 16 + h];
        const int pl = ynj * 32 + (lane & 31);
#pragma unroll
        for (int r = 0; r < 16; ++r) {
            const int ig = ymi * 32 + rowmap32(r, lane);
            const size_t tok = (size_t)b * TPB + t0 + ig;
            const float y = yacc[r] + Dh * bf2f(sXT[pl * 136 + ig]);
            const float z = bf2f(WS_P(p)[tok * LDP + C_Z + h * 64 + pl]);
            WS_MIX(p)[tok * MIXW + 2048 + h * 64 + pl] = f2bf(y * siluf(z));
        }
    }
}
__device__ __forceinline__ void ssd_norm_phase(const Params& p, int l, int G) {
    const int lane = tidx() & 63, wave = tidx() >> 6;
    for (int row = blockIdx.x * 8 + wave; row < NTOK; row += G * 8) {
        bf16_t* rp = WS_MIX(p) + (size_t)row * MIXW + 2048;
        f32x8 v0 = unpack8(*(const u32x4*)(rp + lane * 8)), v1 = unpack8(*(const u32x4*)(rp + 512 + lane * 8));
        float ss = 0.f;
#pragma unroll
        for (int e = 0; e < 8; ++e) ss += v0[e] * v0[e] + v1[e] * v1[e];
        ss = wave_sum(ss);
        const float rstd = rsqrtf(ss * (1.f / 1024.f) + 1e-6f);
        const float* nw = p.ssd_norm_w + l * 1024;
#pragma unroll
        for (int e = 0; e < 8; ++e) { v0[e] = v0[e] * rstd * nw[lane * 8 + e]; v1[e] = v1[e] * rstd * nw[512 + lane * 8 + e]; }
        *(u32x4*)(rp + lane * 8) = pack8(v0); *(u32x4*)(rp + 512 + lane * 8) = pack8(v1);
    }
}

__device__ __forceinline__ void attn_item(const Params& p, int l, int item, unsigned char* shm) {
    const int tid = tidx(), lane = tid & 63, wave = tid >> 6, fr = lane & 15, fq = lane >> 4;
    const int hq = item & 7, bq = item >> 3, qblk = bq % NCH, b = bq / NCH, kh = hq >> 2;
    const bf16_t* P = WS_P(p);
    bf16_t* sK = (bf16_t*)shm; bf16_t* sVT = (bf16_t*)(shm + 34816); bf16_t* sPw = (bf16_t*)(shm + 69632) + wave * (16 * 136);
    const size_t tokq0 = (size_t)b * TPB + qblk * 128;
    bf16x8 aq[4];
#pragma unroll
    for (int kk = 0; kk < 4; ++kk) aq[kk] = *(const bf16x8*)(P + (tokq0 + wave * 16 + fr) * LDP + C_Q + hq * 128 + kk * 32 + 8 * fq);
    float m[4], ls[4]; f32x4 O[8];
    const float sink = p.att_sink[l * 8 + hq];
#pragma unroll
    for (int r = 0; r < 4; ++r) { m[r] = sink; ls[r] = 1.f; }
#pragma unroll
    for (int nd = 0; nd < 8; ++nd) O[nd] = (f32x4){0.f, 0.f, 0.f, 0.f};
    const int nlat = qblk - 2;
    const int ntiles = qblk < 2 ? 2 : 5;
    for (int ti = 0; ti < ntiles; ++ti) {
        int t0; bool masked = false; int kb = 0;
        if (ti < 2) t0 = ti * 128;
        else { kb = nlat - 1 + (ti - 2); if (kb < 0 || kb >= 16) continue; t0 = 256 + kb * 128; masked = true; }
        __syncthreads();
        {
            const bf16_t* kbase = P + ((size_t)b * TPB + t0) * LDP + C_K + kh * 128;
            for (int idx = tid; idx < 2048; idx += 512) { const int key = idx >> 4, dg = idx & 15; *(u32x4*)(sK + key * 136 + dg * 8) = *(const u32x4*)(kbase + (size_t)key * LDP + dg * 8); }
            const bf16_t* vbase = P + ((size_t)b * TPB + t0) * LDP + C_V + kh * 128;
            for (int idx = tid; idx < 2048; idx += 512) {
                const int key = idx & 127, dg = idx >> 7;
                const u32x4 raw = *(const u32x4*)(vbase + (size_t)key * LDP + dg * 8);
                bf16_t* dp = sVT + (dg * 8) * 136 + key;
                dp[0 * 136] = (bf16_t)(raw.x & 0xffffu); dp[1 * 136] = (bf16_t)(raw.x >> 16); dp[2 * 136] = (bf16_t)(raw.y & 0xffffu); dp[3 * 136] = (bf16_t)(raw.y >> 16);
                dp[4 * 136] = (bf16_t)(raw.z & 0xffffu); dp[5 * 136] = (bf16_t)(raw.z >> 16); dp[6 * 136] = (bf16_t)(raw.w & 0xffffu); dp[7 * 136] = (bf16_t)(raw.w >> 16);
            }
        }
        __syncthreads();
        f32x4 s[8];
#pragma unroll
        for (int nt = 0; nt < 8; ++nt) {
            s[nt] = (f32x4){0.f, 0.f, 0.f, 0.f};
#pragma unroll
            for (int kk = 0; kk < 4; ++kk) { const bf16x8 bk = *(const bf16x8*)(sK + (nt * 16 + fr) * 136 + kk * 32 + 8 * fq); s[nt] = __builtin_amdgcn_mfma_f32_16x16x32_bf16(aq[kk], bk, s[nt], 0, 0, 0); }
        }
        if (masked) {
#pragma unroll
            for (int nt = 0; nt < 8; ++nt)
#pragma unroll
                for (int r = 0; r < 4; ++r) { const int rel = (nlat * 128 + wave * 16 + fq * 4 + r) - (kb * 128 + nt * 16 + fr); if (rel > 128 || rel < -128) s[nt][r] = -INFINITY; }
        }
        float alpha[4];
#pragma unroll
        for (int r = 0; r < 4; ++r) {
            float mx = s[0][r];
#pragma unroll
            for (int nt = 1; nt < 8; ++nt) mx = fmaxf(mx, s[nt][r]);
            mx = fmaxf(mx, __shfl_xor(mx, 1)); mx = fmaxf(mx, __shfl_xor(mx, 2)); mx = fmaxf(mx, __shfl_xor(mx, 4)); mx = fmaxf(mx, __shfl_xor(mx, 8));
            const float mn = fmaxf(m[r], mx);
            alpha[r] = __expf(m[r] - mn); m[r] = mn;
            float rs = 0.f;
#pragma unroll
            for (int nt = 0; nt < 8; ++nt) { const float pv = __expf(s[nt][r] - mn); s[nt][r] = pv; rs += pv; }
            rs += __shfl_xor(rs, 1); rs += __shfl_xor(rs, 2); rs += __shfl_xor(rs, 4); rs += __shfl_xor(rs, 8);
            ls[r] = ls[r] * alpha[r] + rs;
        }
#pragma unroll
        for (int nd = 0; nd < 8; ++nd) { O[nd].x *= alpha[0]; O[nd].y *= alpha[1]; O[nd].z *= alpha[2]; O[nd].w *= alpha[3]; }
#pragma unroll
        for (int nt = 0; nt < 8; ++nt)
#pragma unroll
            for (int r = 0; r < 4; ++r) sPw[(fq * 4 + r) * 136 + nt * 16 + fr] = f2bf(s[nt][r]);
        asm volatile("s_waitcnt lgkmcnt(0)" ::: "memory");
#pragma unroll
        for (int kk = 0; kk < 4; ++kk) {
            const bf16x8 ap = *(const bf16x8*)(sPw + fr * 136 + kk * 32 + 8 * fq);
#pragma unroll
            for (int nd = 0; nd < 8; ++nd) { const bf16x8 bv = *(const bf16x8*)(sVT + (nd * 16 + fr) * 136 + kk * 32 + 8 * fq); O[nd] = __builtin_amdgcn_mfma_f32_16x16x32_bf16(ap, bv, O[nd], 0, 0, 0); }
        }
    }
#pragma unroll
    for (int r = 0; r < 4; ++r) {
        const size_t tok = tokq0 + wave * 16 + fq * 4 + r;
        const float il = 1.f / ls[r];
#pragma unroll
        for (int nd = 0; nd < 8; ++nd) {
            const int dcol = hq * 128 + nd * 16 + fr;
            const float ag = bf2f(P[tok * LDP + C_AG + dcol]);
            WS_MIX(p)[tok * MIXW + 1024 + dcol] = f2bf(O[nd][r] * il * siluf(ag));
        }
    }
}

__global__ __launch_bounds__(512) void mega(Params p) {
    extern __shared__ __attribute__((aligned(16))) unsigned char shm[];
    cg::grid_group grid = cg::this_grid();
    const int G = (int)gridDim.x, bid = (int)blockIdx.x;
    const int wave = tidx() >> 6, lane = tidx() & 63;
#ifndef SK_P0
    phase0(p, shm, G);
#endif
    grid.sync();
#pragma unroll 1
    for (int l = 0; l < 4; ++l) {
#ifndef SK_NORM
        norm_phase(p, l, G);
#endif
        grid.sync();
        {
            pg8::Gemm g{WS_U(p), WS_WTIN(p) + (size_t)l * 7424 * 2048, NTOK, 7424, 2048};
            pg8::Order S; S.init(72, 29, G, bid, 0);
            EpiG1 E{WS_P(p)};
#ifndef SK_G1
            pg8::gemm_phase<EpiG1, pg8::Order>((PG8_LAS unsigned char*)shm, g, S, E);
#endif
        }
        grid.sync();
#ifndef SK_X1A
        for (int it = bid; it < 288; it += G) ssd_states_item(p, l, it, shm);
#endif
#ifndef SK_X1B
        for (int it = bid; it < 2304; it += G) lru_item<false>(p, l, it, shm);
#endif
#ifndef SK_QK
        for (int row = bid * 8 + wave; row < NTOK; row += G * 8) qkprep_row(p, l, row, lane);
#endif
        grid.sync();
#ifndef SK_X2A
        for (int it = bid; it < 256; it += G) ssd_recur_item(p, it);
#endif
#ifndef SK_X2B
        for (int it = bid; it < 1152; it += G) attn_item(p, l, it, shm);
#endif
        grid.sync();
#ifndef SK_X3A
        for (int it = bid; it < 288; it += G) ssd_final_item(p, l, it, shm);
#endif
#ifndef SK_X3B
        for (int it = bid; it < 2304; it += G) lru_item<true>(p, l, it, shm);
#endif
        grid.sync();
#ifndef SK_X4
        ssd_norm_phase(p, l, G);
#endif
        grid.sync();
        {
            pg8::Gemm g{WS_MIX(p), WS_WTOUT(p) + (size_t)l * 2048 * 3072, NTOK, 2048, 3072};
            pg8::Order S; S.init(l == 3 ? 64 : 72, 8, G, bid, l == 3 ? 1 : 0);
            EpiG2 E{p, l};
#ifndef SK_G2
            pg8::gemm_phase<EpiG2, pg8::Order>((PG8_LAS unsigned char*)shm, g, S, E);
#endif
        }
        if (l < 3) grid.sync();
    }
}

extern "C" void kernel_launch(void* const* d_in, const int* in_sizes, int n_in, void* d_out, int out_size, void* d_ws, size_t ws_size, hipStream_t stream) {
    static int grid = 0;
    if (grid == 0) {
        if (n_in != 25 || ws_size < WS_END) { fprintf(stderr, "kernel_launch: need 25 inputs and %zu bytes of workspace (got %d, %zu)\n", (size_t)WS_END, n_in, ws_size); grid = -1; return; }
        int dev = 0, cus = 0, per_cu = 0;
        hipGetDevice(&dev);
        hipDeviceGetAttribute(&cus, hipDeviceAttributeMultiprocessorCount, dev);
        if (hipFuncSetAttribute((const void*)mega, hipFuncAttributeMaxDynamicSharedMemorySize, LDS_BYTES) != hipSuccess) { fprintf(stderr, "kernel_launch: hipFuncSetAttribute failed\n"); grid = -1; return; }
        if (hipOccupancyMaxActiveBlocksPerMultiprocessor(&per_cu, (const void*)mega, 512, LDS_BYTES) != hipSuccess || per_cu < 1) { fprintf(stderr, "kernel_launch: occupancy query gave %d\n", per_cu); per_cu = 1; }
        (void)hipGetLastError();
        grid = cus * 1;
        if (grid <= 0) grid = 256;
    }
    if (grid < 0) return;
    Params p{};
    const float** pf = (const float**)&p;
    for (int i = 0; i < 25; ++i) pf[i] = (const float*)d_in[i];
    p.out = (float*)d_out; p.ws = (unsigned char*)d_ws;
    void* args[] = {&p};
    hipError_t e = hipLaunchCooperativeKernel((const void*)mega, dim3(grid), dim3(512), args, LDS_BYTES, stream);
    if (e != hipSuccess) fprintf(stderr, "cooperative launch failed: %s (grid %d)\n", hipGetErrorString(e), grid);
}
```

```cpp
#include <hip/hip_runtime.h>
#include <hip/hip_cooperative_groups.h>
#include <cstdio>
#include <cstdint>
namespace cg = cooperative_groups;
#define DUP_X1A 0
#define DUP_X1B 0
#define DUP_ATT 0
#define DUP_X3A 0
#define DUP_X3B 0
#define DUP_G1 0
#define DUP_P0 0
#define DUP_NORM 0
#define DUP_SYNC 0

__device__ __forceinline__ int tidx() { int t = (int)threadIdx.x; asm volatile("" : "+v"(t)); return t; }

namespace pg8 {
#define PG8_LAS __attribute__((address_space(3)))
typedef unsigned short bf16_t;
typedef short bf16x8 __attribute__((ext_vector_type(8)));
typedef float f32x4 __attribute__((ext_vector_type(4)));
typedef unsigned u32x4 __attribute__((ext_vector_type(4)));
constexpr int BM = 256, BK = 64, HALF = 128, HTB = HALF * BK * 2  , STAGE_BYTES = 8 * HTB, NXCD = 8, WGM = 8;

__host__ __device__ __forceinline__ int lds_byte(int r, int c) { const int st = (r >> 4) * 2 + (c >> 5), rr = r & 15, cc = c & 31, ob = rr * 64 + cc * 2; return st * 1024 + (ob ^ (((ob >> 9) & 1) << 5)); }
__host__ __device__ __forceinline__ void stage_rc(int b, int& R, int& C) { const int st = b / 1024, sb = b % 1024, swz = sb ^ (((sb >> 9) & 1) << 5); R = (st >> 1) * 16 + swz / 64; C = (st & 1) * 32 + (swz % 64) / 2; }
__host__ __device__ __forceinline__ int perm32(int rho) { const int n = rho >> 4, i = rho & 15; return 8 * (i >> 2) + 4 * n + (i & 3); }

struct Unit { int pm, pn; };
struct Gemm { const bf16_t* A; const bf16_t* Bt; int M, N, K; };

struct Order {
    int nM, nN, nwg, G, c, skipctx;
    __device__ void init(int nM_, int nN_, int G_, int c_, int skip_) { nM = nM_; nN = nN_; nwg = nM * nN; G = G_; c = c_; skipctx = skip_; }
    __device__ bool next(int i, Unit& u) const {
        const long L = (long)i * G + c; if (L >= nwg) return false;
        int wgid = (int)L; { const int q = nwg / NXCD, r = nwg % NXCD, xcd = wgid % NXCD, off = wgid / NXCD; wgid = (xcd < r ? xcd * (q + 1) : r * (q + 1) + (xcd - r) * q) + off; }
        const int nig = WGM * nN, gid = wgid / nig, fm = gid * WGM, gsz = (nM - fm) < WGM ? (nM - fm) : WGM;
        int pm = fm + ((wgid % nig) % gsz); u.pn = (wgid % nig) / gsz;
        if (skipctx) pm = (pm >> 3) * 9 + 1 + (pm & 7);
        u.pm = pm; return true;
    }
    __device__ __forceinline__ void a_ready(const Unit&) const {}
    __device__ __forceinline__ void done(const Unit&) const {}
};
typedef __bf16 bf16x2_t __attribute__((ext_vector_type(2)));
typedef float f32x2_t __attribute__((ext_vector_type(2)));
__device__ __forceinline__ unsigned cvt_pk_bf16(float lo, float hi) { f32x2_t v = {lo, hi}; bf16x2_t b = __builtin_convertvector(v, bf16x2_t); return __builtin_bit_cast(unsigned, b); }

template <class Epi, class Sched>
__device__ __forceinline__ void gemm_phase(PG8_LAS unsigned char* lds, const Gemm g, const Sched& S, const Epi& E) {
    const int tid = tidx(), wid = __builtin_amdgcn_readfirstlane(tid >> 6), lane = tid & 63, wr = wid >> 2, wc = wid & 3, fr = lane & 15, fq = lane >> 4;
    const int K = g.K, nt = K / BK;
    unsigned voffA[2], voffB[2];
#pragma unroll
    for (int i = 0; i < 2; ++i) { int R, C; stage_rc(tid * 16 + i * 8192, R, C); const int Rb = Epi::PERM ? ((R & ~31) + perm32(R & 31)) : R;
        voffA[i] = (unsigned)(R * K + C) * 2u; voffB[i] = (unsigned)(Rb * K + C) * 2u; }
    const size_t kstep = (size_t)(BK * 2);
    const size_t hstep = (size_t)HALF * K * 2;
    const size_t tstep = 2 * hstep;
    const unsigned ldsw = (unsigned)wid * 1024u;
    const int aoff = lds_byte(wr * 64 + fr, fq * 8), boff = lds_byte(wc * 32 + fr, fq * 8);
#define PG8_SA(b, h) (((b) * 2 + (h)) * HTB)
#define PG8_SB(b, h) ((4 + (b) * 2 + (h)) * HTB)
#define PG8_STAGE(bufoff, gbase, voff) do { _Pragma("unroll") for (int _i = 0; _i < 2; ++_i) \
        __builtin_amdgcn_global_load_lds((const unsigned*)((const char*)(gbase) + (voff)[_i]), (PG8_LAS unsigned*)(lds + (bufoff) + ldsw + _i * 8192), 16, 0, 0); } while (0)
#define PG8_LDA(dst, b, h) do { _Pragma("unroll") for (int m = 0; m < 4; ++m) _Pragma("unroll") for (int k = 0; k < 2; ++k) dst[m][k] = *(const PG8_LAS bf16x8*)(lds + PG8_SA(b, h) + aoff + m * 2048 + k * 1024); } while (0)
#define PG8_LDB(dst, b, h) do { _Pragma("unroll") for (int n = 0; n < 2; ++n) _Pragma("unroll") for (int k = 0; k < 2; ++k) dst[n][k] = *(const PG8_LAS bf16x8*)(lds + PG8_SB(b, h) + boff + n * 2048 + k * 1024); } while (0)
#define PG8_MMA(ai, bj, At, Bt) do { __builtin_amdgcn_s_setprio(1); _Pragma("unroll") for (int m = 0; m < 4; ++m) _Pragma("unroll") for (int n = 0; n < 2; ++n) _Pragma("unroll") for (int k = 0; k < 2; ++k) \
        acc[ai][bj][m][n] = __builtin_amdgcn_mfma_f32_16x16x32_bf16(Bt[n][k], At[m][k], acc[ai][bj][m][n], 0, 0, 0); __builtin_amdgcn_s_setprio(0); } while (0)
#define PG8_WAIT_V(n) asm volatile("s_waitcnt vmcnt(" #n ")" ::: "memory")
#define PG8_WAIT_L(n) asm volatile("s_waitcnt lgkmcnt(" #n ")" ::: "memory")
#define PG8_BAR __builtin_amdgcn_s_barrier()
#define PG8_SCHED __builtin_amdgcn_sched_barrier(0)
    Unit cur, nxt; int ui = 0;
    if (!S.next(0, cur)) return;
    f32x4 acc[2][2][4][2];
#pragma unroll
    for (int a = 0; a < 2; ++a)
#pragma unroll
        for (int b = 0; b < 2; ++b)
#pragma unroll
            for (int m = 0; m < 4; ++m)
#pragma unroll
                for (int n = 0; n < 2; ++n) acc[a][b][m][n] = (f32x4){0.f, 0.f, 0.f, 0.f};
    bf16x8 At[4][2], B0[2][2], B1[2][2];
    const char* cA = (const char*)g.A + (size_t)cur.pm * tstep; const char* cB = (const char*)g.Bt + (size_t)cur.pn * tstep;
    S.a_ready(cur);
    PG8_STAGE(PG8_SB(0, 0), cB, voffB); PG8_STAGE(PG8_SA(0, 0), cA, voffA); PG8_STAGE(PG8_SB(0, 1), cB + hstep, voffB); PG8_STAGE(PG8_SA(0, 1), cA + hstep, voffA);
    if (wr == 1) PG8_BAR;
    PG8_WAIT_V(4); PG8_BAR;
    PG8_STAGE(PG8_SB(1, 0), cB + kstep, voffB); PG8_STAGE(PG8_SA(1, 0), cA + kstep, voffA); PG8_STAGE(PG8_SB(1, 1), cB + hstep + kstep, voffB);
    PG8_WAIT_V(6); PG8_BAR;
    for (;;) {
        const bool has_next = S.next(ui + 1, nxt);
        const char* nA = has_next ? (const char*)g.A + (size_t)nxt.pm * tstep : cA; const char* nB = has_next ? (const char*)g.Bt + (size_t)nxt.pn * tstep : cB;
        for (int t = 0; t < nt; t += 2) {
            const bool last = (t == nt - 2);
            const char* a1 = cA + (size_t)(t + 1) * kstep;
            const char* a2 = last ? nA : cA + (size_t)(t + 2) * kstep; const char* b2 = last ? nB : cB + (size_t)(t + 2) * kstep;
            const char* a3 = a2 + kstep; const char* b3 = b2 + kstep;
            if (last && has_next) S.a_ready(nxt);
            PG8_LDB(B0, 0, 0); PG8_SCHED; PG8_LDA(At, 0, 0); PG8_STAGE(PG8_SA(1, 1), a1 + hstep, voffA);
            PG8_WAIT_L(8); PG8_BAR; PG8_WAIT_L(0); PG8_MMA(0, 0, At, B0); PG8_BAR; PG8_SCHED;
            PG8_LDB(B1, 0, 1); PG8_STAGE(PG8_SB(0, 0), b2, voffB);
            PG8_BAR; PG8_WAIT_L(0); PG8_MMA(0, 1, At, B1); PG8_BAR;
            PG8_LDA(At, 0, 1); PG8_STAGE(PG8_SA(0, 0), a2, voffA);
            PG8_BAR; PG8_WAIT_L(0); PG8_MMA(1, 0, At, B0); PG8_BAR; PG8_SCHED;
            PG8_STAGE(PG8_SB(0, 1), b2 + hstep, voffB);
            PG8_WAIT_V(6); PG8_BAR; PG8_MMA(1, 1, At, B1); PG8_BAR;
            PG8_LDB(B0, 1, 0); PG8_SCHED; PG8_LDA(At, 1, 0); PG8_STAGE(PG8_SA(0, 1), a2 + hstep, voffA);
            PG8_WAIT_L(8); PG8_BAR; PG8_WAIT_L(0); PG8_MMA(0, 0, At, B0); PG8_BAR; PG8_SCHED;
            PG8_LDB(B1, 1, 1); PG8_STAGE(PG8_SB(1, 0), b3, voffB);
            PG8_BAR; PG8_WAIT_L(0); PG8_MMA(0, 1, At, B1); PG8_BAR;
            PG8_LDA(At, 1, 1); PG8_STAGE(PG8_SA(1, 0), a3, voffA);
            PG8_BAR; PG8_WAIT_L(0); PG8_MMA(1, 0, At, B0); PG8_BAR; PG8_SCHED;
            PG8_STAGE(PG8_SB(1, 1), b3 + hstep, voffB);
            PG8_WAIT_V(6); PG8_BAR; PG8_MMA(1, 1, At, B1); PG8_BAR;
        }
        if constexpr (!Epi::AFTER_DRAIN) { E(acc, cur, wr, wc, fr, fq); S.done(cur); }
        if (!has_next) break;
#pragma unroll
        for (int a = 0; a < 2; ++a)
#pragma unroll
            for (int b = 0; b < 2; ++b)
#pragma unroll
                for (int m = 0; m < 4; ++m)
#pragma unroll
                    for (int n = 0; n < 2; ++n) acc[a][b][m][n] = (f32x4){0.f, 0.f, 0.f, 0.f};
        cur = nxt; cA = nA; cB = nB; ++ui;
    }
    PG8_WAIT_V(0);
    if (wr == 0) PG8_BAR;
    PG8_BAR;
    if constexpr (Epi::AFTER_DRAIN) { E.fused(acc, cur, wr, wc, fr, fq, lds, wid, lane); S.done(cur); }
#undef PG8_SA
#undef PG8_SB
#undef PG8_STAGE
#undef PG8_LDA
#undef PG8_LDB
#undef PG8_MMA
#undef PG8_WAIT_V
#undef PG8_WAIT_L
#undef PG8_BAR
#undef PG8_SCHED
}
}

using pg8::bf16_t; using pg8::bf16x8; using pg8::f32x4; using pg8::cvt_pk_bf16;
typedef float f32x16 __attribute__((ext_vector_type(16)));
typedef float f32x8 __attribute__((ext_vector_type(8)));
typedef unsigned u32x2 __attribute__((ext_vector_type(2)));
typedef unsigned u32x4 __attribute__((ext_vector_type(4)));

constexpr int DM = 2048, TPB = 2304, NTOK = 18432, LDP = 7424, MIXW = 3072, NCH = 18;
constexpr int C_LX = 0, C_LG = 1024, C_Q = 2048, C_K = 3072, C_V = 3328, C_AG = 3584, C_XBC = 4608, C_Z = 6144, C_DT = 7168;
constexpr size_t SZ_WTIN = (size_t)4 * 7424 * 2048 * 2, SZ_WTOUT = (size_t)4 * 2048 * 3072 * 2, SZ_MOD = (size_t)4 * 9 * 6144 * 4, SZ_U = (size_t)NTOK * 2048 * 2,
                 SZ_P = (size_t)NTOK * LDP * 2, SZ_MIX = (size_t)NTOK * MIXW * 2, SZ_XB = (size_t)NTOK * 2048 * 4, SZ_ST = (size_t)8 * 2 * 18 * 16 * 8192 * 2,
                 SZ_AL = (size_t)8 * 2 * 18 * 16 * 4, SZ_SUM = (size_t)8 * 2 * 18 * 1024 * 4;
constexpr size_t OFF_WTIN = 0, OFF_WTOUT = OFF_WTIN + SZ_WTIN, OFF_MOD = OFF_WTOUT + SZ_WTOUT, OFF_U = OFF_MOD + SZ_MOD, OFF_P = OFF_U + SZ_U, OFF_MIX = OFF_P + SZ_P,
                 OFF_XB = OFF_MIX + SZ_MIX, OFF_ST = OFF_XB + SZ_XB, OFF_AL = OFF_ST + SZ_ST, OFF_SUMA = OFF_AL + SZ_AL, OFF_SUMB = OFF_SUMA + SZ_SUM, OFF_BAR = OFF_SUMB + SZ_SUM, WS_END = OFF_BAR + 16384;
constexpr int LDS_BYTES = 131072 + 16;

struct Params {
    const float *x, *c, *ctx, *c_ctx, *norm_w, *ada_w, *ada_b, *w_in, *lru_conv_w, *lru_conv_b, *lru_ga_w, *lru_ga_b, *lru_gx_w, *lru_gx_b, *lru_lambda,
        *att_q_norm, *att_k_norm, *att_sink, *ssd_conv_w, *ssd_conv_b, *ssd_dt_bias, *ssd_A_log, *ssd_D, *ssd_norm_w, *w_out;
    float* out;
    unsigned char* ws;
};
#define WS_WTIN(p) ((bf16_t*)((p).ws + OFF_WTIN))
#define WS_WTOUT(p) ((bf16_t*)((p).ws + OFF_WTOUT))
#define WS_MOD(p) ((float*)((p).ws + OFF_MOD))
#define WS_U(p) ((bf16_t*)((p).ws + OFF_U))
#define WS_P(p) ((bf16_t*)((p).ws + OFF_P))
#define WS_MIX(p) ((bf16_t*)((p).ws + OFF_MIX))
#define WS_XB(p) ((float*)((p).ws + OFF_XB))
#define WS_ST(p) ((bf16_t*)((p).ws + OFF_ST))
#define WS_AL(p) ((float*)((p).ws + OFF_AL))
#define WS_SUMA(p) ((float*)((p).ws + OFF_SUMA))
#define WS_SUMB(p) ((float*)((p).ws + OFF_SUMB))

__device__ __forceinline__ float bf2f(bf16_t v) { return __uint_as_float(((unsigned)v) << 16); }
__device__ __forceinline__ bf16_t f2bf(float f) { return (bf16_t)(cvt_pk_bf16(f, 0.f) & 0xffffu); }
__device__ __forceinline__ float siluf(float v) { return v / (1.f + __expf(-v)); }
__device__ __forceinline__ float sigmf(float v) { return 1.f / (1.f + __expf(-v)); }
__device__ __forceinline__ float softplusf(float v) { return v > 20.f ? v : log1pf(__expf(v)); }
__device__ __forceinline__ float wave_sum(float v) {
#pragma unroll
    for (int o = 1; o < 64; o <<= 1) v += __shfl_xor(v, o);
    return v;
}
__device__ __forceinline__ f32x8 unpack8(const u32x4 w) {
    f32x8 f;
    f[0] = __uint_as_float(w.x << 16); f[1] = __uint_as_float(w.x & 0xffff0000u); f[2] = __uint_as_float(w.y << 16); f[3] = __uint_as_float(w.y & 0xffff0000u);
    f[4] = __uint_as_float(w.z << 16); f[5] = __uint_as_float(w.z & 0xffff0000u); f[6] = __uint_as_float(w.w << 16); f[7] = __uint_as_float(w.w & 0xffff0000u);
    return f;
}
__device__ __forceinline__ u32x4 pack8(const f32x8 f) { u32x4 w; w.x = cvt_pk_bf16(f[0], f[1]); w.y = cvt_pk_bf16(f[2], f[3]); w.z = cvt_pk_bf16(f[4], f[5]); w.w = cvt_pk_bf16(f[6], f[7]); return w; }
__device__ __forceinline__ int chunk_at(int d, int pos) { return d == 0 ? pos : (pos < 2 ? 1 - pos : 19 - pos); }
__device__ __forceinline__ int pos_of(int d, int c) { return d == 0 ? c : (c < 2 ? 1 - c : 19 - c); }
__device__ __forceinline__ int rowmap32(int reg, int lane) { return (reg & 3) + 8 * (reg >> 2) + 4 * (lane >> 5); }

template <int K> __device__ __forceinline__ void mm32(f32x16& acc, const bf16_t* A, int lda, const bf16_t* B, int ldb, int lane) {
    const bf16_t* pa = A + (lane & 31) * lda + 8 * (lane >> 5);
    const bf16_t* pb = B + (lane & 31) * ldb + 8 * (lane >> 5);
#pragma unroll
    for (int k = 0; k < K; k += 16) {
        const bf16x8 a = *(const bf16x8*)(pa + k);
        const bf16x8 b = *(const bf16x8*)(pb + k);
        acc = __builtin_amdgcn_mfma_f32_32x32x16_bf16(a, b, acc, 0, 0, 0);
    }
}

template <int NC, bool SILU, bool TRANS>
__device__ __forceinline__ void stage_conv_tile(bf16_t* dst, int ld, const bf16_t* Pb, int t0, int col0, const float* cw, int CS, const float* cb, int tid) {
    constexpr int CG = NC / 8;
    const int lo = t0 < 256 ? 0 : 256, hi = t0 < 256 ? 256 : TPB;
    for (int idx = tid; idx < 128 * CG; idx += 512) {
        int cgi, tl;
        if (TRANS) { tl = idx & 127; cgi = idx >> 7; } else { cgi = idx % CG; tl = idx / CG; }
        const int t = t0 + tl;
        const f32x4 b0 = *(const f32x4*)(cb + cgi * 8), b1 = *(const f32x4*)(cb + cgi * 8 + 4);
        f32x8 acc; acc[0] = b0.x; acc[1] = b0.y; acc[2] = b0.z; acc[3] = b0.w; acc[4] = b1.x; acc[5] = b1.y; acc[6] = b1.z; acc[7] = b1.w;
#pragma unroll
        for (int k = 0; k < 4; ++k) {
            const int tt = t - 2 + k;
            if (tt >= lo && tt < hi) {
                const f32x8 v = unpack8(*(const u32x4*)(Pb + (size_t)tt * LDP + col0 + cgi * 8));
                const f32x4 w0 = *(const f32x4*)(cw + k * CS + cgi * 8), w1 = *(const f32x4*)(cw + k * CS + cgi * 8 + 4);
                acc[0] += w0.x * v[0]; acc[1] += w0.y * v[1]; acc[2] += w0.z * v[2]; acc[3] += w0.w * v[3];
                acc[4] += w1.x * v[4]; acc[5] += w1.y * v[5]; acc[6] += w1.z * v[6]; acc[7] += w1.w * v[7];
            }
        }
        if (SILU) {
#pragma unroll
            for (int e = 0; e < 8; ++e) acc[e] = siluf(acc[e]);
        }
        if (TRANS) {
#pragma unroll
            for (int e = 0; e < 8; ++e) dst[(cgi * 8 + e) * ld + tl] = f2bf(acc[e]);
        } else {
            *(u32x4*)(dst + tl * ld + cgi * 8) = pack8(acc);
        }
    }
}

__device__ __forceinline__ void transpose_item(const float* W, int K, int N, int nblk, bf16_t* WT, float* scr, int item, int lane) {
    const int kb = item / nblk, nb = item % nblk, k0 = 64 * kb, n0 = 32 * nb;
    const int n = n0 + (lane & 31);
#pragma unroll 8
    for (int i = 0; i < 32; ++i) { const int kk = 2 * i + (lane >> 5); scr[kk * 33 + (lane & 31)] = (n < N) ? W[(size_t)(k0 + kk) * N + n] : 0.f; }
    asm volatile("s_waitcnt lgkmcnt(0)" ::: "memory");
    const int c = lane & 7;
#pragma unroll
    for (int j = 0; j < 4; ++j) {
        const int nn = (lane >> 3) + 8 * j; const float* s = scr + (8 * c) * 33 + nn;
        u32x4 o; o.x = cvt_pk_bf16(s[0 * 33], s[1 * 33]); o.y = cvt_pk_bf16(s[2 * 33], s[3 * 33]); o.z = cvt_pk_bf16(s[4 * 33], s[5 * 33]); o.w = cvt_pk_bf16(s[6 * 33], s[7 * 33]);
        *(u32x4*)(WT + (size_t)(n0 + nn) * K + k0 + 8 * c) = o;
    }
    asm volatile("s_waitcnt lgkmcnt(0)" ::: "memory");
}

__device__ __forceinline__ void phase0(const Params& p, unsigned char* shm, int G) {
    const int tid = tidx(), lane = tid & 63, wave = tid >> 6;
    float* sf = (float*)shm;
    float* MOD = WS_MOD(p);
    for (int item = blockIdx.x; item < 96; item += G) {
        const int l = item / 24, cgp = item % 24;
        __syncthreads();
        for (int idx = tid; idx < 9 * 2048; idx += 512) { const int r = idx >> 11, k = idx & 2047; const float v = r < 8 ? p.c[r * 2048 + k] : p.c_ctx[k]; sf[idx] = siluf(v); }
        __syncthreads();
        f32x4 acc[9];
#pragma unroll
        for (int r = 0; r < 9; ++r) acc[r] = (f32x4){0.f, 0.f, 0.f, 0.f};
        const float* wp = p.ada_w + ((size_t)l * 2048 + wave * 256) * 6144 + cgp * 256 + lane * 4;
#pragma unroll 4
        for (int kk = 0; kk < 256; ++kk) {
            const f32x4 wv = *(const f32x4*)(wp + (size_t)kk * 6144);
            const int k = wave * 256 + kk;
#pragma unroll
            for (int r = 0; r < 9; ++r) { const float s = sf[r * 2048 + k]; acc[r] += wv * s; }
        }
        __syncthreads();
#pragma unroll
        for (int r = 0; r < 9; ++r) *(f32x4*)(sf + (wave * 9 + r) * 256 + lane * 4) = acc[r];
        __syncthreads();
        for (int idx = tid; idx < 9 * 256; idx += 512) {
            const int r = idx >> 8, col = idx & 255; float s = p.ada_b[l * 6144 + cgp * 256 + col];
#pragma unroll
            for (int w = 0; w < 8; ++w) s += sf[(w * 9 + r) * 256 + col];
            MOD[(size_t)(l * 9 + r) * 6144 + cgp * 256 + col] = s;
        }
    }
    __syncthreads();
    float* scr = sf + wave * (64 * 33);
    const int gw = blockIdx.x * 8 + wave, NGW = G * 8;
    constexpr int I_IN = 32 * 232, I_OUT = 48 * 64;
    for (int it = gw; it < 4 * (I_IN + I_OUT); it += NGW) {
        if (it < 4 * I_IN) { const int l = it / I_IN, r = it % I_IN; transpose_item(p.w_in + (size_t)l * 2048 * 7184, 2048, 7184, 232, WS_WTIN(p) + (size_t)l * 7424 * 2048, scr, r, lane); }
        else { const int it2 = it - 4 * I_IN, l = it2 / I_OUT, r = it2 % I_OUT; transpose_item(p.w_out + (size_t)l * 3072 * 2048, 3072, 2048, 64, WS_WTOUT(p) + (size_t)l * 2048 * 3072, scr, r, lane); }
    }
}

__device__ __forceinline__ const float* xrow_src(const Params& p, int l, int row) {
    const int b = row / TPB, t = row % TPB;
    if (l == 0) return t < 256 ? p.ctx + ((size_t)b * 256 + t) * DM : p.x + ((size_t)b * 2048 + (t - 256)) * DM;
    return WS_XB(p) + (size_t)row * DM;
}
__device__ __forceinline__ void norm_phase(const Params& p, int l, int G) {
    const int lane = tidx() & 63, wave = tidx() >> 6;
    bf16_t* U = WS_U(p);
    for (int row = blockIdx.x * 8 + wave; row < NTOK; row += G * 8) {
        const int b = row / TPB, t = row % TPB;
        const float* src = xrow_src(p, l, row);
        const float* md = WS_MOD(p) + (size_t)(l * 9 + (t < 256 ? 8 : b)) * 6144;
        f32x4 v[8]; float ss = 0.f;
#pragma unroll
        for (int j = 0; j < 8; ++j) { v[j] = *(const f32x4*)(src + 4 * lane + 256 * j); ss += v[j].x * v[j].x + v[j].y * v[j].y + v[j].z * v[j].z + v[j].w * v[j].w; }
        ss = wave_sum(ss);
        const float rstd = rsqrtf(ss * (1.f / 2048.f) + 1e-6f);
#pragma unroll
        for (int j = 0; j < 8; ++j) {
            const int col = 4 * lane + 256 * j;
            const f32x4 nw = *(const f32x4*)(p.norm_w + l * 2048 + col), sh = *(const f32x4*)(md + col), sc = *(const f32x4*)(md + 2048 + col);
            const f32x4 y = v[j] * rstd * nw * (sc + 1.f) + sh;
            u32x2 w; w.x = cvt_pk_bf16(y.x, y.y); w.y = cvt_pk_bf16(y.z, y.w);
            *(u32x2*)(U + (size_t)row * DM + col) = w;
        }
    }
}

struct EpiG1 {
    static constexpr bool PERM = false, AFTER_DRAIN = false;
    bf16_t* P;
    __device__ __forceinline__ void operator()(const f32x4 (&acc)[2][2][4][2], const pg8::Unit& u, int wr, int wc, int fr, int fq) const {
        const int row0 = u.pm * 256 + wr * 64 + fr, col0 = u.pn * 256 + wc * 32 + 4 * fq;
#pragma unroll
        for (int ai = 0; ai < 2; ++ai)
#pragma unroll
            for (int m = 0; m < 4; ++m) { bf16_t* rowp = P + (size_t)(row0 + ai * 128 + m * 16) * LDP + col0;
#pragma unroll
                for (int bj = 0; bj < 2; ++bj)
#pragma unroll
                    for (int n = 0; n < 2; ++n) { const f32x4 v = acc[ai][bj][m][n]; u32x2 w; w.x = cvt_pk_bf16(v.x, v.y); w.y = cvt_pk_bf16(v.z, v.w); *(u32x2*)(rowp + bj * 128 + n * 16) = w; } }
    }
};
struct EpiG2 {
    static constexpr bool PERM = false, AFTER_DRAIN = false;
    Params p; int l;
    __device__ __forceinline__ void operator()(const f32x4 (&acc)[2][2][4][2], const pg8::Unit& u, int wr, int wc, int fr, int fq) const {
        const int row0 = u.pm * 256 + wr * 64 + fr, col0 = u.pn * 256 + wc * 32 + 4 * fq;
#pragma unroll
        for (int ai = 0; ai < 2; ++ai)
#pragma unroll
            for (int m = 0; m < 4; ++m) {
                const int row = row0 + ai * 128 + m * 16, b = row / TPB, t = row % TPB;
                if (l == 3 && t < 256) continue;
                const float* xo = xrow_src(p, l, row);
                float* dst = (l == 3) ? p.out + ((size_t)b * 2048 + (t - 256)) * DM : WS_XB(p) + (size_t)row * DM;
                const float* gt = WS_MOD(p) + (size_t)(l * 9 + (t < 256 ? 8 : b)) * 6144 + 4096;
#pragma unroll
                for (int bj = 0; bj < 2; ++bj)
#pragma unroll
                    for (int n = 0; n < 2; ++n) { const int col = col0 + bj * 128 + n * 16; const f32x4 xv = *(const f32x4*)(xo + col), g = *(const f32x4*)(gt + col); *(f32x4*)(dst + col) = xv + g * acc[ai][bj][m][n]; }
            }
    }
};

__device__ __forceinline__ void qkprep_row(const Params& p, int l, int row, int lane) {
    const int t = row % TPB;
    bf16_t* rp = WS_P(p) + (size_t)row * LDP;
    float cs = 1.f, sn = 0.f;
    if (t >= 256) {
        const int s = t - 256, rr = s >> 6, cc = s & 63, f = lane & 31;
        const float inv = exp2f(-(float)f * (13.287712379549449f / 32.f));
        const float ang = (float)(lane < 32 ? rr : cc) * inv;
        cs = __cosf(ang); sn = __sinf(ang);
    }
#pragma unroll
    for (int slot = 0; slot < 10; ++slot) {
        const int col = slot < 8 ? C_Q + slot * 128 : C_K + (slot - 8) * 128;
        const float* w = slot < 8 ? p.att_q_norm + l * 128 : p.att_k_norm + l * 128;
        const float v1 = bf2f(rp[col + lane]), v2 = bf2f(rp[col + 64 + lane]);
        const float ss = wave_sum(v1 * v1 + v2 * v2);
        const float rstd = rsqrtf(ss * (1.f / 128.f) + 1e-6f);
        const float y1 = v1 * rstd * w[lane], y2 = v2 * rstd * w[64 + lane];
        float o1 = y1 * cs - y2 * sn, o2 = y1 * sn + y2 * cs;
        if (slot < 8) { o1 *= 0.08838834764831845f; o2 *= 0.08838834764831845f; }
        rp[col + lane] = f2bf(o1); rp[col + 64 + lane] = f2bf(o2);
    }
}

template <bool FINAL, int D>
__device__ __forceinline__ void lru_dir(const Params& p, int l, int b, int c, int j, unsigned char* shm, float (&hacc)[16]) {
    const int tid = tidx(), lane = tid & 63, wave = tid >> 6, ch = tid & 63, seg = tid >> 6;
    bf16_t* sX = (bf16_t*)shm; bf16_t* sWa = (bf16_t*)(shm + 18432); bf16_t* sWx = (bf16_t*)(shm + 27648);
    float* sA = (float*)(shm + 36864); float* sB = (float*)(shm + 69632); float* sSA = (float*)(shm + 102400); float* sSB = (float*)(shm + 104448);
    const float* ga = p.lru_ga_w + (size_t)((l * 2 + D) * 16 + j) * 4096; const float* gx = p.lru_gx_w + (size_t)((l * 2 + D) * 16 + j) * 4096;
    for (int idx = tid; idx < 4096; idx += 512) { const int i = idx >> 6, o = idx & 63; sWa[o * 72 + i] = f2bf(ga[idx]); sWx[o * 72 + i] = f2bf(gx[idx]); }
    __syncthreads();
    {
        const int mi = wave & 3, nj = wave >> 2;
        f32x16 aa, ax;
#pragma unroll
        for (int r = 0; r < 16; ++r) { aa[r] = 0.f; ax[r] = 0.f; }
        mm32<64>(aa, sX + mi * 32 * 72, 72, sWa + nj * 32 * 72, 72, lane);
        mm32<64>(ax, sX + mi * 32 * 72, 72, sWx + nj * 32 * 72, 72, lane);
        const int cl = nj * 32 + (lane & 31), cgl = j * 64 + cl;
        const float ba = p.lru_ga_b[(l * 2 + D) * 1024 + cgl], bx = p.lru_gx_b[(l * 2 + D) * 1024 + cgl], sp = softplusf(-p.lru_lambda[(l * 2 + D) * 1024 + cgl]);
#pragma unroll
        for (int r = 0; r < 16; ++r) {
            const int tl = mi * 32 + rowmap32(r, lane);
            const float rg = sigmf(aa[r] + ba), ig = sigmf(ax[r] + bx);
            const float la = -8.f * rg * sp;
            const float a = __expf(la), mult = sqrtf(fmaxf(1.f - __expf(2.f * la), 0.f));
            const float xv = bf2f(sX[tl * 72 + cl]);
            sA[tl * 64 + cl] = a; sB[tl * 64 + cl] = mult * ig * xv;
        }
    }
    __syncthreads();
    {
        float A = 1.f, Bc = 0.f;
#pragma unroll
        for (int q = 0; q < 16; ++q) { const int tl = seg * 16 + (D == 0 ? q : 15 - q); const float a = sA[tl * 64 + ch], bb = sB[tl * 64 + ch]; A = a * A; Bc = a * Bc + bb; }
        sSA[seg * 64 + ch] = A; sSB[seg * 64 + ch] = Bc;
    }
    __syncthreads();
    if (!FINAL) {
        if (tid < 64) {
            float At = 1.f, Bt = 0.f;
#pragma unroll
            for (int s = 0; s < 8; ++s) { const int sg = D == 0 ? s : 7 - s; const float a = sSA[sg * 64 + ch], bb = sSB[sg * 64 + ch]; At = a * At; Bt = a * Bt + bb; }
            const size_t idx = (size_t)((b * 2 + D) * 18 + c) * 1024 + j * 64 + ch;
            WS_SUMA(p)[idx] = At; WS_SUMB(p)[idx] = Bt;
        }
    } else {
        float h = 0.f;
        const int pos = pos_of(D, c);
        for (int q = 0; q < pos; ++q) { const int cc = chunk_at(D, q); const size_t idx = (size_t)((b * 2 + D) * 18 + cc) * 1024 + j * 64 + ch; h = WS_SUMA(p)[idx] * h + WS_SUMB(p)[idx]; }
        const int nseg = D == 0 ? seg : 7 - seg;
        for (int s = 0; s < nseg; ++s) { const int sg = D == 0 ? s : 7 - s; h = sSA[sg * 64 + ch] * h + sSB[sg * 64 + ch]; }
#pragma unroll
        for (int q = 0; q < 16; ++q) { const int qq = D == 0 ? q : 15 - q; const int tl = seg * 16 + qq; h = sA[tl * 64 + ch] * h + sB[tl * 64 + ch]; hacc[qq] += h; }
    }
}
template <bool FINAL>
__device__ __forceinline__ void lru_item(const Params& p, int l, int item, unsigned char* shm) {
    const int tid = tidx(), ch = tid & 63, seg = tid >> 6;
    const int j = item & 15, bc = item >> 4, c = bc % NCH, b = bc / NCH, t0 = c * 128;
    const bf16_t* Pb = WS_P(p) + (size_t)b * TPB * LDP;
    __syncthreads();
    stage_conv_tile<64, false, false>((bf16_t*)shm, 72, Pb, t0, C_LX + j * 64, p.lru_conv_w + l * 4 * 1024 + j * 64, 1024, p.lru_conv_b + l * 1024 + j * 64, tid);
    float hacc[16];
#pragma unroll
    for (int q = 0; q < 16; ++q) hacc[q] = 0.f;
    lru_dir<FINAL, 0>(p, l, b, c, j, shm, hacc);
    lru_dir<FINAL, 1>(p, l, b, c, j, shm, hacc);
    if (FINAL) {
#pragma unroll
        for (int q = 0; q < 16; ++q) {
            const size_t tok = (size_t)b * TPB + t0 + seg * 16 + q;
            const float lg = bf2f(WS_P(p)[tok * LDP + C_LG + j * 64 + ch]);
            WS_MIX(p)[tok * MIXW + j * 64 + ch] = f2bf(hacc[q] * siluf(lg));
        }
    }
}

__device__ __forceinline__ void ssd_dt_acs(const Params& p, int l, int b, int c, int g, float* sDt, float* sAcs, float* sAl, bool write_al) {
    const int tid = tidx();
    for (int idx = tid; idx < 128 * 16; idx += 512) {
        const int jj = idx >> 4, col = idx & 15, hh = col >> 1, d = col & 1;
        const float dtp = bf2f(WS_P(p)[((size_t)b * TPB + c * 128 + jj) * LDP + C_DT + g * 8 + hh]);
        sDt[idx] = softplusf(dtp + p.ssd_dt_bias[(l * 2 + d) * 16 + g * 8 + hh]);
    }
    __syncthreads();
    if (tid < 16) {
        const int hh = tid >> 1, d = tid & 1;
        const float A = -__expf(p.ssd_A_log[(l * 2 + d) * 16 + g * 8 + hh]);
        float run = 0.f;
        if (d == 0) { for (int jj = 0; jj < 128; ++jj) { run += sDt[jj * 16 + tid] * A; sAcs[jj * 16 + tid] = run; } }
        else { for (int jj = 127; jj >= 0; --jj) { run += sDt[jj * 16 + tid] * A; sAcs[jj * 16 + tid] = run; } }
        sAl[tid] = run;
        if (write_al) WS_AL(p)[((b * 2 + d) * 18 + c) * 16 + g * 8 + hh] = run;
    }
    __syncthreads();
}
__device__ __forceinline__ void ssd_states_item(const Params& p, int l, int item, unsigned char* shm) {
    const int tid = tidx(), lane = tid & 63, wave = tid >> 6;
    const int g = item & 1, bc = item >> 1, c = bc % NCH, b = bc / NCH, t0 = c * 128;
    const bf16_t* Pb = WS_P(p) + (size_t)b * TPB * LDP;
    bf16_t* sBT = (bf16_t*)shm; bf16_t* sXT = (bf16_t*)(shm + 34816); bf16_t* sXw = (bf16_t*)(shm + 52224);
    float* sDt = (float*)(shm + 87040); float* sAcs = (float*)(shm + 95232); float* sAl = (float*)(shm + 103424);
    __syncthreads();
    ssd_dt_acs(p, l, b, c, g, sDt, sAcs, sAl, true);
    stage_conv_tile<128, true, true>(sBT, 136, Pb, t0, C_XBC + 1024 + g * 128, p.ssd_conv_w + l * 4 * 1536 + 1024 + g * 128, 1536, p.ssd_conv_b + l * 1536 + 1024 + g * 128, tid);
    for (int hh = 0; hh < 8; ++hh) {
        const int h = g * 8 + hh;
        __syncthreads();
        stage_conv_tile<64, true, true>(sXT, 136, Pb, t0, C_XBC + h * 64, p.ssd_conv_w + l * 4 * 1536 + h * 64, 1536, p.ssd_conv_b + l * 1536 + h * 64, tid);
        __syncthreads();
        for (int idx = tid; idx < 64 * 16; idx += 512) {
            const int pp = idx >> 4, j8 = (idx & 15) * 8;
            const f32x8 xv = unpack8(*(const u32x4*)(sXT + pp * 136 + j8));
#pragma unroll
            for (int d = 0; d < 2; ++d) {
                const int col = hh * 2 + d; const float al = sAl[col];
                f32x8 o;
#pragma unroll
                for (int e = 0; e < 8; ++e) o[e] = xv[e] * __expf(al - sAcs[(j8 + e) * 16 + col]) * sDt[(j8 + e) * 16 + col];
                *(u32x4*)(sXw + d * 8704 + pp * 136 + j8) = pack8(o);
            }
        }
        __syncthreads();
        const int mi = wave & 1, nj = wave >> 1;
#pragma unroll
        for (int d = 0; d < 2; ++d) {
            f32x16 acc;
#pragma unroll
            for (int r = 0; r < 16; ++r) acc[r] = 0.f;
            mm32<128>(acc, sXw + d * 8704 + mi * 32 * 136, 136, sBT + nj * 32 * 136, 136, lane);
            bf16_t* base = WS_ST(p) + ((size_t)((b * 2 + d) * 18 + c) * 16 + h) * 8192;
#pragma unroll
            for (int r = 0; r < 16; ++r) base[(mi * 32 + rowmap32(r, lane)) * 128 + nj * 32 + (lane & 31)] = f2bf(acc[r]);
        }
    }
}
__device__ __forceinline__ void ssd_recur_item(const Params& p, int item) {
    const int tid = tidx();
    const int d = item & 1, h = (item >> 1) & 15, b = item >> 5;
    f32x8 h0, h1;
#pragma unroll
    for (int e = 0; e < 8; ++e) { h0[e] = 0.f; h1[e] = 0.f; }
    for (int pos = 0; pos < NCH; ++pos) {
        const int c = chunk_at(d, pos);
        bf16_t* ptr = WS_ST(p) + ((size_t)((b * 2 + d) * 18 + c) * 16 + h) * 8192 + tid * 16;
        const f32x8 s0 = unpack8(*(const u32x4*)ptr), s1 = unpack8(*(const u32x4*)(ptr + 8));
        const float e = __expf(WS_AL(p)[((b * 2 + d) * 18 + c) * 16 + h]);
        *(u32x4*)ptr = pack8(h0); *(u32x4*)(ptr + 8) = pack8(h1);
        h0 = h0 * e + s0; h1 = h1 * e + s1;
    }
}
__device__ __forceinline__ void ssd_final_item(const Params& p, int l, int item, unsigned char* shm) {
    const int tid = tidx(), lane = tid & 63, wave = tid >> 6;
    const int g = item & 1, bc = item >> 1, c = bc % NCH, b = bc / NCH, t0 = c * 128;
    const bf16_t* Pb = WS_P(p) + (size_t)b * TPB * LDP;
    bf16_t* sC = (bf16_t*)shm; bf16_t* sBW = (bf16_t*)(shm + 34816); bf16_t* sXT = (bf16_t*)(shm + 69632); bf16_t* sH = (bf16_t*)(shm + 87040);
    float* sDt = (float*)(shm + 104448); float* sAcs = (float*)(shm + 112640); float* sAl = (float*)(shm + 120832);
    __syncthreads();
    ssd_dt_acs(p, l, b, c, g, sDt, sAcs, sAl, false);
    stage_conv_tile<128, true, false>(sC, 136, Pb, t0, C_XBC + 1280 + g * 128, p.ssd_conv_w + l * 4 * 1536 + 1280 + g * 128, 1536, p.ssd_conv_b + l * 1536 + 1280 + g * 128, tid);
    stage_conv_tile<128, true, false>(sBW, 136, Pb, t0, C_XBC + 1024 + g * 128, p.ssd_conv_w + l * 4 * 1536 + 1024 + g * 128, 1536, p.ssd_conv_b + l * 1536 + 1024 + g * 128, tid);
    __syncthreads();
    const int cmi = wave >> 1, cnj0 = (wave & 1) * 2;
    f32x16 cb0, cb1;
#pragma unroll
    for (int r = 0; r < 16; ++r) { cb0[r] = 0.f; cb1[r] = 0.f; }
    mm32<128>(cb0, sC + cmi * 32 * 136, 136, sBW + cnj0 * 32 * 136, 136, lane);
    mm32<128>(cb1, sC + cmi * 32 * 136, 136, sBW + (cnj0 + 1) * 32 * 136, 136, lane);
    const int ymi = wave & 3, ynj = wave >> 2;
#pragma unroll 1
    for (int hh = 0; hh < 8; ++hh) {
        const int h = g * 8 + hh;
        __syncthreads();
        stage_conv_tile<64, true, true>(sXT, 136, Pb, t0, C_XBC + h * 64, p.ssd_conv_w + l * 4 * 1536 + h * 64, 1536, p.ssd_conv_b + l * 1536 + h * 64, tid);
        f32x16 yacc;
#pragma unroll
        for (int r = 0; r < 16; ++r) yacc[r] = 0.f;
#pragma unroll 1
        for (int d = 0; d < 2; ++d) {
            const int col = hh * 2 + d;
            if (d == 1) __syncthreads();
#pragma unroll
            for (int tt = 0; tt < 2; ++tt) {
                const int jg = (cnj0 + tt) * 32 + (lane & 31);
                const float acj = sAcs[jg * 16 + col], dtj = sDt[jg * 16 + col];
#pragma unroll
                for (int r = 0; r < 16; ++r) {
                    const int ig = cmi * 32 + rowmap32(r, lane);
                    const bool valid = d == 0 ? (jg <= ig) : (jg >= ig);
                    const float cbv = tt == 0 ? cb0[r] : cb1[r];
                    const float val = valid ? cbv * __expf(sAcs[ig * 16 + col] - acj) * dtj : 0.f;
                    sBW[ig * 136 + jg] = f2bf(val);
                }
            }
            {
                const bf16_t* hp = WS_ST(p) + ((size_t)((b * 2 + d) * 18 + c) * 16 + h) * 8192 + tid * 16;
                const int pp = tid >> 3, n0 = (tid & 7) * 16;
                *(u32x4*)(sH + pp * 136 + n0) = *(const u32x4*)hp; *(u32x4*)(sH + pp * 136 + n0 + 8) = *(const u32x4*)(hp + 8);
            }
            __syncthreads();
            f32x16 ad, ao;
#pragma unroll
            for (int r = 0; r < 16; ++r) { ad[r] = 0.f; ao[r] = 0.f; }
            mm32<128>(ad, sBW + ymi * 32 * 136, 136, sXT + ynj * 32 * 136, 136, lane);
            mm32<128>(ao, sC + ymi * 32 * 136, 136, sH + ynj * 32 * 136, 136, lane);
#pragma unroll
            for (int r = 0; r < 16; ++r) { const int ig = ymi * 32 + rowmap32(r, lane); yacc[r] += ad[r] + __expf(sAcs[ig * 16 + col]) * ao[r]; }
        }
        const float Dh = p.ssd_D[l * 16 + h];
        const int pl = ynj * 32 + (lane & 31);
#pragma unroll
        for (int r = 0; r < 16; ++r) {
            const int ig = ymi * 32 + rowmap32(r, lane);
            const size_t tok = (size_t)b * TPB + t0 + ig;
            const float y = yacc[r] + Dh * bf2f(sXT[pl * 136 + ig]);
            const float z = bf2f(WS_P(p)[tok * LDP + C_Z + h * 64 + pl]);
            WS_MIX(p)[tok * MIXW + 2048 + h * 64 + pl] = f2bf(y * siluf(z));
        }
    }
}
__device__ __forceinline__ void ssd_norm_phase(const Params& p, int l, int G) {
    const int lane = tidx() & 63, wave = tidx() >> 6;
    for (int row = blockIdx.x * 8 + wave; row < NTOK; row += G * 8) {
        bf16_t* rp = WS_MIX(p) + (size_t)row * MIXW + 2048;
        f32x8 v0 = unpack8(*(const u32x4*)(rp + lane * 8)), v1 = unpack8(*(const u32x4*)(rp + 512 + lane * 8));
        float ss = 0.f;
#pragma unroll
        for (int e = 0; e < 8; ++e) ss += v0[e] * v0[e] + v1[e] * v1[e];
        ss = wave_sum(ss);
        const float rstd = rsqrtf(ss * (1.f / 1024.f) + 1e-6f);
        const float* nw = p.ssd_norm_w + l * 1024;
#pragma unroll
        for (int e = 0; e < 8; ++e) { v0[e] = v0[e] * rstd * nw[lane * 8 + e]; v1[e] = v1[e] * rstd * nw[512 + lane * 8 + e]; }
        *(u32x4*)(rp + lane * 8) = pack8(v0); *(u32x4*)(rp + 512 + lane * 8) = pack8(v1);
    }
}

__device__ __forceinline__ void attn_item(const Params& p, int l, int item, unsigned char* shm) {
    const int tid = tidx(), lane = tid & 63, wave = tid >> 6, fr = lane & 15, fq = lane >> 4;
    const int hq = item & 7, bq = item >> 3, qblk = bq % NCH, b = bq / NCH, kh = hq >> 2;
    const bf16_t* P = WS_P(p);
    bf16_t* sK = (bf16_t*)shm; bf16_t* sVT = (bf16_t*)(shm + 34816); bf16_t* sPw = (bf16_t*)(shm + 69632) + wave * (16 * 136);
    const size_t tokq0 = (size_t)b * TPB + qblk * 128;
    bf16x8 aq[4];
#pragma unroll
    for (int kk = 0; kk < 4; ++kk) aq[kk] = *(const bf16x8*)(P + (tokq0 + wave * 16 + fr) * LDP + C_Q + hq * 128 + kk * 32 + 8 * fq);
    float m[4], ls[4]; f32x4 O[8];
    const float sink = p.att_sink[l * 8 + hq];
#pragma unroll
    for (int r = 0; r < 4; ++r) { m[r] = sink; ls[r] = 1.f; }
#pragma unroll
    for (int nd = 0; nd < 8; ++nd) O[nd] = (f32x4){0.f, 0.f, 0.f, 0.f};
    const int nlat = qblk - 2;
    const int ntiles = qblk < 2 ? 2 : 5;
    for (int ti = 0; ti < ntiles; ++ti) {
        int t0; bool masked = false; int kb = 0;
        if (ti < 2) t0 = ti * 128;
        else { kb = nlat - 1 + (ti - 2); if (kb < 0 || kb >= 16) continue; t0 = 256 + kb * 128; masked = true; }
        __syncthreads();
        {
            const bf16_t* kbase = P + ((size_t)b * TPB + t0) * LDP + C_K + kh * 128;
            for (int idx = tid; idx < 2048; idx += 512) { const int key = idx >> 4, dg = idx & 15; *(u32x4*)(sK + key * 136 + dg * 8) = *(const u32x4*)(kbase + (size_t)key * LDP + dg * 8); }
            const bf16_t* vbase = P + ((size_t)b * TPB + t0) * LDP + C_V + kh * 128;
            for (int idx = tid; idx < 2048; idx += 512) {
                const int key = idx & 127, dg = idx >> 7;
                const u32x4 raw = *(const u32x4*)(vbase + (size_t)key * LDP + dg * 8);
                bf16_t* dp = sVT + (dg * 8) * 136 + key;
                dp[0 * 136] = (bf16_t)(raw.x & 0xffffu); dp[1 * 136] = (bf16_t)(raw.x >> 16); dp[2 * 136] = (bf16_t)(raw.y & 0xffffu); dp[3 * 136] = (bf16_t)(raw.y >> 16);
                dp[4 * 136] = (bf16_t)(raw.z & 0xffffu); dp[5 * 136] = (bf16_t)(raw.z >> 16); dp[6 * 136] = (bf16_t)(raw.w & 0xffffu); dp[7 * 136] = (bf16_t)(raw.w >> 16);
            }
        }
        __syncthreads();
        f32x4 s[8];
#pragma unroll
        for (int nt = 0; nt < 8; ++nt) {
            s[nt] = (f32x4){0.f, 0.f, 0.f, 0.f};
#pragma unroll
            for (int kk = 0; kk < 4; ++kk) { const bf16x8 bk = *(const bf16x8*)(sK + (nt * 16 + fr) * 136 + kk * 32 + 8 * fq); s[nt] = __builtin_amdgcn_mfma_f32_16x16x32_bf16(aq[kk], bk, s[nt], 0, 0, 0); }
        }
        if (masked) {
#pragma unroll
            for (int nt = 0; nt < 8; ++nt)
#pragma unroll
                for (int r = 0; r < 4; ++r) { const int rel = (nlat * 128 + wave * 16 + fq * 4 + r) - (kb * 128 + nt * 16 + fr); if (rel > 128 || rel < -128) s[nt][r] = -INFINITY; }
        }
        float alpha[4];
#pragma unroll
        for (int r = 0; r < 4; ++r) {
            float mx = s[0][r];
#pragma unroll
            for (int nt = 1; nt < 8; ++nt) mx = fmaxf(mx, s[nt][r]);
            mx = fmaxf(mx, __shfl_xor(mx, 1)); mx = fmaxf(mx, __shfl_xor(mx, 2)); mx = fmaxf(mx, __shfl_xor(mx, 4)); mx = fmaxf(mx, __shfl_xor(mx, 8));
            const float mn = fmaxf(m[r], mx);
            alpha[r] = __expf(m[r] - mn); m[r] = mn;
            float rs = 0.f;
#pragma unroll
            for (int nt = 0; nt < 8; ++nt) { const float pv = __expf(s[nt][r] - mn); s[nt][r] = pv; rs += pv; }
            rs += __shfl_xor(rs, 1); rs += __shfl_xor(rs, 2); rs += __shfl_xor(rs, 4); rs += __shfl_xor(rs, 8);
            ls[r] = ls[r] * alpha[r] + rs;
        }
#pragma unroll
        for (int nd = 0; nd < 8; ++nd) { O[nd].x *= alpha[0]; O[nd].y *= alpha[1]; O[nd].z *= alpha[2]; O[nd].w *= alpha[3]; }
#pragma unroll
        for (int nt = 0; nt < 8; ++nt)
#pragma unroll
            for (int r = 0; r < 4; ++r) sPw[(fq * 4 + r) * 136 + nt * 16 + fr] = f2bf(s[nt][r]);
        asm volatile("s_waitcnt lgkmcnt(0)" ::: "memory");
#pragma unroll
        for (int kk = 0; kk < 4; ++kk) {
            const bf16x8 ap = *(const bf16x8*)(sPw + fr * 136 + kk * 32 + 8 * fq);
#pragma unroll
            for (int nd = 0; nd < 8; ++nd) { const bf16x8 bv = *(const bf16x8*)(sVT + (nd * 16 + fr) * 136 + kk * 32 + 8 * fq); O[nd] = __builtin_amdgcn_mfma_f32_16x16x32_bf16(ap, bv, O[nd], 0, 0, 0); }
        }
    }
#pragma unroll
    for (int r = 0; r < 4; ++r) {
        const size_t tok = tokq0 + wave * 16 + fq * 4 + r;
        const float il = 1.f / ls[r];
#pragma unroll
        for (int nd = 0; nd < 8; ++nd) {
            const int dcol = hq * 128 + nd * 16 + fr;
            const float ag = bf2f(P[tok * LDP + C_AG + dcol]);
            WS_MIX(p)[tok * MIXW + 1024 + dcol] = f2bf(O[nd][r] * il * siluf(ag));
        }
    }
}


#define XB_TMO      128
#define XB_XCNT(j)  (256  + 64 * (j))
#define XB_XSUB(j)  (1280 + 64 * (j))
#define XB_XGEN(j)  (2304 + 64 * (j))
#define XB_TOP      3328
#define XB_TOPGEN   3392
#define XCD_BAR_WORDS 3456
#define XB_SPIN_CAP (1u << 18)
#define LAS __attribute__((address_space(3)))
__device__ __forceinline__ unsigned xb_ld(unsigned* p)              { return __hip_atomic_load(p, __ATOMIC_RELAXED, __HIP_MEMORY_SCOPE_AGENT); }
__device__ __forceinline__ unsigned xb_add(unsigned* p, unsigned v) { return __hip_atomic_fetch_add(p, v, __ATOMIC_RELAXED, __HIP_MEMORY_SCOPE_AGENT); }
__device__ __forceinline__ unsigned xb_xcc_id() { return (unsigned)__builtin_amdgcn_s_getreg((3 << 11) | 20) & 0xFu; }
#define XB_SPIN(cond, bar) do { unsigned _sp = 0; while (cond) { __builtin_amdgcn_s_sleep(1); \
    if ((++_sp & 255u) == 0u) { if (xb_ld(&(bar)[XB_TMO])) break; if (_sp > XB_SPIN_CAP) { atomicAdd(&(bar)[XB_TMO], 1u); break; } } } } while (0)
struct XcdBarrier { unsigned* bar; unsigned x; volatile LAS unsigned* st; };
__device__ __forceinline__ XcdBarrier xcd_barrier_post(unsigned* bar, volatile LAS unsigned* st) {
    XcdBarrier b; b.bar = bar; b.x = xb_xcc_id(); b.st = st;
    if (threadIdx.x == 0) (void)xb_add(&bar[XB_XCNT(b.x)], 1u);
    return b;
}
__device__ __forceinline__ void xcd_barrier_complete(unsigned* bar, unsigned x, unsigned& nloc, unsigned& nx) {
    const unsigned G = gridDim.x * gridDim.y * gridDim.z;
    unsigned sum, cnt, mine, sp = 0u;
    for (;;) {
        sum = 0u; cnt = 0u; mine = 0u;
#pragma unroll
        for (unsigned j = 0; j < 16; ++j) { const unsigned c = xb_ld(&bar[XB_XCNT(j)]); sum += c; cnt += (c > 0u) ? 1u : 0u; mine = (j == x) ? c : mine; }
        if (sum == G) break;
        __builtin_amdgcn_s_sleep(1);
        if ((++sp & 255u) == 0u) { if (xb_ld(&bar[XB_TMO])) break; if (sp > XB_SPIN_CAP) { atomicAdd(&bar[XB_TMO], 1u); break; } }
    }
    nloc = mine > 0u ? mine : 1u; nx = cnt > 0u ? cnt : 1u;
}
__device__ __forceinline__ void xcd_barrier(const XcdBarrier& b) {
    asm volatile("s_waitcnt vmcnt(0)" ::: "memory");
    __syncthreads();
    if (threadIdx.x == 0) {
        unsigned* bar = b.bar;
        __builtin_amdgcn_s_waitcnt(0);
        unsigned nloc = b.st[0], nx = b.st[1];
        if (nloc == 0u) { xcd_barrier_complete(bar, b.x, nloc, nx); b.st[0] = nloc; b.st[1] = nx; }
        const unsigned old = xb_add(&bar[XB_XSUB(b.x)], 1u);
        const unsigned gen = old / nloc;
        if (old + 1u == (gen + 1u) * nloc) {
            __builtin_amdgcn_fence(__ATOMIC_RELEASE, "agent");
            asm volatile("s_waitcnt vmcnt(0)" ::: "memory");
            const unsigned og = xb_add(&bar[XB_TOP], 1u);
            const unsigned tg = og / nx;
            if (og + 1u == (tg + 1u) * nx) xb_add(&bar[XB_TOPGEN], 1u);
            else XB_SPIN(xb_ld(&bar[XB_TOPGEN]) == tg, bar);
            __builtin_amdgcn_fence(__ATOMIC_ACQUIRE, "agent");
            xb_add(&bar[XB_XGEN(b.x)], 1u);
            asm volatile("s_waitcnt vmcnt(0)" ::: "memory");
        } else {
            XB_SPIN(xb_ld(&bar[XB_XGEN(b.x)]) == gen, bar);
            __builtin_amdgcn_fence(__ATOMIC_ACQUIRE, "agent");
            asm volatile("s_waitcnt vmcnt(0)" ::: "memory");
        }
    }
    __syncthreads();
}

__global__ __launch_bounds__(512) void mega(Params p) {
    extern __shared__ __attribute__((aligned(16))) unsigned char shm[];
    cg::grid_group grid = cg::this_grid();
    const int G = (int)gridDim.x, bid = (int)blockIdx.x;
    const int wave = tidx() >> 6, lane = tidx() & 63;
    if (threadIdx.x < 4) ((volatile LAS unsigned*)(shm + 131072))[threadIdx.x] = 0u;
    __syncthreads();
    const XcdBarrier xb = xcd_barrier_post((unsigned*)(p.ws + OFF_BAR), (volatile LAS unsigned*)(shm + 131072));
    for (int rep = 0; rep < 1 + DUP_P0; ++rep) phase0(p, shm, G);
    grid.sync();
#pragma unroll 1
    for (int l = 0; l < 4; ++l) {
        for (int rep = 0; rep < 1 + DUP_NORM; ++rep) norm_phase(p, l, G);
        xcd_barrier(xb);
        {
            pg8::Gemm g{WS_U(p), WS_WTIN(p) + (size_t)l * 7424 * 2048, NTOK, 7424, 2048};
            pg8::Order S; S.init(72, 29, G, bid, 0);
            EpiG1 E{WS_P(p)};
            for (int rep = 0; rep < 1 + DUP_G1; ++rep) pg8::gemm_phase<EpiG1, pg8::Order>((PG8_LAS unsigned char*)shm, g, S, E);
        }
        for (int rep = 0; rep < 1 + DUP_SYNC; ++rep) xcd_barrier(xb);
        for (int rep = 0; rep < 1 + DUP_X1A; ++rep) for (int it = bid; it < 288; it += G) ssd_states_item(p, l, it, shm);
        for (int rep = 0; rep < 1 + DUP_X1B; ++rep) for (int it = bid; it < 2304; it += G) lru_item<false>(p, l, it, shm);
#ifndef SK_QK
        for (int row = bid * 8 + wave; row < NTOK; row += G * 8) qkprep_row(p, l, row, lane);
#endif
        xcd_barrier(xb);
#ifndef SK_X2A
        for (int it = bid; it < 256; it += G) ssd_recur_item(p, it);
#endif
        for (int rep = 0; rep < 1 + DUP_ATT; ++rep) for (int it = bid; it < 1152; it += G) attn_item(p, l, it, shm);
        xcd_barrier(xb);
        for (int rep = 0; rep < 1 + DUP_X3A; ++rep) for (int it = bid; it < 288; it += G) ssd_final_item(p, l, it, shm);
        for (int rep = 0; rep < 1 + DUP_X3B; ++rep) for (int it = bid; it < 2304; it += G) lru_item<true>(p, l, it, shm);
        xcd_barrier(xb);
#ifndef SK_X4
        ssd_norm_phase(p, l, G);
#endif
        xcd_barrier(xb);
        {
            pg8::Gemm g{WS_MIX(p), WS_WTOUT(p) + (size_t)l * 2048 * 3072, NTOK, 2048, 3072};
            pg8::Order S; S.init(l == 3 ? 64 : 72, 8, G, bid, l == 3 ? 1 : 0);
            EpiG2 E{p, l};
#ifndef SK_G2
            pg8::gemm_phase<EpiG2, pg8::Order>((PG8_LAS unsigned char*)shm, g, S, E);
#endif
        }
        if (l < 3) xcd_barrier(xb);
    }
}

extern "C" void kernel_launch(void* const* d_in, const int* in_sizes, int n_in, void* d_out, int out_size, void* d_ws, size_t ws_size, hipStream_t stream) {
    static int grid = 0;
    if (grid == 0) {
        if (n_in != 25 || ws_size < WS_END) { fprintf(stderr, "kernel_launch: need 25 inputs and %zu bytes of workspace (got %d, %zu)\n", (size_t)WS_END, n_in, ws_size); grid = -1; return; }
        int dev = 0, cus = 0, per_cu = 0;
        hipGetDevice(&dev);
        hipDeviceGetAttribute(&cus, hipDeviceAttributeMultiprocessorCount, dev);
        if (hipFuncSetAttribute((const void*)mega, hipFuncAttributeMaxDynamicSharedMemorySize, LDS_BYTES) != hipSuccess) { fprintf(stderr, "kernel_launch: hipFuncSetAttribute failed\n"); grid = -1; return; }
        if (hipOccupancyMaxActiveBlocksPerMultiprocessor(&per_cu, (const void*)mega, 512, LDS_BYTES) != hipSuccess || per_cu < 1) { fprintf(stderr, "kernel_launch: occupancy query gave %d\n", per_cu); per_cu = 1; }
        (void)hipGetLastError();
        grid = cus * 1;
        if (grid <= 0) grid = 256;
    }
    if (grid < 0) return;
    Params p{};
    const float** pf = (const float**)&p;
    for (int i = 0; i < 25; ++i) pf[i] = (const float*)d_in[i];
    p.out = (float*)d_out; p.ws = (unsigned char*)d_ws;
    if (hipMemsetAsync((char*)d_ws + OFF_BAR, 0, 16384, stream) != hipSuccess) { fprintf(stderr, "kernel_launch: memset of barrier words failed\n"); return; }
    void* args[] = {&p};
    hipError_t e = hipLaunchCooperativeKernel((const void*)mega, dim3(grid), dim3(512), args, LDS_BYTES, stream);
    if (e != hipSuccess) fprintf(stderr, "cooperative launch failed: %s (grid %d)\n", hipGetErrorString(e), grid);
}
```

```cpp
#include <hip/hip_runtime.h>
#include <hip/hip_cooperative_groups.h>
#include <cstdio>
#include <cstdint>
namespace cg = cooperative_groups;
#define DUP_X1A 0
#define DUP_X1B 0
#define DUP_ATT 0
#define DUP_X3A 0
#define DUP_X3B 0
#define DUP_G1 0
#define DUP_P0 0
#define DUP_NORM 0
#define DUP_SYNC 0
#define DUP_E1 0

__device__ __forceinline__ int tidx() { int t = (int)threadIdx.x; asm volatile("" : "+v"(t)); return t; }

namespace pg8 {
#define PG8_LAS __attribute__((address_space(3)))
typedef unsigned short bf16_t;
typedef short bf16x8 __attribute__((ext_vector_type(8)));
typedef float f32x4 __attribute__((ext_vector_type(4)));
typedef unsigned u32x4 __attribute__((ext_vector_type(4)));
constexpr int BM = 256, BK = 64, HALF = 128, HTB = HALF * BK * 2  , STAGE_BYTES = 8 * HTB, NXCD = 8, WGM = 8;

__host__ __device__ __forceinline__ int lds_byte(int r, int c) { const int st = (r >> 4) * 2 + (c >> 5), rr = r & 15, cc = c & 31, ob = rr * 64 + cc * 2; return st * 1024 + (ob ^ (((ob >> 9) & 1) << 5)); }
__host__ __device__ __forceinline__ void stage_rc(int b, int& R, int& C) { const int st = b / 1024, sb = b % 1024, swz = sb ^ (((sb >> 9) & 1) << 5); R = (st >> 1) * 16 + swz / 64; C = (st & 1) * 32 + (swz % 64) / 2; }
__host__ __device__ __forceinline__ int perm32(int rho) { const int n = rho >> 4, i = rho & 15; return 8 * (i >> 2) + 4 * n + (i & 3); }

struct Unit { int pm, pn; };
struct Gemm { const bf16_t* A; const bf16_t* Bt; int M, N, K; };

struct Order {
    int nM, nN, nwg, G, c, skipctx;
    __device__ void init(int nM_, int nN_, int G_, int c_, int skip_) { nM = nM_; nN = nN_; nwg = nM * nN; G = G_; c = c_; skipctx = skip_; }
    __device__ bool next(int i, Unit& u) const {
        const long L = (long)i * G + c; if (L >= nwg) return false;
        int wgid = (int)L; { const int q = nwg / NXCD, r = nwg % NXCD, xcd = wgid % NXCD, off = wgid / NXCD; wgid = (xcd < r ? xcd * (q + 1) : r * (q + 1) + (xcd - r) * q) + off; }
        const int nig = WGM * nN, gid = wgid / nig, fm = gid * WGM, gsz = (nM - fm) < WGM ? (nM - fm) : WGM;
        int pm = fm + ((wgid % nig) % gsz); u.pn = (wgid % nig) / gsz;
        if (skipctx) pm = (pm >> 3) * 9 + 1 + (pm & 7);
        u.pm = pm; return true;
    }
    __device__ __forceinline__ void a_ready(const Unit&) const {}
    __device__ __forceinline__ void done(const Unit&) const {}
};
typedef __bf16 bf16x2_t __attribute__((ext_vector_type(2)));
typedef float f32x2_t __attribute__((ext_vector_type(2)));
__device__ __forceinline__ unsigned cvt_pk_bf16(float lo, float hi) { f32x2_t v = {lo, hi}; bf16x2_t b = __builtin_convertvector(v, bf16x2_t); return __builtin_bit_cast(unsigned, b); }

template <class Epi, class Sched>
__device__ __forceinline__ void gemm_phase(PG8_LAS unsigned char* lds, const Gemm g, const Sched& S, const Epi& E) {
    const int tid = tidx(), wid = __builtin_amdgcn_readfirstlane(tid >> 6), lane = tid & 63, wr = wid >> 2, wc = wid & 3, fr = lane & 15, fq = lane >> 4;
    const int K = g.K, nt = K / BK;
    unsigned voffA[2], voffB[2];
#pragma unroll
    for (int i = 0; i < 2; ++i) { int R, C; stage_rc(tid * 16 + i * 8192, R, C); const int Rb = Epi::PERM ? ((R & ~31) + perm32(R & 31)) : R;
        voffA[i] = (unsigned)(R * K + C) * 2u; voffB[i] = (unsigned)(Rb * K + C) * 2u; }
    const size_t kstep = (size_t)(BK * 2);
    const size_t hstep = (size_t)HALF * K * 2;
    const size_t tstep = 2 * hstep;
    const unsigned ldsw = (unsigned)wid * 1024u;
    const int aoff = lds_byte(wr * 64 + fr, fq * 8), boff = lds_byte(wc * 32 + fr, fq * 8);
#define PG8_SA(b, h) (((b) * 2 + (h)) * HTB)
#define PG8_SB(b, h) ((4 + (b) * 2 + (h)) * HTB)
#define PG8_STAGE(bufoff, gbase, voff) do { _Pragma("unroll") for (int _i = 0; _i < 2; ++_i) \
        __builtin_amdgcn_global_load_lds((const unsigned*)((const char*)(gbase) + (voff)[_i]), (PG8_LAS unsigned*)(lds + (bufoff) + ldsw + _i * 8192), 16, 0, 0); } while (0)
#define PG8_LDA(dst, b, h) do { _Pragma("unroll") for (int m = 0; m < 4; ++m) _Pragma("unroll") for (int k = 0; k < 2; ++k) dst[m][k] = *(const PG8_LAS bf16x8*)(lds + PG8_SA(b, h) + aoff + m * 2048 + k * 1024); } while (0)
#define PG8_LDB(dst, b, h) do { _Pragma("unroll") for (int n = 0; n < 2; ++n) _Pragma("unroll") for (int k = 0; k < 2; ++k) dst[n][k] = *(const PG8_LAS bf16x8*)(lds + PG8_SB(b, h) + boff + n * 2048 + k * 1024); } while (0)
#define PG8_MMA(ai, bj, At, Bt) do { __builtin_amdgcn_s_setprio(1); _Pragma("unroll") for (int m = 0; m < 4; ++m) _Pragma("unroll") for (int n = 0; n < 2; ++n) _Pragma("unroll") for (int k = 0; k < 2; ++k) \
        acc[ai][bj][m][n] = __builtin_amdgcn_mfma_f32_16x16x32_bf16(Bt[n][k], At[m][k], acc[ai][bj][m][n], 0, 0, 0); __builtin_amdgcn_s_setprio(0); } while (0)
#define PG8_WAIT_V(n) asm volatile("s_waitcnt vmcnt(" #n ")" ::: "memory")
#define PG8_WAIT_L(n) asm volatile("s_waitcnt lgkmcnt(" #n ")" ::: "memory")
#define PG8_BAR __builtin_amdgcn_s_barrier()
#define PG8_SCHED __builtin_amdgcn_sched_barrier(0)
    Unit cur, nxt; int ui = 0;
    if (!S.next(0, cur)) return;
    f32x4 acc[2][2][4][2];
#pragma unroll
    for (int a = 0; a < 2; ++a)
#pragma unroll
        for (int b = 0; b < 2; ++b)
#pragma unroll
            for (int m = 0; m < 4; ++m)
#pragma unroll
                for (int n = 0; n < 2; ++n) acc[a][b][m][n] = (f32x4){0.f, 0.f, 0.f, 0.f};
    bf16x8 At[4][2], B0[2][2], B1[2][2];
    const char* cA = (const char*)g.A + (size_t)cur.pm * tstep; const char* cB = (const char*)g.Bt + (size_t)cur.pn * tstep;
    S.a_ready(cur);
    PG8_STAGE(PG8_SB(0, 0), cB, voffB); PG8_STAGE(PG8_SA(0, 0), cA, voffA); PG8_STAGE(PG8_SB(0, 1), cB + hstep, voffB); PG8_STAGE(PG8_SA(0, 1), cA + hstep, voffA);
    if (wr == 1) PG8_BAR;
    PG8_WAIT_V(4); PG8_BAR;
    PG8_STAGE(PG8_SB(1, 0), cB + kstep, voffB); PG8_STAGE(PG8_SA(1, 0), cA + kstep, voffA); PG8_STAGE(PG8_SB(1, 1), cB + hstep + kstep, voffB);
    PG8_WAIT_V(6); PG8_BAR;
    for (;;) {
        const bool has_next = S.next(ui + 1, nxt);
        const char* nA = has_next ? (const char*)g.A + (size_t)nxt.pm * tstep : cA; const char* nB = has_next ? (const char*)g.Bt + (size_t)nxt.pn * tstep : cB;
        for (int t = 0; t < nt; t += 2) {
            const bool last = (t == nt - 2);
            const char* a1 = cA + (size_t)(t + 1) * kstep;
            const char* a2 = last ? nA : cA + (size_t)(t + 2) * kstep; const char* b2 = last ? nB : cB + (size_t)(t + 2) * kstep;
            const char* a3 = a2 + kstep; const char* b3 = b2 + kstep;
            if (last && has_next) S.a_ready(nxt);
            PG8_LDB(B0, 0, 0); PG8_SCHED; PG8_LDA(At, 0, 0); PG8_STAGE(PG8_SA(1, 1), a1 + hstep, voffA);
            PG8_WAIT_L(8); PG8_BAR; PG8_WAIT_L(0); PG8_MMA(0, 0, At, B0); PG8_BAR; PG8_SCHED;
            PG8_LDB(B1, 0, 1); PG8_STAGE(PG8_SB(0, 0), b2, voffB);
            PG8_BAR; PG8_WAIT_L(0); PG8_MMA(0, 1, At, B1); PG8_BAR;
            PG8_LDA(At, 0, 1); PG8_STAGE(PG8_SA(0, 0), a2, voffA);
            PG8_BAR; PG8_WAIT_L(0); PG8_MMA(1, 0, At, B0); PG8_BAR; PG8_SCHED;
            PG8_STAGE(PG8_SB(0, 1), b2 + hstep, voffB);
            PG8_WAIT_V(6); PG8_BAR; PG8_MMA(1, 1, At, B1); PG8_BAR;
            PG8_LDB(B0, 1, 0); PG8_SCHED; PG8_LDA(At, 1, 0); PG8_STAGE(PG8_SA(0, 1), a2 + hstep, voffA);
            PG8_WAIT_L(8); PG8_BAR; PG8_WAIT_L(0); PG8_MMA(0, 0, At, B0); PG8_BAR; PG8_SCHED;
            PG8_LDB(B1, 1, 1); PG8_STAGE(PG8_SB(1, 0), b3, voffB);
            PG8_BAR; PG8_WAIT_L(0); PG8_MMA(0, 1, At, B1); PG8_BAR;
            PG8_LDA(At, 1, 1); PG8_STAGE(PG8_SA(1, 0), a3, voffA);
            PG8_BAR; PG8_WAIT_L(0); PG8_MMA(1, 0, At, B0); PG8_BAR; PG8_SCHED;
            PG8_STAGE(PG8_SB(1, 1), b3 + hstep, voffB);
            PG8_WAIT_V(6); PG8_BAR; PG8_MMA(1, 1, At, B1); PG8_BAR;
        }
        if constexpr (!Epi::AFTER_DRAIN) { E(acc, cur, wr, wc, fr, fq); S.done(cur); }
        if (!has_next) break;
#pragma unroll
        for (int a = 0; a < 2; ++a)
#pragma unroll
            for (int b = 0; b < 2; ++b)
#pragma unroll
                for (int m = 0; m < 4; ++m)
#pragma unroll
                    for (int n = 0; n < 2; ++n) acc[a][b][m][n] = (f32x4){0.f, 0.f, 0.f, 0.f};
        cur = nxt; cA = nA; cB = nB; ++ui;
    }
    PG8_WAIT_V(0);
    if (wr == 0) PG8_BAR;
    PG8_BAR;
    if constexpr (Epi::AFTER_DRAIN) { E.fused(acc, cur, wr, wc, fr, fq, lds, wid, lane); S.done(cur); }
#undef PG8_SA
#undef PG8_SB
#undef PG8_STAGE
#undef PG8_LDA
#undef PG8_LDB
#undef PG8_MMA
#undef PG8_WAIT_V
#undef PG8_WAIT_L
#undef PG8_BAR
#undef PG8_SCHED
}
}

using pg8::bf16_t; using pg8::bf16x8; using pg8::f32x4; using pg8::cvt_pk_bf16;
typedef float f32x16 __attribute__((ext_vector_type(16)));
typedef float f32x8 __attribute__((ext_vector_type(8)));
typedef unsigned u32x2 __attribute__((ext_vector_type(2)));
typedef unsigned u32x4 __attribute__((ext_vector_type(4)));

constexpr int DM = 2048, TPB = 2304, NTOK = 18432, LDP = 7424, MIXW = 3072, NCH = 18;
constexpr int C_LX = 0, C_LG = 1024, C_Q = 2048, C_K = 3072, C_V = 3328, C_AG = 3584, C_XBC = 4608, C_Z = 6144, C_DT = 7168;
constexpr size_t SZ_WTIN = (size_t)4 * 7424 * 2048 * 2, SZ_WTOUT = (size_t)4 * 2048 * 3072 * 2, SZ_MOD = (size_t)4 * 9 * 6144 * 4, SZ_U = (size_t)NTOK * 2048 * 2,
                 SZ_P = (size_t)NTOK * LDP * 2, SZ_MIX = (size_t)NTOK * MIXW * 2, SZ_XB = (size_t)NTOK * 2048 * 4, SZ_ST = (size_t)8 * 2 * 18 * 16 * 8192 * 2,
                 SZ_AL = (size_t)8 * 2 * 18 * 16 * 4, SZ_SUM = (size_t)8 * 2 * 18 * 1024 * 4;
constexpr size_t OFF_WTIN = 0, OFF_WTOUT = OFF_WTIN + SZ_WTIN, OFF_MOD = OFF_WTOUT + SZ_WTOUT, OFF_U = OFF_MOD + SZ_MOD, OFF_P = OFF_U + SZ_U, OFF_MIX = OFF_P + SZ_P,
                 OFF_XB = OFF_MIX + SZ_MIX, OFF_ST = OFF_XB + SZ_XB, OFF_AL = OFF_ST + SZ_ST, OFF_SUMA = OFF_AL + SZ_AL, OFF_SUMB = OFF_SUMA + SZ_SUM, OFF_BAR = OFF_SUMB + SZ_SUM, OFF_SBC = OFF_BAR + 32768, OFF_SBT = OFF_SBC + (size_t)NTOK * 512 * 2, OFF_DTA = OFF_SBT + (size_t)8 * 18 * 2 * 16384 * 2,
                 OFF_ACS = OFF_DTA + (size_t)NTOK * 32 * 4, OFF_HINL = OFF_ACS + (size_t)NTOK * 32 * 4, WS_END = OFF_HINL + SZ_SUM;
constexpr size_t OFF_LXC = OFF_U, OFF_SXT = OFF_U + (size_t)NTOK * 1024 * 2;
constexpr int LDS_BYTES = 131072 + 16;

struct Params {
    const float *x, *c, *ctx, *c_ctx, *norm_w, *ada_w, *ada_b, *w_in, *lru_conv_w, *lru_conv_b, *lru_ga_w, *lru_ga_b, *lru_gx_w, *lru_gx_b, *lru_lambda,
        *att_q_norm, *att_k_norm, *att_sink, *ssd_conv_w, *ssd_conv_b, *ssd_dt_bias, *ssd_A_log, *ssd_D, *ssd_norm_w, *w_out;
    float* out;
    unsigned char* ws;
};
#define WS_WTIN(p) ((bf16_t*)((p).ws + OFF_WTIN))
#define WS_WTOUT(p) ((bf16_t*)((p).ws + OFF_WTOUT))
#define WS_MOD(p) ((float*)((p).ws + OFF_MOD))
#define WS_U(p) ((bf16_t*)((p).ws + OFF_U))
#define WS_P(p) ((bf16_t*)((p).ws + OFF_P))
#define WS_MIX(p) ((bf16_t*)((p).ws + OFF_MIX))
#define WS_XB(p) ((float*)((p).ws + OFF_XB))
#define WS_ST(p) ((bf16_t*)((p).ws + OFF_ST))
#define WS_AL(p) ((float*)((p).ws + OFF_AL))
#define WS_SUMA(p) ((float*)((p).ws + OFF_SUMA))
#define WS_SUMB(p) ((float*)((p).ws + OFF_SUMB))
#define WS_LXC(p) ((bf16_t*)((p).ws + OFF_LXC))
#define WS_SXT(p) ((bf16_t*)((p).ws + OFF_SXT))
#define WS_SBC(p) ((bf16_t*)((p).ws + OFF_SBC))
#define WS_SBT(p) ((bf16_t*)((p).ws + OFF_SBT))
#define WS_DTA(p) ((float*)((p).ws + OFF_DTA))
#define WS_ACS(p) ((float*)((p).ws + OFF_ACS))
#define WS_HINL(p) ((float*)((p).ws + OFF_HINL))

__device__ __forceinline__ float bf2f(bf16_t v) { return __uint_as_float(((unsigned)v) << 16); }
__device__ __forceinline__ bf16_t f2bf(float f) { return (bf16_t)(cvt_pk_bf16(f, 0.f) & 0xffffu); }
__device__ __forceinline__ float siluf(float v) { return v / (1.f + __expf(-v)); }
__device__ __forceinline__ float sigmf(float v) { return 1.f / (1.f + __expf(-v)); }
__device__ __forceinline__ float softplusf(float v) { return v > 20.f ? v : log1pf(__expf(v)); }
__device__ __forceinline__ float wave_sum(float v) {
#pragma unroll
    for (int o = 1; o < 64; o <<= 1) v += __shfl_xor(v, o);
    return v;
}
__device__ __forceinline__ f32x8 unpack8(const u32x4 w) {
    f32x8 f;
    f[0] = __uint_as_float(w.x << 16); f[1] = __uint_as_float(w.x & 0xffff0000u); f[2] = __uint_as_float(w.y << 16); f[3] = __uint_as_float(w.y & 0xffff0000u);
    f[4] = __uint_as_float(w.z << 16); f[5] = __uint_as_float(w.z & 0xffff0000u); f[6] = __uint_as_float(w.w << 16); f[7] = __uint_as_float(w.w & 0xffff0000u);
    return f;
}
__device__ __forceinline__ u32x4 pack8(const f32x8 f) { u32x4 w; w.x = cvt_pk_bf16(f[0], f[1]); w.y = cvt_pk_bf16(f[2], f[3]); w.z = cvt_pk_bf16(f[4], f[5]); w.w = cvt_pk_bf16(f[6], f[7]); return w; }
__device__ __forceinline__ int chunk_at(int d, int pos) { return d == 0 ? pos : (pos < 2 ? 1 - pos : 19 - pos); }
__device__ __forceinline__ int pos_of(int d, int c) { return d == 0 ? c : (c < 2 ? 1 - c : 19 - c); }
__device__ __forceinline__ int rowmap32(int reg, int lane) { return (reg & 3) + 8 * (reg >> 2) + 4 * (lane >> 5); }

template <int K> __device__ __forceinline__ void mm32(f32x16& acc, const bf16_t* A, int lda, const bf16_t* B, int ldb, int lane) {
    const bf16_t* pa = A + (lane & 31) * lda + 8 * (lane >> 5);
    const bf16_t* pb = B + (lane & 31) * ldb + 8 * (lane >> 5);
#pragma unroll
    for (int k = 0; k < K; k += 16) {
        const bf16x8 a = *(const bf16x8*)(pa + k);
        const bf16x8 b = *(const bf16x8*)(pb + k);
        acc = __builtin_amdgcn_mfma_f32_32x32x16_bf16(a, b, acc, 0, 0, 0);
    }
}

template <int NC, bool SILU, bool TRANS>
__device__ __forceinline__ void stage_conv_tile(bf16_t* dst, int ld, const bf16_t* Pb, int t0, int col0, const float* cw, int CS, const float* cb, int tid) {
    constexpr int CG = NC / 8;
    const int lo = t0 < 256 ? 0 : 256, hi = t0 < 256 ? 256 : TPB;
    for (int idx = tid; idx < 128 * CG; idx += 512) {
        int cgi, tl;
        if (TRANS) { tl = idx & 127; cgi = idx >> 7; } else { cgi = idx % CG; tl = idx / CG; }
        const int t = t0 + tl;
        const f32x4 b0 = *(const f32x4*)(cb + cgi * 8), b1 = *(const f32x4*)(cb + cgi * 8 + 4);
        f32x8 acc; acc[0] = b0.x; acc[1] = b0.y; acc[2] = b0.z; acc[3] = b0.w; acc[4] = b1.x; acc[5] = b1.y; acc[6] = b1.z; acc[7] = b1.w;
#pragma unroll
        for (int k = 0; k < 4; ++k) {
            const int tt = t - 2 + k;
            if (tt >= lo && tt < hi) {
                const f32x8 v = unpack8(*(const u32x4*)(Pb + (size_t)tt * LDP + col0 + cgi * 8));
                const f32x4 w0 = *(const f32x4*)(cw + k * CS + cgi * 8), w1 = *(const f32x4*)(cw + k * CS + cgi * 8 + 4);
                acc[0] += w0.x * v[0]; acc[1] += w0.y * v[1]; acc[2] += w0.z * v[2]; acc[3] += w0.w * v[3];
                acc[4] += w1.x * v[4]; acc[5] += w1.y * v[5]; acc[6] += w1.z * v[6]; acc[7] += w1.w * v[7];
            }
        }
        if (SILU) {
#pragma unroll
            for (int e = 0; e < 8; ++e) acc[e] = siluf(acc[e]);
        }
        if (TRANS) {
#pragma unroll
            for (int e = 0; e < 8; ++e) dst[(cgi * 8 + e) * ld + tl] = f2bf(acc[e]);
        } else {
            *(u32x4*)(dst + tl * ld + cgi * 8) = pack8(acc);
        }
    }
}

__device__ __forceinline__ void transpose_item(const float* W, int K, int N, int nblk, bf16_t* WT, float* scr, int item, int lane) {
    const int kb = item / nblk, nb = item % nblk, k0 = 64 * kb, n0 = 32 * nb;
    const int n = n0 + (lane & 31);
#pragma unroll 8
    for (int i = 0; i < 32; ++i) { const int kk = 2 * i + (lane >> 5); scr[kk * 33 + (lane & 31)] = (n < N) ? W[(size_t)(k0 + kk) * N + n] : 0.f; }
    asm volatile("s_waitcnt lgkmcnt(0)" ::: "memory");
    const int c = lane & 7;
#pragma unroll
    for (int j = 0; j < 4; ++j) {
        const int nn = (lane >> 3) + 8 * j; const float* s = scr + (8 * c) * 33 + nn;
        u32x4 o; o.x = cvt_pk_bf16(s[0 * 33], s[1 * 33]); o.y = cvt_pk_bf16(s[2 * 33], s[3 * 33]); o.z = cvt_pk_bf16(s[4 * 33], s[5 * 33]); o.w = cvt_pk_bf16(s[6 * 33], s[7 * 33]);
        *(u32x4*)(WT + (size_t)(n0 + nn) * K + k0 + 8 * c) = o;
    }
    asm volatile("s_waitcnt lgkmcnt(0)" ::: "memory");
}

__device__ __forceinline__ void phase0(const Params& p, unsigned char* shm, int G) {
    const int tid = tidx(), lane = tid & 63, wave = tid >> 6;
    float* sf = (float*)shm;
    float* MOD = WS_MOD(p);
    for (int item = blockIdx.x; item < 96; item += G) {
        const int l = item / 24, cgp = item % 24;
        __syncthreads();
        for (int idx = tid; idx < 9 * 2048; idx += 512) { const int r = idx >> 11, k = idx & 2047; const float v = r < 8 ? p.c[r * 2048 + k] : p.c_ctx[k]; sf[idx] = siluf(v); }
        __syncthreads();
        f32x4 acc[9];
#pragma unroll
        for (int r = 0; r < 9; ++r) acc[r] = (f32x4){0.f, 0.f, 0.f, 0.f};
        const float* wp = p.ada_w + ((size_t)l * 2048 + wave * 256) * 6144 + cgp * 256 + lane * 4;
#pragma unroll 4
        for (int kk = 0; kk < 256; ++kk) {
            const f32x4 wv = *(const f32x4*)(wp + (size_t)kk * 6144);
            const int k = wave * 256 + kk;
#pragma unroll
            for (int r = 0; r < 9; ++r) { const float s = sf[r * 2048 + k]; acc[r] += wv * s; }
        }
        __syncthreads();
#pragma unroll
        for (int r = 0; r < 9; ++r) *(f32x4*)(sf + (wave * 9 + r) * 256 + lane * 4) = acc[r];
        __syncthreads();
        for (int idx = tid; idx < 9 * 256; idx += 512) {
            const int r = idx >> 8, col = idx & 255; float s = p.ada_b[l * 6144 + cgp * 256 + col];
#pragma unroll
            for (int w = 0; w < 8; ++w) s += sf[(w * 9 + r) * 256 + col];
            MOD[(size_t)(l * 9 + r) * 6144 + cgp * 256 + col] = s;
        }
    }
    __syncthreads();
    float* scr = sf + wave * (64 * 33);
    const int gw = blockIdx.x * 8 + wave, NGW = G * 8;
    constexpr int I_IN = 32 * 232, I_OUT = 48 * 64;
    for (int it = gw; it < 4 * (I_IN + I_OUT); it += NGW) {
        if (it < 4 * I_IN) { const int l = it / I_IN, r = it % I_IN; transpose_item(p.w_in + (size_t)l * 2048 * 7184, 2048, 7184, 232, WS_WTIN(p) + (size_t)l * 7424 * 2048, scr, r, lane); }
        else { const int it2 = it - 4 * I_IN, l = it2 / I_OUT, r = it2 % I_OUT; transpose_item(p.w_out + (size_t)l * 3072 * 2048, 3072, 2048, 64, WS_WTOUT(p) + (size_t)l * 2048 * 3072, scr, r, lane); }
    }
}

__device__ __forceinline__ const float* xrow_src(const Params& p, int l, int row) {
    const int b = row / TPB, t = row % TPB;
    if (l == 0) return t < 256 ? p.ctx + ((size_t)b * 256 + t) * DM : p.x + ((size_t)b * 2048 + (t - 256)) * DM;
    return WS_XB(p) + (size_t)row * DM;
}
__device__ __forceinline__ void norm_phase(const Params& p, int l, int G) {
    const int lane = tidx() & 63, wave = tidx() >> 6;
    bf16_t* U = WS_U(p);
    for (int row = blockIdx.x * 8 + wave; row < NTOK; row += G * 8) {
        const int b = row / TPB, t = row % TPB;
        const float* src = xrow_src(p, l, row);
        const float* md = WS_MOD(p) + (size_t)(l * 9 + (t < 256 ? 8 : b)) * 6144;
        f32x4 v[8]; float ss = 0.f;
#pragma unroll
        for (int j = 0; j < 8; ++j) { v[j] = *(const f32x4*)(src + 4 * lane + 256 * j); ss += v[j].x * v[j].x + v[j].y * v[j].y + v[j].z * v[j].z + v[j].w * v[j].w; }
        ss = wave_sum(ss);
        const float rstd = rsqrtf(ss * (1.f / 2048.f) + 1e-6f);
#pragma unroll
        for (int j = 0; j < 8; ++j) {
            const int col = 4 * lane + 256 * j;
            const f32x4 nw = *(const f32x4*)(p.norm_w + l * 2048 + col), sh = *(const f32x4*)(md + col), sc = *(const f32x4*)(md + 2048 + col);
            const f32x4 y = v[j] * rstd * nw * (sc + 1.f) + sh;
            u32x2 w; w.x = cvt_pk_bf16(y.x, y.y); w.y = cvt_pk_bf16(y.z, y.w);
            *(u32x2*)(U + (size_t)row * DM + col) = w;
        }
    }
}

struct EpiG1 {
    static constexpr bool PERM = false, AFTER_DRAIN = false;
    bf16_t* P;
    __device__ __forceinline__ void operator()(const f32x4 (&acc)[2][2][4][2], const pg8::Unit& u, int wr, int wc, int fr, int fq) const {
        const int row0 = u.pm * 256 + wr * 64 + fr, col0 = u.pn * 256 + wc * 32 + 4 * fq;
#pragma unroll
        for (int ai = 0; ai < 2; ++ai)
#pragma unroll
            for (int m = 0; m < 4; ++m) { bf16_t* rowp = P + (size_t)(row0 + ai * 128 + m * 16) * LDP + col0;
#pragma unroll
                for (int bj = 0; bj < 2; ++bj)
#pragma unroll
                    for (int n = 0; n < 2; ++n) { const f32x4 v = acc[ai][bj][m][n]; u32x2 w; w.x = cvt_pk_bf16(v.x, v.y); w.y = cvt_pk_bf16(v.z, v.w); *(u32x2*)(rowp + bj * 128 + n * 16) = w; } }
    }
};
struct EpiG2 {
    static constexpr bool PERM = false, AFTER_DRAIN = false;
    Params p; int l;
    __device__ __forceinline__ void operator()(const f32x4 (&acc)[2][2][4][2], const pg8::Unit& u, int wr, int wc, int fr, int fq) const {
        const int row0 = u.pm * 256 + wr * 64 + fr, col0 = u.pn * 256 + wc * 32 + 4 * fq;
#pragma unroll
        for (int ai = 0; ai < 2; ++ai)
#pragma unroll
            for (int m = 0; m < 4; ++m) {
                const int row = row0 + ai * 128 + m * 16, b = row / TPB, t = row % TPB;
                if (l == 3 && t < 256) continue;
                const float* xo = xrow_src(p, l, row);
                float* dst = (l == 3) ? p.out + ((size_t)b * 2048 + (t - 256)) * DM : WS_XB(p) + (size_t)row * DM;
                const float* gt = WS_MOD(p) + (size_t)(l * 9 + (t < 256 ? 8 : b)) * 6144 + 4096;
#pragma unroll
                for (int bj = 0; bj < 2; ++bj)
#pragma unroll
                    for (int n = 0; n < 2; ++n) { const int col = col0 + bj * 128 + n * 16; const f32x4 xv = *(const f32x4*)(xo + col), g = *(const f32x4*)(gt + col); *(f32x4*)(dst + col) = xv + g * acc[ai][bj][m][n]; }
            }
    }
};

__device__ __forceinline__ void qkprep_row(const Params& p, int l, int row, int lane) {
    const int t = row % TPB;
    bf16_t* rp = WS_P(p) + (size_t)row * LDP;
    float cs = 1.f, sn = 0.f;
    if (t >= 256) {
        const int s = t - 256, rr = s >> 6, cc = s & 63, f = lane & 31;
        const float inv = exp2f(-(float)f * (13.287712379549449f / 32.f));
        const float ang = (float)(lane < 32 ? rr : cc) * inv;
        cs = __cosf(ang); sn = __sinf(ang);
    }
#pragma unroll
    for (int slot = 0; slot < 10; ++slot) {
        const int col = slot < 8 ? C_Q + slot * 128 : C_K + (slot - 8) * 128;
        const float* w = slot < 8 ? p.att_q_norm + l * 128 : p.att_k_norm + l * 128;
        const float v1 = bf2f(rp[col + lane]), v2 = bf2f(rp[col + 64 + lane]);
        const float ss = wave_sum(v1 * v1 + v2 * v2);
        const float rstd = rsqrtf(ss * (1.f / 128.f) + 1e-6f);
        const float y1 = v1 * rstd * w[lane], y2 = v2 * rstd * w[64 + lane];
        float o1 = y1 * cs - y2 * sn, o2 = y1 * sn + y2 * cs;
        if (slot < 8) { o1 *= 0.08838834764831845f; o2 *= 0.08838834764831845f; }
        rp[col + lane] = f2bf(o1); rp[col + 64 + lane] = f2bf(o2);
    }
}

template <bool FINAL, int D>
__device__ __forceinline__ void lru_dir(const Params& p, int l, int b, int c, int j, unsigned char* shm, float (&hacc)[16]) {
    const int tid = tidx(), lane = tid & 63, wave = tid >> 6, ch = tid & 63, seg = tid >> 6;
    bf16_t* sX = (bf16_t*)shm; bf16_t* sWa = (bf16_t*)(shm + 18432); bf16_t* sWx = (bf16_t*)(shm + 27648);
    float* sA = (float*)(shm + 36864); float* sB = (float*)(shm + 69632); float* sSA = (float*)(shm + 102400); float* sSB = (float*)(shm + 104448);
    const float* ga = p.lru_ga_w + (size_t)((l * 2 + D) * 16 + j) * 4096; const float* gx = p.lru_gx_w + (size_t)((l * 2 + D) * 16 + j) * 4096;
    for (int idx = tid; idx < 4096; idx += 512) { const int i = idx >> 6, o = idx & 63; sWa[o * 72 + i] = f2bf(ga[idx]); sWx[o * 72 + i] = f2bf(gx[idx]); }
    __syncthreads();
    {
        const int mi = wave & 3, nj = wave >> 2;
        f32x16 aa, ax;
#pragma unroll
        for (int r = 0; r < 16; ++r) { aa[r] = 0.f; ax[r] = 0.f; }
        mm32<64>(aa, sX + mi * 32 * 72, 72, sWa + nj * 32 * 72, 72, lane);
        mm32<64>(ax, sX + mi * 32 * 72, 72, sWx + nj * 32 * 72, 72, lane);
        const int cl = nj * 32 + (lane & 31), cgl = j * 64 + cl;
        const float ba = p.lru_ga_b[(l * 2 + D) * 1024 + cgl], bx = p.lru_gx_b[(l * 2 + D) * 1024 + cgl], sp = softplusf(-p.lru_lambda[(l * 2 + D) * 1024 + cgl]);
#pragma unroll
        for (int r = 0; r < 16; ++r) {
            const int tl = mi * 32 + rowmap32(r, lane);
            const float rg = sigmf(aa[r] + ba), ig = sigmf(ax[r] + bx);
            const float la = -8.f * rg * sp;
            const float a = __expf(la), mult = sqrtf(fmaxf(1.f - __expf(2.f * la), 0.f));
            const float xv = bf2f(sX[tl * 72 + cl]);
            sA[tl * 64 + cl] = a; sB[tl * 64 + cl] = mult * ig * xv;
        }
    }
    __syncthreads();
    {
        float A = 1.f, Bc = 0.f;
#pragma unroll
        for (int q = 0; q < 16; ++q) { const int tl = seg * 16 + (D == 0 ? q : 15 - q); const float a = sA[tl * 64 + ch], bb = sB[tl * 64 + ch]; A = a * A; Bc = a * Bc + bb; }
        sSA[seg * 64 + ch] = A; sSB[seg * 64 + ch] = Bc;
    }
    __syncthreads();
    if (!FINAL) {
        if (tid < 64) {
            float At = 1.f, Bt = 0.f;
#pragma unroll
            for (int s = 0; s < 8; ++s) { const int sg = D == 0 ? s : 7 - s; const float a = sSA[sg * 64 + ch], bb = sSB[sg * 64 + ch]; At = a * At; Bt = a * Bt + bb; }
            const size_t idx = (size_t)((b * 2 + D) * 18 + c) * 1024 + j * 64 + ch;
            WS_SUMA(p)[idx] = At; WS_SUMB(p)[idx] = Bt;
        }
    } else {
        float h = 0.f;
        const int pos = pos_of(D, c);
        for (int q = 0; q < pos; ++q) { const int cc = chunk_at(D, q); const size_t idx = (size_t)((b * 2 + D) * 18 + cc) * 1024 + j * 64 + ch; h = WS_SUMA(p)[idx] * h + WS_SUMB(p)[idx]; }
        const int nseg = D == 0 ? seg : 7 - seg;
        for (int s = 0; s < nseg; ++s) { const int sg = D == 0 ? s : 7 - s; h = sSA[sg * 64 + ch] * h + sSB[sg * 64 + ch]; }
#pragma unroll
        for (int q = 0; q < 16; ++q) { const int qq = D == 0 ? q : 15 - q; const int tl = seg * 16 + qq; h = sA[tl * 64 + ch] * h + sB[tl * 64 + ch]; hacc[qq] += h; }
    }
}
template <bool FINAL>
__device__ __forceinline__ void lru_item(const Params& p, int l, int item, unsigned char* shm) {
    const int tid = tidx(), ch = tid & 63, seg = tid >> 6;
    const int j = item & 15, bc = item >> 4, c = bc % NCH, b = bc / NCH, t0 = c * 128;
    const bf16_t* Pb = WS_P(p) + (size_t)b * TPB * LDP;
    __syncthreads();
    stage_conv_tile<64, false, false>((bf16_t*)shm, 72, Pb, t0, C_LX + j * 64, p.lru_conv_w + l * 4 * 1024 + j * 64, 1024, p.lru_conv_b + l * 1024 + j * 64, tid);
    float hacc[16];
#pragma unroll
    for (int q = 0; q < 16; ++q) hacc[q] = 0.f;
    lru_dir<FINAL, 0>(p, l, b, c, j, shm, hacc);
    lru_dir<FINAL, 1>(p, l, b, c, j, shm, hacc);
    if (FINAL) {
#pragma unroll
        for (int q = 0; q < 16; ++q) {
            const size_t tok = (size_t)b * TPB + t0 + seg * 16 + q;
            const float lg = bf2f(WS_P(p)[tok * LDP + C_LG + j * 64 + ch]);
            WS_MIX(p)[tok * MIXW + j * 64 + ch] = f2bf(hacc[q] * siluf(lg));
        }
    }
}

__device__ __forceinline__ void prep_elem(const Params& p, int l, int G) {
    const int gt = (int)blockIdx.x * 512 + tidx(), NT = G * 512;
    for (int idx = gt; idx < NTOK * 192; idx += NT) {
        const int tok = idx / 192, cgi = idx % 192, b = tok / TPB, t = tok % TPB;
        const int lo = t < 256 ? 0 : 256, hi = t < 256 ? 256 : TPB;
        int col, CS; const float *cw, *cb; bf16_t* dst; bool act;
        if (cgi < 128) { col = C_LX + cgi * 8; cw = p.lru_conv_w + l * 4096 + cgi * 8; CS = 1024; cb = p.lru_conv_b + l * 1024 + cgi * 8; act = false; dst = WS_LXC(p) + (size_t)tok * 1024 + cgi * 8; }
        else { const int c2 = (cgi - 128) * 8; col = C_XBC + 1024 + c2; cw = p.ssd_conv_w + l * 6144 + 1024 + c2; CS = 1536; cb = p.ssd_conv_b + l * 1536 + 1024 + c2; act = true; dst = WS_SBC(p) + (size_t)tok * 512 + c2; }
        const bf16_t* src = WS_P(p) + (size_t)b * TPB * LDP + col;
        u32x4 raw[4];
#pragma unroll
        for (int k = 0; k < 4; ++k) { const int tt = t - 2 + k; raw[k] = (tt >= lo && tt < hi) ? *(const u32x4*)(src + (size_t)tt * LDP) : (u32x4){0u, 0u, 0u, 0u}; }
        const f32x4 b0 = *(const f32x4*)cb, b1 = *(const f32x4*)(cb + 4);
        f32x8 acc; acc[0] = b0.x; acc[1] = b0.y; acc[2] = b0.z; acc[3] = b0.w; acc[4] = b1.x; acc[5] = b1.y; acc[6] = b1.z; acc[7] = b1.w;
#pragma unroll
        for (int k = 0; k < 4; ++k) {
            const f32x8 v = unpack8(raw[k]);
            const f32x4 w0 = *(const f32x4*)(cw + k * CS), w1 = *(const f32x4*)(cw + k * CS + 4);
            acc[0] += w0.x * v[0]; acc[1] += w0.y * v[1]; acc[2] += w0.z * v[2]; acc[3] += w0.w * v[3];
            acc[4] += w1.x * v[4]; acc[5] += w1.y * v[5]; acc[6] += w1.z * v[6]; acc[7] += w1.w * v[7];
        }
        if (act) {
#pragma unroll
            for (int e = 0; e < 8; ++e) acc[e] = siluf(acc[e]);
        }
        *(u32x4*)dst = pack8(acc);
    }
}
__device__ __forceinline__ void prep_tile_item(const Params& p, int l, int item, unsigned char* shm) {
    const int tid = tidx();
    const int t20 = item % 20, bc = item / 20, c = bc % NCH, b = bc / NCH, t0 = c * 128;
    const bf16_t* Pb = WS_P(p) + (size_t)b * TPB * LDP;
    bf16_t* sT = (bf16_t*)shm;
    int ch0; bf16_t* dst;
    if (t20 < 16) { ch0 = t20 * 64; dst = WS_SXT(p) + ((size_t)((b * 18 + c) * 16 + t20)) * 8192; }
    else { const int q = t20 - 16, g = q >> 1, nh = q & 1; ch0 = 1024 + g * 128 + nh * 64; dst = WS_SBT(p) + ((size_t)((b * 18 + c) * 2 + g)) * 16384 + (size_t)nh * 64 * 128; }
    __syncthreads();
    stage_conv_tile<64, true, true>(sT, 136, Pb, t0, C_XBC + ch0, p.ssd_conv_w + l * 6144 + ch0, 1536, p.ssd_conv_b + l * 1536 + ch0, tid);
    __syncthreads();
#pragma unroll
    for (int k = 0; k < 2; ++k) { const int idx = tid + k * 512, r = idx >> 4, ck = idx & 15; *(u32x4*)(dst + r * 128 + ck * 8) = *(const u32x4*)(sT + r * 136 + ck * 8); }
}
__device__ __forceinline__ void prep_dt_item(const Params& p, int l, int item) {
    const int tid = tidx();
    const int c = item % NCH, b = item / NCH;
    const int col32 = tid >> 4, h = col32 >> 1, d = col32 & 1, lane16 = tid & 15, seg = d == 0 ? lane16 : 15 - lane16;
    const float A = -__expf(p.ssd_A_log[(l * 2 + d) * 16 + h]), bias = p.ssd_dt_bias[(l * 2 + d) * 16 + h];
    const bf16_t* src = WS_P(p) + ((size_t)b * TPB + c * 128) * LDP + C_DT + h;
    float dtv[8], cs[8], run = 0.f;
    bf16_t rawv[8];
#pragma unroll
    for (int q = 0; q < 8; ++q) { const int j = seg * 8 + (d == 0 ? q : 7 - q); rawv[q] = src[(size_t)j * LDP]; }
#pragma unroll
    for (int q = 0; q < 8; ++q) { dtv[q] = softplusf(bf2f(rawv[q]) + bias); run += dtv[q] * A; cs[q] = run; }
    float incl = run;
#pragma unroll
    for (int off = 1; off < 16; off <<= 1) { const float v = __shfl_up(incl, off, 16); if (lane16 >= off) incl += v; }
    const float excl = incl - run;
    float* dta = WS_DTA(p) + ((size_t)(b * 18 + c) * 128) * 32 + col32;
    float* acs = WS_ACS(p) + ((size_t)(b * 18 + c) * 128) * 32 + col32;
#pragma unroll
    for (int q = 0; q < 8; ++q) { const int j = seg * 8 + (d == 0 ? q : 7 - q); dta[j * 32] = dtv[q]; acs[j * 32] = cs[q] + excl; }
    if (lane16 == 15) WS_AL(p)[((b * 2 + d) * 18 + c) * 16 + h] = incl;
}
__device__ __forceinline__ void ssd_states_item(const Params& p, int l, int item, unsigned char* shm) {
    const int tid = tidx(), lane = tid & 63, wave = tid >> 6;
    const int g = item & 1, bc = item >> 1, c = bc % NCH, b = bc / NCH;
    bf16_t* sBT = (bf16_t*)shm; bf16_t* sXw = (bf16_t*)(shm + 34816);
    float* sDt = (float*)(shm + 69632); float* sAcs = (float*)(shm + 77824); bf16_t* sO = (bf16_t*)(shm + 86016);
    const bf16_t* xt = WS_SXT(p) + ((size_t)((b * 18 + c) * 16 + g * 8)) * 8192;
    const bf16_t* btp = WS_SBT(p) + ((size_t)((b * 18 + c) * 2 + g)) * 16384;
    __syncthreads();
    {
        const size_t o = ((size_t)(b * 18 + c) * 128 + (tid >> 2)) * 32 + g * 16 + (tid & 3) * 4;
        const f32x4 vdt = *(const f32x4*)(WS_DTA(p) + o), vac = *(const f32x4*)(WS_ACS(p) + o);
        u32x4 bt[4];
#pragma unroll
        for (int k = 0; k < 4; ++k) { const int idx = tid + k * 512; bt[k] = *(const u32x4*)(btp + (idx >> 4) * 128 + (idx & 15) * 8); }
        *(f32x4*)(sDt + (tid >> 2) * 16 + (tid & 3) * 4) = vdt; *(f32x4*)(sAcs + (tid >> 2) * 16 + (tid & 3) * 4) = vac;
#pragma unroll
        for (int k = 0; k < 4; ++k) { const int idx = tid + k * 512; *(u32x4*)(sBT + (idx >> 4) * 136 + (idx & 15) * 8) = bt[k]; }
    }
    u32x4 xr[2];
#pragma unroll
    for (int k = 0; k < 2; ++k) { const int idx = tid + k * 512; xr[k] = *(const u32x4*)(xt + (idx >> 4) * 128 + (idx & 15) * 8); }
#pragma unroll 1
    for (int hh = 0; hh < 8; ++hh) {
        const int h = g * 8 + hh;
        u32x4 xn[2] = {xr[0], xr[1]};
        if (hh < 7) {
#pragma unroll
            for (int k = 0; k < 2; ++k) { const int idx = tid + k * 512; xn[k] = *(const u32x4*)(xt + (size_t)(hh + 1) * 8192 + (idx >> 4) * 128 + (idx & 15) * 8); }
        }
        __syncthreads();
#pragma unroll
        for (int k = 0; k < 2; ++k) {
            const int idx = tid + k * 512, pp = idx >> 4, j8 = (idx & 15) * 8;
            const f32x8 xv = unpack8(xr[k]);
#pragma unroll
            for (int d = 0; d < 2; ++d) {
                const int col = hh * 2 + d; const float al = d == 0 ? sAcs[127 * 16 + col] : sAcs[col];
                f32x8 o;
#pragma unroll
                for (int e = 0; e < 8; ++e) o[e] = xv[e] * __expf(al - sAcs[(j8 + e) * 16 + col]) * sDt[(j8 + e) * 16 + col];
                *(u32x4*)(sXw + d * 8704 + pp * 136 + j8) = pack8(o);
            }
        }
        __syncthreads();
        const int mi = wave & 1, nj = wave >> 1;
#pragma unroll
        for (int d = 0; d < 2; ++d) {
            f32x16 acc;
#pragma unroll
            for (int r = 0; r < 16; ++r) acc[r] = 0.f;
            mm32<128>(acc, sXw + d * 8704 + mi * 32 * 136, 136, sBT + nj * 32 * 136, 136, lane);
#pragma unroll
            for (int r = 0; r < 16; ++r) sO[d * 8704 + (mi * 32 + rowmap32(r, lane)) * 136 + nj * 32 + (lane & 31)] = f2bf(acc[r]);
        }
        __syncthreads();
#pragma unroll
        for (int d = 0; d < 2; ++d) {
            bf16_t* base = WS_ST(p) + ((size_t)((b * 2 + d) * 18 + c) * 16 + h) * 8192;
#pragma unroll
            for (int k = 0; k < 2; ++k) { const int idx = tid + k * 512; *(u32x4*)(base + idx * 8) = *(const u32x4*)(sO + d * 8704 + (idx >> 4) * 136 + (idx & 15) * 8); }
        }
        xr[0] = xn[0]; xr[1] = xn[1];
    }
}
__device__ __forceinline__ void ssd_recur_item(const Params& p, int item) {
    const int tid = tidx();
    const int d = item & 1, h = (item >> 1) & 15, b = item >> 5;
    f32x8 h0, h1;
#pragma unroll
    for (int e = 0; e < 8; ++e) { h0[e] = 0.f; h1[e] = 0.f; }
    for (int pos = 0; pos < NCH; ++pos) {
        const int c = chunk_at(d, pos);
        bf16_t* ptr = WS_ST(p) + ((size_t)((b * 2 + d) * 18 + c) * 16 + h) * 8192 + tid * 16;
        const f32x8 s0 = unpack8(*(const u32x4*)ptr), s1 = unpack8(*(const u32x4*)(ptr + 8));
        const float e = __expf(WS_AL(p)[((b * 2 + d) * 18 + c) * 16 + h]);
        *(u32x4*)ptr = pack8(h0); *(u32x4*)(ptr + 8) = pack8(h1);
        h0 = h0 * e + s0; h1 = h1 * e + s1;
    }
}
__device__ __forceinline__ void ssd_final_item(const Params& p, int l, int item, unsigned char* shm) {
    const int tid = tidx(), lane = tid & 63, wave = tid >> 6;
    const int g = item & 1, bc = item >> 1, c = bc % NCH, b = bc / NCH, t0 = c * 128;
    const size_t tok0 = (size_t)b * TPB + t0;
    bf16_t* sC = (bf16_t*)shm; bf16_t* sBW = (bf16_t*)(shm + 34816); bf16_t* sXT = (bf16_t*)(shm + 69632); bf16_t* sH = (bf16_t*)(shm + 87040);
    float* sDt = (float*)(shm + 104448); float* sAcs = (float*)(shm + 112640);
    bf16_t* sY = sBW;
    const bf16_t* xt = WS_SXT(p) + ((size_t)((b * 18 + c) * 16 + g * 8)) * 8192;
    const bf16_t* zt = WS_P(p) + tok0 * LDP + C_Z + g * 512;
    const bf16_t* hin0 = WS_ST(p) + ((size_t)((b * 2 + 0) * 18 + c) * 16 + g * 8) * 8192;
    const bf16_t* hin1 = WS_ST(p) + ((size_t)((b * 2 + 1) * 18 + c) * 16 + g * 8) * 8192;
    __syncthreads();
    u32x4 xr[2], zr[2], h0r[2];
    {
        const size_t o = ((size_t)(b * 18 + c) * 128 + (tid >> 2)) * 32 + g * 16 + (tid & 3) * 4;
        const f32x4 vdt = *(const f32x4*)(WS_DTA(p) + o), vac = *(const f32x4*)(WS_ACS(p) + o);
        u32x4 cr[4], br[4];
#pragma unroll
        for (int k = 0; k < 4; ++k) { const int idx = tid + k * 512; const bf16_t* s = WS_SBC(p) + (tok0 + (idx >> 4)) * 512 + g * 128 + (idx & 15) * 8; br[k] = *(const u32x4*)s; cr[k] = *(const u32x4*)(s + 256); }
#pragma unroll
        for (int k = 0; k < 2; ++k) {
            const int idx = tid + k * 512;
            xr[k] = *(const u32x4*)(xt + (idx >> 4) * 128 + (idx & 15) * 8);
            zr[k] = *(const u32x4*)(zt + (size_t)(idx >> 3) * LDP + (idx & 7) * 8);
            h0r[k] = *(const u32x4*)(hin0 + idx * 8);
        }
        *(f32x4*)(sDt + (tid >> 2) * 16 + (tid & 3) * 4) = vdt; *(f32x4*)(sAcs + (tid >> 2) * 16 + (tid & 3) * 4) = vac;
#pragma unroll
        for (int k = 0; k < 4; ++k) { const int idx = tid + k * 512; *(u32x4*)(sC + (idx >> 4) * 136 + (idx & 15) * 8) = cr[k]; *(u32x4*)(sBW + (idx >> 4) * 136 + (idx & 15) * 8) = br[k]; }
    }
    __syncthreads();
    const int cmi = wave >> 1, cnj0 = (wave & 1) * 2;
    f32x16 cb0, cb1;
#pragma unroll
    for (int r = 0; r < 16; ++r) { cb0[r] = 0.f; cb1[r] = 0.f; }
    mm32<128>(cb0, sC + cmi * 32 * 136, 136, sBW + cnj0 * 32 * 136, 136, lane);
    mm32<128>(cb1, sC + cmi * 32 * 136, 136, sBW + (cnj0 + 1) * 32 * 136, 136, lane);
    const int ymi = wave & 3, ynj = wave >> 2;
#pragma unroll 1
    for (int hh = 0; hh < 8; ++hh) {
        const int h = g * 8 + hh;
        __syncthreads();
#pragma unroll
        for (int k = 0; k < 2; ++k) { const int idx = tid + k * 512; *(u32x4*)(sXT + (idx >> 4) * 136 + (idx & 15) * 8) = xr[k]; *(u32x4*)(sH + (idx >> 4) * 136 + (idx & 15) * 8) = h0r[k]; }
        u32x4 h1r[2];
#pragma unroll
        for (int k = 0; k < 2; ++k) h1r[k] = *(const u32x4*)(hin1 + (size_t)hh * 8192 + (tid + k * 512) * 8);
        f32x16 yacc;
#pragma unroll
        for (int r = 0; r < 16; ++r) yacc[r] = 0.f;
#pragma unroll 1
        for (int d = 0; d < 2; ++d) {
            const int col = hh * 2 + d;
            if (d == 1) {
                __syncthreads();
#pragma unroll
                for (int k = 0; k < 2; ++k) { const int idx = tid + k * 512; *(u32x4*)(sH + (idx >> 4) * 136 + (idx & 15) * 8) = h1r[k]; }
            }
#pragma unroll
            for (int tt = 0; tt < 2; ++tt) {
                const int jg = (cnj0 + tt) * 32 + (lane & 31);
                const float acj = sAcs[jg * 16 + col], dtj = sDt[jg * 16 + col];
#pragma unroll
                for (int r = 0; r < 16; ++r) {
                    const int ig = cmi * 32 + rowmap32(r, lane);
                    const bool valid = d == 0 ? (jg <= ig) : (jg >= ig);
                    const float cbv = tt == 0 ? cb0[r] : cb1[r];
                    const float val = valid ? cbv * __expf(sAcs[ig * 16 + col] - acj) * dtj : 0.f;
                    sBW[ig * 136 + jg] = f2bf(val);
                }
            }
            __syncthreads();
            f32x16 ad, ao;
#pragma unroll
            for (int r = 0; r < 16; ++r) { ad[r] = 0.f; ao[r] = 0.f; }
            mm32<128>(ad, sBW + ymi * 32 * 136, 136, sXT + ynj * 32 * 136, 136, lane);
            mm32<128>(ao, sC + ymi * 32 * 136, 136, sH + ynj * 32 * 136, 136, lane);
#pragma unroll
            for (int r = 0; r < 16; ++r) { const int ig = ymi * 32 + rowmap32(r, lane); yacc[r] += ad[r] + __expf(sAcs[ig * 16 + col]) * ao[r]; }
            if (d == 0 && hh < 7) {
#pragma unroll
                for (int k = 0; k < 2; ++k) {
                    const int idx = tid + k * 512;
                    xr[k] = *(const u32x4*)(xt + (size_t)(hh + 1) * 8192 + (idx >> 4) * 128 + (idx & 15) * 8);
                    h0r[k] = *(const u32x4*)(hin0 + (size_t)(hh + 1) * 8192 + idx * 8);
                }
            }
        }
        const float Dh = p.ssd_D[l * 16 + h];
        const int pl = ynj * 32 + (lane & 31);
#pragma unroll
        for (int r = 0; r < 16; ++r) { const int ig = ymi * 32 + rowmap32(r, lane); yacc[r] += Dh * bf2f(sXT[pl * 136 + ig]); }
        __syncthreads();
#pragma unroll
        for (int r = 0; r < 16; ++r) { const int ig = ymi * 32 + rowmap32(r, lane); sY[ig * 72 + pl] = f2bf(yacc[r]); }
        __syncthreads();
#pragma unroll
        for (int k = 0; k < 2; ++k) {
            const int idx = tid + k * 512, rr = idx >> 3, pk = idx & 7;
            const f32x8 yv = unpack8(*(const u32x4*)(sY + rr * 72 + pk * 8)), zv = unpack8(zr[k]);
            f32x8 o;
#pragma unroll
            for (int e = 0; e < 8; ++e) o[e] = yv[e] * siluf(zv[e]);
            *(u32x4*)(WS_MIX(p) + (tok0 + rr) * MIXW + 2048 + h * 64 + pk * 8) = pack8(o);
        }
        if (hh < 7) {
#pragma unroll
            for (int k = 0; k < 2; ++k) { const int idx = tid + k * 512; zr[k] = *(const u32x4*)(zt + (size_t)(idx >> 3) * LDP + (hh + 1) * 64 + (idx & 7) * 8); }
        }
    }
}
__device__ __forceinline__ void ssd_norm_phase(const Params& p, int l, int G) {
    const int lane = tidx() & 63, wave = tidx() >> 6;
    for (int row = blockIdx.x * 8 + wave; row < NTOK; row += G * 8) {
        bf16_t* rp = WS_MIX(p) + (size_t)row * MIXW + 2048;
        f32x8 v0 = unpack8(*(const u32x4*)(rp + lane * 8)), v1 = unpack8(*(const u32x4*)(rp + 512 + lane * 8));
        float ss = 0.f;
#pragma unroll
        for (int e = 0; e < 8; ++e) ss += v0[e] * v0[e] + v1[e] * v1[e];
        ss = wave_sum(ss);
        const float rstd = rsqrtf(ss * (1.f / 1024.f) + 1e-6f);
        const float* nw = p.ssd_norm_w + l * 1024;
#pragma unroll
        for (int e = 0; e < 8; ++e) { v0[e] = v0[e] * rstd * nw[lane * 8 + e]; v1[e] = v1[e] * rstd * nw[512 + lane * 8 + e]; }
        *(u32x4*)(rp + lane * 8) = pack8(v0); *(u32x4*)(rp + 512 + lane * 8) = pack8(v1);
    }
}

__device__ __forceinline__ void attn_item(const Params& p, int l, int item, unsigned char* shm) {
    const int tid = tidx(), lane = tid & 63, wave = tid >> 6, fr = lane & 15, fq = lane >> 4;
    const int hq = item & 7, bq = item >> 3, qblk = bq % NCH, b = bq / NCH, kh = hq >> 2;
    const bf16_t* P = WS_P(p);
    bf16_t* sK = (bf16_t*)shm; bf16_t* sVT = (bf16_t*)(shm + 34816); bf16_t* sPw = (bf16_t*)(shm + 69632) + wave * (16 * 136);
    const size_t tokq0 = (size_t)b * TPB + qblk * 128;
    bf16x8 aq[4];
#pragma unroll
    for (int kk = 0; kk < 4; ++kk) aq[kk] = *(const bf16x8*)(P + (tokq0 + wave * 16 + fr) * LDP + C_Q + hq * 128 + kk * 32 + 8 * fq);
    float m[4], ls[4]; f32x4 O[8];
    const float sink = p.att_sink[l * 8 + hq];
#pragma unroll
    for (int r = 0; r < 4; ++r) { m[r] = sink; ls[r] = 1.f; }
#pragma unroll
    for (int nd = 0; nd < 8; ++nd) O[nd] = (f32x4){0.f, 0.f, 0.f, 0.f};
    const int nlat = qblk - 2;
    const int ntiles = qblk < 2 ? 2 : 5;
    for (int ti = 0; ti < ntiles; ++ti) {
        int t0; bool masked = false; int kb = 0;
        if (ti < 2) t0 = ti * 128;
        else { kb = nlat - 1 + (ti - 2); if (kb < 0 || kb >= 16) continue; t0 = 256 + kb * 128; masked = true; }
        __syncthreads();
        {
            const bf16_t* kbase = P + ((size_t)b * TPB + t0) * LDP + C_K + kh * 128;
            for (int idx = tid; idx < 2048; idx += 512) { const int key = idx >> 4, dg = idx & 15; *(u32x4*)(sK + key * 136 + dg * 8) = *(const u32x4*)(kbase + (size_t)key * LDP + dg * 8); }
            const bf16_t* vbase = P + ((size_t)b * TPB + t0) * LDP + C_V + kh * 128;
            for (int idx = tid; idx < 2048; idx += 512) {
                const int key = idx & 127, dg = idx >> 7;
                const u32x4 raw = *(const u32x4*)(vbase + (size_t)key * LDP + dg * 8);
                bf16_t* dp = sVT + (dg * 8) * 136 + key;
                dp[0 * 136] = (bf16_t)(raw.x & 0xffffu); dp[1 * 136] = (bf16_t)(raw.x >> 16); dp[2 * 136] = (bf16_t)(raw.y & 0xffffu); dp[3 * 136] = (bf16_t)(raw.y >> 16);
                dp[4 * 136] = (bf16_t)(raw.z & 0xffffu); dp[5 * 136] = (bf16_t)(raw.z >> 16); dp[6 * 136] = (bf16_t)(raw.w & 0xffffu); dp[7 * 136] = (bf16_t)(raw.w >> 16);
            }
        }
        __syncthreads();
        f32x4 s[8];
#pragma unroll
        for (int nt = 0; nt < 8; ++nt) {
            s[nt] = (f32x4){0.f, 0.f, 0.f, 0.f};
#pragma unroll
            for (int kk = 0; kk < 4; ++kk) { const bf16x8 bk = *(const bf16x8*)(sK + (nt * 16 + fr) * 136 + kk * 32 + 8 * fq); s[nt] = __builtin_amdgcn_mfma_f32_16x16x32_bf16(aq[kk], bk, s[nt], 0, 0, 0); }
        }
        if (masked) {
#pragma unroll
            for (int nt = 0; nt < 8; ++nt)
#pragma unroll
                for (int r = 0; r < 4; ++r) { const int rel = (nlat * 128 + wave * 16 + fq * 4 + r) - (kb * 128 + nt * 16 + fr); if (rel > 128 || rel < -128) s[nt][r] = -INFINITY; }
        }
        float alpha[4];
#pragma unroll
        for (int r = 0; r < 4; ++r) {
            float mx = s[0][r];
#pragma unroll
            for (int nt = 1; nt < 8; ++nt) mx = fmaxf(mx, s[nt][r]);
            mx = fmaxf(mx, __shfl_xor(mx, 1)); mx = fmaxf(mx, __shfl_xor(mx, 2)); mx = fmaxf(mx, __shfl_xor(mx, 4)); mx = fmaxf(mx, __shfl_xor(mx, 8));
            const float mn = fmaxf(m[r], mx);
            alpha[r] = __expf(m[r] - mn); m[r] = mn;
            float rs = 0.f;
#pragma unroll
            for (int nt = 0; nt < 8; ++nt) { const float pv = __expf(s[nt][r] - mn); s[nt][r] = pv; rs += pv; }
            rs += __shfl_xor(rs, 1); rs += __shfl_xor(rs, 2); rs += __shfl_xor(rs, 4); rs += __shfl_xor(rs, 8);
            ls[r] = ls[r] * alpha[r] + rs;
        }
#pragma unroll
        for (int nd = 0; nd < 8; ++nd) { O[nd].x *= alpha[0]; O[nd].y *= alpha[1]; O[nd].z *= alpha[2]; O[nd].w *= alpha[3]; }
#pragma unroll
        for (int nt = 0; nt < 8; ++nt)
#pragma unroll
            for (int r = 0; r < 4; ++r) sPw[(fq * 4 + r) * 136 + nt * 16 + fr] = f2bf(s[nt][r]);
        asm volatile("s_waitcnt lgkmcnt(0)" ::: "memory");
#pragma unroll
        for (int kk = 0; kk < 4; ++kk) {
            const bf16x8 ap = *(const bf16x8*)(sPw + fr * 136 + kk * 32 + 8 * fq);
#pragma unroll
            for (int nd = 0; nd < 8; ++nd) { const bf16x8 bv = *(const bf16x8*)(sVT + (nd * 16 + fr) * 136 + kk * 32 + 8 * fq); O[nd] = __builtin_amdgcn_mfma_f32_16x16x32_bf16(ap, bv, O[nd], 0, 0, 0); }
        }
    }
#pragma unroll
    for (int r = 0; r < 4; ++r) {
        const size_t tok = tokq0 + wave * 16 + fq * 4 + r;
        const float il = 1.f / ls[r];
#pragma unroll
        for (int nd = 0; nd < 8; ++nd) {
            const int dcol = hq * 128 + nd * 16 + fr;
            const float ag = bf2f(P[tok * LDP + C_AG + dcol]);
            WS_MIX(p)[tok * MIXW + 1024 + dcol] = f2bf(O[nd][r] * il * siluf(ag));
        }
    }
}


#define XB_TMO      128
#define XB_XCNT(j)  (256  + 64 * (j))
#define XB_XSUB(j)  (1280 + 64 * (j))
#define XB_XGEN(j)  (2304 + 64 * (j))
#define XB_TOP      3328
#define XB_TOPGEN   3392
#define XCD_BAR_WORDS 3456
#define XB_SPIN_CAP (1u << 18)
#define LAS __attribute__((address_space(3)))
__device__ __forceinline__ unsigned xb_ld(unsigned* p)              { return __hip_atomic_load(p, __ATOMIC_RELAXED, __HIP_MEMORY_SCOPE_AGENT); }
__device__ __forceinline__ unsigned xb_add(unsigned* p, unsigned v) { return __hip_atomic_fetch_add(p, v, __ATOMIC_RELAXED, __HIP_MEMORY_SCOPE_AGENT); }
__device__ __forceinline__ unsigned xb_xcc_id() { return (unsigned)__builtin_amdgcn_s_getreg((3 << 11) | 20) & 0xFu; }
#define XB_SPIN(cond, bar) do { unsigned _sp = 0; while (cond) { __builtin_amdgcn_s_sleep(1); \
    if ((++_sp & 255u) == 0u) { if (xb_ld(&(bar)[XB_TMO])) break; if (_sp > XB_SPIN_CAP) { atomicAdd(&(bar)[XB_TMO], 1u); break; } } } } while (0)
struct XcdBarrier { unsigned* bar; unsigned x; volatile LAS unsigned* st; };
__device__ __forceinline__ XcdBarrier xcd_barrier_post(unsigned* bar, volatile LAS unsigned* st) {
    XcdBarrier b; b.bar = bar; b.x = xb_xcc_id(); b.st = st;
    if (threadIdx.x == 0) (void)xb_add(&bar[XB_XCNT(b.x)], 1u);
    return b;
}
__device__ __forceinline__ void xcd_barrier_complete(unsigned* bar, unsigned x, unsigned& nloc, unsigned& nx) {
    const unsigned G = gridDim.x * gridDim.y * gridDim.z;
    unsigned sum, cnt, mine, sp = 0u;
    for (;;) {
        sum = 0u; cnt = 0u; mine = 0u;
#pragma unroll
        for (unsigned j = 0; j < 16; ++j) { const unsigned c = xb_ld(&bar[XB_XCNT(j)]); sum += c; cnt += (c > 0u) ? 1u : 0u; mine = (j == x) ? c : mine; }
        if (sum == G) break;
        __builtin_amdgcn_s_sleep(1);
        if ((++sp & 255u) == 0u) { if (xb_ld(&bar[XB_TMO])) break; if (sp > XB_SPIN_CAP) { atomicAdd(&bar[XB_TMO], 1u); break; } }
    }
    nloc = mine > 0u ? mine : 1u; nx = cnt > 0u ? cnt : 1u;
}
__device__ __forceinline__ void xcd_barrier(const XcdBarrier& b) {
    asm volatile("s_waitcnt vmcnt(0)" ::: "memory");
    __syncthreads();
    if (threadIdx.x == 0) {
        unsigned* bar = b.bar;
        __builtin_amdgcn_s_waitcnt(0);
        unsigned nloc = b.st[0], nx = b.st[1];
        if (nloc == 0u) { xcd_barrier_complete(bar, b.x, nloc, nx); b.st[0] = nloc; b.st[1] = nx; }
        const unsigned old = xb_add(&bar[XB_XSUB(b.x)], 1u);
        const unsigned gen = old / nloc;
        if (old + 1u == (gen + 1u) * nloc) {
            __builtin_amdgcn_fence(__ATOMIC_RELEASE, "agent");
            asm volatile("s_waitcnt vmcnt(0)" ::: "memory");
            const unsigned og = xb_add(&bar[XB_TOP], 1u);
            const unsigned tg = og / nx;
            if (og + 1u == (tg + 1u) * nx) xb_add(&bar[XB_TOPGEN], 1u);
            else XB_SPIN(xb_ld(&bar[XB_TOPGEN]) == tg, bar);
            __builtin_amdgcn_fence(__ATOMIC_ACQUIRE, "agent");
            xb_add(&bar[XB_XGEN(b.x)], 1u);
            asm volatile("s_waitcnt vmcnt(0)" ::: "memory");
        } else {
            XB_SPIN(xb_ld(&bar[XB_XGEN(b.x)]) == gen, bar);
            __builtin_amdgcn_fence(__ATOMIC_ACQUIRE, "agent");
            asm volatile("s_waitcnt vmcnt(0)" ::: "memory");
        }
    }
    __syncthreads();
}


#define QUEUE_LOOP(ctr, NITEMS, BODY) do { \
    volatile LAS unsigned* _mb = (volatile LAS unsigned*)(shm + 131072 + 8); \
    int it = bid; \
    while (it < (NITEMS)) { \
        unsigned _nx = 0u; if (threadIdx.x == 0) _nx = xb_add((ctr), 1u) + (unsigned)G; \
        BODY; \
        __syncthreads(); \
        if (threadIdx.x == 0) _mb[0] = _nx; \
        __syncthreads(); \
        it = (int)_mb[0]; \
    } } while (0)

__global__ __launch_bounds__(512) void mega(Params p) {
    extern __shared__ __attribute__((aligned(16))) unsigned char shm[];
    cg::grid_group grid = cg::this_grid();
    const int G = (int)gridDim.x, bid = (int)blockIdx.x;
    const int wave = tidx() >> 6, lane = tidx() & 63;
    if (threadIdx.x < 4) ((volatile LAS unsigned*)(shm + 131072))[threadIdx.x] = 0u;
    __syncthreads();
    unsigned* qctr = (unsigned*)(p.ws + OFF_BAR) + 3584;
    const XcdBarrier xb = xcd_barrier_post((unsigned*)(p.ws + OFF_BAR), (volatile LAS unsigned*)(shm + 131072));
    for (int rep = 0; rep < 1 + DUP_P0; ++rep) phase0(p, shm, G);
    grid.sync();
#pragma unroll 1
    for (int l = 0; l < 4; ++l) {
        for (int rep = 0; rep < 1 + DUP_NORM; ++rep) norm_phase(p, l, G);
        xcd_barrier(xb);
        {
            pg8::Gemm g{WS_U(p), WS_WTIN(p) + (size_t)l * 7424 * 2048, NTOK, 7424, 2048};
            pg8::Order S; S.init(72, 29, G, bid, 0);
            EpiG1 E{WS_P(p)};
            for (int rep = 0; rep < 1 + DUP_G1; ++rep) pg8::gemm_phase<EpiG1, pg8::Order>((PG8_LAS unsigned char*)shm, g, S, E);
        }
        for (int rep = 0; rep < 1 + DUP_SYNC; ++rep) xcd_barrier(xb);
        for (int rep = 0; rep < 1 + DUP_E1; ++rep) {
            for (int it = bid; it < 144; it += G) prep_dt_item(p, l, it);
            for (int it = bid; it < 2880; it += G) prep_tile_item(p, l, it, shm);
            prep_elem(p, l, G);
        }
        for (int row = bid * 8 + wave; row < NTOK; row += G * 8) qkprep_row(p, l, row, lane);
        xcd_barrier(xb);
        QUEUE_LOOP(qctr + (l * 3 + 0) * 64, 288 + 2304, { if (it < 288) ssd_states_item(p, l, it, shm); else lru_item<false>(p, l, it - 288, shm); });
        xcd_barrier(xb);
        QUEUE_LOOP(qctr + (l * 3 + 1) * 64, 256 + 1152, { if (it < 256) ssd_recur_item(p, it); else attn_item(p, l, it - 256, shm); });
        xcd_barrier(xb);
        QUEUE_LOOP(qctr + (l * 3 + 2) * 64, 288 + 2304, { if (it < 288) ssd_final_item(p, l, it, shm); else lru_item<true>(p, l, it - 288, shm); });
        xcd_barrier(xb);
#ifndef SK_X4
        ssd_norm_phase(p, l, G);
#endif
        xcd_barrier(xb);
        {
            pg8::Gemm g{WS_MIX(p), WS_WTOUT(p) + (size_t)l * 2048 * 3072, NTOK, 2048, 3072};
            pg8::Order S; S.init(l == 3 ? 64 : 72, 8, G, bid, l == 3 ? 1 : 0);
            EpiG2 E{p, l};
#ifndef SK_G2
            pg8::gemm_phase<EpiG2, pg8::Order>((PG8_LAS unsigned char*)shm, g, S, E);
#endif
        }
        if (l < 3) xcd_barrier(xb);
    }
}

extern "C" void kernel_launch(void* const* d_in, const int* in_sizes, int n_in, void* d_out, int out_size, void* d_ws, size_t ws_size, hipStream_t stream) {
    static int grid = 0;
    if (grid == 0) {
        if (n_in != 25 || ws_size < WS_END) { fprintf(stderr, "kernel_launch: need 25 inputs and %zu bytes of workspace (got %d, %zu)\n", (size_t)WS_END, n_in, ws_size); grid = -1; return; }
        int dev = 0, cus = 0, per_cu = 0;
        hipGetDevice(&dev);
        hipDeviceGetAttribute(&cus, hipDeviceAttributeMultiprocessorCount, dev);
        if (hipFuncSetAttribute((const void*)mega, hipFuncAttributeMaxDynamicSharedMemorySize, LDS_BYTES) != hipSuccess) { fprintf(stderr, "kernel_launch: hipFuncSetAttribute failed\n"); grid = -1; return; }
        if (hipOccupancyMaxActiveBlocksPerMultiprocessor(&per_cu, (const void*)mega, 512, LDS_BYTES) != hipSuccess || per_cu < 1) { fprintf(stderr, "kernel_launch: occupancy query gave %d\n", per_cu); per_cu = 1; }
        (void)hipGetLastError();
        grid = cus * 1;
        if (grid <= 0) grid = 256;
    }
    if (grid < 0) return;
    Params p{};
    const float** pf = (const float**)&p;
    for (int i = 0; i < 25; ++i) pf[i] = (const float*)d_in[i];
    p.out = (float*)d_out; p.ws = (unsigned char*)d_ws;
    if (hipMemsetAsync((char*)d_ws + OFF_BAR, 0, 32768, stream) != hipSuccess) { fprintf(stderr, "kernel_launch: memset of barrier words failed\n"); return; }
    void* args[] = {&p};
    hipError_t e = hipLaunchCooperativeKernel((const void*)mega, dim3(grid), dim3(512), args, LDS_BYTES, stream);
    if (e != hipSuccess) fprintf(stderr, "cooperative launch failed: %s (grid %d)\n", hipGetErrorString(e), grid);
}
```

```cpp
#include <hip/hip_runtime.h>
#include <hip/hip_cooperative_groups.h>
#include <cstdio>
#include <cstdint>
namespace cg = cooperative_groups;
#define DUP_X1A 0
#define DUP_X1B 0
#define DUP_ATT 0
#define DUP_X3A 0
#define DUP_X3B 0
#define DUP_G1 0
#define DUP_P0 0
#define DUP_NORM 0
#define DUP_SYNC 0
#define DUP_E1 0
#define DUP_SWEEP 0
#define DUP_STATES 0
#define DUP_FINAL 0
#define DUP_X1Q 0
#define DUP_ATTQ 0
#define DUP_X3Q 0

__device__ __forceinline__ int tidx() { int t = (int)threadIdx.x; asm volatile("" : "+v"(t)); return t; }

namespace pg8 {
#define PG8_LAS __attribute__((address_space(3)))
typedef unsigned short bf16_t;
typedef short bf16x8 __attribute__((ext_vector_type(8)));
typedef float f32x4 __attribute__((ext_vector_type(4)));
typedef unsigned u32x4 __attribute__((ext_vector_type(4)));
constexpr int BM = 256, BK = 64, HALF = 128, HTB = HALF * BK * 2  , STAGE_BYTES = 8 * HTB, NXCD = 8, WGM = 8;

__host__ __device__ __forceinline__ int lds_byte(int r, int c) { const int st = (r >> 4) * 2 + (c >> 5), rr = r & 15, cc = c & 31, ob = rr * 64 + cc * 2; return st * 1024 + (ob ^ (((ob >> 9) & 1) << 5)); }
__host__ __device__ __forceinline__ void stage_rc(int b, int& R, int& C) { const int st = b / 1024, sb = b % 1024, swz = sb ^ (((sb >> 9) & 1) << 5); R = (st >> 1) * 16 + swz / 64; C = (st & 1) * 32 + (swz % 64) / 2; }
__host__ __device__ __forceinline__ int perm32(int rho) { const int n = rho >> 4, i = rho & 15; return 8 * (i >> 2) + 4 * n + (i & 3); }

struct Unit { int pm, pn; };
struct Gemm { const bf16_t* A; const bf16_t* Bt; int M, N, K; };

struct Order {
    int nM, nN, nwg, G, c, skipctx;
    __device__ void init(int nM_, int nN_, int G_, int c_, int skip_) { nM = nM_; nN = nN_; nwg = nM * nN; G = G_; c = c_; skipctx = skip_; }
    __device__ bool next(int i, Unit& u) const {
        const long L = (long)i * G + c; if (L >= nwg) return false;
        int wgid = (int)L; { const int q = nwg / NXCD, r = nwg % NXCD, xcd = wgid % NXCD, off = wgid / NXCD; wgid = (xcd < r ? xcd * (q + 1) : r * (q + 1) + (xcd - r) * q) + off; }
        const int nig = WGM * nN, gid = wgid / nig, fm = gid * WGM, gsz = (nM - fm) < WGM ? (nM - fm) : WGM;
        int pm = fm + ((wgid % nig) % gsz); u.pn = (wgid % nig) / gsz;
        if (skipctx) pm = (pm >> 3) * 9 + 1 + (pm & 7);
        u.pm = pm; return true;
    }
    __device__ __forceinline__ void a_ready(const Unit&) const {}
    __device__ __forceinline__ void done(const Unit&) const {}
};
typedef __bf16 bf16x2_t __attribute__((ext_vector_type(2)));
typedef float f32x2_t __attribute__((ext_vector_type(2)));
__device__ __forceinline__ unsigned cvt_pk_bf16(float lo, float hi) { f32x2_t v = {lo, hi}; bf16x2_t b = __builtin_convertvector(v, bf16x2_t); return __builtin_bit_cast(unsigned, b); }

template <class Epi, class Sched>
__device__ __forceinline__ void gemm_phase(PG8_LAS unsigned char* lds, const Gemm g, const Sched& S, const Epi& E) {
    const int tid = tidx(), wid = __builtin_amdgcn_readfirstlane(tid >> 6), lane = tid & 63, wr = wid >> 2, wc = wid & 3, fr = lane & 15, fq = lane >> 4;
    const int K = g.K, nt = K / BK;
    unsigned voffA[2], voffB[2];
#pragma unroll
    for (int i = 0; i < 2; ++i) { int R, C; stage_rc(tid * 16 + i * 8192, R, C); const int Rb = Epi::PERM ? ((R & ~31) + perm32(R & 31)) : R;
        voffA[i] = (unsigned)(R * K + C) * 2u; voffB[i] = (unsigned)(Rb * K + C) * 2u; }
    const size_t kstep = (size_t)(BK * 2);
    const size_t hstep = (size_t)HALF * K * 2;
    const size_t tstep = 2 * hstep;
    const unsigned ldsw = (unsigned)wid * 1024u;
    const int aoff = lds_byte(wr * 64 + fr, fq * 8), boff = lds_byte(wc * 32 + fr, fq * 8);
#define PG8_SA(b, h) (((b) * 2 + (h)) * HTB)
#define PG8_SB(b, h) ((4 + (b) * 2 + (h)) * HTB)
#define PG8_STAGE(bufoff, gbase, voff) do { _Pragma("unroll") for (int _i = 0; _i < 2; ++_i) \
        __builtin_amdgcn_global_load_lds((const unsigned*)((const char*)(gbase) + (voff)[_i]), (PG8_LAS unsigned*)(lds + (bufoff) + ldsw + _i * 8192), 16, 0, 0); } while (0)
#define PG8_LDA(dst, b, h) do { _Pragma("unroll") for (int m = 0; m < 4; ++m) _Pragma("unroll") for (int k = 0; k < 2; ++k) dst[m][k] = *(const PG8_LAS bf16x8*)(lds + PG8_SA(b, h) + aoff + m * 2048 + k * 1024); } while (0)
#define PG8_LDB(dst, b, h) do { _Pragma("unroll") for (int n = 0; n < 2; ++n) _Pragma("unroll") for (int k = 0; k < 2; ++k) dst[n][k] = *(const PG8_LAS bf16x8*)(lds + PG8_SB(b, h) + boff + n * 2048 + k * 1024); } while (0)
#define PG8_MMA(ai, bj, At, Bt) do { __builtin_amdgcn_s_setprio(1); _Pragma("unroll") for (int m = 0; m < 4; ++m) _Pragma("unroll") for (int n = 0; n < 2; ++n) _Pragma("unroll") for (int k = 0; k < 2; ++k) \
        acc[ai][bj][m][n] = __builtin_amdgcn_mfma_f32_16x16x32_bf16(Bt[n][k], At[m][k], acc[ai][bj][m][n], 0, 0, 0); __builtin_amdgcn_s_setprio(0); } while (0)
#define PG8_WAIT_V(n) asm volatile("s_waitcnt vmcnt(" #n ")" ::: "memory")
#define PG8_WAIT_L(n) asm volatile("s_waitcnt lgkmcnt(" #n ")" ::: "memory")
#define PG8_BAR __builtin_amdgcn_s_barrier()
#define PG8_SCHED __builtin_amdgcn_sched_barrier(0)
    Unit cur, nxt; int ui = 0;
    if (!S.next(0, cur)) return;
    f32x4 acc[2][2][4][2];
#pragma unroll
    for (int a = 0; a < 2; ++a)
#pragma unroll
        for (int b = 0; b < 2; ++b)
#pragma unroll
            for (int m = 0; m < 4; ++m)
#pragma unroll
                for (int n = 0; n < 2; ++n) acc[a][b][m][n] = (f32x4){0.f, 0.f, 0.f, 0.f};
    bf16x8 At[4][2], B0[2][2], B1[2][2];
    const char* cA = (const char*)g.A + (size_t)cur.pm * tstep; const char* cB = (const char*)g.Bt + (size_t)cur.pn * tstep;
    S.a_ready(cur);
    PG8_STAGE(PG8_SB(0, 0), cB, voffB); PG8_STAGE(PG8_SA(0, 0), cA, voffA); PG8_STAGE(PG8_SB(0, 1), cB + hstep, voffB); PG8_STAGE(PG8_SA(0, 1), cA + hstep, voffA);
    if (wr == 1) PG8_BAR;
    PG8_WAIT_V(4); PG8_BAR;
    PG8_STAGE(PG8_SB(1, 0), cB + kstep, voffB); PG8_STAGE(PG8_SA(1, 0), cA + kstep, voffA); PG8_STAGE(PG8_SB(1, 1), cB + hstep + kstep, voffB);
    PG8_WAIT_V(6); PG8_BAR;
    for (;;) {
        const bool has_next = S.next(ui + 1, nxt);
        const char* nA = has_next ? (const char*)g.A + (size_t)nxt.pm * tstep : cA; const char* nB = has_next ? (const char*)g.Bt + (size_t)nxt.pn * tstep : cB;
        for (int t = 0; t < nt; t += 2) {
            const bool last = (t == nt - 2);
            const char* a1 = cA + (size_t)(t + 1) * kstep;
            const char* a2 = last ? nA : cA + (size_t)(t + 2) * kstep; const char* b2 = last ? nB : cB + (size_t)(t + 2) * kstep;
            const char* a3 = a2 + kstep; const char* b3 = b2 + kstep;
            if (last && has_next) S.a_ready(nxt);
            PG8_LDB(B0, 0, 0); PG8_SCHED; PG8_LDA(At, 0, 0); PG8_STAGE(PG8_SA(1, 1), a1 + hstep, voffA);
            PG8_WAIT_L(8); PG8_BAR; PG8_WAIT_L(0); PG8_MMA(0, 0, At, B0); PG8_BAR; PG8_SCHED;
            PG8_LDB(B1, 0, 1); PG8_STAGE(PG8_SB(0, 0), b2, voffB);
            PG8_BAR; PG8_WAIT_L(0); PG8_MMA(0, 1, At, B1); PG8_BAR;
            PG8_LDA(At, 0, 1); PG8_STAGE(PG8_SA(0, 0), a2, voffA);
            PG8_BAR; PG8_WAIT_L(0); PG8_MMA(1, 0, At, B0); PG8_BAR; PG8_SCHED;
            PG8_STAGE(PG8_SB(0, 1), b2 + hstep, voffB);
            PG8_WAIT_V(6); PG8_BAR; PG8_MMA(1, 1, At, B1); PG8_BAR;
            PG8_LDB(B0, 1, 0); PG8_SCHED; PG8_LDA(At, 1, 0); PG8_STAGE(PG8_SA(0, 1), a2 + hstep, voffA);
            PG8_WAIT_L(8); PG8_BAR; PG8_WAIT_L(0); PG8_MMA(0, 0, At, B0); PG8_BAR; PG8_SCHED;
            PG8_LDB(B1, 1, 1); PG8_STAGE(PG8_SB(1, 0), b3, voffB);
            PG8_BAR; PG8_WAIT_L(0); PG8_MMA(0, 1, At, B1); PG8_BAR;
            PG8_LDA(At, 1, 1); PG8_STAGE(PG8_SA(1, 0), a3, voffA);
            PG8_BAR; PG8_WAIT_L(0); PG8_MMA(1, 0, At, B0); PG8_BAR; PG8_SCHED;
            PG8_STAGE(PG8_SB(1, 1), b3 + hstep, voffB);
            PG8_WAIT_V(6); PG8_BAR; PG8_MMA(1, 1, At, B1); PG8_BAR;
        }
        if constexpr (!Epi::AFTER_DRAIN) { E(acc, cur, wr, wc, fr, fq); S.done(cur); }
        if (!has_next) break;
#pragma unroll
        for (int a = 0; a < 2; ++a)
#pragma unroll
            for (int b = 0; b < 2; ++b)
#pragma unroll
                for (int m = 0; m < 4; ++m)
#pragma unroll
                    for (int n = 0; n < 2; ++n) acc[a][b][m][n] = (f32x4){0.f, 0.f, 0.f, 0.f};
        cur = nxt; cA = nA; cB = nB; ++ui;
    }
    PG8_WAIT_V(0);
    if (wr == 0) PG8_BAR;
    PG8_BAR;
    if constexpr (Epi::AFTER_DRAIN) { E.fused(acc, cur, wr, wc, fr, fq, lds, wid, lane); S.done(cur); }
#undef PG8_SA
#undef PG8_SB
#undef PG8_STAGE
#undef PG8_LDA
#undef PG8_LDB
#undef PG8_MMA
#undef PG8_WAIT_V
#undef PG8_WAIT_L
#undef PG8_BAR
#undef PG8_SCHED
}
}

using pg8::bf16_t; using pg8::bf16x8; using pg8::f32x4; using pg8::cvt_pk_bf16;
typedef float f32x16 __attribute__((ext_vector_type(16)));
typedef float f32x8 __attribute__((ext_vector_type(8)));
typedef unsigned u32x2 __attribute__((ext_vector_type(2)));
typedef unsigned u32x4 __attribute__((ext_vector_type(4)));

constexpr int DM = 2048, TPB = 2304, NTOK = 18432, LDP = 7424, MIXW = 3072, NCH = 18;
constexpr int C_LX = 0, C_LG = 1024, C_Q = 2048, C_K = 3072, C_V = 3328, C_AG = 3584, C_XBC = 4608, C_Z = 6144, C_DT = 7168;
constexpr size_t SZ_WTIN = (size_t)4 * 7424 * 2048 * 2, SZ_WTOUT = (size_t)4 * 2048 * 3072 * 2, SZ_MOD = (size_t)4 * 9 * 6144 * 4, SZ_U = (size_t)NTOK * 2048 * 2,
                 SZ_P = (size_t)NTOK * LDP * 2, SZ_MIX = (size_t)NTOK * MIXW * 2, SZ_XB = (size_t)NTOK * 2048 * 4, SZ_ST = (size_t)8 * 2 * 18 * 16 * 8192 * 2,
                 SZ_AL = (size_t)8 * 2 * 18 * 16 * 4, SZ_SUM = (size_t)8 * 2 * 18 * 1024 * 4;
constexpr size_t OFF_WTIN = 0, OFF_WTOUT = OFF_WTIN + SZ_WTIN, OFF_MOD = OFF_WTOUT + SZ_WTOUT, OFF_U = OFF_MOD + SZ_MOD, OFF_P = OFF_U + SZ_U, OFF_MIX = OFF_P + SZ_P,
                 OFF_XB = OFF_MIX + SZ_MIX, OFF_ST = OFF_XB + SZ_XB, OFF_AL = OFF_ST + SZ_ST, OFF_SUMA = OFF_AL + SZ_AL, OFF_SUMB = OFF_SUMA + SZ_SUM, OFF_BAR = OFF_SUMB + SZ_SUM, OFF_SBC = OFF_BAR + 32768, OFF_SBT = OFF_SBC + (size_t)NTOK * 512 * 2, OFF_DTA = OFF_SBT + (size_t)8 * 18 * 2 * 16384 * 2,
                 OFF_ACS = OFF_DTA + (size_t)NTOK * 32 * 4, OFF_HINL = OFF_ACS + (size_t)NTOK * 32 * 4, OFF_GW = OFF_HINL + SZ_SUM, OFF_DTP = OFF_GW + (size_t)4 * 16 * 16384 * 2, WS_END = OFF_DTP + (size_t)NTOK * 16 * 4;
constexpr size_t OFF_LXC = OFF_U, OFF_SXT = OFF_U + (size_t)NTOK * 1024 * 2;
constexpr int LDS_BYTES = 131072 + 16;

struct Params {
    const float *x, *c, *ctx, *c_ctx, *norm_w, *ada_w, *ada_b, *w_in, *lru_conv_w, *lru_conv_b, *lru_ga_w, *lru_ga_b, *lru_gx_w, *lru_gx_b, *lru_lambda,
        *att_q_norm, *att_k_norm, *att_sink, *ssd_conv_w, *ssd_conv_b, *ssd_dt_bias, *ssd_A_log, *ssd_D, *ssd_norm_w, *w_out;
    float* out;
    unsigned char* ws;
};
#define WS_WTIN(p) ((bf16_t*)((p).ws + OFF_WTIN))
#define WS_WTOUT(p) ((bf16_t*)((p).ws + OFF_WTOUT))
#define WS_MOD(p) ((float*)((p).ws + OFF_MOD))
#define WS_U(p) ((bf16_t*)((p).ws + OFF_U))
#define WS_P(p) ((bf16_t*)((p).ws + OFF_P))
#define WS_MIX(p) ((bf16_t*)((p).ws + OFF_MIX))
#define WS_XB(p) ((float*)((p).ws + OFF_XB))
#define WS_ST(p) ((bf16_t*)((p).ws + OFF_ST))
#define WS_AL(p) ((float*)((p).ws + OFF_AL))
#define WS_SUMA(p) ((float*)((p).ws + OFF_SUMA))
#define WS_SUMB(p) ((float*)((p).ws + OFF_SUMB))
#define WS_LXC(p) ((bf16_t*)((p).ws + OFF_LXC))
#define WS_SXT(p) ((bf16_t*)((p).ws + OFF_SXT))
#define WS_SBC(p) ((bf16_t*)((p).ws + OFF_SBC))
#define WS_SBT(p) ((bf16_t*)((p).ws + OFF_SBT))
#define WS_DTA(p) ((float*)((p).ws + OFF_DTA))
#define WS_ACS(p) ((float*)((p).ws + OFF_ACS))
#define WS_HINL(p) ((float*)((p).ws + OFF_HINL))
#define WS_GW(p) ((bf16_t*)((p).ws + OFF_GW))
#define WS_DTP(p) ((float*)((p).ws + OFF_DTP))

__device__ __forceinline__ float bf2f(bf16_t v) { return __uint_as_float(((unsigned)v) << 16); }
__device__ __forceinline__ bf16_t f2bf(float f) { return (bf16_t)(cvt_pk_bf16(f, 0.f) & 0xffffu); }
__device__ __forceinline__ float siluf(float v) { return v * __builtin_amdgcn_rcpf(1.f + __expf(-v)); }
__device__ __forceinline__ float sigmf(float v) { return __builtin_amdgcn_rcpf(1.f + __expf(-v)); }
__device__ __forceinline__ float softplusf(float v) { return v > 20.f ? v : log1pf(__expf(v)); }
__device__ __forceinline__ float wave_sum(float v) {
#pragma unroll
    for (int o = 1; o < 64; o <<= 1) v += __shfl_xor(v, o);
    return v;
}
__device__ __forceinline__ f32x8 unpack8(const u32x4 w) {
    f32x8 f;
    f[0] = __uint_as_float(w.x << 16); f[1] = __uint_as_float(w.x & 0xffff0000u); f[2] = __uint_as_float(w.y << 16); f[3] = __uint_as_float(w.y & 0xffff0000u);
    f[4] = __uint_as_float(w.z << 16); f[5] = __uint_as_float(w.z & 0xffff0000u); f[6] = __uint_as_float(w.w << 16); f[7] = __uint_as_float(w.w & 0xffff0000u);
    return f;
}
__device__ __forceinline__ u32x4 pack8(const f32x8 f) { u32x4 w; w.x = cvt_pk_bf16(f[0], f[1]); w.y = cvt_pk_bf16(f[2], f[3]); w.z = cvt_pk_bf16(f[4], f[5]); w.w = cvt_pk_bf16(f[6], f[7]); return w; }
__device__ __forceinline__ int chunk_at(int d, int pos) { return d == 0 ? pos : (pos < 2 ? 1 - pos : 19 - pos); }
__device__ __forceinline__ int pos_of(int d, int c) { return d == 0 ? c : (c < 2 ? 1 - c : 19 - c); }
__device__ __forceinline__ int rowmap32(int reg, int lane) { return (reg & 3) + 8 * (reg >> 2) + 4 * (lane >> 5); }

template <int K> __device__ __forceinline__ void mm32(f32x16& acc, const bf16_t* A, int lda, const bf16_t* B, int ldb, int lane) {
    const bf16_t* pa = A + (lane & 31) * lda + 8 * (lane >> 5);
    const bf16_t* pb = B + (lane & 31) * ldb + 8 * (lane >> 5);
#pragma unroll
    for (int k = 0; k < K; k += 16) {
        const bf16x8 a = *(const bf16x8*)(pa + k);
        const bf16x8 b = *(const bf16x8*)(pb + k);
        acc = __builtin_amdgcn_mfma_f32_32x32x16_bf16(a, b, acc, 0, 0, 0);
    }
}

template <int NC, bool SILU, bool TRANS>
__device__ __forceinline__ void stage_conv_tile(bf16_t* dst, int ld, const bf16_t* Pb, int t0, int col0, const float* cw, int CS, const float* cb, int tid) {
    constexpr int CG = NC / 8;
    const int lo = t0 < 256 ? 0 : 256, hi = t0 < 256 ? 256 : TPB;
    for (int idx = tid; idx < 128 * CG; idx += 512) {
        int cgi, tl;
        if (TRANS) { tl = idx & 127; cgi = idx >> 7; } else { cgi = idx % CG; tl = idx / CG; }
        const int t = t0 + tl;
        const f32x4 b0 = *(const f32x4*)(cb + cgi * 8), b1 = *(const f32x4*)(cb + cgi * 8 + 4);
        f32x8 acc; acc[0] = b0.x; acc[1] = b0.y; acc[2] = b0.z; acc[3] = b0.w; acc[4] = b1.x; acc[5] = b1.y; acc[6] = b1.z; acc[7] = b1.w;
#pragma unroll
        for (int k = 0; k < 4; ++k) {
            const int tt = t - 2 + k;
            if (tt >= lo && tt < hi) {
                const f32x8 v = unpack8(*(const u32x4*)(Pb + (size_t)tt * LDP + col0 + cgi * 8));
                const f32x4 w0 = *(const f32x4*)(cw + k * CS + cgi * 8), w1 = *(const f32x4*)(cw + k * CS + cgi * 8 + 4);
                acc[0] += w0.x * v[0]; acc[1] += w0.y * v[1]; acc[2] += w0.z * v[2]; acc[3] += w0.w * v[3];
                acc[4] += w1.x * v[4]; acc[5] += w1.y * v[5]; acc[6] += w1.z * v[6]; acc[7] += w1.w * v[7];
            }
        }
        if (SILU) {
#pragma unroll
            for (int e = 0; e < 8; ++e) acc[e] = siluf(acc[e]);
        }
        if (TRANS) {
#pragma unroll
            for (int e = 0; e < 8; ++e) dst[(cgi * 8 + e) * ld + tl] = f2bf(acc[e]);
        } else {
            *(u32x4*)(dst + tl * ld + cgi * 8) = pack8(acc);
        }
    }
}

__device__ __forceinline__ void transpose_item(const float* W, int K, int N, int nblk, bf16_t* WT, float* scr, int item, int lane) {
    const int kb = item / nblk, nb = item % nblk, k0 = 64 * kb, n0 = 32 * nb;
    const int n = n0 + (lane & 31);
#pragma unroll 8
    for (int i = 0; i < 32; ++i) { const int kk = 2 * i + (lane >> 5); scr[kk * 33 + (lane & 31)] = (n < N) ? W[(size_t)(k0 + kk) * N + n] : 0.f; }
    asm volatile("s_waitcnt lgkmcnt(0)" ::: "memory");
    const int c = lane & 7;
#pragma unroll
    for (int j = 0; j < 4; ++j) {
        const int nn = (lane >> 3) + 8 * j; const float* s = scr + (8 * c) * 33 + nn;
        u32x4 o; o.x = cvt_pk_bf16(s[0 * 33], s[1 * 33]); o.y = cvt_pk_bf16(s[2 * 33], s[3 * 33]); o.z = cvt_pk_bf16(s[4 * 33], s[5 * 33]); o.w = cvt_pk_bf16(s[6 * 33], s[7 * 33]);
        *(u32x4*)(WT + (size_t)(n0 + nn) * K + k0 + 8 * c) = o;
    }
    asm volatile("s_waitcnt lgkmcnt(0)" ::: "memory");
}

__device__ __forceinline__ void phase0(const Params& p, unsigned char* shm, int G) {
    const int tid = tidx(), lane = tid & 63, wave = tid >> 6;
    float* sf = (float*)shm;
    float* MOD = WS_MOD(p);
    for (int item = blockIdx.x; item < 96; item += G) {
        const int l = item / 24, cgp = item % 24;
        __syncthreads();
        for (int idx = tid; idx < 9 * 2048; idx += 512) { const int r = idx >> 11, k = idx & 2047; const float v = r < 8 ? p.c[r * 2048 + k] : p.c_ctx[k]; sf[idx] = siluf(v); }
        __syncthreads();
        f32x4 acc[9];
#pragma unroll
        for (int r = 0; r < 9; ++r) acc[r] = (f32x4){0.f, 0.f, 0.f, 0.f};
        const float* wp = p.ada_w + ((size_t)l * 2048 + wave * 256) * 6144 + cgp * 256 + lane * 4;
#pragma unroll 4
        for (int kk = 0; kk < 256; ++kk) {
            const f32x4 wv = *(const f32x4*)(wp + (size_t)kk * 6144);
            const int k = wave * 256 + kk;
#pragma unroll
            for (int r = 0; r < 9; ++r) { const float s = sf[r * 2048 + k]; acc[r] += wv * s; }
        }
        __syncthreads();
#pragma unroll
        for (int r = 0; r < 9; ++r) *(f32x4*)(sf + (wave * 9 + r) * 256 + lane * 4) = acc[r];
        __syncthreads();
        for (int idx = tid; idx < 9 * 256; idx += 512) {
            const int r = idx >> 8, col = idx & 255; float s = p.ada_b[l * 6144 + cgp * 256 + col];
#pragma unroll
            for (int w = 0; w < 8; ++w) s += sf[(w * 9 + r) * 256 + col];
            MOD[(size_t)(l * 9 + r) * 6144 + cgp * 256 + col] = s;
        }
    }
    __syncthreads();
    float* scr = sf + wave * (64 * 33);
    const int gw = blockIdx.x * 8 + wave, NGW = G * 8;
    constexpr int I_IN = 32 * 232, I_OUT = 48 * 64;
    for (int it = gw; it < 4 * (I_IN + I_OUT); it += NGW) {
        if (it < 4 * I_IN) { const int l = it / I_IN, r = it % I_IN; transpose_item(p.w_in + (size_t)l * 2048 * 7184, 2048, 7184, 232, WS_WTIN(p) + (size_t)l * 7424 * 2048, scr, r, lane); }
        else { const int it2 = it - 4 * I_IN, l = it2 / I_OUT, r = it2 % I_OUT; transpose_item(p.w_out + (size_t)l * 3072 * 2048, 3072, 2048, 64, WS_WTOUT(p) + (size_t)l * 2048 * 3072, scr, r, lane); }
    }
    for (int idx = (int)blockIdx.x * 512 + tid; idx < 4 * 16 * 16384; idx += G * 512) {
        const int i = idx & 63, o = (idx >> 6) & 63, gate = (idx >> 12) & 1, d = (idx >> 13) & 1, j = (idx >> 14) & 15, l = idx >> 18;
        const float* w = gate ? p.lru_gx_w : p.lru_ga_w;
        WS_GW(p)[idx] = f2bf(w[(size_t)((l * 2 + d) * 16 + j) * 4096 + i * 64 + o]);
    }
}

__device__ __forceinline__ const float* xrow_src(const Params& p, int l, int row) {
    const int b = row / TPB, t = row % TPB;
    if (l == 0) return t < 256 ? p.ctx + ((size_t)b * 256 + t) * DM : p.x + ((size_t)b * 2048 + (t - 256)) * DM;
    return WS_XB(p) + (size_t)row * DM;
}
__device__ __forceinline__ void norm_phase(const Params& p, int l, int G) {
    const int lane = tidx() & 63, wave = tidx() >> 6;
    bf16_t* U = WS_U(p);
    for (int row = blockIdx.x * 8 + wave; row < NTOK; row += G * 8) {
        const int b = row / TPB, t = row % TPB;
        const float* src = xrow_src(p, l, row);
        const float* md = WS_MOD(p) + (size_t)(l * 9 + (t < 256 ? 8 : b)) * 6144;
        f32x4 v[8]; float ss = 0.f;
#pragma unroll
        for (int j = 0; j < 8; ++j) { v[j] = *(const f32x4*)(src + 4 * lane + 256 * j); ss += v[j].x * v[j].x + v[j].y * v[j].y + v[j].z * v[j].z + v[j].w * v[j].w; }
        ss = wave_sum(ss);
        const float rstd = rsqrtf(ss * (1.f / 2048.f) + 1e-6f);
#pragma unroll
        for (int j = 0; j < 8; ++j) {
            const int col = 4 * lane + 256 * j;
            const f32x4 nw = *(const f32x4*)(p.norm_w + l * 2048 + col), sh = *(const f32x4*)(md + col), sc = *(const f32x4*)(md + 2048 + col);
            const f32x4 y = v[j] * rstd * nw * (sc + 1.f) + sh;
            u32x2 w; w.x = cvt_pk_bf16(y.x, y.y); w.y = cvt_pk_bf16(y.z, y.w);
            *(u32x2*)(U + (size_t)row * DM + col) = w;
        }
    }
}

struct EpiG1 {
    static constexpr bool PERM = false, AFTER_DRAIN = false;
    bf16_t* P;
    __device__ __forceinline__ void operator()(const f32x4 (&acc)[2][2][4][2], const pg8::Unit& u, int wr, int wc, int fr, int fq) const {
        const int row0 = u.pm * 256 + wr * 64 + fr, col0 = u.pn * 256 + wc * 32 + 4 * fq;
#pragma unroll
        for (int ai = 0; ai < 2; ++ai)
#pragma unroll
            for (int m = 0; m < 4; ++m) { bf16_t* rowp = P + (size_t)(row0 + ai * 128 + m * 16) * LDP + col0;
#pragma unroll
                for (int bj = 0; bj < 2; ++bj)
#pragma unroll
                    for (int n = 0; n < 2; ++n) { const f32x4 v = acc[ai][bj][m][n]; u32x2 w; w.x = cvt_pk_bf16(v.x, v.y); w.y = cvt_pk_bf16(v.z, v.w); *(u32x2*)(rowp + bj * 128 + n * 16) = w; } }
    }
};
struct EpiG2 {
    static constexpr bool PERM = false, AFTER_DRAIN = false;
    Params p; int l;
    __device__ __forceinline__ void operator()(const f32x4 (&acc)[2][2][4][2], const pg8::Unit& u, int wr, int wc, int fr, int fq) const {
        const int row0 = u.pm * 256 + wr * 64 + fr, col0 = u.pn * 256 + wc * 32 + 4 * fq;
#pragma unroll
        for (int ai = 0; ai < 2; ++ai)
#pragma unroll
            for (int m = 0; m < 4; ++m) {
                const int row = row0 + ai * 128 + m * 16, b = row / TPB, t = row % TPB;
                if (l == 3 && t < 256) continue;
                const float* xo = xrow_src(p, l, row);
                float* dst = (l == 3) ? p.out + ((size_t)b * 2048 + (t - 256)) * DM : WS_XB(p) + (size_t)row * DM;
                const float* gt = WS_MOD(p) + (size_t)(l * 9 + (t < 256 ? 8 : b)) * 6144 + 4096;
#pragma unroll
                for (int bj = 0; bj < 2; ++bj)
#pragma unroll
                    for (int n = 0; n < 2; ++n) { const int col = col0 + bj * 128 + n * 16; const f32x4 xv = *(const f32x4*)(xo + col), g = *(const f32x4*)(gt + col); *(f32x4*)(dst + col) = xv + g * acc[ai][bj][m][n]; }
            }
    }
};

__device__ __forceinline__ void qkprep_row(const Params& p, int l, int row, int lane) {
    const int t = row % TPB;
    bf16_t* rp = WS_P(p) + (size_t)row * LDP;
    float cs = 1.f, sn = 0.f;
    if (t >= 256) {
        const int s = t - 256, rr = s >> 6, cc = s & 63, f = lane & 31;
        const float inv = exp2f(-(float)f * (13.287712379549449f / 32.f));
        const float ang = (float)(lane < 32 ? rr : cc) * inv;
        cs = __cosf(ang); sn = __sinf(ang);
    }
#pragma unroll
    for (int slot = 0; slot < 10; ++slot) {
        const int col = slot < 8 ? C_Q + slot * 128 : C_K + (slot - 8) * 128;
        const float* w = slot < 8 ? p.att_q_norm + l * 128 : p.att_k_norm + l * 128;
        const float v1 = bf2f(rp[col + lane]), v2 = bf2f(rp[col + 64 + lane]);
        const float ss = wave_sum(v1 * v1 + v2 * v2);
        const float rstd = rsqrtf(ss * (1.f / 128.f) + 1e-6f);
        const float y1 = v1 * rstd * w[lane], y2 = v2 * rstd * w[64 + lane];
        float o1 = y1 * cs - y2 * sn, o2 = y1 * sn + y2 * cs;
        if (slot < 8) { o1 *= 0.08838834764831845f; o2 *= 0.08838834764831845f; }
        rp[col + lane] = f2bf(o1); rp[col + 64 + lane] = f2bf(o2);
    }
}

template <int D>
__device__ __forceinline__ void lru_sweep_item(const Params& p, int l, int item, unsigned char* shm) {
    const int tid = tidx(), lane = tid & 63, wave = tid >> 6, ch = tid & 63, seg = tid >> 6;
    const int j = item & 15, b = item >> 4;
    bf16_t* sX = (bf16_t*)shm; bf16_t* sW = (bf16_t*)(shm + 18432);
    float* sA = (float*)(shm + 36864); float* sB = (float*)(shm + 69632); float* sSA = (float*)(shm + 102400); float* sSB = (float*)(shm + 104448);
    bf16_t* sOut = (bf16_t*)(shm + 106496);
    const int mi = wave & 3, nj = wave >> 2, cl = nj * 32 + (lane & 31), cgl = j * 64 + cl;
    const float ba = p.lru_ga_b[(l * 2 + D) * 1024 + cgl], bx = p.lru_gx_b[(l * 2 + D) * 1024 + cgl], sp = softplusf(-p.lru_lambda[(l * 2 + D) * 1024 + cgl]);
    __syncthreads();
    {
        u32x4 wr2[2];
#pragma unroll
        for (int k = 0; k < 2; ++k) { const int idx = tid + k * 512; wr2[k] = *(const u32x4*)(WS_GW(p) + (size_t)(l * 16 + j) * 16384 + D * 8192 + idx * 8); }
#pragma unroll
        for (int k = 0; k < 2; ++k) { const int idx = tid + k * 512; *(u32x4*)(sW + (idx >> 3) * 72 + (idx & 7) * 8) = wr2[k]; }
    }
    u32x4 xr[2], lgr[2], hfr[2];
    {
        const size_t tok0 = (size_t)b * TPB + chunk_at(D, 0) * 128;
#pragma unroll
        for (int k = 0; k < 2; ++k) {
            const int idx = tid + k * 512;
            xr[k] = *(const u32x4*)(WS_LXC(p) + (tok0 + (idx >> 3)) * 1024 + j * 64 + (idx & 7) * 8);
            if (D == 1) { lgr[k] = *(const u32x4*)(WS_P(p) + (tok0 + (idx >> 3)) * LDP + C_LG + j * 64 + (idx & 7) * 8); hfr[k] = *(const u32x4*)(WS_MIX(p) + (tok0 + (idx >> 3)) * MIXW + j * 64 + (idx & 7) * 8); }
        }
    }
    float carry = 0.f;
#pragma unroll 1
    for (int pos = 0; pos < NCH; ++pos) {
        const size_t tok0 = (size_t)b * TPB + chunk_at(D, pos) * 128;
#pragma unroll
        for (int k = 0; k < 2; ++k) { const int idx = tid + k * 512; *(u32x4*)(sX + (idx >> 3) * 72 + (idx & 7) * 8) = xr[k]; }
        u32x4 lgc[2], hfc[2];
        if (D == 1) { lgc[0] = lgr[0]; lgc[1] = lgr[1]; hfc[0] = hfr[0]; hfc[1] = hfr[1]; }
        if (pos + 1 < NCH) {
            const size_t tokn = (size_t)b * TPB + chunk_at(D, pos + 1) * 128;
#pragma unroll
            for (int k = 0; k < 2; ++k) {
                const int idx = tid + k * 512;
                xr[k] = *(const u32x4*)(WS_LXC(p) + (tokn + (idx >> 3)) * 1024 + j * 64 + (idx & 7) * 8);
                if (D == 1) { lgr[k] = *(const u32x4*)(WS_P(p) + (tokn + (idx >> 3)) * LDP + C_LG + j * 64 + (idx & 7) * 8); hfr[k] = *(const u32x4*)(WS_MIX(p) + (tokn + (idx >> 3)) * MIXW + j * 64 + (idx & 7) * 8); }
            }
        }
        __syncthreads();
        {
            f32x16 ga, gx;
#pragma unroll
            for (int r = 0; r < 16; ++r) { ga[r] = 0.f; gx[r] = 0.f; }
            mm32<64>(ga, sX + mi * 32 * 72, 72, sW + (nj * 32) * 72, 72, lane);
            mm32<64>(gx, sX + mi * 32 * 72, 72, sW + (64 + nj * 32) * 72, 72, lane);
#pragma unroll
            for (int r = 0; r < 16; ++r) {
                const int tl = mi * 32 + rowmap32(r, lane);
                const float rg = sigmf(ga[r] + ba), ig = sigmf(gx[r] + bx);
                const float a = __expf(-8.f * rg * sp), mult = __builtin_amdgcn_sqrtf(fmaxf(1.f - a * a, 0.f));
                const float xv = bf2f(sX[tl * 72 + cl]);
                sA[tl * 64 + cl] = a; sB[tl * 64 + cl] = mult * ig * xv;
            }
        }
        __syncthreads();
        {
            float A = 1.f, Bc = 0.f;
#pragma unroll
            for (int q = 0; q < 16; ++q) { const int tl = seg * 16 + (D == 0 ? q : 15 - q); const float a = sA[tl * 64 + ch], bb = sB[tl * 64 + ch]; A = a * A; Bc = a * Bc + bb; }
            sSA[seg * 64 + ch] = A; sSB[seg * 64 + ch] = Bc;
        }
        __syncthreads();
        {
            float h = carry, cn = carry;
            const int myord = D == 0 ? seg : 7 - seg;
#pragma unroll
            for (int s = 0; s < 8; ++s) { const int sg = D == 0 ? s : 7 - s; const float a = sSA[sg * 64 + ch], bb = sSB[sg * 64 + ch]; cn = a * cn + bb; if (s < myord) h = cn; }
            carry = cn;
#pragma unroll
            for (int q = 0; q < 16; ++q) { const int tl = seg * 16 + (D == 0 ? q : 15 - q); h = sA[tl * 64 + ch] * h + sB[tl * 64 + ch]; sOut[tl * 72 + ch] = f2bf(h); }
        }
        __syncthreads();
#pragma unroll
        for (int k = 0; k < 2; ++k) {
            const int idx = tid + k * 512, rr = idx >> 3, ck = idx & 7;
            const u32x4 hv = *(const u32x4*)(sOut + rr * 72 + ck * 8);
            bf16_t* dst = WS_MIX(p) + (tok0 + rr) * MIXW + j * 64 + ck * 8;
            if (D == 0) *(u32x4*)dst = hv;
            else {
                const f32x8 a = unpack8(hv), f = unpack8(hfc[k]), g = unpack8(lgc[k]);
                f32x8 o;
#pragma unroll
                for (int e = 0; e < 8; ++e) o[e] = (a[e] + f[e]) * siluf(g[e]);
                *(u32x4*)dst = pack8(o);
            }
        }
    }
}

__device__ __forceinline__ void prep_elem(const Params& p, int l, int G) {
    const int gt = (int)blockIdx.x * 512 + tidx(), NT = G * 512;
    for (int idx = gt; idx < NTOK * 192; idx += NT) {
        const int tok = idx / 192, cgi = idx % 192, b = tok / TPB, t = tok % TPB;
        const int lo = t < 256 ? 0 : 256, hi = t < 256 ? 256 : TPB;
        int col, CS; const float *cw, *cb; bf16_t* dst; bool act;
        if (cgi < 128) { col = C_LX + cgi * 8; cw = p.lru_conv_w + l * 4096 + cgi * 8; CS = 1024; cb = p.lru_conv_b + l * 1024 + cgi * 8; act = false; dst = WS_LXC(p) + (size_t)tok * 1024 + cgi * 8; }
        else { const int c2 = (cgi - 128) * 8; col = C_XBC + 1024 + c2; cw = p.ssd_conv_w + l * 6144 + 1024 + c2; CS = 1536; cb = p.ssd_conv_b + l * 1536 + 1024 + c2; act = true; dst = WS_SBC(p) + (size_t)tok * 512 + c2; }
        const bf16_t* src = WS_P(p) + (size_t)b * TPB * LDP + col;
        u32x4 raw[4];
#pragma unroll
        for (int k = 0; k < 4; ++k) { const int tt = t - 2 + k; raw[k] = (tt >= lo && tt < hi) ? *(const u32x4*)(src + (size_t)tt * LDP) : (u32x4){0u, 0u, 0u, 0u}; }
        const f32x4 b0 = *(const f32x4*)cb, b1 = *(const f32x4*)(cb + 4);
        f32x8 acc; acc[0] = b0.x; acc[1] = b0.y; acc[2] = b0.z; acc[3] = b0.w; acc[4] = b1.x; acc[5] = b1.y; acc[6] = b1.z; acc[7] = b1.w;
#pragma unroll
        for (int k = 0; k < 4; ++k) {
            const f32x8 v = unpack8(raw[k]);
            const f32x4 w0 = *(const f32x4*)(cw + k * CS), w1 = *(const f32x4*)(cw + k * CS + 4);
            acc[0] += w0.x * v[0]; acc[1] += w0.y * v[1]; acc[2] += w0.z * v[2]; acc[3] += w0.w * v[3];
            acc[4] += w1.x * v[4]; acc[5] += w1.y * v[5]; acc[6] += w1.z * v[6]; acc[7] += w1.w * v[7];
        }
        if (act) {
#pragma unroll
            for (int e = 0; e < 8; ++e) acc[e] = siluf(acc[e]);
        }
        *(u32x4*)dst = pack8(acc);
    }
}
__device__ __forceinline__ void prep_tile_item(const Params& p, int l, int item, unsigned char* shm) {
    const int tid = tidx();
    const int t20 = item % 20, bc = item / 20, c = bc % NCH, b = bc / NCH, t0 = c * 128;
    const bf16_t* Pb = WS_P(p) + (size_t)b * TPB * LDP;
    bf16_t* sT = (bf16_t*)shm;
    int ch0; bf16_t* dst;
    if (t20 < 16) { ch0 = t20 * 64; dst = WS_SXT(p) + ((size_t)((b * 18 + c) * 16 + t20)) * 8192; }
    else { const int q = t20 - 16, g = q >> 1, nh = q & 1; ch0 = 1024 + g * 128 + nh * 64; dst = WS_SBT(p) + ((size_t)((b * 18 + c) * 2 + g)) * 16384 + (size_t)nh * 64 * 128; }
    __syncthreads();
    stage_conv_tile<64, true, true>(sT, 136, Pb, t0, C_XBC + ch0, p.ssd_conv_w + l * 6144 + ch0, 1536, p.ssd_conv_b + l * 1536 + ch0, tid);
    __syncthreads();
#pragma unroll
    for (int k = 0; k < 2; ++k) { const int idx = tid + k * 512, r = idx >> 4, ck = idx & 15; *(u32x4*)(dst + r * 128 + ck * 8) = *(const u32x4*)(sT + r * 136 + ck * 8); }
}
__device__ __forceinline__ void prep_dt_item(const Params& p, int l, int item) {
    const int tid = tidx();
    const int c = item % NCH, b = item / NCH;
    const int col32 = tid >> 4, h = col32 >> 1, d = col32 & 1, lane16 = tid & 15, seg = d == 0 ? lane16 : 15 - lane16;
    const float A = -__expf(p.ssd_A_log[(l * 2 + d) * 16 + h]), bias = p.ssd_dt_bias[(l * 2 + d) * 16 + h];
    const float* src = WS_DTP(p) + ((size_t)b * TPB + c * 128) * 16 + h;
    float dtv[8], cs[8], run = 0.f;
    float rawv[8];
#pragma unroll
    for (int q = 0; q < 8; ++q) { const int j = seg * 8 + (d == 0 ? q : 7 - q); rawv[q] = src[j * 16]; }
#pragma unroll
    for (int q = 0; q < 8; ++q) { dtv[q] = softplusf(rawv[q] + bias); run += dtv[q] * A; cs[q] = run; }
    float incl = run;
#pragma unroll
    for (int off = 1; off < 16; off <<= 1) { const float v = __shfl_up(incl, off, 16); if (lane16 >= off) incl += v; }
    const float excl = incl - run;
    float* dta = WS_DTA(p) + ((size_t)(b * 18 + c) * 128) * 32 + col32;
    float* acs = WS_ACS(p) + ((size_t)(b * 18 + c) * 128) * 32 + col32;
#pragma unroll
    for (int q = 0; q < 8; ++q) { const int j = seg * 8 + (d == 0 ? q : 7 - q); dta[j * 32] = dtv[q]; acs[j * 32] = cs[q] + excl; }
    if (lane16 == 15) WS_AL(p)[((b * 2 + d) * 18 + c) * 16 + h] = incl;
}
__device__ __forceinline__ void ssd_states_item(const Params& p, int l, int item, unsigned char* shm) {
    const int tid = tidx(), lane = tid & 63, wave = tid >> 6;
    const int g = item & 1, bc = item >> 1, c = bc % NCH, b = bc / NCH;
    bf16_t* sBT = (bf16_t*)shm; bf16_t* sXw = (bf16_t*)(shm + 34816);
    float* sDt = (float*)(shm + 69632); float* sAcs = (float*)(shm + 77824); bf16_t* sO = (bf16_t*)(shm + 86016); float* sWg = (float*)(shm + 120832);
    const bf16_t* xt = WS_SXT(p) + ((size_t)((b * 18 + c) * 16 + g * 8)) * 8192;
    const bf16_t* btp = WS_SBT(p) + ((size_t)((b * 18 + c) * 2 + g)) * 16384;
    __syncthreads();
    {
        const size_t o = ((size_t)(b * 18 + c) * 128 + (tid >> 2)) * 32 + g * 16 + (tid & 3) * 4;
        const f32x4 vdt = *(const f32x4*)(WS_DTA(p) + o), vac = *(const f32x4*)(WS_ACS(p) + o);
        u32x4 bt[4];
#pragma unroll
        for (int k = 0; k < 4; ++k) { const int idx = tid + k * 512; bt[k] = *(const u32x4*)(btp + (idx >> 4) * 128 + (idx & 15) * 8); }
        *(f32x4*)(sDt + (tid >> 2) * 16 + (tid & 3) * 4) = vdt; *(f32x4*)(sAcs + (tid >> 2) * 16 + (tid & 3) * 4) = vac;
#pragma unroll
        for (int k = 0; k < 4; ++k) { const int idx = tid + k * 512; *(u32x4*)(sBT + (idx >> 4) * 136 + (idx & 15) * 8) = bt[k]; }
    }
    u32x4 xr[2];
#pragma unroll
    for (int k = 0; k < 2; ++k) { const int idx = tid + k * 512; xr[k] = *(const u32x4*)(xt + (idx >> 4) * 128 + (idx & 15) * 8); }
    __syncthreads();
#pragma unroll
    for (int k = 0; k < 4; ++k) { const int idx = tid + k * 512, jj = idx >> 4, col = idx & 15; const float al = (col & 1) == 0 ? sAcs[127 * 16 + col] : sAcs[col]; sWg[col * 128 + jj] = __expf(al - sAcs[jj * 16 + col]) * sDt[jj * 16 + col]; }
#pragma unroll 1
    for (int hh = 0; hh < 8; ++hh) {
        const int h = g * 8 + hh;
        u32x4 xn[2] = {xr[0], xr[1]};
        if (hh < 7) {
#pragma unroll
            for (int k = 0; k < 2; ++k) { const int idx = tid + k * 512; xn[k] = *(const u32x4*)(xt + (size_t)(hh + 1) * 8192 + (idx >> 4) * 128 + (idx & 15) * 8); }
        }
        __syncthreads();
#pragma unroll
        for (int k = 0; k < 2; ++k) {
            const int idx = tid + k * 512, pp = idx >> 4, j8 = (idx & 15) * 8;
            const f32x8 xv = unpack8(xr[k]);
#pragma unroll
            for (int d = 0; d < 2; ++d) {
                const f32x4 w0 = *(const f32x4*)(sWg + (hh * 2 + d) * 128 + j8), w1 = *(const f32x4*)(sWg + (hh * 2 + d) * 128 + j8 + 4);
                f32x8 o;
                o[0] = xv[0] * w0.x; o[1] = xv[1] * w0.y; o[2] = xv[2] * w0.z; o[3] = xv[3] * w0.w; o[4] = xv[4] * w1.x; o[5] = xv[5] * w1.y; o[6] = xv[6] * w1.z; o[7] = xv[7] * w1.w;
                *(u32x4*)(sXw + d * 8704 + pp * 136 + j8) = pack8(o);
            }
        }
        __syncthreads();
        const int mi = wave & 1, nj = wave >> 1;
#pragma unroll
        for (int d = 0; d < 2; ++d) {
            f32x16 acc;
#pragma unroll
            for (int r = 0; r < 16; ++r) acc[r] = 0.f;
            mm32<128>(acc, sXw + d * 8704 + mi * 32 * 136, 136, sBT + nj * 32 * 136, 136, lane);
#pragma unroll
            for (int r = 0; r < 16; ++r) sO[d * 8704 + (mi * 32 + rowmap32(r, lane)) * 136 + nj * 32 + (lane & 31)] = f2bf(acc[r]);
        }
        __syncthreads();
#pragma unroll
        for (int d = 0; d < 2; ++d) {
            bf16_t* base = WS_ST(p) + ((size_t)((b * 2 + d) * 18 + c) * 16 + h) * 8192;
#pragma unroll
            for (int k = 0; k < 2; ++k) { const int idx = tid + k * 512; *(u32x4*)(base + idx * 8) = *(const u32x4*)(sO + d * 8704 + (idx >> 4) * 136 + (idx & 15) * 8); }
        }
        xr[0] = xn[0]; xr[1] = xn[1];
    }
}
__device__ __forceinline__ void ssd_recur_item(const Params& p, int item) {
    const int tid = tidx();
    const int d = item & 1, h = (item >> 1) & 15, b = item >> 5;
    f32x8 h0, h1;
#pragma unroll
    for (int e = 0; e < 8; ++e) { h0[e] = 0.f; h1[e] = 0.f; }
    for (int pos = 0; pos < NCH; ++pos) {
        const int c = chunk_at(d, pos);
        bf16_t* ptr = WS_ST(p) + ((size_t)((b * 2 + d) * 18 + c) * 16 + h) * 8192 + tid * 16;
        const f32x8 s0 = unpack8(*(const u32x4*)ptr), s1 = unpack8(*(const u32x4*)(ptr + 8));
        const float e = __expf(WS_AL(p)[((b * 2 + d) * 18 + c) * 16 + h]);
        *(u32x4*)ptr = pack8(h0); *(u32x4*)(ptr + 8) = pack8(h1);
        h0 = h0 * e + s0; h1 = h1 * e + s1;
    }
}
__device__ __forceinline__ void ssd_final_item(const Params& p, int l, int item, unsigned char* shm) {
    const int tid = tidx(), lane = tid & 63, wave = tid >> 6;
    const int g = item & 1, bc = item >> 1, c = bc % NCH, b = bc / NCH, t0 = c * 128;
    const size_t tok0 = (size_t)b * TPB + t0;
    bf16_t* sC = (bf16_t*)shm; bf16_t* sBW = (bf16_t*)(shm + 34816); bf16_t* sXT = (bf16_t*)(shm + 69632); bf16_t* sH = (bf16_t*)(shm + 87040);
    float* sDt = (float*)(shm + 104448); float* sAcs = (float*)(shm + 112640);
    bf16_t* sY = sBW;
    const bf16_t* xt = WS_SXT(p) + ((size_t)((b * 18 + c) * 16 + g * 8)) * 8192;
    const bf16_t* zt = WS_P(p) + tok0 * LDP + C_Z + g * 512;
    const bf16_t* hin0 = WS_ST(p) + ((size_t)((b * 2 + 0) * 18 + c) * 16 + g * 8) * 8192;
    const bf16_t* hin1 = WS_ST(p) + ((size_t)((b * 2 + 1) * 18 + c) * 16 + g * 8) * 8192;
    __syncthreads();
    u32x4 xr[2], zr[2], h0r[2];
    {
        const size_t o = ((size_t)(b * 18 + c) * 128 + (tid >> 2)) * 32 + g * 16 + (tid & 3) * 4;
        const f32x4 vdt = *(const f32x4*)(WS_DTA(p) + o), vac = *(const f32x4*)(WS_ACS(p) + o);
        u32x4 cr[4], br[4];
#pragma unroll
        for (int k = 0; k < 4; ++k) { const int idx = tid + k * 512; const bf16_t* s = WS_SBC(p) + (tok0 + (idx >> 4)) * 512 + g * 128 + (idx & 15) * 8; br[k] = *(const u32x4*)s; cr[k] = *(const u32x4*)(s + 256); }
#pragma unroll
        for (int k = 0; k < 2; ++k) {
            const int idx = tid + k * 512;
            xr[k] = *(const u32x4*)(xt + (idx >> 4) * 128 + (idx & 15) * 8);
            zr[k] = *(const u32x4*)(zt + (size_t)(idx >> 3) * LDP + (idx & 7) * 8);
            h0r[k] = *(const u32x4*)(hin0 + idx * 8);
        }
        *(f32x4*)(sDt + (tid >> 2) * 16 + (tid & 3) * 4) = vdt; *(f32x4*)(sAcs + (tid >> 2) * 16 + (tid & 3) * 4) = vac;
#pragma unroll
        for (int k = 0; k < 4; ++k) { const int idx = tid + k * 512; *(u32x4*)(sC + (idx >> 4) * 136 + (idx & 15) * 8) = cr[k]; *(u32x4*)(sBW + (idx >> 4) * 136 + (idx & 15) * 8) = br[k]; }
    }
    __syncthreads();
    const int cmi = wave >> 1, cnj0 = (wave & 1) * 2;
    f32x16 cb0, cb1;
#pragma unroll
    for (int r = 0; r < 16; ++r) { cb0[r] = 0.f; cb1[r] = 0.f; }
    mm32<128>(cb0, sC + cmi * 32 * 136, 136, sBW + cnj0 * 32 * 136, 136, lane);
    mm32<128>(cb1, sC + cmi * 32 * 136, 136, sBW + (cnj0 + 1) * 32 * 136, 136, lane);
    const int ymi = wave & 3, ynj = wave >> 2;
#pragma unroll 1
    for (int hh = 0; hh < 8; ++hh) {
        const int h = g * 8 + hh;
        __syncthreads();
#pragma unroll
        for (int k = 0; k < 2; ++k) { const int idx = tid + k * 512; *(u32x4*)(sXT + (idx >> 4) * 136 + (idx & 15) * 8) = xr[k]; *(u32x4*)(sH + (idx >> 4) * 136 + (idx & 15) * 8) = h0r[k]; }
        u32x4 h1r[2];
#pragma unroll
        for (int k = 0; k < 2; ++k) h1r[k] = *(const u32x4*)(hin1 + (size_t)hh * 8192 + (tid + k * 512) * 8);
        f32x16 yacc;
#pragma unroll
        for (int r = 0; r < 16; ++r) yacc[r] = 0.f;
#pragma unroll 1
        for (int d = 0; d < 2; ++d) {
            const int col = hh * 2 + d;
            if (d == 1) {
                __syncthreads();
#pragma unroll
                for (int k = 0; k < 2; ++k) { const int idx = tid + k * 512; *(u32x4*)(sH + (idx >> 4) * 136 + (idx & 15) * 8) = h1r[k]; }
            }
#pragma unroll
            for (int tt = 0; tt < 2; ++tt) {
                const int jg = (cnj0 + tt) * 32 + (lane & 31);
                const float acj = sAcs[jg * 16 + col], dtj = sDt[jg * 16 + col];
#pragma unroll
                for (int r = 0; r < 16; ++r) {
                    const int ig = cmi * 32 + rowmap32(r, lane);
                    const bool valid = d == 0 ? (jg <= ig) : (jg >= ig);
                    const float cbv = tt == 0 ? cb0[r] : cb1[r];
                    const float val = valid ? cbv * __expf(sAcs[ig * 16 + col] - acj) * dtj : 0.f;
                    sBW[ig * 136 + jg] = f2bf(val);
                }
            }
            __syncthreads();
            f32x16 ad, ao;
#pragma unroll
            for (int r = 0; r < 16; ++r) { ad[r] = 0.f; ao[r] = 0.f; }
            mm32<128>(ad, sBW + ymi * 32 * 136, 136, sXT + ynj * 32 * 136, 136, lane);
            mm32<128>(ao, sC + ymi * 32 * 136, 136, sH + ynj * 32 * 136, 136, lane);
#pragma unroll
            for (int r = 0; r < 16; ++r) { const int ig = ymi * 32 + rowmap32(r, lane); yacc[r] += ad[r] + __expf(sAcs[ig * 16 + col]) * ao[r]; }
            if (d == 0 && hh < 7) {
#pragma unroll
                for (int k = 0; k < 2; ++k) {
                    const int idx = tid + k * 512;
                    xr[k] = *(const u32x4*)(xt + (size_t)(hh + 1) * 8192 + (idx >> 4) * 128 + (idx & 15) * 8);
                    h0r[k] = *(const u32x4*)(hin0 + (size_t)(hh + 1) * 8192 + idx * 8);
                }
            }
        }
        const float Dh = p.ssd_D[l * 16 + h];
        const int pl = ynj * 32 + (lane & 31);
#pragma unroll
        for (int r = 0; r < 16; ++r) { const int ig = ymi * 32 + rowmap32(r, lane); yacc[r] += Dh * bf2f(sXT[pl * 136 + ig]); }
        __syncthreads();
#pragma unroll
        for (int r = 0; r < 16; ++r) { const int ig = ymi * 32 + rowmap32(r, lane); sY[ig * 72 + pl] = f2bf(yacc[r]); }
        __syncthreads();
#pragma unroll
        for (int k = 0; k < 2; ++k) {
            const int idx = tid + k * 512, rr = idx >> 3, pk = idx & 7;
            const f32x8 yv = unpack8(*(const u32x4*)(sY + rr * 72 + pk * 8)), zv = unpack8(zr[k]);
            f32x8 o;
#pragma unroll
            for (int e = 0; e < 8; ++e) o[e] = yv[e] * siluf(zv[e]);
            *(u32x4*)(WS_MIX(p) + (tok0 + rr) * MIXW + 2048 + h * 64 + pk * 8) = pack8(o);
        }
        if (hh < 7) {
#pragma unroll
            for (int k = 0; k < 2; ++k) { const int idx = tid + k * 512; zr[k] = *(const u32x4*)(zt + (size_t)(idx >> 3) * LDP + (hh + 1) * 64 + (idx & 7) * 8); }
        }
    }
}
__device__ __forceinline__ void ssd_norm_phase(const Params& p, int l, int G) {
    const int lane = tidx() & 63, wave = tidx() >> 6;
    for (int row = blockIdx.x * 8 + wave; row < NTOK; row += G * 8) {
        bf16_t* rp = WS_MIX(p) + (size_t)row * MIXW + 2048;
        f32x8 v0 = unpack8(*(const u32x4*)(rp + lane * 8)), v1 = unpack8(*(const u32x4*)(rp + 512 + lane * 8));
        float ss = 0.f;
#pragma unroll
        for (int e = 0; e < 8; ++e) ss += v0[e] * v0[e] + v1[e] * v1[e];
        ss = wave_sum(ss);
        const float rstd = rsqrtf(ss * (1.f / 1024.f) + 1e-6f);
        const float* nw = p.ssd_norm_w + l * 1024;
#pragma unroll
        for (int e = 0; e < 8; ++e) { v0[e] = v0[e] * rstd * nw[lane * 8 + e]; v1[e] = v1[e] * rstd * nw[512 + lane * 8 + e]; }
        *(u32x4*)(rp + lane * 8) = pack8(v0); *(u32x4*)(rp + 512 + lane * 8) = pack8(v1);
    }
}

__device__ __forceinline__ void attn_item(const Params& p, int l, int item, unsigned char* shm) {
    const int tid = tidx(), lane = tid & 63, wave = tid >> 6, fr = lane & 15, fq = lane >> 4;
    const int hq = item & 7, bq = item >> 3, qblk = bq % NCH, b = bq / NCH, kh = hq >> 2;
    const bf16_t* P = WS_P(p);
    bf16_t* sK = (bf16_t*)shm; bf16_t* sVT = (bf16_t*)(shm + 34816); bf16_t* sPw = (bf16_t*)(shm + 69632) + wave * (16 * 136);
    const size_t tokq0 = (size_t)b * TPB + qblk * 128;
    bf16x8 aq[4];
#pragma unroll
    for (int kk = 0; kk < 4; ++kk) aq[kk] = *(const bf16x8*)(P + (tokq0 + wave * 16 + fr) * LDP + C_Q + hq * 128 + kk * 32 + 8 * fq);
    float m[4], ls[4]; f32x4 O[8];
    const float sink = p.att_sink[l * 8 + hq];
#pragma unroll
    for (int r = 0; r < 4; ++r) { m[r] = sink; ls[r] = 1.f; }
#pragma unroll
    for (int nd = 0; nd < 8; ++nd) O[nd] = (f32x4){0.f, 0.f, 0.f, 0.f};
    const int nlat = qblk - 2;
    const int kb_lo = nlat - 1 < 0 ? 0 : nlat - 1, kb_hi = nlat + 1 > 15 ? 15 : nlat + 1;
    const int ntl = qblk < 2 ? 2 : 2 + (kb_hi - kb_lo + 1);
    u32x4 kr[4], vr[4];
    {
        const bf16_t* kbase = P + ((size_t)b * TPB) * LDP + C_K + kh * 128;
#pragma unroll
        for (int k = 0; k < 4; ++k) { const int idx = tid + k * 512; kr[k] = *(const u32x4*)(kbase + (size_t)(idx >> 4) * LDP + (idx & 15) * 8); vr[k] = *(const u32x4*)(kbase + (C_V - C_K) + (size_t)(idx & 127) * LDP + (idx >> 7) * 8); }
    }
    for (int ti = 0; ti < ntl; ++ti) {
        const bool masked = ti >= 2; const int kb = kb_lo + (ti - 2);
        __syncthreads();
#pragma unroll
        for (int k = 0; k < 4; ++k) {
            const int idx = tid + k * 512;
            *(u32x4*)(sK + (idx >> 4) * 136 + (idx & 15) * 8) = kr[k];
            const u32x4 raw = vr[k];
            bf16_t* dp = sVT + ((idx >> 7) * 8) * 136 + (idx & 127);
            dp[0 * 136] = (bf16_t)(raw.x & 0xffffu); dp[1 * 136] = (bf16_t)(raw.x >> 16); dp[2 * 136] = (bf16_t)(raw.y & 0xffffu); dp[3 * 136] = (bf16_t)(raw.y >> 16);
            dp[4 * 136] = (bf16_t)(raw.z & 0xffffu); dp[5 * 136] = (bf16_t)(raw.z >> 16); dp[6 * 136] = (bf16_t)(raw.w & 0xffffu); dp[7 * 136] = (bf16_t)(raw.w >> 16);
        }
        if (ti + 1 < ntl) {
            const int tn = ti + 1, t0n = tn < 2 ? tn * 128 : 256 + (kb_lo + (tn - 2)) * 128;
            const bf16_t* kbase = P + ((size_t)b * TPB + t0n) * LDP + C_K + kh * 128;
#pragma unroll
            for (int k = 0; k < 4; ++k) { const int idx = tid + k * 512; kr[k] = *(const u32x4*)(kbase + (size_t)(idx >> 4) * LDP + (idx & 15) * 8); vr[k] = *(const u32x4*)(kbase + (C_V - C_K) + (size_t)(idx & 127) * LDP + (idx >> 7) * 8); }
        }
        __syncthreads();
        f32x4 s[8];
#pragma unroll
        for (int nt = 0; nt < 8; ++nt) {
            s[nt] = (f32x4){0.f, 0.f, 0.f, 0.f};
#pragma unroll
            for (int kk = 0; kk < 4; ++kk) { const bf16x8 bk = *(const bf16x8*)(sK + (nt * 16 + fr) * 136 + kk * 32 + 8 * fq); s[nt] = __builtin_amdgcn_mfma_f32_16x16x32_bf16(aq[kk], bk, s[nt], 0, 0, 0); }
        }
        if (masked) {
#pragma unroll
            for (int nt = 0; nt < 8; ++nt)
#pragma unroll
                for (int r = 0; r < 4; ++r) { const int rel = (nlat * 128 + wave * 16 + fq * 4 + r) - (kb * 128 + nt * 16 + fr); if (rel > 128 || rel < -128) s[nt][r] = -INFINITY; }
        }
        float alpha[4];
#pragma unroll
        for (int r = 0; r < 4; ++r) {
            float mx = s[0][r];
#pragma unroll
            for (int nt = 1; nt < 8; ++nt) mx = fmaxf(mx, s[nt][r]);
            mx = fmaxf(mx, __shfl_xor(mx, 1)); mx = fmaxf(mx, __shfl_xor(mx, 2)); mx = fmaxf(mx, __shfl_xor(mx, 4)); mx = fmaxf(mx, __shfl_xor(mx, 8));
            const float mn = fmaxf(m[r], mx);
            alpha[r] = __expf(m[r] - mn); m[r] = mn;
            float rs = 0.f;
#pragma unroll
            for (int nt = 0; nt < 8; ++nt) { const float pv = __expf(s[nt][r] - mn); s[nt][r] = pv; rs += pv; }
            rs += __shfl_xor(rs, 1); rs += __shfl_xor(rs, 2); rs += __shfl_xor(rs, 4); rs += __shfl_xor(rs, 8);
            ls[r] = ls[r] * alpha[r] + rs;
        }
#pragma unroll
        for (int nd = 0; nd < 8; ++nd) { O[nd].x *= alpha[0]; O[nd].y *= alpha[1]; O[nd].z *= alpha[2]; O[nd].w *= alpha[3]; }
#pragma unroll
        for (int nt = 0; nt < 8; ++nt)
#pragma unroll
            for (int r = 0; r < 4; ++r) sPw[(fq * 4 + r) * 136 + nt * 16 + fr] = f2bf(s[nt][r]);
        asm volatile("s_waitcnt lgkmcnt(0)" ::: "memory");
#pragma unroll
        for (int kk = 0; kk < 4; ++kk) {
            const bf16x8 ap = *(const bf16x8*)(sPw + fr * 136 + kk * 32 + 8 * fq);
#pragma unroll
            for (int nd = 0; nd < 8; ++nd) { const bf16x8 bv = *(const bf16x8*)(sVT + (nd * 16 + fr) * 136 + kk * 32 + 8 * fq); O[nd] = __builtin_amdgcn_mfma_f32_16x16x32_bf16(ap, bv, O[nd], 0, 0, 0); }
        }
    }
#pragma unroll
    for (int r = 0; r < 4; ++r) {
        const size_t tok = tokq0 + wave * 16 + fq * 4 + r;
        const float il = 1.f / ls[r];
#pragma unroll
        for (int nd = 0; nd < 8; ++nd) {
            const int dcol = hq * 128 + nd * 16 + fr;
            const float ag = bf2f(P[tok * LDP + C_AG + dcol]);
            WS_MIX(p)[tok * MIXW + 1024 + dcol] = f2bf(O[nd][r] * il * siluf(ag));
        }
    }
}


#define XB_TMO      128
#define XB_XCNT(j)  (256  + 64 * (j))
#define XB_XSUB(j)  (1280 + 64 * (j))
#define XB_XGEN(j)  (2304 + 64 * (j))
#define XB_TOP      3328
#define XB_TOPGEN   3392
#define XCD_BAR_WORDS 3456
#define XB_SPIN_CAP (1u << 18)
#define LAS __attribute__((address_space(3)))
__device__ __forceinline__ unsigned xb_ld(unsigned* p)              { return __hip_atomic_load(p, __ATOMIC_RELAXED, __HIP_MEMORY_SCOPE_AGENT); }
__device__ __forceinline__ unsigned xb_add(unsigned* p, unsigned v) { return __hip_atomic_fetch_add(p, v, __ATOMIC_RELAXED, __HIP_MEMORY_SCOPE_AGENT); }
__device__ __forceinline__ unsigned xb_xcc_id() { return (unsigned)__builtin_amdgcn_s_getreg((3 << 11) | 20) & 0xFu; }
#define XB_SPIN(cond, bar) do { unsigned _sp = 0; while (cond) { __builtin_amdgcn_s_sleep(1); \
    if ((++_sp & 255u) == 0u) { if (xb_ld(&(bar)[XB_TMO])) break; if (_sp > XB_SPIN_CAP) { atomicAdd(&(bar)[XB_TMO], 1u); break; } } } } while (0)
struct XcdBarrier { unsigned* bar; unsigned x; volatile LAS unsigned* st; };
__device__ __forceinline__ XcdBarrier xcd_barrier_post(unsigned* bar, volatile LAS unsigned* st) {
    XcdBarrier b; b.bar = bar; b.x = xb_xcc_id(); b.st = st;
    if (threadIdx.x == 0) (void)xb_add(&bar[XB_XCNT(b.x)], 1u);
    return b;
}
__device__ __forceinline__ void xcd_barrier_complete(unsigned* bar, unsigned x, unsigned& nloc, unsigned& nx) {
    const unsigned G = gridDim.x * gridDim.y * gridDim.z;
    unsigned sum, cnt, mine, sp = 0u;
    for (;;) {
        sum = 0u; cnt = 0u; mine = 0u;
#pragma unroll
        for (unsigned j = 0; j < 16; ++j) { const unsigned c = xb_ld(&bar[XB_XCNT(j)]); sum += c; cnt += (c > 0u) ? 1u : 0u; mine = (j == x) ? c : mine; }
        if (sum == G) break;
        __builtin_amdgcn_s_sleep(1);
        if ((++sp & 255u) == 0u) { if (xb_ld(&bar[XB_TMO])) break; if (sp > XB_SPIN_CAP) { atomicAdd(&bar[XB_TMO], 1u); break; } }
    }
    nloc = mine > 0u ? mine : 1u; nx = cnt > 0u ? cnt : 1u;
}
__device__ __forceinline__ void xcd_barrier(const XcdBarrier& b) {
    asm volatile("s_waitcnt vmcnt(0)" ::: "memory");
    __syncthreads();
    if (threadIdx.x == 0) {
        unsigned* bar = b.bar;
        __builtin_amdgcn_s_waitcnt(0);
        unsigned nloc = b.st[0], nx = b.st[1];
        if (nloc == 0u) { xcd_barrier_complete(bar, b.x, nloc, nx); b.st[0] = nloc; b.st[1] = nx; }
        const unsigned old = xb_add(&bar[XB_XSUB(b.x)], 1u);
        const unsigned gen = old / nloc;
        if (old + 1u == (gen + 1u) * nloc) {
            __builtin_amdgcn_fence(__ATOMIC_RELEASE, "agent");
            asm volatile("s_waitcnt vmcnt(0)" ::: "memory");
            const unsigned og = xb_add(&bar[XB_TOP], 1u);
            const unsigned tg = og / nx;
            if (og + 1u == (tg + 1u) * nx) xb_add(&bar[XB_TOPGEN], 1u);
            else XB_SPIN(xb_ld(&bar[XB_TOPGEN]) == tg, bar);
            __builtin_amdgcn_fence(__ATOMIC_ACQUIRE, "agent");
            xb_add(&bar[XB_XGEN(b.x)], 1u);
            asm volatile("s_waitcnt vmcnt(0)" ::: "memory");
        } else {
            XB_SPIN(xb_ld(&bar[XB_XGEN(b.x)]) == gen, bar);
            __builtin_amdgcn_fence(__ATOMIC_ACQUIRE, "agent");
            asm volatile("s_waitcnt vmcnt(0)" ::: "memory");
        }
    }
    __syncthreads();
}


#define QUEUE_LOOP(ctr, NITEMS, BODY) do { \
    volatile LAS unsigned* _mb = (volatile LAS unsigned*)(shm + 131072 + 8); \
    int it = bid; \
    while (it < (NITEMS)) { \
        unsigned _nx = 0u; if (threadIdx.x == 0) _nx = xb_add((ctr), 1u) + (unsigned)G; \
        BODY; \
        __syncthreads(); \
        if (threadIdx.x == 0) _mb[0] = _nx; \
        __syncthreads(); \
        it = (int)_mb[0]; \
    } } while (0)

__global__ __launch_bounds__(512) void mega(Params p) {
    extern __shared__ __attribute__((aligned(16))) unsigned char shm[];
    cg::grid_group grid = cg::this_grid();
    const int G = (int)gridDim.x, bid = (int)blockIdx.x;
    if (threadIdx.x < 4) ((volatile LAS unsigned*)(shm + 131072))[threadIdx.x] = 0u;
    __syncthreads();
    unsigned* qctr = (unsigned*)(p.ws + OFF_BAR) + 3584;
    const XcdBarrier xb = xcd_barrier_post((unsigned*)(p.ws + OFF_BAR), (volatile LAS unsigned*)(shm + 131072));
    for (int rep = 0; rep < 1 + DUP_P0; ++rep) phase0(p, shm, G);
    grid.sync();
#pragma unroll 1
    for (int l = 0; l < 4; ++l) {
        for (int rep = 0; rep < 1 + DUP_NORM; ++rep) norm_phase(p, l, G);
        xcd_barrier(xb);
        {
            pg8::Gemm g{WS_U(p), WS_WTIN(p) + (size_t)l * 7424 * 2048, NTOK, 7168, 2048};
            pg8::Order S; S.init(72, 28, G, bid, 0);
            EpiG1 E{WS_P(p)};
            for (int rep = 0; rep < 1 + DUP_G1; ++rep) pg8::gemm_phase<EpiG1, pg8::Order>((PG8_LAS unsigned char*)shm, g, S, E);
            {
                const int tq = tidx(), wave = tq >> 6, lane = tq & 63, fr = lane & 15, fq = lane >> 4;
                for (int wu = bid * 8 + wave; wu < NTOK / 16; wu += G * 8) {
                    const bf16_t* ap = WS_U(p) + (size_t)(wu * 16 + fr) * 2048 + 8 * fq;
                    const bf16_t* bp = WS_WTIN(p) + ((size_t)l * 7424 + 7168 + fr) * 2048 + 8 * fq;
                    f32x4 acc = (f32x4){0.f, 0.f, 0.f, 0.f};
#pragma unroll 8
                    for (int kk = 0; kk < 64; ++kk) { const bf16x8 a = *(const bf16x8*)(ap + kk * 32), bq = *(const bf16x8*)(bp + kk * 32); acc = __builtin_amdgcn_mfma_f32_16x16x32_bf16(a, bq, acc, 0, 0, 0); }
#pragma unroll
                    for (int r = 0; r < 4; ++r) WS_DTP(p)[(size_t)(wu * 16 + fq * 4 + r) * 16 + fr] = acc[r];
                }
            }
        }
        for (int rep = 0; rep < 1 + DUP_SYNC; ++rep) xcd_barrier(xb);
        for (int rep = 0; rep < 1 + DUP_E1; ++rep) {
            for (int it = bid; it < 144; it += G) prep_dt_item(p, l, it);
            for (int it = bid; it < 2880; it += G) prep_tile_item(p, l, it, shm);
            prep_elem(p, l, G);
        }
        { const int tq = tidx(), wave = tq >> 6, lane = tq & 63; for (int row = bid * 8 + wave; row < NTOK; row += G * 8) qkprep_row(p, l, row, lane); }
        xcd_barrier(xb);
        QUEUE_LOOP(qctr + (l * 3 + 0) * 64, 128 + 288, { if (it < 128) lru_sweep_item<0>(p, l, it, shm); else ssd_states_item(p, l, it - 128, shm); });
#if DUP_SWEEP
        __syncthreads(); for (int it = bid; it < 128; it += G) lru_sweep_item<0>(p, l, it, shm);
#endif
#if DUP_STATES
        __syncthreads(); for (int it = bid; it < 256; it += G) ssd_states_item(p, l, it, shm);
#endif
        xcd_barrier(xb);
        QUEUE_LOOP(qctr + (l * 3 + 1) * 64, 256 + 1152, { if (it < 256) ssd_recur_item(p, it); else attn_item(p, l, it - 256, shm); });
#if DUP_ATTQ
        __syncthreads(); QUEUE_LOOP(qctr + (12 + l * 3 + 1) * 64, 1152, { attn_item(p, l, it, shm); });
#endif
        xcd_barrier(xb);
        QUEUE_LOOP(qctr + (l * 3 + 2) * 64, 128 + 288, { if (it < 128) lru_sweep_item<1>(p, l, it, shm); else ssd_final_item(p, l, it - 128, shm); });
#if DUP_FINAL
        __syncthreads(); for (int it = bid; it < 256; it += G) ssd_final_item(p, l, it, shm);
#endif
        xcd_barrier(xb);
#ifndef SK_X4
        ssd_norm_phase(p, l, G);
#endif
        xcd_barrier(xb);
        {
            pg8::Gemm g{WS_MIX(p), WS_WTOUT(p) + (size_t)l * 2048 * 3072, NTOK, 2048, 3072};
            pg8::Order S; S.init(l == 3 ? 64 : 72, 8, G, bid, l == 3 ? 1 : 0);
            EpiG2 E{p, l};
#ifndef SK_G2
            pg8::gemm_phase<EpiG2, pg8::Order>((PG8_LAS unsigned char*)shm, g, S, E);
#endif
        }
        if (l < 3) xcd_barrier(xb);
    }
}

extern "C" void kernel_launch(void* const* d_in, const int* in_sizes, int n_in, void* d_out, int out_size, void* d_ws, size_t ws_size, hipStream_t stream) {
    static int grid = 0;
    if (grid == 0) {
        if (n_in != 25 || ws_size < WS_END) { fprintf(stderr, "kernel_launch: need 25 inputs and %zu bytes of workspace (got %d, %zu)\n", (size_t)WS_END, n_in, ws_size); grid = -1; return; }
        int dev = 0, cus = 0, per_cu = 0;
        hipGetDevice(&dev);
        hipDeviceGetAttribute(&cus, hipDeviceAttributeMultiprocessorCount, dev);
        if (hipFuncSetAttribute((const void*)mega, hipFuncAttributeMaxDynamicSharedMemorySize, LDS_BYTES) != hipSuccess) { fprintf(stderr, "kernel_launch: hipFuncSetAttribute failed\n"); grid = -1; return; }
        if (hipOccupancyMaxActiveBlocksPerMultiprocessor(&per_cu, (const void*)mega, 512, LDS_BYTES) != hipSuccess || per_cu < 1) { fprintf(stderr, "kernel_launch: occupancy query gave %d\n", per_cu); per_cu = 1; }
        (void)hipGetLastError();
        grid = cus * 1;
        if (grid <= 0) grid = 256;
    }
    if (grid < 0) return;
    Params p{};
    const float** pf = (const float**)&p;
    for (int i = 0; i < 25; ++i) pf[i] = (const float*)d_in[i];
    p.out = (float*)d_out; p.ws = (unsigned char*)d_ws;
    if (hipMemsetAsync((char*)d_ws + OFF_BAR, 0, 32768, stream) != hipSuccess) { fprintf(stderr, "kernel_launch: memset of barrier words failed\n"); return; }
    void* args[] = {&p};
    hipError_t e = hipLaunchCooperativeKernel((const void*)mega, dim3(grid), dim3(512), args, LDS_BYTES, stream);
    if (e != hipSuccess) fprintf(stderr, "cooperative launch failed: %s (grid %d)\n", hipGetErrorString(e), grid);
}
```

```cpp
#include <hip/hip_runtime.h>
#include <hip/hip_cooperative_groups.h>
#include <cstdio>
#include <cstdint>
namespace cg = cooperative_groups;
#define DUP_X1A 0
#define DUP_X1B 0
#define DUP_ATT 0
#define DUP_X3A 0
#define DUP_X3B 0
#define DUP_G1 0
#define DUP_P0 0
#define DUP_NORM 0
#define DUP_SYNC 0
#define DUP_E1 0
#define DUP_SWEEP 0
#define DUP_STATES 0
#define DUP_FINAL 0
#define AMODE 0
#define FMODE 0
#define DUP_X1Q 0
#define DUP_ATTQ 0
#define DUP_X3Q 0

__device__ __forceinline__ int tidx() { int t = (int)threadIdx.x; asm volatile("" : "+v"(t)); return t; }

namespace pg8 {
#define PG8_LAS __attribute__((address_space(3)))
typedef unsigned short bf16_t;
typedef short bf16x8 __attribute__((ext_vector_type(8)));
typedef float f32x4 __attribute__((ext_vector_type(4)));
typedef unsigned u32x4 __attribute__((ext_vector_type(4)));
constexpr int BM = 256, BK = 64, HALF = 128, HTB = HALF * BK * 2  , STAGE_BYTES = 8 * HTB, NXCD = 8, WGM = 8;

__host__ __device__ __forceinline__ int lds_byte(int r, int c) { const int st = (r >> 4) * 2 + (c >> 5), rr = r & 15, cc = c & 31, ob = rr * 64 + cc * 2; return st * 1024 + (ob ^ (((ob >> 9) & 1) << 5)); }
__host__ __device__ __forceinline__ void stage_rc(int b, int& R, int& C) { const int st = b / 1024, sb = b % 1024, swz = sb ^ (((sb >> 9) & 1) << 5); R = (st >> 1) * 16 + swz / 64; C = (st & 1) * 32 + (swz % 64) / 2; }
__host__ __device__ __forceinline__ int perm32(int rho) { const int n = rho >> 4, i = rho & 15; return 8 * (i >> 2) + 4 * n + (i & 3); }

struct Unit { int pm, pn; };
struct Gemm { const bf16_t* A; const bf16_t* Bt; int M, N, K; };

struct Order {
    int nM, nN, nwg, G, c, skipctx;
    __device__ void init(int nM_, int nN_, int G_, int c_, int skip_) { nM = nM_; nN = nN_; nwg = nM * nN; G = G_; c = c_; skipctx = skip_; }
    __device__ bool next(int i, Unit& u) const {
        const long L = (long)i * G + c; if (L >= nwg) return false;
        int wgid = (int)L; { const int q = nwg / NXCD, r = nwg % NXCD, xcd = wgid % NXCD, off = wgid / NXCD; wgid = (xcd < r ? xcd * (q + 1) : r * (q + 1) + (xcd - r) * q) + off; }
        const int nig = WGM * nN, gid = wgid / nig, fm = gid * WGM, gsz = (nM - fm) < WGM ? (nM - fm) : WGM;
        int pm = fm + ((wgid % nig) % gsz); u.pn = (wgid % nig) / gsz;
        if (skipctx) pm = (pm >> 3) * 9 + 1 + (pm & 7);
        u.pm = pm; return true;
    }
    __device__ __forceinline__ void a_ready(const Unit&) const {}
    __device__ __forceinline__ void done(const Unit&) const {}
};
typedef __bf16 bf16x2_t __attribute__((ext_vector_type(2)));
typedef float f32x2_t __attribute__((ext_vector_type(2)));
__device__ __forceinline__ unsigned cvt_pk_bf16(float lo, float hi) { f32x2_t v = {lo, hi}; bf16x2_t b = __builtin_convertvector(v, bf16x2_t); return __builtin_bit_cast(unsigned, b); }

template <class Epi, class Sched>
__device__ __forceinline__ void gemm_phase(PG8_LAS unsigned char* lds, const Gemm g, const Sched& S, const Epi& E) {
    const int tid = tidx(), wid = __builtin_amdgcn_readfirstlane(tid >> 6), lane = tid & 63, wr = wid >> 2, wc = wid & 3, fr = lane & 15, fq = lane >> 4;
    const int K = g.K, nt = K / BK;
    unsigned voffA[2], voffB[2];
#pragma unroll
    for (int i = 0; i < 2; ++i) { int R, C; stage_rc(tid * 16 + i * 8192, R, C); const int Rb = Epi::PERM ? ((R & ~31) + perm32(R & 31)) : R;
        voffA[i] = (unsigned)(R * K + C) * 2u; voffB[i] = (unsigned)(Rb * K + C) * 2u; }
    const size_t kstep = (size_t)(BK * 2);
    const size_t hstep = (size_t)HALF * K * 2;
    const size_t tstep = 2 * hstep;
    const unsigned ldsw = (unsigned)wid * 1024u;
    const int aoff = lds_byte(wr * 64 + fr, fq * 8), boff = lds_byte(wc * 32 + fr, fq * 8);
#define PG8_SA(b, h) (((b) * 2 + (h)) * HTB)
#define PG8_SB(b, h) ((4 + (b) * 2 + (h)) * HTB)
#define PG8_STAGE(bufoff, gbase, voff) do { _Pragma("unroll") for (int _i = 0; _i < 2; ++_i) \
        __builtin_amdgcn_global_load_lds((const unsigned*)((const char*)(gbase) + (voff)[_i]), (PG8_LAS unsigned*)(lds + (bufoff) + ldsw + _i * 8192), 16, 0, 0); } while (0)
#define PG8_LDA(dst, b, h) do { _Pragma("unroll") for (int m = 0; m < 4; ++m) _Pragma("unroll") for (int k = 0; k < 2; ++k) dst[m][k] = *(const PG8_LAS bf16x8*)(lds + PG8_SA(b, h) + aoff + m * 2048 + k * 1024); } while (0)
#define PG8_LDB(dst, b, h) do { _Pragma("unroll") for (int n = 0; n < 2; ++n) _Pragma("unroll") for (int k = 0; k < 2; ++k) dst[n][k] = *(const PG8_LAS bf16x8*)(lds + PG8_SB(b, h) + boff + n * 2048 + k * 1024); } while (0)
#define PG8_MMA(ai, bj, At, Bt) do { __builtin_amdgcn_s_setprio(1); _Pragma("unroll") for (int m = 0; m < 4; ++m) _Pragma("unroll") for (int n = 0; n < 2; ++n) _Pragma("unroll") for (int k = 0; k < 2; ++k) \
        acc[ai][bj][m][n] = __builtin_amdgcn_mfma_f32_16x16x32_bf16(Bt[n][k], At[m][k], acc[ai][bj][m][n], 0, 0, 0); __builtin_amdgcn_s_setprio(0); } while (0)
#define PG8_WAIT_V(n) asm volatile("s_waitcnt vmcnt(" #n ")" ::: "memory")
#define PG8_WAIT_L(n) asm volatile("s_waitcnt lgkmcnt(" #n ")" ::: "memory")
#define PG8_BAR __builtin_amdgcn_s_barrier()
#define PG8_SCHED __builtin_amdgcn_sched_barrier(0)
    Unit cur, nxt; int ui = 0;
    if (!S.next(0, cur)) return;
    f32x4 acc[2][2][4][2];
#pragma unroll
    for (int a = 0; a < 2; ++a)
#pragma unroll
        for (int b = 0; b < 2; ++b)
#pragma unroll
            for (int m = 0; m < 4; ++m)
#pragma unroll
                for (int n = 0; n < 2; ++n) acc[a][b][m][n] = (f32x4){0.f, 0.f, 0.f, 0.f};
    bf16x8 At[4][2], B0[2][2], B1[2][2];
    const char* cA = (const char*)g.A + (size_t)cur.pm * tstep; const char* cB = (const char*)g.Bt + (size_t)cur.pn * tstep;
    S.a_ready(cur);
    PG8_STAGE(PG8_SB(0, 0), cB, voffB); PG8_STAGE(PG8_SA(0, 0), cA, voffA); PG8_STAGE(PG8_SB(0, 1), cB + hstep, voffB); PG8_STAGE(PG8_SA(0, 1), cA + hstep, voffA);
    if (wr == 1) PG8_BAR;
    PG8_WAIT_V(4); PG8_BAR;
    PG8_STAGE(PG8_SB(1, 0), cB + kstep, voffB); PG8_STAGE(PG8_SA(1, 0), cA + kstep, voffA); PG8_STAGE(PG8_SB(1, 1), cB + hstep + kstep, voffB);
    PG8_WAIT_V(6); PG8_BAR;
    for (;;) {
        const bool has_next = S.next(ui + 1, nxt);
        const char* nA = has_next ? (const char*)g.A + (size_t)nxt.pm * tstep : cA; const char* nB = has_next ? (const char*)g.Bt + (size_t)nxt.pn * tstep : cB;
        for (int t = 0; t < nt; t += 2) {
            const bool last = (t == nt - 2);
            const char* a1 = cA + (size_t)(t + 1) * kstep;
            const char* a2 = last ? nA : cA + (size_t)(t + 2) * kstep; const char* b2 = last ? nB : cB + (size_t)(t + 2) * kstep;
            const char* a3 = a2 + kstep; const char* b3 = b2 + kstep;
            if (last && has_next) S.a_ready(nxt);
            PG8_LDB(B0, 0, 0); PG8_SCHED; PG8_LDA(At, 0, 0); PG8_STAGE(PG8_SA(1, 1), a1 + hstep, voffA);
            PG8_WAIT_L(8); PG8_BAR; PG8_WAIT_L(0); PG8_MMA(0, 0, At, B0); PG8_BAR; PG8_SCHED;
            PG8_LDB(B1, 0, 1); PG8_STAGE(PG8_SB(0, 0), b2, voffB);
            PG8_BAR; PG8_WAIT_L(0); PG8_MMA(0, 1, At, B1); PG8_BAR;
            PG8_LDA(At, 0, 1); PG8_STAGE(PG8_SA(0, 0), a2, voffA);
            PG8_BAR; PG8_WAIT_L(0); PG8_MMA(1, 0, At, B0); PG8_BAR; PG8_SCHED;
            PG8_STAGE(PG8_SB(0, 1), b2 + hstep, voffB);
            PG8_WAIT_V(6); PG8_BAR; PG8_MMA(1, 1, At, B1); PG8_BAR;
            PG8_LDB(B0, 1, 0); PG8_SCHED; PG8_LDA(At, 1, 0); PG8_STAGE(PG8_SA(0, 1), a2 + hstep, voffA);
            PG8_WAIT_L(8); PG8_BAR; PG8_WAIT_L(0); PG8_MMA(0, 0, At, B0); PG8_BAR; PG8_SCHED;
            PG8_LDB(B1, 1, 1); PG8_STAGE(PG8_SB(1, 0), b3, voffB);
            PG8_BAR; PG8_WAIT_L(0); PG8_MMA(0, 1, At, B1); PG8_BAR;
            PG8_LDA(At, 1, 1); PG8_STAGE(PG8_SA(1, 0), a3, voffA);
            PG8_BAR; PG8_WAIT_L(0); PG8_MMA(1, 0, At, B0); PG8_BAR; PG8_SCHED;
            PG8_STAGE(PG8_SB(1, 1), b3 + hstep, voffB);
            PG8_WAIT_V(6); PG8_BAR; PG8_MMA(1, 1, At, B1); PG8_BAR;
        }
        if constexpr (!Epi::AFTER_DRAIN) { E(acc, cur, wr, wc, fr, fq); S.done(cur); }
        if (!has_next) break;
#pragma unroll
        for (int a = 0; a < 2; ++a)
#pragma unroll
            for (int b = 0; b < 2; ++b)
#pragma unroll
                for (int m = 0; m < 4; ++m)
#pragma unroll
                    for (int n = 0; n < 2; ++n) acc[a][b][m][n] = (f32x4){0.f, 0.f, 0.f, 0.f};
        cur = nxt; cA = nA; cB = nB; ++ui;
    }
    PG8_WAIT_V(0);
    if (wr == 0) PG8_BAR;
    PG8_BAR;
    if constexpr (Epi::AFTER_DRAIN) { E.fused(acc, cur, wr, wc, fr, fq, lds, wid, lane); S.done(cur); }
#undef PG8_SA
#undef PG8_SB
#undef PG8_STAGE
#undef PG8_LDA
#undef PG8_LDB
#undef PG8_MMA
#undef PG8_WAIT_V
#undef PG8_WAIT_L
#undef PG8_BAR
#undef PG8_SCHED
}
}

using pg8::bf16_t; using pg8::bf16x8; using pg8::f32x4; using pg8::cvt_pk_bf16;
typedef float f32x16 __attribute__((ext_vector_type(16)));
typedef float f32x8 __attribute__((ext_vector_type(8)));
typedef unsigned u32x2 __attribute__((ext_vector_type(2)));
typedef unsigned u32x4 __attribute__((ext_vector_type(4)));

constexpr int DM = 2048, TPB = 2304, NTOK = 18432, LDP = 7424, MIXW = 3072, NCH = 18;
constexpr int C_LX = 0, C_LG = 1024, C_Q = 2048, C_K = 3072, C_V = 3328, C_AG = 3584, C_XBC = 4608, C_Z = 6144, C_DT = 7168;
constexpr size_t SZ_WTIN = (size_t)4 * 7424 * 2048 * 2, SZ_WTOUT = (size_t)4 * 2048 * 3072 * 2, SZ_MOD = (size_t)4 * 9 * 6144 * 4, SZ_U = (size_t)NTOK * 2048 * 2,
                 SZ_P = (size_t)NTOK * LDP * 2, SZ_MIX = (size_t)NTOK * MIXW * 2, SZ_XB = (size_t)NTOK * 2048 * 4, SZ_ST = (size_t)8 * 2 * 18 * 16 * 8192 * 2,
                 SZ_AL = (size_t)8 * 2 * 18 * 16 * 4, SZ_SUM = (size_t)8 * 2 * 18 * 1024 * 4;
constexpr size_t OFF_WTIN = 0, OFF_WTOUT = OFF_WTIN + SZ_WTIN, OFF_MOD = OFF_WTOUT + SZ_WTOUT, OFF_U = OFF_MOD + SZ_MOD, OFF_P = OFF_U + SZ_U, OFF_MIX = OFF_P + SZ_P,
                 OFF_XB = OFF_MIX + SZ_MIX, OFF_ST = OFF_XB + SZ_XB, OFF_AL = OFF_ST + SZ_ST, OFF_SUMA = OFF_AL + SZ_AL, OFF_SUMB = OFF_SUMA + SZ_SUM, OFF_BAR = OFF_SUMB + SZ_SUM, OFF_SBC = OFF_BAR + 32768, OFF_SBT = OFF_SBC + (size_t)NTOK * 512 * 2, OFF_DTA = OFF_SBT + (size_t)8 * 18 * 2 * 16384 * 2,
                 OFF_ACS = OFF_DTA + (size_t)NTOK * 32 * 4, OFF_HINL = OFF_ACS + (size_t)NTOK * 32 * 4, OFF_GW = OFF_HINL + SZ_SUM, OFF_DTP = OFF_GW + (size_t)4 * 16 * 16384 * 2, OFF_VT = OFF_DTP + (size_t)NTOK * 16 * 4, WS_END = OFF_VT + (size_t)8 * 18 * 2 * 16384 * 2;
constexpr size_t OFF_LXC = OFF_U, OFF_SXT = OFF_U + (size_t)NTOK * 1024 * 2;
constexpr int LDS_BYTES = 131072 + 16;

struct Params {
    const float *x, *c, *ctx, *c_ctx, *norm_w, *ada_w, *ada_b, *w_in, *lru_conv_w, *lru_conv_b, *lru_ga_w, *lru_ga_b, *lru_gx_w, *lru_gx_b, *lru_lambda,
        *att_q_norm, *att_k_norm, *att_sink, *ssd_conv_w, *ssd_conv_b, *ssd_dt_bias, *ssd_A_log, *ssd_D, *ssd_norm_w, *w_out;
    float* out;
    unsigned char* ws;
};
#define WS_WTIN(p) ((bf16_t*)((p).ws + OFF_WTIN))
#define WS_WTOUT(p) ((bf16_t*)((p).ws + OFF_WTOUT))
#define WS_MOD(p) ((float*)((p).ws + OFF_MOD))
#define WS_U(p) ((bf16_t*)((p).ws + OFF_U))
#define WS_P(p) ((bf16_t*)((p).ws + OFF_P))
#define WS_MIX(p) ((bf16_t*)((p).ws + OFF_MIX))
#define WS_XB(p) ((float*)((p).ws + OFF_XB))
#define WS_ST(p) ((bf16_t*)((p).ws + OFF_ST))
#define WS_AL(p) ((float*)((p).ws + OFF_AL))
#define WS_SUMA(p) ((float*)((p).ws + OFF_SUMA))
#define WS_SUMB(p) ((float*)((p).ws + OFF_SUMB))
#define WS_LXC(p) ((bf16_t*)((p).ws + OFF_LXC))
#define WS_SXT(p) ((bf16_t*)((p).ws + OFF_SXT))
#define WS_SBC(p) ((bf16_t*)((p).ws + OFF_SBC))
#define WS_SBT(p) ((bf16_t*)((p).ws + OFF_SBT))
#define WS_DTA(p) ((float*)((p).ws + OFF_DTA))
#define WS_ACS(p) ((float*)((p).ws + OFF_ACS))
#define WS_HINL(p) ((float*)((p).ws + OFF_HINL))
#define WS_GW(p) ((bf16_t*)((p).ws + OFF_GW))
#define WS_DTP(p) ((float*)((p).ws + OFF_DTP))
#define WS_VT(p) ((bf16_t*)((p).ws + OFF_VT))

__device__ __forceinline__ float bf2f(bf16_t v) { return __uint_as_float(((unsigned)v) << 16); }
__device__ __forceinline__ bf16_t f2bf(float f) { return (bf16_t)(cvt_pk_bf16(f, 0.f) & 0xffffu); }
__device__ __forceinline__ float siluf(float v) { return v * __builtin_amdgcn_rcpf(1.f + __expf(-v)); }
__device__ __forceinline__ float sigmf(float v) { return __builtin_amdgcn_rcpf(1.f + __expf(-v)); }
__device__ __forceinline__ float softplusf(float v) { return v > 20.f ? v : log1pf(__expf(v)); }
__device__ __forceinline__ float wave_sum(float v) {
#pragma unroll
    for (int o = 1; o < 64; o <<= 1) v += __shfl_xor(v, o);
    return v;
}
__device__ __forceinline__ f32x8 unpack8(const u32x4 w) {
    f32x8 f;
    f[0] = __uint_as_float(w.x << 16); f[1] = __uint_as_float(w.x & 0xffff0000u); f[2] = __uint_as_float(w.y << 16); f[3] = __uint_as_float(w.y & 0xffff0000u);
    f[4] = __uint_as_float(w.z << 16); f[5] = __uint_as_float(w.z & 0xffff0000u); f[6] = __uint_as_float(w.w << 16); f[7] = __uint_as_float(w.w & 0xffff0000u);
    return f;
}
__device__ __forceinline__ u32x4 pack8(const f32x8 f) { u32x4 w; w.x = cvt_pk_bf16(f[0], f[1]); w.y = cvt_pk_bf16(f[2], f[3]); w.z = cvt_pk_bf16(f[4], f[5]); w.w = cvt_pk_bf16(f[6], f[7]); return w; }
__device__ __forceinline__ void lds_barrier() { asm volatile("s_waitcnt lgkmcnt(0)" ::: "memory"); __builtin_amdgcn_s_barrier(); asm volatile("" ::: "memory"); }
__device__ __forceinline__ int chunk_at(int d, int pos) { return d == 0 ? pos : (pos < 2 ? 1 - pos : 19 - pos); }
__device__ __forceinline__ int pos_of(int d, int c) { return d == 0 ? c : (c < 2 ? 1 - c : 19 - c); }
__device__ __forceinline__ int rowmap32(int reg, int lane) { return (reg & 3) + 8 * (reg >> 2) + 4 * (lane >> 5); }

template <int K> __device__ __forceinline__ void mm32(f32x16& acc, const bf16_t* A, int lda, const bf16_t* B, int ldb, int lane) {
    const bf16_t* pa = A + (lane & 31) * lda + 8 * (lane >> 5);
    const bf16_t* pb = B + (lane & 31) * ldb + 8 * (lane >> 5);
#pragma unroll
    for (int k = 0; k < K; k += 16) {
        const bf16x8 a = *(const bf16x8*)(pa + k);
        const bf16x8 b = *(const bf16x8*)(pb + k);
        acc = __builtin_amdgcn_mfma_f32_32x32x16_bf16(a, b, acc, 0, 0, 0);
    }
}

template <int NC, bool SILU, bool TRANS>
__device__ __forceinline__ void stage_conv_tile(bf16_t* dst, int ld, const bf16_t* Pb, int t0, int col0, const float* cw, int CS, const float* cb, int tid) {
    constexpr int CG = NC / 8;
    const int lo = t0 < 256 ? 0 : 256, hi = t0 < 256 ? 256 : TPB;
    for (int idx = tid; idx < 128 * CG; idx += 512) {
        int cgi, tl;
        if (TRANS) { tl = idx & 127; cgi = idx >> 7; } else { cgi = idx % CG; tl = idx / CG; }
        const int t = t0 + tl;
        const f32x4 b0 = *(const f32x4*)(cb + cgi * 8), b1 = *(const f32x4*)(cb + cgi * 8 + 4);
        f32x8 acc; acc[0] = b0.x; acc[1] = b0.y; acc[2] = b0.z; acc[3] = b0.w; acc[4] = b1.x; acc[5] = b1.y; acc[6] = b1.z; acc[7] = b1.w;
#pragma unroll
        for (int k = 0; k < 4; ++k) {
            const int tt = t - 2 + k;
            if (tt >= lo && tt < hi) {
                const f32x8 v = unpack8(*(const u32x4*)(Pb + (size_t)tt * LDP + col0 + cgi * 8));
                const f32x4 w0 = *(const f32x4*)(cw + k * CS + cgi * 8), w1 = *(const f32x4*)(cw + k * CS + cgi * 8 + 4);
                acc[0] += w0.x * v[0]; acc[1] += w0.y * v[1]; acc[2] += w0.z * v[2]; acc[3] += w0.w * v[3];
                acc[4] += w1.x * v[4]; acc[5] += w1.y * v[5]; acc[6] += w1.z * v[6]; acc[7] += w1.w * v[7];
            }
        }
        if (SILU) {
#pragma unroll
            for (int e = 0; e < 8; ++e) acc[e] = siluf(acc[e]);
        }
        if (TRANS) {
#pragma unroll
            for (int e = 0; e < 8; ++e) dst[(cgi * 8 + e) * ld + tl] = f2bf(acc[e]);
        } else {
            *(u32x4*)(dst + tl * ld + cgi * 8) = pack8(acc);
        }
    }
}

__device__ __forceinline__ void transpose_item(const float* W, int K, int N, int nblk, bf16_t* WT, float* scr, int item, int lane) {
    const int kb = item / nblk, nb = item % nblk, k0 = 64 * kb, n0 = 32 * nb;
    const int c4 = lane & 7, r8 = lane >> 3, n = n0 + c4 * 4;
    f32x4 tv[8];
#pragma unroll
    for (int i = 0; i < 8; ++i) tv[i] = (n < N) ? *(const f32x4*)(W + (size_t)(k0 + i * 8 + r8) * N + n) : (f32x4){0.f, 0.f, 0.f, 0.f};
#pragma unroll
    for (int i = 0; i < 8; ++i) { float* d = scr + (i * 8 + r8) * 33 + c4 * 4; d[0] = tv[i].x; d[1] = tv[i].y; d[2] = tv[i].z; d[3] = tv[i].w; }
    asm volatile("s_waitcnt lgkmcnt(0)" ::: "memory");
    const int c = lane & 7;
#pragma unroll
    for (int j = 0; j < 4; ++j) {
        const int nn = (lane >> 3) + 8 * j; const float* s = scr + (8 * c) * 33 + nn;
        u32x4 o; o.x = cvt_pk_bf16(s[0 * 33], s[1 * 33]); o.y = cvt_pk_bf16(s[2 * 33], s[3 * 33]); o.z = cvt_pk_bf16(s[4 * 33], s[5 * 33]); o.w = cvt_pk_bf16(s[6 * 33], s[7 * 33]);
        *(u32x4*)(WT + (size_t)(n0 + nn) * K + k0 + 8 * c) = o;
    }
    asm volatile("s_waitcnt lgkmcnt(0)" ::: "memory");
}

__device__ __forceinline__ void phase0(const Params& p, unsigned char* shm, int G) {
    const int tid = tidx(), lane = tid & 63, wave = tid >> 6;
    float* sf = (float*)shm;
    float* MOD = WS_MOD(p);
    for (int item = blockIdx.x; item < 96; item += G) {
        const int l = item / 24, cgp = item % 24;
        __syncthreads();
        for (int idx = tid; idx < 9 * 2048; idx += 512) { const int r = idx >> 11, k = idx & 2047; const float v = r < 8 ? p.c[r * 2048 + k] : p.c_ctx[k]; sf[idx] = siluf(v); }
        __syncthreads();
        f32x4 acc[9];
#pragma unroll
        for (int r = 0; r < 9; ++r) acc[r] = (f32x4){0.f, 0.f, 0.f, 0.f};
        const float* wp = p.ada_w + ((size_t)l * 2048 + wave * 256) * 6144 + cgp * 256 + lane * 4;
#pragma unroll 16
        for (int kk = 0; kk < 256; ++kk) {
            const f32x4 wv = *(const f32x4*)(wp + (size_t)kk * 6144);
            const int k = wave * 256 + kk;
#pragma unroll
            for (int r = 0; r < 9; ++r) { const float s = sf[r * 2048 + k]; acc[r] += wv * s; }
        }
        __syncthreads();
#pragma unroll
        for (int r = 0; r < 9; ++r) *(f32x4*)(sf + (wave * 9 + r) * 256 + lane * 4) = acc[r];
        __syncthreads();
        for (int idx = tid; idx < 9 * 256; idx += 512) {
            const int r = idx >> 8, col = idx & 255; float s = p.ada_b[l * 6144 + cgp * 256 + col];
#pragma unroll
            for (int w = 0; w < 8; ++w) s += sf[(w * 9 + r) * 256 + col];
            MOD[(size_t)(l * 9 + r) * 6144 + cgp * 256 + col] = s;
        }
    }
    __syncthreads();
    float* scr = sf + wave * (64 * 33);
    const int gw = blockIdx.x * 8 + wave, NGW = G * 8;
    constexpr int I_IN = 32 * 232, I_OUT = 48 * 64;
    for (int it = gw; it < 4 * (I_IN + I_OUT); it += NGW) {
        if (it < 4 * I_IN) { const int l = it / I_IN, r = it % I_IN; transpose_item(p.w_in + (size_t)l * 2048 * 7184, 2048, 7184, 232, WS_WTIN(p) + (size_t)l * 7424 * 2048, scr, r, lane); }
        else { const int it2 = it - 4 * I_IN, l = it2 / I_OUT, r = it2 % I_OUT; transpose_item(p.w_out + (size_t)l * 3072 * 2048, 3072, 2048, 64, WS_WTOUT(p) + (size_t)l * 2048 * 3072, scr, r, lane); }
    }
    for (int idx = (int)blockIdx.x * 512 + tid; idx < 4 * 16 * 16384; idx += G * 512) {
        const int i = idx & 63, o = (idx >> 6) & 63, gate = (idx >> 12) & 1, d = (idx >> 13) & 1, j = (idx >> 14) & 15, l = idx >> 18;
        const float* w = gate ? p.lru_gx_w : p.lru_ga_w;
        WS_GW(p)[idx] = f2bf(w[(size_t)((l * 2 + d) * 16 + j) * 4096 + i * 64 + o]);
    }
}

__device__ __forceinline__ const float* xrow_src(const Params& p, int l, int row) {
    const int b = row / TPB, t = row % TPB;
    if (l == 0) return t < 256 ? p.ctx + ((size_t)b * 256 + t) * DM : p.x + ((size_t)b * 2048 + (t - 256)) * DM;
    return WS_XB(p) + (size_t)row * DM;
}
__device__ __forceinline__ void norm_phase(const Params& p, int l, int G) {
    const int lane = tidx() & 63, wave = tidx() >> 6;
    bf16_t* U = WS_U(p);
    for (int row = blockIdx.x * 8 + wave; row < NTOK; row += G * 8) {
        const int b = row / TPB, t = row % TPB;
        const float* src = xrow_src(p, l, row);
        const float* md = WS_MOD(p) + (size_t)(l * 9 + (t < 256 ? 8 : b)) * 6144;
        f32x4 v[8]; float ss = 0.f;
#pragma unroll
        for (int j = 0; j < 8; ++j) { v[j] = *(const f32x4*)(src + 4 * lane + 256 * j); ss += v[j].x * v[j].x + v[j].y * v[j].y + v[j].z * v[j].z + v[j].w * v[j].w; }
        ss = wave_sum(ss);
        const float rstd = rsqrtf(ss * (1.f / 2048.f) + 1e-6f);
#pragma unroll
        for (int j = 0; j < 8; ++j) {
            const int col = 4 * lane + 256 * j;
            const f32x4 nw = *(const f32x4*)(p.norm_w + l * 2048 + col), sh = *(const f32x4*)(md + col), sc = *(const f32x4*)(md + 2048 + col);
            const f32x4 y = v[j] * rstd * nw * (sc + 1.f) + sh;
            u32x2 w; w.x = cvt_pk_bf16(y.x, y.y); w.y = cvt_pk_bf16(y.z, y.w);
            *(u32x2*)(U + (size_t)row * DM + col) = w;
        }
    }
}

struct EpiG1 {
    static constexpr bool PERM = false, AFTER_DRAIN = false;
    bf16_t* P;
    __device__ __forceinline__ void operator()(const f32x4 (&acc)[2][2][4][2], const pg8::Unit& u, int wr, int wc, int fr, int fq) const {
        const int row0 = u.pm * 256 + wr * 64 + fr, col0 = u.pn * 256 + wc * 32 + 4 * fq;
#pragma unroll
        for (int ai = 0; ai < 2; ++ai)
#pragma unroll
            for (int m = 0; m < 4; ++m) { bf16_t* rowp = P + (size_t)(row0 + ai * 128 + m * 16) * LDP + col0;
#pragma unroll
                for (int bj = 0; bj < 2; ++bj)
#pragma unroll
                    for (int n = 0; n < 2; ++n) { const f32x4 v = acc[ai][bj][m][n]; u32x2 w; w.x = cvt_pk_bf16(v.x, v.y); w.y = cvt_pk_bf16(v.z, v.w); *(u32x2*)(rowp + bj * 128 + n * 16) = w; } }
    }
};
struct EpiG2 {
    static constexpr bool PERM = false, AFTER_DRAIN = false;
    Params p; int l;
    __device__ __forceinline__ void operator()(const f32x4 (&acc)[2][2][4][2], const pg8::Unit& u, int wr, int wc, int fr, int fq) const {
        const int row0 = u.pm * 256 + wr * 64 + fr, col0 = u.pn * 256 + wc * 32 + 4 * fq;
#pragma unroll
        for (int ai = 0; ai < 2; ++ai)
#pragma unroll
            for (int m = 0; m < 4; ++m) {
                const int row = row0 + ai * 128 + m * 16, b = row / TPB, t = row % TPB;
                if (l == 3 && t < 256) continue;
                const float* xo = xrow_src(p, l, row);
                float* dst = (l == 3) ? p.out + ((size_t)b * 2048 + (t - 256)) * DM : WS_XB(p) + (size_t)row * DM;
                const float* gt = WS_MOD(p) + (size_t)(l * 9 + (t < 256 ? 8 : b)) * 6144 + 4096;
#pragma unroll
                for (int bj = 0; bj < 2; ++bj)
#pragma unroll
                    for (int n = 0; n < 2; ++n) { const int col = col0 + bj * 128 + n * 16; const f32x4 xv = *(const f32x4*)(xo + col), g = *(const f32x4*)(gt + col); *(f32x4*)(dst + col) = xv + g * acc[ai][bj][m][n]; }
            }
    }
};

__device__ __forceinline__ void qkprep_row(const Params& p, int l, int row, int lane) {
    const int t = row % TPB;
    bf16_t* rp = WS_P(p) + (size_t)row * LDP;
    float cs = 1.f, sn = 0.f;
    if (t >= 256) {
        const int s = t - 256, rr = s >> 6, cc = s & 63, f = lane & 31;
        const float inv = exp2f(-(float)f * (13.287712379549449f / 32.f));
        const float ang = (float)(lane < 32 ? rr : cc) * inv;
        cs = __cosf(ang); sn = __sinf(ang);
    }
#pragma unroll
    for (int slot = 0; slot < 10; ++slot) {
        const int col = slot < 8 ? C_Q + slot * 128 : C_K + (slot - 8) * 128;
        const float* w = slot < 8 ? p.att_q_norm + l * 128 : p.att_k_norm + l * 128;
        const float v1 = bf2f(rp[col + lane]), v2 = bf2f(rp[col + 64 + lane]);
        const float ss = wave_sum(v1 * v1 + v2 * v2);
        const float rstd = rsqrtf(ss * (1.f / 128.f) + 1e-6f);
        const float y1 = v1 * rstd * w[lane], y2 = v2 * rstd * w[64 + lane];
        float o1 = y1 * cs - y2 * sn, o2 = y1 * sn + y2 * cs;
        if (slot < 8) { o1 *= 0.08838834764831845f; o2 *= 0.08838834764831845f; }
        rp[col + lane] = f2bf(o1); rp[col + 64 + lane] = f2bf(o2);
    }
}

template <int D>
__device__ __forceinline__ void lru_sweep_item(const Params& p, int l, int item, unsigned char* shm) {
    const int tid = tidx(), lane = tid & 63, wave = tid >> 6, ch = tid & 63, seg = tid >> 6;
    const int j = item & 15, b = item >> 4;
    bf16_t* sX = (bf16_t*)shm; bf16_t* sW = (bf16_t*)(shm + 18432);
    float* sA = (float*)(shm + 36864); float* sB = (float*)(shm + 69632); float* sSA = (float*)(shm + 102400); float* sSB = (float*)(shm + 104448);
    bf16_t* sOut = (bf16_t*)(shm + 106496);
    const int mi = wave & 3, nj = wave >> 2, cl = nj * 32 + (lane & 31), cgl = j * 64 + cl;
    const float ba = p.lru_ga_b[(l * 2 + D) * 1024 + cgl], bx = p.lru_gx_b[(l * 2 + D) * 1024 + cgl], sp = softplusf(-p.lru_lambda[(l * 2 + D) * 1024 + cgl]);
    lds_barrier();
    {
        u32x4 wr2[2];
#pragma unroll
        for (int k = 0; k < 2; ++k) { const int idx = tid + k * 512; wr2[k] = *(const u32x4*)(WS_GW(p) + (size_t)(l * 16 + j) * 16384 + D * 8192 + idx * 8); }
#pragma unroll
        for (int k = 0; k < 2; ++k) { const int idx = tid + k * 512; *(u32x4*)(sW + (idx >> 3) * 72 + (idx & 7) * 8) = wr2[k]; }
    }
    u32x4 xr[2], lgr[2], hfr[2];
    {
        const size_t tok0 = (size_t)b * TPB + chunk_at(D, 0) * 128;
#pragma unroll
        for (int k = 0; k < 2; ++k) {
            const int idx = tid + k * 512;
            xr[k] = *(const u32x4*)(WS_LXC(p) + (tok0 + (idx >> 3)) * 1024 + j * 64 + (idx & 7) * 8);
            if (D == 1) { lgr[k] = *(const u32x4*)(WS_P(p) + (tok0 + (idx >> 3)) * LDP + C_LG + j * 64 + (idx & 7) * 8); hfr[k] = *(const u32x4*)(WS_MIX(p) + (tok0 + (idx >> 3)) * MIXW + j * 64 + (idx & 7) * 8); }
        }
    }
    float carry = 0.f;
#pragma unroll 1
    for (int pos = 0; pos < NCH; ++pos) {
        const size_t tok0 = (size_t)b * TPB + chunk_at(D, pos) * 128;
#pragma unroll
        for (int k = 0; k < 2; ++k) { const int idx = tid + k * 512; *(u32x4*)(sX + (idx >> 3) * 72 + (idx & 7) * 8) = xr[k]; }
        u32x4 lgc[2], hfc[2];
        if (D == 1) { lgc[0] = lgr[0]; lgc[1] = lgr[1]; hfc[0] = hfr[0]; hfc[1] = hfr[1]; }
        if (pos + 1 < NCH) {
            const size_t tokn = (size_t)b * TPB + chunk_at(D, pos + 1) * 128;
#pragma unroll
            for (int k = 0; k < 2; ++k) {
                const int idx = tid + k * 512;
                xr[k] = *(const u32x4*)(WS_LXC(p) + (tokn + (idx >> 3)) * 1024 + j * 64 + (idx & 7) * 8);
                if (D == 1) { lgr[k] = *(const u32x4*)(WS_P(p) + (tokn + (idx >> 3)) * LDP + C_LG + j * 64 + (idx & 7) * 8); hfr[k] = *(const u32x4*)(WS_MIX(p) + (tokn + (idx >> 3)) * MIXW + j * 64 + (idx & 7) * 8); }
            }
        }
        lds_barrier();
        {
            f32x16 ga, gx;
#pragma unroll
            for (int r = 0; r < 16; ++r) { ga[r] = 0.f; gx[r] = 0.f; }
            mm32<64>(ga, sX + mi * 32 * 72, 72, sW + (nj * 32) * 72, 72, lane);
            mm32<64>(gx, sX + mi * 32 * 72, 72, sW + (64 + nj * 32) * 72, 72, lane);
#pragma unroll
            for (int r = 0; r < 16; ++r) {
                const int tl = mi * 32 + rowmap32(r, lane);
                const float rg = sigmf(ga[r] + ba), ig = sigmf(gx[r] + bx);
                const float a = __expf(-8.f * rg * sp), mult = __builtin_amdgcn_sqrtf(fmaxf(1.f - a * a, 0.f));
                const float xv = bf2f(sX[tl * 72 + cl]);
                sA[tl * 64 + cl] = a; sB[tl * 64 + cl] = mult * ig * xv;
            }
        }
        lds_barrier();
        {
            float A = 1.f, Bc = 0.f;
#pragma unroll
            for (int q = 0; q < 16; ++q) { const int tl = seg * 16 + (D == 0 ? q : 15 - q); const float a = sA[tl * 64 + ch], bb = sB[tl * 64 + ch]; A = a * A; Bc = a * Bc + bb; }
            sSA[seg * 64 + ch] = A; sSB[seg * 64 + ch] = Bc;
        }
        lds_barrier();
        {
            float h = carry, cn = carry;
            const int myord = D == 0 ? seg : 7 - seg;
#pragma unroll
            for (int s = 0; s < 8; ++s) { const int sg = D == 0 ? s : 7 - s; const float a = sSA[sg * 64 + ch], bb = sSB[sg * 64 + ch]; cn = a * cn + bb; if (s < myord) h = cn; }
            carry = cn;
#pragma unroll
            for (int q = 0; q < 16; ++q) { const int tl = seg * 16 + (D == 0 ? q : 15 - q); h = sA[tl * 64 + ch] * h + sB[tl * 64 + ch]; sOut[tl * 72 + ch] = f2bf(h); }
        }
        lds_barrier();
#pragma unroll
        for (int k = 0; k < 2; ++k) {
            const int idx = tid + k * 512, rr = idx >> 3, ck = idx & 7;
            const u32x4 hv = *(const u32x4*)(sOut + rr * 72 + ck * 8);
            bf16_t* dst = WS_MIX(p) + (tok0 + rr) * MIXW + j * 64 + ck * 8;
            if (D == 0) *(u32x4*)dst = hv;
            else {
                const f32x8 a = unpack8(hv), f = unpack8(hfc[k]), g = unpack8(lgc[k]);
                f32x8 o;
#pragma unroll
                for (int e = 0; e < 8; ++e) o[e] = (a[e] + f[e]) * siluf(g[e]);
                *(u32x4*)dst = pack8(o);
            }
        }
    }
}

__device__ __forceinline__ void prep_elem(const Params& p, int l, int G) {
    const int gt = (int)blockIdx.x * 512 + tidx(), NT = G * 512;
    constexpr int NI = NTOK * 192, U = 3;
    for (int base = gt; base < NI; base += NT * U) {
        u32x4 raw[U][4];
#pragma unroll
        for (int u = 0; u < U; ++u) {
            const int idx = base + u * NT;
            if (idx < NI) {
                const int tok = idx / 192, cgi = idx % 192, b = tok / TPB, t = tok % TPB;
                const int lo = t < 256 ? 0 : 256, hi = t < 256 ? 256 : TPB;
                const int col = cgi < 128 ? C_LX + cgi * 8 : C_XBC + 1024 + (cgi - 128) * 8;
                const bf16_t* src = WS_P(p) + (size_t)b * TPB * LDP + col;
#pragma unroll
                for (int k = 0; k < 4; ++k) { const int tt = t - 2 + k; raw[u][k] = (tt >= lo && tt < hi) ? *(const u32x4*)(src + (size_t)tt * LDP) : (u32x4){0u, 0u, 0u, 0u}; }
            }
        }
#pragma unroll
        for (int u = 0; u < U; ++u) {
            const int idx = base + u * NT;
            if (idx < NI) {
                const int tok = idx / 192, cgi = idx % 192;
                int CS; const float *cw, *cb; bf16_t* dst; bool act;
                if (cgi < 128) { cw = p.lru_conv_w + l * 4096 + cgi * 8; CS = 1024; cb = p.lru_conv_b + l * 1024 + cgi * 8; act = false; dst = WS_LXC(p) + (size_t)tok * 1024 + cgi * 8; }
                else { const int c2 = (cgi - 128) * 8; cw = p.ssd_conv_w + l * 6144 + 1024 + c2; CS = 1536; cb = p.ssd_conv_b + l * 1536 + 1024 + c2; act = true; dst = WS_SBC(p) + (size_t)tok * 512 + c2; }
                const f32x4 b0 = *(const f32x4*)cb, b1 = *(const f32x4*)(cb + 4);
                f32x8 acc; acc[0] = b0.x; acc[1] = b0.y; acc[2] = b0.z; acc[3] = b0.w; acc[4] = b1.x; acc[5] = b1.y; acc[6] = b1.z; acc[7] = b1.w;
#pragma unroll
                for (int k = 0; k < 4; ++k) {
                    const f32x8 v = unpack8(raw[u][k]);
                    const f32x4 w0 = *(const f32x4*)(cw + k * CS), w1 = *(const f32x4*)(cw + k * CS + 4);
                    acc[0] += w0.x * v[0]; acc[1] += w0.y * v[1]; acc[2] += w0.z * v[2]; acc[3] += w0.w * v[3];
                    acc[4] += w1.x * v[4]; acc[5] += w1.y * v[5]; acc[6] += w1.z * v[6]; acc[7] += w1.w * v[7];
                }
                if (act) {
#pragma unroll
                    for (int e = 0; e < 8; ++e) acc[e] = siluf(acc[e]);
                }
                *(u32x4*)dst = pack8(acc);
            }
        }
    }
}
__device__ __forceinline__ void prep_tile_item(const Params& p, int l, int item, unsigned char* shm) {
    const int tid = tidx();
    const int t24 = item % 24, bc = item / 24, c = bc % NCH, b = bc / NCH, t0 = c * 128;
    const bf16_t* Pb = WS_P(p) + (size_t)b * TPB * LDP;
    bf16_t* sT = (bf16_t*)shm;
    int col0, ch0 = 0; bf16_t* dst; const bool conv = t24 < 20;
    if (t24 < 16) { ch0 = t24 * 64; col0 = C_XBC + ch0; dst = WS_SXT(p) + ((size_t)((b * 18 + c) * 16 + t24)) * 8192; }
    else if (t24 < 20) { const int q = t24 - 16, g = q >> 1, nh = q & 1; ch0 = 1024 + g * 128 + nh * 64; col0 = C_XBC + ch0; dst = WS_SBT(p) + ((size_t)((b * 18 + c) * 2 + g)) * 16384 + (size_t)nh * 64 * 128; }
    else { const int q = t24 - 20, kh = q >> 1, dh = q & 1; col0 = C_V + kh * 128 + dh * 64; dst = WS_VT(p) + ((size_t)((b * 18 + c) * 2 + kh)) * 16384 + (size_t)dh * 64 * 128; }
    const int lo = t0 < 256 ? 0 : 256, hi = t0 < 256 ? 256 : TPB;
    const float* cw = p.ssd_conv_w + l * 6144 + ch0; const float* cb = p.ssd_conv_b + l * 1536 + ch0;
    u32x4 raw[2][4];
#pragma unroll
    for (int k = 0; k < 2; ++k) {
        const int idx = tid + k * 512, cgi = idx & 7, t = t0 + (idx >> 3);
        if (conv) {
#pragma unroll
            for (int q = 0; q < 4; ++q) { const int tt = t - 2 + q; raw[k][q] = (tt >= lo && tt < hi) ? *(const u32x4*)(Pb + (size_t)tt * LDP + col0 + cgi * 8) : (u32x4){0u, 0u, 0u, 0u}; }
        } else raw[k][2] = *(const u32x4*)(Pb + (size_t)t * LDP + col0 + cgi * 8);
    }
    lds_barrier();
#pragma unroll
    for (int k = 0; k < 2; ++k) {
        const int idx = tid + k * 512, cgi = idx & 7, tl = idx >> 3;
        f32x8 acc;
        if (conv) {
            const f32x4 b0 = *(const f32x4*)(cb + cgi * 8), b1 = *(const f32x4*)(cb + cgi * 8 + 4);
            acc[0] = b0.x; acc[1] = b0.y; acc[2] = b0.z; acc[3] = b0.w; acc[4] = b1.x; acc[5] = b1.y; acc[6] = b1.z; acc[7] = b1.w;
#pragma unroll
            for (int q = 0; q < 4; ++q) {
                const f32x8 v = unpack8(raw[k][q]);
                const f32x4 w0 = *(const f32x4*)(cw + q * 1536 + cgi * 8), w1 = *(const f32x4*)(cw + q * 1536 + cgi * 8 + 4);
                acc[0] += w0.x * v[0]; acc[1] += w0.y * v[1]; acc[2] += w0.z * v[2]; acc[3] += w0.w * v[3];
                acc[4] += w1.x * v[4]; acc[5] += w1.y * v[5]; acc[6] += w1.z * v[6]; acc[7] += w1.w * v[7];
            }
#pragma unroll
            for (int e = 0; e < 8; ++e) acc[e] = siluf(acc[e]);
        } else acc = unpack8(raw[k][2]);
#pragma unroll
        for (int e = 0; e < 8; ++e) sT[(cgi * 8 + e) * 130 + tl] = f2bf(acc[e]);
    }
    lds_barrier();
#pragma unroll
    for (int k = 0; k < 2; ++k) {
        const int idx = tid + k * 512, r = idx >> 4, ck = idx & 15;
        const unsigned* sp = (const unsigned*)(sT + r * 130 + ck * 8);
        u32x4 o; o.x = sp[0]; o.y = sp[1]; o.z = sp[2]; o.w = sp[3];
        *(u32x4*)(dst + r * 128 + ck * 8) = o;
    }
}
__device__ __forceinline__ void prep_dt_item(const Params& p, int l, int item) {
    const int tid = tidx();
    const int c = item % NCH, b = item / NCH;
    const int col32 = tid >> 4, h = col32 >> 1, d = col32 & 1, lane16 = tid & 15, seg = d == 0 ? lane16 : 15 - lane16;
    const float A = -__expf(p.ssd_A_log[(l * 2 + d) * 16 + h]), bias = p.ssd_dt_bias[(l * 2 + d) * 16 + h];
    const float* src = WS_DTP(p) + ((size_t)b * TPB + c * 128) * 16 + h;
    float dtv[8], cs[8], run = 0.f;
    float rawv[8];
#pragma unroll
    for (int q = 0; q < 8; ++q) { const int j = seg * 8 + (d == 0 ? q : 7 - q); rawv[q] = src[j * 16]; }
#pragma unroll
    for (int q = 0; q < 8; ++q) { dtv[q] = softplusf(rawv[q] + bias); run += dtv[q] * A; cs[q] = run; }
    float incl = run;
#pragma unroll
    for (int off = 1; off < 16; off <<= 1) { const float v = __shfl_up(incl, off, 16); if (lane16 >= off) incl += v; }
    const float excl = incl - run;
    float* dta = WS_DTA(p) + ((size_t)(b * 18 + c) * 128) * 32 + col32;
    float* acs = WS_ACS(p) + ((size_t)(b * 18 + c) * 128) * 32 + col32;
#pragma unroll
    for (int q = 0; q < 8; ++q) { const int j = seg * 8 + (d == 0 ? q : 7 - q); dta[j * 32] = dtv[q]; acs[j * 32] = cs[q] + excl; }
    if (lane16 == 15) WS_AL(p)[((b * 2 + d) * 18 + c) * 16 + h] = incl;
}
__device__ __forceinline__ void ssd_states_item(const Params& p, int l, int item, unsigned char* shm) {
    const int tid = tidx(), lane = tid & 63, wave = tid >> 6;
    const int g = item & 1, bc = item >> 1, c = bc % NCH, b = bc / NCH;
    bf16_t* sBT = (bf16_t*)shm; bf16_t* sXw = (bf16_t*)(shm + 34816);
    float* sDt = (float*)(shm + 69632); float* sAcs = (float*)(shm + 77824); bf16_t* sO = (bf16_t*)(shm + 86016); float* sWg = (float*)(shm + 120832);
    const bf16_t* xt = WS_SXT(p) + ((size_t)((b * 18 + c) * 16 + g * 8)) * 8192;
    const bf16_t* btp = WS_SBT(p) + ((size_t)((b * 18 + c) * 2 + g)) * 16384;
    lds_barrier();
    {
        const size_t o = ((size_t)(b * 18 + c) * 128 + (tid >> 2)) * 32 + g * 16 + (tid & 3) * 4;
        const f32x4 vdt = *(const f32x4*)(WS_DTA(p) + o), vac = *(const f32x4*)(WS_ACS(p) + o);
        u32x4 bt[4];
#pragma unroll
        for (int k = 0; k < 4; ++k) { const int idx = tid + k * 512; bt[k] = *(const u32x4*)(btp + (idx >> 4) * 128 + (idx & 15) * 8); }
        *(f32x4*)(sDt + (tid >> 2) * 16 + (tid & 3) * 4) = vdt; *(f32x4*)(sAcs + (tid >> 2) * 16 + (tid & 3) * 4) = vac;
#pragma unroll
        for (int k = 0; k < 4; ++k) { const int idx = tid + k * 512; *(u32x4*)(sBT + (idx >> 4) * 136 + (idx & 15) * 8) = bt[k]; }
    }
    u32x4 xr[2];
#pragma unroll
    for (int k = 0; k < 2; ++k) { const int idx = tid + k * 512; xr[k] = *(const u32x4*)(xt + (idx >> 4) * 128 + (idx & 15) * 8); }
    lds_barrier();
#pragma unroll
    for (int k = 0; k < 4; ++k) { const int idx = tid + k * 512, jj = idx >> 4, col = idx & 15; const float al = (col & 1) == 0 ? sAcs[127 * 16 + col] : sAcs[col]; sWg[col * 128 + jj] = __expf(al - sAcs[jj * 16 + col]) * sDt[jj * 16 + col]; }
#pragma unroll 1
    for (int hh = 0; hh < 8; ++hh) {
        const int h = g * 8 + hh;
        u32x4 xn[2] = {xr[0], xr[1]};
        if (hh < 7) {
#pragma unroll
            for (int k = 0; k < 2; ++k) { const int idx = tid + k * 512; xn[k] = *(const u32x4*)(xt + (size_t)(hh + 1) * 8192 + (idx >> 4) * 128 + (idx & 15) * 8); }
        }
        lds_barrier();
#pragma unroll
        for (int k = 0; k < 2; ++k) {
            const int idx = tid + k * 512, pp = idx >> 4, j8 = (idx & 15) * 8;
            const f32x8 xv = unpack8(xr[k]);
#pragma unroll
            for (int d = 0; d < 2; ++d) {
                const f32x4 w0 = *(const f32x4*)(sWg + (hh * 2 + d) * 128 + j8), w1 = *(const f32x4*)(sWg + (hh * 2 + d) * 128 + j8 + 4);
                f32x8 o;
                o[0] = xv[0] * w0.x; o[1] = xv[1] * w0.y; o[2] = xv[2] * w0.z; o[3] = xv[3] * w0.w; o[4] = xv[4] * w1.x; o[5] = xv[5] * w1.y; o[6] = xv[6] * w1.z; o[7] = xv[7] * w1.w;
                *(u32x4*)(sXw + d * 8704 + pp * 136 + j8) = pack8(o);
            }
        }
        lds_barrier();
        const int mi = wave & 1, nj = wave >> 1;
#pragma unroll
        for (int d = 0; d < 2; ++d) {
            f32x16 acc;
#pragma unroll
            for (int r = 0; r < 16; ++r) acc[r] = 0.f;
            mm32<128>(acc, sXw + d * 8704 + mi * 32 * 136, 136, sBT + nj * 32 * 136, 136, lane);
#pragma unroll
            for (int r = 0; r < 16; ++r) sO[d * 8704 + (mi * 32 + rowmap32(r, lane)) * 136 + nj * 32 + (lane & 31)] = f2bf(acc[r]);
        }
        lds_barrier();
#pragma unroll
        for (int d = 0; d < 2; ++d) {
            bf16_t* base = WS_ST(p) + ((size_t)((b * 2 + d) * 18 + c) * 16 + h) * 8192;
#pragma unroll
            for (int k = 0; k < 2; ++k) { const int idx = tid + k * 512; *(u32x4*)(base + idx * 8) = *(const u32x4*)(sO + d * 8704 + (idx >> 4) * 136 + (idx & 15) * 8); }
        }
        xr[0] = xn[0]; xr[1] = xn[1];
    }
}
__device__ __forceinline__ void ssd_recur_item(const Params& p, int item) {
    const int tid = tidx();
    const int d = item & 1, h = (item >> 1) & 15, b = item >> 5;
    u32x4 s0[NCH], s1[NCH]; float ev[NCH];
#pragma unroll
    for (int pos = 0; pos < NCH; ++pos) {
        const int c = chunk_at(d, pos);
        const bf16_t* ptr = WS_ST(p) + ((size_t)((b * 2 + d) * 18 + c) * 16 + h) * 8192 + tid * 16;
        s0[pos] = *(const u32x4*)ptr; s1[pos] = *(const u32x4*)(ptr + 8);
        ev[pos] = WS_AL(p)[((b * 2 + d) * 18 + c) * 16 + h];
    }
    f32x8 h0, h1;
#pragma unroll
    for (int e = 0; e < 8; ++e) { h0[e] = 0.f; h1[e] = 0.f; }
#pragma unroll
    for (int pos = 0; pos < NCH; ++pos) {
        const int c = chunk_at(d, pos);
        bf16_t* ptr = WS_ST(p) + ((size_t)((b * 2 + d) * 18 + c) * 16 + h) * 8192 + tid * 16;
        *(u32x4*)ptr = pack8(h0); *(u32x4*)(ptr + 8) = pack8(h1);
        const float e = __expf(ev[pos]);
        h0 = h0 * e + unpack8(s0[pos]); h1 = h1 * e + unpack8(s1[pos]);
    }
}
template <int MODE>
__device__ __forceinline__ void ssd_final_item(const Params& p, int l, int item, unsigned char* shm) {
    const int tid = tidx(), lane = tid & 63, wave = tid >> 6;
    const int g = item & 1, bc = item >> 1, c = bc % NCH, b = bc / NCH, t0 = c * 128;
    const size_t tok0 = (size_t)b * TPB + t0;
    bf16_t* sC = (bf16_t*)shm; bf16_t* sBW = (bf16_t*)(shm + 34816); bf16_t* sXT = (bf16_t*)(shm + 69632); bf16_t* sH = (bf16_t*)(shm + 87040);
    float* sDt = (float*)(shm + 104448); float* sAcs = (float*)(shm + 112640);
    bf16_t* sY = sBW;
    const bf16_t* xt = WS_SXT(p) + ((size_t)((b * 18 + c) * 16 + g * 8)) * 8192;
    const bf16_t* zt = WS_P(p) + tok0 * LDP + C_Z + g * 512;
    const bf16_t* hin0 = WS_ST(p) + ((size_t)((b * 2 + 0) * 18 + c) * 16 + g * 8) * 8192;
    const bf16_t* hin1 = WS_ST(p) + ((size_t)((b * 2 + 1) * 18 + c) * 16 + g * 8) * 8192;
    lds_barrier();
    u32x4 xr[2], zr[2], h0r[2];
    {
        const size_t o = ((size_t)(b * 18 + c) * 128 + (tid >> 2)) * 32 + g * 16 + (tid & 3) * 4;
        const f32x4 vdt = *(const f32x4*)(WS_DTA(p) + o), vac = *(const f32x4*)(WS_ACS(p) + o);
        u32x4 cr[4], br[4];
#pragma unroll
        for (int k = 0; k < 4; ++k) { const int idx = tid + k * 512; const bf16_t* s = WS_SBC(p) + (tok0 + (idx >> 4)) * 512 + g * 128 + (idx & 15) * 8; br[k] = *(const u32x4*)s; cr[k] = *(const u32x4*)(s + 256); }
#pragma unroll
        for (int k = 0; k < 2; ++k) {
            const int idx = tid + k * 512;
            xr[k] = *(const u32x4*)(xt + (idx >> 4) * 128 + (idx & 15) * 8);
            zr[k] = *(const u32x4*)(zt + (size_t)(idx >> 3) * LDP + (idx & 7) * 8);
            h0r[k] = *(const u32x4*)(hin0 + idx * 8);
        }
        *(f32x4*)(sDt + (tid >> 2) * 16 + (tid & 3) * 4) = vdt; *(f32x4*)(sAcs + (tid >> 2) * 16 + (tid & 3) * 4) = vac;
#pragma unroll
        for (int k = 0; k < 4; ++k) { const int idx = tid + k * 512; *(u32x4*)(sC + (idx >> 4) * 136 + (idx & 15) * 8) = cr[k]; *(u32x4*)(sBW + (idx >> 4) * 136 + (idx & 15) * 8) = br[k]; }
    }
    lds_barrier();
    const int cmi = wave >> 1, cnj0 = (wave & 1) * 2;
    f32x16 cb0, cb1;
#pragma unroll
    for (int r = 0; r < 16; ++r) { cb0[r] = 0.f; cb1[r] = 0.f; }
    mm32<128>(cb0, sC + cmi * 32 * 136, 136, sBW + cnj0 * 32 * 136, 136, lane);
    mm32<128>(cb1, sC + cmi * 32 * 136, 136, sBW + (cnj0 + 1) * 32 * 136, 136, lane);
    const int ymi = wave & 3, ynj = wave >> 2;
#pragma unroll 1
    for (int hh = 0; hh < 8; ++hh) {
        const int h = g * 8 + hh;
        lds_barrier();
#pragma unroll
        for (int k = 0; k < 2; ++k) { const int idx = tid + k * 512; *(u32x4*)(sXT + (idx >> 4) * 136 + (idx & 15) * 8) = xr[k]; *(u32x4*)(sH + (idx >> 4) * 136 + (idx & 15) * 8) = h0r[k]; }
        u32x4 h1r[2];
#pragma unroll
        for (int k = 0; k < 2; ++k) h1r[k] = *(const u32x4*)(hin1 + (size_t)hh * 8192 + (tid + k * 512) * 8);
        f32x16 yacc;
#pragma unroll
        for (int r = 0; r < 16; ++r) yacc[r] = 0.f;
#pragma unroll 1
        for (int d = 0; d < 2; ++d) {
            const int col = hh * 2 + d;
            if (d == 1) {
                lds_barrier();
#pragma unroll
                for (int k = 0; k < 2; ++k) { const int idx = tid + k * 512; *(u32x4*)(sH + (idx >> 4) * 136 + (idx & 15) * 8) = h1r[k]; }
            }
            if (MODE < 2) {
                float aci[16];
#pragma unroll
                for (int r = 0; r < 16; ++r) aci[r] = sAcs[(cmi * 32 + rowmap32(r, lane)) * 16 + col];
#pragma unroll
                for (int tt = 0; tt < 2; ++tt) {
                    const int jg = (cnj0 + tt) * 32 + (lane & 31);
                    const float acj = sAcs[jg * 16 + col], dtj = sDt[jg * 16 + col];
                    const int dj0 = jg - cmi * 32 - 4 * (lane >> 5), dj = d == 0 ? dj0 : -dj0;
#pragma unroll
                    for (int r = 0; r < 16; ++r) {
                        const int ro = (r & 3) + 8 * (r >> 2);
                        const int sd = d == 0 ? dj - ro : dj + ro;
                        float arg = aci[r] - acj; arg = sd <= 0 ? arg : -INFINITY;
                        const float cbv = tt == 0 ? cb0[r] : cb1[r];
                        sBW[(cmi * 32 + rowmap32(r, lane)) * 136 + jg] = f2bf(cbv * __expf(arg) * dtj);
                    }
                }
            }
            lds_barrier();
            f32x16 ad, ao;
#pragma unroll
            for (int r = 0; r < 16; ++r) { ad[r] = 0.f; ao[r] = 0.f; }
            if (MODE < 3) { mm32<128>(ad, sBW + ymi * 32 * 136, 136, sXT + ynj * 32 * 136, 136, lane);
            mm32<128>(ao, sC + ymi * 32 * 136, 136, sH + ynj * 32 * 136, 136, lane); }
#pragma unroll
            for (int r = 0; r < 16; ++r) { const int ig = ymi * 32 + rowmap32(r, lane); yacc[r] += ad[r] + __expf(sAcs[ig * 16 + col]) * ao[r]; }
            if (d == 0 && hh < 7) {
#pragma unroll
                for (int k = 0; k < 2; ++k) {
                    const int idx = tid + k * 512;
                    xr[k] = *(const u32x4*)(xt + (size_t)(hh + 1) * 8192 + (idx >> 4) * 128 + (idx & 15) * 8);
                    h0r[k] = *(const u32x4*)(hin0 + (size_t)(hh + 1) * 8192 + idx * 8);
                }
            }
        }
        const float Dh = p.ssd_D[l * 16 + h];
        const int pl = ynj * 32 + (lane & 31);
#pragma unroll
        for (int r = 0; r < 16; ++r) { const int ig = ymi * 32 + rowmap32(r, lane); yacc[r] += Dh * bf2f(sXT[pl * 136 + ig]); }
        lds_barrier();
#pragma unroll
        for (int r = 0; r < 16; ++r) { const int ig = ymi * 32 + rowmap32(r, lane); sY[ig * 72 + pl] = f2bf(yacc[r]); }
        lds_barrier();
#pragma unroll
        for (int k = 0; k < 2; ++k) {
            const int idx = tid + k * 512, rr = idx >> 3, pk = idx & 7;
            const f32x8 yv = unpack8(*(const u32x4*)(sY + rr * 72 + pk * 8)), zv = unpack8(zr[k]);
            f32x8 o;
#pragma unroll
            for (int e = 0; e < 8; ++e) o[e] = yv[e] * siluf(zv[e]);
            if (MODE < 1) *(u32x4*)(WS_MIX(p) + (tok0 + rr) * MIXW + 2048 + h * 64 + pk * 8) = pack8(o); else asm volatile("" :: "v"(o[0]), "v"(o[7]));
        }
        if (hh < 7) {
#pragma unroll
            for (int k = 0; k < 2; ++k) { const int idx = tid + k * 512; zr[k] = *(const u32x4*)(zt + (size_t)(idx >> 3) * LDP + (hh + 1) * 64 + (idx & 7) * 8); }
        }
    }
}
__device__ __forceinline__ void ssd_norm_phase(const Params& p, int l, int G) {
    const int lane = tidx() & 63, wave = tidx() >> 6;
    for (int row = blockIdx.x * 8 + wave; row < NTOK; row += G * 8) {
        bf16_t* rp = WS_MIX(p) + (size_t)row * MIXW + 2048;
        f32x8 v0 = unpack8(*(const u32x4*)(rp + lane * 8)), v1 = unpack8(*(const u32x4*)(rp + 512 + lane * 8));
        float ss = 0.f;
#pragma unroll
        for (int e = 0; e < 8; ++e) ss += v0[e] * v0[e] + v1[e] * v1[e];
        ss = wave_sum(ss);
        const float rstd = rsqrtf(ss * (1.f / 1024.f) + 1e-6f);
        const float* nw = p.ssd_norm_w + l * 1024;
#pragma unroll
        for (int e = 0; e < 8; ++e) { v0[e] = v0[e] * rstd * nw[lane * 8 + e]; v1[e] = v1[e] * rstd * nw[512 + lane * 8 + e]; }
        *(u32x4*)(rp + lane * 8) = pack8(v0); *(u32x4*)(rp + 512 + lane * 8) = pack8(v1);
    }
}

template <int MODE>
__device__ __forceinline__ void attn_item(const Params& p, int l, int item, unsigned char* shm) {
    const int tid = tidx(), lane = tid & 63, wave = tid >> 6, fr = lane & 15, fq = lane >> 4;
    const int hq = item & 7, bq = item >> 3, qblk = bq % NCH, b = bq / NCH, kh = hq >> 2;
    const bf16_t* P = WS_P(p);
    bf16_t* sK = (bf16_t*)shm; bf16_t* sVT = (bf16_t*)(shm + 34816); bf16_t* sPw = (bf16_t*)(shm + 69632) + wave * (16 * 136);
    const size_t tokq0 = (size_t)b * TPB + qblk * 128;
    bf16x8 aq[4];
#pragma unroll
    for (int kk = 0; kk < 4; ++kk) aq[kk] = *(const bf16x8*)(P + (tokq0 + wave * 16 + fr) * LDP + C_Q + hq * 128 + kk * 32 + 8 * fq);
    float m[4], ls[4]; f32x4 O[8];
    const float sink = p.att_sink[l * 8 + hq];
#pragma unroll
    for (int r = 0; r < 4; ++r) { m[r] = sink; ls[r] = 1.f; }
#pragma unroll
    for (int nd = 0; nd < 8; ++nd) O[nd] = (f32x4){0.f, 0.f, 0.f, 0.f};
    const int nlat = qblk - 2;
    const int kb_lo = nlat - 1 < 0 ? 0 : nlat - 1, kb_hi = nlat + 1 > 15 ? 15 : nlat + 1;
    const int ntl = qblk < 2 ? 2 : 2 + (kb_hi - kb_lo + 1);
    u32x4 kr[4], vr[4];
    const bf16_t* vtb = WS_VT(p) + ((size_t)(b * 18) * 2 + kh) * 16384;
    {
        const bf16_t* kbase = P + ((size_t)b * TPB) * LDP + C_K + kh * 128;
#pragma unroll
        for (int k = 0; k < 4; ++k) { const int idx = tid + k * 512; kr[k] = *(const u32x4*)(kbase + (size_t)(idx >> 4) * LDP + (idx & 15) * 8); vr[k] = *(const u32x4*)(vtb + idx * 8); }
    }
    for (int ti = 0; ti < ntl; ++ti) {
        const bool masked = ti >= 2; const int kb = kb_lo + (ti - 2);
        lds_barrier();
#pragma unroll
        for (int k = 0; k < 4; ++k) {
            const int idx = tid + k * 512;
            *(u32x4*)(sK + (idx >> 4) * 136 + (idx & 15) * 8) = kr[k];
            *(u32x4*)(sVT + (idx >> 4) * 136 + (idx & 15) * 8) = vr[k];
        }
        if (ti + 1 < ntl) {
            const int tn = ti + 1, t0n = tn < 2 ? tn * 128 : 256 + (kb_lo + (tn - 2)) * 128;
            const bf16_t* kbase = P + ((size_t)b * TPB + t0n) * LDP + C_K + kh * 128;
            const bf16_t* vtn = vtb + (size_t)(t0n >> 7) * 32768;
#pragma unroll
            for (int k = 0; k < 4; ++k) { const int idx = tid + k * 512; kr[k] = *(const u32x4*)(kbase + (size_t)(idx >> 4) * LDP + (idx & 15) * 8); vr[k] = *(const u32x4*)(vtn + idx * 8); }
        }
        lds_barrier();
        f32x4 s[8];
#pragma unroll
        for (int nt = 0; nt < 8; ++nt) {
            s[nt] = (f32x4){0.f, 0.f, 0.f, 0.f};
#pragma unroll
            for (int kk = 0; kk < 4; ++kk) if (MODE < 4) { const bf16x8 bk = *(const bf16x8*)(sK + (nt * 16 + fr) * 136 + kk * 32 + 8 * fq); s[nt] = __builtin_amdgcn_mfma_f32_16x16x32_bf16(aq[kk], bk, s[nt], 0, 0, 0); }
        }
        if (masked) {
#pragma unroll
            for (int nt = 0; nt < 8; ++nt)
#pragma unroll
                for (int r = 0; r < 4; ++r) { const int rel = (nlat * 128 + wave * 16 + fq * 4 + r) - (kb * 128 + nt * 16 + fr); if (rel > 128 || rel < -128) s[nt][r] = -INFINITY; }
        }
        float alpha[4] = {1.f, 1.f, 1.f, 1.f};
        if (MODE < 3) {
#pragma unroll
        for (int r = 0; r < 4; ++r) {
            float mx = s[0][r];
#pragma unroll
            for (int nt = 1; nt < 8; ++nt) mx = fmaxf(mx, s[nt][r]);
            mx = fmaxf(mx, __shfl_xor(mx, 1)); mx = fmaxf(mx, __shfl_xor(mx, 2)); mx = fmaxf(mx, __shfl_xor(mx, 4)); mx = fmaxf(mx, __shfl_xor(mx, 8));
            const float mn = fmaxf(m[r], mx);
            alpha[r] = __expf(m[r] - mn); m[r] = mn;
            float rs = 0.f;
#pragma unroll
            for (int nt = 0; nt < 8; ++nt) { const float pv = __expf(s[nt][r] - mn); s[nt][r] = pv; rs += pv; }
            rs += __shfl_xor(rs, 1); rs += __shfl_xor(rs, 2); rs += __shfl_xor(rs, 4); rs += __shfl_xor(rs, 8);
            ls[r] = ls[r] * alpha[r] + rs;
        }
        }
#pragma unroll
        for (int nd = 0; nd < 8; ++nd) { O[nd].x *= alpha[0]; O[nd].y *= alpha[1]; O[nd].z *= alpha[2]; O[nd].w *= alpha[3]; }
#pragma unroll
        for (int nt = 0; nt < 8; ++nt)
#pragma unroll
            for (int r = 0; r < 4; ++r) if (MODE < 2) sPw[(fq * 4 + r) * 136 + nt * 16 + fr] = f2bf(s[nt][r]);
        asm volatile("s_waitcnt lgkmcnt(0)" ::: "memory");
#pragma unroll
        for (int kk = 0; kk < 4; ++kk) if (MODE < 2) {
            const bf16x8 ap = *(const bf16x8*)(sPw + fr * 136 + kk * 32 + 8 * fq);
#pragma unroll
            for (int nd = 0; nd < 8; ++nd) { const bf16x8 bv = *(const bf16x8*)(sVT + (nd * 16 + fr) * 136 + kk * 32 + 8 * fq); O[nd] = __builtin_amdgcn_mfma_f32_16x16x32_bf16(ap, bv, O[nd], 0, 0, 0); }
        }
    }
    u32x4 agr[4];
#pragma unroll
    for (int k = 0; k < 4; ++k) { const int idx = tid + k * 512; agr[k] = *(const u32x4*)(P + (tokq0 + (idx >> 4)) * LDP + C_AG + hq * 128 + (idx & 15) * 8); }
    lds_barrier();
#pragma unroll
    for (int r = 0; r < 4; ++r) {
        const float il = __builtin_amdgcn_rcpf(ls[r]);
#pragma unroll
        for (int nd = 0; nd < 8; ++nd) sK[(wave * 16 + fq * 4 + r) * 136 + nd * 16 + fr] = f2bf(O[nd][r] * il);
    }
    lds_barrier();
#pragma unroll
    for (int k = 0; k < 4; ++k) {
        const int idx = tid + k * 512, rr = idx >> 4, ck = idx & 15;
        const f32x8 ov = unpack8(*(const u32x4*)(sK + rr * 136 + ck * 8)), gv = unpack8(agr[k]);
        f32x8 o;
#pragma unroll
        for (int e = 0; e < 8; ++e) o[e] = ov[e] * siluf(gv[e]);
        if (MODE < 1) *(u32x4*)(WS_MIX(p) + (tokq0 + rr) * MIXW + 1024 + hq * 128 + ck * 8) = pack8(o); else asm volatile("" :: "v"(o[0]), "v"(o[7]));
    }
}


#define XB_TMO      128
#define XB_XCNT(j)  (256  + 64 * (j))
#define XB_XSUB(j)  (1280 + 64 * (j))
#define XB_XGEN(j)  (2304 + 64 * (j))
#define XB_TOP      3328
#define XB_TOPGEN   3392
#define XCD_BAR_WORDS 3456
#define XB_SPIN_CAP (1u << 18)
#define LAS __attribute__((address_space(3)))
__device__ __forceinline__ unsigned xb_ld(unsigned* p)              { return __hip_atomic_load(p, __ATOMIC_RELAXED, __HIP_MEMORY_SCOPE_AGENT); }
__device__ __forceinline__ unsigned xb_add(unsigned* p, unsigned v) { return __hip_atomic_fetch_add(p, v, __ATOMIC_RELAXED, __HIP_MEMORY_SCOPE_AGENT); }
__device__ __forceinline__ unsigned xb_xcc_id() { return (unsigned)__builtin_amdgcn_s_getreg((3 << 11) | 20) & 0xFu; }
#define XB_SPIN(cond, bar) do { unsigned _sp = 0; while (cond) { __builtin_amdgcn_s_sleep(1); \
    if ((++_sp & 255u) == 0u) { if (xb_ld(&(bar)[XB_TMO])) break; if (_sp > XB_SPIN_CAP) { atomicAdd(&(bar)[XB_TMO], 1u); break; } } } } while (0)
struct XcdBarrier { unsigned* bar; unsigned x; volatile LAS unsigned* st; };
__device__ __forceinline__ XcdBarrier xcd_barrier_post(unsigned* bar, volatile LAS unsigned* st) {
    XcdBarrier b; b.bar = bar; b.x = xb_xcc_id(); b.st = st;
    if (threadIdx.x == 0) (void)xb_add(&bar[XB_XCNT(b.x)], 1u);
    return b;
}
__device__ __forceinline__ void xcd_barrier_complete(unsigned* bar, unsigned x, unsigned& nloc, unsigned& nx) {
    const unsigned G = gridDim.x * gridDim.y * gridDim.z;
    unsigned sum, cnt, mine, sp = 0u;
    for (;;) {
        sum = 0u; cnt = 0u; mine = 0u;
#pragma unroll
        for (unsigned j = 0; j < 16; ++j) { const unsigned c = xb_ld(&bar[XB_XCNT(j)]); sum += c; cnt += (c > 0u) ? 1u : 0u; mine = (j == x) ? c : mine; }
        if (sum == G) break;
        __builtin_amdgcn_s_sleep(1);
        if ((++sp & 255u) == 0u) { if (xb_ld(&bar[XB_TMO])) break; if (sp > XB_SPIN_CAP) { atomicAdd(&bar[XB_TMO], 1u); break; } }
    }
    nloc = mine > 0u ? mine : 1u; nx = cnt > 0u ? cnt : 1u;
}
__device__ __forceinline__ void xcd_barrier(const XcdBarrier& b) {
    asm volatile("s_waitcnt vmcnt(0)" ::: "memory");
    __syncthreads();
    if (threadIdx.x == 0) {
        unsigned* bar = b.bar;
        __builtin_amdgcn_s_waitcnt(0);
        unsigned nloc = b.st[0], nx = b.st[1];
        if (nloc == 0u) { xcd_barrier_complete(bar, b.x, nloc, nx); b.st[0] = nloc; b.st[1] = nx; }
        const unsigned old = xb_add(&bar[XB_XSUB(b.x)], 1u);
        const unsigned gen = old / nloc;
        if (old + 1u == (gen + 1u) * nloc) {
            __builtin_amdgcn_fence(__ATOMIC_RELEASE, "agent");
            asm volatile("s_waitcnt vmcnt(0)" ::: "memory");
            const unsigned og = xb_add(&bar[XB_TOP], 1u);
            const unsigned tg = og / nx;
            if (og + 1u == (tg + 1u) * nx) xb_add(&bar[XB_TOPGEN], 1u);
            else XB_SPIN(xb_ld(&bar[XB_TOPGEN]) == tg, bar);
            __builtin_amdgcn_fence(__ATOMIC_ACQUIRE, "agent");
            xb_add(&bar[XB_XGEN(b.x)], 1u);
            asm volatile("s_waitcnt vmcnt(0)" ::: "memory");
        } else {
            XB_SPIN(xb_ld(&bar[XB_XGEN(b.x)]) == gen, bar);
            __builtin_amdgcn_fence(__ATOMIC_ACQUIRE, "agent");
            asm volatile("s_waitcnt vmcnt(0)" ::: "memory");
        }
    }
    __syncthreads();
}


#define QUEUE_LOOP(ctr, NITEMS, BODY) do { \
    volatile LAS unsigned* _mb = (volatile LAS unsigned*)(shm + 131072 + 8); \
    int it = bid; \
    while (it < (NITEMS)) { \
        unsigned _nx = 0u; if (threadIdx.x == 0) _nx = xb_add((ctr), 1u) + (unsigned)G; \
        BODY; \
        __syncthreads(); \
        if (threadIdx.x == 0) _mb[0] = _nx; \
        __syncthreads(); \
        it = (int)_mb[0]; \
    } } while (0)

__global__ __launch_bounds__(512) void mega(Params p) {
    extern __shared__ __attribute__((aligned(16))) unsigned char shm[];
    cg::grid_group grid = cg::this_grid();
    const int G = (int)gridDim.x, bid = (int)blockIdx.x;
    if (threadIdx.x < 4) ((volatile LAS unsigned*)(shm + 131072))[threadIdx.x] = 0u;
    __syncthreads();
    unsigned* qctr = (unsigned*)(p.ws + OFF_BAR) + 3584;
    const XcdBarrier xb = xcd_barrier_post((unsigned*)(p.ws + OFF_BAR), (volatile LAS unsigned*)(shm + 131072));
    for (int rep = 0; rep < 1 + DUP_P0; ++rep) phase0(p, shm, G);
    grid.sync();
#pragma unroll 1
    for (int l = 0; l < 4; ++l) {
        for (int rep = 0; rep < 1 + DUP_NORM; ++rep) norm_phase(p, l, G);
        xcd_barrier(xb);
        {
            pg8::Gemm g{WS_U(p), WS_WTIN(p) + (size_t)l * 7424 * 2048, NTOK, 7168, 2048};
            pg8::Order S; S.init(72, 28, G, bid, 0);
            EpiG1 E{WS_P(p)};
            for (int rep = 0; rep < 1 + DUP_G1; ++rep) pg8::gemm_phase<EpiG1, pg8::Order>((PG8_LAS unsigned char*)shm, g, S, E);
            {
                const int tq = tidx(), wave = tq >> 6, lane = tq & 63, fr = lane & 15, fq = lane >> 4;
                for (int wu = bid * 8 + wave; wu < NTOK / 16; wu += G * 8) {
                    const bf16_t* ap = WS_U(p) + (size_t)(wu * 16 + fr) * 2048 + 8 * fq;
                    const bf16_t* bp = WS_WTIN(p) + ((size_t)l * 7424 + 7168 + fr) * 2048 + 8 * fq;
                    f32x4 acc = (f32x4){0.f, 0.f, 0.f, 0.f};
#pragma unroll 8
                    for (int kk = 0; kk < 64; ++kk) { const bf16x8 a = *(const bf16x8*)(ap + kk * 32), bq = *(const bf16x8*)(bp + kk * 32); acc = __builtin_amdgcn_mfma_f32_16x16x32_bf16(a, bq, acc, 0, 0, 0); }
#pragma unroll
                    for (int r = 0; r < 4; ++r) WS_DTP(p)[(size_t)(wu * 16 + fq * 4 + r) * 16 + fr] = acc[r];
                }
            }
        }
        for (int rep = 0; rep < 1 + DUP_SYNC; ++rep) xcd_barrier(xb);
        for (int rep = 0; rep < 1 + DUP_E1; ++rep) {
            for (int it = bid; it < 144; it += G) prep_dt_item(p, l, it);
            for (int it = bid; it < 3456; it += G) prep_tile_item(p, l, it, shm);
            prep_elem(p, l, G);
        }
        { const int tq = tidx(), wave = tq >> 6, lane = tq & 63; for (int row = bid * 8 + wave; row < NTOK; row += G * 8) qkprep_row(p, l, row, lane); }
        xcd_barrier(xb);
        QUEUE_LOOP(qctr + (l * 3 + 0) * 64, 128 + 288, { if (it < 128) lru_sweep_item<0>(p, l, it, shm); else ssd_states_item(p, l, it - 128, shm); });
#if DUP_SWEEP
        __syncthreads(); for (int it = bid; it < 128; it += G) lru_sweep_item<0>(p, l, it, shm);
#endif
#if DUP_STATES
        __syncthreads(); for (int it = bid; it < 256; it += G) ssd_states_item(p, l, it, shm);
#endif
        xcd_barrier(xb);
        QUEUE_LOOP(qctr + (l * 3 + 1) * 64, 256 + 1152, { if (it < 256) ssd_recur_item(p, it); else attn_item<0>(p, l, it - 256, shm); });
#if DUP_ATTQ
        __syncthreads(); QUEUE_LOOP(qctr + (12 + l * 3 + 1) * 64, 1152, { attn_item<AMODE>(p, l, it, shm); });
#endif
        xcd_barrier(xb);
        QUEUE_LOOP(qctr + (l * 3 + 2) * 64, 128 + 288, { if (it < 128) lru_sweep_item<1>(p, l, it, shm); else ssd_final_item<0>(p, l, it - 128, shm); });
#if DUP_FINAL
        __syncthreads(); for (int it = bid; it < 256; it += G) ssd_final_item<FMODE>(p, l, it, shm);
#endif
        xcd_barrier(xb);
#ifndef SK_X4
        ssd_norm_phase(p, l, G);
#endif
        xcd_barrier(xb);
        {
            pg8::Gemm g{WS_MIX(p), WS_WTOUT(p) + (size_t)l * 2048 * 3072, NTOK, 2048, 3072};
            pg8::Order S; S.init(l == 3 ? 64 : 72, 8, G, bid, l == 3 ? 1 : 0);
            EpiG2 E{p, l};
#ifndef SK_G2
            pg8::gemm_phase<EpiG2, pg8::Order>((PG8_LAS unsigned char*)shm, g, S, E);
#endif
        }
        if (l < 3) xcd_barrier(xb);
    }
}

extern "C" void kernel_launch(void* const* d_in, const int* in_sizes, int n_in, void* d_out, int out_size, void* d_ws, size_t ws_size, hipStream_t stream) {
    static int grid = 0;
    if (grid == 0) {
        if (n_in != 25 || ws_size < WS_END) { fprintf(stderr, "kernel_launch: need 25 inputs and %zu bytes of workspace (got %d, %zu)\n", (size_t)WS_END, n_in, ws_size); grid = -1; return; }
        int dev = 0, cus = 0, per_cu = 0;
        hipGetDevice(&dev);
        hipDeviceGetAttribute(&cus, hipDeviceAttributeMultiprocessorCount, dev);
        if (hipFuncSetAttribute((const void*)mega, hipFuncAttributeMaxDynamicSharedMemorySize, LDS_BYTES) != hipSuccess) { fprintf(stderr, "kernel_launch: hipFuncSetAttribute failed\n"); grid = -1; return; }
        if (hipOccupancyMaxActiveBlocksPerMultiprocessor(&per_cu, (const void*)mega, 512, LDS_BYTES) != hipSuccess || per_cu < 1) { fprintf(stderr, "kernel_launch: occupancy query gave %d\n", per_cu); per_cu = 1; }
        (void)hipGetLastError();
        grid = cus * 1;
        if (grid <= 0) grid = 256;
    }
    if (grid < 0) return;
    Params p{};
    const float** pf = (const float**)&p;
    for (int i = 0; i < 25; ++i) pf[i] = (const float*)d_in[i];
    p.out = (float*)d_out; p.ws = (unsigned char*)d_ws;
    if (hipMemsetAsync((char*)d_ws + OFF_BAR, 0, 32768, stream) != hipSuccess) { fprintf(stderr, "kernel_launch: memset of barrier words failed\n"); return; }
    void* args[] = {&p};
    hipError_t e = hipLaunchCooperativeKernel((const void*)mega, dim3(grid), dim3(512), args, LDS_BYTES, stream);
    if (e != hipSuccess) fprintf(stderr, "cooperative launch failed: %s (grid %d)\n", hipGetErrorString(e), grid);
}
```

```cpp
#include <hip/hip_runtime.h>
#include <hip/hip_cooperative_groups.h>
#include <cstdio>
#include <cstdint>
namespace cg = cooperative_groups;
#define DUP_X1A 0
#define DUP_X1B 0
#define DUP_ATT 0
#define DUP_X3A 0
#define DUP_X3B 0
#define DUP_G1 0
#define DUP_P0 0
#define DUP_NORM 0
#define DUP_SYNC 0
#define DUP_E1 0
#define E1SEL 0
#define DUP_SWEEP 0
#define DUP_STATES 0
#define DUP_FINAL 0
#define AMODE 0
#define FMODE 0
#define DUP_X1Q 0
#define DUP_ATTQ 0
#define DUP_X3Q 0

__device__ __forceinline__ int tidx() { int t = (int)threadIdx.x; asm volatile("" : "+v"(t)); return t; }

namespace pg8 {
#define PG8_LAS __attribute__((address_space(3)))
typedef unsigned short bf16_t;
typedef short bf16x8 __attribute__((ext_vector_type(8)));
typedef float f32x4 __attribute__((ext_vector_type(4)));
typedef unsigned u32x4 __attribute__((ext_vector_type(4)));
constexpr int BM = 256, BK = 64, HALF = 128, HTB = HALF * BK * 2  , STAGE_BYTES = 8 * HTB, NXCD = 8, WGM = 8;

__host__ __device__ __forceinline__ int lds_byte(int r, int c) { const int st = (r >> 4) * 2 + (c >> 5), rr = r & 15, cc = c & 31, ob = rr * 64 + cc * 2; return st * 1024 + (ob ^ (((ob >> 9) & 1) << 5)); }
__host__ __device__ __forceinline__ void stage_rc(int b, int& R, int& C) { const int st = b / 1024, sb = b % 1024, swz = sb ^ (((sb >> 9) & 1) << 5); R = (st >> 1) * 16 + swz / 64; C = (st & 1) * 32 + (swz % 64) / 2; }
__host__ __device__ __forceinline__ int perm32(int rho) { const int n = rho >> 4, i = rho & 15; return 8 * (i >> 2) + 4 * n + (i & 3); }

struct Unit { int pm, pn; };
struct Gemm { const bf16_t* A; const bf16_t* Bt; int M, N, K; };

struct Order {
    int nM, nN, nwg, G, c, skipctx;
    __device__ void init(int nM_, int nN_, int G_, int c_, int skip_) { nM = nM_; nN = nN_; nwg = nM * nN; G = G_; c = c_; skipctx = skip_; }
    __device__ bool next(int i, Unit& u) const {
        const long L = (long)i * G + c; if (L >= nwg) return false;
        int wgid = (int)L; { const int q = nwg / NXCD, r = nwg % NXCD, xcd = wgid % NXCD, off = wgid / NXCD; wgid = (xcd < r ? xcd * (q + 1) : r * (q + 1) + (xcd - r) * q) + off; }
        const int nig = WGM * nN, gid = wgid / nig, fm = gid * WGM, gsz = (nM - fm) < WGM ? (nM - fm) : WGM;
        int pm = fm + ((wgid % nig) % gsz); u.pn = (wgid % nig) / gsz;
        if (skipctx) pm = (pm >> 3) * 9 + 1 + (pm & 7);
        u.pm = pm; return true;
    }
    __device__ __forceinline__ void a_ready(const Unit&) const {}
    __device__ __forceinline__ void done(const Unit&) const {}
};
typedef __bf16 bf16x2_t __attribute__((ext_vector_type(2)));
typedef float f32x2_t __attribute__((ext_vector_type(2)));
__device__ __forceinline__ unsigned cvt_pk_bf16(float lo, float hi) { f32x2_t v = {lo, hi}; bf16x2_t b = __builtin_convertvector(v, bf16x2_t); return __builtin_bit_cast(unsigned, b); }

template <class Epi, class Sched>
__device__ __forceinline__ void gemm_phase(PG8_LAS unsigned char* lds, const Gemm g, const Sched& S, const Epi& E) {
    const int tid = tidx(), wid = __builtin_amdgcn_readfirstlane(tid >> 6), lane = tid & 63, wr = wid >> 2, wc = wid & 3, fr = lane & 15, fq = lane >> 4;
    const int K = g.K, nt = K / BK;
    unsigned voffA[2], voffB[2];
#pragma unroll
    for (int i = 0; i < 2; ++i) { int R, C; stage_rc(tid * 16 + i * 8192, R, C); const int Rb = Epi::PERM ? ((R & ~31) + perm32(R & 31)) : R;
        voffA[i] = (unsigned)(R * K + C) * 2u; voffB[i] = (unsigned)(Rb * K + C) * 2u; }
    const size_t kstep = (size_t)(BK * 2);
    const size_t hstep = (size_t)HALF * K * 2;
    const size_t tstep = 2 * hstep;
    const unsigned ldsw = (unsigned)wid * 1024u;
    const int aoff = lds_byte(wr * 64 + fr, fq * 8), boff = lds_byte(wc * 32 + fr, fq * 8);
#define PG8_SA(b, h) (((b) * 2 + (h)) * HTB)
#define PG8_SB(b, h) ((4 + (b) * 2 + (h)) * HTB)
#define PG8_STAGE(bufoff, gbase, voff) do { _Pragma("unroll") for (int _i = 0; _i < 2; ++_i) \
        __builtin_amdgcn_global_load_lds((const unsigned*)((const char*)(gbase) + (voff)[_i]), (PG8_LAS unsigned*)(lds + (bufoff) + ldsw + _i * 8192), 16, 0, 0); } while (0)
#define PG8_LDA(dst, b, h) do { _Pragma("unroll") for (int m = 0; m < 4; ++m) _Pragma("unroll") for (int k = 0; k < 2; ++k) dst[m][k] = *(const PG8_LAS bf16x8*)(lds + PG8_SA(b, h) + aoff + m * 2048 + k * 1024); } while (0)
#define PG8_LDB(dst, b, h) do { _Pragma("unroll") for (int n = 0; n < 2; ++n) _Pragma("unroll") for (int k = 0; k < 2; ++k) dst[n][k] = *(const PG8_LAS bf16x8*)(lds + PG8_SB(b, h) + boff + n * 2048 + k * 1024); } while (0)
#define PG8_MMA(ai, bj, At, Bt) do { __builtin_amdgcn_s_setprio(1); _Pragma("unroll") for (int m = 0; m < 4; ++m) _Pragma("unroll") for (int n = 0; n < 2; ++n) _Pragma("unroll") for (int k = 0; k < 2; ++k) \
        acc[ai][bj][m][n] = __builtin_amdgcn_mfma_f32_16x16x32_bf16(Bt[n][k], At[m][k], acc[ai][bj][m][n], 0, 0, 0); __builtin_amdgcn_s_setprio(0); } while (0)
#define PG8_WAIT_V(n) asm volatile("s_waitcnt vmcnt(" #n ")" ::: "memory")
#define PG8_WAIT_L(n) asm volatile("s_waitcnt lgkmcnt(" #n ")" ::: "memory")
#define PG8_BAR __builtin_amdgcn_s_barrier()
#define PG8_SCHED __builtin_amdgcn_sched_barrier(0)
    Unit cur, nxt; int ui = 0;
    if (!S.next(0, cur)) return;
    f32x4 acc[2][2][4][2];
#pragma unroll
    for (int a = 0; a < 2; ++a)
#pragma unroll
        for (int b = 0; b < 2; ++b)
#pragma unroll
            for (int m = 0; m < 4; ++m)
#pragma unroll
                for (int n = 0; n < 2; ++n) acc[a][b][m][n] = (f32x4){0.f, 0.f, 0.f, 0.f};
    bf16x8 At[4][2], B0[2][2], B1[2][2];
    const char* cA = (const char*)g.A + (size_t)cur.pm * tstep; const char* cB = (const char*)g.Bt + (size_t)cur.pn * tstep;
    S.a_ready(cur);
    PG8_STAGE(PG8_SB(0, 0), cB, voffB); PG8_STAGE(PG8_SA(0, 0), cA, voffA); PG8_STAGE(PG8_SB(0, 1), cB + hstep, voffB); PG8_STAGE(PG8_SA(0, 1), cA + hstep, voffA);
    if (wr == 1) PG8_BAR;
    PG8_WAIT_V(4); PG8_BAR;
    PG8_STAGE(PG8_SB(1, 0), cB + kstep, voffB); PG8_STAGE(PG8_SA(1, 0), cA + kstep, voffA); PG8_STAGE(PG8_SB(1, 1), cB + hstep + kstep, voffB);
    PG8_WAIT_V(6); PG8_BAR;
    for (;;) {
        const bool has_next = S.next(ui + 1, nxt);
        const char* nA = has_next ? (const char*)g.A + (size_t)nxt.pm * tstep : cA; const char* nB = has_next ? (const char*)g.Bt + (size_t)nxt.pn * tstep : cB;
        for (int t = 0; t < nt; t += 2) {
            const bool last = (t == nt - 2);
            const char* a1 = cA + (size_t)(t + 1) * kstep;
            const char* a2 = last ? nA : cA + (size_t)(t + 2) * kstep; const char* b2 = last ? nB : cB + (size_t)(t + 2) * kstep;
            const char* a3 = a2 + kstep; const char* b3 = b2 + kstep;
            if (last && has_next) S.a_ready(nxt);
            PG8_LDB(B0, 0, 0); PG8_SCHED; PG8_LDA(At, 0, 0); PG8_STAGE(PG8_SA(1, 1), a1 + hstep, voffA);
            PG8_WAIT_L(8); PG8_BAR; PG8_WAIT_L(0); PG8_MMA(0, 0, At, B0); PG8_BAR; PG8_SCHED;
            PG8_LDB(B1, 0, 1); PG8_STAGE(PG8_SB(0, 0), b2, voffB);
            PG8_BAR; PG8_WAIT_L(0); PG8_MMA(0, 1, At, B1); PG8_BAR;
            PG8_LDA(At, 0, 1); PG8_STAGE(PG8_SA(0, 0), a2, voffA);
            PG8_BAR; PG8_WAIT_L(0); PG8_MMA(1, 0, At, B0); PG8_BAR; PG8_SCHED;
            PG8_STAGE(PG8_SB(0, 1), b2 + hstep, voffB);
            PG8_WAIT_V(6); PG8_BAR; PG8_MMA(1, 1, At, B1); PG8_BAR;
            PG8_LDB(B0, 1, 0); PG8_SCHED; PG8_LDA(At, 1, 0); PG8_STAGE(PG8_SA(0, 1), a2 + hstep, voffA);
            PG8_WAIT_L(8); PG8_BAR; PG8_WAIT_L(0); PG8_MMA(0, 0, At, B0); PG8_BAR; PG8_SCHED;
            PG8_LDB(B1, 1, 1); PG8_STAGE(PG8_SB(1, 0), b3, voffB);
            PG8_BAR; PG8_WAIT_L(0); PG8_MMA(0, 1, At, B1); PG8_BAR;
            PG8_LDA(At, 1, 1); PG8_STAGE(PG8_SA(1, 0), a3, voffA);
            PG8_BAR; PG8_WAIT_L(0); PG8_MMA(1, 0, At, B0); PG8_BAR; PG8_SCHED;
            PG8_STAGE(PG8_SB(1, 1), b3 + hstep, voffB);
            PG8_WAIT_V(6); PG8_BAR; PG8_MMA(1, 1, At, B1); PG8_BAR;
        }
        if constexpr (!Epi::AFTER_DRAIN) { E(acc, cur, wr, wc, fr, fq); S.done(cur); }
        if (!has_next) break;
#pragma unroll
        for (int a = 0; a < 2; ++a)
#pragma unroll
            for (int b = 0; b < 2; ++b)
#pragma unroll
                for (int m = 0; m < 4; ++m)
#pragma unroll
                    for (int n = 0; n < 2; ++n) acc[a][b][m][n] = (f32x4){0.f, 0.f, 0.f, 0.f};
        cur = nxt; cA = nA; cB = nB; ++ui;
    }
    PG8_WAIT_V(0);
    if (wr == 0) PG8_BAR;
    PG8_BAR;
    if constexpr (Epi::AFTER_DRAIN) { E.fused(acc, cur, wr, wc, fr, fq, lds, wid, lane); S.done(cur); }
#undef PG8_SA
#undef PG8_SB
#undef PG8_STAGE
#undef PG8_LDA
#undef PG8_LDB
#undef PG8_MMA
#undef PG8_WAIT_V
#undef PG8_WAIT_L
#undef PG8_BAR
#undef PG8_SCHED
}
}

using pg8::bf16_t; using pg8::bf16x8; using pg8::f32x4; using pg8::cvt_pk_bf16;
typedef float f32x16 __attribute__((ext_vector_type(16)));
typedef float f32x8 __attribute__((ext_vector_type(8)));
typedef unsigned u32x2 __attribute__((ext_vector_type(2)));
typedef unsigned u32x4 __attribute__((ext_vector_type(4)));

constexpr int DM = 2048, TPB = 2304, NTOK = 18432, LDP = 7424, MIXW = 3072, NCH = 18;
constexpr int C_LX = 0, C_LG = 1024, C_Q = 2048, C_K = 3072, C_V = 3328, C_AG = 3584, C_XBC = 4608, C_Z = 6144, C_DT = 7168;
constexpr size_t SZ_WTIN = (size_t)4 * 7424 * 2048 * 2, SZ_WTOUT = (size_t)4 * 2048 * 3072 * 2, SZ_MOD = (size_t)4 * 9 * 6144 * 4, SZ_U = (size_t)NTOK * 2048 * 2,
                 SZ_P = (size_t)NTOK * LDP * 2, SZ_MIX = (size_t)NTOK * MIXW * 2, SZ_XB = (size_t)NTOK * 2048 * 4, SZ_ST = (size_t)8 * 2 * 18 * 16 * 8192 * 2,
                 SZ_AL = (size_t)8 * 2 * 18 * 16 * 4, SZ_SUM = (size_t)8 * 2 * 18 * 1024 * 4;
constexpr size_t OFF_WTIN = 0, OFF_WTOUT = OFF_WTIN + SZ_WTIN, OFF_MOD = OFF_WTOUT + SZ_WTOUT, OFF_U = OFF_MOD + SZ_MOD, OFF_P = OFF_U + SZ_U, OFF_MIX = OFF_P + SZ_P,
                 OFF_XB = OFF_MIX + SZ_MIX, OFF_ST = OFF_XB + SZ_XB, OFF_AL = OFF_ST + SZ_ST, OFF_SUMA = OFF_AL + SZ_AL, OFF_SUMB = OFF_SUMA + SZ_SUM, OFF_BAR = OFF_SUMB + SZ_SUM, OFF_SBC = OFF_BAR + 32768, OFF_SBT = OFF_SBC + (size_t)NTOK * 512 * 2, OFF_DTA = OFF_SBT + (size_t)8 * 18 * 2 * 16384 * 2,
                 OFF_ACS = OFF_DTA + (size_t)NTOK * 32 * 4, OFF_HINL = OFF_ACS + (size_t)NTOK * 32 * 4, OFF_GW = OFF_HINL + SZ_SUM, OFF_DTP = OFF_GW + (size_t)4 * 16 * 16384 * 2, OFF_VT = OFF_DTP + (size_t)NTOK * 16 * 4, WS_END = OFF_VT + (size_t)8 * 18 * 2 * 16384 * 2;
constexpr size_t OFF_LXC = OFF_U, OFF_SXT = OFF_U + (size_t)NTOK * 1024 * 2;
constexpr int LDS_CTL = 147456;
constexpr int LDS_BYTES = LDS_CTL + 16;

struct Params {
    const float *x, *c, *ctx, *c_ctx, *norm_w, *ada_w, *ada_b, *w_in, *lru_conv_w, *lru_conv_b, *lru_ga_w, *lru_ga_b, *lru_gx_w, *lru_gx_b, *lru_lambda,
        *att_q_norm, *att_k_norm, *att_sink, *ssd_conv_w, *ssd_conv_b, *ssd_dt_bias, *ssd_A_log, *ssd_D, *ssd_norm_w, *w_out;
    float* out;
    unsigned char* ws;
};
#define WS_WTIN(p) ((bf16_t*)((p).ws + OFF_WTIN))
#define WS_WTOUT(p) ((bf16_t*)((p).ws + OFF_WTOUT))
#define WS_MOD(p) ((float*)((p).ws + OFF_MOD))
#define WS_U(p) ((bf16_t*)((p).ws + OFF_U))
#define WS_P(p) ((bf16_t*)((p).ws + OFF_P))
#define WS_MIX(p) ((bf16_t*)((p).ws + OFF_MIX))
#define WS_XB(p) ((float*)((p).ws + OFF_XB))
#define WS_ST(p) ((bf16_t*)((p).ws + OFF_ST))
#define WS_AL(p) ((float*)((p).ws + OFF_AL))
#define WS_SUMA(p) ((float*)((p).ws + OFF_SUMA))
#define WS_SUMB(p) ((float*)((p).ws + OFF_SUMB))
#define WS_LXC(p) ((bf16_t*)((p).ws + OFF_LXC))
#define WS_SXT(p) ((bf16_t*)((p).ws + OFF_SXT))
#define WS_SBC(p) ((bf16_t*)((p).ws + OFF_SBC))
#define WS_SBT(p) ((bf16_t*)((p).ws + OFF_SBT))
#define WS_DTA(p) ((float*)((p).ws + OFF_DTA))
#define WS_ACS(p) ((float*)((p).ws + OFF_ACS))
#define WS_HINL(p) ((float*)((p).ws + OFF_HINL))
#define WS_GW(p) ((bf16_t*)((p).ws + OFF_GW))
#define WS_DTP(p) ((float*)((p).ws + OFF_DTP))
#define WS_VT(p) ((bf16_t*)((p).ws + OFF_VT))

__device__ __forceinline__ float bf2f(bf16_t v) { return __uint_as_float(((unsigned)v) << 16); }
__device__ __forceinline__ bf16_t f2bf(float f) { return (bf16_t)(cvt_pk_bf16(f, 0.f) & 0xffffu); }
__device__ __forceinline__ float siluf(float v) { return v * __builtin_amdgcn_rcpf(1.f + __expf(-v)); }
__device__ __forceinline__ float sigmf(float v) { return __builtin_amdgcn_rcpf(1.f + __expf(-v)); }
__device__ __forceinline__ float softplusf(float v) { return v > 20.f ? v : log1pf(__expf(v)); }
__device__ __forceinline__ float wave_sum(float v) {
#pragma unroll
    for (int o = 1; o < 64; o <<= 1) v += __shfl_xor(v, o);
    return v;
}
__device__ __forceinline__ f32x8 unpack8(const u32x4 w) {
    f32x8 f;
    f[0] = __uint_as_float(w.x << 16); f[1] = __uint_as_float(w.x & 0xffff0000u); f[2] = __uint_as_float(w.y << 16); f[3] = __uint_as_float(w.y & 0xffff0000u);
    f[4] = __uint_as_float(w.z << 16); f[5] = __uint_as_float(w.z & 0xffff0000u); f[6] = __uint_as_float(w.w << 16); f[7] = __uint_as_float(w.w & 0xffff0000u);
    return f;
}
__device__ __forceinline__ u32x4 pack8(const f32x8 f) { u32x4 w; w.x = cvt_pk_bf16(f[0], f[1]); w.y = cvt_pk_bf16(f[2], f[3]); w.z = cvt_pk_bf16(f[4], f[5]); w.w = cvt_pk_bf16(f[6], f[7]); return w; }
__device__ __forceinline__ void lds_barrier() { asm volatile("s_waitcnt lgkmcnt(0)" ::: "memory"); __builtin_amdgcn_s_barrier(); asm volatile("" ::: "memory"); }
__device__ __forceinline__ float dpp_f(float v, int ctrl_sel) {
    const int x = __builtin_bit_cast(int, v); int r;
    if (ctrl_sel == 0) r = __builtin_amdgcn_update_dpp(x, x, 0xB1, 0xF, 0xF, false);
    else if (ctrl_sel == 1) r = __builtin_amdgcn_update_dpp(x, x, 0x4E, 0xF, 0xF, false);
    else if (ctrl_sel == 2) r = __builtin_amdgcn_update_dpp(x, x, 0x141, 0xF, 0xF, false);
    else r = __builtin_amdgcn_update_dpp(x, x, 0x140, 0xF, 0xF, false);
    return __builtin_bit_cast(float, r);
}
__device__ __forceinline__ float row16_max(float v) { v = fmaxf(v, dpp_f(v, 0)); v = fmaxf(v, dpp_f(v, 1)); v = fmaxf(v, dpp_f(v, 2)); v = fmaxf(v, dpp_f(v, 3)); return v; }
__device__ __forceinline__ float row16_sum(float v) { v += dpp_f(v, 0); v += dpp_f(v, 1); v += dpp_f(v, 2); v += dpp_f(v, 3); return v; }
__device__ __forceinline__ int chunk_at(int d, int pos) { return d == 0 ? pos : (pos < 2 ? 1 - pos : 19 - pos); }
__device__ __forceinline__ int pos_of(int d, int c) { return d == 0 ? c : (c < 2 ? 1 - c : 19 - c); }
__device__ __forceinline__ int rowmap32(int reg, int lane) { return (reg & 3) + 8 * (reg >> 2) + 4 * (lane >> 5); }

template <int K> __device__ __forceinline__ void mm32(f32x16& acc, const bf16_t* A, int lda, const bf16_t* B, int ldb, int lane) {
    const bf16_t* pa = A + (lane & 31) * lda + 8 * (lane >> 5);
    const bf16_t* pb = B + (lane & 31) * ldb + 8 * (lane >> 5);
#pragma unroll
    for (int k = 0; k < K; k += 16) {
        const bf16x8 a = *(const bf16x8*)(pa + k);
        const bf16x8 b = *(const bf16x8*)(pb + k);
        acc = __builtin_amdgcn_mfma_f32_32x32x16_bf16(a, b, acc, 0, 0, 0);
    }
}

template <int NC, bool SILU, bool TRANS>
__device__ __forceinline__ void stage_conv_tile(bf16_t* dst, int ld, const bf16_t* Pb, int t0, int col0, const float* cw, int CS, const float* cb, int tid) {
    constexpr int CG = NC / 8;
    const int lo = t0 < 256 ? 0 : 256, hi = t0 < 256 ? 256 : TPB;
    for (int idx = tid; idx < 128 * CG; idx += 512) {
        int cgi, tl;
        if (TRANS) { tl = idx & 127; cgi = idx >> 7; } else { cgi = idx % CG; tl = idx / CG; }
        const int t = t0 + tl;
        const f32x4 b0 = *(const f32x4*)(cb + cgi * 8), b1 = *(const f32x4*)(cb + cgi * 8 + 4);
        f32x8 acc; acc[0] = b0.x; acc[1] = b0.y; acc[2] = b0.z; acc[3] = b0.w; acc[4] = b1.x; acc[5] = b1.y; acc[6] = b1.z; acc[7] = b1.w;
#pragma unroll
        for (int k = 0; k < 4; ++k) {
            const int tt = t - 2 + k;
            if (tt >= lo && tt < hi) {
                const f32x8 v = unpack8(*(const u32x4*)(Pb + (size_t)tt * LDP + col0 + cgi * 8));
                const f32x4 w0 = *(const f32x4*)(cw + k * CS + cgi * 8), w1 = *(const f32x4*)(cw + k * CS + cgi * 8 + 4);
                acc[0] += w0.x * v[0]; acc[1] += w0.y * v[1]; acc[2] += w0.z * v[2]; acc[3] += w0.w * v[3];
                acc[4] += w1.x * v[4]; acc[5] += w1.y * v[5]; acc[6] += w1.z * v[6]; acc[7] += w1.w * v[7];
            }
        }
        if (SILU) {
#pragma unroll
            for (int e = 0; e < 8; ++e) acc[e] = siluf(acc[e]);
        }
        if (TRANS) {
#pragma unroll
            for (int e = 0; e < 8; ++e) dst[(cgi * 8 + e) * ld + tl] = f2bf(acc[e]);
        } else {
            *(u32x4*)(dst + tl * ld + cgi * 8) = pack8(acc);
        }
    }
}

__device__ __forceinline__ void transpose_item(const float* W, int K, int N, int nblk, bf16_t* WT, float* scr, int item, int lane) {
    const int kb = item / nblk, nb = item % nblk, k0 = 64 * kb, n0 = 32 * nb;
    const int c4 = lane & 7, r8 = lane >> 3, n = n0 + c4 * 4;
    f32x4 tv[8];
#pragma unroll
    for (int i = 0; i < 8; ++i) tv[i] = (n < N) ? *(const f32x4*)(W + (size_t)(k0 + i * 8 + r8) * N + n) : (f32x4){0.f, 0.f, 0.f, 0.f};
#pragma unroll
    for (int i = 0; i < 8; ++i) { float* d = scr + (i * 8 + r8) * 33 + c4 * 4; d[0] = tv[i].x; d[1] = tv[i].y; d[2] = tv[i].z; d[3] = tv[i].w; }
    asm volatile("s_waitcnt lgkmcnt(0)" ::: "memory");
    const int c = lane & 7;
#pragma unroll
    for (int j = 0; j < 4; ++j) {
        const int nn = (lane >> 3) + 8 * j; const float* s = scr + (8 * c) * 33 + nn;
        u32x4 o; o.x = cvt_pk_bf16(s[0 * 33], s[1 * 33]); o.y = cvt_pk_bf16(s[2 * 33], s[3 * 33]); o.z = cvt_pk_bf16(s[4 * 33], s[5 * 33]); o.w = cvt_pk_bf16(s[6 * 33], s[7 * 33]);
        *(u32x4*)(WT + (size_t)(n0 + nn) * K + k0 + 8 * c) = o;
    }
    asm volatile("s_waitcnt lgkmcnt(0)" ::: "memory");
}

__device__ __forceinline__ void phase0(const Params& p, unsigned char* shm, int G) {
    const int tid = tidx(), lane = tid & 63, wave = tid >> 6;
    float* sf = (float*)shm;
    float* MOD = WS_MOD(p);
    for (int item = blockIdx.x; item < 96; item += G) {
        const int l = item / 24, cgp = item % 24;
        __syncthreads();
        for (int idx = tid; idx < 9 * 2048; idx += 512) { const int r = idx >> 11, k = idx & 2047; const float v = r < 8 ? p.c[r * 2048 + k] : p.c_ctx[k]; sf[idx] = siluf(v); }
        __syncthreads();
        f32x4 acc[9];
#pragma unroll
        for (int r = 0; r < 9; ++r) acc[r] = (f32x4){0.f, 0.f, 0.f, 0.f};
        const float* wp = p.ada_w + ((size_t)l * 2048 + wave * 256) * 6144 + cgp * 256 + lane * 4;
#pragma unroll 16
        for (int kk = 0; kk < 256; ++kk) {
            const f32x4 wv = *(const f32x4*)(wp + (size_t)kk * 6144);
            const int k = wave * 256 + kk;
#pragma unroll
            for (int r = 0; r < 9; ++r) { const float s = sf[r * 2048 + k]; acc[r] += wv * s; }
        }
        __syncthreads();
#pragma unroll
        for (int r = 0; r < 9; ++r) *(f32x4*)(sf + (wave * 9 + r) * 256 + lane * 4) = acc[r];
        __syncthreads();
        for (int idx = tid; idx < 9 * 256; idx += 512) {
            const int r = idx >> 8, col = idx & 255; float s = p.ada_b[l * 6144 + cgp * 256 + col];
#pragma unroll
            for (int w = 0; w < 8; ++w) s += sf[(w * 9 + r) * 256 + col];
            MOD[(size_t)(l * 9 + r) * 6144 + cgp * 256 + col] = s;
        }
    }
    __syncthreads();
    float* scr = sf + wave * (64 * 33);
    const int gw = blockIdx.x * 8 + wave, NGW = G * 8;
    constexpr int I_IN = 32 * 232, I_OUT = 48 * 64;
    for (int it = gw; it < 4 * (I_IN + I_OUT); it += NGW) {
        if (it < 4 * I_IN) { const int l = it / I_IN, r = it % I_IN; transpose_item(p.w_in + (size_t)l * 2048 * 7184, 2048, 7184, 232, WS_WTIN(p) + (size_t)l * 7424 * 2048, scr, r, lane); }
        else { const int it2 = it - 4 * I_IN, l = it2 / I_OUT, r = it2 % I_OUT; transpose_item(p.w_out + (size_t)l * 3072 * 2048, 3072, 2048, 64, WS_WTOUT(p) + (size_t)l * 2048 * 3072, scr, r, lane); }
    }
    for (int idx = (int)blockIdx.x * 512 + tid; idx < 4 * 16 * 16384; idx += G * 512) {
        const int i = idx & 63, o = (idx >> 6) & 63, gate = (idx >> 12) & 1, d = (idx >> 13) & 1, j = (idx >> 14) & 15, l = idx >> 18;
        const float* w = gate ? p.lru_gx_w : p.lru_ga_w;
        WS_GW(p)[idx] = f2bf(w[(size_t)((l * 2 + d) * 16 + j) * 4096 + i * 64 + o]);
    }
}

__device__ __forceinline__ const float* xrow_src(const Params& p, int l, int row) {
    const int b = row / TPB, t = row % TPB;
    if (l == 0) return t < 256 ? p.ctx + ((size_t)b * 256 + t) * DM : p.x + ((size_t)b * 2048 + (t - 256)) * DM;
    return WS_XB(p) + (size_t)row * DM;
}
__device__ __forceinline__ void norm_phase(const Params& p, int l, int G) {
    const int lane = tidx() & 63, wave = tidx() >> 6;
    bf16_t* U = WS_U(p);
    for (int row = blockIdx.x * 8 + wave; row < NTOK; row += G * 8) {
        const int b = row / TPB, t = row % TPB;
        const float* src = xrow_src(p, l, row);
        const float* md = WS_MOD(p) + (size_t)(l * 9 + (t < 256 ? 8 : b)) * 6144;
        f32x4 v[8]; float ss = 0.f;
#pragma unroll
        for (int j = 0; j < 8; ++j) { v[j] = *(const f32x4*)(src + 4 * lane + 256 * j); ss += v[j].x * v[j].x + v[j].y * v[j].y + v[j].z * v[j].z + v[j].w * v[j].w; }
        ss = wave_sum(ss);
        const float rstd = rsqrtf(ss * (1.f / 2048.f) + 1e-6f);
#pragma unroll
        for (int j = 0; j < 8; ++j) {
            const int col = 4 * lane + 256 * j;
            const f32x4 nw = *(const f32x4*)(p.norm_w + l * 2048 + col), sh = *(const f32x4*)(md + col), sc = *(const f32x4*)(md + 2048 + col);
            const f32x4 y = v[j] * rstd * nw * (sc + 1.f) + sh;
            u32x2 w; w.x = cvt_pk_bf16(y.x, y.y); w.y = cvt_pk_bf16(y.z, y.w);
            *(u32x2*)(U + (size_t)row * DM + col) = w;
        }
    }
}

struct EpiG1 {
    static constexpr bool PERM = false, AFTER_DRAIN = false;
    bf16_t* P;
    __device__ __forceinline__ void operator()(const f32x4 (&acc)[2][2][4][2], const pg8::Unit& u, int wr, int wc, int fr, int fq) const {
        const int row0 = u.pm * 256 + wr * 64 + fr, col0 = u.pn * 256 + wc * 32 + 4 * fq;
#pragma unroll
        for (int ai = 0; ai < 2; ++ai)
#pragma unroll
            for (int m = 0; m < 4; ++m) { bf16_t* rowp = P + (size_t)(row0 + ai * 128 + m * 16) * LDP + col0;
#pragma unroll
                for (int bj = 0; bj < 2; ++bj)
#pragma unroll
                    for (int n = 0; n < 2; ++n) { const f32x4 v = acc[ai][bj][m][n]; u32x2 w; w.x = cvt_pk_bf16(v.x, v.y); w.y = cvt_pk_bf16(v.z, v.w); *(u32x2*)(rowp + bj * 128 + n * 16) = w; } }
    }
};
struct EpiG2 {
    static constexpr bool PERM = false, AFTER_DRAIN = false;
    Params p; int l;
    __device__ __forceinline__ void operator()(const f32x4 (&acc)[2][2][4][2], const pg8::Unit& u, int wr, int wc, int fr, int fq) const {
        const int row0 = u.pm * 256 + wr * 64 + fr, col0 = u.pn * 256 + wc * 32 + 4 * fq;
#pragma unroll
        for (int ai = 0; ai < 2; ++ai)
#pragma unroll
            for (int m = 0; m < 4; ++m) {
                const int row = row0 + ai * 128 + m * 16, b = row / TPB, t = row % TPB;
                if (l == 3 && t < 256) continue;
                const float* xo = xrow_src(p, l, row);
                float* dst = (l == 3) ? p.out + ((size_t)b * 2048 + (t - 256)) * DM : WS_XB(p) + (size_t)row * DM;
                const float* gt = WS_MOD(p) + (size_t)(l * 9 + (t < 256 ? 8 : b)) * 6144 + 4096;
#pragma unroll
                for (int bj = 0; bj < 2; ++bj)
#pragma unroll
                    for (int n = 0; n < 2; ++n) { const int col = col0 + bj * 128 + n * 16; const f32x4 xv = *(const f32x4*)(xo + col), g = *(const f32x4*)(gt + col); *(f32x4*)(dst + col) = xv + g * acc[ai][bj][m][n]; }
            }
    }
};

__device__ __forceinline__ void qkprep_row(const Params& p, int l, int row, int lane) {
    const int t = row % TPB;
    bf16_t* rp = WS_P(p) + (size_t)row * LDP;
    float cs = 1.f, sn = 0.f;
    if (t >= 256) {
        const int s = t - 256, rr = s >> 6, cc = s & 63, f = lane & 31;
        const float inv = exp2f(-(float)f * (13.287712379549449f / 32.f));
        const float ang = (float)(lane < 32 ? rr : cc) * inv;
        cs = __cosf(ang); sn = __sinf(ang);
    }
#pragma unroll
    for (int slot = 0; slot < 10; ++slot) {
        const int col = slot < 8 ? C_Q + slot * 128 : C_K + (slot - 8) * 128;
        const float* w = slot < 8 ? p.att_q_norm + l * 128 : p.att_k_norm + l * 128;
        const float v1 = bf2f(rp[col + lane]), v2 = bf2f(rp[col + 64 + lane]);
        const float ss = wave_sum(v1 * v1 + v2 * v2);
        const float rstd = rsqrtf(ss * (1.f / 128.f) + 1e-6f);
        const float y1 = v1 * rstd * w[lane], y2 = v2 * rstd * w[64 + lane];
        float o1 = y1 * cs - y2 * sn, o2 = y1 * sn + y2 * cs;
        if (slot < 8) { o1 *= 0.08838834764831845f; o2 *= 0.08838834764831845f; }
        rp[col + lane] = f2bf(o1); rp[col + 64 + lane] = f2bf(o2);
    }
}

template <int D>
__device__ __forceinline__ void lru_sweep_item(const Params& p, int l, int item, unsigned char* shm) {
    const int tid = tidx(), lane = tid & 63, wave = tid >> 6, ch = tid & 63, seg = tid >> 6;
    const int j = item & 15, b = item >> 4;
    bf16_t* sX = (bf16_t*)shm; bf16_t* sW = (bf16_t*)(shm + 18432);
    float* sA = (float*)(shm + 36864); float* sB = (float*)(shm + 69632); float* sSA = (float*)(shm + 102400); float* sSB = (float*)(shm + 104448);
    bf16_t* sOut = (bf16_t*)(shm + 106496);
    const int mi = wave & 3, nj = wave >> 2, cl = nj * 32 + (lane & 31), cgl = j * 64 + cl;
    const float ba = p.lru_ga_b[(l * 2 + D) * 1024 + cgl], bx = p.lru_gx_b[(l * 2 + D) * 1024 + cgl], sp = softplusf(-p.lru_lambda[(l * 2 + D) * 1024 + cgl]);
    lds_barrier();
    {
        u32x4 wr2[2];
#pragma unroll
        for (int k = 0; k < 2; ++k) { const int idx = tid + k * 512; wr2[k] = *(const u32x4*)(WS_GW(p) + (size_t)(l * 16 + j) * 16384 + D * 8192 + idx * 8); }
#pragma unroll
        for (int k = 0; k < 2; ++k) { const int idx = tid + k * 512; *(u32x4*)(sW + (idx >> 3) * 72 + (idx & 7) * 8) = wr2[k]; }
    }
    u32x4 xr[2], lgr[2], hfr[2];
    {
        const size_t tok0 = (size_t)b * TPB + chunk_at(D, 0) * 128;
#pragma unroll
        for (int k = 0; k < 2; ++k) {
            const int idx = tid + k * 512;
            xr[k] = *(const u32x4*)(WS_LXC(p) + (tok0 + (idx >> 3)) * 1024 + j * 64 + (idx & 7) * 8);
            if (D == 1) { lgr[k] = *(const u32x4*)(WS_P(p) + (tok0 + (idx >> 3)) * LDP + C_LG + j * 64 + (idx & 7) * 8); hfr[k] = *(const u32x4*)(WS_MIX(p) + (tok0 + (idx >> 3)) * MIXW + j * 64 + (idx & 7) * 8); }
        }
    }
    float carry = 0.f;
#pragma unroll 1
    for (int pos = 0; pos < NCH; ++pos) {
        const size_t tok0 = (size_t)b * TPB + chunk_at(D, pos) * 128;
#pragma unroll
        for (int k = 0; k < 2; ++k) { const int idx = tid + k * 512; *(u32x4*)(sX + (idx >> 3) * 72 + (idx & 7) * 8) = xr[k]; }
        u32x4 lgc[2], hfc[2];
        if (D == 1) { lgc[0] = lgr[0]; lgc[1] = lgr[1]; hfc[0] = hfr[0]; hfc[1] = hfr[1]; }
        if (pos + 1 < NCH) {
            const size_t tokn = (size_t)b * TPB + chunk_at(D, pos + 1) * 128;
#pragma unroll
            for (int k = 0; k < 2; ++k) {
                const int idx = tid + k * 512;
                xr[k] = *(const u32x4*)(WS_LXC(p) + (tokn + (idx >> 3)) * 1024 + j * 64 + (idx & 7) * 8);
                if (D == 1) { lgr[k] = *(const u32x4*)(WS_P(p) + (tokn + (idx >> 3)) * LDP + C_LG + j * 64 + (idx & 7) * 8); hfr[k] = *(const u32x4*)(WS_MIX(p) + (tokn + (idx >> 3)) * MIXW + j * 64 + (idx & 7) * 8); }
            }
        }
        lds_barrier();
        {
            f32x16 ga, gx;
#pragma unroll
            for (int r = 0; r < 16; ++r) { ga[r] = 0.f; gx[r] = 0.f; }
            mm32<64>(ga, sX + mi * 32 * 72, 72, sW + (nj * 32) * 72, 72, lane);
            mm32<64>(gx, sX + mi * 32 * 72, 72, sW + (64 + nj * 32) * 72, 72, lane);
#pragma unroll
            for (int r = 0; r < 16; ++r) {
                const int tl = mi * 32 + rowmap32(r, lane);
                const float rg = sigmf(ga[r] + ba), ig = sigmf(gx[r] + bx);
                const float a = __expf(-8.f * rg * sp), mult = __builtin_amdgcn_sqrtf(fmaxf(1.f - a * a, 0.f));
                const float xv = bf2f(sX[tl * 72 + cl]);
                sA[tl * 64 + cl] = a; sB[tl * 64 + cl] = mult * ig * xv;
            }
        }
        lds_barrier();
        {
            float A = 1.f, Bc = 0.f;
#pragma unroll
            for (int q = 0; q < 16; ++q) { const int tl = seg * 16 + (D == 0 ? q : 15 - q); const float a = sA[tl * 64 + ch], bb = sB[tl * 64 + ch]; A = a * A; Bc = a * Bc + bb; }
            sSA[seg * 64 + ch] = A; sSB[seg * 64 + ch] = Bc;
        }
        lds_barrier();
        {
            float h = carry, cn = carry;
            const int myord = D == 0 ? seg : 7 - seg;
#pragma unroll
            for (int s = 0; s < 8; ++s) { const int sg = D == 0 ? s : 7 - s; const float a = sSA[sg * 64 + ch], bb = sSB[sg * 64 + ch]; cn = a * cn + bb; if (s < myord) h = cn; }
            carry = cn;
#pragma unroll
            for (int q = 0; q < 16; ++q) { const int tl = seg * 16 + (D == 0 ? q : 15 - q); h = sA[tl * 64 + ch] * h + sB[tl * 64 + ch]; sOut[tl * 72 + ch] = f2bf(h); }
        }
        lds_barrier();
#pragma unroll
        for (int k = 0; k < 2; ++k) {
            const int idx = tid + k * 512, rr = idx >> 3, ck = idx & 7;
            const u32x4 hv = *(const u32x4*)(sOut + rr * 72 + ck * 8);
            bf16_t* dst = WS_MIX(p) + (tok0 + rr) * MIXW + j * 64 + ck * 8;
            if (D == 0) *(u32x4*)dst = hv;
            else {
                const f32x8 a = unpack8(hv), f = unpack8(hfc[k]), g = unpack8(lgc[k]);
                f32x8 o;
#pragma unroll
                for (int e = 0; e < 8; ++e) o[e] = (a[e] + f[e]) * siluf(g[e]);
                *(u32x4*)dst = pack8(o);
            }
        }
    }
}

__device__ __forceinline__ void prep_elem(const Params& p, int l, int G) {
    const int gt = (int)blockIdx.x * 512 + tidx(), NT = G * 512;
    constexpr int NI = NTOK * 192, U = 3;
    for (int base = gt; base < NI; base += NT * U) {
        u32x4 raw[U][4];
#pragma unroll
        for (int u = 0; u < U; ++u) {
            const int idx = base + u * NT;
            if (idx < NI) {
                const int tok = idx / 192, cgi = idx % 192, b = tok / TPB, t = tok % TPB;
                const int lo = t < 256 ? 0 : 256, hi = t < 256 ? 256 : TPB;
                const int col = cgi < 128 ? C_LX + cgi * 8 : C_XBC + 1024 + (cgi - 128) * 8;
                const bf16_t* src = WS_P(p) + (size_t)b * TPB * LDP + col;
#pragma unroll
                for (int k = 0; k < 4; ++k) { const int tt = t - 2 + k; raw[u][k] = (tt >= lo && tt < hi) ? *(const u32x4*)(src + (size_t)tt * LDP) : (u32x4){0u, 0u, 0u, 0u}; }
            }
        }
#pragma unroll
        for (int u = 0; u < U; ++u) {
            const int idx = base + u * NT;
            if (idx < NI) {
                const int tok = idx / 192, cgi = idx % 192;
                int CS; const float *cw, *cb; bf16_t* dst; bool act;
                if (cgi < 128) { cw = p.lru_conv_w + l * 4096 + cgi * 8; CS = 1024; cb = p.lru_conv_b + l * 1024 + cgi * 8; act = false; dst = WS_LXC(p) + (size_t)tok * 1024 + cgi * 8; }
                else { const int c2 = (cgi - 128) * 8; cw = p.ssd_conv_w + l * 6144 + 1024 + c2; CS = 1536; cb = p.ssd_conv_b + l * 1536 + 1024 + c2; act = true; dst = WS_SBC(p) + (size_t)tok * 512 + c2; }
                const f32x4 b0 = *(const f32x4*)cb, b1 = *(const f32x4*)(cb + 4);
                f32x8 acc; acc[0] = b0.x; acc[1] = b0.y; acc[2] = b0.z; acc[3] = b0.w; acc[4] = b1.x; acc[5] = b1.y; acc[6] = b1.z; acc[7] = b1.w;
#pragma unroll
                for (int k = 0; k < 4; ++k) {
                    const f32x8 v = unpack8(raw[u][k]);
                    const f32x4 w0 = *(const f32x4*)(cw + k * CS), w1 = *(const f32x4*)(cw + k * CS + 4);
                    acc[0] += w0.x * v[0]; acc[1] += w0.y * v[1]; acc[2] += w0.z * v[2]; acc[3] += w0.w * v[3];
                    acc[4] += w1.x * v[4]; acc[5] += w1.y * v[5]; acc[6] += w1.z * v[6]; acc[7] += w1.w * v[7];
                }
                if (act) {
#pragma unroll
                    for (int e = 0; e < 8; ++e) acc[e] = siluf(acc[e]);
                }
                *(u32x4*)dst = pack8(acc);
            }
        }
    }
}
struct PrepTile { int col0, ch0, t0, lo, hi, conv; const bf16_t* Pb; bf16_t* dst; };
__device__ __forceinline__ PrepTile prep_tile_decode(const Params& p, int item) {
    PrepTile T;
    const int t24 = item % 24, bc = item / 24, c = bc % NCH, b = bc / NCH;
    T.t0 = c * 128; T.Pb = WS_P(p) + (size_t)b * TPB * LDP; T.ch0 = 0; T.conv = t24 < 20;
    if (t24 < 16) { T.ch0 = t24 * 64; T.col0 = C_XBC + T.ch0; T.dst = WS_SXT(p) + ((size_t)((b * 18 + c) * 16 + t24)) * 8192; }
    else if (t24 < 20) { const int q = t24 - 16, g = q >> 1, nh = q & 1; T.ch0 = 1024 + g * 128 + nh * 64; T.col0 = C_XBC + T.ch0; T.dst = WS_SBT(p) + ((size_t)((b * 18 + c) * 2 + g)) * 16384 + (size_t)nh * 64 * 128; }
    else { const int q = t24 - 20, kh = q >> 1, dh = q & 1; T.col0 = C_V + kh * 128 + dh * 64; T.dst = WS_VT(p) + ((size_t)((b * 18 + c) * 2 + kh)) * 16384 + (size_t)dh * 64 * 128; }
    T.lo = T.t0 < 256 ? 0 : 256; T.hi = T.t0 < 256 ? 256 : TPB;
    return T;
}
__device__ __forceinline__ void prep_tile_load(const PrepTile& T, int tid, u32x4 (&raw)[2][4]) {
#pragma unroll
    for (int k = 0; k < 2; ++k) {
        const int idx = tid + k * 512, cgi = idx & 7, t = T.t0 + (idx >> 3);
#pragma unroll
        for (int q = 0; q < 4; ++q) {
            const int tt = T.conv ? t - 2 + q : t;
            const bool ok = T.conv ? (tt >= T.lo && tt < T.hi) : (q == 2);
            raw[k][q] = ok ? *(const u32x4*)(T.Pb + (size_t)tt * LDP + T.col0 + cgi * 8) : (u32x4){0u, 0u, 0u, 0u};
        }
    }
}
__device__ __forceinline__ void prep_tile_finish(const Params& p, int l, const PrepTile& T, int tid, const u32x4 (&raw)[2][4], unsigned char* shm) {
    bf16_t* sT = (bf16_t*)shm;
    const float* cw = p.ssd_conv_w + l * 6144 + T.ch0; const float* cb = p.ssd_conv_b + l * 1536 + T.ch0;
    lds_barrier();
#pragma unroll
    for (int k = 0; k < 2; ++k) {
        const int idx = tid + k * 512, cgi = idx & 7, tl = idx >> 3;
        f32x8 acc;
        if (T.conv) {
            const f32x4 b0 = *(const f32x4*)(cb + cgi * 8), b1 = *(const f32x4*)(cb + cgi * 8 + 4);
            acc[0] = b0.x; acc[1] = b0.y; acc[2] = b0.z; acc[3] = b0.w; acc[4] = b1.x; acc[5] = b1.y; acc[6] = b1.z; acc[7] = b1.w;
#pragma unroll
            for (int q = 0; q < 4; ++q) {
                const f32x8 v = unpack8(raw[k][q]);
                const f32x4 w0 = *(const f32x4*)(cw + q * 1536 + cgi * 8), w1 = *(const f32x4*)(cw + q * 1536 + cgi * 8 + 4);
                acc[0] += w0.x * v[0]; acc[1] += w0.y * v[1]; acc[2] += w0.z * v[2]; acc[3] += w0.w * v[3];
                acc[4] += w1.x * v[4]; acc[5] += w1.y * v[5]; acc[6] += w1.z * v[6]; acc[7] += w1.w * v[7];
            }
#pragma unroll
            for (int e = 0; e < 8; ++e) acc[e] = siluf(acc[e]);
        } else acc = unpack8(raw[k][2]);
#pragma unroll
        for (int e = 0; e < 8; ++e) sT[(cgi * 8 + e) * 130 + tl] = f2bf(acc[e]);
    }
    lds_barrier();
#pragma unroll
    for (int k = 0; k < 2; ++k) {
        const int idx = tid + k * 512, r = idx >> 4, ck = idx & 15;
        const unsigned* sp = (const unsigned*)(sT + r * 130 + ck * 8);
        u32x4 o; o.x = sp[0]; o.y = sp[1]; o.z = sp[2]; o.w = sp[3];
        *(u32x4*)(T.dst + r * 128 + ck * 8) = o;
    }
}
__device__ __forceinline__ void prep_tiles(const Params& p, int l, int bid, int G, unsigned char* shm) {
    const int tid = tidx();
    if (bid >= 3456) return;
    u32x4 raw[2][4], nraw[2][4];
    { const PrepTile T0 = prep_tile_decode(p, bid); prep_tile_load(T0, tid, raw); }
#pragma unroll 1
    for (int it = bid; it < 3456; it += G) {
        const bool more = it + G < 3456;
        if (more) { const PrepTile Tn = prep_tile_decode(p, it + G); prep_tile_load(Tn, tid, nraw); }
        { const PrepTile T = prep_tile_decode(p, it); prep_tile_finish(p, l, T, tid, raw, shm); }
        if (more) {
#pragma unroll
            for (int k = 0; k < 2; ++k)
#pragma unroll
                for (int q = 0; q < 4; ++q) raw[k][q] = nraw[k][q];
        }
    }
}
__device__ __forceinline__ void prep_dt_item(const Params& p, int l, int item) {
    const int tid = tidx();
    const int c = item % NCH, b = item / NCH;
    const int col32 = tid >> 4, h = col32 >> 1, d = col32 & 1, lane16 = tid & 15, seg = d == 0 ? lane16 : 15 - lane16;
    const float A = -__expf(p.ssd_A_log[(l * 2 + d) * 16 + h]), bias = p.ssd_dt_bias[(l * 2 + d) * 16 + h];
    const float* src = WS_DTP(p) + ((size_t)b * TPB + c * 128) * 16 + h;
    float dtv[8], cs[8], run = 0.f;
    float rawv[8];
#pragma unroll
    for (int q = 0; q < 8; ++q) { const int j = seg * 8 + (d == 0 ? q : 7 - q); rawv[q] = src[j * 16]; }
#pragma unroll
    for (int q = 0; q < 8; ++q) { dtv[q] = softplusf(rawv[q] + bias); run += dtv[q] * A; cs[q] = run; }
    float incl = run;
#pragma unroll
    for (int off = 1; off < 16; off <<= 1) { const float v = __shfl_up(incl, off, 16); if (lane16 >= off) incl += v; }
    const float excl = incl - run;
    float* dta = WS_DTA(p) + ((size_t)(b * 18 + c) * 128) * 32 + col32;
    float* acs = WS_ACS(p) + ((size_t)(b * 18 + c) * 128) * 32 + col32;
#pragma unroll
    for (int q = 0; q < 8; ++q) { const int j = seg * 8 + (d == 0 ? q : 7 - q); dta[j * 32] = dtv[q]; acs[j * 32] = cs[q] + excl; }
    if (lane16 == 15) WS_AL(p)[((b * 2 + d) * 18 + c) * 16 + h] = incl;
}
__device__ __forceinline__ void ssd_states_item(const Params& p, int l, int item, unsigned char* shm) {
    const int tid = tidx(), lane = tid & 63, wave = tid >> 6;
    const int g = item & 1, bc = item >> 1, c = bc % NCH, b = bc / NCH;
    bf16_t* sBT = (bf16_t*)shm; bf16_t* sXw = (bf16_t*)(shm + 34816);
    float* sDt = (float*)(shm + 69632); float* sAcs = (float*)(shm + 77824); bf16_t* sO = (bf16_t*)(shm + 86016); float* sWg = (float*)(shm + 120832);
    const bf16_t* xt = WS_SXT(p) + ((size_t)((b * 18 + c) * 16 + g * 8)) * 8192;
    const bf16_t* btp = WS_SBT(p) + ((size_t)((b * 18 + c) * 2 + g)) * 16384;
    lds_barrier();
    {
        const size_t o = ((size_t)(b * 18 + c) * 128 + (tid >> 2)) * 32 + g * 16 + (tid & 3) * 4;
        const f32x4 vdt = *(const f32x4*)(WS_DTA(p) + o), vac = *(const f32x4*)(WS_ACS(p) + o);
        u32x4 bt[4];
#pragma unroll
        for (int k = 0; k < 4; ++k) { const int idx = tid + k * 512; bt[k] = *(const u32x4*)(btp + (idx >> 4) * 128 + (idx & 15) * 8); }
        *(f32x4*)(sDt + (tid >> 2) * 16 + (tid & 3) * 4) = vdt; *(f32x4*)(sAcs + (tid >> 2) * 16 + (tid & 3) * 4) = vac;
#pragma unroll
        for (int k = 0; k < 4; ++k) { const int idx = tid + k * 512; *(u32x4*)(sBT + (idx >> 4) * 136 + (idx & 15) * 8) = bt[k]; }
    }
    u32x4 xr[2];
#pragma unroll
    for (int k = 0; k < 2; ++k) { const int idx = tid + k * 512; xr[k] = *(const u32x4*)(xt + (idx >> 4) * 128 + (idx & 15) * 8); }
    lds_barrier();
#pragma unroll
    for (int k = 0; k < 4; ++k) { const int idx = tid + k * 512, jj = idx >> 4, col = idx & 15; const float al = (col & 1) == 0 ? sAcs[127 * 16 + col] : sAcs[col]; sWg[col * 128 + jj] = __expf(al - sAcs[jj * 16 + col]) * sDt[jj * 16 + col]; }
#pragma unroll 1
    for (int hh = 0; hh < 8; ++hh) {
        const int h = g * 8 + hh;
        u32x4 xn[2] = {xr[0], xr[1]};
        if (hh < 7) {
#pragma unroll
            for (int k = 0; k < 2; ++k) { const int idx = tid + k * 512; xn[k] = *(const u32x4*)(xt + (size_t)(hh + 1) * 8192 + (idx >> 4) * 128 + (idx & 15) * 8); }
        }
        lds_barrier();
#pragma unroll
        for (int k = 0; k < 2; ++k) {
            const int idx = tid + k * 512, pp = idx >> 4, j8 = (idx & 15) * 8;
            const f32x8 xv = unpack8(xr[k]);
#pragma unroll
            for (int d = 0; d < 2; ++d) {
                const f32x4 w0 = *(const f32x4*)(sWg + (hh * 2 + d) * 128 + j8), w1 = *(const f32x4*)(sWg + (hh * 2 + d) * 128 + j8 + 4);
                f32x8 o;
                o[0] = xv[0] * w0.x; o[1] = xv[1] * w0.y; o[2] = xv[2] * w0.z; o[3] = xv[3] * w0.w; o[4] = xv[4] * w1.x; o[5] = xv[5] * w1.y; o[6] = xv[6] * w1.z; o[7] = xv[7] * w1.w;
                *(u32x4*)(sXw + d * 8704 + pp * 136 + j8) = pack8(o);
            }
        }
        lds_barrier();
        const int mi = wave & 1, nj = wave >> 1;
#pragma unroll
        for (int d = 0; d < 2; ++d) {
            f32x16 acc;
#pragma unroll
            for (int r = 0; r < 16; ++r) acc[r] = 0.f;
            mm32<128>(acc, sXw + d * 8704 + mi * 32 * 136, 136, sBT + nj * 32 * 136, 136, lane);
#pragma unroll
            for (int r = 0; r < 16; ++r) sO[d * 8704 + (mi * 32 + rowmap32(r, lane)) * 136 + nj * 32 + (lane & 31)] = f2bf(acc[r]);
        }
        lds_barrier();
#pragma unroll
        for (int d = 0; d < 2; ++d) {
            bf16_t* base = WS_ST(p) + ((size_t)((b * 2 + d) * 18 + c) * 16 + h) * 8192;
#pragma unroll
            for (int k = 0; k < 2; ++k) { const int idx = tid + k * 512; *(u32x4*)(base + idx * 8) = *(const u32x4*)(sO + d * 8704 + (idx >> 4) * 136 + (idx & 15) * 8); }
        }
        xr[0] = xn[0]; xr[1] = xn[1];
    }
}
__device__ __forceinline__ void ssd_recur_item(const Params& p, int item) {
    const int tid = tidx();
    const int d = item & 1, h = (item >> 1) & 15, b = item >> 5;
    u32x4 s0[NCH], s1[NCH]; float ev[NCH];
#pragma unroll
    for (int pos = 0; pos < NCH; ++pos) {
        const int c = chunk_at(d, pos);
        const bf16_t* ptr = WS_ST(p) + ((size_t)((b * 2 + d) * 18 + c) * 16 + h) * 8192 + tid * 16;
        s0[pos] = *(const u32x4*)ptr; s1[pos] = *(const u32x4*)(ptr + 8);
        ev[pos] = WS_AL(p)[((b * 2 + d) * 18 + c) * 16 + h];
    }
    f32x8 h0, h1;
#pragma unroll
    for (int e = 0; e < 8; ++e) { h0[e] = 0.f; h1[e] = 0.f; }
#pragma unroll
    for (int pos = 0; pos < NCH; ++pos) {
        const int c = chunk_at(d, pos);
        bf16_t* ptr = WS_ST(p) + ((size_t)((b * 2 + d) * 18 + c) * 16 + h) * 8192 + tid * 16;
        *(u32x4*)ptr = pack8(h0); *(u32x4*)(ptr + 8) = pack8(h1);
        const float e = __expf(ev[pos]);
        h0 = h0 * e + unpack8(s0[pos]); h1 = h1 * e + unpack8(s1[pos]);
    }
}
template <int MODE>
__device__ __forceinline__ void ssd_final_item(const Params& p, int l, int item, unsigned char* shm) {
    const int tid = tidx(), lane = tid & 63, wave = tid >> 6;
    const int g = item & 1, bc = item >> 1, c = bc % NCH, b = bc / NCH, t0 = c * 128;
    const size_t tok0 = (size_t)b * TPB + t0;
    bf16_t* sC = (bf16_t*)shm; bf16_t* sBW = (bf16_t*)(shm + 34816); bf16_t* sXT = (bf16_t*)(shm + 69632); bf16_t* sH = (bf16_t*)(shm + 87040);
    float* sDt = (float*)(shm + 104448); float* sAcs = (float*)(shm + 112640);
    bf16_t* sY = sBW;
    const bf16_t* xt = WS_SXT(p) + ((size_t)((b * 18 + c) * 16 + g * 8)) * 8192;
    const bf16_t* zt = WS_P(p) + tok0 * LDP + C_Z + g * 512;
    const bf16_t* hin0 = WS_ST(p) + ((size_t)((b * 2 + 0) * 18 + c) * 16 + g * 8) * 8192;
    const bf16_t* hin1 = WS_ST(p) + ((size_t)((b * 2 + 1) * 18 + c) * 16 + g * 8) * 8192;
    lds_barrier();
    u32x4 xr[2], zr[2], h0r[2];
    {
        const size_t o = ((size_t)(b * 18 + c) * 128 + (tid >> 2)) * 32 + g * 16 + (tid & 3) * 4;
        const f32x4 vdt = *(const f32x4*)(WS_DTA(p) + o), vac = *(const f32x4*)(WS_ACS(p) + o);
        u32x4 cr[4], br[4];
#pragma unroll
        for (int k = 0; k < 4; ++k) { const int idx = tid + k * 512; const bf16_t* s = WS_SBC(p) + (tok0 + (idx >> 4)) * 512 + g * 128 + (idx & 15) * 8; br[k] = *(const u32x4*)s; cr[k] = *(const u32x4*)(s + 256); }
#pragma unroll
        for (int k = 0; k < 2; ++k) {
            const int idx = tid + k * 512;
            xr[k] = *(const u32x4*)(xt + (idx >> 4) * 128 + (idx & 15) * 8);
            zr[k] = *(const u32x4*)(zt + (size_t)(idx >> 3) * LDP + (idx & 7) * 8);
            h0r[k] = *(const u32x4*)(hin0 + idx * 8);
        }
        *(f32x4*)(sDt + (tid >> 2) * 16 + (tid & 3) * 4) = vdt; *(f32x4*)(sAcs + (tid >> 2) * 16 + (tid & 3) * 4) = vac;
#pragma unroll
        for (int k = 0; k < 4; ++k) { const int idx = tid + k * 512; *(u32x4*)(sC + (idx >> 4) * 136 + (idx & 15) * 8) = cr[k]; *(u32x4*)(sBW + (idx >> 4) * 136 + (idx & 15) * 8) = br[k]; }
    }
    lds_barrier();
    const int cmi = wave >> 1, cnj0 = (wave & 1) * 2;
    f32x16 cb0, cb1;
#pragma unroll
    for (int r = 0; r < 16; ++r) { cb0[r] = 0.f; cb1[r] = 0.f; }
    mm32<128>(cb0, sC + cmi * 32 * 136, 136, sBW + cnj0 * 32 * 136, 136, lane);
    mm32<128>(cb1, sC + cmi * 32 * 136, 136, sBW + (cnj0 + 1) * 32 * 136, 136, lane);
    const int ymi = wave & 3, ynj = wave >> 2;
#pragma unroll 1
    for (int hh = 0; hh < 8; ++hh) {
        const int h = g * 8 + hh;
        lds_barrier();
#pragma unroll
        for (int k = 0; k < 2; ++k) { const int idx = tid + k * 512; *(u32x4*)(sXT + (idx >> 4) * 136 + (idx & 15) * 8) = xr[k]; *(u32x4*)(sH + (idx >> 4) * 136 + (idx & 15) * 8) = h0r[k]; }
        u32x4 h1r[2];
#pragma unroll
        for (int k = 0; k < 2; ++k) h1r[k] = *(const u32x4*)(hin1 + (size_t)hh * 8192 + (tid + k * 512) * 8);
        f32x16 yacc;
#pragma unroll
        for (int r = 0; r < 16; ++r) yacc[r] = 0.f;
#pragma unroll 1
        for (int d = 0; d < 2; ++d) {
            const int col = hh * 2 + d;
            if (d == 1) {
                lds_barrier();
#pragma unroll
                for (int k = 0; k < 2; ++k) { const int idx = tid + k * 512; *(u32x4*)(sH + (idx >> 4) * 136 + (idx & 15) * 8) = h1r[k]; }
            }
            if (MODE < 2) {
                float aci[16];
#pragma unroll
                for (int r = 0; r < 16; ++r) aci[r] = sAcs[(cmi * 32 + rowmap32(r, lane)) * 16 + col];
#pragma unroll
                for (int tt = 0; tt < 2; ++tt) {
                    const int jg = (cnj0 + tt) * 32 + (lane & 31);
                    const float acj = sAcs[jg * 16 + col], dtj = sDt[jg * 16 + col];
                    const int dj0 = jg - cmi * 32 - 4 * (lane >> 5), dj = d == 0 ? dj0 : -dj0;
#pragma unroll
                    for (int r = 0; r < 16; ++r) {
                        const int ro = (r & 3) + 8 * (r >> 2);
                        const int sd = d == 0 ? dj - ro : dj + ro;
                        float arg = aci[r] - acj; arg = sd <= 0 ? arg : -INFINITY;
                        const float cbv = tt == 0 ? cb0[r] : cb1[r];
                        sBW[(cmi * 32 + rowmap32(r, lane)) * 136 + jg] = f2bf(cbv * __expf(arg) * dtj);
                    }
                }
            }
            lds_barrier();
            f32x16 ad, ao;
#pragma unroll
            for (int r = 0; r < 16; ++r) { ad[r] = 0.f; ao[r] = 0.f; }
            if (MODE < 3) { mm32<128>(ad, sBW + ymi * 32 * 136, 136, sXT + ynj * 32 * 136, 136, lane);
            mm32<128>(ao, sC + ymi * 32 * 136, 136, sH + ynj * 32 * 136, 136, lane); }
#pragma unroll
            for (int r = 0; r < 16; ++r) { const int ig = ymi * 32 + rowmap32(r, lane); yacc[r] += ad[r] + __expf(sAcs[ig * 16 + col]) * ao[r]; }
            if (d == 0 && hh < 7) {
#pragma unroll
                for (int k = 0; k < 2; ++k) {
                    const int idx = tid + k * 512;
                    xr[k] = *(const u32x4*)(xt + (size_t)(hh + 1) * 8192 + (idx >> 4) * 128 + (idx & 15) * 8);
                    h0r[k] = *(const u32x4*)(hin0 + (size_t)(hh + 1) * 8192 + idx * 8);
                }
            }
        }
        const float Dh = p.ssd_D[l * 16 + h];
        const int pl = ynj * 32 + (lane & 31);
#pragma unroll
        for (int r = 0; r < 16; ++r) { const int ig = ymi * 32 + rowmap32(r, lane); yacc[r] += Dh * bf2f(sXT[pl * 136 + ig]); }
        lds_barrier();
#pragma unroll
        for (int r = 0; r < 16; ++r) { const int ig = ymi * 32 + rowmap32(r, lane); sY[ig * 72 + pl] = f2bf(yacc[r]); }
        lds_barrier();
#pragma unroll
        for (int k = 0; k < 2; ++k) {
            const int idx = tid + k * 512, rr = idx >> 3, pk = idx & 7;
            const f32x8 yv = unpack8(*(const u32x4*)(sY + rr * 72 + pk * 8)), zv = unpack8(zr[k]);
            f32x8 o;
#pragma unroll
            for (int e = 0; e < 8; ++e) o[e] = yv[e] * siluf(zv[e]);
            if (MODE < 1) *(u32x4*)(WS_MIX(p) + (tok0 + rr) * MIXW + 2048 + h * 64 + pk * 8) = pack8(o); else asm volatile("" :: "v"(o[0]), "v"(o[7]));
        }
        if (hh < 7) {
#pragma unroll
            for (int k = 0; k < 2; ++k) { const int idx = tid + k * 512; zr[k] = *(const u32x4*)(zt + (size_t)(idx >> 3) * LDP + (hh + 1) * 64 + (idx & 7) * 8); }
        }
    }
}
__device__ __forceinline__ void ssd_norm_phase(const Params& p, int l, int G) {
    const int lane = tidx() & 63, wave = tidx() >> 6;
    for (int row = blockIdx.x * 8 + wave; row < NTOK; row += G * 8) {
        bf16_t* rp = WS_MIX(p) + (size_t)row * MIXW + 2048;
        f32x8 v0 = unpack8(*(const u32x4*)(rp + lane * 8)), v1 = unpack8(*(const u32x4*)(rp + 512 + lane * 8));
        float ss = 0.f;
#pragma unroll
        for (int e = 0; e < 8; ++e) ss += v0[e] * v0[e] + v1[e] * v1[e];
        ss = wave_sum(ss);
        const float rstd = rsqrtf(ss * (1.f / 1024.f) + 1e-6f);
        const float* nw = p.ssd_norm_w + l * 1024;
#pragma unroll
        for (int e = 0; e < 8; ++e) { v0[e] = v0[e] * rstd * nw[lane * 8 + e]; v1[e] = v1[e] * rstd * nw[512 + lane * 8 + e]; }
        *(u32x4*)(rp + lane * 8) = pack8(v0); *(u32x4*)(rp + 512 + lane * 8) = pack8(v1);
    }
}

template <int MODE>
__device__ __forceinline__ void attn_item(const Params& p, int l, int item, unsigned char* shm) {
    const int tid = tidx(), lane = tid & 63, wave = tid >> 6, fr = lane & 15, fq = lane >> 4;
    const int hp = item & 3, bq = item >> 2, qblk = bq % NCH, b = bq / NCH, kh = hp >> 1;
    const bf16_t* P = WS_P(p);
    bf16_t* sK = (bf16_t*)shm; bf16_t* sVT = (bf16_t*)(shm + 34816); bf16_t* sPw = (bf16_t*)(shm + 69632) + wave * (2 * 16 * 136);
    const size_t tokq0 = (size_t)b * TPB + qblk * 128;
    bf16x8 aq[2][4];
#pragma unroll
    for (int hd = 0; hd < 2; ++hd)
#pragma unroll
        for (int kk = 0; kk < 4; ++kk) aq[hd][kk] = *(const bf16x8*)(P + (tokq0 + wave * 16 + fr) * LDP + C_Q + (hp * 2 + hd) * 128 + kk * 32 + 8 * fq);
    float m[2][4], ls[2][4]; f32x4 O[2][8];
#pragma unroll
    for (int hd = 0; hd < 2; ++hd) {
        const float sink = p.att_sink[l * 8 + hp * 2 + hd];
#pragma unroll
        for (int r = 0; r < 4; ++r) { m[hd][r] = sink; ls[hd][r] = 1.f; }
#pragma unroll
        for (int nd = 0; nd < 8; ++nd) O[hd][nd] = (f32x4){0.f, 0.f, 0.f, 0.f};
    }
    const int nlat = qblk - 2;
    const int kb_lo = nlat - 1 < 0 ? 0 : nlat - 1, kb_hi = nlat + 1 > 15 ? 15 : nlat + 1;
    const int ntl = qblk < 2 ? 2 : 2 + (kb_hi - kb_lo + 1);
    u32x4 kr[4], vr[4];
    const bf16_t* vtb = WS_VT(p) + ((size_t)(b * 18) * 2 + kh) * 16384;
    {
        const bf16_t* kbase = P + ((size_t)b * TPB) * LDP + C_K + kh * 128;
#pragma unroll
        for (int k = 0; k < 4; ++k) { const int idx = tid + k * 512; kr[k] = *(const u32x4*)(kbase + (size_t)(idx >> 4) * LDP + (idx & 15) * 8); vr[k] = *(const u32x4*)(vtb + idx * 8); }
    }
#pragma unroll 1
    for (int ti = 0; ti < ntl; ++ti) {
        const bool masked = ti >= 2; const int kb = kb_lo + (ti - 2);
        lds_barrier();
#pragma unroll
        for (int k = 0; k < 4; ++k) {
            const int idx = tid + k * 512;
            *(u32x4*)(sK + (idx >> 4) * 136 + (idx & 15) * 8) = kr[k];
            *(u32x4*)(sVT + (idx >> 4) * 136 + (idx & 15) * 8) = vr[k];
        }
        if (ti + 1 < ntl) {
            const int tn = ti + 1, t0n = tn < 2 ? tn * 128 : 256 + (kb_lo + (tn - 2)) * 128;
            const bf16_t* kbase = P + ((size_t)b * TPB + t0n) * LDP + C_K + kh * 128;
            const bf16_t* vtn = vtb + (size_t)(t0n >> 7) * 32768;
#pragma unroll
            for (int k = 0; k < 4; ++k) { const int idx = tid + k * 512; kr[k] = *(const u32x4*)(kbase + (size_t)(idx >> 4) * LDP + (idx & 15) * 8); vr[k] = *(const u32x4*)(vtn + idx * 8); }
        }
        lds_barrier();
#pragma unroll 1
        for (int hf = 0; hf < 2; ++hf) {
            f32x4 s[2][4];
#pragma unroll
            for (int nt = 0; nt < 4; ++nt) {
                s[0][nt] = (f32x4){0.f, 0.f, 0.f, 0.f}; s[1][nt] = (f32x4){0.f, 0.f, 0.f, 0.f};
#pragma unroll
                for (int kk = 0; kk < 4; ++kk) {
                    const bf16x8 bk = *(const bf16x8*)(sK + ((hf * 4 + nt) * 16 + fr) * 136 + kk * 32 + 8 * fq);
                    s[0][nt] = __builtin_amdgcn_mfma_f32_16x16x32_bf16(aq[0][kk], bk, s[0][nt], 0, 0, 0);
                    s[1][nt] = __builtin_amdgcn_mfma_f32_16x16x32_bf16(aq[1][kk], bk, s[1][nt], 0, 0, 0);
                }
                __builtin_amdgcn_sched_barrier(0);
            }
            if (masked) {
#pragma unroll
                for (int nt = 0; nt < 4; ++nt)
#pragma unroll
                    for (int r = 0; r < 4; ++r) { const int rel = (nlat * 128 + wave * 16 + fq * 4 + r) - (kb * 128 + (hf * 4 + nt) * 16 + fr); if (rel > 128 || rel < -128) { s[0][nt][r] = -INFINITY; s[1][nt][r] = -INFINITY; } }
            }
#pragma unroll
            for (int hd = 0; hd < 2; ++hd) {
                float alpha[4];
#pragma unroll
                for (int r = 0; r < 4; ++r) {
                    float mx = fmaxf(fmaxf(s[hd][0][r], s[hd][1][r]), fmaxf(s[hd][2][r], s[hd][3][r]));
                    mx = row16_max(mx);
                    const float mn = fmaxf(m[hd][r], mx);
                    alpha[r] = __expf(m[hd][r] - mn); m[hd][r] = mn;
                    float rs = 0.f;
#pragma unroll
                    for (int nt = 0; nt < 4; ++nt) { const float pv = __expf(s[hd][nt][r] - mn); s[hd][nt][r] = pv; rs += pv; }
                    rs = row16_sum(rs);
                    ls[hd][r] = ls[hd][r] * alpha[r] + rs;
                }
#pragma unroll
                for (int nd = 0; nd < 8; ++nd) { O[hd][nd].x *= alpha[0]; O[hd][nd].y *= alpha[1]; O[hd][nd].z *= alpha[2]; O[hd][nd].w *= alpha[3]; }
#pragma unroll
                for (int nt = 0; nt < 4; ++nt)
#pragma unroll
                    for (int r = 0; r < 4; ++r) sPw[hd * (16 * 136) + (fq * 4 + r) * 136 + nt * 16 + fr] = f2bf(s[hd][nt][r]);
            }
            asm volatile("s_waitcnt lgkmcnt(0)" ::: "memory");
#pragma unroll
            for (int kk = 0; kk < 2; ++kk) {
                const bf16x8 ap0 = *(const bf16x8*)(sPw + fr * 136 + kk * 32 + 8 * fq);
                const bf16x8 ap1 = *(const bf16x8*)(sPw + 16 * 136 + fr * 136 + kk * 32 + 8 * fq);
#pragma unroll
                for (int nd = 0; nd < 8; ++nd) {
                    const bf16x8 bv = *(const bf16x8*)(sVT + (nd * 16 + fr) * 136 + hf * 64 + kk * 32 + 8 * fq);
                    O[0][nd] = __builtin_amdgcn_mfma_f32_16x16x32_bf16(ap0, bv, O[0][nd], 0, 0, 0);
                    O[1][nd] = __builtin_amdgcn_mfma_f32_16x16x32_bf16(ap1, bv, O[1][nd], 0, 0, 0);
                    if (nd == 3) __builtin_amdgcn_sched_barrier(0);
                }
                __builtin_amdgcn_sched_barrier(0);
            }
            asm volatile("s_waitcnt lgkmcnt(0)" ::: "memory");
        }
    }
#pragma unroll
    for (int hd = 0; hd < 2; ++hd) {
        const int hq = hp * 2 + hd;
        u32x4 agr[4];
#pragma unroll
        for (int k = 0; k < 4; ++k) { const int idx = tid + k * 512; agr[k] = *(const u32x4*)(P + (tokq0 + (idx >> 4)) * LDP + C_AG + hq * 128 + (idx & 15) * 8); }
        lds_barrier();
#pragma unroll
        for (int r = 0; r < 4; ++r) {
            const float il = __builtin_amdgcn_rcpf(ls[hd][r]);
#pragma unroll
            for (int nd = 0; nd < 8; ++nd) sK[(wave * 16 + fq * 4 + r) * 136 + nd * 16 + fr] = f2bf(O[hd][nd][r] * il);
        }
        lds_barrier();
#pragma unroll
        for (int k = 0; k < 4; ++k) {
            const int idx = tid + k * 512, rr = idx >> 4, ck = idx & 15;
            const f32x8 ov = unpack8(*(const u32x4*)(sK + rr * 136 + ck * 8)), gv = unpack8(agr[k]);
            f32x8 o;
#pragma unroll
            for (int e = 0; e < 8; ++e) o[e] = ov[e] * siluf(gv[e]);
            *(u32x4*)(WS_MIX(p) + (tokq0 + rr) * MIXW + 1024 + hq * 128 + ck * 8) = pack8(o);
        }
    }
}

#define XB_TMO      128
#define XB_XCNT(j)  (256  + 64 * (j))
#define XB_XSUB(j)  (1280 + 64 * (j))
#define XB_XGEN(j)  (2304 + 64 * (j))
#define XB_TOP      3328
#define XB_TOPGEN   3392
#define XCD_BAR_WORDS 3456
#define XB_SPIN_CAP (1u << 18)
#define LAS __attribute__((address_space(3)))
__device__ __forceinline__ unsigned xb_ld(unsigned* p)              { return __hip_atomic_load(p, __ATOMIC_RELAXED, __HIP_MEMORY_SCOPE_AGENT); }
__device__ __forceinline__ unsigned xb_add(unsigned* p, unsigned v) { return __hip_atomic_fetch_add(p, v, __ATOMIC_RELAXED, __HIP_MEMORY_SCOPE_AGENT); }
__device__ __forceinline__ unsigned xb_xcc_id() { return (unsigned)__builtin_amdgcn_s_getreg((3 << 11) | 20) & 0xFu; }
#define XB_SPIN(cond, bar) do { unsigned _sp = 0; while (cond) { __builtin_amdgcn_s_sleep(1); \
    if ((++_sp & 255u) == 0u) { if (xb_ld(&(bar)[XB_TMO])) break; if (_sp > XB_SPIN_CAP) { atomicAdd(&(bar)[XB_TMO], 1u); break; } } } } while (0)
struct XcdBarrier { unsigned* bar; unsigned x; volatile LAS unsigned* st; };
__device__ __forceinline__ XcdBarrier xcd_barrier_post(unsigned* bar, volatile LAS unsigned* st) {
    XcdBarrier b; b.bar = bar; b.x = xb_xcc_id(); b.st = st;
    if (tidx() == 0) (void)xb_add(&bar[XB_XCNT(b.x)], 1u);
    return b;
}
__device__ __forceinline__ void xcd_barrier_complete(unsigned* bar, unsigned x, unsigned& nloc, unsigned& nx) {
    const unsigned G = gridDim.x * gridDim.y * gridDim.z;
    unsigned sum, cnt, mine, sp = 0u;
    for (;;) {
        sum = 0u; cnt = 0u; mine = 0u;
#pragma unroll
        for (unsigned j = 0; j < 16; ++j) { const unsigned c = xb_ld(&bar[XB_XCNT(j)]); sum += c; cnt += (c > 0u) ? 1u : 0u; mine = (j == x) ? c : mine; }
        if (sum == G) break;
        __builtin_amdgcn_s_sleep(1);
        if ((++sp & 255u) == 0u) { if (xb_ld(&bar[XB_TMO])) break; if (sp > XB_SPIN_CAP) { atomicAdd(&bar[XB_TMO], 1u); break; } }
    }
    nloc = mine > 0u ? mine : 1u; nx = cnt > 0u ? cnt : 1u;
}
__device__ __forceinline__ void xcd_barrier(const XcdBarrier& b) {
    asm volatile("s_waitcnt vmcnt(0)" ::: "memory");
    __syncthreads();
    if (tidx() == 0) {
        unsigned* bar = b.bar;
        __builtin_amdgcn_s_waitcnt(0);
        unsigned nloc = b.st[0], nx = b.st[1];
        if (nloc == 0u) { xcd_barrier_complete(bar, b.x, nloc, nx); b.st[0] = nloc; b.st[1] = nx; }
        const unsigned old = xb_add(&bar[XB_XSUB(b.x)], 1u);
        const unsigned gen = old / nloc;
        if (old + 1u == (gen + 1u) * nloc) {
            __builtin_amdgcn_fence(__ATOMIC_RELEASE, "agent");
            asm volatile("s_waitcnt vmcnt(0)" ::: "memory");
            const unsigned og = xb_add(&bar[XB_TOP], 1u);
            const unsigned tg = og / nx;
            if (og + 1u == (tg + 1u) * nx) xb_add(&bar[XB_TOPGEN], 1u);
            else XB_SPIN(xb_ld(&bar[XB_TOPGEN]) == tg, bar);
            __builtin_amdgcn_fence(__ATOMIC_ACQUIRE, "agent");
            xb_add(&bar[XB_XGEN(b.x)], 1u);
            asm volatile("s_waitcnt vmcnt(0)" ::: "memory");
        } else {
            XB_SPIN(xb_ld(&bar[XB_XGEN(b.x)]) == gen, bar);
            __builtin_amdgcn_fence(__ATOMIC_ACQUIRE, "agent");
            asm volatile("s_waitcnt vmcnt(0)" ::: "memory");
        }
    }
    __syncthreads();
}


#define QUEUE_LOOP(ctr, NITEMS, BODY) do { \
    volatile LAS unsigned* _mb = (volatile LAS unsigned*)(shm + LDS_CTL + 8); \
    int it = bid; \
    while (it < (NITEMS)) { \
        unsigned _nx = 0u; if (tidx() == 0) _nx = xb_add((ctr), 1u) + (unsigned)G; \
        BODY; \
        __syncthreads(); \
        if (tidx() == 0) _mb[0] = _nx; \
        __syncthreads(); \
        it = (int)_mb[0]; \
    } } while (0)

__global__ __launch_bounds__(512) void mega(Params p) {
    extern __shared__ __attribute__((aligned(16))) unsigned char shm[];
    cg::grid_group grid = cg::this_grid();
    const int G = (int)gridDim.x, bid = (int)blockIdx.x;
    if (tidx() < 4) ((volatile LAS unsigned*)(shm + LDS_CTL))[tidx()] = 0u;
    __syncthreads();
    unsigned* qctr = (unsigned*)(p.ws + OFF_BAR) + 3584;
    const XcdBarrier xb = xcd_barrier_post((unsigned*)(p.ws + OFF_BAR), (volatile LAS unsigned*)(shm + LDS_CTL));
    for (int rep = 0; rep < 1 + DUP_P0; ++rep) phase0(p, shm, G);
    grid.sync();
#pragma unroll 1
    for (int l = 0; l < 4; ++l) {
        for (int rep = 0; rep < 1 + DUP_NORM; ++rep) norm_phase(p, l, G);
        xcd_barrier(xb);
        {
            pg8::Gemm g{WS_U(p), WS_WTIN(p) + (size_t)l * 7424 * 2048, NTOK, 7168, 2048};
            pg8::Order S; S.init(72, 28, G, bid, 0);
            EpiG1 E{WS_P(p)};
            for (int rep = 0; rep < 1 + DUP_G1; ++rep) pg8::gemm_phase<EpiG1, pg8::Order>((PG8_LAS unsigned char*)shm, g, S, E);
            {
                const int tq = tidx(), wave = tq >> 6, lane = tq & 63, fr = lane & 15, fq = lane >> 4;
                for (int wu = bid * 8 + wave; wu < NTOK / 16; wu += G * 8) {
                    const bf16_t* ap = WS_U(p) + (size_t)(wu * 16 + fr) * 2048 + 8 * fq;
                    const bf16_t* bp = WS_WTIN(p) + ((size_t)l * 7424 + 7168 + fr) * 2048 + 8 * fq;
                    f32x4 acc = (f32x4){0.f, 0.f, 0.f, 0.f};
#pragma unroll 8
                    for (int kk = 0; kk < 64; ++kk) { const bf16x8 a = *(const bf16x8*)(ap + kk * 32), bq = *(const bf16x8*)(bp + kk * 32); acc = __builtin_amdgcn_mfma_f32_16x16x32_bf16(a, bq, acc, 0, 0, 0); }
#pragma unroll
                    for (int r = 0; r < 4; ++r) WS_DTP(p)[(size_t)(wu * 16 + fq * 4 + r) * 16 + fr] = acc[r];
                }
            }
        }
        for (int rep = 0; rep < 1 + DUP_SYNC; ++rep) xcd_barrier(xb);
        for (int rep = 0; rep < 1 + DUP_E1; ++rep) {
            if (rep == 0 || E1SEL == 0 || E1SEL == 1) for (int it = bid; it < 144; it += G) prep_dt_item(p, l, it);
            if (rep == 0 || E1SEL == 0 || E1SEL == 2) { __syncthreads(); prep_tiles(p, l, bid, G, shm); }
            if (rep == 0 || E1SEL == 0 || E1SEL == 3) prep_elem(p, l, G);
        }
        { const int tq = tidx(), wave = tq >> 6, lane = tq & 63; for (int row = bid * 8 + wave; row < NTOK; row += G * 8) qkprep_row(p, l, row, lane); }
        xcd_barrier(xb);
        QUEUE_LOOP(qctr + (l * 3 + 0) * 64, 128 + 288, { if (it < 128) lru_sweep_item<0>(p, l, it, shm); else ssd_states_item(p, l, it - 128, shm); });
#if DUP_SWEEP
        __syncthreads(); for (int it = bid; it < 128; it += G) lru_sweep_item<0>(p, l, it, shm);
#endif
#if DUP_STATES
        __syncthreads(); for (int it = bid; it < 256; it += G) ssd_states_item(p, l, it, shm);
#endif
        xcd_barrier(xb);
        QUEUE_LOOP(qctr + (l * 3 + 1) * 64, 256 + 576, { if (it < 256) ssd_recur_item(p, it); else attn_item<0>(p, l, it - 256, shm); });
#if DUP_ATTQ
        __syncthreads(); QUEUE_LOOP(qctr + (12 + l * 3 + 1) * 64, 576, { attn_item<AMODE>(p, l, it, shm); });
#endif
        xcd_barrier(xb);
        QUEUE_LOOP(qctr + (l * 3 + 2) * 64, 128 + 288, { if (it < 128) lru_sweep_item<1>(p, l, it, shm); else ssd_final_item<0>(p, l, it - 128, shm); });
#if DUP_FINAL
        __syncthreads(); for (int it = bid; it < 256; it += G) ssd_final_item<FMODE>(p, l, it, shm);
#endif
        xcd_barrier(xb);
#ifndef SK_X4
        ssd_norm_phase(p, l, G);
#endif
        xcd_barrier(xb);
        {
            pg8::Gemm g{WS_MIX(p), WS_WTOUT(p) + (size_t)l * 2048 * 3072, NTOK, 2048, 3072};
            pg8::Order S; S.init(l == 3 ? 64 : 72, 8, G, bid, l == 3 ? 1 : 0);
            EpiG2 E{p, l};
#ifndef SK_G2
            pg8::gemm_phase<EpiG2, pg8::Order>((PG8_LAS unsigned char*)shm, g, S, E);
#endif
        }
        if (l < 3) xcd_barrier(xb);
    }
}

extern "C" void kernel_launch(void* const* d_in, const int* in_sizes, int n_in, void* d_out, int out_size, void* d_ws, size_t ws_size, hipStream_t stream) {
    static int grid = 0;
    if (grid == 0) {
        if (n_in != 25 || ws_size < WS_END) { fprintf(stderr, "kernel_launch: need 25 inputs and %zu bytes of workspace (got %d, %zu)\n", (size_t)WS_END, n_in, ws_size); grid = -1; return; }
        int dev = 0, cus = 0, per_cu = 0;
        hipGetDevice(&dev);
        hipDeviceGetAttribute(&cus, hipDeviceAttributeMultiprocessorCount, dev);
        if (hipFuncSetAttribute((const void*)mega, hipFuncAttributeMaxDynamicSharedMemorySize, LDS_BYTES) != hipSuccess) { fprintf(stderr, "kernel_launch: hipFuncSetAttribute failed\n"); grid = -1; return; }
        if (hipOccupancyMaxActiveBlocksPerMultiprocessor(&per_cu, (const void*)mega, 512, LDS_BYTES) != hipSuccess || per_cu < 1) { fprintf(stderr, "kernel_launch: occupancy query gave %d\n", per_cu); per_cu = 1; }
        (void)hipGetLastError();
        grid = cus * 1;
        if (grid <= 0) grid = 256;
    }
    if (grid < 0) return;
    Params p{};
    const float** pf = (const float**)&p;
    for (int i = 0; i < 25; ++i) pf[i] = (const float*)d_in[i];
    p.out = (float*)d_out; p.ws = (unsigned char*)d_ws;
    if (hipMemsetAsync((char*)d_ws + OFF_BAR, 0, 32768, stream) != hipSuccess) { fprintf(stderr, "kernel_launch: memset of barrier words failed\n"); return; }
    void* args[] = {&p};
    hipError_t e = hipLaunchCooperativeKernel((const void*)mega, dim3(grid), dim3(512), args, LDS_BYTES, stream);
    if (e != hipSuccess) fprintf(stderr, "cooperative launch failed: %s (grid %d)\n", hipGetErrorString(e), grid);
}
```

```cpp
#include <hip/hip_runtime.h>
#include <hip/hip_cooperative_groups.h>
#include <cstdio>
#include <cstdint>
namespace cg = cooperative_groups;
#define DUP_X1A 0
#define DUP_X1B 0
#define DUP_ATT 0
#define DUP_X3A 0
#define DUP_X3B 0
#define DUP_G1 0
#define DUP_P0 0
#define DUP_NORM 0
#define DUP_SYNC 0
#define DUP_E1 0
#define DUP_SWEEP1 0
#define DUP_G2 0
#define DUP_QK 0
#define E1SEL 0
#define DUP_SWEEP 0
#define DUP_STATES 0
#define DUP_FINAL 0
#define AMODE 0
#define FMODE 0
#define DUP_X1Q 0
#define DUP_ATTQ 0
#define DUP_X3Q 0

__device__ __forceinline__ int tidx() { int t = (int)threadIdx.x; asm volatile("" : "+v"(t)); return t; }

namespace pg8 {
#define PG8_LAS __attribute__((address_space(3)))
typedef unsigned short bf16_t;
typedef short bf16x8 __attribute__((ext_vector_type(8)));
typedef float f32x4 __attribute__((ext_vector_type(4)));
typedef unsigned u32x4 __attribute__((ext_vector_type(4)));
constexpr int BM = 256, BK = 64, HALF = 128, HTB = HALF * BK * 2  , STAGE_BYTES = 8 * HTB, NXCD = 8, WGM = 8;

__host__ __device__ __forceinline__ int lds_byte(int r, int c) { const int st = (r >> 4) * 2 + (c >> 5), rr = r & 15, cc = c & 31, ob = rr * 64 + cc * 2; return st * 1024 + (ob ^ (((ob >> 9) & 1) << 5)); }
__host__ __device__ __forceinline__ void stage_rc(int b, int& R, int& C) { const int st = b / 1024, sb = b % 1024, swz = sb ^ (((sb >> 9) & 1) << 5); R = (st >> 1) * 16 + swz / 64; C = (st & 1) * 32 + (swz % 64) / 2; }
__host__ __device__ __forceinline__ int perm32(int rho) { const int n = rho >> 4, i = rho & 15; return 8 * (i >> 2) + 4 * n + (i & 3); }

struct Unit { int pm, pn; };
struct Gemm { const bf16_t* A; const bf16_t* Bt; int M, N, K; };

struct Order {
    int nM, nN, nwg, G, c, skipctx;
    __device__ void init(int nM_, int nN_, int G_, int c_, int skip_) { nM = nM_; nN = nN_; nwg = nM * nN; G = G_; c = c_; skipctx = skip_; }
    __device__ bool next(int i, Unit& u) const {
        const long L = (long)i * G + c; if (L >= nwg) return false;
        int wgid = (int)L; { const int q = nwg / NXCD, r = nwg % NXCD, xcd = wgid % NXCD, off = wgid / NXCD; wgid = (xcd < r ? xcd * (q + 1) : r * (q + 1) + (xcd - r) * q) + off; }
        const int nig = WGM * nN, gid = wgid / nig, fm = gid * WGM, gsz = (nM - fm) < WGM ? (nM - fm) : WGM;
        int pm = fm + ((wgid % nig) % gsz); u.pn = (wgid % nig) / gsz;
        if (skipctx) pm = (pm >> 3) * 9 + 1 + (pm & 7);
        u.pm = pm; return true;
    }
    __device__ __forceinline__ void a_ready(const Unit&) const {}
    __device__ __forceinline__ void done(const Unit&) const {}
};
typedef __bf16 bf16x2_t __attribute__((ext_vector_type(2)));
typedef float f32x2_t __attribute__((ext_vector_type(2)));
__device__ __forceinline__ unsigned cvt_pk_bf16(float lo, float hi) { f32x2_t v = {lo, hi}; bf16x2_t b = __builtin_convertvector(v, bf16x2_t); return __builtin_bit_cast(unsigned, b); }

template <class Epi, class Sched>
__device__ __forceinline__ void gemm_phase(PG8_LAS unsigned char* lds, const Gemm g, const Sched& S, const Epi& E) {
    const int tid = tidx(), wid = __builtin_amdgcn_readfirstlane(tid >> 6), lane = tid & 63, wr = wid >> 2, wc = wid & 3, fr = lane & 15, fq = lane >> 4;
    const int K = g.K, nt = K / BK;
    unsigned voffA[2], voffB[2];
#pragma unroll
    for (int i = 0; i < 2; ++i) { int R, C; stage_rc(tid * 16 + i * 8192, R, C); const int Rb = Epi::PERM ? ((R & ~31) + perm32(R & 31)) : R;
        voffA[i] = (unsigned)(R * K + C) * 2u; voffB[i] = (unsigned)(Rb * K + C) * 2u; }
    const size_t kstep = (size_t)(BK * 2);
    const size_t hstep = (size_t)HALF * K * 2;
    const size_t tstep = 2 * hstep;
    const unsigned ldsw = (unsigned)wid * 1024u;
    const int aoff = lds_byte(wr * 64 + fr, fq * 8), boff = lds_byte(wc * 32 + fr, fq * 8);
#define PG8_SA(b, h) (((b) * 2 + (h)) * HTB)
#define PG8_SB(b, h) ((4 + (b) * 2 + (h)) * HTB)
#define PG8_STAGE(bufoff, gbase, voff) do { _Pragma("unroll") for (int _i = 0; _i < 2; ++_i) \
        __builtin_amdgcn_global_load_lds((const unsigned*)((const char*)(gbase) + (voff)[_i]), (PG8_LAS unsigned*)(lds + (bufoff) + ldsw + _i * 8192), 16, 0, 0); } while (0)
#define PG8_LDA(dst, b, h) do { _Pragma("unroll") for (int m = 0; m < 4; ++m) _Pragma("unroll") for (int k = 0; k < 2; ++k) dst[m][k] = *(const PG8_LAS bf16x8*)(lds + PG8_SA(b, h) + aoff + m * 2048 + k * 1024); } while (0)
#define PG8_LDB(dst, b, h) do { _Pragma("unroll") for (int n = 0; n < 2; ++n) _Pragma("unroll") for (int k = 0; k < 2; ++k) dst[n][k] = *(const PG8_LAS bf16x8*)(lds + PG8_SB(b, h) + boff + n * 2048 + k * 1024); } while (0)
#define PG8_MMA(ai, bj, At, Bt) do { __builtin_amdgcn_s_setprio(1); _Pragma("unroll") for (int m = 0; m < 4; ++m) _Pragma("unroll") for (int n = 0; n < 2; ++n) _Pragma("unroll") for (int k = 0; k < 2; ++k) \
        acc[ai][bj][m][n] = __builtin_amdgcn_mfma_f32_16x16x32_bf16(Bt[n][k], At[m][k], acc[ai][bj][m][n], 0, 0, 0); __builtin_amdgcn_s_setprio(0); } while (0)
#define PG8_WAIT_V(n) asm volatile("s_waitcnt vmcnt(" #n ")" ::: "memory")
#define PG8_WAIT_L(n) asm volatile("s_waitcnt lgkmcnt(" #n ")" ::: "memory")
#define PG8_BAR __builtin_amdgcn_s_barrier()
#define PG8_SCHED __builtin_amdgcn_sched_barrier(0)
    Unit cur, nxt; int ui = 0;
    if (!S.next(0, cur)) return;
    f32x4 acc[2][2][4][2];
#pragma unroll
    for (int a = 0; a < 2; ++a)
#pragma unroll
        for (int b = 0; b < 2; ++b)
#pragma unroll
            for (int m = 0; m < 4; ++m)
#pragma unroll
                for (int n = 0; n < 2; ++n) acc[a][b][m][n] = (f32x4){0.f, 0.f, 0.f, 0.f};
    bf16x8 At[4][2], B0[2][2], B1[2][2];
    const char* cA = (const char*)g.A + (size_t)cur.pm * tstep; const char* cB = (const char*)g.Bt + (size_t)cur.pn * tstep;
    S.a_ready(cur);
    PG8_STAGE(PG8_SB(0, 0), cB, voffB); PG8_STAGE(PG8_SA(0, 0), cA, voffA); PG8_STAGE(PG8_SB(0, 1), cB + hstep, voffB); PG8_STAGE(PG8_SA(0, 1), cA + hstep, voffA);
    if (wr == 1) PG8_BAR;
    PG8_WAIT_V(4); PG8_BAR;
    PG8_STAGE(PG8_SB(1, 0), cB + kstep, voffB); PG8_STAGE(PG8_SA(1, 0), cA + kstep, voffA); PG8_STAGE(PG8_SB(1, 1), cB + hstep + kstep, voffB);
    PG8_WAIT_V(6); PG8_BAR;
    for (;;) {
        const bool has_next = S.next(ui + 1, nxt);
        const char* nA = has_next ? (const char*)g.A + (size_t)nxt.pm * tstep : cA; const char* nB = has_next ? (const char*)g.Bt + (size_t)nxt.pn * tstep : cB;
        for (int t = 0; t < nt; t += 2) {
            const bool last = (t == nt - 2);
            const char* a1 = cA + (size_t)(t + 1) * kstep;
            const char* a2 = last ? nA : cA + (size_t)(t + 2) * kstep; const char* b2 = last ? nB : cB + (size_t)(t + 2) * kstep;
            const char* a3 = a2 + kstep; const char* b3 = b2 + kstep;
            if (last && has_next) S.a_ready(nxt);
            PG8_LDB(B0, 0, 0); PG8_SCHED; PG8_LDA(At, 0, 0); PG8_STAGE(PG8_SA(1, 1), a1 + hstep, voffA);
            PG8_WAIT_L(8); PG8_BAR; PG8_WAIT_L(0); PG8_MMA(0, 0, At, B0); PG8_BAR; PG8_SCHED;
            PG8_LDB(B1, 0, 1); PG8_STAGE(PG8_SB(0, 0), b2, voffB);
            PG8_BAR; PG8_WAIT_L(0); PG8_MMA(0, 1, At, B1); PG8_BAR;
            PG8_LDA(At, 0, 1); PG8_STAGE(PG8_SA(0, 0), a2, voffA);
            PG8_BAR; PG8_WAIT_L(0); PG8_MMA(1, 0, At, B0); PG8_BAR; PG8_SCHED;
            PG8_STAGE(PG8_SB(0, 1), b2 + hstep, voffB);
            PG8_WAIT_V(6); PG8_BAR; PG8_MMA(1, 1, At, B1); PG8_BAR;
            PG8_LDB(B0, 1, 0); PG8_SCHED; PG8_LDA(At, 1, 0); PG8_STAGE(PG8_SA(0, 1), a2 + hstep, voffA);
            PG8_WAIT_L(8); PG8_BAR; PG8_WAIT_L(0); PG8_MMA(0, 0, At, B0); PG8_BAR; PG8_SCHED;
            PG8_LDB(B1, 1, 1); PG8_STAGE(PG8_SB(1, 0), b3, voffB);
            PG8_BAR; PG8_WAIT_L(0); PG8_MMA(0, 1, At, B1); PG8_BAR;
            PG8_LDA(At, 1, 1); PG8_STAGE(PG8_SA(1, 0), a3, voffA);
            PG8_BAR; PG8_WAIT_L(0); PG8_MMA(1, 0, At, B0); PG8_BAR; PG8_SCHED;
            PG8_STAGE(PG8_SB(1, 1), b3 + hstep, voffB);
            PG8_WAIT_V(6); PG8_BAR; PG8_MMA(1, 1, At, B1); PG8_BAR;
        }
        if constexpr (!Epi::AFTER_DRAIN) { E(acc, cur, wr, wc, fr, fq); S.done(cur); }
        if (!has_next) break;
#pragma unroll
        for (int a = 0; a < 2; ++a)
#pragma unroll
            for (int b = 0; b < 2; ++b)
#pragma unroll
                for (int m = 0; m < 4; ++m)
#pragma unroll
                    for (int n = 0; n < 2; ++n) acc[a][b][m][n] = (f32x4){0.f, 0.f, 0.f, 0.f};
        cur = nxt; cA = nA; cB = nB; ++ui;
    }
    PG8_WAIT_V(0);
    if (wr == 0) PG8_BAR;
    PG8_BAR;
    if constexpr (Epi::AFTER_DRAIN) { E.fused(acc, cur, wr, wc, fr, fq, lds, wid, lane); S.done(cur); }
#undef PG8_SA
#undef PG8_SB
#undef PG8_STAGE
#undef PG8_LDA
#undef PG8_LDB
#undef PG8_MMA
#undef PG8_WAIT_V
#undef PG8_WAIT_L
#undef PG8_BAR
#undef PG8_SCHED
}
}

using pg8::bf16_t; using pg8::bf16x8; using pg8::f32x4; using pg8::cvt_pk_bf16;
typedef float f32x16 __attribute__((ext_vector_type(16)));
typedef float f32x8 __attribute__((ext_vector_type(8)));
typedef unsigned u32x2 __attribute__((ext_vector_type(2)));
typedef unsigned u32x4 __attribute__((ext_vector_type(4)));

constexpr int DM = 2048, TPB = 2304, NTOK = 18432, LDP = 7424, MIXW = 3072, NCH = 18;
constexpr int C_LX = 0, C_LG = 1024, C_Q = 2048, C_K = 3072, C_V = 3328, C_AG = 3584, C_XBC = 4608, C_Z = 6144, C_DT = 7168;
constexpr size_t SZ_WTIN = (size_t)4 * 7424 * 2048 * 2, SZ_WTOUT = (size_t)4 * 2048 * 3072 * 2, SZ_MOD = (size_t)4 * 9 * 6144 * 4, SZ_U = (size_t)NTOK * 2048 * 2,
                 SZ_P = (size_t)NTOK * LDP * 2, SZ_MIX = (size_t)NTOK * MIXW * 2, SZ_XB = (size_t)NTOK * 2048 * 4, SZ_ST = (size_t)8 * 2 * 18 * 16 * 8192 * 2,
                 SZ_AL = (size_t)8 * 2 * 18 * 16 * 4, SZ_SUM = (size_t)8 * 2 * 18 * 1024 * 4;
constexpr size_t OFF_WTIN = 0, OFF_WTOUT = OFF_WTIN + SZ_WTIN, OFF_MOD = OFF_WTOUT + SZ_WTOUT, OFF_U = OFF_MOD + SZ_MOD, OFF_P = OFF_U + SZ_U, OFF_MIX = OFF_P + SZ_P,
                 OFF_XB = OFF_MIX + SZ_MIX, OFF_ST = OFF_XB + SZ_XB, OFF_AL = OFF_ST + SZ_ST, OFF_SUMA = OFF_AL + SZ_AL, OFF_SUMB = OFF_SUMA + SZ_SUM, OFF_BAR = OFF_SUMB + SZ_SUM, OFF_SBC = OFF_BAR + 32768, OFF_SBT = OFF_SBC + (size_t)NTOK * 512 * 2, OFF_DTA = OFF_SBT + (size_t)8 * 18 * 2 * 16384 * 2,
                 OFF_ACS = OFF_DTA + (size_t)NTOK * 32 * 4, OFF_HINL = OFF_ACS + (size_t)NTOK * 32 * 4, OFF_GW = OFF_HINL + SZ_SUM, OFF_DTP = OFF_GW + (size_t)4 * 16 * 16384 * 2, OFF_VT = OFF_DTP + (size_t)NTOK * 16 * 4, WS_END = OFF_VT + (size_t)8 * 18 * 2 * 16384 * 2;
constexpr size_t OFF_LXC = OFF_U, OFF_SXT = OFF_U + (size_t)NTOK * 1024 * 2;
constexpr int LDS_CTL = 147456;
constexpr int LDS_BYTES = LDS_CTL + 16;

struct Params {
    const float *x, *c, *ctx, *c_ctx, *norm_w, *ada_w, *ada_b, *w_in, *lru_conv_w, *lru_conv_b, *lru_ga_w, *lru_ga_b, *lru_gx_w, *lru_gx_b, *lru_lambda,
        *att_q_norm, *att_k_norm, *att_sink, *ssd_conv_w, *ssd_conv_b, *ssd_dt_bias, *ssd_A_log, *ssd_D, *ssd_norm_w, *w_out;
    float* out;
    unsigned char* ws;
};
#define WS_WTIN(p) ((bf16_t*)((p).ws + OFF_WTIN))
#define WS_WTOUT(p) ((bf16_t*)((p).ws + OFF_WTOUT))
#define WS_MOD(p) ((float*)((p).ws + OFF_MOD))
#define WS_U(p) ((bf16_t*)((p).ws + OFF_U))
#define WS_P(p) ((bf16_t*)((p).ws + OFF_P))
#define WS_MIX(p) ((bf16_t*)((p).ws + OFF_MIX))
#define WS_XB(p) ((float*)((p).ws + OFF_XB))
#define WS_ST(p) ((bf16_t*)((p).ws + OFF_ST))
#define WS_AL(p) ((float*)((p).ws + OFF_AL))
#define WS_SUMA(p) ((float*)((p).ws + OFF_SUMA))
#define WS_SUMB(p) ((float*)((p).ws + OFF_SUMB))
#define WS_LXC(p) ((bf16_t*)((p).ws + OFF_LXC))
#define WS_SXT(p) ((bf16_t*)((p).ws + OFF_SXT))
#define WS_SBC(p) ((bf16_t*)((p).ws + OFF_SBC))
#define WS_SBT(p) ((bf16_t*)((p).ws + OFF_SBT))
#define WS_DTA(p) ((float*)((p).ws + OFF_DTA))
#define WS_ACS(p) ((float*)((p).ws + OFF_ACS))
#define WS_HINL(p) ((float*)((p).ws + OFF_HINL))
#define WS_GW(p) ((bf16_t*)((p).ws + OFF_GW))
#define WS_DTP(p) ((float*)((p).ws + OFF_DTP))
#define WS_VT(p) ((bf16_t*)((p).ws + OFF_VT))

__device__ __forceinline__ float bf2f(bf16_t v) { return __uint_as_float(((unsigned)v) << 16); }
__device__ __forceinline__ bf16_t f2bf(float f) { return (bf16_t)(cvt_pk_bf16(f, 0.f) & 0xffffu); }
__device__ __forceinline__ float siluf(float v) { return v * __builtin_amdgcn_rcpf(1.f + __expf(-v)); }
__device__ __forceinline__ float sigmf(float v) { return __builtin_amdgcn_rcpf(1.f + __expf(-v)); }
__device__ __forceinline__ float softplusf(float v) { return v > 20.f ? v : log1pf(__expf(v)); }
__device__ __forceinline__ float wave_sum(float v) {
#pragma unroll
    for (int o = 1; o < 64; o <<= 1) v += __shfl_xor(v, o);
    return v;
}
__device__ __forceinline__ f32x8 unpack8(const u32x4 w) {
    f32x8 f;
    f[0] = __uint_as_float(w.x << 16); f[1] = __uint_as_float(w.x & 0xffff0000u); f[2] = __uint_as_float(w.y << 16); f[3] = __uint_as_float(w.y & 0xffff0000u);
    f[4] = __uint_as_float(w.z << 16); f[5] = __uint_as_float(w.z & 0xffff0000u); f[6] = __uint_as_float(w.w << 16); f[7] = __uint_as_float(w.w & 0xffff0000u);
    return f;
}
__device__ __forceinline__ u32x4 pack8(const f32x8 f) { u32x4 w; w.x = cvt_pk_bf16(f[0], f[1]); w.y = cvt_pk_bf16(f[2], f[3]); w.z = cvt_pk_bf16(f[4], f[5]); w.w = cvt_pk_bf16(f[6], f[7]); return w; }
__device__ __forceinline__ void lds_barrier() { asm volatile("s_waitcnt lgkmcnt(0)" ::: "memory"); __builtin_amdgcn_s_barrier(); asm volatile("" ::: "memory"); }
__device__ __forceinline__ float dpp_f(float v, int ctrl_sel) {
    const int x = __builtin_bit_cast(int, v); int r;
    if (ctrl_sel == 0) r = __builtin_amdgcn_update_dpp(x, x, 0xB1, 0xF, 0xF, false);
    else if (ctrl_sel == 1) r = __builtin_amdgcn_update_dpp(x, x, 0x4E, 0xF, 0xF, false);
    else if (ctrl_sel == 2) r = __builtin_amdgcn_update_dpp(x, x, 0x141, 0xF, 0xF, false);
    else r = __builtin_amdgcn_update_dpp(x, x, 0x140, 0xF, 0xF, false);
    return __builtin_bit_cast(float, r);
}
__device__ __forceinline__ float row16_max(float v) { v = fmaxf(v, dpp_f(v, 0)); v = fmaxf(v, dpp_f(v, 1)); v = fmaxf(v, dpp_f(v, 2)); v = fmaxf(v, dpp_f(v, 3)); return v; }
__device__ __forceinline__ float row16_sum(float v) { v += dpp_f(v, 0); v += dpp_f(v, 1); v += dpp_f(v, 2); v += dpp_f(v, 3); return v; }
__device__ __forceinline__ int chunk_at(int d, int pos) { return d == 0 ? pos : (pos < 2 ? 1 - pos : 19 - pos); }
__device__ __forceinline__ int pos_of(int d, int c) { return d == 0 ? c : (c < 2 ? 1 - c : 19 - c); }
__device__ __forceinline__ int rowmap32(int reg, int lane) { return (reg & 3) + 8 * (reg >> 2) + 4 * (lane >> 5); }

template <int K> __device__ __forceinline__ void mm32(f32x16& acc, const bf16_t* A, int lda, const bf16_t* B, int ldb, int lane) {
    const bf16_t* pa = A + (lane & 31) * lda + 8 * (lane >> 5);
    const bf16_t* pb = B + (lane & 31) * ldb + 8 * (lane >> 5);
#pragma unroll
    for (int k = 0; k < K; k += 16) {
        const bf16x8 a = *(const bf16x8*)(pa + k);
        const bf16x8 b = *(const bf16x8*)(pb + k);
        acc = __builtin_amdgcn_mfma_f32_32x32x16_bf16(a, b, acc, 0, 0, 0);
    }
}

template <int NC, bool SILU, bool TRANS>
__device__ __forceinline__ void stage_conv_tile(bf16_t* dst, int ld, const bf16_t* Pb, int t0, int col0, const float* cw, int CS, const float* cb, int tid) {
    constexpr int CG = NC / 8;
    const int lo = t0 < 256 ? 0 : 256, hi = t0 < 256 ? 256 : TPB;
    for (int idx = tid; idx < 128 * CG; idx += 512) {
        int cgi, tl;
        if (TRANS) { tl = idx & 127; cgi = idx >> 7; } else { cgi = idx % CG; tl = idx / CG; }
        const int t = t0 + tl;
        const f32x4 b0 = *(const f32x4*)(cb + cgi * 8), b1 = *(const f32x4*)(cb + cgi * 8 + 4);
        f32x8 acc; acc[0] = b0.x; acc[1] = b0.y; acc[2] = b0.z; acc[3] = b0.w; acc[4] = b1.x; acc[5] = b1.y; acc[6] = b1.z; acc[7] = b1.w;
#pragma unroll
        for (int k = 0; k < 4; ++k) {
            const int tt = t - 2 + k;
            if (tt >= lo && tt < hi) {
                const f32x8 v = unpack8(*(const u32x4*)(Pb + (size_t)tt * LDP + col0 + cgi * 8));
                const f32x4 w0 = *(const f32x4*)(cw + k * CS + cgi * 8), w1 = *(const f32x4*)(cw + k * CS + cgi * 8 + 4);
                acc[0] += w0.x * v[0]; acc[1] += w0.y * v[1]; acc[2] += w0.z * v[2]; acc[3] += w0.w * v[3];
                acc[4] += w1.x * v[4]; acc[5] += w1.y * v[5]; acc[6] += w1.z * v[6]; acc[7] += w1.w * v[7];
            }
        }
        if (SILU) {
#pragma unroll
            for (int e = 0; e < 8; ++e) acc[e] = siluf(acc[e]);
        }
        if (TRANS) {
#pragma unroll
            for (int e = 0; e < 8; ++e) dst[(cgi * 8 + e) * ld + tl] = f2bf(acc[e]);
        } else {
            *(u32x4*)(dst + tl * ld + cgi * 8) = pack8(acc);
        }
    }
}

__device__ __forceinline__ void transpose_item(const float* W, int K, int N, int nblk, bf16_t* WT, float* scr, int item, int lane) {
    const int kb = item / nblk, nb = item % nblk, k0 = 64 * kb, n0 = 32 * nb;
    const int c4 = lane & 7, r8 = lane >> 3, n = n0 + c4 * 4;
    f32x4 tv[8];
#pragma unroll
    for (int i = 0; i < 8; ++i) tv[i] = (n < N) ? *(const f32x4*)(W + (size_t)(k0 + i * 8 + r8) * N + n) : (f32x4){0.f, 0.f, 0.f, 0.f};
#pragma unroll
    for (int i = 0; i < 8; ++i) { float* d = scr + (i * 8 + r8) * 33 + c4 * 4; d[0] = tv[i].x; d[1] = tv[i].y; d[2] = tv[i].z; d[3] = tv[i].w; }
    asm volatile("s_waitcnt lgkmcnt(0)" ::: "memory");
    const int c = lane & 7;
#pragma unroll
    for (int j = 0; j < 4; ++j) {
        const int nn = (lane >> 3) + 8 * j; const float* s = scr + (8 * c) * 33 + nn;
        u32x4 o; o.x = cvt_pk_bf16(s[0 * 33], s[1 * 33]); o.y = cvt_pk_bf16(s[2 * 33], s[3 * 33]); o.z = cvt_pk_bf16(s[4 * 33], s[5 * 33]); o.w = cvt_pk_bf16(s[6 * 33], s[7 * 33]);
        *(u32x4*)(WT + (size_t)(n0 + nn) * K + k0 + 8 * c) = o;
    }
    asm volatile("s_waitcnt lgkmcnt(0)" ::: "memory");
}

__device__ __forceinline__ void phase0(const Params& p, unsigned char* shm, int G) {
    const int tid = tidx(), lane = tid & 63, wave = tid >> 6;
    float* sf = (float*)shm;
    float* MOD = WS_MOD(p);
    for (int item = blockIdx.x; item < 96; item += G) {
        const int l = item / 24, cgp = item % 24;
        __syncthreads();
        for (int idx = tid; idx < 9 * 2048; idx += 512) { const int r = idx >> 11, k = idx & 2047; const float v = r < 8 ? p.c[r * 2048 + k] : p.c_ctx[k]; sf[idx] = siluf(v); }
        __syncthreads();
        f32x4 acc[9];
#pragma unroll
        for (int r = 0; r < 9; ++r) acc[r] = (f32x4){0.f, 0.f, 0.f, 0.f};
        const float* wp = p.ada_w + ((size_t)l * 2048 + wave * 256) * 6144 + cgp * 256 + lane * 4;
#pragma unroll 16
        for (int kk = 0; kk < 256; ++kk) {
            const f32x4 wv = *(const f32x4*)(wp + (size_t)kk * 6144);
            const int k = wave * 256 + kk;
#pragma unroll
            for (int r = 0; r < 9; ++r) { const float s = sf[r * 2048 + k]; acc[r] += wv * s; }
        }
        __syncthreads();
#pragma unroll
        for (int r = 0; r < 9; ++r) *(f32x4*)(sf + (wave * 9 + r) * 256 + lane * 4) = acc[r];
        __syncthreads();
        for (int idx = tid; idx < 9 * 256; idx += 512) {
            const int r = idx >> 8, col = idx & 255; float s = p.ada_b[l * 6144 + cgp * 256 + col];
#pragma unroll
            for (int w = 0; w < 8; ++w) s += sf[(w * 9 + r) * 256 + col];
            MOD[(size_t)(l * 9 + r) * 6144 + cgp * 256 + col] = s;
        }
    }
    __syncthreads();
    float* scr = sf + wave * (64 * 33);
    const int gw = blockIdx.x * 8 + wave, NGW = G * 8;
    constexpr int I_IN = 32 * 232, I_OUT = 48 * 64;
    for (int it = gw; it < 4 * (I_IN + I_OUT); it += NGW) {
        if (it < 4 * I_IN) { const int l = it / I_IN, r = it % I_IN; transpose_item(p.w_in + (size_t)l * 2048 * 7184, 2048, 7184, 232, WS_WTIN(p) + (size_t)l * 7424 * 2048, scr, r, lane); }
        else { const int it2 = it - 4 * I_IN, l = it2 / I_OUT, r = it2 % I_OUT; transpose_item(p.w_out + (size_t)l * 3072 * 2048, 3072, 2048, 64, WS_WTOUT(p) + (size_t)l * 2048 * 3072, scr, r, lane); }
    }
    for (int idx = (int)blockIdx.x * 512 + tid; idx < 4 * 16 * 16384; idx += G * 512) {
        const int i = idx & 63, o = (idx >> 6) & 63, gate = (idx >> 12) & 1, d = (idx >> 13) & 1, j = (idx >> 14) & 15, l = idx >> 18;
        const float* w = gate ? p.lru_gx_w : p.lru_ga_w;
        WS_GW(p)[idx] = f2bf(w[(size_t)((l * 2 + d) * 16 + j) * 4096 + i * 64 + o]);
    }
}

__device__ __forceinline__ const float* xrow_src(const Params& p, int l, int row) {
    const int b = row / TPB, t = row % TPB;
    if (l == 0) return t < 256 ? p.ctx + ((size_t)b * 256 + t) * DM : p.x + ((size_t)b * 2048 + (t - 256)) * DM;
    return WS_XB(p) + (size_t)row * DM;
}
__device__ __forceinline__ void norm_phase(const Params& p, int l, int G) {
    const int lane = tidx() & 63, wave = tidx() >> 6;
    bf16_t* U = WS_U(p);
    for (int row = blockIdx.x * 8 + wave; row < NTOK; row += G * 8) {
        const int b = row / TPB, t = row % TPB;
        const float* src = xrow_src(p, l, row);
        const float* md = WS_MOD(p) + (size_t)(l * 9 + (t < 256 ? 8 : b)) * 6144;
        f32x4 v[8]; float ss = 0.f;
#pragma unroll
        for (int j = 0; j < 8; ++j) { v[j] = *(const f32x4*)(src + 4 * lane + 256 * j); ss += v[j].x * v[j].x + v[j].y * v[j].y + v[j].z * v[j].z + v[j].w * v[j].w; }
        ss = wave_sum(ss);
        const float rstd = rsqrtf(ss * (1.f / 2048.f) + 1e-6f);
#pragma unroll
        for (int j = 0; j < 8; ++j) {
            const int col = 4 * lane + 256 * j;
            const f32x4 nw = *(const f32x4*)(p.norm_w + l * 2048 + col), sh = *(const f32x4*)(md + col), sc = *(const f32x4*)(md + 2048 + col);
            const f32x4 y = v[j] * rstd * nw * (sc + 1.f) + sh;
            u32x2 w; w.x = cvt_pk_bf16(y.x, y.y); w.y = cvt_pk_bf16(y.z, y.w);
            *(u32x2*)(U + (size_t)row * DM + col) = w;
        }
    }
}

struct EpiG1 {
    static constexpr bool PERM = true, AFTER_DRAIN = false;
    bf16_t* P;
    __device__ __forceinline__ void operator()(const f32x4 (&acc)[2][2][4][2], const pg8::Unit& u, int wr, int wc, int fr, int fq) const {
        const int row0 = u.pm * 256 + wr * 64 + fr, col0 = u.pn * 256 + wc * 32 + 8 * fq;
#pragma unroll
        for (int ai = 0; ai < 2; ++ai)
#pragma unroll
            for (int m = 0; m < 4; ++m) { bf16_t* rowp = P + (size_t)(row0 + ai * 128 + m * 16) * LDP + col0;
#pragma unroll
                for (int bj = 0; bj < 2; ++bj) { const f32x4 v0 = acc[ai][bj][m][0], v1 = acc[ai][bj][m][1];
                    u32x4 w; w.x = cvt_pk_bf16(v0.x, v0.y); w.y = cvt_pk_bf16(v0.z, v0.w); w.z = cvt_pk_bf16(v1.x, v1.y); w.w = cvt_pk_bf16(v1.z, v1.w);
                    *(u32x4*)(rowp + bj * 128) = w; } }
    }
};
struct EpiG2 {
    static constexpr bool PERM = false, AFTER_DRAIN = false;
    Params p; int l; int scr;
    __device__ __forceinline__ void operator()(const f32x4 (&acc)[2][2][4][2], const pg8::Unit& u, int wr, int wc, int fr, int fq) const {
        const int row0 = u.pm * 256 + wr * 64 + fr, col0 = u.pn * 256 + wc * 32 + 4 * fq;
#pragma unroll
        for (int ai = 0; ai < 2; ++ai)
#pragma unroll
            for (int m = 0; m < 4; ++m) {
                const int row = row0 + ai * 128 + m * 16, b = row / TPB, t = row % TPB;
                if (l == 3 && t < 256) continue;
                const float* xo = xrow_src(p, l, row);
                float* dst = scr ? (float*)WS_P(p) + (size_t)row * DM : (l == 3) ? p.out + ((size_t)b * 2048 + (t - 256)) * DM : WS_XB(p) + (size_t)row * DM;
                const float* gt = WS_MOD(p) + (size_t)(l * 9 + (t < 256 ? 8 : b)) * 6144 + 4096;
#pragma unroll
                for (int bj = 0; bj < 2; ++bj)
#pragma unroll
                    for (int n = 0; n < 2; ++n) { const int col = col0 + bj * 128 + n * 16; const f32x4 xv = *(const f32x4*)(xo + col), g = *(const f32x4*)(gt + col); *(f32x4*)(dst + col) = xv + g * acc[ai][bj][m][n]; }
            }
    }
};

template <int SCR>
__device__ __forceinline__ void qkprep_row(const Params& p, int l, int row, int lane) {
    const int t = row % TPB;
    bf16_t* rp = WS_P(p) + (size_t)row * LDP;
    float cs = 1.f, sn = 0.f;
    if (t >= 256) {
        const int s = t - 256, rr = s >> 6, cc = s & 63, f = lane & 31;
        const float inv = exp2f(-(float)f * (13.287712379549449f / 32.f));
        const float ang = (float)(lane < 32 ? rr : cc) * inv;
        cs = __cosf(ang); sn = __sinf(ang);
    }
#pragma unroll
    for (int slot = 0; slot < 10; ++slot) {
        const int col = slot < 8 ? C_Q + slot * 128 : C_K + (slot - 8) * 128;
        const float* w = slot < 8 ? p.att_q_norm + l * 128 : p.att_k_norm + l * 128;
        const float v1 = bf2f(rp[col + lane]), v2 = bf2f(rp[col + 64 + lane]);
        const float ss = wave_sum(v1 * v1 + v2 * v2);
        const float rstd = rsqrtf(ss * (1.f / 128.f) + 1e-6f);
        const float y1 = v1 * rstd * w[lane], y2 = v2 * rstd * w[64 + lane];
        float o1 = y1 * cs - y2 * sn, o2 = y1 * sn + y2 * cs;
        if (slot < 8) { o1 *= 0.08838834764831845f; o2 *= 0.08838834764831845f; }
        if (SCR) { bf16_t* sp = WS_ST(p) + (size_t)row * 1280 + slot * 128; sp[lane] = f2bf(o1); sp[64 + lane] = f2bf(o2); } else { rp[col + lane] = f2bf(o1); rp[col + 64 + lane] = f2bf(o2); }
    }
}

template <int D, int SCR = 0>
__device__ __forceinline__ void lru_sweep_item(const Params& p, int l, int item, unsigned char* shm) {
    const int tid = tidx(), lane = tid & 63, wave = tid >> 6, ch = tid & 63, seg = tid >> 6;
    const int j = item & 15, b = item >> 4;
    bf16_t* sX = (bf16_t*)shm; bf16_t* sW = (bf16_t*)(shm + 18432);
    float* sA = (float*)(shm + 36864); float* sB = (float*)(shm + 69632); float* sSA = (float*)(shm + 102400); float* sSB = (float*)(shm + 104448);
    bf16_t* sOut = (bf16_t*)(shm + 106496);
    const int mi = wave & 3, nj = wave >> 2, cl = nj * 32 + (lane & 31), cgl = j * 64 + cl;
    const float ba = p.lru_ga_b[(l * 2 + D) * 1024 + cgl], bx = p.lru_gx_b[(l * 2 + D) * 1024 + cgl], sp = softplusf(-p.lru_lambda[(l * 2 + D) * 1024 + cgl]);
    lds_barrier();
    {
        u32x4 wr2[2];
#pragma unroll
        for (int k = 0; k < 2; ++k) { const int idx = tid + k * 512; wr2[k] = *(const u32x4*)(WS_GW(p) + (size_t)(l * 16 + j) * 16384 + D * 8192 + idx * 8); }
#pragma unroll
        for (int k = 0; k < 2; ++k) { const int idx = tid + k * 512; *(u32x4*)(sW + (idx >> 3) * 72 + (idx & 7) * 8) = wr2[k]; }
    }
    u32x4 xr[2], lgr[2], hfr[2];
    {
        const size_t tok0 = (size_t)b * TPB + chunk_at(D, 0) * 128;
#pragma unroll
        for (int k = 0; k < 2; ++k) {
            const int idx = tid + k * 512;
            xr[k] = *(const u32x4*)(WS_LXC(p) + (tok0 + (idx >> 3)) * 1024 + j * 64 + (idx & 7) * 8);
            if (D == 1) { lgr[k] = *(const u32x4*)(WS_P(p) + (tok0 + (idx >> 3)) * LDP + C_LG + j * 64 + (idx & 7) * 8); hfr[k] = *(const u32x4*)(WS_MIX(p) + (tok0 + (idx >> 3)) * MIXW + j * 64 + (idx & 7) * 8); }
        }
    }
    float carry = 0.f;
#pragma unroll 1
    for (int pos = 0; pos < NCH; ++pos) {
        const size_t tok0 = (size_t)b * TPB + chunk_at(D, pos) * 128;
#pragma unroll
        for (int k = 0; k < 2; ++k) { const int idx = tid + k * 512; *(u32x4*)(sX + (idx >> 3) * 72 + (idx & 7) * 8) = xr[k]; }
        u32x4 lgc[2], hfc[2];
        if (D == 1) { lgc[0] = lgr[0]; lgc[1] = lgr[1]; hfc[0] = hfr[0]; hfc[1] = hfr[1]; }
        if (pos + 1 < NCH) {
            const size_t tokn = (size_t)b * TPB + chunk_at(D, pos + 1) * 128;
#pragma unroll
            for (int k = 0; k < 2; ++k) {
                const int idx = tid + k * 512;
                xr[k] = *(const u32x4*)(WS_LXC(p) + (tokn + (idx >> 3)) * 1024 + j * 64 + (idx & 7) * 8);
                if (D == 1) { lgr[k] = *(const u32x4*)(WS_P(p) + (tokn + (idx >> 3)) * LDP + C_LG + j * 64 + (idx & 7) * 8); hfr[k] = *(const u32x4*)(WS_MIX(p) + (tokn + (idx >> 3)) * MIXW + j * 64 + (idx & 7) * 8); }
            }
        }
        lds_barrier();
        {
            f32x16 ga, gx;
#pragma unroll
            for (int r = 0; r < 16; ++r) { ga[r] = 0.f; gx[r] = 0.f; }
            mm32<64>(ga, sX + mi * 32 * 72, 72, sW + (nj * 32) * 72, 72, lane);
            mm32<64>(gx, sX + mi * 32 * 72, 72, sW + (64 + nj * 32) * 72, 72, lane);
#pragma unroll
            for (int r = 0; r < 16; ++r) {
                const int tl = mi * 32 + rowmap32(r, lane);
                const float rg = sigmf(ga[r] + ba), ig = sigmf(gx[r] + bx);
                const float a = __expf(-8.f * rg * sp), mult = __builtin_amdgcn_sqrtf(fmaxf(1.f - a * a, 0.f));
                const float xv = bf2f(sX[tl * 72 + cl]);
                sA[tl * 64 + cl] = a; sB[tl * 64 + cl] = mult * ig * xv;
            }
        }
        lds_barrier();
        {
            float A = 1.f, Bc = 0.f;
#pragma unroll
            for (int q = 0; q < 16; ++q) { const int tl = seg * 16 + (D == 0 ? q : 15 - q); const float a = sA[tl * 64 + ch], bb = sB[tl * 64 + ch]; A = a * A; Bc = a * Bc + bb; }
            sSA[seg * 64 + ch] = A; sSB[seg * 64 + ch] = Bc;
        }
        lds_barrier();
        {
            float h = carry, cn = carry;
            const int myord = D == 0 ? seg : 7 - seg;
#pragma unroll
            for (int s = 0; s < 8; ++s) { const int sg = D == 0 ? s : 7 - s; const float a = sSA[sg * 64 + ch], bb = sSB[sg * 64 + ch]; cn = a * cn + bb; if (s < myord) h = cn; }
            carry = cn;
#pragma unroll
            for (int q = 0; q < 16; ++q) { const int tl = seg * 16 + (D == 0 ? q : 15 - q); h = sA[tl * 64 + ch] * h + sB[tl * 64 + ch]; sOut[tl * 72 + ch] = f2bf(h); }
        }
        lds_barrier();
#pragma unroll
        for (int k = 0; k < 2; ++k) {
            const int idx = tid + k * 512, rr = idx >> 3, ck = idx & 7;
            const u32x4 hv = *(const u32x4*)(sOut + rr * 72 + ck * 8);
            bf16_t* dst = SCR ? WS_P(p) + (tok0 + rr) * LDP + j * 64 + ck * 8 : WS_MIX(p) + (tok0 + rr) * MIXW + j * 64 + ck * 8;
            if (D == 0) *(u32x4*)dst = hv;
            else {
                const f32x8 a = unpack8(hv), f = unpack8(hfc[k]), g = unpack8(lgc[k]);
                f32x8 o;
#pragma unroll
                for (int e = 0; e < 8; ++e) o[e] = (a[e] + f[e]) * siluf(g[e]);
                *(u32x4*)dst = pack8(o);
            }
        }
    }
}

__device__ __forceinline__ void prep_elem(const Params& p, int l, int G) {
    const int gt = (int)blockIdx.x * 512 + tidx(), NT = G * 512;
    constexpr int NI = NTOK * 192, U = 3;
    for (int base = gt; base < NI; base += NT * U) {
        u32x4 raw[U][4];
#pragma unroll
        for (int u = 0; u < U; ++u) {
            const int idx = base + u * NT;
            if (idx < NI) {
                const int tok = idx / 192, cgi = idx % 192, b = tok / TPB, t = tok % TPB;
                const int lo = t < 256 ? 0 : 256, hi = t < 256 ? 256 : TPB;
                const int col = cgi < 128 ? C_LX + cgi * 8 : C_XBC + 1024 + (cgi - 128) * 8;
                const bf16_t* src = WS_P(p) + (size_t)b * TPB * LDP + col;
#pragma unroll
                for (int k = 0; k < 4; ++k) { const int tt = t - 2 + k; raw[u][k] = (tt >= lo && tt < hi) ? *(const u32x4*)(src + (size_t)tt * LDP) : (u32x4){0u, 0u, 0u, 0u}; }
            }
        }
#pragma unroll
        for (int u = 0; u < U; ++u) {
            const int idx = base + u * NT;
            if (idx < NI) {
                const int tok = idx / 192, cgi = idx % 192;
                int CS; const float *cw, *cb; bf16_t* dst; bool act;
                if (cgi < 128) { cw = p.lru_conv_w + l * 4096 + cgi * 8; CS = 1024; cb = p.lru_conv_b + l * 1024 + cgi * 8; act = false; dst = WS_LXC(p) + (size_t)tok * 1024 + cgi * 8; }
                else { const int c2 = (cgi - 128) * 8; cw = p.ssd_conv_w + l * 6144 + 1024 + c2; CS = 1536; cb = p.ssd_conv_b + l * 1536 + 1024 + c2; act = true; dst = WS_SBC(p) + (size_t)tok * 512 + c2; }
                const f32x4 b0 = *(const f32x4*)cb, b1 = *(const f32x4*)(cb + 4);
                f32x8 acc; acc[0] = b0.x; acc[1] = b0.y; acc[2] = b0.z; acc[3] = b0.w; acc[4] = b1.x; acc[5] = b1.y; acc[6] = b1.z; acc[7] = b1.w;
#pragma unroll
                for (int k = 0; k < 4; ++k) {
                    const f32x8 v = unpack8(raw[u][k]);
                    const f32x4 w0 = *(const f32x4*)(cw + k * CS), w1 = *(const f32x4*)(cw + k * CS + 4);
                    acc[0] += w0.x * v[0]; acc[1] += w0.y * v[1]; acc[2] += w0.z * v[2]; acc[3] += w0.w * v[3];
                    acc[4] += w1.x * v[4]; acc[5] += w1.y * v[5]; acc[6] += w1.z * v[6]; acc[7] += w1.w * v[7];
                }
                if (act) {
#pragma unroll
                    for (int e = 0; e < 8; ++e) acc[e] = siluf(acc[e]);
                }
                *(u32x4*)dst = pack8(acc);
            }
        }
    }
}
struct PrepTile { int col0, ch0, t0, lo, hi, conv; const bf16_t* Pb; bf16_t* dst; };
__device__ __forceinline__ PrepTile prep_tile_decode(const Params& p, int item) {
    PrepTile T;
    const int t24 = item % 24, bc = item / 24, c = bc % NCH, b = bc / NCH;
    T.t0 = c * 128; T.Pb = WS_P(p) + (size_t)b * TPB * LDP; T.ch0 = 0; T.conv = t24 < 20;
    if (t24 < 16) { T.ch0 = t24 * 64; T.col0 = C_XBC + T.ch0; T.dst = WS_SXT(p) + ((size_t)((b * 18 + c) * 16 + t24)) * 8192; }
    else if (t24 < 20) { const int q = t24 - 16, g = q >> 1, nh = q & 1; T.ch0 = 1024 + g * 128 + nh * 64; T.col0 = C_XBC + T.ch0; T.dst = WS_SBT(p) + ((size_t)((b * 18 + c) * 2 + g)) * 16384 + (size_t)nh * 64 * 128; }
    else { const int q = t24 - 20, kh = q >> 1, dh = q & 1; T.col0 = C_V + kh * 128 + dh * 64; T.dst = WS_VT(p) + ((size_t)((b * 18 + c) * 2 + kh)) * 16384 + (size_t)dh * 64 * 128; }
    T.lo = T.t0 < 256 ? 0 : 256; T.hi = T.t0 < 256 ? 256 : TPB;
    return T;
}
__device__ __forceinline__ void prep_tile_load(const PrepTile& T, int tid, u32x4 (&raw)[2][4]) {
#pragma unroll
    for (int k = 0; k < 2; ++k) {
        const int idx = tid + k * 512, cgi = idx & 7, t = T.t0 + (idx >> 3);
#pragma unroll
        for (int q = 0; q < 4; ++q) {
            const int tt = T.conv ? t - 2 + q : t;
            const bool ok = T.conv ? (tt >= T.lo && tt < T.hi) : (q == 2);
            raw[k][q] = ok ? *(const u32x4*)(T.Pb + (size_t)tt * LDP + T.col0 + cgi * 8) : (u32x4){0u, 0u, 0u, 0u};
        }
    }
}
__device__ __forceinline__ void prep_tile_finish(const Params& p, int l, const PrepTile& T, int tid, const u32x4 (&raw)[2][4], unsigned char* shm) {
    bf16_t* sT = (bf16_t*)shm;
    const float* cw = p.ssd_conv_w + l * 6144 + T.ch0; const float* cb = p.ssd_conv_b + l * 1536 + T.ch0;
    lds_barrier();
#pragma unroll
    for (int k = 0; k < 2; ++k) {
        const int idx = tid + k * 512, cgi = idx & 7, tl = idx >> 3;
        f32x8 acc;
        if (T.conv) {
            const f32x4 b0 = *(const f32x4*)(cb + cgi * 8), b1 = *(const f32x4*)(cb + cgi * 8 + 4);
            acc[0] = b0.x; acc[1] = b0.y; acc[2] = b0.z; acc[3] = b0.w; acc[4] = b1.x; acc[5] = b1.y; acc[6] = b1.z; acc[7] = b1.w;
#pragma unroll
            for (int q = 0; q < 4; ++q) {
                const f32x8 v = unpack8(raw[k][q]);
                const f32x4 w0 = *(const f32x4*)(cw + q * 1536 + cgi * 8), w1 = *(const f32x4*)(cw + q * 1536 + cgi * 8 + 4);
                acc[0] += w0.x * v[0]; acc[1] += w0.y * v[1]; acc[2] += w0.z * v[2]; acc[3] += w0.w * v[3];
                acc[4] += w1.x * v[4]; acc[5] += w1.y * v[5]; acc[6] += w1.z * v[6]; acc[7] += w1.w * v[7];
            }
#pragma unroll
            for (int e = 0; e < 8; ++e) acc[e] = siluf(acc[e]);
        } else acc = unpack8(raw[k][2]);
#pragma unroll
        for (int e = 0; e < 8; ++e) sT[(cgi * 8 + e) * 130 + tl] = f2bf(acc[e]);
    }
    lds_barrier();
#pragma unroll
    for (int k = 0; k < 2; ++k) {
        const int idx = tid + k * 512, r = idx >> 4, ck = idx & 15;
        const unsigned* sp = (const unsigned*)(sT + r * 130 + ck * 8);
        u32x4 o; o.x = sp[0]; o.y = sp[1]; o.z = sp[2]; o.w = sp[3];
        *(u32x4*)(T.dst + r * 128 + ck * 8) = o;
    }
}
__device__ __forceinline__ void prep_tiles(const Params& p, int l, int bid, int G, unsigned char* shm) {
    const int tid = tidx();
    if (bid >= 3456) return;
    u32x4 raw[2][4], nraw[2][4];
    { const PrepTile T0 = prep_tile_decode(p, bid); prep_tile_load(T0, tid, raw); }
#pragma unroll 1
    for (int it = bid; it < 3456; it += G) {
        const bool more = it + G < 3456;
        if (more) { const PrepTile Tn = prep_tile_decode(p, it + G); prep_tile_load(Tn, tid, nraw); }
        { const PrepTile T = prep_tile_decode(p, it); prep_tile_finish(p, l, T, tid, raw, shm); }
        if (more) {
#pragma unroll
            for (int k = 0; k < 2; ++k)
#pragma unroll
                for (int q = 0; q < 4; ++q) raw[k][q] = nraw[k][q];
        }
    }
}
__device__ __forceinline__ void prep_dt_item(const Params& p, int l, int item) {
    const int tid = tidx();
    const int c = item % NCH, b = item / NCH;
    const int col32 = tid >> 4, h = col32 >> 1, d = col32 & 1, lane16 = tid & 15, seg = d == 0 ? lane16 : 15 - lane16;
    const float A = -__expf(p.ssd_A_log[(l * 2 + d) * 16 + h]), bias = p.ssd_dt_bias[(l * 2 + d) * 16 + h];
    const float* src = WS_DTP(p) + ((size_t)b * TPB + c * 128) * 16 + h;
    float dtv[8], cs[8], run = 0.f;
    float rawv[8];
#pragma unroll
    for (int q = 0; q < 8; ++q) { const int j = seg * 8 + (d == 0 ? q : 7 - q); rawv[q] = src[j * 16]; }
#pragma unroll
    for (int q = 0; q < 8; ++q) { dtv[q] = softplusf(rawv[q] + bias); run += dtv[q] * A; cs[q] = run; }
    float incl = run;
#pragma unroll
    for (int off = 1; off < 16; off <<= 1) { const float v = __shfl_up(incl, off, 16); if (lane16 >= off) incl += v; }
    const float excl = incl - run;
    float* dta = WS_DTA(p) + ((size_t)(b * 18 + c) * 128) * 32 + col32;
    float* acs = WS_ACS(p) + ((size_t)(b * 18 + c) * 128) * 32 + col32;
#pragma unroll
    for (int q = 0; q < 8; ++q) { const int j = seg * 8 + (d == 0 ? q : 7 - q); dta[j * 32] = dtv[q]; acs[j * 32] = cs[q] + excl; }
    if (lane16 == 15) WS_AL(p)[((b * 2 + d) * 18 + c) * 16 + h] = incl;
}
__device__ __forceinline__ void ssd_states_item(const Params& p, int l, int item, unsigned char* shm) {
    const int tid = tidx(), lane = tid & 63, wave = tid >> 6;
    const int g = item & 1, hh0 = ((item >> 1) & 1) * 4, bc = item >> 2, c = bc % NCH, b = bc / NCH;
    bf16_t* sBT = (bf16_t*)shm; bf16_t* sXw = (bf16_t*)(shm + 34816);
    float* sDt = (float*)(shm + 69632); float* sAcs = (float*)(shm + 77824); bf16_t* sO = (bf16_t*)(shm + 86016); float* sWg = (float*)(shm + 120832);
    const bf16_t* xt = WS_SXT(p) + ((size_t)((b * 18 + c) * 16 + g * 8)) * 8192;
    const bf16_t* btp = WS_SBT(p) + ((size_t)((b * 18 + c) * 2 + g)) * 16384;
    lds_barrier();
    {
        const size_t o = ((size_t)(b * 18 + c) * 128 + (tid >> 2)) * 32 + g * 16 + (tid & 3) * 4;
        const f32x4 vdt = *(const f32x4*)(WS_DTA(p) + o), vac = *(const f32x4*)(WS_ACS(p) + o);
        u32x4 bt[4];
#pragma unroll
        for (int k = 0; k < 4; ++k) { const int idx = tid + k * 512; bt[k] = *(const u32x4*)(btp + (idx >> 4) * 128 + (idx & 15) * 8); }
        *(f32x4*)(sDt + (tid >> 2) * 16 + (tid & 3) * 4) = vdt; *(f32x4*)(sAcs + (tid >> 2) * 16 + (tid & 3) * 4) = vac;
#pragma unroll
        for (int k = 0; k < 4; ++k) { const int idx = tid + k * 512; *(u32x4*)(sBT + (idx >> 4) * 136 + (idx & 15) * 8) = bt[k]; }
    }
    u32x4 xr[2];
#pragma unroll
    for (int k = 0; k < 2; ++k) { const int idx = tid + k * 512; xr[k] = *(const u32x4*)(xt + (size_t)hh0 * 8192 + (idx >> 4) * 128 + (idx & 15) * 8); }
    lds_barrier();
#pragma unroll
    for (int k = 0; k < 4; ++k) { const int idx = tid + k * 512, jj = idx >> 4, col = idx & 15; const float al = (col & 1) == 0 ? sAcs[127 * 16 + col] : sAcs[col]; sWg[col * 128 + jj] = __expf(al - sAcs[jj * 16 + col]) * sDt[jj * 16 + col]; }
#pragma unroll 1
    for (int hh = hh0; hh < hh0 + 4; ++hh) {
        const int h = g * 8 + hh;
        u32x4 xn[2] = {xr[0], xr[1]};
        if (hh < hh0 + 3) {
#pragma unroll
            for (int k = 0; k < 2; ++k) { const int idx = tid + k * 512; xn[k] = *(const u32x4*)(xt + (size_t)(hh + 1) * 8192 + (idx >> 4) * 128 + (idx & 15) * 8); }
        }
        lds_barrier();
#pragma unroll
        for (int k = 0; k < 2; ++k) {
            const int idx = tid + k * 512, pp = idx >> 4, j8 = (idx & 15) * 8;
            const f32x8 xv = unpack8(xr[k]);
#pragma unroll
            for (int d = 0; d < 2; ++d) {
                const f32x4 w0 = *(const f32x4*)(sWg + (hh * 2 + d) * 128 + j8), w1 = *(const f32x4*)(sWg + (hh * 2 + d) * 128 + j8 + 4);
                f32x8 o;
                o[0] = xv[0] * w0.x; o[1] = xv[1] * w0.y; o[2] = xv[2] * w0.z; o[3] = xv[3] * w0.w; o[4] = xv[4] * w1.x; o[5] = xv[5] * w1.y; o[6] = xv[6] * w1.z; o[7] = xv[7] * w1.w;
                *(u32x4*)(sXw + d * 8704 + pp * 136 + j8) = pack8(o);
            }
        }
        lds_barrier();
        const int mi = wave & 1, nj = wave >> 1;
#pragma unroll
        for (int d = 0; d < 2; ++d) {
            f32x16 acc;
#pragma unroll
            for (int r = 0; r < 16; ++r) acc[r] = 0.f;
            mm32<128>(acc, sXw + d * 8704 + mi * 32 * 136, 136, sBT + nj * 32 * 136, 136, lane);
#pragma unroll
            for (int r = 0; r < 16; ++r) sO[d * 8704 + (mi * 32 + rowmap32(r, lane)) * 136 + nj * 32 + (lane & 31)] = f2bf(acc[r]);
        }
        lds_barrier();
#pragma unroll
        for (int d = 0; d < 2; ++d) {
            bf16_t* base = WS_ST(p) + ((size_t)((b * 2 + d) * 18 + c) * 16 + h) * 8192;
#pragma unroll
            for (int k = 0; k < 2; ++k) { const int idx = tid + k * 512; *(u32x4*)(base + idx * 8) = *(const u32x4*)(sO + d * 8704 + (idx >> 4) * 136 + (idx & 15) * 8); }
        }
        xr[0] = xn[0]; xr[1] = xn[1];
    }
}
__device__ __forceinline__ void ssd_recur_item(const Params& p, int item) {
    const int tid = tidx();
    const int d = item & 1, h = (item >> 1) & 15, b = item >> 5;
    u32x4 s0[NCH], s1[NCH]; float ev[NCH];
#pragma unroll
    for (int pos = 0; pos < NCH; ++pos) {
        const int c = chunk_at(d, pos);
        const bf16_t* ptr = WS_ST(p) + ((size_t)((b * 2 + d) * 18 + c) * 16 + h) * 8192 + tid * 16;
        s0[pos] = *(const u32x4*)ptr; s1[pos] = *(const u32x4*)(ptr + 8);
        ev[pos] = WS_AL(p)[((b * 2 + d) * 18 + c) * 16 + h];
    }
    f32x8 h0, h1;
#pragma unroll
    for (int e = 0; e < 8; ++e) { h0[e] = 0.f; h1[e] = 0.f; }
#pragma unroll
    for (int pos = 0; pos < NCH; ++pos) {
        const int c = chunk_at(d, pos);
        bf16_t* ptr = WS_ST(p) + ((size_t)((b * 2 + d) * 18 + c) * 16 + h) * 8192 + tid * 16;
        *(u32x4*)ptr = pack8(h0); *(u32x4*)(ptr + 8) = pack8(h1);
        const float e = __expf(ev[pos]);
        h0 = h0 * e + unpack8(s0[pos]); h1 = h1 * e + unpack8(s1[pos]);
    }
}
template <int MODE>
__device__ __forceinline__ void ssd_final_item(const Params& p, int l, int item, unsigned char* shm) {
    const int tid = tidx(), lane = tid & 63, wave = tid >> 6;
    const int g = item & 1, hh0 = ((item >> 1) & 1) * 4, bc = item >> 2, c = bc % NCH, b = bc / NCH, t0 = c * 128;
    const size_t tok0 = (size_t)b * TPB + t0;
    bf16_t* sC = (bf16_t*)shm; bf16_t* sBW = (bf16_t*)(shm + 34816); bf16_t* sXT = (bf16_t*)(shm + 69632); bf16_t* sH = (bf16_t*)(shm + 87040);
    float* sDt = (float*)(shm + 104448); float* sAcs = (float*)(shm + 112640);
    bf16_t* sY = sBW;
    const bf16_t* xt = WS_SXT(p) + ((size_t)((b * 18 + c) * 16 + g * 8)) * 8192;
    const bf16_t* zt = WS_P(p) + tok0 * LDP + C_Z + g * 512;
    const bf16_t* hin0 = WS_ST(p) + ((size_t)((b * 2 + 0) * 18 + c) * 16 + g * 8) * 8192;
    const bf16_t* hin1 = WS_ST(p) + ((size_t)((b * 2 + 1) * 18 + c) * 16 + g * 8) * 8192;
    lds_barrier();
    u32x4 xr[2], zr[2], h0r[2];
    {
        const size_t o = ((size_t)(b * 18 + c) * 128 + (tid >> 2)) * 32 + g * 16 + (tid & 3) * 4;
        const f32x4 vdt = *(const f32x4*)(WS_DTA(p) + o), vac = *(const f32x4*)(WS_ACS(p) + o);
        u32x4 cr[4], br[4];
#pragma unroll
        for (int k = 0; k < 4; ++k) { const int idx = tid + k * 512; const bf16_t* s = WS_SBC(p) + (tok0 + (idx >> 4)) * 512 + g * 128 + (idx & 15) * 8; br[k] = *(const u32x4*)s; cr[k] = *(const u32x4*)(s + 256); }
#pragma unroll
        for (int k = 0; k < 2; ++k) {
            const int idx = tid + k * 512;
            xr[k] = *(const u32x4*)(xt + (size_t)hh0 * 8192 + (idx >> 4) * 128 + (idx & 15) * 8);
            zr[k] = *(const u32x4*)(zt + (size_t)(idx >> 3) * LDP + hh0 * 64 + (idx & 7) * 8);
            h0r[k] = *(const u32x4*)(hin0 + (size_t)hh0 * 8192 + idx * 8);
        }
        *(f32x4*)(sDt + (tid >> 2) * 16 + (tid & 3) * 4) = vdt; *(f32x4*)(sAcs + (tid >> 2) * 16 + (tid & 3) * 4) = vac;
#pragma unroll
        for (int k = 0; k < 4; ++k) { const int idx = tid + k * 512; *(u32x4*)(sC + (idx >> 4) * 136 + (idx & 15) * 8) = cr[k]; *(u32x4*)(sBW + (idx >> 4) * 136 + (idx & 15) * 8) = br[k]; }
    }
    lds_barrier();
    const int cmi = wave >> 1, cnj0 = (wave & 1) * 2;
    f32x16 cb0, cb1;
#pragma unroll
    for (int r = 0; r < 16; ++r) { cb0[r] = 0.f; cb1[r] = 0.f; }
    mm32<128>(cb0, sC + cmi * 32 * 136, 136, sBW + cnj0 * 32 * 136, 136, lane);
    mm32<128>(cb1, sC + cmi * 32 * 136, 136, sBW + (cnj0 + 1) * 32 * 136, 136, lane);
    const int ymi = wave & 3, ynj = wave >> 2;
#pragma unroll 1
    for (int hh = hh0; hh < hh0 + 4; ++hh) {
        const int h = g * 8 + hh;
        lds_barrier();
#pragma unroll
        for (int k = 0; k < 2; ++k) { const int idx = tid + k * 512; *(u32x4*)(sXT + (idx >> 4) * 136 + (idx & 15) * 8) = xr[k]; *(u32x4*)(sH + (idx >> 4) * 136 + (idx & 15) * 8) = h0r[k]; }
        u32x4 h1r[2];
#pragma unroll
        for (int k = 0; k < 2; ++k) h1r[k] = *(const u32x4*)(hin1 + (size_t)hh * 8192 + (tid + k * 512) * 8);
        f32x16 yacc;
#pragma unroll
        for (int r = 0; r < 16; ++r) yacc[r] = 0.f;
#pragma unroll 1
        for (int d = 0; d < 2; ++d) {
            const int col = hh * 2 + d;
            if (d == 1) {
                lds_barrier();
#pragma unroll
                for (int k = 0; k < 2; ++k) { const int idx = tid + k * 512; *(u32x4*)(sH + (idx >> 4) * 136 + (idx & 15) * 8) = h1r[k]; }
            }
            if (MODE < 2) {
                float aci[16];
#pragma unroll
                for (int r = 0; r < 16; ++r) aci[r] = sAcs[(cmi * 32 + rowmap32(r, lane)) * 16 + col];
#pragma unroll
                for (int tt = 0; tt < 2; ++tt) {
                    const int jg = (cnj0 + tt) * 32 + (lane & 31);
                    const float acj = sAcs[jg * 16 + col], dtj = sDt[jg * 16 + col];
                    const int dj0 = jg - cmi * 32 - 4 * (lane >> 5), dj = d == 0 ? dj0 : -dj0;
#pragma unroll
                    for (int r = 0; r < 16; ++r) {
                        const int ro = (r & 3) + 8 * (r >> 2);
                        const int sd = d == 0 ? dj - ro : dj + ro;
                        float arg = aci[r] - acj; arg = sd <= 0 ? arg : -INFINITY;
                        const float cbv = tt == 0 ? cb0[r] : cb1[r];
                        sBW[(cmi * 32 + rowmap32(r, lane)) * 136 + jg] = f2bf(cbv * __expf(arg) * dtj);
                    }
                }
            }
            lds_barrier();
            f32x16 ad, ao;
#pragma unroll
            for (int r = 0; r < 16; ++r) { ad[r] = 0.f; ao[r] = 0.f; }
            if (MODE < 3) { mm32<128>(ad, sBW + ymi * 32 * 136, 136, sXT + ynj * 32 * 136, 136, lane);
            mm32<128>(ao, sC + ymi * 32 * 136, 136, sH + ynj * 32 * 136, 136, lane); }
#pragma unroll
            for (int r = 0; r < 16; ++r) { const int ig = ymi * 32 + rowmap32(r, lane); yacc[r] += ad[r] + __expf(sAcs[ig * 16 + col]) * ao[r]; }
            if (d == 0 && hh < hh0 + 3) {
#pragma unroll
                for (int k = 0; k < 2; ++k) {
                    const int idx = tid + k * 512;
                    xr[k] = *(const u32x4*)(xt + (size_t)(hh + 1) * 8192 + (idx >> 4) * 128 + (idx & 15) * 8);
                    h0r[k] = *(const u32x4*)(hin0 + (size_t)(hh + 1) * 8192 + idx * 8);
                }
            }
        }
        const float Dh = p.ssd_D[l * 16 + h];
        const int pl = ynj * 32 + (lane & 31);
#pragma unroll
        for (int r = 0; r < 16; ++r) { const int ig = ymi * 32 + rowmap32(r, lane); yacc[r] += Dh * bf2f(sXT[pl * 136 + ig]); }
        lds_barrier();
#pragma unroll
        for (int r = 0; r < 16; ++r) { const int ig = ymi * 32 + rowmap32(r, lane); sY[ig * 72 + pl] = f2bf(yacc[r]); }
        lds_barrier();
#pragma unroll
        for (int k = 0; k < 2; ++k) {
            const int idx = tid + k * 512, rr = idx >> 3, pk = idx & 7;
            const f32x8 yv = unpack8(*(const u32x4*)(sY + rr * 72 + pk * 8)), zv = unpack8(zr[k]);
            f32x8 o;
#pragma unroll
            for (int e = 0; e < 8; ++e) o[e] = yv[e] * siluf(zv[e]);
            if (MODE < 1) *(u32x4*)(WS_MIX(p) + (tok0 + rr) * MIXW + 2048 + h * 64 + pk * 8) = pack8(o); else asm volatile("" :: "v"(o[0]), "v"(o[7]));
        }
        if (hh < hh0 + 3) {
#pragma unroll
            for (int k = 0; k < 2; ++k) { const int idx = tid + k * 512; zr[k] = *(const u32x4*)(zt + (size_t)(idx >> 3) * LDP + (hh + 1) * 64 + (idx & 7) * 8); }
        }
    }
}
__device__ __forceinline__ void ssd_norm_phase(const Params& p, int l, int G) {
    const int lane = tidx() & 63, wave = tidx() >> 6;
    for (int row = blockIdx.x * 8 + wave; row < NTOK; row += G * 8) {
        bf16_t* rp = WS_MIX(p) + (size_t)row * MIXW + 2048;
        f32x8 v0 = unpack8(*(const u32x4*)(rp + lane * 8)), v1 = unpack8(*(const u32x4*)(rp + 512 + lane * 8));
        float ss = 0.f;
#pragma unroll
        for (int e = 0; e < 8; ++e) ss += v0[e] * v0[e] + v1[e] * v1[e];
        ss = wave_sum(ss);
        const float rstd = rsqrtf(ss * (1.f / 1024.f) + 1e-6f);
        const float* nw = p.ssd_norm_w + l * 1024;
#pragma unroll
        for (int e = 0; e < 8; ++e) { v0[e] = v0[e] * rstd * nw[lane * 8 + e]; v1[e] = v1[e] * rstd * nw[512 + lane * 8 + e]; }
        *(u32x4*)(rp + lane * 8) = pack8(v0); *(u32x4*)(rp + 512 + lane * 8) = pack8(v1);
    }
}

template <int MODE>
__device__ __forceinline__ void attn_item(const Params& p, int l, int item, unsigned char* shm) {
    const int tid = tidx(), lane = tid & 63, wave = tid >> 6, fr = lane & 15, fq = lane >> 4;
    const int hp = item & 3, bq = item >> 2, qblk = bq % NCH, b = bq / NCH, kh = hp >> 1;
    const bf16_t* P = WS_P(p);
    bf16_t* sK = (bf16_t*)shm; bf16_t* sVT = (bf16_t*)(shm + 34816); bf16_t* sPw = (bf16_t*)(shm + 69632) + wave * (2 * 16 * 136);
    const size_t tokq0 = (size_t)b * TPB + qblk * 128;
    bf16x8 aq[2][4];
#pragma unroll
    for (int hd = 0; hd < 2; ++hd)
#pragma unroll
        for (int kk = 0; kk < 4; ++kk) aq[hd][kk] = *(const bf16x8*)(P + (tokq0 + wave * 16 + fr) * LDP + C_Q + (hp * 2 + hd) * 128 + kk * 32 + 8 * fq);
    float m[2][4], ls[2][4]; f32x4 O[2][8];
#pragma unroll
    for (int hd = 0; hd < 2; ++hd) {
        const float sink = p.att_sink[l * 8 + hp * 2 + hd];
#pragma unroll
        for (int r = 0; r < 4; ++r) { m[hd][r] = sink; ls[hd][r] = 1.f; }
#pragma unroll
        for (int nd = 0; nd < 8; ++nd) O[hd][nd] = (f32x4){0.f, 0.f, 0.f, 0.f};
    }
    const int nlat = qblk - 2;
    const int kb_lo = nlat - 1 < 0 ? 0 : nlat - 1, kb_hi = nlat + 1 > 15 ? 15 : nlat + 1;
    const int ntl = qblk < 2 ? 2 : 2 + (kb_hi - kb_lo + 1);
    u32x4 kr[4], vr[4];
    const bf16_t* vtb = WS_VT(p) + ((size_t)(b * 18) * 2 + kh) * 16384;
    {
        const bf16_t* kbase = P + ((size_t)b * TPB) * LDP + C_K + kh * 128;
#pragma unroll
        for (int k = 0; k < 4; ++k) { const int idx = tid + k * 512; kr[k] = *(const u32x4*)(kbase + (size_t)(idx >> 4) * LDP + (idx & 15) * 8); vr[k] = *(const u32x4*)(vtb + idx * 8); }
    }
#pragma unroll 1
    for (int ti = 0; ti < ntl; ++ti) {
        const bool masked = ti >= 2; const int kb = kb_lo + (ti - 2);
        lds_barrier();
#pragma unroll
        for (int k = 0; k < 4; ++k) {
            const int idx = tid + k * 512;
            *(u32x4*)(sK + (idx >> 4) * 136 + (idx & 15) * 8) = kr[k];
            *(u32x4*)(sVT + (idx >> 4) * 136 + (idx & 15) * 8) = vr[k];
        }
        if (ti + 1 < ntl) {
            const int tn = ti + 1, t0n = tn < 2 ? tn * 128 : 256 + (kb_lo + (tn - 2)) * 128;
            const bf16_t* kbase = P + ((size_t)b * TPB + t0n) * LDP + C_K + kh * 128;
            const bf16_t* vtn = vtb + (size_t)(t0n >> 7) * 32768;
#pragma unroll
            for (int k = 0; k < 4; ++k) { const int idx = tid + k * 512; kr[k] = *(const u32x4*)(kbase + (size_t)(idx >> 4) * LDP + (idx & 15) * 8); vr[k] = *(const u32x4*)(vtn + idx * 8); }
        }
        lds_barrier();
#pragma unroll 1
        for (int hf = 0; hf < 2; ++hf) {
            f32x4 s[2][4];
#pragma unroll
            for (int nt = 0; nt < 4; ++nt) {
                s[0][nt] = (f32x4){0.f, 0.f, 0.f, 0.f}; s[1][nt] = (f32x4){0.f, 0.f, 0.f, 0.f};
#pragma unroll
                for (int kk = 0; kk < 4; ++kk) {
                    const bf16x8 bk = *(const bf16x8*)(sK + ((hf * 4 + nt) * 16 + fr) * 136 + kk * 32 + 8 * fq);
                    s[0][nt] = __builtin_amdgcn_mfma_f32_16x16x32_bf16(aq[0][kk], bk, s[0][nt], 0, 0, 0);
                    s[1][nt] = __builtin_amdgcn_mfma_f32_16x16x32_bf16(aq[1][kk], bk, s[1][nt], 0, 0, 0);
                }
                __builtin_amdgcn_sched_barrier(0);
            }
            if (masked) {
#pragma unroll
                for (int nt = 0; nt < 4; ++nt)
#pragma unroll
                    for (int r = 0; r < 4; ++r) { const int rel = (nlat * 128 + wave * 16 + fq * 4 + r) - (kb * 128 + (hf * 4 + nt) * 16 + fr); if (rel > 128 || rel < -128) { s[0][nt][r] = -INFINITY; s[1][nt][r] = -INFINITY; } }
            }
#pragma unroll
            for (int hd = 0; hd < 2; ++hd) {
                float alpha[4];
#pragma unroll
                for (int r = 0; r < 4; ++r) {
                    float mx = fmaxf(fmaxf(s[hd][0][r], s[hd][1][r]), fmaxf(s[hd][2][r], s[hd][3][r]));
                    mx = row16_max(mx);
                    const float mn = fmaxf(m[hd][r], mx);
                    alpha[r] = __expf(m[hd][r] - mn); m[hd][r] = mn;
                    float rs = 0.f;
#pragma unroll
                    for (int nt = 0; nt < 4; ++nt) { const float pv = __expf(s[hd][nt][r] - mn); s[hd][nt][r] = pv; rs += pv; }
                    rs = row16_sum(rs);
                    ls[hd][r] = ls[hd][r] * alpha[r] + rs;
                }
#pragma unroll
                for (int nd = 0; nd < 8; ++nd) { O[hd][nd].x *= alpha[0]; O[hd][nd].y *= alpha[1]; O[hd][nd].z *= alpha[2]; O[hd][nd].w *= alpha[3]; }
#pragma unroll
                for (int nt = 0; nt < 4; ++nt)
#pragma unroll
                    for (int r = 0; r < 4; ++r) sPw[hd * (16 * 136) + (fq * 4 + r) * 136 + nt * 16 + fr] = f2bf(s[hd][nt][r]);
            }
            asm volatile("s_waitcnt lgkmcnt(0)" ::: "memory");
#pragma unroll
            for (int kk = 0; kk < 2; ++kk) {
                const bf16x8 ap0 = *(const bf16x8*)(sPw + fr * 136 + kk * 32 + 8 * fq);
                const bf16x8 ap1 = *(const bf16x8*)(sPw + 16 * 136 + fr * 136 + kk * 32 + 8 * fq);
#pragma unroll
                for (int nd = 0; nd < 8; ++nd) {
                    const bf16x8 bv = *(const bf16x8*)(sVT + (nd * 16 + fr) * 136 + hf * 64 + kk * 32 + 8 * fq);
                    O[0][nd] = __builtin_amdgcn_mfma_f32_16x16x32_bf16(ap0, bv, O[0][nd], 0, 0, 0);
                    O[1][nd] = __builtin_amdgcn_mfma_f32_16x16x32_bf16(ap1, bv, O[1][nd], 0, 0, 0);
                    if (nd == 3) __builtin_amdgcn_sched_barrier(0);
                }
                __builtin_amdgcn_sched_barrier(0);
            }
            asm volatile("s_waitcnt lgkmcnt(0)" ::: "memory");
        }
    }
#pragma unroll
    for (int hd = 0; hd < 2; ++hd) {
        const int hq = hp * 2 + hd;
        u32x4 agr[4];
#pragma unroll
        for (int k = 0; k < 4; ++k) { const int idx = tid + k * 512; agr[k] = *(const u32x4*)(P + (tokq0 + (idx >> 4)) * LDP + C_AG + hq * 128 + (idx & 15) * 8); }
        lds_barrier();
#pragma unroll
        for (int r = 0; r < 4; ++r) {
            const float il = __builtin_amdgcn_rcpf(ls[hd][r]);
#pragma unroll
            for (int nd = 0; nd < 8; ++nd) sK[(wave * 16 + fq * 4 + r) * 136 + nd * 16 + fr] = f2bf(O[hd][nd][r] * il);
        }
        lds_barrier();
#pragma unroll
        for (int k = 0; k < 4; ++k) {
            const int idx = tid + k * 512, rr = idx >> 4, ck = idx & 15;
            const f32x8 ov = unpack8(*(const u32x4*)(sK + rr * 136 + ck * 8)), gv = unpack8(agr[k]);
            f32x8 o;
#pragma unroll
            for (int e = 0; e < 8; ++e) o[e] = ov[e] * siluf(gv[e]);
            *(u32x4*)(WS_MIX(p) + (tokq0 + rr) * MIXW + 1024 + hq * 128 + ck * 8) = pack8(o);
        }
    }
}

#define XB_TMO      128
#define XB_XCNT(j)  (256  + 64 * (j))
#define XB_XSUB(j)  (1280 + 64 * (j))
#define XB_XGEN(j)  (2304 + 64 * (j))
#define XB_TOP      3328
#define XB_TOPGEN   3392
#define XCD_BAR_WORDS 3456
#define XB_SPIN_CAP (1u << 18)
#define LAS __attribute__((address_space(3)))
__device__ __forceinline__ unsigned xb_ld(unsigned* p)              { return __hip_atomic_load(p, __ATOMIC_RELAXED, __HIP_MEMORY_SCOPE_AGENT); }
__device__ __forceinline__ unsigned xb_add(unsigned* p, unsigned v) { return __hip_atomic_fetch_add(p, v, __ATOMIC_RELAXED, __HIP_MEMORY_SCOPE_AGENT); }
__device__ __forceinline__ unsigned xb_xcc_id() { return (unsigned)__builtin_amdgcn_s_getreg((3 << 11) | 20) & 0xFu; }
#define XB_SPIN(cond, bar) do { unsigned _sp = 0; while (cond) { __builtin_amdgcn_s_sleep(1); \
    if ((++_sp & 255u) == 0u) { if (xb_ld(&(bar)[XB_TMO])) break; if (_sp > XB_SPIN_CAP) { atomicAdd(&(bar)[XB_TMO], 1u); break; } } } } while (0)
struct XcdBarrier { unsigned* bar; unsigned x; volatile LAS unsigned* st; };
__device__ __forceinline__ XcdBarrier xcd_barrier_post(unsigned* bar, volatile LAS unsigned* st) {
    XcdBarrier b; b.bar = bar; b.x = xb_xcc_id(); b.st = st;
    if (tidx() == 0) (void)xb_add(&bar[XB_XCNT(b.x)], 1u);
    return b;
}
__device__ __forceinline__ void xcd_barrier_complete(unsigned* bar, unsigned x, unsigned& nloc, unsigned& nx) {
    const unsigned G = gridDim.x * gridDim.y * gridDim.z;
    unsigned sum, cnt, mine, sp = 0u;
    for (;;) {
        sum = 0u; cnt = 0u; mine = 0u;
#pragma unroll
        for (unsigned j = 0; j < 16; ++j) { const unsigned c = xb_ld(&bar[XB_XCNT(j)]); sum += c; cnt += (c > 0u) ? 1u : 0u; mine = (j == x) ? c : mine; }
        if (sum == G) break;
        __builtin_amdgcn_s_sleep(1);
        if ((++sp & 255u) == 0u) { if (xb_ld(&bar[XB_TMO])) break; if (sp > XB_SPIN_CAP) { atomicAdd(&bar[XB_TMO], 1u); break; } }
    }
    nloc = mine > 0u ? mine : 1u; nx = cnt > 0u ? cnt : 1u;
}
__device__ __forceinline__ void xcd_barrier(const XcdBarrier& b) {
    asm volatile("s_waitcnt vmcnt(0)" ::: "memory");
    __syncthreads();
    if (tidx() == 0) {
        unsigned* bar = b.bar;
        __builtin_amdgcn_s_waitcnt(0);
        unsigned nloc = b.st[0], nx = b.st[1];
        if (nloc == 0u) { xcd_barrier_complete(bar, b.x, nloc, nx); b.st[0] = nloc; b.st[1] = nx; }
        const unsigned old = xb_add(&bar[XB_XSUB(b.x)], 1u);
        const unsigned gen = old / nloc;
        if (old + 1u == (gen + 1u) * nloc) {
            __builtin_amdgcn_fence(__ATOMIC_RELEASE, "agent");
            asm volatile("s_waitcnt vmcnt(0)" ::: "memory");
            const unsigned og = xb_add(&bar[XB_TOP], 1u);
            const unsigned tg = og / nx;
            if (og + 1u == (tg + 1u) * nx) xb_add(&bar[XB_TOPGEN], 1u);
            else XB_SPIN(xb_ld(&bar[XB_TOPGEN]) == tg, bar);
            __builtin_amdgcn_fence(__ATOMIC_ACQUIRE, "agent");
            xb_add(&bar[XB_XGEN(b.x)], 1u);
            asm volatile("s_waitcnt vmcnt(0)" ::: "memory");
        } else {
            XB_SPIN(xb_ld(&bar[XB_XGEN(b.x)]) == gen, bar);
            __builtin_amdgcn_fence(__ATOMIC_ACQUIRE, "agent");
            asm volatile("s_waitcnt vmcnt(0)" ::: "memory");
        }
    }
    __syncthreads();
}


#define QUEUE_LOOP(ctr, NITEMS, BODY) do { \
    volatile LAS unsigned* _mb = (volatile LAS unsigned*)(shm + LDS_CTL + 8); \
    int it = bid; \
    while (it < (NITEMS)) { \
        unsigned _nx = 0u; if (tidx() == 0) _nx = xb_add((ctr), 1u) + (unsigned)G; \
        BODY; \
        __syncthreads(); \
        if (tidx() == 0) _mb[0] = _nx; \
        __syncthreads(); \
        it = (int)_mb[0]; \
    } } while (0)

__global__ __launch_bounds__(512) void mega(Params p) {
    extern __shared__ __attribute__((aligned(16))) unsigned char shm[];
    cg::grid_group grid = cg::this_grid();
    const int G = (int)gridDim.x, bid = (int)blockIdx.x;
    if (tidx() < 4) ((volatile LAS unsigned*)(shm + LDS_CTL))[tidx()] = 0u;
    __syncthreads();
    unsigned* qctr = (unsigned*)(p.ws + OFF_BAR) + 3584;
    const XcdBarrier xb = xcd_barrier_post((unsigned*)(p.ws + OFF_BAR), (volatile LAS unsigned*)(shm + LDS_CTL));
    for (int rep = 0; rep < 1 + DUP_P0; ++rep) phase0(p, shm, G);
    grid.sync();
#pragma unroll 1
    for (int l = 0; l < 4; ++l) {
        for (int rep = 0; rep < 1 + DUP_NORM; ++rep) norm_phase(p, l, G);
        xcd_barrier(xb);
        {
            pg8::Gemm g{WS_U(p), WS_WTIN(p) + (size_t)l * 7424 * 2048, NTOK, 7168, 2048};
            pg8::Order S; S.init(72, 28, G, bid, 0);
            EpiG1 E{WS_P(p)};
            for (int rep = 0; rep < 1 + DUP_G1; ++rep) pg8::gemm_phase<EpiG1, pg8::Order>((PG8_LAS unsigned char*)shm, g, S, E);
            {
                const int tq = tidx(), wave = tq >> 6, lane = tq & 63, fr = lane & 15, fq = lane >> 4;
                for (int wu = bid * 8 + wave; wu < NTOK / 16; wu += G * 8) {
                    const bf16_t* ap = WS_U(p) + (size_t)(wu * 16 + fr) * 2048 + 8 * fq;
                    const bf16_t* bp = WS_WTIN(p) + ((size_t)l * 7424 + 7168 + fr) * 2048 + 8 * fq;
                    f32x4 acc = (f32x4){0.f, 0.f, 0.f, 0.f};
#pragma unroll 8
                    for (int kk = 0; kk < 64; ++kk) { const bf16x8 a = *(const bf16x8*)(ap + kk * 32), bq = *(const bf16x8*)(bp + kk * 32); acc = __builtin_amdgcn_mfma_f32_16x16x32_bf16(a, bq, acc, 0, 0, 0); }
#pragma unroll
                    for (int r = 0; r < 4; ++r) WS_DTP(p)[(size_t)(wu * 16 + fq * 4 + r) * 16 + fr] = acc[r];
                }
            }
        }
        for (int rep = 0; rep < 1 + DUP_SYNC; ++rep) xcd_barrier(xb);
        for (int rep = 0; rep < 1 + DUP_E1; ++rep) {
            if (rep == 0 || E1SEL == 0 || E1SEL == 1) for (int it = bid; it < 144; it += G) prep_dt_item(p, l, it);
            if (rep == 0 || E1SEL == 0 || E1SEL == 2) { __syncthreads(); prep_tiles(p, l, bid, G, shm); }
            if (rep == 0 || E1SEL == 0 || E1SEL == 3) prep_elem(p, l, G);
        }
        { const int tq = tidx(), wave = tq >> 6, lane = tq & 63; for (int row = bid * 8 + wave; row < NTOK; row += G * 8) qkprep_row<0>(p, l, row, lane);
#if DUP_QK
          for (int row = bid * 8 + wave; row < NTOK; row += G * 8) qkprep_row<1>(p, l, row, lane);
#endif
        }
        xcd_barrier(xb);
        QUEUE_LOOP(qctr + (l * 3 + 0) * 64, 128 + 576, { if (it < 128) lru_sweep_item<0>(p, l, it, shm); else ssd_states_item(p, l, it - 128, shm); });
#if DUP_X1Q
        __syncthreads(); QUEUE_LOOP(qctr + (12 + l * 3 + 0) * 64, 128 + 576, { if (it < 128) lru_sweep_item<0>(p, l, it, shm); else ssd_states_item(p, l, it - 128, shm); });
#endif
#if DUP_SWEEP
        __syncthreads(); for (int it = bid; it < 128; it += G) lru_sweep_item<0>(p, l, it, shm);
#endif
#if DUP_STATES
        __syncthreads(); for (int it = bid; it < 256; it += G) ssd_states_item(p, l, it, shm);
#endif
        xcd_barrier(xb);
        QUEUE_LOOP(qctr + (l * 3 + 1) * 64, 256 + 576, { if (it < 256) ssd_recur_item(p, it); else attn_item<0>(p, l, it - 256, shm); });
#if DUP_ATTQ
        __syncthreads(); QUEUE_LOOP(qctr + (12 + l * 3 + 1) * 64, 576, { attn_item<AMODE>(p, l, it, shm); });
#endif
        xcd_barrier(xb);
        QUEUE_LOOP(qctr + (l * 3 + 2) * 64, 128 + 576, { if (it < 128) lru_sweep_item<1>(p, l, it, shm); else ssd_final_item<0>(p, l, it - 128, shm); });
#if DUP_FINAL
        __syncthreads(); for (int it = bid; it < 256; it += G) ssd_final_item<FMODE>(p, l, it, shm);
#endif
#if DUP_SWEEP1
        __syncthreads(); for (int it = bid; it < 128; it += G) lru_sweep_item<1, 1>(p, l, it, shm);
#endif
        xcd_barrier(xb);
#ifndef SK_X4
        ssd_norm_phase(p, l, G);
#endif
        xcd_barrier(xb);
        {
            pg8::Gemm g{WS_MIX(p), WS_WTOUT(p) + (size_t)l * 2048 * 3072, NTOK, 2048, 3072};
            pg8::Order S; S.init(l == 3 ? 64 : 72, 8, G, bid, l == 3 ? 1 : 0);
            EpiG2 E{p, l, 0};
#if DUP_G2
            { EpiG2 E2{p, l, 1}; pg8::gemm_phase<EpiG2, pg8::Order>((PG8_LAS unsigned char*)shm, g, S, E2); }
#endif
#ifndef SK_G2
            pg8::gemm_phase<EpiG2, pg8::Order>((PG8_LAS unsigned char*)shm, g, S, E);
#endif
        }
        if (l < 3) xcd_barrier(xb);
    }
}

extern "C" void kernel_launch(void* const* d_in, const int* in_sizes, int n_in, void* d_out, int out_size, void* d_ws, size_t ws_size, hipStream_t stream) {
    static int grid = 0;
    if (grid == 0) {
        if (n_in != 25 || ws_size < WS_END) { fprintf(stderr, "kernel_launch: need 25 inputs and %zu bytes of workspace (got %d, %zu)\n", (size_t)WS_END, n_in, ws_size); grid = -1; return; }
        int dev = 0, cus = 0, per_cu = 0;
        hipGetDevice(&dev);
        hipDeviceGetAttribute(&cus, hipDeviceAttributeMultiprocessorCount, dev);
        if (hipFuncSetAttribute((const void*)mega, hipFuncAttributeMaxDynamicSharedMemorySize, LDS_BYTES) != hipSuccess) { fprintf(stderr, "kernel_launch: hipFuncSetAttribute failed\n"); grid = -1; return; }
        if (hipOccupancyMaxActiveBlocksPerMultiprocessor(&per_cu, (const void*)mega, 512, LDS_BYTES) != hipSuccess || per_cu < 1) { fprintf(stderr, "kernel_launch: occupancy query gave %d\n", per_cu); per_cu = 1; }
        (void)hipGetLastError();
        grid = cus * 1;
        if (grid <= 0) grid = 256;
    }
    if (grid < 0) return;
    Params p{};
    const float** pf = (const float**)&p;
    for (int i = 0; i < 25; ++i) pf[i] = (const float*)d_in[i];
    p.out = (float*)d_out; p.ws = (unsigned char*)d_ws;
    if (hipMemsetAsync((char*)d_ws + OFF_BAR, 0, 32768, stream) != hipSuccess) { fprintf(stderr, "kernel_launch: memset of barrier words failed\n"); return; }
    void* args[] = {&p};
    hipError_t e = hipLaunchCooperativeKernel((const void*)mega, dim3(grid), dim3(512), args, LDS_BYTES, stream);
    if (e != hipSuccess) fprintf(stderr, "cooperative launch failed: %s (grid %d)\n", hipGetErrorString(e), grid);
}
```

```cpp
#include <hip/hip_runtime.h>
#include <hip/hip_cooperative_groups.h>
#include <cstdio>
#include <cstdint>
namespace cg = cooperative_groups;
#define DUP_X1A 0
#define DUP_X1B 0
#define DUP_ATT 0
#define DUP_X3A 0
#define DUP_X3B 0
#define DUP_G1 0
#define DUP_P0 0
#define DUP_NORM 0
#define DUP_SYNC 0
#define DUP_E1 0
#define DUP_SWEEP1 0
#define DUP_G2 0
#define DUP_QK 0
#define E1SEL 0
#define DUP_SWEEP 0
#define DUP_STATES 0
#define DUP_FINAL 0
#define AMODE 0
#define FMODE 0
#define DUP_X1Q 0
#define DUP_ATTQ 0
#define DUP_X3Q 0

__device__ __forceinline__ int tidx() { int t = (int)threadIdx.x; asm volatile("" : "+v"(t)); return t; }

namespace pg8 {
#define PG8_LAS __attribute__((address_space(3)))
typedef unsigned short bf16_t;
typedef short bf16x8 __attribute__((ext_vector_type(8)));
typedef float f32x4 __attribute__((ext_vector_type(4)));
typedef unsigned u32x4 __attribute__((ext_vector_type(4)));
constexpr int BM = 256, BK = 64, HALF = 128, HTB = HALF * BK * 2  , STAGE_BYTES = 8 * HTB, NXCD = 8, WGM = 8;

__host__ __device__ __forceinline__ int lds_byte(int r, int c) { const int st = (r >> 4) * 2 + (c >> 5), rr = r & 15, cc = c & 31, ob = rr * 64 + cc * 2; return st * 1024 + (ob ^ (((ob >> 9) & 1) << 5)); }
__host__ __device__ __forceinline__ void stage_rc(int b, int& R, int& C) { const int st = b / 1024, sb = b % 1024, swz = sb ^ (((sb >> 9) & 1) << 5); R = (st >> 1) * 16 + swz / 64; C = (st & 1) * 32 + (swz % 64) / 2; }
__host__ __device__ __forceinline__ int perm32(int rho) { const int n = rho >> 4, i = rho & 15; return 8 * (i >> 2) + 4 * n + (i & 3); }

struct Unit { int pm, pn; };
struct Gemm { const bf16_t* A; const bf16_t* Bt; int M, N, K; };

struct Order {
    int nM, nN, nwg, G, c, skipctx;
    __device__ void init(int nM_, int nN_, int G_, int c_, int skip_) { nM = nM_; nN = nN_; nwg = nM * nN; G = G_; c = c_; skipctx = skip_; }
    __device__ bool next(int i, Unit& u) const {
        const long L = (long)i * G + c; if (L >= nwg) return false;
        int wgid = (int)L; { const int q = nwg / NXCD, r = nwg % NXCD, xcd = wgid % NXCD, off = wgid / NXCD; wgid = (xcd < r ? xcd * (q + 1) : r * (q + 1) + (xcd - r) * q) + off; }
        const int nig = WGM * nN, gid = wgid / nig, fm = gid * WGM, gsz = (nM - fm) < WGM ? (nM - fm) : WGM;
        int pm = fm + ((wgid % nig) % gsz); u.pn = (wgid % nig) / gsz;
        if (skipctx) pm = (pm >> 3) * 9 + 1 + (pm & 7);
        u.pm = pm; return true;
    }
    __device__ __forceinline__ void a_ready(const Unit&) const {}
    __device__ __forceinline__ void done(const Unit&) const {}
};
typedef __bf16 bf16x2_t __attribute__((ext_vector_type(2)));
typedef float f32x2_t __attribute__((ext_vector_type(2)));
__device__ __forceinline__ unsigned cvt_pk_bf16(float lo, float hi) { f32x2_t v = {lo, hi}; bf16x2_t b = __builtin_convertvector(v, bf16x2_t); return __builtin_bit_cast(unsigned, b); }

template <class Epi, class Sched>
__device__ __forceinline__ void gemm_phase(PG8_LAS unsigned char* lds, const Gemm g, const Sched& S, const Epi& E) {
    const int tid = tidx(), wid = __builtin_amdgcn_readfirstlane(tid >> 6), lane = tid & 63, wr = wid >> 2, wc = wid & 3, fr = lane & 15, fq = lane >> 4;
    const int K = g.K, nt = K / BK;
    unsigned voffA[2], voffB[2];
#pragma unroll
    for (int i = 0; i < 2; ++i) { int R, C; stage_rc(tid * 16 + i * 8192, R, C); const int Rb = Epi::PERM ? ((R & ~31) + perm32(R & 31)) : R;
        voffA[i] = (unsigned)(R * K + C) * 2u; voffB[i] = (unsigned)(Rb * K + C) * 2u; }
    const size_t kstep = (size_t)(BK * 2);
    const size_t hstep = (size_t)HALF * K * 2;
    const size_t tstep = 2 * hstep;
    const unsigned ldsw = (unsigned)wid * 1024u;
    const int aoff = lds_byte(wr * 64 + fr, fq * 8), boff = lds_byte(wc * 32 + fr, fq * 8);
#define PG8_SA(b, h) (((b) * 2 + (h)) * HTB)
#define PG8_SB(b, h) ((4 + (b) * 2 + (h)) * HTB)
#define PG8_STAGE(bufoff, gbase, voff) do { _Pragma("unroll") for (int _i = 0; _i < 2; ++_i) \
        __builtin_amdgcn_global_load_lds((const unsigned*)((const char*)(gbase) + (voff)[_i]), (PG8_LAS unsigned*)(lds + (bufoff) + ldsw + _i * 8192), 16, 0, 0); } while (0)
#define PG8_LDA(dst, b, h) do { _Pragma("unroll") for (int m = 0; m < 4; ++m) _Pragma("unroll") for (int k = 0; k < 2; ++k) dst[m][k] = *(const PG8_LAS bf16x8*)(lds + PG8_SA(b, h) + aoff + m * 2048 + k * 1024); } while (0)
#define PG8_LDB(dst, b, h) do { _Pragma("unroll") for (int n = 0; n < 2; ++n) _Pragma("unroll") for (int k = 0; k < 2; ++k) dst[n][k] = *(const PG8_LAS bf16x8*)(lds + PG8_SB(b, h) + boff + n * 2048 + k * 1024); } while (0)
#define PG8_MMA(ai, bj, At, Bt) do { __builtin_amdgcn_s_setprio(1); _Pragma("unroll") for (int m = 0; m < 4; ++m) _Pragma("unroll") for (int n = 0; n < 2; ++n) _Pragma("unroll") for (int k = 0; k < 2; ++k) \
        acc[ai][bj][m][n] = __builtin_amdgcn_mfma_f32_16x16x32_bf16(Bt[n][k], At[m][k], acc[ai][bj][m][n], 0, 0, 0); __builtin_amdgcn_s_setprio(0); } while (0)
#define PG8_WAIT_V(n) asm volatile("s_waitcnt vmcnt(" #n ")" ::: "memory")
#define PG8_WAIT_L(n) asm volatile("s_waitcnt lgkmcnt(" #n ")" ::: "memory")
#define PG8_BAR __builtin_amdgcn_s_barrier()
#define PG8_SCHED __builtin_amdgcn_sched_barrier(0)
    Unit cur, nxt; int ui = 0;
    if (!S.next(0, cur)) return;
    f32x4 acc[2][2][4][2];
#pragma unroll
    for (int a = 0; a < 2; ++a)
#pragma unroll
        for (int b = 0; b < 2; ++b)
#pragma unroll
            for (int m = 0; m < 4; ++m)
#pragma unroll
                for (int n = 0; n < 2; ++n) acc[a][b][m][n] = (f32x4){0.f, 0.f, 0.f, 0.f};
    bf16x8 At[4][2], B0[2][2], B1[2][2];
    const char* cA = (const char*)g.A + (size_t)cur.pm * tstep; const char* cB = (const char*)g.Bt + (size_t)cur.pn * tstep;
    S.a_ready(cur);
    PG8_STAGE(PG8_SB(0, 0), cB, voffB); PG8_STAGE(PG8_SA(0, 0), cA, voffA); PG8_STAGE(PG8_SB(0, 1), cB + hstep, voffB); PG8_STAGE(PG8_SA(0, 1), cA + hstep, voffA);
    if (wr == 1) PG8_BAR;
    PG8_WAIT_V(4); PG8_BAR;
    PG8_STAGE(PG8_SB(1, 0), cB + kstep, voffB); PG8_STAGE(PG8_SA(1, 0), cA + kstep, voffA); PG8_STAGE(PG8_SB(1, 1), cB + hstep + kstep, voffB);
    PG8_WAIT_V(6); PG8_BAR;
    for (;;) {
        const bool has_next = S.next(ui + 1, nxt);
        const char* nA = has_next ? (const char*)g.A + (size_t)nxt.pm * tstep : cA; const char* nB = has_next ? (const char*)g.Bt + (size_t)nxt.pn * tstep : cB;
        for (int t = 0; t < nt; t += 2) {
            const bool last = (t == nt - 2);
            const char* a1 = cA + (size_t)(t + 1) * kstep;
            const char* a2 = last ? nA : cA + (size_t)(t + 2) * kstep; const char* b2 = last ? nB : cB + (size_t)(t + 2) * kstep;
            const char* a3 = a2 + kstep; const char* b3 = b2 + kstep;
            if (last && has_next) S.a_ready(nxt);
            PG8_LDB(B0, 0, 0); PG8_SCHED; PG8_LDA(At, 0, 0); PG8_STAGE(PG8_SA(1, 1), a1 + hstep, voffA);
            PG8_WAIT_L(8); PG8_BAR; PG8_WAIT_L(0); PG8_MMA(0, 0, At, B0); PG8_BAR; PG8_SCHED;
            PG8_LDB(B1, 0, 1); PG8_STAGE(PG8_SB(0, 0), b2, voffB);
            PG8_BAR; PG8_WAIT_L(0); PG8_MMA(0, 1, At, B1); PG8_BAR;
            PG8_LDA(At, 0, 1); PG8_STAGE(PG8_SA(0, 0), a2, voffA);
            PG8_BAR; PG8_WAIT_L(0); PG8_MMA(1, 0, At, B0); PG8_BAR; PG8_SCHED;
            PG8_STAGE(PG8_SB(0, 1), b2 + hstep, voffB);
            PG8_WAIT_V(6); PG8_BAR; PG8_MMA(1, 1, At, B1); PG8_BAR;
            PG8_LDB(B0, 1, 0); PG8_SCHED; PG8_LDA(At, 1, 0); PG8_STAGE(PG8_SA(0, 1), a2 + hstep, voffA);
            PG8_WAIT_L(8); PG8_BAR; PG8_WAIT_L(0); PG8_MMA(0, 0, At, B0); PG8_BAR; PG8_SCHED;
            PG8_LDB(B1, 1, 1); PG8_STAGE(PG8_SB(1, 0), b3, voffB);
            PG8_BAR; PG8_WAIT_L(0); PG8_MMA(0, 1, At, B1); PG8_BAR;
            PG8_LDA(At, 1, 1); PG8_STAGE(PG8_SA(1, 0), a3, voffA);
            PG8_BAR; PG8_WAIT_L(0); PG8_MMA(1, 0, At, B0); PG8_BAR; PG8_SCHED;
            PG8_STAGE(PG8_SB(1, 1), b3 + hstep, voffB);
            PG8_WAIT_V(6); PG8_BAR; PG8_MMA(1, 1, At, B1); PG8_BAR;
        }
        if constexpr (!Epi::AFTER_DRAIN) { E(acc, cur, wr, wc, fr, fq); S.done(cur); }
        if (!has_next) break;
#pragma unroll
        for (int a = 0; a < 2; ++a)
#pragma unroll
            for (int b = 0; b < 2; ++b)
#pragma unroll
                for (int m = 0; m < 4; ++m)
#pragma unroll
                    for (int n = 0; n < 2; ++n) acc[a][b][m][n] = (f32x4){0.f, 0.f, 0.f, 0.f};
        cur = nxt; cA = nA; cB = nB; ++ui;
    }
    PG8_WAIT_V(0);
    if (wr == 0) PG8_BAR;
    PG8_BAR;
    if constexpr (Epi::AFTER_DRAIN) { E.fused(acc, cur, wr, wc, fr, fq, lds, wid, lane); S.done(cur); }
#undef PG8_SA
#undef PG8_SB
#undef PG8_STAGE
#undef PG8_LDA
#undef PG8_LDB
#undef PG8_MMA
#undef PG8_WAIT_V
#undef PG8_WAIT_L
#undef PG8_BAR
#undef PG8_SCHED
}
}

using pg8::bf16_t; using pg8::bf16x8; using pg8::f32x4; using pg8::cvt_pk_bf16;
typedef float f32x16 __attribute__((ext_vector_type(16)));
typedef float f32x8 __attribute__((ext_vector_type(8)));
typedef unsigned u32x2 __attribute__((ext_vector_type(2)));
typedef unsigned u32x4 __attribute__((ext_vector_type(4)));

constexpr int DM = 2048, TPB = 2304, NTOK = 18432, LDP = 7424, MIXW = 3072, NCH = 18;
constexpr int C_LX = 0, C_LG = 1024, C_Q = 2048, C_K = 3072, C_V = 3328, C_AG = 3584, C_XBC = 4608, C_Z = 6144, C_DT = 7168;
constexpr size_t SZ_WTIN = (size_t)4 * 7424 * 2048 * 2, SZ_WTOUT = (size_t)4 * 2048 * 3072 * 2, SZ_MOD = (size_t)4 * 9 * 6144 * 4, SZ_U = (size_t)NTOK * 2048 * 2,
                 SZ_P = (size_t)NTOK * LDP * 2, SZ_MIX = (size_t)NTOK * MIXW * 2, SZ_XB = (size_t)NTOK * 2048 * 4, SZ_ST = (size_t)8 * 2 * 18 * 16 * 8192 * 2,
                 SZ_AL = (size_t)8 * 2 * 18 * 16 * 4, SZ_SUM = (size_t)8 * 2 * 18 * 1024 * 4;
constexpr size_t OFF_WTIN = 0, OFF_WTOUT = OFF_WTIN + SZ_WTIN, OFF_MOD = OFF_WTOUT + SZ_WTOUT, OFF_U = OFF_MOD + SZ_MOD, OFF_P = OFF_U + SZ_U, OFF_MIX = OFF_P + SZ_P,
                 OFF_XB = OFF_MIX + SZ_MIX, OFF_ST = OFF_XB + SZ_XB, OFF_AL = OFF_ST + SZ_ST, OFF_SUMA = OFF_AL + SZ_AL, OFF_SUMB = OFF_SUMA + SZ_SUM, OFF_BAR = OFF_SUMB + SZ_SUM, OFF_SBC = OFF_BAR + 32768, OFF_SBT = OFF_SBC + (size_t)NTOK * 512 * 2, OFF_DTA = OFF_SBT + (size_t)8 * 18 * 2 * 16384 * 2,
                 OFF_ACS = OFF_DTA + (size_t)NTOK * 32 * 4, OFF_HINL = OFF_ACS + (size_t)NTOK * 32 * 4, OFF_GW = OFF_HINL + SZ_SUM, OFF_DTP = OFF_GW + (size_t)4 * 16 * 16384 * 2, OFF_VT = OFF_DTP + (size_t)NTOK * 16 * 4, WS_END = OFF_VT + (size_t)8 * 18 * 2 * 16384 * 2;
constexpr size_t OFF_LXC = OFF_U, OFF_SXT = OFF_U + (size_t)NTOK * 1024 * 2;
constexpr int LDS_CTL = 147456;
constexpr int LDS_BYTES = LDS_CTL + 16;

struct Params {
    const float *x, *c, *ctx, *c_ctx, *norm_w, *ada_w, *ada_b, *w_in, *lru_conv_w, *lru_conv_b, *lru_ga_w, *lru_ga_b, *lru_gx_w, *lru_gx_b, *lru_lambda,
        *att_q_norm, *att_k_norm, *att_sink, *ssd_conv_w, *ssd_conv_b, *ssd_dt_bias, *ssd_A_log, *ssd_D, *ssd_norm_w, *w_out;
    float* out;
    unsigned char* ws;
};
#define WS_WTIN(p) ((bf16_t*)((p).ws + OFF_WTIN))
#define WS_WTOUT(p) ((bf16_t*)((p).ws + OFF_WTOUT))
#define WS_MOD(p) ((float*)((p).ws + OFF_MOD))
#define WS_U(p) ((bf16_t*)((p).ws + OFF_U))
#define WS_P(p) ((bf16_t*)((p).ws + OFF_P))
#define WS_MIX(p) ((bf16_t*)((p).ws + OFF_MIX))
#define WS_XB(p) ((float*)((p).ws + OFF_XB))
#define WS_ST(p) ((bf16_t*)((p).ws + OFF_ST))
#define WS_AL(p) ((float*)((p).ws + OFF_AL))
#define WS_SUMA(p) ((float*)((p).ws + OFF_SUMA))
#define WS_SUMB(p) ((float*)((p).ws + OFF_SUMB))
#define WS_LXC(p) ((bf16_t*)((p).ws + OFF_LXC))
#define WS_SXT(p) ((bf16_t*)((p).ws + OFF_SXT))
#define WS_SBC(p) ((bf16_t*)((p).ws + OFF_SBC))
#define WS_SBT(p) ((bf16_t*)((p).ws + OFF_SBT))
#define WS_DTA(p) ((float*)((p).ws + OFF_DTA))
#define WS_ACS(p) ((float*)((p).ws + OFF_ACS))
#define WS_HINL(p) ((float*)((p).ws + OFF_HINL))
#define WS_GW(p) ((bf16_t*)((p).ws + OFF_GW))
#define WS_DTP(p) ((float*)((p).ws + OFF_DTP))
#define WS_VT(p) ((bf16_t*)((p).ws + OFF_VT))

__device__ __forceinline__ float bf2f(bf16_t v) { return __uint_as_float(((unsigned)v) << 16); }
__device__ __forceinline__ bf16_t f2bf(float f) { return (bf16_t)(cvt_pk_bf16(f, 0.f) & 0xffffu); }
__device__ __forceinline__ float siluf(float v) { return v * __builtin_amdgcn_rcpf(1.f + __expf(-v)); }
__device__ __forceinline__ float sigmf(float v) { return __builtin_amdgcn_rcpf(1.f + __expf(-v)); }
__device__ __forceinline__ float softplusf(float v) { return v > 20.f ? v : log1pf(__expf(v)); }
__device__ __forceinline__ float wave_sum(float v) {
#pragma unroll
    for (int o = 1; o < 64; o <<= 1) v += __shfl_xor(v, o);
    return v;
}
__device__ __forceinline__ f32x8 unpack8(const u32x4 w) {
    f32x8 f;
    f[0] = __uint_as_float(w.x << 16); f[1] = __uint_as_float(w.x & 0xffff0000u); f[2] = __uint_as_float(w.y << 16); f[3] = __uint_as_float(w.y & 0xffff0000u);
    f[4] = __uint_as_float(w.z << 16); f[5] = __uint_as_float(w.z & 0xffff0000u); f[6] = __uint_as_float(w.w << 16); f[7] = __uint_as_float(w.w & 0xffff0000u);
    return f;
}
__device__ __forceinline__ u32x4 pack8(const f32x8 f) { u32x4 w; w.x = cvt_pk_bf16(f[0], f[1]); w.y = cvt_pk_bf16(f[2], f[3]); w.z = cvt_pk_bf16(f[4], f[5]); w.w = cvt_pk_bf16(f[6], f[7]); return w; }
__device__ __forceinline__ void lds_barrier() { asm volatile("s_waitcnt lgkmcnt(0)" ::: "memory"); __builtin_amdgcn_s_barrier(); asm volatile("" ::: "memory"); }
__device__ __forceinline__ float dpp_f(float v, int ctrl_sel) {
    const int x = __builtin_bit_cast(int, v); int r;
    if (ctrl_sel == 0) r = __builtin_amdgcn_update_dpp(x, x, 0xB1, 0xF, 0xF, false);
    else if (ctrl_sel == 1) r = __builtin_amdgcn_update_dpp(x, x, 0x4E, 0xF, 0xF, false);
    else if (ctrl_sel == 2) r = __builtin_amdgcn_update_dpp(x, x, 0x141, 0xF, 0xF, false);
    else r = __builtin_amdgcn_update_dpp(x, x, 0x140, 0xF, 0xF, false);
    return __builtin_bit_cast(float, r);
}
__device__ __forceinline__ float row16_max(float v) { v = fmaxf(v, dpp_f(v, 0)); v = fmaxf(v, dpp_f(v, 1)); v = fmaxf(v, dpp_f(v, 2)); v = fmaxf(v, dpp_f(v, 3)); return v; }
__device__ __forceinline__ float row16_sum(float v) { v += dpp_f(v, 0); v += dpp_f(v, 1); v += dpp_f(v, 2); v += dpp_f(v, 3); return v; }
__device__ __forceinline__ int chunk_at(int d, int pos) { return d == 0 ? pos : (pos < 2 ? 1 - pos : 19 - pos); }
__device__ __forceinline__ int pos_of(int d, int c) { return d == 0 ? c : (c < 2 ? 1 - c : 19 - c); }
__device__ __forceinline__ int rowmap32(int reg, int lane) { return (reg & 3) + 8 * (reg >> 2) + 4 * (lane >> 5); }

template <int K> __device__ __forceinline__ void mm32(f32x16& acc, const bf16_t* A, int lda, const bf16_t* B, int ldb, int lane) {
    const bf16_t* pa = A + (lane & 31) * lda + 8 * (lane >> 5);
    const bf16_t* pb = B + (lane & 31) * ldb + 8 * (lane >> 5);
#pragma unroll
    for (int k = 0; k < K; k += 16) {
        const bf16x8 a = *(const bf16x8*)(pa + k);
        const bf16x8 b = *(const bf16x8*)(pb + k);
        acc = __builtin_amdgcn_mfma_f32_32x32x16_bf16(a, b, acc, 0, 0, 0);
    }
}

template <int NC, bool SILU, bool TRANS>
__device__ __forceinline__ void stage_conv_tile(bf16_t* dst, int ld, const bf16_t* Pb, int t0, int col0, const float* cw, int CS, const float* cb, int tid) {
    constexpr int CG = NC / 8;
    const int lo = t0 < 256 ? 0 : 256, hi = t0 < 256 ? 256 : TPB;
    for (int idx = tid; idx < 128 * CG; idx += 512) {
        int cgi, tl;
        if (TRANS) { tl = idx & 127; cgi = idx >> 7; } else { cgi = idx % CG; tl = idx / CG; }
        const int t = t0 + tl;
        const f32x4 b0 = *(const f32x4*)(cb + cgi * 8), b1 = *(const f32x4*)(cb + cgi * 8 + 4);
        f32x8 acc; acc[0] = b0.x; acc[1] = b0.y; acc[2] = b0.z; acc[3] = b0.w; acc[4] = b1.x; acc[5] = b1.y; acc[6] = b1.z; acc[7] = b1.w;
#pragma unroll
        for (int k = 0; k < 4; ++k) {
            const int tt = t - 2 + k;
            if (tt >= lo && tt < hi) {
                const f32x8 v = unpack8(*(const u32x4*)(Pb + (size_t)tt * LDP + col0 + cgi * 8));
                const f32x4 w0 = *(const f32x4*)(cw + k * CS + cgi * 8), w1 = *(const f32x4*)(cw + k * CS + cgi * 8 + 4);
                acc[0] += w0.x * v[0]; acc[1] += w0.y * v[1]; acc[2] += w0.z * v[2]; acc[3] += w0.w * v[3];
                acc[4] += w1.x * v[4]; acc[5] += w1.y * v[5]; acc[6] += w1.z * v[6]; acc[7] += w1.w * v[7];
            }
        }
        if (SILU) {
#pragma unroll
            for (int e = 0; e < 8; ++e) acc[e] = siluf(acc[e]);
        }
        if (TRANS) {
#pragma unroll
            for (int e = 0; e < 8; ++e) dst[(cgi * 8 + e) * ld + tl] = f2bf(acc[e]);
        } else {
            *(u32x4*)(dst + tl * ld + cgi * 8) = pack8(acc);
        }
    }
}

__device__ __forceinline__ void transpose_item(const float* W, int K, int N, int nblk, bf16_t* WT, float* scr, int item, int lane) {
    const int kb = item / nblk, nb = item % nblk, k0 = 64 * kb, n0 = 32 * nb;
    const int c4 = lane & 7, r8 = lane >> 3, n = n0 + c4 * 4;
    f32x4 tv[8];
#pragma unroll
    for (int i = 0; i < 8; ++i) tv[i] = (n < N) ? *(const f32x4*)(W + (size_t)(k0 + i * 8 + r8) * N + n) : (f32x4){0.f, 0.f, 0.f, 0.f};
#pragma unroll
    for (int i = 0; i < 8; ++i) { float* d = scr + (i * 8 + r8) * 33 + c4 * 4; d[0] = tv[i].x; d[1] = tv[i].y; d[2] = tv[i].z; d[3] = tv[i].w; }
    asm volatile("s_waitcnt lgkmcnt(0)" ::: "memory");
    const int c = lane & 7;
#pragma unroll
    for (int j = 0; j < 4; ++j) {
        const int nn = (lane >> 3) + 8 * j; const float* s = scr + (8 * c) * 33 + nn;
        u32x4 o; o.x = cvt_pk_bf16(s[0 * 33], s[1 * 33]); o.y = cvt_pk_bf16(s[2 * 33], s[3 * 33]); o.z = cvt_pk_bf16(s[4 * 33], s[5 * 33]); o.w = cvt_pk_bf16(s[6 * 33], s[7 * 33]);
        *(u32x4*)(WT + (size_t)(n0 + nn) * K + k0 + 8 * c) = o;
    }
    asm volatile("s_waitcnt lgkmcnt(0)" ::: "memory");
}

__device__ __forceinline__ void phase0(const Params& p, unsigned char* shm, int G) {
    const int tid = tidx(), lane = tid & 63, wave = tid >> 6;
    float* sf = (float*)shm;
    float* MOD = WS_MOD(p);
    for (int item = blockIdx.x; item < 96; item += G) {
        const int l = item / 24, cgp = item % 24;
        __syncthreads();
        for (int idx = tid; idx < 9 * 2048; idx += 512) { const int r = idx >> 11, k = idx & 2047; const float v = r < 8 ? p.c[r * 2048 + k] : p.c_ctx[k]; sf[idx] = siluf(v); }
        __syncthreads();
        f32x4 acc[9];
#pragma unroll
        for (int r = 0; r < 9; ++r) acc[r] = (f32x4){0.f, 0.f, 0.f, 0.f};
        const float* wp = p.ada_w + ((size_t)l * 2048 + wave * 256) * 6144 + cgp * 256 + lane * 4;
#pragma unroll 16
        for (int kk = 0; kk < 256; ++kk) {
            const f32x4 wv = *(const f32x4*)(wp + (size_t)kk * 6144);
            const int k = wave * 256 + kk;
#pragma unroll
            for (int r = 0; r < 9; ++r) { const float s = sf[r * 2048 + k]; acc[r] += wv * s; }
        }
        __syncthreads();
#pragma unroll
        for (int r = 0; r < 9; ++r) *(f32x4*)(sf + (wave * 9 + r) * 256 + lane * 4) = acc[r];
        __syncthreads();
        for (int idx = tid; idx < 9 * 256; idx += 512) {
            const int r = idx >> 8, col = idx & 255; float s = p.ada_b[l * 6144 + cgp * 256 + col];
#pragma unroll
            for (int w = 0; w < 8; ++w) s += sf[(w * 9 + r) * 256 + col];
            MOD[(size_t)(l * 9 + r) * 6144 + cgp * 256 + col] = s;
        }
    }
    __syncthreads();
    float* scr = sf + wave * (64 * 33);
    const int gw = blockIdx.x * 8 + wave, NGW = G * 8;
    constexpr int I_IN = 32 * 232, I_OUT = 48 * 64;
    for (int it = gw; it < 4 * (I_IN + I_OUT); it += NGW) {
        if (it < 4 * I_IN) { const int l = it / I_IN, r = it % I_IN; transpose_item(p.w_in + (size_t)l * 2048 * 7184, 2048, 7184, 232, WS_WTIN(p) + (size_t)l * 7424 * 2048, scr, r, lane); }
        else { const int it2 = it - 4 * I_IN, l = it2 / I_OUT, r = it2 % I_OUT; transpose_item(p.w_out + (size_t)l * 3072 * 2048, 3072, 2048, 64, WS_WTOUT(p) + (size_t)l * 2048 * 3072, scr, r, lane); }
    }
    for (int idx = (int)blockIdx.x * 512 + tid; idx < 4 * 16 * 16384; idx += G * 512) {
        const int i = idx & 63, o = (idx >> 6) & 63, gate = (idx >> 12) & 1, d = (idx >> 13) & 1, j = (idx >> 14) & 15, l = idx >> 18;
        const float* w = gate ? p.lru_gx_w : p.lru_ga_w;
        WS_GW(p)[idx] = f2bf(w[(size_t)((l * 2 + d) * 16 + j) * 4096 + i * 64 + o]);
    }
}

__device__ __forceinline__ const float* xrow_src(const Params& p, int l, int row) {
    const int b = row / TPB, t = row % TPB;
    if (l == 0) return t < 256 ? p.ctx + ((size_t)b * 256 + t) * DM : p.x + ((size_t)b * 2048 + (t - 256)) * DM;
    return WS_XB(p) + (size_t)row * DM;
}
__device__ __forceinline__ void norm_phase(const Params& p, int l, int G) {
    const int lane = tidx() & 63, wave = tidx() >> 6;
    bf16_t* U = WS_U(p);
    for (int row = blockIdx.x * 8 + wave; row < NTOK; row += G * 8) {
        const int b = row / TPB, t = row % TPB;
        const float* src = xrow_src(p, l, row);
        const float* md = WS_MOD(p) + (size_t)(l * 9 + (t < 256 ? 8 : b)) * 6144;
        f32x4 v[8]; float ss = 0.f;
#pragma unroll
        for (int j = 0; j < 8; ++j) { v[j] = *(const f32x4*)(src + 4 * lane + 256 * j); ss += v[j].x * v[j].x + v[j].y * v[j].y + v[j].z * v[j].z + v[j].w * v[j].w; }
        ss = wave_sum(ss);
        const float rstd = rsqrtf(ss * (1.f / 2048.f) + 1e-6f);
#pragma unroll
        for (int j = 0; j < 8; ++j) {
            const int col = 4 * lane + 256 * j;
            const f32x4 nw = *(const f32x4*)(p.norm_w + l * 2048 + col), sh = *(const f32x4*)(md + col), sc = *(const f32x4*)(md + 2048 + col);
            const f32x4 y = v[j] * rstd * nw * (sc + 1.f) + sh;
            u32x2 w; w.x = cvt_pk_bf16(y.x, y.y); w.y = cvt_pk_bf16(y.z, y.w);
            *(u32x2*)(U + (size_t)row * DM + col) = w;
        }
    }
}

struct EpiG1 {
    static constexpr bool PERM = true, AFTER_DRAIN = false;
    bf16_t* P;
    __device__ __forceinline__ void operator()(const f32x4 (&acc)[2][2][4][2], const pg8::Unit& u, int wr, int wc, int fr, int fq) const {
        const int row0 = u.pm * 256 + wr * 64 + fr, col0 = u.pn * 256 + wc * 32 + 8 * fq;
#pragma unroll
        for (int ai = 0; ai < 2; ++ai)
#pragma unroll
            for (int m = 0; m < 4; ++m) { bf16_t* rowp = P + (size_t)(row0 + ai * 128 + m * 16) * LDP + col0;
#pragma unroll
                for (int bj = 0; bj < 2; ++bj) { const f32x4 v0 = acc[ai][bj][m][0], v1 = acc[ai][bj][m][1];
                    u32x4 w; w.x = cvt_pk_bf16(v0.x, v0.y); w.y = cvt_pk_bf16(v0.z, v0.w); w.z = cvt_pk_bf16(v1.x, v1.y); w.w = cvt_pk_bf16(v1.z, v1.w);
                    *(u32x4*)(rowp + bj * 128) = w; } }
    }
};
struct EpiG2 {
    static constexpr bool PERM = true, AFTER_DRAIN = false;
    Params p; int l; int scr;
    __device__ __forceinline__ void operator()(const f32x4 (&acc)[2][2][4][2], const pg8::Unit& u, int wr, int wc, int fr, int fq) const {
        const int row0 = u.pm * 256 + wr * 64 + fr, col0 = u.pn * 256 + wc * 32 + 8 * fq;
#pragma unroll
        for (int ai = 0; ai < 2; ++ai)
#pragma unroll
            for (int m = 0; m < 4; ++m) {
                const int row = row0 + ai * 128 + m * 16, b = row / TPB, t = row % TPB;
                if (l == 3 && t < 256) continue;
                const float* xo = xrow_src(p, l, row);
                float* dst = scr ? (float*)WS_P(p) + (size_t)row * DM : (l == 3) ? p.out + ((size_t)b * 2048 + (t - 256)) * DM : WS_XB(p) + (size_t)row * DM;
                const float* gt = WS_MOD(p) + (size_t)(l * 9 + (t < 256 ? 8 : b)) * 6144 + 4096;
#pragma unroll
                for (int bj = 0; bj < 2; ++bj)
#pragma unroll
                    for (int n = 0; n < 2; ++n) { const int col = col0 + bj * 128 + n * 4; const f32x4 xv = *(const f32x4*)(xo + col), g = *(const f32x4*)(gt + col); *(f32x4*)(dst + col) = xv + g * acc[ai][bj][m][n]; }
            }
    }
};

template <int SCR>
__device__ __forceinline__ void qkprep_row(const Params& p, int l, int row, int lane) {
    const int t = row % TPB;
    bf16_t* rp = WS_P(p) + (size_t)row * LDP;
    float cs = 1.f, sn = 0.f;
    if (t >= 256) {
        const int s = t - 256, rr = s >> 6, cc = s & 63, f = lane & 31;
        const float inv = exp2f(-(float)f * (13.287712379549449f / 32.f));
        const float ang = (float)(lane < 32 ? rr : cc) * inv;
        cs = __cosf(ang); sn = __sinf(ang);
    }
#pragma unroll
    for (int slot = 0; slot < 10; ++slot) {
        const int col = slot < 8 ? C_Q + slot * 128 : C_K + (slot - 8) * 128;
        const float* w = slot < 8 ? p.att_q_norm + l * 128 : p.att_k_norm + l * 128;
        const float v1 = bf2f(rp[col + lane]), v2 = bf2f(rp[col + 64 + lane]);
        const float ss = wave_sum(v1 * v1 + v2 * v2);
        const float rstd = rsqrtf(ss * (1.f / 128.f) + 1e-6f);
        const float y1 = v1 * rstd * w[lane], y2 = v2 * rstd * w[64 + lane];
        float o1 = y1 * cs - y2 * sn, o2 = y1 * sn + y2 * cs;
        if (slot < 8) { o1 *= 0.08838834764831845f; o2 *= 0.08838834764831845f; }
        if (SCR) { bf16_t* sp = WS_ST(p) + (size_t)row * 1280 + slot * 128; sp[lane] = f2bf(o1); sp[64 + lane] = f2bf(o2); } else { rp[col + lane] = f2bf(o1); rp[col + 64 + lane] = f2bf(o2); }
    }
}

template <int D, int SCR = 0>
__device__ __forceinline__ void lru_sweep_item(const Params& p, int l, int item, unsigned char* shm) {
    const int tid = tidx(), lane = tid & 63, wave = tid >> 6, ch = tid & 63, seg = tid >> 6;
    const int j = item & 15, b = item >> 4;
    bf16_t* sX = (bf16_t*)shm; bf16_t* sW = (bf16_t*)(shm + 18432);
    float* sA = (float*)(shm + 36864); float* sB = (float*)(shm + 69632); float* sSA = (float*)(shm + 102400); float* sSB = (float*)(shm + 104448);
    bf16_t* sOut = (bf16_t*)(shm + 106496);
    const int mi = wave & 3, nj = wave >> 2, cl = nj * 32 + (lane & 31), cgl = j * 64 + cl;
    const float ba = p.lru_ga_b[(l * 2 + D) * 1024 + cgl], bx = p.lru_gx_b[(l * 2 + D) * 1024 + cgl], sp = softplusf(-p.lru_lambda[(l * 2 + D) * 1024 + cgl]);
    lds_barrier();
    {
        u32x4 wr2[2];
#pragma unroll
        for (int k = 0; k < 2; ++k) { const int idx = tid + k * 512; wr2[k] = *(const u32x4*)(WS_GW(p) + (size_t)(l * 16 + j) * 16384 + D * 8192 + idx * 8); }
#pragma unroll
        for (int k = 0; k < 2; ++k) { const int idx = tid + k * 512; *(u32x4*)(sW + (idx >> 3) * 72 + (idx & 7) * 8) = wr2[k]; }
    }
    u32x4 xr[2], lgr[2], hfr[2];
    {
        const size_t tok0 = (size_t)b * TPB + chunk_at(D, 0) * 128;
#pragma unroll
        for (int k = 0; k < 2; ++k) {
            const int idx = tid + k * 512;
            xr[k] = *(const u32x4*)(WS_LXC(p) + (tok0 + (idx >> 3)) * 1024 + j * 64 + (idx & 7) * 8);
            if (D == 1) { lgr[k] = *(const u32x4*)(WS_P(p) + (tok0 + (idx >> 3)) * LDP + C_LG + j * 64 + (idx & 7) * 8); hfr[k] = *(const u32x4*)(WS_MIX(p) + (tok0 + (idx >> 3)) * MIXW + j * 64 + (idx & 7) * 8); }
        }
    }
    float carry = 0.f;
#pragma unroll 1
    for (int pos = 0; pos < NCH; ++pos) {
        const size_t tok0 = (size_t)b * TPB + chunk_at(D, pos) * 128;
#pragma unroll
        for (int k = 0; k < 2; ++k) { const int idx = tid + k * 512; *(u32x4*)(sX + (idx >> 3) * 72 + (idx & 7) * 8) = xr[k]; }
        u32x4 lgc[2], hfc[2];
        if (D == 1) { lgc[0] = lgr[0]; lgc[1] = lgr[1]; hfc[0] = hfr[0]; hfc[1] = hfr[1]; }
        if (pos + 1 < NCH) {
            const size_t tokn = (size_t)b * TPB + chunk_at(D, pos + 1) * 128;
#pragma unroll
            for (int k = 0; k < 2; ++k) {
                const int idx = tid + k * 512;
                xr[k] = *(const u32x4*)(WS_LXC(p) + (tokn + (idx >> 3)) * 1024 + j * 64 + (idx & 7) * 8);
                if (D == 1) { lgr[k] = *(const u32x4*)(WS_P(p) + (tokn + (idx >> 3)) * LDP + C_LG + j * 64 + (idx & 7) * 8); hfr[k] = *(const u32x4*)(WS_MIX(p) + (tokn + (idx >> 3)) * MIXW + j * 64 + (idx & 7) * 8); }
            }
        }
        lds_barrier();
        {
            f32x16 ga, gx;
#pragma unroll
            for (int r = 0; r < 16; ++r) { ga[r] = 0.f; gx[r] = 0.f; }
            mm32<64>(ga, sX + mi * 32 * 72, 72, sW + (nj * 32) * 72, 72, lane);
            mm32<64>(gx, sX + mi * 32 * 72, 72, sW + (64 + nj * 32) * 72, 72, lane);
#pragma unroll
            for (int r = 0; r < 16; ++r) {
                const int tl = mi * 32 + rowmap32(r, lane);
                const float rg = sigmf(ga[r] + ba), ig = sigmf(gx[r] + bx);
                const float a = __expf(-8.f * rg * sp), mult = __builtin_amdgcn_sqrtf(fmaxf(1.f - a * a, 0.f));
                const float xv = bf2f(sX[tl * 72 + cl]);
                sA[tl * 64 + cl] = a; sB[tl * 64 + cl] = mult * ig * xv;
            }
        }
        lds_barrier();
        {
            float A = 1.f, Bc = 0.f;
#pragma unroll
            for (int q = 0; q < 16; ++q) { const int tl = seg * 16 + (D == 0 ? q : 15 - q); const float a = sA[tl * 64 + ch], bb = sB[tl * 64 + ch]; A = a * A; Bc = a * Bc + bb; }
            sSA[seg * 64 + ch] = A; sSB[seg * 64 + ch] = Bc;
        }
        lds_barrier();
        {
            float h = carry, cn = carry;
            const int myord = D == 0 ? seg : 7 - seg;
#pragma unroll
            for (int s = 0; s < 8; ++s) { const int sg = D == 0 ? s : 7 - s; const float a = sSA[sg * 64 + ch], bb = sSB[sg * 64 + ch]; cn = a * cn + bb; if (s < myord) h = cn; }
            carry = cn;
#pragma unroll
            for (int q = 0; q < 16; ++q) { const int tl = seg * 16 + (D == 0 ? q : 15 - q); h = sA[tl * 64 + ch] * h + sB[tl * 64 + ch]; sOut[tl * 72 + ch] = f2bf(h); }
        }
        lds_barrier();
#pragma unroll
        for (int k = 0; k < 2; ++k) {
            const int idx = tid + k * 512, rr = idx >> 3, ck = idx & 7;
            const u32x4 hv = *(const u32x4*)(sOut + rr * 72 + ck * 8);
            bf16_t* dst = SCR ? WS_P(p) + (tok0 + rr) * LDP + j * 64 + ck * 8 : WS_MIX(p) + (tok0 + rr) * MIXW + j * 64 + ck * 8;
            if (D == 0) *(u32x4*)dst = hv;
            else {
                const f32x8 a = unpack8(hv), f = unpack8(hfc[k]), g = unpack8(lgc[k]);
                f32x8 o;
#pragma unroll
                for (int e = 0; e < 8; ++e) o[e] = (a[e] + f[e]) * siluf(g[e]);
                *(u32x4*)dst = pack8(o);
            }
        }
    }
}

__device__ __forceinline__ void prep_elem(const Params& p, int l, int G) {
    const int gt = (int)blockIdx.x * 512 + tidx(), NT = G * 512;
    constexpr int NI = NTOK * 192, U = 3;
    for (int base = gt; base < NI; base += NT * U) {
        u32x4 raw[U][4];
#pragma unroll
        for (int u = 0; u < U; ++u) {
            const int idx = base + u * NT;
            if (idx < NI) {
                const int tok = idx / 192, cgi = idx % 192, b = tok / TPB, t = tok % TPB;
                const int lo = t < 256 ? 0 : 256, hi = t < 256 ? 256 : TPB;
                const int col = cgi < 128 ? C_LX + cgi * 8 : C_XBC + 1024 + (cgi - 128) * 8;
                const bf16_t* src = WS_P(p) + (size_t)b * TPB * LDP + col;
#pragma unroll
                for (int k = 0; k < 4; ++k) { const int tt = t - 2 + k; raw[u][k] = (tt >= lo && tt < hi) ? *(const u32x4*)(src + (size_t)tt * LDP) : (u32x4){0u, 0u, 0u, 0u}; }
            }
        }
#pragma unroll
        for (int u = 0; u < U; ++u) {
            const int idx = base + u * NT;
            if (idx < NI) {
                const int tok = idx / 192, cgi = idx % 192;
                int CS; const float *cw, *cb; bf16_t* dst; bool act;
                if (cgi < 128) { cw = p.lru_conv_w + l * 4096 + cgi * 8; CS = 1024; cb = p.lru_conv_b + l * 1024 + cgi * 8; act = false; dst = WS_LXC(p) + (size_t)tok * 1024 + cgi * 8; }
                else { const int c2 = (cgi - 128) * 8; cw = p.ssd_conv_w + l * 6144 + 1024 + c2; CS = 1536; cb = p.ssd_conv_b + l * 1536 + 1024 + c2; act = true; dst = WS_SBC(p) + (size_t)tok * 512 + c2; }
                const f32x4 b0 = *(const f32x4*)cb, b1 = *(const f32x4*)(cb + 4);
                f32x8 acc; acc[0] = b0.x; acc[1] = b0.y; acc[2] = b0.z; acc[3] = b0.w; acc[4] = b1.x; acc[5] = b1.y; acc[6] = b1.z; acc[7] = b1.w;
#pragma unroll
                for (int k = 0; k < 4; ++k) {
                    const f32x8 v = unpack8(raw[u][k]);
                    const f32x4 w0 = *(const f32x4*)(cw + k * CS), w1 = *(const f32x4*)(cw + k * CS + 4);
                    acc[0] += w0.x * v[0]; acc[1] += w0.y * v[1]; acc[2] += w0.z * v[2]; acc[3] += w0.w * v[3];
                    acc[4] += w1.x * v[4]; acc[5] += w1.y * v[5]; acc[6] += w1.z * v[6]; acc[7] += w1.w * v[7];
                }
                if (act) {
#pragma unroll
                    for (int e = 0; e < 8; ++e) acc[e] = siluf(acc[e]);
                }
                *(u32x4*)dst = pack8(acc);
            }
        }
    }
}
struct PrepTile { int col0, ch0, t0, lo, hi, conv; const bf16_t* Pb; bf16_t* dst; };
__device__ __forceinline__ PrepTile prep_tile_decode(const Params& p, int item) {
    PrepTile T;
    const int t24 = item % 24, bc = item / 24, c = bc % NCH, b = bc / NCH;
    T.t0 = c * 128; T.Pb = WS_P(p) + (size_t)b * TPB * LDP; T.ch0 = 0; T.conv = t24 < 20;
    if (t24 < 16) { T.ch0 = t24 * 64; T.col0 = C_XBC + T.ch0; T.dst = WS_SXT(p) + ((size_t)((b * 18 + c) * 16 + t24)) * 8192; }
    else if (t24 < 20) { const int q = t24 - 16, g = q >> 1, nh = q & 1; T.ch0 = 1024 + g * 128 + nh * 64; T.col0 = C_XBC + T.ch0; T.dst = WS_SBT(p) + ((size_t)((b * 18 + c) * 2 + g)) * 16384 + (size_t)nh * 64 * 128; }
    else { const int q = t24 - 20, kh = q >> 1, dh = q & 1; T.col0 = C_V + kh * 128 + dh * 64; T.dst = WS_VT(p) + ((size_t)((b * 18 + c) * 2 + kh)) * 16384 + (size_t)dh * 64 * 128; }
    T.lo = T.t0 < 256 ? 0 : 256; T.hi = T.t0 < 256 ? 256 : TPB;
    return T;
}
__device__ __forceinline__ void prep_tile_load(const PrepTile& T, int tid, u32x4 (&raw)[2][4]) {
#pragma unroll
    for (int k = 0; k < 2; ++k) {
        const int idx = tid + k * 512, cgi = idx & 7, t = T.t0 + (idx >> 3);
#pragma unroll
        for (int q = 0; q < 4; ++q) {
            const int tt = T.conv ? t - 2 + q : t;
            const bool ok = T.conv ? (tt >= T.lo && tt < T.hi) : (q == 2);
            raw[k][q] = ok ? *(const u32x4*)(T.Pb + (size_t)tt * LDP + T.col0 + cgi * 8) : (u32x4){0u, 0u, 0u, 0u};
        }
    }
}
__device__ __forceinline__ void prep_tile_finish(const Params& p, int l, const PrepTile& T, int tid, const u32x4 (&raw)[2][4], unsigned char* shm) {
    bf16_t* sT = (bf16_t*)shm;
    const float* cw = p.ssd_conv_w + l * 6144 + T.ch0; const float* cb = p.ssd_conv_b + l * 1536 + T.ch0;
    lds_barrier();
#pragma unroll
    for (int k = 0; k < 2; ++k) {
        const int idx = tid + k * 512, cgi = idx & 7, tl = idx >> 3;
        f32x8 acc;
        if (T.conv) {
            const f32x4 b0 = *(const f32x4*)(cb + cgi * 8), b1 = *(const f32x4*)(cb + cgi * 8 + 4);
            acc[0] = b0.x; acc[1] = b0.y; acc[2] = b0.z; acc[3] = b0.w; acc[4] = b1.x; acc[5] = b1.y; acc[6] = b1.z; acc[7] = b1.w;
#pragma unroll
            for (int q = 0; q < 4; ++q) {
                const f32x8 v = unpack8(raw[k][q]);
                const f32x4 w0 = *(const f32x4*)(cw + q * 1536 + cgi * 8), w1 = *(const f32x4*)(cw + q * 1536 + cgi * 8 + 4);
                acc[0] += w0.x * v[0]; acc[1] += w0.y * v[1]; acc[2] += w0.z * v[2]; acc[3] += w0.w * v[3];
                acc[4] += w1.x * v[4]; acc[5] += w1.y * v[5]; acc[6] += w1.z * v[6]; acc[7] += w1.w * v[7];
            }
#pragma unroll
            for (int e = 0; e < 8; ++e) acc[e] = siluf(acc[e]);
        } else acc = unpack8(raw[k][2]);
#pragma unroll
        for (int e = 0; e < 8; ++e) sT[(cgi * 8 + e) * 130 + tl] = f2bf(acc[e]);
    }
    lds_barrier();
#pragma unroll
    for (int k = 0; k < 2; ++k) {
        const int idx = tid + k * 512, r = idx >> 4, ck = idx & 15;
        const unsigned* sp = (const unsigned*)(sT + r * 130 + ck * 8);
        u32x4 o; o.x = sp[0]; o.y = sp[1]; o.z = sp[2]; o.w = sp[3];
        *(u32x4*)(T.dst + r * 128 + ck * 8) = o;
    }
}
__device__ __forceinline__ void prep_tiles(const Params& p, int l, int bid, int G, unsigned char* shm) {
    const int tid = tidx();
    if (bid >= 3456) return;
    u32x4 raw[2][4], nraw[2][4];
    { const PrepTile T0 = prep_tile_decode(p, bid); prep_tile_load(T0, tid, raw); }
#pragma unroll 1
    for (int it = bid; it < 3456; it += G) {
        const bool more = it + G < 3456;
        if (more) { const PrepTile Tn = prep_tile_decode(p, it + G); prep_tile_load(Tn, tid, nraw); }
        { const PrepTile T = prep_tile_decode(p, it); prep_tile_finish(p, l, T, tid, raw, shm); }
        if (more) {
#pragma unroll
            for (int k = 0; k < 2; ++k)
#pragma unroll
                for (int q = 0; q < 4; ++q) raw[k][q] = nraw[k][q];
        }
    }
}
__device__ __forceinline__ void prep_dt_item(const Params& p, int l, int item) {
    const int tid = tidx();
    const int c = item % NCH, b = item / NCH;
    const int col32 = tid >> 4, h = col32 >> 1, d = col32 & 1, lane16 = tid & 15, seg = d == 0 ? lane16 : 15 - lane16;
    const float A = -__expf(p.ssd_A_log[(l * 2 + d) * 16 + h]), bias = p.ssd_dt_bias[(l * 2 + d) * 16 + h];
    const float* src = WS_DTP(p) + ((size_t)b * TPB + c * 128) * 16 + h;
    float dtv[8], cs[8], run = 0.f;
    float rawv[8];
#pragma unroll
    for (int q = 0; q < 8; ++q) { const int j = seg * 8 + (d == 0 ? q : 7 - q); rawv[q] = src[j * 16]; }
#pragma unroll
    for (int q = 0; q < 8; ++q) { dtv[q] = softplusf(rawv[q] + bias); run += dtv[q] * A; cs[q] = run; }
    float incl = run;
#pragma unroll
    for (int off = 1; off < 16; off <<= 1) { const float v = __shfl_up(incl, off, 16); if (lane16 >= off) incl += v; }
    const float excl = incl - run;
    float* dta = WS_DTA(p) + ((size_t)(b * 18 + c) * 128) * 32 + col32;
    float* acs = WS_ACS(p) + ((size_t)(b * 18 + c) * 128) * 32 + col32;
#pragma unroll
    for (int q = 0; q < 8; ++q) { const int j = seg * 8 + (d == 0 ? q : 7 - q); dta[j * 32] = dtv[q]; acs[j * 32] = cs[q] + excl; }
    if (lane16 == 15) WS_AL(p)[((b * 2 + d) * 18 + c) * 16 + h] = incl;
}
__device__ __forceinline__ void ssd_states_item(const Params& p, int l, int item, unsigned char* shm) {
    const int tid = tidx(), lane = tid & 63, wave = tid >> 6;
    const int g = item & 1, hh0 = ((item >> 1) & 1) * 4, bc = item >> 2, c = bc % NCH, b = bc / NCH;
    bf16_t* sBT = (bf16_t*)shm; bf16_t* sXw = (bf16_t*)(shm + 34816);
    float* sDt = (float*)(shm + 69632); float* sAcs = (float*)(shm + 77824); bf16_t* sO = (bf16_t*)(shm + 86016); float* sWg = (float*)(shm + 120832);
    const bf16_t* xt = WS_SXT(p) + ((size_t)((b * 18 + c) * 16 + g * 8)) * 8192;
    const bf16_t* btp = WS_SBT(p) + ((size_t)((b * 18 + c) * 2 + g)) * 16384;
    lds_barrier();
    {
        const size_t o = ((size_t)(b * 18 + c) * 128 + (tid >> 2)) * 32 + g * 16 + (tid & 3) * 4;
        const f32x4 vdt = *(const f32x4*)(WS_DTA(p) + o), vac = *(const f32x4*)(WS_ACS(p) + o);
        u32x4 bt[4];
#pragma unroll
        for (int k = 0; k < 4; ++k) { const int idx = tid + k * 512; bt[k] = *(const u32x4*)(btp + (idx >> 4) * 128 + (idx & 15) * 8); }
        *(f32x4*)(sDt + (tid >> 2) * 16 + (tid & 3) * 4) = vdt; *(f32x4*)(sAcs + (tid >> 2) * 16 + (tid & 3) * 4) = vac;
#pragma unroll
        for (int k = 0; k < 4; ++k) { const int idx = tid + k * 512; *(u32x4*)(sBT + (idx >> 4) * 136 + (idx & 15) * 8) = bt[k]; }
    }
    u32x4 xr[2];
#pragma unroll
    for (int k = 0; k < 2; ++k) { const int idx = tid + k * 512; xr[k] = *(const u32x4*)(xt + (size_t)hh0 * 8192 + (idx >> 4) * 128 + (idx & 15) * 8); }
    lds_barrier();
#pragma unroll
    for (int k = 0; k < 4; ++k) { const int idx = tid + k * 512, jj = idx >> 4, col = idx & 15; const float al = (col & 1) == 0 ? sAcs[127 * 16 + col] : sAcs[col]; sWg[col * 128 + jj] = __expf(al - sAcs[jj * 16 + col]) * sDt[jj * 16 + col]; }
#pragma unroll 1
    for (int hh = hh0; hh < hh0 + 4; ++hh) {
        const int h = g * 8 + hh;
        u32x4 xn[2] = {xr[0], xr[1]};
        if (hh < hh0 + 3) {
#pragma unroll
            for (int k = 0; k < 2; ++k) { const int idx = tid + k * 512; xn[k] = *(const u32x4*)(xt + (size_t)(hh + 1) * 8192 + (idx >> 4) * 128 + (idx & 15) * 8); }
        }
        lds_barrier();
#pragma unroll
        for (int k = 0; k < 2; ++k) {
            const int idx = tid + k * 512, pp = idx >> 4, j8 = (idx & 15) * 8;
            const f32x8 xv = unpack8(xr[k]);
#pragma unroll
            for (int d = 0; d < 2; ++d) {
                const f32x4 w0 = *(const f32x4*)(sWg + (hh * 2 + d) * 128 + j8), w1 = *(const f32x4*)(sWg + (hh * 2 + d) * 128 + j8 + 4);
                f32x8 o;
                o[0] = xv[0] * w0.x; o[1] = xv[1] * w0.y; o[2] = xv[2] * w0.z; o[3] = xv[3] * w0.w; o[4] = xv[4] * w1.x; o[5] = xv[5] * w1.y; o[6] = xv[6] * w1.z; o[7] = xv[7] * w1.w;
                *(u32x4*)(sXw + d * 8704 + pp * 136 + j8) = pack8(o);
            }
        }
        lds_barrier();
        const int mi = wave & 1, nj = wave >> 1;
#pragma unroll
        for (int d = 0; d < 2; ++d) {
            f32x16 acc;
#pragma unroll
            for (int r = 0; r < 16; ++r) acc[r] = 0.f;
            mm32<128>(acc, sXw + d * 8704 + mi * 32 * 136, 136, sBT + nj * 32 * 136, 136, lane);
#pragma unroll
            for (int r = 0; r < 16; ++r) sO[d * 8704 + (mi * 32 + rowmap32(r, lane)) * 136 + nj * 32 + (lane & 31)] = f2bf(acc[r]);
        }
        lds_barrier();
#pragma unroll
        for (int d = 0; d < 2; ++d) {
            bf16_t* base = WS_ST(p) + ((size_t)((b * 2 + d) * 18 + c) * 16 + h) * 8192;
#pragma unroll
            for (int k = 0; k < 2; ++k) { const int idx = tid + k * 512; *(u32x4*)(base + idx * 8) = *(const u32x4*)(sO + d * 8704 + (idx >> 4) * 136 + (idx & 15) * 8); }
        }
        xr[0] = xn[0]; xr[1] = xn[1];
    }
}
__device__ __forceinline__ void ssd_recur_item(const Params& p, int item) {
    const int tid = tidx();
    const int d = item & 1, h = (item >> 1) & 15, b = item >> 5;
    u32x4 s0[NCH], s1[NCH]; float ev[NCH];
#pragma unroll
    for (int pos = 0; pos < NCH; ++pos) {
        const int c = chunk_at(d, pos);
        const bf16_t* ptr = WS_ST(p) + ((size_t)((b * 2 + d) * 18 + c) * 16 + h) * 8192 + tid * 16;
        s0[pos] = *(const u32x4*)ptr; s1[pos] = *(const u32x4*)(ptr + 8);
        ev[pos] = WS_AL(p)[((b * 2 + d) * 18 + c) * 16 + h];
    }
    f32x8 h0, h1;
#pragma unroll
    for (int e = 0; e < 8; ++e) { h0[e] = 0.f; h1[e] = 0.f; }
#pragma unroll
    for (int pos = 0; pos < NCH; ++pos) {
        const int c = chunk_at(d, pos);
        bf16_t* ptr = WS_ST(p) + ((size_t)((b * 2 + d) * 18 + c) * 16 + h) * 8192 + tid * 16;
        *(u32x4*)ptr = pack8(h0); *(u32x4*)(ptr + 8) = pack8(h1);
        const float e = __expf(ev[pos]);
        h0 = h0 * e + unpack8(s0[pos]); h1 = h1 * e + unpack8(s1[pos]);
    }
}
template <int MODE>
__device__ __forceinline__ void ssd_final_item(const Params& p, int l, int item, unsigned char* shm) {
    const int tid = tidx(), lane = tid & 63, wave = tid >> 6;
    const int g = item & 1, hh0 = ((item >> 1) & 1) * 4, bc = item >> 2, c = bc % NCH, b = bc / NCH, t0 = c * 128;
    const size_t tok0 = (size_t)b * TPB + t0;
    bf16_t* sC = (bf16_t*)shm; bf16_t* sBW = (bf16_t*)(shm + 34816); bf16_t* sXT = (bf16_t*)(shm + 69632); bf16_t* sH = (bf16_t*)(shm + 87040);
    float* sDt = (float*)(shm + 104448); float* sAcs = (float*)(shm + 112640);
    bf16_t* sY = sBW;
    const bf16_t* xt = WS_SXT(p) + ((size_t)((b * 18 + c) * 16 + g * 8)) * 8192;
    const bf16_t* zt = WS_P(p) + tok0 * LDP + C_Z + g * 512;
    const bf16_t* hin0 = WS_ST(p) + ((size_t)((b * 2 + 0) * 18 + c) * 16 + g * 8) * 8192;
    const bf16_t* hin1 = WS_ST(p) + ((size_t)((b * 2 + 1) * 18 + c) * 16 + g * 8) * 8192;
    lds_barrier();
    u32x4 xr[2], zr[2], h0r[2];
    {
        const size_t o = ((size_t)(b * 18 + c) * 128 + (tid >> 2)) * 32 + g * 16 + (tid & 3) * 4;
        const f32x4 vdt = *(const f32x4*)(WS_DTA(p) + o), vac = *(const f32x4*)(WS_ACS(p) + o);
        u32x4 cr[4], br[4];
#pragma unroll
        for (int k = 0; k < 4; ++k) { const int idx = tid + k * 512; const bf16_t* s = WS_SBC(p) + (tok0 + (idx >> 4)) * 512 + g * 128 + (idx & 15) * 8; br[k] = *(const u32x4*)s; cr[k] = *(const u32x4*)(s + 256); }
#pragma unroll
        for (int k = 0; k < 2; ++k) {
            const int idx = tid + k * 512;
            xr[k] = *(const u32x4*)(xt + (size_t)hh0 * 8192 + (idx >> 4) * 128 + (idx & 15) * 8);
            zr[k] = *(const u32x4*)(zt + (size_t)(idx >> 3) * LDP + hh0 * 64 + (idx & 7) * 8);
            h0r[k] = *(const u32x4*)(hin0 + (size_t)hh0 * 8192 + idx * 8);
        }
        *(f32x4*)(sDt + (tid >> 2) * 16 + (tid & 3) * 4) = vdt; *(f32x4*)(sAcs + (tid >> 2) * 16 + (tid & 3) * 4) = vac;
#pragma unroll
        for (int k = 0; k < 4; ++k) { const int idx = tid + k * 512; *(u32x4*)(sC + (idx >> 4) * 136 + (idx & 15) * 8) = cr[k]; *(u32x4*)(sBW + (idx >> 4) * 136 + (idx & 15) * 8) = br[k]; }
    }
    lds_barrier();
    const int cmi = wave >> 1, cnj0 = (wave & 1) * 2;
    f32x16 cb0, cb1;
#pragma unroll
    for (int r = 0; r < 16; ++r) { cb0[r] = 0.f; cb1[r] = 0.f; }
    mm32<128>(cb0, sC + cmi * 32 * 136, 136, sBW + cnj0 * 32 * 136, 136, lane);
    mm32<128>(cb1, sC + cmi * 32 * 136, 136, sBW + (cnj0 + 1) * 32 * 136, 136, lane);
    const int ymi = wave & 3, ynj = wave >> 2;
#pragma unroll 1
    for (int hh = hh0; hh < hh0 + 4; ++hh) {
        const int h = g * 8 + hh;
        lds_barrier();
#pragma unroll
        for (int k = 0; k < 2; ++k) { const int idx = tid + k * 512; *(u32x4*)(sXT + (idx >> 4) * 136 + (idx & 15) * 8) = xr[k]; *(u32x4*)(sH + (idx >> 4) * 136 + (idx & 15) * 8) = h0r[k]; }
        u32x4 h1r[2];
#pragma unroll
        for (int k = 0; k < 2; ++k) h1r[k] = *(const u32x4*)(hin1 + (size_t)hh * 8192 + (tid + k * 512) * 8);
        f32x16 yacc;
#pragma unroll
        for (int r = 0; r < 16; ++r) yacc[r] = 0.f;
#pragma unroll 1
        for (int d = 0; d < 2; ++d) {
            const int col = hh * 2 + d;
            if (d == 1) {
                lds_barrier();
#pragma unroll
                for (int k = 0; k < 2; ++k) { const int idx = tid + k * 512; *(u32x4*)(sH + (idx >> 4) * 136 + (idx & 15) * 8) = h1r[k]; }
            }
            if (MODE < 2) {
                float aci[16];
#pragma unroll
                for (int r = 0; r < 16; ++r) aci[r] = sAcs[(cmi * 32 + rowmap32(r, lane)) * 16 + col];
#pragma unroll
                for (int tt = 0; tt < 2; ++tt) {
                    const int jg = (cnj0 + tt) * 32 + (lane & 31);
                    const float acj = sAcs[jg * 16 + col], dtj = sDt[jg * 16 + col];
                    const int dj0 = jg - cmi * 32 - 4 * (lane >> 5), dj = d == 0 ? dj0 : -dj0;
#pragma unroll
                    for (int r = 0; r < 16; ++r) {
                        const int ro = (r & 3) + 8 * (r >> 2);
                        const int sd = d == 0 ? dj - ro : dj + ro;
                        float arg = aci[r] - acj; arg = sd <= 0 ? arg : -INFINITY;
                        const float cbv = tt == 0 ? cb0[r] : cb1[r];
                        sBW[(cmi * 32 + rowmap32(r, lane)) * 136 + jg] = f2bf(cbv * __expf(arg) * dtj);
                    }
                }
            }
            lds_barrier();
            f32x16 ad, ao;
#pragma unroll
            for (int r = 0; r < 16; ++r) { ad[r] = 0.f; ao[r] = 0.f; }
            if (MODE < 3) { mm32<128>(ad, sBW + ymi * 32 * 136, 136, sXT + ynj * 32 * 136, 136, lane);
            mm32<128>(ao, sC + ymi * 32 * 136, 136, sH + ynj * 32 * 136, 136, lane); }
#pragma unroll
            for (int r = 0; r < 16; ++r) { const int ig = ymi * 32 + rowmap32(r, lane); yacc[r] += ad[r] + __expf(sAcs[ig * 16 + col]) * ao[r]; }
            if (d == 0 && hh < hh0 + 3) {
#pragma unroll
                for (int k = 0; k < 2; ++k) {
                    const int idx = tid + k * 512;
                    xr[k] = *(const u32x4*)(xt + (size_t)(hh + 1) * 8192 + (idx >> 4) * 128 + (idx & 15) * 8);
                    h0r[k] = *(const u32x4*)(hin0 + (size_t)(hh + 1) * 8192 + idx * 8);
                }
            }
        }
        const float Dh = p.ssd_D[l * 16 + h];
        const int pl = ynj * 32 + (lane & 31);
#pragma unroll
        for (int r = 0; r < 16; ++r) { const int ig = ymi * 32 + rowmap32(r, lane); yacc[r] += Dh * bf2f(sXT[pl * 136 + ig]); }
        lds_barrier();
#pragma unroll
        for (int r = 0; r < 16; ++r) { const int ig = ymi * 32 + rowmap32(r, lane); sY[ig * 72 + pl] = f2bf(yacc[r]); }
        lds_barrier();
#pragma unroll
        for (int k = 0; k < 2; ++k) {
            const int idx = tid + k * 512, rr = idx >> 3, pk = idx & 7;
            const f32x8 yv = unpack8(*(const u32x4*)(sY + rr * 72 + pk * 8)), zv = unpack8(zr[k]);
            f32x8 o;
#pragma unroll
            for (int e = 0; e < 8; ++e) o[e] = yv[e] * siluf(zv[e]);
            if (MODE < 1) *(u32x4*)(WS_MIX(p) + (tok0 + rr) * MIXW + 2048 + h * 64 + pk * 8) = pack8(o); else asm volatile("" :: "v"(o[0]), "v"(o[7]));
        }
        if (hh < hh0 + 3) {
#pragma unroll
            for (int k = 0; k < 2; ++k) { const int idx = tid + k * 512; zr[k] = *(const u32x4*)(zt + (size_t)(idx >> 3) * LDP + (hh + 1) * 64 + (idx & 7) * 8); }
        }
    }
}
__device__ __forceinline__ void ssd_norm_phase(const Params& p, int l, int G) {
    const int lane = tidx() & 63, wave = tidx() >> 6;
    for (int row = blockIdx.x * 8 + wave; row < NTOK; row += G * 8) {
        bf16_t* rp = WS_MIX(p) + (size_t)row * MIXW + 2048;
        f32x8 v0 = unpack8(*(const u32x4*)(rp + lane * 8)), v1 = unpack8(*(const u32x4*)(rp + 512 + lane * 8));
        float ss = 0.f;
#pragma unroll
        for (int e = 0; e < 8; ++e) ss += v0[e] * v0[e] + v1[e] * v1[e];
        ss = wave_sum(ss);
        const float rstd = rsqrtf(ss * (1.f / 1024.f) + 1e-6f);
        const float* nw = p.ssd_norm_w + l * 1024;
#pragma unroll
        for (int e = 0; e < 8; ++e) { v0[e] = v0[e] * rstd * nw[lane * 8 + e]; v1[e] = v1[e] * rstd * nw[512 + lane * 8 + e]; }
        *(u32x4*)(rp + lane * 8) = pack8(v0); *(u32x4*)(rp + 512 + lane * 8) = pack8(v1);
    }
}

template <int MODE>
__device__ __forceinline__ void attn_item(const Params& p, int l, int item, unsigned char* shm) {
    const int tid = tidx(), lane = tid & 63, wave = tid >> 6, fr = lane & 15, fq = lane >> 4;
    const int hp = item & 3, bq = item >> 2, qblk = bq % NCH, b = bq / NCH, kh = hp >> 1;
    const bf16_t* P = WS_P(p);
    bf16_t* sK = (bf16_t*)shm; bf16_t* sVT = (bf16_t*)(shm + 34816); bf16_t* sPw = (bf16_t*)(shm + 69632) + wave * (2 * 16 * 136);
    const size_t tokq0 = (size_t)b * TPB + qblk * 128;
    bf16x8 aq[2][4];
#pragma unroll
    for (int hd = 0; hd < 2; ++hd)
#pragma unroll
        for (int kk = 0; kk < 4; ++kk) aq[hd][kk] = *(const bf16x8*)(P + (tokq0 + wave * 16 + fr) * LDP + C_Q + (hp * 2 + hd) * 128 + kk * 32 + 8 * fq);
    float m[2][4], ls[2][4]; f32x4 O[2][8];
#pragma unroll
    for (int hd = 0; hd < 2; ++hd) {
        const float sink = p.att_sink[l * 8 + hp * 2 + hd];
#pragma unroll
        for (int r = 0; r < 4; ++r) { m[hd][r] = sink; ls[hd][r] = 1.f; }
#pragma unroll
        for (int nd = 0; nd < 8; ++nd) O[hd][nd] = (f32x4){0.f, 0.f, 0.f, 0.f};
    }
    const int nlat = qblk - 2;
    const int kb_lo = nlat - 1 < 0 ? 0 : nlat - 1, kb_hi = nlat + 1 > 15 ? 15 : nlat + 1;
    const int ntl = qblk < 2 ? 2 : 2 + (kb_hi - kb_lo + 1);
    u32x4 kr[4], vr[4];
    const bf16_t* vtb = WS_VT(p) + ((size_t)(b * 18) * 2 + kh) * 16384;
    {
        const bf16_t* kbase = P + ((size_t)b * TPB) * LDP + C_K + kh * 128;
#pragma unroll
        for (int k = 0; k < 4; ++k) { const int idx = tid + k * 512; kr[k] = *(const u32x4*)(kbase + (size_t)(idx >> 4) * LDP + (idx & 15) * 8); vr[k] = *(const u32x4*)(vtb + idx * 8); }
    }
#pragma unroll 1
    for (int ti = 0; ti < ntl; ++ti) {
        const bool masked = ti >= 2; const int kb = kb_lo + (ti - 2);
        lds_barrier();
#pragma unroll
        for (int k = 0; k < 4; ++k) {
            const int idx = tid + k * 512;
            *(u32x4*)(sK + (idx >> 4) * 136 + (idx & 15) * 8) = kr[k];
            *(u32x4*)(sVT + (idx >> 4) * 136 + (idx & 15) * 8) = vr[k];
        }
        if (ti + 1 < ntl) {
            const int tn = ti + 1, t0n = tn < 2 ? tn * 128 : 256 + (kb_lo + (tn - 2)) * 128;
            const bf16_t* kbase = P + ((size_t)b * TPB + t0n) * LDP + C_K + kh * 128;
            const bf16_t* vtn = vtb + (size_t)(t0n >> 7) * 32768;
#pragma unroll
            for (int k = 0; k < 4; ++k) { const int idx = tid + k * 512; kr[k] = *(const u32x4*)(kbase + (size_t)(idx >> 4) * LDP + (idx & 15) * 8); vr[k] = *(const u32x4*)(vtn + idx * 8); }
        }
        lds_barrier();
#pragma unroll 1
        for (int hf = 0; hf < 2; ++hf) {
            f32x4 s[2][4];
#pragma unroll
            for (int nt = 0; nt < 4; ++nt) {
                s[0][nt] = (f32x4){0.f, 0.f, 0.f, 0.f}; s[1][nt] = (f32x4){0.f, 0.f, 0.f, 0.f};
#pragma unroll
                for (int kk = 0; kk < 4; ++kk) {
                    const bf16x8 bk = *(const bf16x8*)(sK + ((hf * 4 + nt) * 16 + fr) * 136 + kk * 32 + 8 * fq);
                    s[0][nt] = __builtin_amdgcn_mfma_f32_16x16x32_bf16(aq[0][kk], bk, s[0][nt], 0, 0, 0);
                    s[1][nt] = __builtin_amdgcn_mfma_f32_16x16x32_bf16(aq[1][kk], bk, s[1][nt], 0, 0, 0);
                }
                __builtin_amdgcn_sched_barrier(0);
            }
            if (masked) {
#pragma unroll
                for (int nt = 0; nt < 4; ++nt)
#pragma unroll
                    for (int r = 0; r < 4; ++r) { const int rel = (nlat * 128 + wave * 16 + fq * 4 + r) - (kb * 128 + (hf * 4 + nt) * 16 + fr); if (rel > 128 || rel < -128) { s[0][nt][r] = -INFINITY; s[1][nt][r] = -INFINITY; } }
            }
#pragma unroll
            for (int hd = 0; hd < 2; ++hd) {
                float alpha[4];
#pragma unroll
                for (int r = 0; r < 4; ++r) {
                    float mx = fmaxf(fmaxf(s[hd][0][r], s[hd][1][r]), fmaxf(s[hd][2][r], s[hd][3][r]));
                    mx = row16_max(mx);
                    const float mn = fmaxf(m[hd][r], mx);
                    alpha[r] = __expf(m[hd][r] - mn); m[hd][r] = mn;
                    float rs = 0.f;
#pragma unroll
                    for (int nt = 0; nt < 4; ++nt) { const float pv = __expf(s[hd][nt][r] - mn); s[hd][nt][r] = pv; rs += pv; }
                    rs = row16_sum(rs);
                    ls[hd][r] = ls[hd][r] * alpha[r] + rs;
                }
#pragma unroll
                for (int nd = 0; nd < 8; ++nd) { O[hd][nd].x *= alpha[0]; O[hd][nd].y *= alpha[1]; O[hd][nd].z *= alpha[2]; O[hd][nd].w *= alpha[3]; }
#pragma unroll
                for (int nt = 0; nt < 4; ++nt)
#pragma unroll
                    for (int r = 0; r < 4; ++r) sPw[hd * (16 * 136) + (fq * 4 + r) * 136 + nt * 16 + fr] = f2bf(s[hd][nt][r]);
            }
            asm volatile("s_waitcnt lgkmcnt(0)" ::: "memory");
#pragma unroll
            for (int kk = 0; kk < 2; ++kk) {
                const bf16x8 ap0 = *(const bf16x8*)(sPw + fr * 136 + kk * 32 + 8 * fq);
                const bf16x8 ap1 = *(const bf16x8*)(sPw + 16 * 136 + fr * 136 + kk * 32 + 8 * fq);
#pragma unroll
                for (int nd = 0; nd < 8; ++nd) {
                    const bf16x8 bv = *(const bf16x8*)(sVT + (nd * 16 + fr) * 136 + hf * 64 + kk * 32 + 8 * fq);
                    O[0][nd] = __builtin_amdgcn_mfma_f32_16x16x32_bf16(ap0, bv, O[0][nd], 0, 0, 0);
                    O[1][nd] = __builtin_amdgcn_mfma_f32_16x16x32_bf16(ap1, bv, O[1][nd], 0, 0, 0);
                    if (nd == 3) __builtin_amdgcn_sched_barrier(0);
                }
                __builtin_amdgcn_sched_barrier(0);
            }
            asm volatile("s_waitcnt lgkmcnt(0)" ::: "memory");
        }
    }
#pragma unroll
    for (int hd = 0; hd < 2; ++hd) {
        const int hq = hp * 2 + hd;
        u32x4 agr[4];
#pragma unroll
        for (int k = 0; k < 4; ++k) { const int idx = tid + k * 512; agr[k] = *(const u32x4*)(P + (tokq0 + (idx >> 4)) * LDP + C_AG + hq * 128 + (idx & 15) * 8); }
        lds_barrier();
#pragma unroll
        for (int r = 0; r < 4; ++r) {
            const float il = __builtin_amdgcn_rcpf(ls[hd][r]);
#pragma unroll
            for (int nd = 0; nd < 8; ++nd) sK[(wave * 16 + fq * 4 + r) * 136 + nd * 16 + fr] = f2bf(O[hd][nd][r] * il);
        }
        lds_barrier();
#pragma unroll
        for (int k = 0; k < 4; ++k) {
            const int idx = tid + k * 512, rr = idx >> 4, ck = idx & 15;
            const f32x8 ov = unpack8(*(const u32x4*)(sK + rr * 136 + ck * 8)), gv = unpack8(agr[k]);
            f32x8 o;
#pragma unroll
            for (int e = 0; e < 8; ++e) o[e] = ov[e] * siluf(gv[e]);
            *(u32x4*)(WS_MIX(p) + (tokq0 + rr) * MIXW + 1024 + hq * 128 + ck * 8) = pack8(o);
        }
    }
}

#define XB_TMO      128
#define XB_XCNT(j)  (256  + 64 * (j))
#define XB_XSUB(j)  (1280 + 64 * (j))
#define XB_XGEN(j)  (2304 + 64 * (j))
#define XB_TOP      3328
#define XB_TOPGEN   3392
#define XCD_BAR_WORDS 3456
#define XB_SPIN_CAP (1u << 18)
#define LAS __attribute__((address_space(3)))
__device__ __forceinline__ unsigned xb_ld(unsigned* p)              { return __hip_atomic_load(p, __ATOMIC_RELAXED, __HIP_MEMORY_SCOPE_AGENT); }
__device__ __forceinline__ unsigned xb_add(unsigned* p, unsigned v) { return __hip_atomic_fetch_add(p, v, __ATOMIC_RELAXED, __HIP_MEMORY_SCOPE_AGENT); }
__device__ __forceinline__ unsigned xb_xcc_id() { return (unsigned)__builtin_amdgcn_s_getreg((3 << 11) | 20) & 0xFu; }
#define XB_SPIN(cond, bar) do { unsigned _sp = 0; while (cond) { __builtin_amdgcn_s_sleep(1); \
    if ((++_sp & 255u) == 0u) { if (xb_ld(&(bar)[XB_TMO])) break; if (_sp > XB_SPIN_CAP) { atomicAdd(&(bar)[XB_TMO], 1u); break; } } } } while (0)
struct XcdBarrier { unsigned* bar; unsigned x; volatile LAS unsigned* st; };
__device__ __forceinline__ XcdBarrier xcd_barrier_post(unsigned* bar, volatile LAS unsigned* st) {
    XcdBarrier b; b.bar = bar; b.x = xb_xcc_id(); b.st = st;
    if (tidx() == 0) (void)xb_add(&bar[XB_XCNT(b.x)], 1u);
    return b;
}
__device__ __forceinline__ void xcd_barrier_complete(unsigned* bar, unsigned x, unsigned& nloc, unsigned& nx) {
    const unsigned G = gridDim.x * gridDim.y * gridDim.z;
    unsigned sum, cnt, mine, sp = 0u;
    for (;;) {
        sum = 0u; cnt = 0u; mine = 0u;
#pragma unroll
        for (unsigned j = 0; j < 16; ++j) { const unsigned c = xb_ld(&bar[XB_XCNT(j)]); sum += c; cnt += (c > 0u) ? 1u : 0u; mine = (j == x) ? c : mine; }
        if (sum == G) break;
        __builtin_amdgcn_s_sleep(1);
        if ((++sp & 255u) == 0u) { if (xb_ld(&bar[XB_TMO])) break; if (sp > XB_SPIN_CAP) { atomicAdd(&bar[XB_TMO], 1u); break; } }
    }
    nloc = mine > 0u ? mine : 1u; nx = cnt > 0u ? cnt : 1u;
}
__device__ __forceinline__ void xcd_barrier(const XcdBarrier& b) {
    asm volatile("s_waitcnt vmcnt(0)" ::: "memory");
    __syncthreads();
    if (tidx() == 0) {
        unsigned* bar = b.bar;
        __builtin_amdgcn_s_waitcnt(0);
        unsigned nloc = b.st[0], nx = b.st[1];
        if (nloc == 0u) { xcd_barrier_complete(bar, b.x, nloc, nx); b.st[0] = nloc; b.st[1] = nx; }
        const unsigned old = xb_add(&bar[XB_XSUB(b.x)], 1u);
        const unsigned gen = old / nloc;
        if (old + 1u == (gen + 1u) * nloc) {
            __builtin_amdgcn_fence(__ATOMIC_RELEASE, "agent");
            asm volatile("s_waitcnt vmcnt(0)" ::: "memory");
            const unsigned og = xb_add(&bar[XB_TOP], 1u);
            const unsigned tg = og / nx;
            if (og + 1u == (tg + 1u) * nx) xb_add(&bar[XB_TOPGEN], 1u);
            else XB_SPIN(xb_ld(&bar[XB_TOPGEN]) == tg, bar);
            __builtin_amdgcn_fence(__ATOMIC_ACQUIRE, "agent");
            xb_add(&bar[XB_XGEN(b.x)], 1u);
            asm volatile("s_waitcnt vmcnt(0)" ::: "memory");
        } else {
            XB_SPIN(xb_ld(&bar[XB_XGEN(b.x)]) == gen, bar);
            __builtin_amdgcn_fence(__ATOMIC_ACQUIRE, "agent");
            asm volatile("s_waitcnt vmcnt(0)" ::: "memory");
        }
    }
    __syncthreads();
}


#define QUEUE_LOOP(ctr, NITEMS, BODY) do { \
    volatile LAS unsigned* _mb = (volatile LAS unsigned*)(shm + LDS_CTL + 8); \
    int it = bid; \
    while (it < (NITEMS)) { \
        unsigned _nx = 0u; if (tidx() == 0) _nx = xb_add((ctr), 1u) + (unsigned)G; \
        BODY; \
        __syncthreads(); \
        if (tidx() == 0) _mb[0] = _nx; \
        __syncthreads(); \
        it = (int)_mb[0]; \
    } } while (0)

__global__ __launch_bounds__(512) void mega(Params p) {
    extern __shared__ __attribute__((aligned(16))) unsigned char shm[];
    cg::grid_group grid = cg::this_grid();
    const int G = (int)gridDim.x, bid = (int)blockIdx.x;
    if (tidx() < 4) ((volatile LAS unsigned*)(shm + LDS_CTL))[tidx()] = 0u;
    __syncthreads();
    unsigned* qctr = (unsigned*)(p.ws + OFF_BAR) + 3584;
    const XcdBarrier xb = xcd_barrier_post((unsigned*)(p.ws + OFF_BAR), (volatile LAS unsigned*)(shm + LDS_CTL));
    for (int rep = 0; rep < 1 + DUP_P0; ++rep) phase0(p, shm, G);
    grid.sync();
#pragma unroll 1
    for (int l = 0; l < 4; ++l) {
        for (int rep = 0; rep < 1 + DUP_NORM; ++rep) norm_phase(p, l, G);
        xcd_barrier(xb);
        {
            pg8::Gemm g{WS_U(p), WS_WTIN(p) + (size_t)l * 7424 * 2048, NTOK, 7168, 2048};
            pg8::Order S; S.init(72, 28, G, bid, 0);
            EpiG1 E{WS_P(p)};
            for (int rep = 0; rep < 1 + DUP_G1; ++rep) pg8::gemm_phase<EpiG1, pg8::Order>((PG8_LAS unsigned char*)shm, g, S, E);
            {
                const int tq = tidx(), wave = tq >> 6, lane = tq & 63, fr = lane & 15, fq = lane >> 4;
                for (int wu = bid * 8 + wave; wu < NTOK / 16; wu += G * 8) {
                    const bf16_t* ap = WS_U(p) + (size_t)(wu * 16 + fr) * 2048 + 8 * fq;
                    const bf16_t* bp = WS_WTIN(p) + ((size_t)l * 7424 + 7168 + fr) * 2048 + 8 * fq;
                    f32x4 acc = (f32x4){0.f, 0.f, 0.f, 0.f};
#pragma unroll 8
                    for (int kk = 0; kk < 64; ++kk) { const bf16x8 a = *(const bf16x8*)(ap + kk * 32), bq = *(const bf16x8*)(bp + kk * 32); acc = __builtin_amdgcn_mfma_f32_16x16x32_bf16(a, bq, acc, 0, 0, 0); }
#pragma unroll
                    for (int r = 0; r < 4; ++r) WS_DTP(p)[(size_t)(wu * 16 + fq * 4 + r) * 16 + fr] = acc[r];
                }
            }
        }
        for (int rep = 0; rep < 1 + DUP_SYNC; ++rep) xcd_barrier(xb);
        for (int rep = 0; rep < 1 + DUP_E1; ++rep) {
            if (rep == 0 || E1SEL == 0 || E1SEL == 1) for (int it = bid; it < 144; it += G) prep_dt_item(p, l, it);
            if (rep == 0 || E1SEL == 0 || E1SEL == 2) { __syncthreads(); prep_tiles(p, l, bid, G, shm); }
            if (rep == 0 || E1SEL == 0 || E1SEL == 3) prep_elem(p, l, G);
        }
        { const int tq = tidx(), wave = tq >> 6, lane = tq & 63; for (int row = bid * 8 + wave; row < NTOK; row += G * 8) qkprep_row<0>(p, l, row, lane);
#if DUP_QK
          for (int row = bid * 8 + wave; row < NTOK; row += G * 8) qkprep_row<1>(p, l, row, lane);
#endif
        }
        xcd_barrier(xb);
        QUEUE_LOOP(qctr + (l * 3 + 0) * 64, 128 + 576, { if (it < 128) lru_sweep_item<0>(p, l, it, shm); else ssd_states_item(p, l, it - 128, shm); });
#if DUP_X1Q
        __syncthreads(); QUEUE_LOOP(qctr + (12 + l * 3 + 0) * 64, 128 + 576, { if (it < 128) lru_sweep_item<0>(p, l, it, shm); else ssd_states_item(p, l, it - 128, shm); });
#endif
#if DUP_SWEEP
        __syncthreads(); for (int it = bid; it < 128; it += G) lru_sweep_item<0>(p, l, it, shm);
#endif
#if DUP_STATES
        __syncthreads(); for (int it = bid; it < 256; it += G) ssd_states_item(p, l, it, shm);
#endif
        xcd_barrier(xb);
        QUEUE_LOOP(qctr + (l * 3 + 1) * 64, 256 + 576, { if (it < 256) ssd_recur_item(p, it); else attn_item<0>(p, l, it - 256, shm); });
#if DUP_ATTQ
        __syncthreads(); QUEUE_LOOP(qctr + (12 + l * 3 + 1) * 64, 576, { attn_item<AMODE>(p, l, it, shm); });
#endif
        xcd_barrier(xb);
        QUEUE_LOOP(qctr + (l * 3 + 2) * 64, 128 + 576, { if (it < 128) lru_sweep_item<1>(p, l, it, shm); else ssd_final_item<0>(p, l, it - 128, shm); });
#if DUP_FINAL
        __syncthreads(); for (int it = bid; it < 256; it += G) ssd_final_item<FMODE>(p, l, it, shm);
#endif
#if DUP_SWEEP1
        __syncthreads(); for (int it = bid; it < 128; it += G) lru_sweep_item<1, 1>(p, l, it, shm);
#endif
        xcd_barrier(xb);
#ifndef SK_X4
        ssd_norm_phase(p, l, G);
#endif
        xcd_barrier(xb);
        {
            pg8::Gemm g{WS_MIX(p), WS_WTOUT(p) + (size_t)l * 2048 * 3072, NTOK, 2048, 3072};
            pg8::Order S; S.init(l == 3 ? 64 : 72, 8, G, bid, l == 3 ? 1 : 0);
            EpiG2 E{p, l, 0};
#if DUP_G2
            { EpiG2 E2{p, l, 1}; pg8::gemm_phase<EpiG2, pg8::Order>((PG8_LAS unsigned char*)shm, g, S, E2); }
#endif
#ifndef SK_G2
            pg8::gemm_phase<EpiG2, pg8::Order>((PG8_LAS unsigned char*)shm, g, S, E);
#endif
        }
        if (l < 3) xcd_barrier(xb);
    }
}

extern "C" void kernel_launch(void* const* d_in, const int* in_sizes, int n_in, void* d_out, int out_size, void* d_ws, size_t ws_size, hipStream_t stream) {
    static int grid = 0;
    if (grid == 0) {
        if (n_in != 25 || ws_size < WS_END) { fprintf(stderr, "kernel_launch: need 25 inputs and %zu bytes of workspace (got %d, %zu)\n", (size_t)WS_END, n_in, ws_size); grid = -1; return; }
        int dev = 0, cus = 0, per_cu = 0;
        hipGetDevice(&dev);
        hipDeviceGetAttribute(&cus, hipDeviceAttributeMultiprocessorCount, dev);
        if (hipFuncSetAttribute((const void*)mega, hipFuncAttributeMaxDynamicSharedMemorySize, LDS_BYTES) != hipSuccess) { fprintf(stderr, "kernel_launch: hipFuncSetAttribute failed\n"); grid = -1; return; }
        if (hipOccupancyMaxActiveBlocksPerMultiprocessor(&per_cu, (const void*)mega, 512, LDS_BYTES) != hipSuccess || per_cu < 1) { fprintf(stderr, "kernel_launch: occupancy query gave %d\n", per_cu); per_cu = 1; }
        (void)hipGetLastError();
        grid = cus * 1;
        if (grid <= 0) grid = 256;
    }
    if (grid < 0) return;
    Params p{};
    const float** pf = (const float**)&p;
    for (int i = 0; i < 25; ++i) pf[i] = (const float*)d_in[i];
    p.out = (float*)d_out; p.ws = (unsigned char*)d_ws;
    if (hipMemsetAsync((char*)d_ws + OFF_BAR, 0, 32768, stream) != hipSuccess) { fprintf(stderr, "kernel_launch: memset of barrier words failed\n"); return; }
    void* args[] = {&p};
    hipError_t e = hipLaunchCooperativeKernel((const void*)mega, dim3(grid), dim3(512), args, LDS_BYTES, stream);
    if (e != hipSuccess) fprintf(stderr, "cooperative launch failed: %s (grid %d)\n", hipGetErrorString(e), grid);
}
```

```cpp
#include <hip/hip_runtime.h>
#include <hip/hip_cooperative_groups.h>
#include <cstdio>
#include <cstdint>
namespace cg = cooperative_groups;
#define DUP_X1A 0
#define DUP_X1B 0
#define DUP_ATT 0
#define DUP_X3A 0
#define DUP_X3B 0
#define DUP_G1 0
#define DUP_P0 0
#define DUP_NORM 0
#define DUP_SYNC 0
#define DUP_E1 0
#define DUP_SWEEP1 0
#define DUP_G2 0
#define DUP_QK 0
#define E1SEL 0
#define DUP_SWEEP 0
#define DUP_STATES 0
#define DUP_FINAL 0
#define AMODE 0
#define FMODE 0
#define DUP_X1Q 0
#define DUP_ATTQ 0
#define DUP_X3Q 0

__device__ __forceinline__ int tidx() { int t = (int)threadIdx.x; asm volatile("" : "+v"(t)); return t; }

namespace pg8 {
#define PG8_LAS __attribute__((address_space(3)))
typedef unsigned short bf16_t;
typedef short bf16x8 __attribute__((ext_vector_type(8)));
typedef float f32x4 __attribute__((ext_vector_type(4)));
typedef unsigned u32x4 __attribute__((ext_vector_type(4)));
constexpr int BM = 256, BK = 64, HALF = 128, HTB = HALF * BK * 2  , STAGE_BYTES = 8 * HTB, NXCD = 8, WGM = 8;

__host__ __device__ __forceinline__ int lds_byte(int r, int c) { const int st = (r >> 4) * 2 + (c >> 5), rr = r & 15, cc = c & 31, ob = rr * 64 + cc * 2; return st * 1024 + (ob ^ (((ob >> 9) & 1) << 5)); }
__host__ __device__ __forceinline__ void stage_rc(int b, int& R, int& C) { const int st = b / 1024, sb = b % 1024, swz = sb ^ (((sb >> 9) & 1) << 5); R = (st >> 1) * 16 + swz / 64; C = (st & 1) * 32 + (swz % 64) / 2; }
__host__ __device__ __forceinline__ int perm32(int rho) { const int n = rho >> 4, i = rho & 15; return 8 * (i >> 2) + 4 * n + (i & 3); }

struct Unit { int pm, pn; };
struct Gemm { const bf16_t* A; const bf16_t* Bt; int M, N, K; };

struct Order {
    int nM, nN, nwg, G, c, skipctx;
    __device__ void init(int nM_, int nN_, int G_, int c_, int skip_) { nM = nM_; nN = nN_; nwg = nM * nN; G = G_; c = c_; skipctx = skip_; }
    __device__ bool next(int i, Unit& u) const {
        const long L = (long)i * G + c; if (L >= nwg) return false;
        int wgid = (int)L; { const int q = nwg / NXCD, r = nwg % NXCD, xcd = wgid % NXCD, off = wgid / NXCD; wgid = (xcd < r ? xcd * (q + 1) : r * (q + 1) + (xcd - r) * q) + off; }
        const int nig = WGM * nN, gid = wgid / nig, fm = gid * WGM, gsz = (nM - fm) < WGM ? (nM - fm) : WGM;
        int pm = fm + ((wgid % nig) % gsz); u.pn = (wgid % nig) / gsz;
        if (skipctx) pm = (pm >> 3) * 9 + 1 + (pm & 7);
        u.pm = pm; return true;
    }
    __device__ __forceinline__ void a_ready(const Unit&) const {}
    __device__ __forceinline__ void done(const Unit&) const {}
};
typedef __bf16 bf16x2_t __attribute__((ext_vector_type(2)));
typedef float f32x2_t __attribute__((ext_vector_type(2)));
__device__ __forceinline__ unsigned cvt_pk_bf16(float lo, float hi) { f32x2_t v = {lo, hi}; bf16x2_t b = __builtin_convertvector(v, bf16x2_t); return __builtin_bit_cast(unsigned, b); }

template <class Epi, class Sched>
__device__ __forceinline__ void gemm_phase(PG8_LAS unsigned char* lds, const Gemm g, const Sched& S, const Epi& E) {
    const int tid = tidx(), wid = __builtin_amdgcn_readfirstlane(tid >> 6), lane = tid & 63, wr = wid >> 2, wc = wid & 3, fr = lane & 15, fq = lane >> 4;
    const int K = g.K, nt = K / BK;
    unsigned voffA[2], voffB[2];
#pragma unroll
    for (int i = 0; i < 2; ++i) { int R, C; stage_rc(tid * 16 + i * 8192, R, C); const int Rb = Epi::PERM ? ((R & ~31) + perm32(R & 31)) : R;
        voffA[i] = (unsigned)(R * K + C) * 2u; voffB[i] = (unsigned)(Rb * K + C) * 2u; }
    const size_t kstep = (size_t)(BK * 2);
    const size_t hstep = (size_t)HALF * K * 2;
    const size_t tstep = 2 * hstep;
    const unsigned ldsw = (unsigned)wid * 1024u;
    const int aoff = lds_byte(wr * 64 + fr, fq * 8), boff = lds_byte(wc * 32 + fr, fq * 8);
#define PG8_SA(b, h) (((b) * 2 + (h)) * HTB)
#define PG8_SB(b, h) ((4 + (b) * 2 + (h)) * HTB)
#define PG8_STAGE(bufoff, gbase, voff) do { _Pragma("unroll") for (int _i = 0; _i < 2; ++_i) \
        __builtin_amdgcn_global_load_lds((const unsigned*)((const char*)(gbase) + (voff)[_i]), (PG8_LAS unsigned*)(lds + (bufoff) + ldsw + _i * 8192), 16, 0, 0); } while (0)
#define PG8_LDA(dst, b, h) do { _Pragma("unroll") for (int m = 0; m < 4; ++m) _Pragma("unroll") for (int k = 0; k < 2; ++k) dst[m][k] = *(const PG8_LAS bf16x8*)(lds + PG8_SA(b, h) + aoff + m * 2048 + k * 1024); } while (0)
#define PG8_LDB(dst, b, h) do { _Pragma("unroll") for (int n = 0; n < 2; ++n) _Pragma("unroll") for (int k = 0; k < 2; ++k) dst[n][k] = *(const PG8_LAS bf16x8*)(lds + PG8_SB(b, h) + boff + n * 2048 + k * 1024); } while (0)
#define PG8_MMA(ai, bj, At, Bt) do { __builtin_amdgcn_s_setprio(1); _Pragma("unroll") for (int m = 0; m < 4; ++m) _Pragma("unroll") for (int n = 0; n < 2; ++n) _Pragma("unroll") for (int k = 0; k < 2; ++k) \
        acc[ai][bj][m][n] = __builtin_amdgcn_mfma_f32_16x16x32_bf16(Bt[n][k], At[m][k], acc[ai][bj][m][n], 0, 0, 0); __builtin_amdgcn_s_setprio(0); } while (0)
#define PG8_WAIT_V(n) asm volatile("s_waitcnt vmcnt(" #n ")" ::: "memory")
#define PG8_WAIT_L(n) asm volatile("s_waitcnt lgkmcnt(" #n ")" ::: "memory")
#define PG8_BAR __builtin_amdgcn_s_barrier()
#define PG8_SCHED __builtin_amdgcn_sched_barrier(0)
    Unit cur, nxt; int ui = 0;
    if (!S.next(0, cur)) return;
    f32x4 acc[2][2][4][2];
#pragma unroll
    for (int a = 0; a < 2; ++a)
#pragma unroll
        for (int b = 0; b < 2; ++b)
#pragma unroll
            for (int m = 0; m < 4; ++m)
#pragma unroll
                for (int n = 0; n < 2; ++n) acc[a][b][m][n] = (f32x4){0.f, 0.f, 0.f, 0.f};
    bf16x8 At[4][2], B0[2][2], B1[2][2];
    const char* cA = (const char*)g.A + (size_t)cur.pm * tstep; const char* cB = (const char*)g.Bt + (size_t)cur.pn * tstep;
    S.a_ready(cur);
    PG8_STAGE(PG8_SB(0, 0), cB, voffB); PG8_STAGE(PG8_SA(0, 0), cA, voffA); PG8_STAGE(PG8_SB(0, 1), cB + hstep, voffB); PG8_STAGE(PG8_SA(0, 1), cA + hstep, voffA);
    if (wr == 1) PG8_BAR;
    PG8_WAIT_V(4); PG8_BAR;
    PG8_STAGE(PG8_SB(1, 0), cB + kstep, voffB); PG8_STAGE(PG8_SA(1, 0), cA + kstep, voffA); PG8_STAGE(PG8_SB(1, 1), cB + hstep + kstep, voffB);
    PG8_WAIT_V(6); PG8_BAR;
    for (;;) {
        const bool has_next = S.next(ui + 1, nxt);
        const char* nA = has_next ? (const char*)g.A + (size_t)nxt.pm * tstep : cA; const char* nB = has_next ? (const char*)g.Bt + (size_t)nxt.pn * tstep : cB;
        for (int t = 0; t < nt; t += 2) {
            const bool last = (t == nt - 2);
            const char* a1 = cA + (size_t)(t + 1) * kstep;
            const char* a2 = last ? nA : cA + (size_t)(t + 2) * kstep; const char* b2 = last ? nB : cB + (size_t)(t + 2) * kstep;
            const char* a3 = a2 + kstep; const char* b3 = b2 + kstep;
            if (last && has_next) S.a_ready(nxt);
            PG8_LDB(B0, 0, 0); PG8_SCHED; PG8_LDA(At, 0, 0); PG8_STAGE(PG8_SA(1, 1), a1 + hstep, voffA);
            PG8_WAIT_L(8); PG8_BAR; PG8_WAIT_L(0); PG8_MMA(0, 0, At, B0); PG8_BAR; PG8_SCHED;
            PG8_LDB(B1, 0, 1); PG8_STAGE(PG8_SB(0, 0), b2, voffB);
            PG8_BAR; PG8_WAIT_L(0); PG8_MMA(0, 1, At, B1); PG8_BAR;
            PG8_LDA(At, 0, 1); PG8_STAGE(PG8_SA(0, 0), a2, voffA);
            PG8_BAR; PG8_WAIT_L(0); PG8_MMA(1, 0, At, B0); PG8_BAR; PG8_SCHED;
            PG8_STAGE(PG8_SB(0, 1), b2 + hstep, voffB);
            PG8_WAIT_V(6); PG8_BAR; PG8_MMA(1, 1, At, B1); PG8_BAR;
            PG8_LDB(B0, 1, 0); PG8_SCHED; PG8_LDA(At, 1, 0); PG8_STAGE(PG8_SA(0, 1), a2 + hstep, voffA);
            PG8_WAIT_L(8); PG8_BAR; PG8_WAIT_L(0); PG8_MMA(0, 0, At, B0); PG8_BAR; PG8_SCHED;
            PG8_LDB(B1, 1, 1); PG8_STAGE(PG8_SB(1, 0), b3, voffB);
            PG8_BAR; PG8_WAIT_L(0); PG8_MMA(0, 1, At, B1); PG8_BAR;
            PG8_LDA(At, 1, 1); PG8_STAGE(PG8_SA(1, 0), a3, voffA);
            PG8_BAR; PG8_WAIT_L(0); PG8_MMA(1, 0, At, B0); PG8_BAR; PG8_SCHED;
            PG8_STAGE(PG8_SB(1, 1), b3 + hstep, voffB);
            PG8_WAIT_V(6); PG8_BAR; PG8_MMA(1, 1, At, B1); PG8_BAR;
        }
        if constexpr (!Epi::AFTER_DRAIN) { E(acc, cur, wr, wc, fr, fq); S.done(cur); }
        if (!has_next) break;
#pragma unroll
        for (int a = 0; a < 2; ++a)
#pragma unroll
            for (int b = 0; b < 2; ++b)
#pragma unroll
                for (int m = 0; m < 4; ++m)
#pragma unroll
                    for (int n = 0; n < 2; ++n) acc[a][b][m][n] = (f32x4){0.f, 0.f, 0.f, 0.f};
        cur = nxt; cA = nA; cB = nB; ++ui;
    }
    PG8_WAIT_V(0);
    if (wr == 0) PG8_BAR;
    PG8_BAR;
    if constexpr (Epi::AFTER_DRAIN) { E.fused(acc, cur, wr, wc, fr, fq, lds, wid, lane); S.done(cur); }
#undef PG8_SA
#undef PG8_SB
#undef PG8_STAGE
#undef PG8_LDA
#undef PG8_LDB
#undef PG8_MMA
#undef PG8_WAIT_V
#undef PG8_WAIT_L
#undef PG8_BAR
#undef PG8_SCHED
}
}

using pg8::bf16_t; using pg8::bf16x8; using pg8::f32x4; using pg8::cvt_pk_bf16;
typedef float f32x16 __attribute__((ext_vector_type(16)));
typedef float f32x8 __attribute__((ext_vector_type(8)));
typedef unsigned u32x2 __attribute__((ext_vector_type(2)));
typedef unsigned u32x4 __attribute__((ext_vector_type(4)));

constexpr int DM = 2048, TPB = 2304, NTOK = 18432, LDP = 7424, MIXW = 3072, NCH = 18;
constexpr int C_LX = 0, C_LG = 1024, C_Q = 2048, C_K = 3072, C_V = 3328, C_AG = 3584, C_XBC = 4608, C_Z = 6144, C_DT = 7168;
constexpr size_t SZ_WTIN = (size_t)4 * 7424 * 2048 * 2, SZ_WTOUT = (size_t)4 * 2048 * 3072 * 2, SZ_MOD = (size_t)4 * 9 * 6144 * 4, SZ_U = (size_t)NTOK * 2048 * 2,
                 SZ_P = (size_t)NTOK * LDP * 2, SZ_MIX = (size_t)NTOK * MIXW * 2, SZ_XB = (size_t)NTOK * 2048 * 4, SZ_ST = (size_t)8 * 2 * 18 * 16 * 8192 * 2,
                 SZ_AL = (size_t)8 * 2 * 18 * 16 * 4, SZ_SUM = (size_t)8 * 2 * 18 * 1024 * 4;
constexpr size_t OFF_WTIN = 0, OFF_WTOUT = OFF_WTIN + SZ_WTIN, OFF_MOD = OFF_WTOUT + SZ_WTOUT, OFF_U = OFF_MOD + SZ_MOD, OFF_P = OFF_U + SZ_U, OFF_MIX = OFF_P + SZ_P,
                 OFF_XB = OFF_MIX + SZ_MIX, OFF_ST = OFF_XB + SZ_XB, OFF_AL = OFF_ST + SZ_ST, OFF_SUMA = OFF_AL + SZ_AL, OFF_SUMB = OFF_SUMA + SZ_SUM, OFF_BAR = OFF_SUMB + SZ_SUM, OFF_SBC = OFF_BAR + 32768, OFF_SBT = OFF_SBC + (size_t)NTOK * 512 * 2, OFF_DTA = OFF_SBT + (size_t)8 * 18 * 2 * 16384 * 2,
                 OFF_ACS = OFF_DTA + (size_t)NTOK * 32 * 4, OFF_HINL = OFF_ACS + (size_t)NTOK * 32 * 4, OFF_GW = OFF_HINL + SZ_SUM, OFF_DTP = OFF_GW + (size_t)4 * 16 * 16384 * 2, OFF_VT = OFF_DTP + (size_t)NTOK * 16 * 4, WS_END = OFF_VT + (size_t)8 * 18 * 2 * 16384 * 2;
constexpr size_t OFF_LXC = OFF_U, OFF_SXT = OFF_U + (size_t)NTOK * 1024 * 2;
constexpr int LDS_CTL = 147456;
constexpr int LDS_BYTES = LDS_CTL + 16;

struct Params {
    const float *x, *c, *ctx, *c_ctx, *norm_w, *ada_w, *ada_b, *w_in, *lru_conv_w, *lru_conv_b, *lru_ga_w, *lru_ga_b, *lru_gx_w, *lru_gx_b, *lru_lambda,
        *att_q_norm, *att_k_norm, *att_sink, *ssd_conv_w, *ssd_conv_b, *ssd_dt_bias, *ssd_A_log, *ssd_D, *ssd_norm_w, *w_out;
    float* out;
    unsigned char* ws;
};
#define WS_WTIN(p) ((bf16_t*)((p).ws + OFF_WTIN))
#define WS_WTOUT(p) ((bf16_t*)((p).ws + OFF_WTOUT))
#define WS_MOD(p) ((float*)((p).ws + OFF_MOD))
#define WS_U(p) ((bf16_t*)((p).ws + OFF_U))
#define WS_P(p) ((bf16_t*)((p).ws + OFF_P))
#define WS_MIX(p) ((bf16_t*)((p).ws + OFF_MIX))
#define WS_XB(p) ((float*)((p).ws + OFF_XB))
#define WS_ST(p) ((bf16_t*)((p).ws + OFF_ST))
#define WS_AL(p) ((float*)((p).ws + OFF_AL))
#define WS_SUMA(p) ((float*)((p).ws + OFF_SUMA))
#define WS_SUMB(p) ((float*)((p).ws + OFF_SUMB))
#define WS_LXC(p) ((bf16_t*)((p).ws + OFF_LXC))
#define WS_SXT(p) ((bf16_t*)((p).ws + OFF_SXT))
#define WS_SBC(p) ((bf16_t*)((p).ws + OFF_SBC))
#define WS_SBT(p) ((bf16_t*)((p).ws + OFF_SBT))
#define WS_DTA(p) ((float*)((p).ws + OFF_DTA))
#define WS_ACS(p) ((float*)((p).ws + OFF_ACS))
#define WS_HINL(p) ((float*)((p).ws + OFF_HINL))
#define WS_GW(p) ((bf16_t*)((p).ws + OFF_GW))
#define WS_DTP(p) ((float*)((p).ws + OFF_DTP))
#define WS_VT(p) ((bf16_t*)((p).ws + OFF_VT))

__device__ __forceinline__ float bf2f(bf16_t v) { return __uint_as_float(((unsigned)v) << 16); }
__device__ __forceinline__ bf16_t f2bf(float f) { return (bf16_t)(cvt_pk_bf16(f, 0.f) & 0xffffu); }
__device__ __forceinline__ float siluf(float v) { return v * __builtin_amdgcn_rcpf(1.f + __expf(-v)); }
__device__ __forceinline__ float sigmf(float v) { return __builtin_amdgcn_rcpf(1.f + __expf(-v)); }
__device__ __forceinline__ float softplusf(float v) { return v > 20.f ? v : log1pf(__expf(v)); }
__device__ __forceinline__ float wave_sum(float v) {
#pragma unroll
    for (int o = 1; o < 64; o <<= 1) v += __shfl_xor(v, o);
    return v;
}
__device__ __forceinline__ f32x8 unpack8(const u32x4 w) {
    f32x8 f;
    f[0] = __uint_as_float(w.x << 16); f[1] = __uint_as_float(w.x & 0xffff0000u); f[2] = __uint_as_float(w.y << 16); f[3] = __uint_as_float(w.y & 0xffff0000u);
    f[4] = __uint_as_float(w.z << 16); f[5] = __uint_as_float(w.z & 0xffff0000u); f[6] = __uint_as_float(w.w << 16); f[7] = __uint_as_float(w.w & 0xffff0000u);
    return f;
}
__device__ __forceinline__ u32x4 pack8(const f32x8 f) { u32x4 w; w.x = cvt_pk_bf16(f[0], f[1]); w.y = cvt_pk_bf16(f[2], f[3]); w.z = cvt_pk_bf16(f[4], f[5]); w.w = cvt_pk_bf16(f[6], f[7]); return w; }
__device__ __forceinline__ void lds_barrier() { asm volatile("s_waitcnt lgkmcnt(0)" ::: "memory"); __builtin_amdgcn_s_barrier(); asm volatile("" ::: "memory"); }
__device__ __forceinline__ float dpp_f(float v, int ctrl_sel) {
    const int x = __builtin_bit_cast(int, v); int r;
    if (ctrl_sel == 0) r = __builtin_amdgcn_update_dpp(x, x, 0xB1, 0xF, 0xF, false);
    else if (ctrl_sel == 1) r = __builtin_amdgcn_update_dpp(x, x, 0x4E, 0xF, 0xF, false);
    else if (ctrl_sel == 2) r = __builtin_amdgcn_update_dpp(x, x, 0x141, 0xF, 0xF, false);
    else r = __builtin_amdgcn_update_dpp(x, x, 0x140, 0xF, 0xF, false);
    return __builtin_bit_cast(float, r);
}
__device__ __forceinline__ float row16_max(float v) { v = fmaxf(v, dpp_f(v, 0)); v = fmaxf(v, dpp_f(v, 1)); v = fmaxf(v, dpp_f(v, 2)); v = fmaxf(v, dpp_f(v, 3)); return v; }
__device__ __forceinline__ float row16_sum(float v) { v += dpp_f(v, 0); v += dpp_f(v, 1); v += dpp_f(v, 2); v += dpp_f(v, 3); return v; }
__device__ __forceinline__ int chunk_at(int d, int pos) { return d == 0 ? pos : (pos < 2 ? 1 - pos : 19 - pos); }
__device__ __forceinline__ int pos_of(int d, int c) { return d == 0 ? c : (c < 2 ? 1 - c : 19 - c); }
__device__ __forceinline__ int rowmap32(int reg, int lane) { return (reg & 3) + 8 * (reg >> 2) + 4 * (lane >> 5); }

template <int K> __device__ __forceinline__ void mm32(f32x16& acc, const bf16_t* A, int lda, const bf16_t* B, int ldb, int lane) {
    const bf16_t* pa = A + (lane & 31) * lda + 8 * (lane >> 5);
    const bf16_t* pb = B + (lane & 31) * ldb + 8 * (lane >> 5);
#pragma unroll
    for (int k = 0; k < K; k += 16) {
        const bf16x8 a = *(const bf16x8*)(pa + k);
        const bf16x8 b = *(const bf16x8*)(pb + k);
        acc = __builtin_amdgcn_mfma_f32_32x32x16_bf16(a, b, acc, 0, 0, 0);
    }
}

template <int NC, bool SILU, bool TRANS>
__device__ __forceinline__ void stage_conv_tile(bf16_t* dst, int ld, const bf16_t* Pb, int t0, int col0, const float* cw, int CS, const float* cb, int tid) {
    constexpr int CG = NC / 8;
    const int lo = t0 < 256 ? 0 : 256, hi = t0 < 256 ? 256 : TPB;
    for (int idx = tid; idx < 128 * CG; idx += 512) {
        int cgi, tl;
        if (TRANS) { tl = idx & 127; cgi = idx >> 7; } else { cgi = idx % CG; tl = idx / CG; }
        const int t = t0 + tl;
        const f32x4 b0 = *(const f32x4*)(cb + cgi * 8), b1 = *(const f32x4*)(cb + cgi * 8 + 4);
        f32x8 acc; acc[0] = b0.x; acc[1] = b0.y; acc[2] = b0.z; acc[3] = b0.w; acc[4] = b1.x; acc[5] = b1.y; acc[6] = b1.z; acc[7] = b1.w;
#pragma unroll
        for (int k = 0; k < 4; ++k) {
            const int tt = t - 2 + k;
            if (tt >= lo && tt < hi) {
                const f32x8 v = unpack8(*(const u32x4*)(Pb + (size_t)tt * LDP + col0 + cgi * 8));
                const f32x4 w0 = *(const f32x4*)(cw + k * CS + cgi * 8), w1 = *(const f32x4*)(cw + k * CS + cgi * 8 + 4);
                acc[0] += w0.x * v[0]; acc[1] += w0.y * v[1]; acc[2] += w0.z * v[2]; acc[3] += w0.w * v[3];
                acc[4] += w1.x * v[4]; acc[5] += w1.y * v[5]; acc[6] += w1.z * v[6]; acc[7] += w1.w * v[7];
            }
        }
        if (SILU) {
#pragma unroll
            for (int e = 0; e < 8; ++e) acc[e] = siluf(acc[e]);
        }
        if (TRANS) {
#pragma unroll
            for (int e = 0; e < 8; ++e) dst[(cgi * 8 + e) * ld + tl] = f2bf(acc[e]);
        } else {
            *(u32x4*)(dst + tl * ld + cgi * 8) = pack8(acc);
        }
    }
}

__device__ __forceinline__ void transpose_item(const float* W, int K, int N, int nblk, bf16_t* WT, float* scr, int item, int lane) {
    const int kb = item / nblk, nb = item % nblk, k0 = 64 * kb, n0 = 32 * nb;
    const int c4 = lane & 7, r8 = lane >> 3, n = n0 + c4 * 4;
    f32x4 tv[8];
#pragma unroll
    for (int i = 0; i < 8; ++i) tv[i] = (n < N) ? *(const f32x4*)(W + (size_t)(k0 + i * 8 + r8) * N + n) : (f32x4){0.f, 0.f, 0.f, 0.f};
#pragma unroll
    for (int i = 0; i < 8; ++i) { float* d = scr + (i * 8 + r8) * 33 + c4 * 4; d[0] = tv[i].x; d[1] = tv[i].y; d[2] = tv[i].z; d[3] = tv[i].w; }
    asm volatile("s_waitcnt lgkmcnt(0)" ::: "memory");
    const int c = lane & 7;
#pragma unroll
    for (int j = 0; j < 4; ++j) {
        const int nn = (lane >> 3) + 8 * j; const float* s = scr + (8 * c) * 33 + nn;
        u32x4 o; o.x = cvt_pk_bf16(s[0 * 33], s[1 * 33]); o.y = cvt_pk_bf16(s[2 * 33], s[3 * 33]); o.z = cvt_pk_bf16(s[4 * 33], s[5 * 33]); o.w = cvt_pk_bf16(s[6 * 33], s[7 * 33]);
        *(u32x4*)(WT + (size_t)(n0 + nn) * K + k0 + 8 * c) = o;
    }
    asm volatile("s_waitcnt lgkmcnt(0)" ::: "memory");
}

__device__ __forceinline__ void phase0(const Params& p, unsigned char* shm, int G) {
    const int tid = tidx(), lane = tid & 63, wave = tid >> 6;
    float* sf = (float*)shm;
    float* MOD = WS_MOD(p);
    for (int item = blockIdx.x; item < 96; item += G) {
        const int l = item / 24, cgp = item % 24;
        __syncthreads();
        for (int idx = tid; idx < 9 * 2048; idx += 512) { const int r = idx >> 11, k = idx & 2047; const float v = r < 8 ? p.c[r * 2048 + k] : p.c_ctx[k]; sf[idx] = siluf(v); }
        __syncthreads();
        f32x4 acc[9];
#pragma unroll
        for (int r = 0; r < 9; ++r) acc[r] = (f32x4){0.f, 0.f, 0.f, 0.f};
        const float* wp = p.ada_w + ((size_t)l * 2048 + wave * 256) * 6144 + cgp * 256 + lane * 4;
#pragma unroll 16
        for (int kk = 0; kk < 256; ++kk) {
            const f32x4 wv = *(const f32x4*)(wp + (size_t)kk * 6144);
            const int k = wave * 256 + kk;
#pragma unroll
            for (int r = 0; r < 9; ++r) { const float s = sf[r * 2048 + k]; acc[r] += wv * s; }
        }
        __syncthreads();
#pragma unroll
        for (int r = 0; r < 9; ++r) *(f32x4*)(sf + (wave * 9 + r) * 256 + lane * 4) = acc[r];
        __syncthreads();
        for (int idx = tid; idx < 9 * 256; idx += 512) {
            const int r = idx >> 8, col = idx & 255; float s = p.ada_b[l * 6144 + cgp * 256 + col];
#pragma unroll
            for (int w = 0; w < 8; ++w) s += sf[(w * 9 + r) * 256 + col];
            MOD[(size_t)(l * 9 + r) * 6144 + cgp * 256 + col] = s;
        }
    }
    __syncthreads();
    float* scr = sf + wave * (64 * 33);
    const int gw = blockIdx.x * 8 + wave, NGW = G * 8;
    constexpr int I_IN = 32 * 232, I_OUT = 48 * 64;
    for (int it = gw; it < 4 * (I_IN + I_OUT); it += NGW) {
        if (it < 4 * I_IN) { const int l = it / I_IN, r = it % I_IN; transpose_item(p.w_in + (size_t)l * 2048 * 7184, 2048, 7184, 232, WS_WTIN(p) + (size_t)l * 7424 * 2048, scr, r, lane); }
        else { const int it2 = it - 4 * I_IN, l = it2 / I_OUT, r = it2 % I_OUT; transpose_item(p.w_out + (size_t)l * 3072 * 2048, 3072, 2048, 64, WS_WTOUT(p) + (size_t)l * 2048 * 3072, scr, r, lane); }
    }
    for (int idx = (int)blockIdx.x * 512 + tid; idx < 4 * 16 * 16384; idx += G * 512) {
        const int i = idx & 63, o = (idx >> 6) & 63, gate = (idx >> 12) & 1, d = (idx >> 13) & 1, j = (idx >> 14) & 15, l = idx >> 18;
        const float* w = gate ? p.lru_gx_w : p.lru_ga_w;
        WS_GW(p)[idx] = f2bf(w[(size_t)((l * 2 + d) * 16 + j) * 4096 + i * 64 + o]);
    }
}

__device__ __forceinline__ const float* xrow_src(const Params& p, int l, int row) {
    const int b = row / TPB, t = row % TPB;
    if (l == 0) return t < 256 ? p.ctx + ((size_t)b * 256 + t) * DM : p.x + ((size_t)b * 2048 + (t - 256)) * DM;
    return WS_XB(p) + (size_t)row * DM;
}
__device__ __forceinline__ void norm_phase(const Params& p, int l, int G) {
    const int lane = tidx() & 63, wave = tidx() >> 6;
    bf16_t* U = WS_U(p);
    for (int row = blockIdx.x * 8 + wave; row < NTOK; row += G * 8) {
        const int b = row / TPB, t = row % TPB;
        const float* src = xrow_src(p, l, row);
        const float* md = WS_MOD(p) + (size_t)(l * 9 + (t < 256 ? 8 : b)) * 6144;
        f32x4 v[8]; float ss = 0.f;
#pragma unroll
        for (int j = 0; j < 8; ++j) { v[j] = *(const f32x4*)(src + 4 * lane + 256 * j); ss += v[j].x * v[j].x + v[j].y * v[j].y + v[j].z * v[j].z + v[j].w * v[j].w; }
        ss = wave_sum(ss);
        const float rstd = rsqrtf(ss * (1.f / 2048.f) + 1e-6f);
#pragma unroll
        for (int j = 0; j < 8; ++j) {
            const int col = 4 * lane + 256 * j;
            const f32x4 nw = *(const f32x4*)(p.norm_w + l * 2048 + col), sh = *(const f32x4*)(md + col), sc = *(const f32x4*)(md + 2048 + col);
            const f32x4 y = v[j] * rstd * nw * (sc + 1.f) + sh;
            u32x2 w; w.x = cvt_pk_bf16(y.x, y.y); w.y = cvt_pk_bf16(y.z, y.w);
            *(u32x2*)(U + (size_t)row * DM + col) = w;
        }
    }
}

struct EpiG1 {
    static constexpr bool PERM = true, AFTER_DRAIN = false;
    bf16_t* P;
    __device__ __forceinline__ void operator()(const f32x4 (&acc)[2][2][4][2], const pg8::Unit& u, int wr, int wc, int fr, int fq) const {
        const int row0 = u.pm * 256 + wr * 64 + fr, col0 = u.pn * 256 + wc * 32 + 8 * fq;
#pragma unroll
        for (int ai = 0; ai < 2; ++ai)
#pragma unroll
            for (int m = 0; m < 4; ++m) { bf16_t* rowp = P + (size_t)(row0 + ai * 128 + m * 16) * LDP + col0;
#pragma unroll
                for (int bj = 0; bj < 2; ++bj) { const f32x4 v0 = acc[ai][bj][m][0], v1 = acc[ai][bj][m][1];
                    u32x4 w; w.x = cvt_pk_bf16(v0.x, v0.y); w.y = cvt_pk_bf16(v0.z, v0.w); w.z = cvt_pk_bf16(v1.x, v1.y); w.w = cvt_pk_bf16(v1.z, v1.w);
                    *(u32x4*)(rowp + bj * 128) = w; } }
    }
};
struct EpiG2 {
    static constexpr bool PERM = true, AFTER_DRAIN = false;
    Params p; int l; int scr;
    __device__ __forceinline__ void operator()(const f32x4 (&acc)[2][2][4][2], const pg8::Unit& u, int wr, int wc, int fr, int fq) const {
        const int row0 = u.pm * 256 + wr * 64 + fr, col0 = u.pn * 256 + wc * 32 + 8 * fq;
#pragma unroll
        for (int ai = 0; ai < 2; ++ai)
#pragma unroll
            for (int m = 0; m < 4; ++m) {
                const int row = row0 + ai * 128 + m * 16, b = row / TPB, t = row % TPB;
                if (l == 3 && t < 256) continue;
                const float* xo = xrow_src(p, l, row);
                float* dst = scr ? (float*)WS_P(p) + (size_t)row * DM : (l == 3) ? p.out + ((size_t)b * 2048 + (t - 256)) * DM : WS_XB(p) + (size_t)row * DM;
                const float* gt = WS_MOD(p) + (size_t)(l * 9 + (t < 256 ? 8 : b)) * 6144 + 4096;
#pragma unroll
                for (int bj = 0; bj < 2; ++bj)
#pragma unroll
                    for (int n = 0; n < 2; ++n) { const int col = col0 + bj * 128 + n * 4; const f32x4 xv = *(const f32x4*)(xo + col), g = *(const f32x4*)(gt + col); *(f32x4*)(dst + col) = xv + g * acc[ai][bj][m][n]; }
            }
    }
};

template <int SCR>
__device__ __forceinline__ void qkprep_row(const Params& p, int l, int row, int lane) {
    const int t = row % TPB;
    bf16_t* rp = WS_P(p) + (size_t)row * LDP;
    float cs = 1.f, sn = 0.f;
    if (t >= 256) {
        const int s = t - 256, rr = s >> 6, cc = s & 63, f = lane & 31;
        const float inv = exp2f(-(float)f * (13.287712379549449f / 32.f));
        const float ang = (float)(lane < 32 ? rr : cc) * inv;
        cs = __cosf(ang); sn = __sinf(ang);
    }
#pragma unroll
    for (int slot = 0; slot < 10; ++slot) {
        const int col = slot < 8 ? C_Q + slot * 128 : C_K + (slot - 8) * 128;
        const float* w = slot < 8 ? p.att_q_norm + l * 128 : p.att_k_norm + l * 128;
        const float v1 = bf2f(rp[col + lane]), v2 = bf2f(rp[col + 64 + lane]);
        const float ss = wave_sum(v1 * v1 + v2 * v2);
        const float rstd = rsqrtf(ss * (1.f / 128.f) + 1e-6f);
        const float y1 = v1 * rstd * w[lane], y2 = v2 * rstd * w[64 + lane];
        float o1 = y1 * cs - y2 * sn, o2 = y1 * sn + y2 * cs;
        if (slot < 8) { o1 *= 0.08838834764831845f; o2 *= 0.08838834764831845f; }
        if (SCR) { bf16_t* sp = WS_ST(p) + (size_t)row * 1280 + slot * 128; sp[lane] = f2bf(o1); sp[64 + lane] = f2bf(o2); } else { rp[col + lane] = f2bf(o1); rp[col + 64 + lane] = f2bf(o2); }
    }
}

template <int D, int SCR = 0>
__device__ __forceinline__ void lru_sweep_item(const Params& p, int l, int item, unsigned char* shm) {
    const int tid = tidx(), lane = tid & 63, wave = tid >> 6, ch = tid & 63, seg = tid >> 6;
    const int j = item & 15, b = item >> 4;
    bf16_t* sX = (bf16_t*)shm; bf16_t* sW = (bf16_t*)(shm + 18432);
    float* sA = (float*)(shm + 36864); float* sB = (float*)(shm + 69632); float* sSA = (float*)(shm + 102400); float* sSB = (float*)(shm + 104448);
    bf16_t* sOut = (bf16_t*)(shm + 106496);
    const int mi = wave & 3, nj = wave >> 2, cl = nj * 32 + (lane & 31), cgl = j * 64 + cl;
    const float ba = p.lru_ga_b[(l * 2 + D) * 1024 + cgl], bx = p.lru_gx_b[(l * 2 + D) * 1024 + cgl], sp = softplusf(-p.lru_lambda[(l * 2 + D) * 1024 + cgl]);
    lds_barrier();
    {
        u32x4 wr2[2];
#pragma unroll
        for (int k = 0; k < 2; ++k) { const int idx = tid + k * 512; wr2[k] = *(const u32x4*)(WS_GW(p) + (size_t)(l * 16 + j) * 16384 + D * 8192 + idx * 8); }
#pragma unroll
        for (int k = 0; k < 2; ++k) { const int idx = tid + k * 512; *(u32x4*)(sW + (idx >> 3) * 72 + (idx & 7) * 8) = wr2[k]; }
    }
    u32x4 xr[2], lgr[2], hfr[2];
    {
        const size_t tok0 = (size_t)b * TPB + chunk_at(D, 0) * 128;
#pragma unroll
        for (int k = 0; k < 2; ++k) {
            const int idx = tid + k * 512;
            xr[k] = *(const u32x4*)(WS_LXC(p) + (tok0 + (idx >> 3)) * 1024 + j * 64 + (idx & 7) * 8);
            if (D == 1) { lgr[k] = *(const u32x4*)(WS_P(p) + (tok0 + (idx >> 3)) * LDP + C_LG + j * 64 + (idx & 7) * 8); hfr[k] = *(const u32x4*)(WS_MIX(p) + (tok0 + (idx >> 3)) * MIXW + j * 64 + (idx & 7) * 8); }
        }
    }
    float carry = 0.f;
#pragma unroll 1
    for (int pos = 0; pos < NCH; ++pos) {
        const size_t tok0 = (size_t)b * TPB + chunk_at(D, pos) * 128;
#pragma unroll
        for (int k = 0; k < 2; ++k) { const int idx = tid + k * 512; *(u32x4*)(sX + (idx >> 3) * 72 + (idx & 7) * 8) = xr[k]; }
        u32x4 lgc[2], hfc[2];
        if (D == 1) { lgc[0] = lgr[0]; lgc[1] = lgr[1]; hfc[0] = hfr[0]; hfc[1] = hfr[1]; }
        if (pos + 1 < NCH) {
            const size_t tokn = (size_t)b * TPB + chunk_at(D, pos + 1) * 128;
#pragma unroll
            for (int k = 0; k < 2; ++k) {
                const int idx = tid + k * 512;
                xr[k] = *(const u32x4*)(WS_LXC(p) + (tokn + (idx >> 3)) * 1024 + j * 64 + (idx & 7) * 8);
                if (D == 1) { lgr[k] = *(const u32x4*)(WS_P(p) + (tokn + (idx >> 3)) * LDP + C_LG + j * 64 + (idx & 7) * 8); hfr[k] = *(const u32x4*)(WS_MIX(p) + (tokn + (idx >> 3)) * MIXW + j * 64 + (idx & 7) * 8); }
            }
        }
        lds_barrier();
        {
            f32x16 ga, gx;
#pragma unroll
            for (int r = 0; r < 16; ++r) { ga[r] = 0.f; gx[r] = 0.f; }
            mm32<64>(ga, sX + mi * 32 * 72, 72, sW + (nj * 32) * 72, 72, lane);
            mm32<64>(gx, sX + mi * 32 * 72, 72, sW + (64 + nj * 32) * 72, 72, lane);
#pragma unroll
            for (int r = 0; r < 16; ++r) {
                const int tl = mi * 32 + rowmap32(r, lane);
                const float rg = sigmf(ga[r] + ba), ig = sigmf(gx[r] + bx);
                const float a = __expf(-8.f * rg * sp), mult = __builtin_amdgcn_sqrtf(fmaxf(1.f - a * a, 0.f));
                const float xv = bf2f(sX[tl * 72 + cl]);
                sA[tl * 64 + cl] = a; sB[tl * 64 + cl] = mult * ig * xv;
            }
        }
        lds_barrier();
        {
            float A = 1.f, Bc = 0.f;
#pragma unroll
            for (int q = 0; q < 16; ++q) { const int tl = seg * 16 + (D == 0 ? q : 15 - q); const float a = sA[tl * 64 + ch], bb = sB[tl * 64 + ch]; A = a * A; Bc = a * Bc + bb; }
            sSA[seg * 64 + ch] = A; sSB[seg * 64 + ch] = Bc;
        }
        lds_barrier();
        {
            float h = carry, cn = carry;
            const int myord = D == 0 ? seg : 7 - seg;
#pragma unroll
            for (int s = 0; s < 8; ++s) { const int sg = D == 0 ? s : 7 - s; const float a = sSA[sg * 64 + ch], bb = sSB[sg * 64 + ch]; cn = a * cn + bb; if (s < myord) h = cn; }
            carry = cn;
#pragma unroll
            for (int q = 0; q < 16; ++q) { const int tl = seg * 16 + (D == 0 ? q : 15 - q); h = sA[tl * 64 + ch] * h + sB[tl * 64 + ch]; sOut[tl * 72 + ch] = f2bf(h); }
        }
        lds_barrier();
#pragma unroll
        for (int k = 0; k < 2; ++k) {
            const int idx = tid + k * 512, rr = idx >> 3, ck = idx & 7;
            const u32x4 hv = *(const u32x4*)(sOut + rr * 72 + ck * 8);
            bf16_t* dst = SCR ? WS_P(p) + (tok0 + rr) * LDP + j * 64 + ck * 8 : WS_MIX(p) + (tok0 + rr) * MIXW + j * 64 + ck * 8;
            if (D == 0) *(u32x4*)dst = hv;
            else {
                const f32x8 a = unpack8(hv), f = unpack8(hfc[k]), g = unpack8(lgc[k]);
                f32x8 o;
#pragma unroll
                for (int e = 0; e < 8; ++e) o[e] = (a[e] + f[e]) * siluf(g[e]);
                *(u32x4*)dst = pack8(o);
            }
        }
    }
}

__device__ __forceinline__ void prep_elem(const Params& p, int l, int G) {
    const int gt = (int)blockIdx.x * 512 + tidx(), NT = G * 512;
    constexpr int NI = (NTOK / 4) * 192;
#pragma unroll 1
    for (int idx = gt; idx < NI; idx += NT) {
        const int tok = (idx / 192) * 4, cgi = idx % 192, b = tok / TPB, t = tok % TPB;
        const int lo = t < 256 ? 0 : 256, hi = t < 256 ? 256 : TPB;
        int col, CS, rs; const float *cw, *cb; bf16_t* dst; bool act;
        if (cgi < 128) { col = C_LX + cgi * 8; cw = p.lru_conv_w + l * 4096 + cgi * 8; CS = 1024; cb = p.lru_conv_b + l * 1024 + cgi * 8; act = false; dst = WS_LXC(p) + (size_t)tok * 1024 + cgi * 8; rs = 1024; }
        else { const int c2 = (cgi - 128) * 8; col = C_XBC + 1024 + c2; cw = p.ssd_conv_w + l * 6144 + 1024 + c2; CS = 1536; cb = p.ssd_conv_b + l * 1536 + 1024 + c2; act = true; dst = WS_SBC(p) + (size_t)tok * 512 + c2; rs = 512; }
        const bf16_t* src = WS_P(p) + (size_t)b * TPB * LDP + col;
        u32x4 raw[7];
#pragma unroll
        for (int r = 0; r < 7; ++r) { const int tt = t - 2 + r; raw[r] = (tt >= lo && tt < hi) ? *(const u32x4*)(src + (size_t)tt * LDP) : (u32x4){0u, 0u, 0u, 0u}; }
        const f32x4 b0 = *(const f32x4*)cb, b1 = *(const f32x4*)(cb + 4);
        f32x8 acc[4];
#pragma unroll
        for (int o = 0; o < 4; ++o) { acc[o][0] = b0.x; acc[o][1] = b0.y; acc[o][2] = b0.z; acc[o][3] = b0.w; acc[o][4] = b1.x; acc[o][5] = b1.y; acc[o][6] = b1.z; acc[o][7] = b1.w; }
#pragma unroll
        for (int k = 0; k < 4; ++k) {
            const f32x4 w0 = *(const f32x4*)(cw + k * CS), w1 = *(const f32x4*)(cw + k * CS + 4);
#pragma unroll
            for (int o = 0; o < 4; ++o) {
                const f32x8 v = unpack8(raw[o + k]);
                acc[o][0] += w0.x * v[0]; acc[o][1] += w0.y * v[1]; acc[o][2] += w0.z * v[2]; acc[o][3] += w0.w * v[3];
                acc[o][4] += w1.x * v[4]; acc[o][5] += w1.y * v[5]; acc[o][6] += w1.z * v[6]; acc[o][7] += w1.w * v[7];
            }
        }
#pragma unroll
        for (int o = 0; o < 4; ++o) {
            if (act) {
#pragma unroll
                for (int e = 0; e < 8; ++e) acc[o][e] = siluf(acc[o][e]);
            }
            *(u32x4*)(dst + (size_t)o * rs) = pack8(acc[o]);
        }
    }
}
struct PrepTile { int col0, ch0, t0, lo, hi, conv; const bf16_t* Pb; bf16_t* dst; };
__device__ __forceinline__ PrepTile prep_tile_decode(const Params& p, int item) {
    PrepTile T;
    const int t24 = item % 24, bc = item / 24, c = bc % NCH, b = bc / NCH;
    T.t0 = c * 128; T.Pb = WS_P(p) + (size_t)b * TPB * LDP; T.ch0 = 0; T.conv = t24 < 20;
    if (t24 < 16) { T.ch0 = t24 * 64; T.col0 = C_XBC + T.ch0; T.dst = WS_SXT(p) + ((size_t)((b * 18 + c) * 16 + t24)) * 8192; }
    else if (t24 < 20) { const int q = t24 - 16, g = q >> 1, nh = q & 1; T.ch0 = 1024 + g * 128 + nh * 64; T.col0 = C_XBC + T.ch0; T.dst = WS_SBT(p) + ((size_t)((b * 18 + c) * 2 + g)) * 16384 + (size_t)nh * 64 * 128; }
    else { const int q = t24 - 20, kh = q >> 1, dh = q & 1; T.col0 = C_V + kh * 128 + dh * 64; T.dst = WS_VT(p) + ((size_t)((b * 18 + c) * 2 + kh)) * 16384 + (size_t)dh * 64 * 128; }
    T.lo = T.t0 < 256 ? 0 : 256; T.hi = T.t0 < 256 ? 256 : TPB;
    return T;
}
__device__ __forceinline__ void prep_tile_load(const PrepTile& T, int tid, u32x4 (&raw)[2][4]) {
#pragma unroll
    for (int k = 0; k < 2; ++k) {
        const int idx = tid + k * 512, cgi = idx & 7, t = T.t0 + (idx >> 3);
#pragma unroll
        for (int q = 0; q < 4; ++q) {
            const int tt = T.conv ? t - 2 + q : t;
            const bool ok = T.conv ? (tt >= T.lo && tt < T.hi) : (q == 2);
            raw[k][q] = ok ? *(const u32x4*)(T.Pb + (size_t)tt * LDP + T.col0 + cgi * 8) : (u32x4){0u, 0u, 0u, 0u};
        }
    }
}
__device__ __forceinline__ void prep_tile_finish(const Params& p, int l, const PrepTile& T, int tid, const u32x4 (&raw)[2][4], unsigned char* shm) {
    bf16_t* sT = (bf16_t*)shm;
    const float* cw = p.ssd_conv_w + l * 6144 + T.ch0; const float* cb = p.ssd_conv_b + l * 1536 + T.ch0;
    lds_barrier();
#pragma unroll
    for (int k = 0; k < 2; ++k) {
        const int idx = tid + k * 512, cgi = idx & 7, tl = idx >> 3;
        f32x8 acc;
        if (T.conv) {
            const f32x4 b0 = *(const f32x4*)(cb + cgi * 8), b1 = *(const f32x4*)(cb + cgi * 8 + 4);
            acc[0] = b0.x; acc[1] = b0.y; acc[2] = b0.z; acc[3] = b0.w; acc[4] = b1.x; acc[5] = b1.y; acc[6] = b1.z; acc[7] = b1.w;
#pragma unroll
            for (int q = 0; q < 4; ++q) {
                const f32x8 v = unpack8(raw[k][q]);
                const f32x4 w0 = *(const f32x4*)(cw + q * 1536 + cgi * 8), w1 = *(const f32x4*)(cw + q * 1536 + cgi * 8 + 4);
                acc[0] += w0.x * v[0]; acc[1] += w0.y * v[1]; acc[2] += w0.z * v[2]; acc[3] += w0.w * v[3];
                acc[4] += w1.x * v[4]; acc[5] += w1.y * v[5]; acc[6] += w1.z * v[6]; acc[7] += w1.w * v[7];
            }
#pragma unroll
            for (int e = 0; e < 8; ++e) acc[e] = siluf(acc[e]);
        } else acc = unpack8(raw[k][2]);
#pragma unroll
        for (int e = 0; e < 8; ++e) sT[(cgi * 8 + e) * 130 + tl] = f2bf(acc[e]);
    }
    lds_barrier();
#pragma unroll
    for (int k = 0; k < 2; ++k) {
        const int idx = tid + k * 512, r = idx >> 4, ck = idx & 15;
        const unsigned* sp = (const unsigned*)(sT + r * 130 + ck * 8);
        u32x4 o; o.x = sp[0]; o.y = sp[1]; o.z = sp[2]; o.w = sp[3];
        *(u32x4*)(T.dst + r * 128 + ck * 8) = o;
    }
}
__device__ __forceinline__ void prep_tiles(const Params& p, int l, int bid, int G, unsigned char* shm) {
    const int tid = tidx();
    if (bid >= 3456) return;
    u32x4 raw[2][4], nraw[2][4];
    { const PrepTile T0 = prep_tile_decode(p, bid); prep_tile_load(T0, tid, raw); }
#pragma unroll 1
    for (int it = bid; it < 3456; it += G) {
        const bool more = it + G < 3456;
        if (more) { const PrepTile Tn = prep_tile_decode(p, it + G); prep_tile_load(Tn, tid, nraw); }
        { const PrepTile T = prep_tile_decode(p, it); prep_tile_finish(p, l, T, tid, raw, shm); }
        if (more) {
#pragma unroll
            for (int k = 0; k < 2; ++k)
#pragma unroll
                for (int q = 0; q < 4; ++q) raw[k][q] = nraw[k][q];
        }
    }
}
__device__ __forceinline__ void prep_dt_item(const Params& p, int l, int item) {
    const int tid = tidx();
    const int c = item % NCH, b = item / NCH;
    const int col32 = tid >> 4, h = col32 >> 1, d = col32 & 1, lane16 = tid & 15, seg = d == 0 ? lane16 : 15 - lane16;
    const float A = -__expf(p.ssd_A_log[(l * 2 + d) * 16 + h]), bias = p.ssd_dt_bias[(l * 2 + d) * 16 + h];
    const float* src = WS_DTP(p) + ((size_t)b * TPB + c * 128) * 16 + h;
    float dtv[8], cs[8], run = 0.f;
    float rawv[8];
#pragma unroll
    for (int q = 0; q < 8; ++q) { const int j = seg * 8 + (d == 0 ? q : 7 - q); rawv[q] = src[j * 16]; }
#pragma unroll
    for (int q = 0; q < 8; ++q) { dtv[q] = softplusf(rawv[q] + bias); run += dtv[q] * A; cs[q] = run; }
    float incl = run;
#pragma unroll
    for (int off = 1; off < 16; off <<= 1) { const float v = __shfl_up(incl, off, 16); if (lane16 >= off) incl += v; }
    const float excl = incl - run;
    float* dta = WS_DTA(p) + ((size_t)(b * 18 + c) * 128) * 32 + col32;
    float* acs = WS_ACS(p) + ((size_t)(b * 18 + c) * 128) * 32 + col32;
#pragma unroll
    for (int q = 0; q < 8; ++q) { const int j = seg * 8 + (d == 0 ? q : 7 - q); dta[j * 32] = dtv[q]; acs[j * 32] = cs[q] + excl; }
    if (lane16 == 15) WS_AL(p)[((b * 2 + d) * 18 + c) * 16 + h] = incl;
}
__device__ __forceinline__ void ssd_states_item(const Params& p, int l, int item, unsigned char* shm) {
    const int tid = tidx(), lane = tid & 63, wave = tid >> 6;
    const int g = item & 1, hh0 = ((item >> 1) & 1) * 4, bc = item >> 2, c = bc % NCH, b = bc / NCH;
    bf16_t* sBT = (bf16_t*)shm; bf16_t* sXw = (bf16_t*)(shm + 34816);
    float* sDt = (float*)(shm + 69632); float* sAcs = (float*)(shm + 77824); bf16_t* sO = (bf16_t*)(shm + 86016); float* sWg = (float*)(shm + 120832);
    const bf16_t* xt = WS_SXT(p) + ((size_t)((b * 18 + c) * 16 + g * 8)) * 8192;
    const bf16_t* btp = WS_SBT(p) + ((size_t)((b * 18 + c) * 2 + g)) * 16384;
    lds_barrier();
    {
        const size_t o = ((size_t)(b * 18 + c) * 128 + (tid >> 2)) * 32 + g * 16 + (tid & 3) * 4;
        const f32x4 vdt = *(const f32x4*)(WS_DTA(p) + o), vac = *(const f32x4*)(WS_ACS(p) + o);
        u32x4 bt[4];
#pragma unroll
        for (int k = 0; k < 4; ++k) { const int idx = tid + k * 512; bt[k] = *(const u32x4*)(btp + (idx >> 4) * 128 + (idx & 15) * 8); }
        *(f32x4*)(sDt + (tid >> 2) * 16 + (tid & 3) * 4) = vdt; *(f32x4*)(sAcs + (tid >> 2) * 16 + (tid & 3) * 4) = vac;
#pragma unroll
        for (int k = 0; k < 4; ++k) { const int idx = tid + k * 512; *(u32x4*)(sBT + (idx >> 4) * 136 + (idx & 15) * 8) = bt[k]; }
    }
    u32x4 xr[2];
#pragma unroll
    for (int k = 0; k < 2; ++k) { const int idx = tid + k * 512; xr[k] = *(const u32x4*)(xt + (size_t)hh0 * 8192 + (idx >> 4) * 128 + (idx & 15) * 8); }
    lds_barrier();
#pragma unroll
    for (int k = 0; k < 4; ++k) { const int idx = tid + k * 512, jj = idx >> 4, col = idx & 15; const float al = (col & 1) == 0 ? sAcs[127 * 16 + col] : sAcs[col]; sWg[col * 128 + jj] = __expf(al - sAcs[jj * 16 + col]) * sDt[jj * 16 + col]; }
#pragma unroll 1
    for (int hh = hh0; hh < hh0 + 4; ++hh) {
        const int h = g * 8 + hh;
        u32x4 xn[2] = {xr[0], xr[1]};
        if (hh < hh0 + 3) {
#pragma unroll
            for (int k = 0; k < 2; ++k) { const int idx = tid + k * 512; xn[k] = *(const u32x4*)(xt + (size_t)(hh + 1) * 8192 + (idx >> 4) * 128 + (idx & 15) * 8); }
        }
        lds_barrier();
#pragma unroll
        for (int k = 0; k < 2; ++k) {
            const int idx = tid + k * 512, pp = idx >> 4, j8 = (idx & 15) * 8;
            const f32x8 xv = unpack8(xr[k]);
#pragma unroll
            for (int d = 0; d < 2; ++d) {
                const f32x4 w0 = *(const f32x4*)(sWg + (hh * 2 + d) * 128 + j8), w1 = *(const f32x4*)(sWg + (hh * 2 + d) * 128 + j8 + 4);
                f32x8 o;
                o[0] = xv[0] * w0.x; o[1] = xv[1] * w0.y; o[2] = xv[2] * w0.z; o[3] = xv[3] * w0.w; o[4] = xv[4] * w1.x; o[5] = xv[5] * w1.y; o[6] = xv[6] * w1.z; o[7] = xv[7] * w1.w;
                *(u32x4*)(sXw + d * 8704 + pp * 136 + j8) = pack8(o);
            }
        }
        lds_barrier();
        const int mi = wave & 1, nj = wave >> 1;
#pragma unroll
        for (int d = 0; d < 2; ++d) {
            f32x16 acc;
#pragma unroll
            for (int r = 0; r < 16; ++r) acc[r] = 0.f;
            mm32<128>(acc, sXw + d * 8704 + mi * 32 * 136, 136, sBT + nj * 32 * 136, 136, lane);
#pragma unroll
            for (int r = 0; r < 16; ++r) sO[d * 8704 + (mi * 32 + rowmap32(r, lane)) * 136 + nj * 32 + (lane & 31)] = f2bf(acc[r]);
        }
        lds_barrier();
#pragma unroll
        for (int d = 0; d < 2; ++d) {
            bf16_t* base = WS_ST(p) + ((size_t)((b * 2 + d) * 18 + c) * 16 + h) * 8192;
#pragma unroll
            for (int k = 0; k < 2; ++k) { const int idx = tid + k * 512; *(u32x4*)(base + idx * 8) = *(const u32x4*)(sO + d * 8704 + (idx >> 4) * 136 + (idx & 15) * 8); }
        }
        xr[0] = xn[0]; xr[1] = xn[1];
    }
}
__device__ __forceinline__ void ssd_recur_item(const Params& p, int item) {
    const int tid = tidx();
    const int d = item & 1, h = (item >> 1) & 15, b = item >> 5;
    u32x4 s0[NCH], s1[NCH]; float ev[NCH];
#pragma unroll
    for (int pos = 0; pos < NCH; ++pos) {
        const int c = chunk_at(d, pos);
        const bf16_t* ptr = WS_ST(p) + ((size_t)((b * 2 + d) * 18 + c) * 16 + h) * 8192 + tid * 16;
        s0[pos] = *(const u32x4*)ptr; s1[pos] = *(const u32x4*)(ptr + 8);
        ev[pos] = WS_AL(p)[((b * 2 + d) * 18 + c) * 16 + h];
    }
    f32x8 h0, h1;
#pragma unroll
    for (int e = 0; e < 8; ++e) { h0[e] = 0.f; h1[e] = 0.f; }
#pragma unroll
    for (int pos = 0; pos < NCH; ++pos) {
        const int c = chunk_at(d, pos);
        bf16_t* ptr = WS_ST(p) + ((size_t)((b * 2 + d) * 18 + c) * 16 + h) * 8192 + tid * 16;
        *(u32x4*)ptr = pack8(h0); *(u32x4*)(ptr + 8) = pack8(h1);
        const float e = __expf(ev[pos]);
        h0 = h0 * e + unpack8(s0[pos]); h1 = h1 * e + unpack8(s1[pos]);
    }
}
template <int MODE>
__device__ __forceinline__ void ssd_final_item(const Params& p, int l, int item, unsigned char* shm) {
    const int tid = tidx(), lane = tid & 63, wave = tid >> 6;
    const int g = item & 1, hh0 = ((item >> 1) & 1) * 4, bc = item >> 2, c = bc % NCH, b = bc / NCH, t0 = c * 128;
    const size_t tok0 = (size_t)b * TPB + t0;
    bf16_t* sC = (bf16_t*)shm; bf16_t* sBW = (bf16_t*)(shm + 34816); bf16_t* sXT = (bf16_t*)(shm + 69632); bf16_t* sH = (bf16_t*)(shm + 87040);
    float* sDt = (float*)(shm + 104448); float* sAcs = (float*)(shm + 112640);
    bf16_t* sY = sBW;
    const bf16_t* xt = WS_SXT(p) + ((size_t)((b * 18 + c) * 16 + g * 8)) * 8192;
    const bf16_t* zt = WS_P(p) + tok0 * LDP + C_Z + g * 512;
    const bf16_t* hin0 = WS_ST(p) + ((size_t)((b * 2 + 0) * 18 + c) * 16 + g * 8) * 8192;
    const bf16_t* hin1 = WS_ST(p) + ((size_t)((b * 2 + 1) * 18 + c) * 16 + g * 8) * 8192;
    lds_barrier();
    u32x4 xr[2], zr[2], h0r[2];
    {
        const size_t o = ((size_t)(b * 18 + c) * 128 + (tid >> 2)) * 32 + g * 16 + (tid & 3) * 4;
        const f32x4 vdt = *(const f32x4*)(WS_DTA(p) + o), vac = *(const f32x4*)(WS_ACS(p) + o);
        u32x4 cr[4], br[4];
#pragma unroll
        for (int k = 0; k < 4; ++k) { const int idx = tid + k * 512; const bf16_t* s = WS_SBC(p) + (tok0 + (idx >> 4)) * 512 + g * 128 + (idx & 15) * 8; br[k] = *(const u32x4*)s; cr[k] = *(const u32x4*)(s + 256); }
#pragma unroll
        for (int k = 0; k < 2; ++k) {
            const int idx = tid + k * 512;
            xr[k] = *(const u32x4*)(xt + (size_t)hh0 * 8192 + (idx >> 4) * 128 + (idx & 15) * 8);
            zr[k] = *(const u32x4*)(zt + (size_t)(idx >> 3) * LDP + hh0 * 64 + (idx & 7) * 8);
            h0r[k] = *(const u32x4*)(hin0 + (size_t)hh0 * 8192 + idx * 8);
        }
        *(f32x4*)(sDt + (tid >> 2) * 16 + (tid & 3) * 4) = vdt; *(f32x4*)(sAcs + (tid >> 2) * 16 + (tid & 3) * 4) = vac;
#pragma unroll
        for (int k = 0; k < 4; ++k) { const int idx = tid + k * 512; *(u32x4*)(sC + (idx >> 4) * 136 + (idx & 15) * 8) = cr[k]; *(u32x4*)(sBW + (idx >> 4) * 136 + (idx & 15) * 8) = br[k]; }
    }
    lds_barrier();
    const int cmi = wave >> 1, cnj0 = (wave & 1) * 2;
    f32x16 cb0, cb1;
#pragma unroll
    for (int r = 0; r < 16; ++r) { cb0[r] = 0.f; cb1[r] = 0.f; }
    mm32<128>(cb0, sC + cmi * 32 * 136, 136, sBW + cnj0 * 32 * 136, 136, lane);
    mm32<128>(cb1, sC + cmi * 32 * 136, 136, sBW + (cnj0 + 1) * 32 * 136, 136, lane);
    const int ymi = wave & 3, ynj = wave >> 2;
#pragma unroll 1
    for (int hh = hh0; hh < hh0 + 4; ++hh) {
        const int h = g * 8 + hh;
        lds_barrier();
#pragma unroll
        for (int k = 0; k < 2; ++k) { const int idx = tid + k * 512; *(u32x4*)(sXT + (idx >> 4) * 136 + (idx & 15) * 8) = xr[k]; *(u32x4*)(sH + (idx >> 4) * 136 + (idx & 15) * 8) = h0r[k]; }
        u32x4 h1r[2];
#pragma unroll
        for (int k = 0; k < 2; ++k) h1r[k] = *(const u32x4*)(hin1 + (size_t)hh * 8192 + (tid + k * 512) * 8);
        f32x16 yacc;
#pragma unroll
        for (int r = 0; r < 16; ++r) yacc[r] = 0.f;
#pragma unroll 1
        for (int d = 0; d < 2; ++d) {
            const int col = hh * 2 + d;
            if (d == 1) {
                lds_barrier();
#pragma unroll
                for (int k = 0; k < 2; ++k) { const int idx = tid + k * 512; *(u32x4*)(sH + (idx >> 4) * 136 + (idx & 15) * 8) = h1r[k]; }
            }
            if (MODE < 2) {
                float aci[16];
#pragma unroll
                for (int r = 0; r < 16; ++r) aci[r] = sAcs[(cmi * 32 + rowmap32(r, lane)) * 16 + col];
#pragma unroll
                for (int tt = 0; tt < 2; ++tt) {
                    const int jg = (cnj0 + tt) * 32 + (lane & 31);
                    const float acj = sAcs[jg * 16 + col], dtj = sDt[jg * 16 + col];
                    const int dj0 = jg - cmi * 32 - 4 * (lane >> 5), dj = d == 0 ? dj0 : -dj0;
#pragma unroll
                    for (int r = 0; r < 16; ++r) {
                        const int ro = (r & 3) + 8 * (r >> 2);
                        const int sd = d == 0 ? dj - ro : dj + ro;
                        float arg = aci[r] - acj; arg = sd <= 0 ? arg : -INFINITY;
                        const float cbv = tt == 0 ? cb0[r] : cb1[r];
                        sBW[(cmi * 32 + rowmap32(r, lane)) * 136 + jg] = f2bf(cbv * __expf(arg) * dtj);
                    }
                }
            }
            lds_barrier();
            f32x16 ad, ao;
#pragma unroll
            for (int r = 0; r < 16; ++r) { ad[r] = 0.f; ao[r] = 0.f; }
            if (MODE < 3) { mm32<128>(ad, sBW + ymi * 32 * 136, 136, sXT + ynj * 32 * 136, 136, lane);
            mm32<128>(ao, sC + ymi * 32 * 136, 136, sH + ynj * 32 * 136, 136, lane); }
#pragma unroll
            for (int r = 0; r < 16; ++r) { const int ig = ymi * 32 + rowmap32(r, lane); yacc[r] += ad[r] + __expf(sAcs[ig * 16 + col]) * ao[r]; }
            if (d == 0 && hh < hh0 + 3) {
#pragma unroll
                for (int k = 0; k < 2; ++k) {
                    const int idx = tid + k * 512;
                    xr[k] = *(const u32x4*)(xt + (size_t)(hh + 1) * 8192 + (idx >> 4) * 128 + (idx & 15) * 8);
                    h0r[k] = *(const u32x4*)(hin0 + (size_t)(hh + 1) * 8192 + idx * 8);
                }
            }
        }
        const float Dh = p.ssd_D[l * 16 + h];
        const int pl = ynj * 32 + (lane & 31);
#pragma unroll
        for (int r = 0; r < 16; ++r) { const int ig = ymi * 32 + rowmap32(r, lane); yacc[r] += Dh * bf2f(sXT[pl * 136 + ig]); }
        lds_barrier();
#pragma unroll
        for (int r = 0; r < 16; ++r) { const int ig = ymi * 32 + rowmap32(r, lane); sY[ig * 72 + pl] = f2bf(yacc[r]); }
        lds_barrier();
#pragma unroll
        for (int k = 0; k < 2; ++k) {
            const int idx = tid + k * 512, rr = idx >> 3, pk = idx & 7;
            const f32x8 yv = unpack8(*(const u32x4*)(sY + rr * 72 + pk * 8)), zv = unpack8(zr[k]);
            f32x8 o;
#pragma unroll
            for (int e = 0; e < 8; ++e) o[e] = yv[e] * siluf(zv[e]);
            if (MODE < 1) *(u32x4*)(WS_MIX(p) + (tok0 + rr) * MIXW + 2048 + h * 64 + pk * 8) = pack8(o); else asm volatile("" :: "v"(o[0]), "v"(o[7]));
        }
        if (hh < hh0 + 3) {
#pragma unroll
            for (int k = 0; k < 2; ++k) { const int idx = tid + k * 512; zr[k] = *(const u32x4*)(zt + (size_t)(idx >> 3) * LDP + (hh + 1) * 64 + (idx & 7) * 8); }
        }
    }
}
__device__ __forceinline__ void ssd_norm_phase(const Params& p, int l, int G) {
    const int lane = tidx() & 63, wave = tidx() >> 6;
    for (int row = blockIdx.x * 8 + wave; row < NTOK; row += G * 8) {
        bf16_t* rp = WS_MIX(p) + (size_t)row * MIXW + 2048;
        f32x8 v0 = unpack8(*(const u32x4*)(rp + lane * 8)), v1 = unpack8(*(const u32x4*)(rp + 512 + lane * 8));
        float ss = 0.f;
#pragma unroll
        for (int e = 0; e < 8; ++e) ss += v0[e] * v0[e] + v1[e] * v1[e];
        ss = wave_sum(ss);
        const float rstd = rsqrtf(ss * (1.f / 1024.f) + 1e-6f);
        const float* nw = p.ssd_norm_w + l * 1024;
#pragma unroll
        for (int e = 0; e < 8; ++e) { v0[e] = v0[e] * rstd * nw[lane * 8 + e]; v1[e] = v1[e] * rstd * nw[512 + lane * 8 + e]; }
        *(u32x4*)(rp + lane * 8) = pack8(v0); *(u32x4*)(rp + 512 + lane * 8) = pack8(v1);
    }
}

template <int MODE>
__device__ __forceinline__ void attn_item(const Params& p, int l, int item, unsigned char* shm) {
    const int tid = tidx(), lane = tid & 63, wave = tid >> 6, fr = lane & 15, fq = lane >> 4;
    const int hp = item & 3, bq = item >> 2, qblk = bq % NCH, b = bq / NCH, kh = hp >> 1;
    const bf16_t* P = WS_P(p);
    bf16_t* sK = (bf16_t*)shm; bf16_t* sVT = (bf16_t*)(shm + 34816); bf16_t* sPw = (bf16_t*)(shm + 69632) + wave * (2 * 16 * 136);
    const size_t tokq0 = (size_t)b * TPB + qblk * 128;
    bf16x8 aq[2][4];
#pragma unroll
    for (int hd = 0; hd < 2; ++hd)
#pragma unroll
        for (int kk = 0; kk < 4; ++kk) aq[hd][kk] = *(const bf16x8*)(P + (tokq0 + wave * 16 + fr) * LDP + C_Q + (hp * 2 + hd) * 128 + kk * 32 + 8 * fq);
    float m[2][4], ls[2][4]; f32x4 O[2][8];
#pragma unroll
    for (int hd = 0; hd < 2; ++hd) {
        const float sink = p.att_sink[l * 8 + hp * 2 + hd];
#pragma unroll
        for (int r = 0; r < 4; ++r) { m[hd][r] = sink; ls[hd][r] = 1.f; }
#pragma unroll
        for (int nd = 0; nd < 8; ++nd) O[hd][nd] = (f32x4){0.f, 0.f, 0.f, 0.f};
    }
    const int nlat = qblk - 2;
    const int kb_lo = nlat - 1 < 0 ? 0 : nlat - 1, kb_hi = nlat + 1 > 15 ? 15 : nlat + 1;
    const int ntl = qblk < 2 ? 2 : 2 + (kb_hi - kb_lo + 1);
    u32x4 kr[4], vr[4];
    const bf16_t* vtb = WS_VT(p) + ((size_t)(b * 18) * 2 + kh) * 16384;
    {
        const bf16_t* kbase = P + ((size_t)b * TPB) * LDP + C_K + kh * 128;
#pragma unroll
        for (int k = 0; k < 4; ++k) { const int idx = tid + k * 512; kr[k] = *(const u32x4*)(kbase + (size_t)(idx >> 4) * LDP + (idx & 15) * 8); vr[k] = *(const u32x4*)(vtb + idx * 8); }
    }
#pragma unroll 1
    for (int ti = 0; ti < ntl; ++ti) {
        const bool masked = ti >= 2; const int kb = kb_lo + (ti - 2);
        lds_barrier();
#pragma unroll
        for (int k = 0; k < 4; ++k) {
            const int idx = tid + k * 512;
            *(u32x4*)(sK + (idx >> 4) * 136 + (idx & 15) * 8) = kr[k];
            *(u32x4*)(sVT + (idx >> 4) * 136 + (idx & 15) * 8) = vr[k];
        }
        if (ti + 1 < ntl) {
            const int tn = ti + 1, t0n = tn < 2 ? tn * 128 : 256 + (kb_lo + (tn - 2)) * 128;
            const bf16_t* kbase = P + ((size_t)b * TPB + t0n) * LDP + C_K + kh * 128;
            const bf16_t* vtn = vtb + (size_t)(t0n >> 7) * 32768;
#pragma unroll
            for (int k = 0; k < 4; ++k) { const int idx = tid + k * 512; kr[k] = *(const u32x4*)(kbase + (size_t)(idx >> 4) * LDP + (idx & 15) * 8); vr[k] = *(const u32x4*)(vtn + idx * 8); }
        }
        lds_barrier();
#pragma unroll 1
        for (int hf = 0; hf < 2; ++hf) {
            f32x4 s[2][4];
#pragma unroll
            for (int nt = 0; nt < 4; ++nt) {
                s[0][nt] = (f32x4){0.f, 0.f, 0.f, 0.f}; s[1][nt] = (f32x4){0.f, 0.f, 0.f, 0.f};
#pragma unroll
                for (int kk = 0; kk < 4; ++kk) {
                    const bf16x8 bk = *(const bf16x8*)(sK + ((hf * 4 + nt) * 16 + fr) * 136 + kk * 32 + 8 * fq);
                    s[0][nt] = __builtin_amdgcn_mfma_f32_16x16x32_bf16(aq[0][kk], bk, s[0][nt], 0, 0, 0);
                    s[1][nt] = __builtin_amdgcn_mfma_f32_16x16x32_bf16(aq[1][kk], bk, s[1][nt], 0, 0, 0);
                }
                __builtin_amdgcn_sched_barrier(0);
            }
            if (masked) {
#pragma unroll
                for (int nt = 0; nt < 4; ++nt)
#pragma unroll
                    for (int r = 0; r < 4; ++r) { const int rel = (nlat * 128 + wave * 16 + fq * 4 + r) - (kb * 128 + (hf * 4 + nt) * 16 + fr); if (rel > 128 || rel < -128) { s[0][nt][r] = -INFINITY; s[1][nt][r] = -INFINITY; } }
            }
#pragma unroll
            for (int hd = 0; hd < 2; ++hd) {
                float alpha[4];
#pragma unroll
                for (int r = 0; r < 4; ++r) {
                    float mx = fmaxf(fmaxf(s[hd][0][r], s[hd][1][r]), fmaxf(s[hd][2][r], s[hd][3][r]));
                    mx = row16_max(mx);
                    const float mn = fmaxf(m[hd][r], mx);
                    alpha[r] = __expf(m[hd][r] - mn); m[hd][r] = mn;
                    float rs = 0.f;
#pragma unroll
                    for (int nt = 0; nt < 4; ++nt) { const float pv = __expf(s[hd][nt][r] - mn); s[hd][nt][r] = pv; rs += pv; }
                    rs = row16_sum(rs);
                    ls[hd][r] = ls[hd][r] * alpha[r] + rs;
                }
#pragma unroll
                for (int nd = 0; nd < 8; ++nd) { O[hd][nd].x *= alpha[0]; O[hd][nd].y *= alpha[1]; O[hd][nd].z *= alpha[2]; O[hd][nd].w *= alpha[3]; }
#pragma unroll
                for (int nt = 0; nt < 4; ++nt)
#pragma unroll
                    for (int r = 0; r < 4; ++r) sPw[hd * (16 * 136) + (fq * 4 + r) * 136 + nt * 16 + fr] = f2bf(s[hd][nt][r]);
            }
            asm volatile("s_waitcnt lgkmcnt(0)" ::: "memory");
#pragma unroll
            for (int kk = 0; kk < 2; ++kk) {
                const bf16x8 ap0 = *(const bf16x8*)(sPw + fr * 136 + kk * 32 + 8 * fq);
                const bf16x8 ap1 = *(const bf16x8*)(sPw + 16 * 136 + fr * 136 + kk * 32 + 8 * fq);
#pragma unroll
                for (int nd = 0; nd < 8; ++nd) {
                    const bf16x8 bv = *(const bf16x8*)(sVT + (nd * 16 + fr) * 136 + hf * 64 + kk * 32 + 8 * fq);
                    O[0][nd] = __builtin_amdgcn_mfma_f32_16x16x32_bf16(ap0, bv, O[0][nd], 0, 0, 0);
                    O[1][nd] = __builtin_amdgcn_mfma_f32_16x16x32_bf16(ap1, bv, O[1][nd], 0, 0, 0);
                    if (nd == 3) __builtin_amdgcn_sched_barrier(0);
                }
                __builtin_amdgcn_sched_barrier(0);
            }
            asm volatile("s_waitcnt lgkmcnt(0)" ::: "memory");
        }
    }
#pragma unroll
    for (int hd = 0; hd < 2; ++hd) {
        const int hq = hp * 2 + hd;
        u32x4 agr[4];
#pragma unroll
        for (int k = 0; k < 4; ++k) { const int idx = tid + k * 512; agr[k] = *(const u32x4*)(P + (tokq0 + (idx >> 4)) * LDP + C_AG + hq * 128 + (idx & 15) * 8); }
        lds_barrier();
#pragma unroll
        for (int r = 0; r < 4; ++r) {
            const float il = __builtin_amdgcn_rcpf(ls[hd][r]);
#pragma unroll
            for (int nd = 0; nd < 8; ++nd) sK[(wave * 16 + fq * 4 + r) * 136 + nd * 16 + fr] = f2bf(O[hd][nd][r] * il);
        }
        lds_barrier();
#pragma unroll
        for (int k = 0; k < 4; ++k) {
            const int idx = tid + k * 512, rr = idx >> 4, ck = idx & 15;
            const f32x8 ov = unpack8(*(const u32x4*)(sK + rr * 136 + ck * 8)), gv = unpack8(agr[k]);
            f32x8 o;
#pragma unroll
            for (int e = 0; e < 8; ++e) o[e] = ov[e] * siluf(gv[e]);
            *(u32x4*)(WS_MIX(p) + (tokq0 + rr) * MIXW + 1024 + hq * 128 + ck * 8) = pack8(o);
        }
    }
}

#define XB_TMO      128
#define XB_XCNT(j)  (256  + 64 * (j))
#define XB_XSUB(j)  (1280 + 64 * (j))
#define XB_XGEN(j)  (2304 + 64 * (j))
#define XB_TOP      3328
#define XB_TOPGEN   3392
#define XCD_BAR_WORDS 3456
#define XB_SPIN_CAP (1u << 18)
#define LAS __attribute__((address_space(3)))
__device__ __forceinline__ unsigned xb_ld(unsigned* p)              { return __hip_atomic_load(p, __ATOMIC_RELAXED, __HIP_MEMORY_SCOPE_AGENT); }
__device__ __forceinline__ unsigned xb_add(unsigned* p, unsigned v) { return __hip_atomic_fetch_add(p, v, __ATOMIC_RELAXED, __HIP_MEMORY_SCOPE_AGENT); }
__device__ __forceinline__ unsigned xb_xcc_id() { return (unsigned)__builtin_amdgcn_s_getreg((3 << 11) | 20) & 0xFu; }
#define XB_SPIN(cond, bar) do { unsigned _sp = 0; while (cond) { __builtin_amdgcn_s_sleep(1); \
    if ((++_sp & 255u) == 0u) { if (xb_ld(&(bar)[XB_TMO])) break; if (_sp > XB_SPIN_CAP) { atomicAdd(&(bar)[XB_TMO], 1u); break; } } } } while (0)
struct XcdBarrier { unsigned* bar; unsigned x; volatile LAS unsigned* st; };
__device__ __forceinline__ XcdBarrier xcd_barrier_post(unsigned* bar, volatile LAS unsigned* st) {
    XcdBarrier b; b.bar = bar; b.x = xb_xcc_id(); b.st = st;
    if (tidx() == 0) (void)xb_add(&bar[XB_XCNT(b.x)], 1u);
    return b;
}
__device__ __forceinline__ void xcd_barrier_complete(unsigned* bar, unsigned x, unsigned& nloc, unsigned& nx) {
    const unsigned G = gridDim.x * gridDim.y * gridDim.z;
    unsigned sum, cnt, mine, sp = 0u;
    for (;;) {
        sum = 0u; cnt = 0u; mine = 0u;
#pragma unroll
        for (unsigned j = 0; j < 16; ++j) { const unsigned c = xb_ld(&bar[XB_XCNT(j)]); sum += c; cnt += (c > 0u) ? 1u : 0u; mine = (j == x) ? c : mine; }
        if (sum == G) break;
        __builtin_amdgcn_s_sleep(1);
        if ((++sp & 255u) == 0u) { if (xb_ld(&bar[XB_TMO])) break; if (sp > XB_SPIN_CAP) { atomicAdd(&bar[XB_TMO], 1u); break; } }
    }
    nloc = mine > 0u ? mine : 1u; nx = cnt > 0u ? cnt : 1u;
}
__device__ __forceinline__ void xcd_barrier(const XcdBarrier& b) {
    asm volatile("s_waitcnt vmcnt(0)" ::: "memory");
    __syncthreads();
    if (tidx() == 0) {
        unsigned* bar = b.bar;
        __builtin_amdgcn_s_waitcnt(0);
        unsigned nloc = b.st[0], nx = b.st[1];
        if (nloc == 0u) { xcd_barrier_complete(bar, b.x, nloc, nx); b.st[0] = nloc; b.st[1] = nx; }
        const unsigned old = xb_add(&bar[XB_XSUB(b.x)], 1u);
        const unsigned gen = old / nloc;
        if (old + 1u == (gen + 1u) * nloc) {
            __builtin_amdgcn_fence(__ATOMIC_RELEASE, "agent");
            asm volatile("s_waitcnt vmcnt(0)" ::: "memory");
            const unsigned og = xb_add(&bar[XB_TOP], 1u);
            const unsigned tg = og / nx;
            if (og + 1u == (tg + 1u) * nx) xb_add(&bar[XB_TOPGEN], 1u);
            else XB_SPIN(xb_ld(&bar[XB_TOPGEN]) == tg, bar);
            __builtin_amdgcn_fence(__ATOMIC_ACQUIRE, "agent");
            xb_add(&bar[XB_XGEN(b.x)], 1u);
            asm volatile("s_waitcnt vmcnt(0)" ::: "memory");
        } else {
            XB_SPIN(xb_ld(&bar[XB_XGEN(b.x)]) == gen, bar);
            __builtin_amdgcn_fence(__ATOMIC_ACQUIRE, "agent");
            asm volatile("s_waitcnt vmcnt(0)" ::: "memory");
        }
    }
    __syncthreads();
}


#define QUEUE_LOOP(ctr, NITEMS, BODY) do { \
    volatile LAS unsigned* _mb = (volatile LAS unsigned*)(shm + LDS_CTL + 8); \
    int it = bid; \
    while (it < (NITEMS)) { \
        unsigned _nx = 0u; if (tidx() == 0) _nx = xb_add((ctr), 1u) + (unsigned)G; \
        BODY; \
        __syncthreads(); \
        if (tidx() == 0) _mb[0] = _nx; \
        __syncthreads(); \
        it = (int)_mb[0]; \
    } } while (0)

__global__ __launch_bounds__(512) void mega(Params p) {
    extern __shared__ __attribute__((aligned(16))) unsigned char shm[];
    cg::grid_group grid = cg::this_grid();
    const int G = (int)gridDim.x, bid = (int)blockIdx.x;
    if (tidx() < 4) ((volatile LAS unsigned*)(shm + LDS_CTL))[tidx()] = 0u;
    __syncthreads();
    unsigned* qctr = (unsigned*)(p.ws + OFF_BAR) + 3584;
    const XcdBarrier xb = xcd_barrier_post((unsigned*)(p.ws + OFF_BAR), (volatile LAS unsigned*)(shm + LDS_CTL));
    for (int rep = 0; rep < 1 + DUP_P0; ++rep) phase0(p, shm, G);
    grid.sync();
#pragma unroll 1
    for (int l = 0; l < 4; ++l) {
        for (int rep = 0; rep < 1 + DUP_NORM; ++rep) norm_phase(p, l, G);
        xcd_barrier(xb);
        {
            pg8::Gemm g{WS_U(p), WS_WTIN(p) + (size_t)l * 7424 * 2048, NTOK, 7168, 2048};
            pg8::Order S; S.init(72, 28, G, bid, 0);
            EpiG1 E{WS_P(p)};
            for (int rep = 0; rep < 1 + DUP_G1; ++rep) pg8::gemm_phase<EpiG1, pg8::Order>((PG8_LAS unsigned char*)shm, g, S, E);
            {
                const int tq = tidx(), wave = tq >> 6, lane = tq & 63, fr = lane & 15, fq = lane >> 4;
                for (int wu = bid * 8 + wave; wu < NTOK / 16; wu += G * 8) {
                    const bf16_t* ap = WS_U(p) + (size_t)(wu * 16 + fr) * 2048 + 8 * fq;
                    const bf16_t* bp = WS_WTIN(p) + ((size_t)l * 7424 + 7168 + fr) * 2048 + 8 * fq;
                    f32x4 acc = (f32x4){0.f, 0.f, 0.f, 0.f};
#pragma unroll 8
                    for (int kk = 0; kk < 64; ++kk) { const bf16x8 a = *(const bf16x8*)(ap + kk * 32), bq = *(const bf16x8*)(bp + kk * 32); acc = __builtin_amdgcn_mfma_f32_16x16x32_bf16(a, bq, acc, 0, 0, 0); }
#pragma unroll
                    for (int r = 0; r < 4; ++r) WS_DTP(p)[(size_t)(wu * 16 + fq * 4 + r) * 16 + fr] = acc[r];
                }
            }
        }
        for (int rep = 0; rep < 1 + DUP_SYNC; ++rep) xcd_barrier(xb);
        for (int rep = 0; rep < 1 + DUP_E1; ++rep) {
            if (rep == 0 || E1SEL == 0 || E1SEL == 1) for (int it = bid; it < 144; it += G) prep_dt_item(p, l, it);
            if (rep == 0 || E1SEL == 0 || E1SEL == 2) { __syncthreads(); prep_tiles(p, l, bid, G, shm); }
            if (rep == 0 || E1SEL == 0 || E1SEL == 3) prep_elem(p, l, G);
        }
        { const int tq = tidx(), wave = tq >> 6, lane = tq & 63; for (int row = bid * 8 + wave; row < NTOK; row += G * 8) qkprep_row<0>(p, l, row, lane);
#if DUP_QK
          for (int row = bid * 8 + wave; row < NTOK; row += G * 8) qkprep_row<1>(p, l, row, lane);
#endif
        }
        xcd_barrier(xb);
        QUEUE_LOOP(qctr + (l * 3 + 0) * 64, 128 + 576, { if (it < 128) lru_sweep_item<0>(p, l, it, shm); else ssd_states_item(p, l, it - 128, shm); });
#if DUP_X1Q
        __syncthreads(); QUEUE_LOOP(qctr + (12 + l * 3 + 0) * 64, 128 + 576, { if (it < 128) lru_sweep_item<0>(p, l, it, shm); else ssd_states_item(p, l, it - 128, shm); });
#endif
#if DUP_SWEEP
        __syncthreads(); for (int it = bid; it < 128; it += G) lru_sweep_item<0>(p, l, it, shm);
#endif
#if DUP_STATES
        __syncthreads(); for (int it = bid; it < 256; it += G) ssd_states_item(p, l, it, shm);
#endif
        xcd_barrier(xb);
        QUEUE_LOOP(qctr + (l * 3 + 1) * 64, 256 + 576, { if (it < 256) ssd_recur_item(p, it); else attn_item<0>(p, l, it - 256, shm); });
#if DUP_ATTQ
        __syncthreads(); QUEUE_LOOP(qctr + (12 + l * 3 + 1) * 64, 576, { attn_item<AMODE>(p, l, it, shm); });
#endif
        xcd_barrier(xb);
        QUEUE_LOOP(qctr + (l * 3 + 2) * 64, 128 + 576, { if (it < 128) lru_sweep_item<1>(p, l, it, shm); else ssd_final_item<0>(p, l, it - 128, shm); });
#if DUP_FINAL
        __syncthreads(); for (int it = bid; it < 256; it += G) ssd_final_item<FMODE>(p, l, it, shm);
#endif
#if DUP_SWEEP1
        __syncthreads(); for (int it = bid; it < 128; it += G) lru_sweep_item<1, 1>(p, l, it, shm);
#endif
        xcd_barrier(xb);
#ifndef SK_X4
        ssd_norm_phase(p, l, G);
#endif
        xcd_barrier(xb);
        {
            pg8::Gemm g{WS_MIX(p), WS_WTOUT(p) + (size_t)l * 2048 * 3072, NTOK, 2048, 3072};
            pg8::Order S; S.init(l == 3 ? 64 : 72, 8, G, bid, l == 3 ? 1 : 0);
            EpiG2 E{p, l, 0};
#if DUP_G2
            { EpiG2 E2{p, l, 1}; pg8::gemm_phase<EpiG2, pg8::Order>((PG8_LAS unsigned char*)shm, g, S, E2); }
#endif
#ifndef SK_G2
            pg8::gemm_phase<EpiG2, pg8::Order>((PG8_LAS unsigned char*)shm, g, S, E);
#endif
        }
        if (l < 3) xcd_barrier(xb);
    }
}

extern "C" void kernel_launch(void* const* d_in, const int* in_sizes, int n_in, void* d_out, int out_size, void* d_ws, size_t ws_size, hipStream_t stream) {
    static int grid = 0;
    if (grid == 0) {
        if (n_in != 25 || ws_size < WS_END) { fprintf(stderr, "kernel_launch: need 25 inputs and %zu bytes of workspace (got %d, %zu)\n", (size_t)WS_END, n_in, ws_size); grid = -1; return; }
        int dev = 0, cus = 0, per_cu = 0;
        hipGetDevice(&dev);
        hipDeviceGetAttribute(&cus, hipDeviceAttributeMultiprocessorCount, dev);
        if (hipFuncSetAttribute((const void*)mega, hipFuncAttributeMaxDynamicSharedMemorySize, LDS_BYTES) != hipSuccess) { fprintf(stderr, "kernel_launch: hipFuncSetAttribute failed\n"); grid = -1; return; }
        if (hipOccupancyMaxActiveBlocksPerMultiprocessor(&per_cu, (const void*)mega, 512, LDS_BYTES) != hipSuccess || per_cu < 1) { fprintf(stderr, "kernel_launch: occupancy query gave %d\n", per_cu); per_cu = 1; }
        (void)hipGetLastError();
        grid = cus * 1;
        if (grid <= 0) grid = 256;
    }
    if (grid < 0) return;
    Params p{};
    const float** pf = (const float**)&p;
    for (int i = 0; i < 25; ++i) pf[i] = (const float*)d_in[i];
    p.out = (float*)d_out; p.ws = (unsigned char*)d_ws;
    if (hipMemsetAsync((char*)d_ws + OFF_BAR, 0, 32768, stream) != hipSuccess) { fprintf(stderr, "kernel_launch: memset of barrier words failed\n"); return; }
    void* args[] = {&p};
    hipError_t e = hipLaunchCooperativeKernel((const void*)mega, dim3(grid), dim3(512), args, LDS_BYTES, stream);
    if (e != hipSuccess) fprintf(stderr, "cooperative launch failed: %s (grid %d)\n", hipGetErrorString(e), grid);
}
```

```cpp
#include <hip/hip_runtime.h>
#include <hip/hip_cooperative_groups.h>
#include <cstdio>
#include <cstdint>
namespace cg = cooperative_groups;
#define DUP_X1A 0
#define DUP_X1B 0
#define DUP_ATT 0
#define DUP_X3A 0
#define DUP_X3B 0
#define DUP_G1 0
#define DUP_P0 0
#define DUP_NORM 0
#define DUP_SYNC 0
#define DUP_E1 0
#define DUP_SWEEP1 0
#define DUP_G2 0
#define DUP_QK 0
#define E1SEL 0
#define DUP_SWEEP 0
#define DUP_STATES 0
#define DUP_FINAL 0
#define AMODE 0
#define FMODE 0
#define DUP_X1Q 0
#define DUP_ATTQ 0
#define DUP_X3Q 0

__device__ __forceinline__ int tidx() { int t = (int)threadIdx.x; asm volatile("" : "+v"(t)); return t; }

namespace pg8 {
#define PG8_LAS __attribute__((address_space(3)))
typedef unsigned short bf16_t;
typedef short bf16x8 __attribute__((ext_vector_type(8)));
typedef float f32x4 __attribute__((ext_vector_type(4)));
typedef unsigned u32x4 __attribute__((ext_vector_type(4)));
constexpr int BM = 256, BK = 64, HALF = 128, HTB = HALF * BK * 2  , STAGE_BYTES = 8 * HTB, NXCD = 8, WGM = 8;

__host__ __device__ __forceinline__ int lds_byte(int r, int c) { const int st = (r >> 4) * 2 + (c >> 5), rr = r & 15, cc = c & 31, ob = rr * 64 + cc * 2; return st * 1024 + (ob ^ (((ob >> 9) & 1) << 5)); }
__host__ __device__ __forceinline__ void stage_rc(int b, int& R, int& C) { const int st = b / 1024, sb = b % 1024, swz = sb ^ (((sb >> 9) & 1) << 5); R = (st >> 1) * 16 + swz / 64; C = (st & 1) * 32 + (swz % 64) / 2; }
__host__ __device__ __forceinline__ int perm32(int rho) { const int n = rho >> 4, i = rho & 15; return 8 * (i >> 2) + 4 * n + (i & 3); }

struct Unit { int pm, pn; };
struct Gemm { const bf16_t* A; const bf16_t* Bt; int M, N, K; };

struct Order {
    int nM, nN, nwg, G, c, skipctx;
    __device__ void init(int nM_, int nN_, int G_, int c_, int skip_) { nM = nM_; nN = nN_; nwg = nM * nN; G = G_; c = c_; skipctx = skip_; }
    __device__ bool next(int i, Unit& u) const {
        const long L = (long)i * G + c; if (L >= nwg) return false;
        int wgid = (int)L; { const int q = nwg / NXCD, r = nwg % NXCD, xcd = wgid % NXCD, off = wgid / NXCD; wgid = (xcd < r ? xcd * (q + 1) : r * (q + 1) + (xcd - r) * q) + off; }
        const int nig = WGM * nN, gid = wgid / nig, fm = gid * WGM, gsz = (nM - fm) < WGM ? (nM - fm) : WGM;
        int pm = fm + ((wgid % nig) % gsz); u.pn = (wgid % nig) / gsz;
        if (skipctx) pm = (pm >> 3) * 9 + 1 + (pm & 7);
        u.pm = pm; return true;
    }
    __device__ __forceinline__ void a_ready(const Unit&) const {}
    __device__ __forceinline__ void done(const Unit&) const {}
};
typedef __bf16 bf16x2_t __attribute__((ext_vector_type(2)));
typedef float f32x2_t __attribute__((ext_vector_type(2)));
__device__ __forceinline__ unsigned cvt_pk_bf16(float lo, float hi) { f32x2_t v = {lo, hi}; bf16x2_t b = __builtin_convertvector(v, bf16x2_t); return __builtin_bit_cast(unsigned, b); }

template <class Epi, class Sched>
__device__ __forceinline__ void gemm_phase(PG8_LAS unsigned char* lds, const Gemm g, const Sched& S, const Epi& E) {
    const int tid = tidx(), wid = __builtin_amdgcn_readfirstlane(tid >> 6), lane = tid & 63, wr = wid >> 2, wc = wid & 3, fr = lane & 15, fq = lane >> 4;
    const int K = g.K, nt = K / BK;
    unsigned voffA[2], voffB[2];
#pragma unroll
    for (int i = 0; i < 2; ++i) { int R, C; stage_rc(tid * 16 + i * 8192, R, C); const int Rb = Epi::PERM ? ((R & ~31) + perm32(R & 31)) : R;
        voffA[i] = (unsigned)(R * K + C) * 2u; voffB[i] = (unsigned)(Rb * K + C) * 2u; }
    const size_t kstep = (size_t)(BK * 2);
    const size_t hstep = (size_t)HALF * K * 2;
    const size_t tstep = 2 * hstep;
    const unsigned ldsw = (unsigned)wid * 1024u;
    const int aoff = lds_byte(wr * 64 + fr, fq * 8), boff = lds_byte(wc * 32 + fr, fq * 8);
#define PG8_SA(b, h) (((b) * 2 + (h)) * HTB)
#define PG8_SB(b, h) ((4 + (b) * 2 + (h)) * HTB)
#define PG8_STAGE(bufoff, gbase, voff) do { _Pragma("unroll") for (int _i = 0; _i < 2; ++_i) \
        __builtin_amdgcn_global_load_lds((const unsigned*)((const char*)(gbase) + (voff)[_i]), (PG8_LAS unsigned*)(lds + (bufoff) + ldsw + _i * 8192), 16, 0, 0); } while (0)
#define PG8_LDA(dst, b, h) do { _Pragma("unroll") for (int m = 0; m < 4; ++m) _Pragma("unroll") for (int k = 0; k < 2; ++k) dst[m][k] = *(const PG8_LAS bf16x8*)(lds + PG8_SA(b, h) + aoff + m * 2048 + k * 1024); } while (0)
#define PG8_LDB(dst, b, h) do { _Pragma("unroll") for (int n = 0; n < 2; ++n) _Pragma("unroll") for (int k = 0; k < 2; ++k) dst[n][k] = *(const PG8_LAS bf16x8*)(lds + PG8_SB(b, h) + boff + n * 2048 + k * 1024); } while (0)
#define PG8_MMA(ai, bj, At, Bt) do { __builtin_amdgcn_s_setprio(1); _Pragma("unroll") for (int m = 0; m < 4; ++m) _Pragma("unroll") for (int n = 0; n < 2; ++n) _Pragma("unroll") for (int k = 0; k < 2; ++k) \
        acc[ai][bj][m][n] = __builtin_amdgcn_mfma_f32_16x16x32_bf16(Bt[n][k], At[m][k], acc[ai][bj][m][n], 0, 0, 0); __builtin_amdgcn_s_setprio(0); } while (0)
#define PG8_WAIT_V(n) asm volatile("s_waitcnt vmcnt(" #n ")" ::: "memory")
#define PG8_WAIT_L(n) asm volatile("s_waitcnt lgkmcnt(" #n ")" ::: "memory")
#define PG8_BAR __builtin_amdgcn_s_barrier()
#define PG8_SCHED __builtin_amdgcn_sched_barrier(0)
    Unit cur, nxt; int ui = 0;
    if (!S.next(0, cur)) return;
    f32x4 acc[2][2][4][2];
#pragma unroll
    for (int a = 0; a < 2; ++a)
#pragma unroll
        for (int b = 0; b < 2; ++b)
#pragma unroll
            for (int m = 0; m < 4; ++m)
#pragma unroll
                for (int n = 0; n < 2; ++n) acc[a][b][m][n] = (f32x4){0.f, 0.f, 0.f, 0.f};
    bf16x8 At[4][2], B0[2][2], B1[2][2];
    const char* cA = (const char*)g.A + (size_t)cur.pm * tstep; const char* cB = (const char*)g.Bt + (size_t)cur.pn * tstep;
    S.a_ready(cur);
    PG8_STAGE(PG8_SB(0, 0), cB, voffB); PG8_STAGE(PG8_SA(0, 0), cA, voffA); PG8_STAGE(PG8_SB(0, 1), cB + hstep, voffB); PG8_STAGE(PG8_SA(0, 1), cA + hstep, voffA);
    if (wr == 1) PG8_BAR;
    PG8_WAIT_V(4); PG8_BAR;
    PG8_STAGE(PG8_SB(1, 0), cB + kstep, voffB); PG8_STAGE(PG8_SA(1, 0), cA + kstep, voffA); PG8_STAGE(PG8_SB(1, 1), cB + hstep + kstep, voffB);
    PG8_WAIT_V(6); PG8_BAR;
    for (;;) {
        const bool has_next = S.next(ui + 1, nxt);
        const char* nA = has_next ? (const char*)g.A + (size_t)nxt.pm * tstep : cA; const char* nB = has_next ? (const char*)g.Bt + (size_t)nxt.pn * tstep : cB;
        for (int t = 0; t < nt; t += 2) {
            const bool last = (t == nt - 2);
            const char* a1 = cA + (size_t)(t + 1) * kstep;
            const char* a2 = last ? nA : cA + (size_t)(t + 2) * kstep; const char* b2 = last ? nB : cB + (size_t)(t + 2) * kstep;
            const char* a3 = a2 + kstep; const char* b3 = b2 + kstep;
            if (last && has_next) S.a_ready(nxt);
            PG8_LDB(B0, 0, 0); PG8_SCHED; PG8_LDA(At, 0, 0); PG8_STAGE(PG8_SA(1, 1), a1 + hstep, voffA);
            PG8_WAIT_L(8); PG8_BAR; PG8_WAIT_L(0); PG8_MMA(0, 0, At, B0); PG8_BAR; PG8_SCHED;
            PG8_LDB(B1, 0, 1); PG8_STAGE(PG8_SB(0, 0), b2, voffB);
            PG8_BAR; PG8_WAIT_L(0); PG8_MMA(0, 1, At, B1); PG8_BAR;
            PG8_LDA(At, 0, 1); PG8_STAGE(PG8_SA(0, 0), a2, voffA);
            PG8_BAR; PG8_WAIT_L(0); PG8_MMA(1, 0, At, B0); PG8_BAR; PG8_SCHED;
            PG8_STAGE(PG8_SB(0, 1), b2 + hstep, voffB);
            PG8_WAIT_V(6); PG8_BAR; PG8_MMA(1, 1, At, B1); PG8_BAR;
            PG8_LDB(B0, 1, 0); PG8_SCHED; PG8_LDA(At, 1, 0); PG8_STAGE(PG8_SA(0, 1), a2 + hstep, voffA);
            PG8_WAIT_L(8); PG8_BAR; PG8_WAIT_L(0); PG8_MMA(0, 0, At, B0); PG8_BAR; PG8_SCHED;
            PG8_LDB(B1, 1, 1); PG8_STAGE(PG8_SB(1, 0), b3, voffB);
            PG8_BAR; PG8_WAIT_L(0); PG8_MMA(0, 1, At, B1); PG8_BAR;
            PG8_LDA(At, 1, 1); PG8_STAGE(PG8_SA(1, 0), a3, voffA);
            PG8_BAR; PG8_WAIT_L(0); PG8_MMA(1, 0, At, B0); PG8_BAR; PG8_SCHED;
            PG8_STAGE(PG8_SB(1, 1), b3 + hstep, voffB);
            PG8_WAIT_V(6); PG8_BAR; PG8_MMA(1, 1, At, B1); PG8_BAR;
        }
        if constexpr (!Epi::AFTER_DRAIN) { E(acc, cur, wr, wc, fr, fq); S.done(cur); }
        if (!has_next) break;
#pragma unroll
        for (int a = 0; a < 2; ++a)
#pragma unroll
            for (int b = 0; b < 2; ++b)
#pragma unroll
                for (int m = 0; m < 4; ++m)
#pragma unroll
                    for (int n = 0; n < 2; ++n) acc[a][b][m][n] = (f32x4){0.f, 0.f, 0.f, 0.f};
        cur = nxt; cA = nA; cB = nB; ++ui;
    }
    PG8_WAIT_V(0);
    if (wr == 0) PG8_BAR;
    PG8_BAR;
    if constexpr (Epi::AFTER_DRAIN) { E.fused(acc, cur, wr, wc, fr, fq, lds, wid, lane); S.done(cur); }
#undef PG8_SA
#undef PG8_SB
#undef PG8_STAGE
#undef PG8_LDA
#undef PG8_LDB
#undef PG8_MMA
#undef PG8_WAIT_V
#undef PG8_WAIT_L
#undef PG8_BAR
#undef PG8_SCHED
}
}

using pg8::bf16_t; using pg8::bf16x8; using pg8::f32x4; using pg8::cvt_pk_bf16;
typedef float f32x16 __attribute__((ext_vector_type(16)));
typedef float f32x8 __attribute__((ext_vector_type(8)));
typedef unsigned u32x2 __attribute__((ext_vector_type(2)));
typedef unsigned u32x4 __attribute__((ext_vector_type(4)));

constexpr int DM = 2048, TPB = 2304, NTOK = 18432, LDP = 7424, MIXW = 3072, NCH = 18;
constexpr int C_LX = 0, C_LG = 1024, C_Q = 2048, C_K = 3072, C_V = 3328, C_AG = 3584, C_XBC = 4608, C_Z = 6144, C_DT = 7168;
constexpr size_t SZ_WTIN = (size_t)4 * 7424 * 2048 * 2, SZ_WTOUT = (size_t)4 * 2048 * 3072 * 2, SZ_MOD = (size_t)4 * 9 * 6144 * 4, SZ_U = (size_t)NTOK * 2048 * 2,
                 SZ_P = (size_t)NTOK * LDP * 2, SZ_MIX = (size_t)NTOK * MIXW * 2, SZ_XB = (size_t)NTOK * 2048 * 4, SZ_ST = (size_t)8 * 2 * 18 * 16 * 8192 * 2,
                 SZ_AL = (size_t)8 * 2 * 18 * 16 * 4, SZ_SUM = (size_t)8 * 2 * 18 * 1024 * 4;
constexpr size_t OFF_WTIN = 0, OFF_WTOUT = OFF_WTIN + SZ_WTIN, OFF_MOD = OFF_WTOUT + SZ_WTOUT, OFF_U = OFF_MOD + SZ_MOD, OFF_P = OFF_U + SZ_U, OFF_MIX = OFF_P + SZ_P,
                 OFF_XB = OFF_MIX + SZ_MIX, OFF_ST = OFF_XB + SZ_XB, OFF_AL = OFF_ST + SZ_ST, OFF_SUMA = OFF_AL + SZ_AL, OFF_SUMB = OFF_SUMA + SZ_SUM, OFF_BAR = OFF_SUMB + SZ_SUM, OFF_SBC = OFF_BAR + 32768, OFF_SBT = OFF_SBC + (size_t)NTOK * 512 * 2, OFF_DTA = OFF_SBT + (size_t)8 * 18 * 2 * 16384 * 2,
                 OFF_ACS = OFF_DTA + (size_t)NTOK * 32 * 4, OFF_HINL = OFF_ACS + (size_t)NTOK * 32 * 4, OFF_GW = OFF_HINL + SZ_SUM, OFF_DTP = OFF_GW + (size_t)4 * 16 * 16384 * 2, OFF_VT = OFF_DTP + (size_t)NTOK * 16 * 4, WS_END = OFF_VT + (size_t)8 * 18 * 2 * 16384 * 2;
constexpr size_t OFF_LXC = OFF_U, OFF_SXT = OFF_U + (size_t)NTOK * 1024 * 2;
constexpr int LDS_CTL = 147456;
constexpr int LDS_BYTES = LDS_CTL + 16;

struct Params {
    const float *x, *c, *ctx, *c_ctx, *norm_w, *ada_w, *ada_b, *w_in, *lru_conv_w, *lru_conv_b, *lru_ga_w, *lru_ga_b, *lru_gx_w, *lru_gx_b, *lru_lambda,
        *att_q_norm, *att_k_norm, *att_sink, *ssd_conv_w, *ssd_conv_b, *ssd_dt_bias, *ssd_A_log, *ssd_D, *ssd_norm_w, *w_out;
    float* out;
    unsigned char* ws;
};
#define WS_WTIN(p) ((bf16_t*)((p).ws + OFF_WTIN))
#define WS_WTOUT(p) ((bf16_t*)((p).ws + OFF_WTOUT))
#define WS_MOD(p) ((float*)((p).ws + OFF_MOD))
#define WS_U(p) ((bf16_t*)((p).ws + OFF_U))
#define WS_P(p) ((bf16_t*)((p).ws + OFF_P))
#define WS_MIX(p) ((bf16_t*)((p).ws + OFF_MIX))
#define WS_XB(p) ((float*)((p).ws + OFF_XB))
#define WS_ST(p) ((bf16_t*)((p).ws + OFF_ST))
#define WS_AL(p) ((float*)((p).ws + OFF_AL))
#define WS_SUMA(p) ((float*)((p).ws + OFF_SUMA))
#define WS_SUMB(p) ((float*)((p).ws + OFF_SUMB))
#define WS_LXC(p) ((bf16_t*)((p).ws + OFF_LXC))
#define WS_SXT(p) ((bf16_t*)((p).ws + OFF_SXT))
#define WS_SBC(p) ((bf16_t*)((p).ws + OFF_SBC))
#define WS_SBT(p) ((bf16_t*)((p).ws + OFF_SBT))
#define WS_DTA(p) ((float*)((p).ws + OFF_DTA))
#define WS_ACS(p) ((float*)((p).ws + OFF_ACS))
#define WS_HINL(p) ((float*)((p).ws + OFF_HINL))
#define WS_GW(p) ((bf16_t*)((p).ws + OFF_GW))
#define WS_DTP(p) ((float*)((p).ws + OFF_DTP))
#define WS_VT(p) ((bf16_t*)((p).ws + OFF_VT))

__device__ __forceinline__ float bf2f(bf16_t v) { return __uint_as_float(((unsigned)v) << 16); }
__device__ __forceinline__ bf16_t f2bf(float f) { return (bf16_t)(cvt_pk_bf16(f, 0.f) & 0xffffu); }
__device__ __forceinline__ float siluf(float v) { return v * __builtin_amdgcn_rcpf(1.f + __expf(-v)); }
__device__ __forceinline__ float sigmf(float v) { return __builtin_amdgcn_rcpf(1.f + __expf(-v)); }
__device__ __forceinline__ float softplusf(float v) { return v > 20.f ? v : log1pf(__expf(v)); }
__device__ __forceinline__ float wave_sum(float v) {
#pragma unroll
    for (int o = 1; o < 64; o <<= 1) v += __shfl_xor(v, o);
    return v;
}
__device__ __forceinline__ f32x8 unpack8(const u32x4 w) {
    f32x8 f;
    f[0] = __uint_as_float(w.x << 16); f[1] = __uint_as_float(w.x & 0xffff0000u); f[2] = __uint_as_float(w.y << 16); f[3] = __uint_as_float(w.y & 0xffff0000u);
    f[4] = __uint_as_float(w.z << 16); f[5] = __uint_as_float(w.z & 0xffff0000u); f[6] = __uint_as_float(w.w << 16); f[7] = __uint_as_float(w.w & 0xffff0000u);
    return f;
}
__device__ __forceinline__ u32x4 pack8(const f32x8 f) { u32x4 w; w.x = cvt_pk_bf16(f[0], f[1]); w.y = cvt_pk_bf16(f[2], f[3]); w.z = cvt_pk_bf16(f[4], f[5]); w.w = cvt_pk_bf16(f[6], f[7]); return w; }
__device__ __forceinline__ void lds_barrier() { asm volatile("s_waitcnt lgkmcnt(0)" ::: "memory"); __builtin_amdgcn_s_barrier(); asm volatile("" ::: "memory"); }
__device__ __forceinline__ float dpp_f(float v, int ctrl_sel) {
    const int x = __builtin_bit_cast(int, v); int r;
    if (ctrl_sel == 0) r = __builtin_amdgcn_update_dpp(x, x, 0xB1, 0xF, 0xF, false);
    else if (ctrl_sel == 1) r = __builtin_amdgcn_update_dpp(x, x, 0x4E, 0xF, 0xF, false);
    else if (ctrl_sel == 2) r = __builtin_amdgcn_update_dpp(x, x, 0x141, 0xF, 0xF, false);
    else r = __builtin_amdgcn_update_dpp(x, x, 0x140, 0xF, 0xF, false);
    return __builtin_bit_cast(float, r);
}
__device__ __forceinline__ float row16_max(float v) { v = fmaxf(v, dpp_f(v, 0)); v = fmaxf(v, dpp_f(v, 1)); v = fmaxf(v, dpp_f(v, 2)); v = fmaxf(v, dpp_f(v, 3)); return v; }
__device__ __forceinline__ float row16_sum(float v) { v += dpp_f(v, 0); v += dpp_f(v, 1); v += dpp_f(v, 2); v += dpp_f(v, 3); return v; }
__device__ __forceinline__ int chunk_at(int d, int pos) { return d == 0 ? pos : (pos < 2 ? 1 - pos : 19 - pos); }
__device__ __forceinline__ int pos_of(int d, int c) { return d == 0 ? c : (c < 2 ? 1 - c : 19 - c); }
__device__ __forceinline__ int rowmap32(int reg, int lane) { return (reg & 3) + 8 * (reg >> 2) + 4 * (lane >> 5); }

template <int K> __device__ __forceinline__ void mm32(f32x16& acc, const bf16_t* A, int lda, const bf16_t* B, int ldb, int lane) {
    const bf16_t* pa = A + (lane & 31) * lda + 8 * (lane >> 5);
    const bf16_t* pb = B + (lane & 31) * ldb + 8 * (lane >> 5);
#pragma unroll
    for (int k = 0; k < K; k += 16) {
        const bf16x8 a = *(const bf16x8*)(pa + k);
        const bf16x8 b = *(const bf16x8*)(pb + k);
        acc = __builtin_amdgcn_mfma_f32_32x32x16_bf16(a, b, acc, 0, 0, 0);
    }
}

template <int NC, bool SILU, bool TRANS>
__device__ __forceinline__ void stage_conv_tile(bf16_t* dst, int ld, const bf16_t* Pb, int t0, int col0, const float* cw, int CS, const float* cb, int tid) {
    constexpr int CG = NC / 8;
    const int lo = t0 < 256 ? 0 : 256, hi = t0 < 256 ? 256 : TPB;
    for (int idx = tid; idx < 128 * CG; idx += 512) {
        int cgi, tl;
        if (TRANS) { tl = idx & 127; cgi = idx >> 7; } else { cgi = idx % CG; tl = idx / CG; }
        const int t = t0 + tl;
        const f32x4 b0 = *(const f32x4*)(cb + cgi * 8), b1 = *(const f32x4*)(cb + cgi * 8 + 4);
        f32x8 acc; acc[0] = b0.x; acc[1] = b0.y; acc[2] = b0.z; acc[3] = b0.w; acc[4] = b1.x; acc[5] = b1.y; acc[6] = b1.z; acc[7] = b1.w;
#pragma unroll
        for (int k = 0; k < 4; ++k) {
            const int tt = t - 2 + k;
            if (tt >= lo && tt < hi) {
                const f32x8 v = unpack8(*(const u32x4*)(Pb + (size_t)tt * LDP + col0 + cgi * 8));
                const f32x4 w0 = *(const f32x4*)(cw + k * CS + cgi * 8), w1 = *(const f32x4*)(cw + k * CS + cgi * 8 + 4);
                acc[0] += w0.x * v[0]; acc[1] += w0.y * v[1]; acc[2] += w0.z * v[2]; acc[3] += w0.w * v[3];
                acc[4] += w1.x * v[4]; acc[5] += w1.y * v[5]; acc[6] += w1.z * v[6]; acc[7] += w1.w * v[7];
            }
        }
        if (SILU) {
#pragma unroll
            for (int e = 0; e < 8; ++e) acc[e] = siluf(acc[e]);
        }
        if (TRANS) {
#pragma unroll
            for (int e = 0; e < 8; ++e) dst[(cgi * 8 + e) * ld + tl] = f2bf(acc[e]);
        } else {
            *(u32x4*)(dst + tl * ld + cgi * 8) = pack8(acc);
        }
    }
}

__device__ __forceinline__ void transpose_item(const float* W, int K, int N, int nblk, bf16_t* WT, float* scr, int item, int lane) {
    const int kb = item / nblk, nb = item % nblk, k0 = 64 * kb, n0 = 32 * nb;
    const int c4 = lane & 7, r8 = lane >> 3, n = n0 + c4 * 4;
    f32x4 tv[8];
#pragma unroll
    for (int i = 0; i < 8; ++i) tv[i] = (n < N) ? *(const f32x4*)(W + (size_t)(k0 + i * 8 + r8) * N + n) : (f32x4){0.f, 0.f, 0.f, 0.f};
#pragma unroll
    for (int i = 0; i < 8; ++i) { float* d = scr + (i * 8 + r8) * 33 + c4 * 4; d[0] = tv[i].x; d[1] = tv[i].y; d[2] = tv[i].z; d[3] = tv[i].w; }
    asm volatile("s_waitcnt lgkmcnt(0)" ::: "memory");
    const int c = lane & 7;
#pragma unroll
    for (int j = 0; j < 4; ++j) {
        const int nn = (lane >> 3) + 8 * j; const float* s = scr + (8 * c) * 33 + nn;
        u32x4 o; o.x = cvt_pk_bf16(s[0 * 33], s[1 * 33]); o.y = cvt_pk_bf16(s[2 * 33], s[3 * 33]); o.z = cvt_pk_bf16(s[4 * 33], s[5 * 33]); o.w = cvt_pk_bf16(s[6 * 33], s[7 * 33]);
        *(u32x4*)(WT + (size_t)(n0 + nn) * K + k0 + 8 * c) = o;
    }
    asm volatile("s_waitcnt lgkmcnt(0)" ::: "memory");
}

__device__ __forceinline__ void phase0(const Params& p, unsigned char* shm, int G) {
    const int tid = tidx(), lane = tid & 63, wave = tid >> 6;
    float* sf = (float*)shm;
    float* MOD = WS_MOD(p);
    for (int item = blockIdx.x; item < 96; item += G) {
        const int l = item / 24, cgp = item % 24;
        __syncthreads();
        for (int idx = tid; idx < 9 * 2048; idx += 512) { const int r = idx >> 11, k = idx & 2047; const float v = r < 8 ? p.c[r * 2048 + k] : p.c_ctx[k]; sf[idx] = siluf(v); }
        __syncthreads();
        f32x4 acc[9];
#pragma unroll
        for (int r = 0; r < 9; ++r) acc[r] = (f32x4){0.f, 0.f, 0.f, 0.f};
        const float* wp = p.ada_w + ((size_t)l * 2048 + wave * 256) * 6144 + cgp * 256 + lane * 4;
#pragma unroll 16
        for (int kk = 0; kk < 256; ++kk) {
            const f32x4 wv = *(const f32x4*)(wp + (size_t)kk * 6144);
            const int k = wave * 256 + kk;
#pragma unroll
            for (int r = 0; r < 9; ++r) { const float s = sf[r * 2048 + k]; acc[r] += wv * s; }
        }
        __syncthreads();
#pragma unroll
        for (int r = 0; r < 9; ++r) *(f32x4*)(sf + (wave * 9 + r) * 256 + lane * 4) = acc[r];
        __syncthreads();
        for (int idx = tid; idx < 9 * 256; idx += 512) {
            const int r = idx >> 8, col = idx & 255; float s = p.ada_b[l * 6144 + cgp * 256 + col];
#pragma unroll
            for (int w = 0; w < 8; ++w) s += sf[(w * 9 + r) * 256 + col];
            MOD[(size_t)(l * 9 + r) * 6144 + cgp * 256 + col] = s;
        }
    }
    __syncthreads();
    float* scr = sf + wave * (64 * 33);
    const int gw = blockIdx.x * 8 + wave, NGW = G * 8;
    constexpr int I_IN = 32 * 232, I_OUT = 48 * 64;
    for (int it = gw; it < 4 * (I_IN + I_OUT); it += NGW) {
        if (it < 4 * I_IN) { const int l = it / I_IN, r = it % I_IN; transpose_item(p.w_in + (size_t)l * 2048 * 7184, 2048, 7184, 232, WS_WTIN(p) + (size_t)l * 7424 * 2048, scr, r, lane); }
        else { const int it2 = it - 4 * I_IN, l = it2 / I_OUT, r = it2 % I_OUT; transpose_item(p.w_out + (size_t)l * 3072 * 2048, 3072, 2048, 64, WS_WTOUT(p) + (size_t)l * 2048 * 3072, scr, r, lane); }
    }
    for (int idx = (int)blockIdx.x * 512 + tid; idx < 4 * 16 * 16384; idx += G * 512) {
        const int i = idx & 63, o = (idx >> 6) & 63, gate = (idx >> 12) & 1, d = (idx >> 13) & 1, j = (idx >> 14) & 15, l = idx >> 18;
        const float* w = gate ? p.lru_gx_w : p.lru_ga_w;
        WS_GW(p)[idx] = f2bf(w[(size_t)((l * 2 + d) * 16 + j) * 4096 + i * 64 + o]);
    }
}

__device__ __forceinline__ const float* xrow_src(const Params& p, int l, int row) {
    const int b = row / TPB, t = row % TPB;
    if (l == 0) return t < 256 ? p.ctx + ((size_t)b * 256 + t) * DM : p.x + ((size_t)b * 2048 + (t - 256)) * DM;
    return WS_XB(p) + (size_t)row * DM;
}
__device__ __forceinline__ void norm_phase(const Params& p, int l, int G) {
    const int lane = tidx() & 63, wave = tidx() >> 6;
    bf16_t* U = WS_U(p);
    for (int row = blockIdx.x * 8 + wave; row < NTOK; row += G * 8) {
        const int b = row / TPB, t = row % TPB;
        const float* src = xrow_src(p, l, row);
        const float* md = WS_MOD(p) + (size_t)(l * 9 + (t < 256 ? 8 : b)) * 6144;
        f32x4 v[8]; float ss = 0.f;
#pragma unroll
        for (int j = 0; j < 8; ++j) { v[j] = *(const f32x4*)(src + 4 * lane + 256 * j); ss += v[j].x * v[j].x + v[j].y * v[j].y + v[j].z * v[j].z + v[j].w * v[j].w; }
        ss = wave_sum(ss);
        const float rstd = rsqrtf(ss * (1.f / 2048.f) + 1e-6f);
#pragma unroll
        for (int j = 0; j < 8; ++j) {
            const int col = 4 * lane + 256 * j;
            const f32x4 nw = *(const f32x4*)(p.norm_w + l * 2048 + col), sh = *(const f32x4*)(md + col), sc = *(const f32x4*)(md + 2048 + col);
            const f32x4 y = v[j] * rstd * nw * (sc + 1.f) + sh;
            u32x2 w; w.x = cvt_pk_bf16(y.x, y.y); w.y = cvt_pk_bf16(y.z, y.w);
            *(u32x2*)(U + (size_t)row * DM + col) = w;
        }
    }
}

struct EpiG1 {
    static constexpr bool PERM = true, AFTER_DRAIN = false;
    bf16_t* P;
    __device__ __forceinline__ void operator()(const f32x4 (&acc)[2][2][4][2], const pg8::Unit& u, int wr, int wc, int fr, int fq) const {
        const int row0 = u.pm * 256 + wr * 64 + fr, col0 = u.pn * 256 + wc * 32 + 8 * fq;
#pragma unroll
        for (int ai = 0; ai < 2; ++ai)
#pragma unroll
            for (int m = 0; m < 4; ++m) { bf16_t* rowp = P + (size_t)(row0 + ai * 128 + m * 16) * LDP + col0;
#pragma unroll
                for (int bj = 0; bj < 2; ++bj) { const f32x4 v0 = acc[ai][bj][m][0], v1 = acc[ai][bj][m][1];
                    u32x4 w; w.x = cvt_pk_bf16(v0.x, v0.y); w.y = cvt_pk_bf16(v0.z, v0.w); w.z = cvt_pk_bf16(v1.x, v1.y); w.w = cvt_pk_bf16(v1.z, v1.w);
                    *(u32x4*)(rowp + bj * 128) = w; } }
    }
};
struct EpiG2 {
    static constexpr bool PERM = true, AFTER_DRAIN = false;
    Params p; int l; int scr;
    __device__ __forceinline__ void operator()(const f32x4 (&acc)[2][2][4][2], const pg8::Unit& u, int wr, int wc, int fr, int fq) const {
        const int row0 = u.pm * 256 + wr * 64 + fr, col0 = u.pn * 256 + wc * 32 + 8 * fq;
#pragma unroll
        for (int ai = 0; ai < 2; ++ai)
#pragma unroll
            for (int m = 0; m < 4; ++m) {
                const int row = row0 + ai * 128 + m * 16, b = row / TPB, t = row % TPB;
                if (l == 3 && t < 256) continue;
                const float* xo = xrow_src(p, l, row);
                float* dst = scr ? (float*)WS_P(p) + (size_t)row * DM : (l == 3) ? p.out + ((size_t)b * 2048 + (t - 256)) * DM : WS_XB(p) + (size_t)row * DM;
                const float* gt = WS_MOD(p) + (size_t)(l * 9 + (t < 256 ? 8 : b)) * 6144 + 4096;
#pragma unroll
                for (int bj = 0; bj < 2; ++bj)
#pragma unroll
                    for (int n = 0; n < 2; ++n) { const int col = col0 + bj * 128 + n * 4; const f32x4 xv = *(const f32x4*)(xo + col), g = *(const f32x4*)(gt + col); *(f32x4*)(dst + col) = xv + g * acc[ai][bj][m][n]; }
            }
    }
};

template <int SCR>
__device__ __forceinline__ void qkprep_row(const Params& p, int l, int row, int lane) {
    const int t = row % TPB;
    bf16_t* rp = WS_P(p) + (size_t)row * LDP;
    float cs = 1.f, sn = 0.f;
    if (t >= 256) {
        const int s = t - 256, rr = s >> 6, cc = s & 63, f = lane & 31;
        const float inv = exp2f(-(float)f * (13.287712379549449f / 32.f));
        const float ang = (float)(lane < 32 ? rr : cc) * inv;
        cs = __cosf(ang); sn = __sinf(ang);
    }
    bf16_t r1[10], r2[10];
#pragma unroll
    for (int slot = 0; slot < 10; ++slot) { const int col = slot < 8 ? C_Q + slot * 128 : C_K + (slot - 8) * 128; r1[slot] = rp[col + lane]; r2[slot] = rp[col + 64 + lane]; }
#pragma unroll
    for (int slot = 0; slot < 10; ++slot) {
        const int col = slot < 8 ? C_Q + slot * 128 : C_K + (slot - 8) * 128;
        const float* w = slot < 8 ? p.att_q_norm + l * 128 : p.att_k_norm + l * 128;
        const float v1 = bf2f(r1[slot]), v2 = bf2f(r2[slot]);
        const float ss = wave_sum(v1 * v1 + v2 * v2);
        const float rstd = rsqrtf(ss * (1.f / 128.f) + 1e-6f);
        const float y1 = v1 * rstd * w[lane], y2 = v2 * rstd * w[64 + lane];
        float o1 = y1 * cs - y2 * sn, o2 = y1 * sn + y2 * cs;
        if (slot < 8) { o1 *= 0.08838834764831845f; o2 *= 0.08838834764831845f; }
        if (SCR) { bf16_t* sp = WS_ST(p) + (size_t)row * 1280 + slot * 128; sp[lane] = f2bf(o1); sp[64 + lane] = f2bf(o2); } else { rp[col + lane] = f2bf(o1); rp[col + 64 + lane] = f2bf(o2); }
    }
}

template <int D, int SCR = 0>
__device__ __forceinline__ void lru_sweep_item(const Params& p, int l, int item, unsigned char* shm) {
    const int tid = tidx(), lane = tid & 63, wave = tid >> 6, ch = tid & 63, seg = tid >> 6;
    const int j = item & 15, b = item >> 4;
    bf16_t* sX = (bf16_t*)shm; bf16_t* sW = (bf16_t*)(shm + 18432);
    float* sA = (float*)(shm + 36864); float* sB = (float*)(shm + 69632); float* sSA = (float*)(shm + 102400); float* sSB = (float*)(shm + 104448);
    bf16_t* sOut = (bf16_t*)(shm + 106496);
    const int mi = wave & 3, nj = wave >> 2, cl = nj * 32 + (lane & 31), cgl = j * 64 + cl;
    const float ba = p.lru_ga_b[(l * 2 + D) * 1024 + cgl], bx = p.lru_gx_b[(l * 2 + D) * 1024 + cgl], sp = softplusf(-p.lru_lambda[(l * 2 + D) * 1024 + cgl]);
    lds_barrier();
    {
        u32x4 wr2[2];
#pragma unroll
        for (int k = 0; k < 2; ++k) { const int idx = tid + k * 512; wr2[k] = *(const u32x4*)(WS_GW(p) + (size_t)(l * 16 + j) * 16384 + D * 8192 + idx * 8); }
#pragma unroll
        for (int k = 0; k < 2; ++k) { const int idx = tid + k * 512; *(u32x4*)(sW + (idx >> 3) * 72 + (idx & 7) * 8) = wr2[k]; }
    }
    u32x4 xr[2], lgr[2], hfr[2];
    {
        const size_t tok0 = (size_t)b * TPB + chunk_at(D, 0) * 128;
#pragma unroll
        for (int k = 0; k < 2; ++k) {
            const int idx = tid + k * 512;
            xr[k] = *(const u32x4*)(WS_LXC(p) + (tok0 + (idx >> 3)) * 1024 + j * 64 + (idx & 7) * 8);
            if (D == 1) { lgr[k] = *(const u32x4*)(WS_P(p) + (tok0 + (idx >> 3)) * LDP + C_LG + j * 64 + (idx & 7) * 8); hfr[k] = *(const u32x4*)(WS_MIX(p) + (tok0 + (idx >> 3)) * MIXW + j * 64 + (idx & 7) * 8); }
        }
    }
    float carry = 0.f;
#pragma unroll 1
    for (int pos = 0; pos < NCH; ++pos) {
        const size_t tok0 = (size_t)b * TPB + chunk_at(D, pos) * 128;
#pragma unroll
        for (int k = 0; k < 2; ++k) { const int idx = tid + k * 512; *(u32x4*)(sX + (idx >> 3) * 72 + (idx & 7) * 8) = xr[k]; }
        u32x4 lgc[2], hfc[2];
        if (D == 1) { lgc[0] = lgr[0]; lgc[1] = lgr[1]; hfc[0] = hfr[0]; hfc[1] = hfr[1]; }
        if (pos + 1 < NCH) {
            const size_t tokn = (size_t)b * TPB + chunk_at(D, pos + 1) * 128;
#pragma unroll
            for (int k = 0; k < 2; ++k) {
                const int idx = tid + k * 512;
                xr[k] = *(const u32x4*)(WS_LXC(p) + (tokn + (idx >> 3)) * 1024 + j * 64 + (idx & 7) * 8);
                if (D == 1) { lgr[k] = *(const u32x4*)(WS_P(p) + (tokn + (idx >> 3)) * LDP + C_LG + j * 64 + (idx & 7) * 8); hfr[k] = *(const u32x4*)(WS_MIX(p) + (tokn + (idx >> 3)) * MIXW + j * 64 + (idx & 7) * 8); }
            }
        }
        lds_barrier();
        {
            f32x16 ga, gx;
#pragma unroll
            for (int r = 0; r < 16; ++r) { ga[r] = 0.f; gx[r] = 0.f; }
            mm32<64>(ga, sX + mi * 32 * 72, 72, sW + (nj * 32) * 72, 72, lane);
            mm32<64>(gx, sX + mi * 32 * 72, 72, sW + (64 + nj * 32) * 72, 72, lane);
#pragma unroll
            for (int r = 0; r < 16; ++r) {
                const int tl = mi * 32 + rowmap32(r, lane);
                const float rg = sigmf(ga[r] + ba), ig = sigmf(gx[r] + bx);
                const float a = __expf(-8.f * rg * sp), mult = __builtin_amdgcn_sqrtf(fmaxf(1.f - a * a, 0.f));
                const float xv = bf2f(sX[tl * 72 + cl]);
                sA[tl * 64 + cl] = a; sB[tl * 64 + cl] = mult * ig * xv;
            }
        }
        lds_barrier();
        {
            float A = 1.f, Bc = 0.f;
#pragma unroll
            for (int q = 0; q < 16; ++q) { const int tl = seg * 16 + (D == 0 ? q : 15 - q); const float a = sA[tl * 64 + ch], bb = sB[tl * 64 + ch]; A = a * A; Bc = a * Bc + bb; }
            sSA[seg * 64 + ch] = A; sSB[seg * 64 + ch] = Bc;
        }
        lds_barrier();
        {
            float h = carry, cn = carry;
            const int myord = D == 0 ? seg : 7 - seg;
#pragma unroll
            for (int s = 0; s < 8; ++s) { const int sg = D == 0 ? s : 7 - s; const float a = sSA[sg * 64 + ch], bb = sSB[sg * 64 + ch]; cn = a * cn + bb; if (s < myord) h = cn; }
            carry = cn;
#pragma unroll
            for (int q = 0; q < 16; ++q) { const int tl = seg * 16 + (D == 0 ? q : 15 - q); h = sA[tl * 64 + ch] * h + sB[tl * 64 + ch]; sOut[tl * 72 + ch] = f2bf(h); }
        }
        lds_barrier();
#pragma unroll
        for (int k = 0; k < 2; ++k) {
            const int idx = tid + k * 512, rr = idx >> 3, ck = idx & 7;
            const u32x4 hv = *(const u32x4*)(sOut + rr * 72 + ck * 8);
            bf16_t* dst = SCR ? WS_P(p) + (tok0 + rr) * LDP + j * 64 + ck * 8 : WS_MIX(p) + (tok0 + rr) * MIXW + j * 64 + ck * 8;
            if (D == 0) *(u32x4*)dst = hv;
            else {
                const f32x8 a = unpack8(hv), f = unpack8(hfc[k]), g = unpack8(lgc[k]);
                f32x8 o;
#pragma unroll
                for (int e = 0; e < 8; ++e) o[e] = (a[e] + f[e]) * siluf(g[e]);
                *(u32x4*)dst = pack8(o);
            }
        }
    }
}

__device__ __forceinline__ void prep_elem(const Params& p, int l, int G) {
    const int gt = (int)blockIdx.x * 512 + tidx(), NT = G * 512;
    constexpr int NI = (NTOK / 4) * 192;
#pragma unroll 1
    for (int idx = gt; idx < NI; idx += NT) {
        const int tok = (idx / 192) * 4, cgi = idx % 192, b = tok / TPB, t = tok % TPB;
        const int lo = t < 256 ? 0 : 256, hi = t < 256 ? 256 : TPB;
        int col, CS, rs; const float *cw, *cb; bf16_t* dst; bool act;
        if (cgi < 128) { col = C_LX + cgi * 8; cw = p.lru_conv_w + l * 4096 + cgi * 8; CS = 1024; cb = p.lru_conv_b + l * 1024 + cgi * 8; act = false; dst = WS_LXC(p) + (size_t)tok * 1024 + cgi * 8; rs = 1024; }
        else { const int c2 = (cgi - 128) * 8; col = C_XBC + 1024 + c2; cw = p.ssd_conv_w + l * 6144 + 1024 + c2; CS = 1536; cb = p.ssd_conv_b + l * 1536 + 1024 + c2; act = true; dst = WS_SBC(p) + (size_t)tok * 512 + c2; rs = 512; }
        const bf16_t* src = WS_P(p) + (size_t)b * TPB * LDP + col;
        u32x4 raw[7];
#pragma unroll
        for (int r = 0; r < 7; ++r) { const int tt = t - 2 + r; raw[r] = (tt >= lo && tt < hi) ? *(const u32x4*)(src + (size_t)tt * LDP) : (u32x4){0u, 0u, 0u, 0u}; }
        const f32x4 b0 = *(const f32x4*)cb, b1 = *(const f32x4*)(cb + 4);
        f32x8 acc[4];
#pragma unroll
        for (int o = 0; o < 4; ++o) { acc[o][0] = b0.x; acc[o][1] = b0.y; acc[o][2] = b0.z; acc[o][3] = b0.w; acc[o][4] = b1.x; acc[o][5] = b1.y; acc[o][6] = b1.z; acc[o][7] = b1.w; }
#pragma unroll
        for (int k = 0; k < 4; ++k) {
            const f32x4 w0 = *(const f32x4*)(cw + k * CS), w1 = *(const f32x4*)(cw + k * CS + 4);
#pragma unroll
            for (int o = 0; o < 4; ++o) {
                const f32x8 v = unpack8(raw[o + k]);
                acc[o][0] += w0.x * v[0]; acc[o][1] += w0.y * v[1]; acc[o][2] += w0.z * v[2]; acc[o][3] += w0.w * v[3];
                acc[o][4] += w1.x * v[4]; acc[o][5] += w1.y * v[5]; acc[o][6] += w1.z * v[6]; acc[o][7] += w1.w * v[7];
            }
        }
#pragma unroll
        for (int o = 0; o < 4; ++o) {
            if (act) {
#pragma unroll
                for (int e = 0; e < 8; ++e) acc[o][e] = siluf(acc[o][e]);
            }
            *(u32x4*)(dst + (size_t)o * rs) = pack8(acc[o]);
        }
    }
}
struct PrepTile { int col0, ch0, t0, lo, hi, conv; const bf16_t* Pb; bf16_t* dst; };
__device__ __forceinline__ PrepTile prep_tile_decode(const Params& p, int item) {
    PrepTile T;
    const int t24 = item % 24, bc = item / 24, c = bc % NCH, b = bc / NCH;
    T.t0 = c * 128; T.Pb = WS_P(p) + (size_t)b * TPB * LDP; T.ch0 = 0; T.conv = t24 < 20;
    if (t24 < 16) { T.ch0 = t24 * 64; T.col0 = C_XBC + T.ch0; T.dst = WS_SXT(p) + ((size_t)((b * 18 + c) * 16 + t24)) * 8192; }
    else if (t24 < 20) { const int q = t24 - 16, g = q >> 1, nh = q & 1; T.ch0 = 1024 + g * 128 + nh * 64; T.col0 = C_XBC + T.ch0; T.dst = WS_SBT(p) + ((size_t)((b * 18 + c) * 2 + g)) * 16384 + (size_t)nh * 64 * 128; }
    else { const int q = t24 - 20, kh = q >> 1, dh = q & 1; T.col0 = C_V + kh * 128 + dh * 64; T.dst = WS_VT(p) + ((size_t)((b * 18 + c) * 2 + kh)) * 16384 + (size_t)dh * 64 * 128; }
    T.lo = T.t0 < 256 ? 0 : 256; T.hi = T.t0 < 256 ? 256 : TPB;
    return T;
}
__device__ __forceinline__ void prep_tile_load(const PrepTile& T, int tid, u32x4 (&raw)[2][4]) {
#pragma unroll
    for (int k = 0; k < 2; ++k) {
        const int idx = tid + k * 512, cgi = idx & 7, t = T.t0 + (idx >> 3);
#pragma unroll
        for (int q = 0; q < 4; ++q) {
            const int tt = T.conv ? t - 2 + q : t;
            const bool ok = T.conv ? (tt >= T.lo && tt < T.hi) : (q == 2);
            raw[k][q] = ok ? *(const u32x4*)(T.Pb + (size_t)tt * LDP + T.col0 + cgi * 8) : (u32x4){0u, 0u, 0u, 0u};
        }
    }
}
__device__ __forceinline__ void prep_tile_finish(const Params& p, int l, const PrepTile& T, int tid, const u32x4 (&raw)[2][4], unsigned char* shm) {
    bf16_t* sT = (bf16_t*)shm;
    const float* cw = p.ssd_conv_w + l * 6144 + T.ch0; const float* cb = p.ssd_conv_b + l * 1536 + T.ch0;
    lds_barrier();
#pragma unroll
    for (int k = 0; k < 2; ++k) {
        const int idx = tid + k * 512, cgi = idx & 7, tl = idx >> 3;
        f32x8 acc;
        if (T.conv) {
            const f32x4 b0 = *(const f32x4*)(cb + cgi * 8), b1 = *(const f32x4*)(cb + cgi * 8 + 4);
            acc[0] = b0.x; acc[1] = b0.y; acc[2] = b0.z; acc[3] = b0.w; acc[4] = b1.x; acc[5] = b1.y; acc[6] = b1.z; acc[7] = b1.w;
#pragma unroll
            for (int q = 0; q < 4; ++q) {
                const f32x8 v = unpack8(raw[k][q]);
                const f32x4 w0 = *(const f32x4*)(cw + q * 1536 + cgi * 8), w1 = *(const f32x4*)(cw + q * 1536 + cgi * 8 + 4);
                acc[0] += w0.x * v[0]; acc[1] += w0.y * v[1]; acc[2] += w0.z * v[2]; acc[3] += w0.w * v[3];
                acc[4] += w1.x * v[4]; acc[5] += w1.y * v[5]; acc[6] += w1.z * v[6]; acc[7] += w1.w * v[7];
            }
#pragma unroll
            for (int e = 0; e < 8; ++e) acc[e] = siluf(acc[e]);
        } else acc = unpack8(raw[k][2]);
#pragma unroll
        for (int e = 0; e < 8; ++e) sT[(cgi * 8 + e) * 130 + tl] = f2bf(acc[e]);
    }
    lds_barrier();
#pragma unroll
    for (int k = 0; k < 2; ++k) {
        const int idx = tid + k * 512, r = idx >> 4, ck = idx & 15;
        const unsigned* sp = (const unsigned*)(sT + r * 130 + ck * 8);
        u32x4 o; o.x = sp[0]; o.y = sp[1]; o.z = sp[2]; o.w = sp[3];
        *(u32x4*)(T.dst + r * 128 + ck * 8) = o;
    }
}
__device__ __forceinline__ void prep_tiles(const Params& p, int l, int bid, int G, unsigned char* shm) {
    const int tid = tidx();
    if (bid >= 3456) return;
    u32x4 raw[2][4], nraw[2][4];
    { const PrepTile T0 = prep_tile_decode(p, bid); prep_tile_load(T0, tid, raw); }
#pragma unroll 1
    for (int it = bid; it < 3456; it += G) {
        const bool more = it + G < 3456;
        if (more) { const PrepTile Tn = prep_tile_decode(p, it + G); prep_tile_load(Tn, tid, nraw); }
        { const PrepTile T = prep_tile_decode(p, it); prep_tile_finish(p, l, T, tid, raw, shm); }
        if (more) {
#pragma unroll
            for (int k = 0; k < 2; ++k)
#pragma unroll
                for (int q = 0; q < 4; ++q) raw[k][q] = nraw[k][q];
        }
    }
}
__device__ __forceinline__ void prep_dt_item(const Params& p, int l, int item) {
    const int tid = tidx();
    const int c = item % NCH, b = item / NCH;
    const int col32 = tid >> 4, h = col32 >> 1, d = col32 & 1, lane16 = tid & 15, seg = d == 0 ? lane16 : 15 - lane16;
    const float A = -__expf(p.ssd_A_log[(l * 2 + d) * 16 + h]), bias = p.ssd_dt_bias[(l * 2 + d) * 16 + h];
    const float* src = WS_DTP(p) + ((size_t)b * TPB + c * 128) * 16 + h;
    float dtv[8], cs[8], run = 0.f;
    float rawv[8];
#pragma unroll
    for (int q = 0; q < 8; ++q) { const int j = seg * 8 + (d == 0 ? q : 7 - q); rawv[q] = src[j * 16]; }
#pragma unroll
    for (int q = 0; q < 8; ++q) { dtv[q] = softplusf(rawv[q] + bias); run += dtv[q] * A; cs[q] = run; }
    float incl = run;
#pragma unroll
    for (int off = 1; off < 16; off <<= 1) { const float v = __shfl_up(incl, off, 16); if (lane16 >= off) incl += v; }
    const float excl = incl - run;
    float* dta = WS_DTA(p) + ((size_t)(b * 18 + c) * 128) * 32 + col32;
    float* acs = WS_ACS(p) + ((size_t)(b * 18 + c) * 128) * 32 + col32;
#pragma unroll
    for (int q = 0; q < 8; ++q) { const int j = seg * 8 + (d == 0 ? q : 7 - q); dta[j * 32] = dtv[q]; acs[j * 32] = cs[q] + excl; }
    if (lane16 == 15) WS_AL(p)[((b * 2 + d) * 18 + c) * 16 + h] = incl;
}
__device__ __forceinline__ void ssd_states_item(const Params& p, int l, int item, unsigned char* shm) {
    const int tid = tidx(), lane = tid & 63, wave = tid >> 6;
    const int g = item & 1, hh0 = ((item >> 1) & 1) * 4, bc = item >> 2, c = bc % NCH, b = bc / NCH;
    bf16_t* sBT = (bf16_t*)shm; bf16_t* sXw = (bf16_t*)(shm + 34816);
    float* sDt = (float*)(shm + 69632); float* sAcs = (float*)(shm + 77824); bf16_t* sO = (bf16_t*)(shm + 86016); float* sWg = (float*)(shm + 120832);
    const bf16_t* xt = WS_SXT(p) + ((size_t)((b * 18 + c) * 16 + g * 8)) * 8192;
    const bf16_t* btp = WS_SBT(p) + ((size_t)((b * 18 + c) * 2 + g)) * 16384;
    lds_barrier();
    {
        const size_t o = ((size_t)(b * 18 + c) * 128 + (tid >> 2)) * 32 + g * 16 + (tid & 3) * 4;
        const f32x4 vdt = *(const f32x4*)(WS_DTA(p) + o), vac = *(const f32x4*)(WS_ACS(p) + o);
        u32x4 bt[4];
#pragma unroll
        for (int k = 0; k < 4; ++k) { const int idx = tid + k * 512; bt[k] = *(const u32x4*)(btp + (idx >> 4) * 128 + (idx & 15) * 8); }
        *(f32x4*)(sDt + (tid >> 2) * 16 + (tid & 3) * 4) = vdt; *(f32x4*)(sAcs + (tid >> 2) * 16 + (tid & 3) * 4) = vac;
#pragma unroll
        for (int k = 0; k < 4; ++k) { const int idx = tid + k * 512; *(u32x4*)(sBT + (idx >> 4) * 136 + (idx & 15) * 8) = bt[k]; }
    }
    u32x4 xr[2];
#pragma unroll
    for (int k = 0; k < 2; ++k) { const int idx = tid + k * 512; xr[k] = *(const u32x4*)(xt + (size_t)hh0 * 8192 + (idx >> 4) * 128 + (idx & 15) * 8); }
    lds_barrier();
#pragma unroll
    for (int k = 0; k < 4; ++k) { const int idx = tid + k * 512, jj = idx >> 4, col = idx & 15; const float al = (col & 1) == 0 ? sAcs[127 * 16 + col] : sAcs[col]; sWg[col * 128 + jj] = __expf(al - sAcs[jj * 16 + col]) * sDt[jj * 16 + col]; }
#pragma unroll 1
    for (int hh = hh0; hh < hh0 + 4; ++hh) {
        const int h = g * 8 + hh;
        u32x4 xn[2] = {xr[0], xr[1]};
        if (hh < hh0 + 3) {
#pragma unroll
            for (int k = 0; k < 2; ++k) { const int idx = tid + k * 512; xn[k] = *(const u32x4*)(xt + (size_t)(hh + 1) * 8192 + (idx >> 4) * 128 + (idx & 15) * 8); }
        }
        lds_barrier();
#pragma unroll
        for (int k = 0; k < 2; ++k) {
            const int idx = tid + k * 512, pp = idx >> 4, j8 = (idx & 15) * 8;
            const f32x8 xv = unpack8(xr[k]);
#pragma unroll
            for (int d = 0; d < 2; ++d) {
                const f32x4 w0 = *(const f32x4*)(sWg + (hh * 2 + d) * 128 + j8), w1 = *(const f32x4*)(sWg + (hh * 2 + d) * 128 + j8 + 4);
                f32x8 o;
                o[0] = xv[0] * w0.x; o[1] = xv[1] * w0.y; o[2] = xv[2] * w0.z; o[3] = xv[3] * w0.w; o[4] = xv[4] * w1.x; o[5] = xv[5] * w1.y; o[6] = xv[6] * w1.z; o[7] = xv[7] * w1.w;
                *(u32x4*)(sXw + d * 8704 + pp * 136 + j8) = pack8(o);
            }
        }
        lds_barrier();
        const int mi = wave & 1, nj = wave >> 1;
#pragma unroll
        for (int d = 0; d < 2; ++d) {
            f32x16 acc;
#pragma unroll
            for (int r = 0; r < 16; ++r) acc[r] = 0.f;
            mm32<128>(acc, sXw + d * 8704 + mi * 32 * 136, 136, sBT + nj * 32 * 136, 136, lane);
#pragma unroll
            for (int r = 0; r < 16; ++r) sO[d * 8704 + (mi * 32 + rowmap32(r, lane)) * 136 + nj * 32 + (lane & 31)] = f2bf(acc[r]);
        }
        lds_barrier();
#pragma unroll
        for (int d = 0; d < 2; ++d) {
            bf16_t* base = WS_ST(p) + ((size_t)((b * 2 + d) * 18 + c) * 16 + h) * 8192;
#pragma unroll
            for (int k = 0; k < 2; ++k) { const int idx = tid + k * 512; *(u32x4*)(base + idx * 8) = *(const u32x4*)(sO + d * 8704 + (idx >> 4) * 136 + (idx & 15) * 8); }
        }
        xr[0] = xn[0]; xr[1] = xn[1];
    }
}
__device__ __forceinline__ void ssd_recur_item(const Params& p, int item) {
    const int tid = tidx();
    const int d = item & 1, h = (item >> 1) & 15, b = item >> 5;
    u32x4 s0[NCH], s1[NCH]; float ev[NCH];
#pragma unroll
    for (int pos = 0; pos < NCH; ++pos) {
        const int c = chunk_at(d, pos);
        const bf16_t* ptr = WS_ST(p) + ((size_t)((b * 2 + d) * 18 + c) * 16 + h) * 8192 + tid * 16;
        s0[pos] = *(const u32x4*)ptr; s1[pos] = *(const u32x4*)(ptr + 8);
        ev[pos] = WS_AL(p)[((b * 2 + d) * 18 + c) * 16 + h];
    }
    f32x8 h0, h1;
#pragma unroll
    for (int e = 0; e < 8; ++e) { h0[e] = 0.f; h1[e] = 0.f; }
#pragma unroll
    for (int pos = 0; pos < NCH; ++pos) {
        const int c = chunk_at(d, pos);
        bf16_t* ptr = WS_ST(p) + ((size_t)((b * 2 + d) * 18 + c) * 16 + h) * 8192 + tid * 16;
        *(u32x4*)ptr = pack8(h0); *(u32x4*)(ptr + 8) = pack8(h1);
        const float e = __expf(ev[pos]);
        h0 = h0 * e + unpack8(s0[pos]); h1 = h1 * e + unpack8(s1[pos]);
    }
}
template <int MODE>
__device__ __forceinline__ void ssd_final_item(const Params& p, int l, int item, unsigned char* shm) {
    const int tid = tidx(), lane = tid & 63, wave = tid >> 6;
    const int g = item & 1, hh0 = ((item >> 1) & 1) * 4, bc = item >> 2, c = bc % NCH, b = bc / NCH, t0 = c * 128;
    const size_t tok0 = (size_t)b * TPB + t0;
    bf16_t* sC = (bf16_t*)shm; bf16_t* sBW = (bf16_t*)(shm + 34816); bf16_t* sXT = (bf16_t*)(shm + 69632); bf16_t* sH = (bf16_t*)(shm + 87040);
    float* sDt = (float*)(shm + 104448); float* sAcs = (float*)(shm + 112640);
    bf16_t* sY = sBW;
    const bf16_t* xt = WS_SXT(p) + ((size_t)((b * 18 + c) * 16 + g * 8)) * 8192;
    const bf16_t* zt = WS_P(p) + tok0 * LDP + C_Z + g * 512;
    const bf16_t* hin0 = WS_ST(p) + ((size_t)((b * 2 + 0) * 18 + c) * 16 + g * 8) * 8192;
    const bf16_t* hin1 = WS_ST(p) + ((size_t)((b * 2 + 1) * 18 + c) * 16 + g * 8) * 8192;
    lds_barrier();
    u32x4 xr[2], zr[2], h0r[2];
    {
        const size_t o = ((size_t)(b * 18 + c) * 128 + (tid >> 2)) * 32 + g * 16 + (tid & 3) * 4;
        const f32x4 vdt = *(const f32x4*)(WS_DTA(p) + o), vac = *(const f32x4*)(WS_ACS(p) + o);
        u32x4 cr[4], br[4];
#pragma unroll
        for (int k = 0; k < 4; ++k) { const int idx = tid + k * 512; const bf16_t* s = WS_SBC(p) + (tok0 + (idx >> 4)) * 512 + g * 128 + (idx & 15) * 8; br[k] = *(const u32x4*)s; cr[k] = *(const u32x4*)(s + 256); }
#pragma unroll
        for (int k = 0; k < 2; ++k) {
            const int idx = tid + k * 512;
            xr[k] = *(const u32x4*)(xt + (size_t)hh0 * 8192 + (idx >> 4) * 128 + (idx & 15) * 8);
            zr[k] = *(const u32x4*)(zt + (size_t)(idx >> 3) * LDP + hh0 * 64 + (idx & 7) * 8);
            h0r[k] = *(const u32x4*)(hin0 + (size_t)hh0 * 8192 + idx * 8);
        }
        *(f32x4*)(sDt + (tid >> 2) * 16 + (tid & 3) * 4) = vdt; *(f32x4*)(sAcs + (tid >> 2) * 16 + (tid & 3) * 4) = vac;
#pragma unroll
        for (int k = 0; k < 4; ++k) { const int idx = tid + k * 512; *(u32x4*)(sC + (idx >> 4) * 136 + (idx & 15) * 8) = cr[k]; *(u32x4*)(sBW + (idx >> 4) * 136 + (idx & 15) * 8) = br[k]; }
    }
    lds_barrier();
    const int cmi = wave >> 1, cnj0 = (wave & 1) * 2;
    f32x16 cb0, cb1;
#pragma unroll
    for (int r = 0; r < 16; ++r) { cb0[r] = 0.f; cb1[r] = 0.f; }
    mm32<128>(cb0, sC + cmi * 32 * 136, 136, sBW + cnj0 * 32 * 136, 136, lane);
    mm32<128>(cb1, sC + cmi * 32 * 136, 136, sBW + (cnj0 + 1) * 32 * 136, 136, lane);
    const int ymi = wave & 3, ynj = wave >> 2;
#pragma unroll 1
    for (int hh = hh0; hh < hh0 + 4; ++hh) {
        const int h = g * 8 + hh;
        lds_barrier();
#pragma unroll
        for (int k = 0; k < 2; ++k) { const int idx = tid + k * 512; *(u32x4*)(sXT + (idx >> 4) * 136 + (idx & 15) * 8) = xr[k]; *(u32x4*)(sH + (idx >> 4) * 136 + (idx & 15) * 8) = h0r[k]; }
        u32x4 h1r[2];
#pragma unroll
        for (int k = 0; k < 2; ++k) h1r[k] = *(const u32x4*)(hin1 + (size_t)hh * 8192 + (tid + k * 512) * 8);
        f32x16 yacc;
#pragma unroll
        for (int r = 0; r < 16; ++r) yacc[r] = 0.f;
#pragma unroll 1
        for (int d = 0; d < 2; ++d) {
            const int col = hh * 2 + d;
            if (d == 1) {
                lds_barrier();
#pragma unroll
                for (int k = 0; k < 2; ++k) { const int idx = tid + k * 512; *(u32x4*)(sH + (idx >> 4) * 136 + (idx & 15) * 8) = h1r[k]; }
            }
            if (MODE < 2) {
                float aci[16];
#pragma unroll
                for (int r = 0; r < 16; ++r) aci[r] = sAcs[(cmi * 32 + rowmap32(r, lane)) * 16 + col];
#pragma unroll
                for (int tt = 0; tt < 2; ++tt) {
                    const int jg = (cnj0 + tt) * 32 + (lane & 31);
                    const float acj = sAcs[jg * 16 + col], dtj = sDt[jg * 16 + col];
                    const int dj0 = jg - cmi * 32 - 4 * (lane >> 5), dj = d == 0 ? dj0 : -dj0;
#pragma unroll
                    for (int r = 0; r < 16; ++r) {
                        const int ro = (r & 3) + 8 * (r >> 2);
                        const int sd = d == 0 ? dj - ro : dj + ro;
                        float arg = aci[r] - acj; arg = sd <= 0 ? arg : -INFINITY;
                        const float cbv = tt == 0 ? cb0[r] : cb1[r];
                        sBW[(cmi * 32 + rowmap32(r, lane)) * 136 + jg] = f2bf(cbv * __expf(arg) * dtj);
                    }
                }
            }
            lds_barrier();
            f32x16 ad, ao;
#pragma unroll
            for (int r = 0; r < 16; ++r) { ad[r] = 0.f; ao[r] = 0.f; }
            if (MODE < 3) { mm32<128>(ad, sBW + ymi * 32 * 136, 136, sXT + ynj * 32 * 136, 136, lane);
            mm32<128>(ao, sC + ymi * 32 * 136, 136, sH + ynj * 32 * 136, 136, lane); }
#pragma unroll
            for (int r = 0; r < 16; ++r) { const int ig = ymi * 32 + rowmap32(r, lane); yacc[r] += ad[r] + __expf(sAcs[ig * 16 + col]) * ao[r]; }
            if (d == 0 && hh < hh0 + 3) {
#pragma unroll
                for (int k = 0; k < 2; ++k) {
                    const int idx = tid + k * 512;
                    xr[k] = *(const u32x4*)(xt + (size_t)(hh + 1) * 8192 + (idx >> 4) * 128 + (idx & 15) * 8);
                    h0r[k] = *(const u32x4*)(hin0 + (size_t)(hh + 1) * 8192 + idx * 8);
                }
            }
        }
        const float Dh = p.ssd_D[l * 16 + h];
        const int pl = ynj * 32 + (lane & 31);
#pragma unroll
        for (int r = 0; r < 16; ++r) { const int ig = ymi * 32 + rowmap32(r, lane); yacc[r] += Dh * bf2f(sXT[pl * 136 + ig]); }
        lds_barrier();
#pragma unroll
        for (int r = 0; r < 16; ++r) { const int ig = ymi * 32 + rowmap32(r, lane); sY[ig * 72 + pl] = f2bf(yacc[r]); }
        lds_barrier();
#pragma unroll
        for (int k = 0; k < 2; ++k) {
            const int idx = tid + k * 512, rr = idx >> 3, pk = idx & 7;
            const f32x8 yv = unpack8(*(const u32x4*)(sY + rr * 72 + pk * 8)), zv = unpack8(zr[k]);
            f32x8 o;
#pragma unroll
            for (int e = 0; e < 8; ++e) o[e] = yv[e] * siluf(zv[e]);
            if (MODE < 1) *(u32x4*)(WS_MIX(p) + (tok0 + rr) * MIXW + 2048 + h * 64 + pk * 8) = pack8(o); else asm volatile("" :: "v"(o[0]), "v"(o[7]));
        }
        if (hh < hh0 + 3) {
#pragma unroll
            for (int k = 0; k < 2; ++k) { const int idx = tid + k * 512; zr[k] = *(const u32x4*)(zt + (size_t)(idx >> 3) * LDP + (hh + 1) * 64 + (idx & 7) * 8); }
        }
    }
}
__device__ __forceinline__ void ssd_norm_phase(const Params& p, int l, int G) {
    const int lane = tidx() & 63, wave = tidx() >> 6;
    for (int row = blockIdx.x * 8 + wave; row < NTOK; row += G * 8) {
        bf16_t* rp = WS_MIX(p) + (size_t)row * MIXW + 2048;
        f32x8 v0 = unpack8(*(const u32x4*)(rp + lane * 8)), v1 = unpack8(*(const u32x4*)(rp + 512 + lane * 8));
        float ss = 0.f;
#pragma unroll
        for (int e = 0; e < 8; ++e) ss += v0[e] * v0[e] + v1[e] * v1[e];
        ss = wave_sum(ss);
        const float rstd = rsqrtf(ss * (1.f / 1024.f) + 1e-6f);
        const float* nw = p.ssd_norm_w + l * 1024;
#pragma unroll
        for (int e = 0; e < 8; ++e) { v0[e] = v0[e] * rstd * nw[lane * 8 + e]; v1[e] = v1[e] * rstd * nw[512 + lane * 8 + e]; }
        *(u32x4*)(rp + lane * 8) = pack8(v0); *(u32x4*)(rp + 512 + lane * 8) = pack8(v1);
    }
}

template <int MODE>
__device__ __forceinline__ void attn_item(const Params& p, int l, int item, unsigned char* shm) {
    const int tid = tidx(), lane = tid & 63, wave = tid >> 6, fr = lane & 15, fq = lane >> 4;
    const int hp = item & 3, bq = item >> 2, qblk = bq % NCH, b = bq / NCH, kh = hp >> 1;
    const bf16_t* P = WS_P(p);
    bf16_t* sK = (bf16_t*)shm; bf16_t* sVT = (bf16_t*)(shm + 34816); bf16_t* sPw = (bf16_t*)(shm + 69632) + wave * (2 * 16 * 136);
    const size_t tokq0 = (size_t)b * TPB + qblk * 128;
    bf16x8 aq[2][4];
#pragma unroll
    for (int hd = 0; hd < 2; ++hd)
#pragma unroll
        for (int kk = 0; kk < 4; ++kk) aq[hd][kk] = *(const bf16x8*)(P + (tokq0 + wave * 16 + fr) * LDP + C_Q + (hp * 2 + hd) * 128 + kk * 32 + 8 * fq);
    float m[2][4], ls[2][4]; f32x4 O[2][8];
#pragma unroll
    for (int hd = 0; hd < 2; ++hd) {
        const float sink = p.att_sink[l * 8 + hp * 2 + hd];
#pragma unroll
        for (int r = 0; r < 4; ++r) { m[hd][r] = sink; ls[hd][r] = 1.f; }
#pragma unroll
        for (int nd = 0; nd < 8; ++nd) O[hd][nd] = (f32x4){0.f, 0.f, 0.f, 0.f};
    }
    const int nlat = qblk - 2;
    const int kb_lo = nlat - 1 < 0 ? 0 : nlat - 1, kb_hi = nlat + 1 > 15 ? 15 : nlat + 1;
    const int ntl = qblk < 2 ? 2 : 2 + (kb_hi - kb_lo + 1);
    u32x4 kr[4], vr[4];
    const bf16_t* vtb = WS_VT(p) + ((size_t)(b * 18) * 2 + kh) * 16384;
    {
        const bf16_t* kbase = P + ((size_t)b * TPB) * LDP + C_K + kh * 128;
#pragma unroll
        for (int k = 0; k < 4; ++k) { const int idx = tid + k * 512; kr[k] = *(const u32x4*)(kbase + (size_t)(idx >> 4) * LDP + (idx & 15) * 8); vr[k] = *(const u32x4*)(vtb + idx * 8); }
    }
#pragma unroll 1
    for (int ti = 0; ti < ntl; ++ti) {
        const bool masked = ti >= 2; const int kb = kb_lo + (ti - 2);
        lds_barrier();
#pragma unroll
        for (int k = 0; k < 4; ++k) {
            const int idx = tid + k * 512;
            *(u32x4*)(sK + (idx >> 4) * 136 + (idx & 15) * 8) = kr[k];
            *(u32x4*)(sVT + (idx >> 4) * 136 + (idx & 15) * 8) = vr[k];
        }
        if (ti + 1 < ntl) {
            const int tn = ti + 1, t0n = tn < 2 ? tn * 128 : 256 + (kb_lo + (tn - 2)) * 128;
            const bf16_t* kbase = P + ((size_t)b * TPB + t0n) * LDP + C_K + kh * 128;
            const bf16_t* vtn = vtb + (size_t)(t0n >> 7) * 32768;
#pragma unroll
            for (int k = 0; k < 4; ++k) { const int idx = tid + k * 512; kr[k] = *(const u32x4*)(kbase + (size_t)(idx >> 4) * LDP + (idx & 15) * 8); vr[k] = *(const u32x4*)(vtn + idx * 8); }
        }
        lds_barrier();
#pragma unroll 1
        for (int hf = 0; hf < 2; ++hf) {
            f32x4 s[2][4];
#pragma unroll
            for (int nt = 0; nt < 4; ++nt) {
                s[0][nt] = (f32x4){0.f, 0.f, 0.f, 0.f}; s[1][nt] = (f32x4){0.f, 0.f, 0.f, 0.f};
#pragma unroll
                for (int kk = 0; kk < 4; ++kk) {
                    const bf16x8 bk = *(const bf16x8*)(sK + ((hf * 4 + nt) * 16 + fr) * 136 + kk * 32 + 8 * fq);
                    s[0][nt] = __builtin_amdgcn_mfma_f32_16x16x32_bf16(aq[0][kk], bk, s[0][nt], 0, 0, 0);
                    s[1][nt] = __builtin_amdgcn_mfma_f32_16x16x32_bf16(aq[1][kk], bk, s[1][nt], 0, 0, 0);
                }
                __builtin_amdgcn_sched_barrier(0);
            }
            if (masked) {
#pragma unroll
                for (int nt = 0; nt < 4; ++nt)
#pragma unroll
                    for (int r = 0; r < 4; ++r) { const int rel = (nlat * 128 + wave * 16 + fq * 4 + r) - (kb * 128 + (hf * 4 + nt) * 16 + fr); if (rel > 128 || rel < -128) { s[0][nt][r] = -INFINITY; s[1][nt][r] = -INFINITY; } }
            }
#pragma unroll
            for (int hd = 0; hd < 2; ++hd) {
                float alpha[4];
#pragma unroll
                for (int r = 0; r < 4; ++r) {
                    float mx = fmaxf(fmaxf(s[hd][0][r], s[hd][1][r]), fmaxf(s[hd][2][r], s[hd][3][r]));
                    mx = row16_max(mx);
                    const float mn = fmaxf(m[hd][r], mx);
                    alpha[r] = __expf(m[hd][r] - mn); m[hd][r] = mn;
                    float rs = 0.f;
#pragma unroll
                    for (int nt = 0; nt < 4; ++nt) { const float pv = __expf(s[hd][nt][r] - mn); s[hd][nt][r] = pv; rs += pv; }
                    rs = row16_sum(rs);
                    ls[hd][r] = ls[hd][r] * alpha[r] + rs;
                }
#pragma unroll
                for (int nd = 0; nd < 8; ++nd) { O[hd][nd].x *= alpha[0]; O[hd][nd].y *= alpha[1]; O[hd][nd].z *= alpha[2]; O[hd][nd].w *= alpha[3]; }
#pragma unroll
                for (int nt = 0; nt < 4; ++nt)
#pragma unroll
                    for (int r = 0; r < 4; ++r) sPw[hd * (16 * 136) + (fq * 4 + r) * 136 + nt * 16 + fr] = f2bf(s[hd][nt][r]);
            }
            asm volatile("s_waitcnt lgkmcnt(0)" ::: "memory");
#pragma unroll
            for (int kk = 0; kk < 2; ++kk) {
                const bf16x8 ap0 = *(const bf16x8*)(sPw + fr * 136 + kk * 32 + 8 * fq);
                const bf16x8 ap1 = *(const bf16x8*)(sPw + 16 * 136 + fr * 136 + kk * 32 + 8 * fq);
#pragma unroll
                for (int nd = 0; nd < 8; ++nd) {
                    const bf16x8 bv = *(const bf16x8*)(sVT + (nd * 16 + fr) * 136 + hf * 64 + kk * 32 + 8 * fq);
                    O[0][nd] = __builtin_amdgcn_mfma_f32_16x16x32_bf16(ap0, bv, O[0][nd], 0, 0, 0);
                    O[1][nd] = __builtin_amdgcn_mfma_f32_16x16x32_bf16(ap1, bv, O[1][nd], 0, 0, 0);
                    if (nd == 3) __builtin_amdgcn_sched_barrier(0);
                }
                __builtin_amdgcn_sched_barrier(0);
            }
            asm volatile("s_waitcnt lgkmcnt(0)" ::: "memory");
        }
    }
#pragma unroll
    for (int hd = 0; hd < 2; ++hd) {
        const int hq = hp * 2 + hd;
        u32x4 agr[4];
#pragma unroll
        for (int k = 0; k < 4; ++k) { const int idx = tid + k * 512; agr[k] = *(const u32x4*)(P + (tokq0 + (idx >> 4)) * LDP + C_AG + hq * 128 + (idx & 15) * 8); }
        lds_barrier();
#pragma unroll
        for (int r = 0; r < 4; ++r) {
            const float il = __builtin_amdgcn_rcpf(ls[hd][r]);
#pragma unroll
            for (int nd = 0; nd < 8; ++nd) sK[(wave * 16 + fq * 4 + r) * 136 + nd * 16 + fr] = f2bf(O[hd][nd][r] * il);
        }
        lds_barrier();
#pragma unroll
        for (int k = 0; k < 4; ++k) {
            const int idx = tid + k * 512, rr = idx >> 4, ck = idx & 15;
            const f32x8 ov = unpack8(*(const u32x4*)(sK + rr * 136 + ck * 8)), gv = unpack8(agr[k]);
            f32x8 o;
#pragma unroll
            for (int e = 0; e < 8; ++e) o[e] = ov[e] * siluf(gv[e]);
            *(u32x4*)(WS_MIX(p) + (tokq0 + rr) * MIXW + 1024 + hq * 128 + ck * 8) = pack8(o);
        }
    }
}

#define XB_TMO      128
#define XB_XCNT(j)  (256  + 64 * (j))
#define XB_XSUB(j)  (1280 + 64 * (j))
#define XB_XGEN(j)  (2304 + 64 * (j))
#define XB_TOP      3328
#define XB_TOPGEN   3392
#define XCD_BAR_WORDS 3456
#define XB_SPIN_CAP (1u << 18)
#define LAS __attribute__((address_space(3)))
__device__ __forceinline__ unsigned xb_ld(unsigned* p)              { return __hip_atomic_load(p, __ATOMIC_RELAXED, __HIP_MEMORY_SCOPE_AGENT); }
__device__ __forceinline__ unsigned xb_add(unsigned* p, unsigned v) { return __hip_atomic_fetch_add(p, v, __ATOMIC_RELAXED, __HIP_MEMORY_SCOPE_AGENT); }
__device__ __forceinline__ unsigned xb_xcc_id() { return (unsigned)__builtin_amdgcn_s_getreg((3 << 11) | 20) & 0xFu; }
#define XB_SPIN(cond, bar) do { unsigned _sp = 0; while (cond) { __builtin_amdgcn_s_sleep(1); \
    if ((++_sp & 255u) == 0u) { if (xb_ld(&(bar)[XB_TMO])) break; if (_sp > XB_SPIN_CAP) { atomicAdd(&(bar)[XB_TMO], 1u); break; } } } } while (0)
struct XcdBarrier { unsigned* bar; unsigned x; volatile LAS unsigned* st; };
__device__ __forceinline__ XcdBarrier xcd_barrier_post(unsigned* bar, volatile LAS unsigned* st) {
    XcdBarrier b; b.bar = bar; b.x = xb_xcc_id(); b.st = st;
    if (tidx() == 0) (void)xb_add(&bar[XB_XCNT(b.x)], 1u);
    return b;
}
__device__ __forceinline__ void xcd_barrier_complete(unsigned* bar, unsigned x, unsigned& nloc, unsigned& nx) {
    const unsigned G = gridDim.x * gridDim.y * gridDim.z;
    unsigned sum, cnt, mine, sp = 0u;
    for (;;) {
        sum = 0u; cnt = 0u; mine = 0u;
#pragma unroll
        for (unsigned j = 0; j < 16; ++j) { const unsigned c = xb_ld(&bar[XB_XCNT(j)]); sum += c; cnt += (c > 0u) ? 1u : 0u; mine = (j == x) ? c : mine; }
        if (sum == G) break;
        __builtin_amdgcn_s_sleep(1);
        if ((++sp & 255u) == 0u) { if (xb_ld(&bar[XB_TMO])) break; if (sp > XB_SPIN_CAP) { atomicAdd(&bar[XB_TMO], 1u); break; } }
    }
    nloc = mine > 0u ? mine : 1u; nx = cnt > 0u ? cnt : 1u;
}
__device__ __forceinline__ void xcd_barrier(const XcdBarrier& b) {
    asm volatile("s_waitcnt vmcnt(0)" ::: "memory");
    __syncthreads();
    if (tidx() == 0) {
        unsigned* bar = b.bar;
        __builtin_amdgcn_s_waitcnt(0);
        unsigned nloc = b.st[0], nx = b.st[1];
        if (nloc == 0u) { xcd_barrier_complete(bar, b.x, nloc, nx); b.st[0] = nloc; b.st[1] = nx; }
        const unsigned old = xb_add(&bar[XB_XSUB(b.x)], 1u);
        const unsigned gen = old / nloc;
        if (old + 1u == (gen + 1u) * nloc) {
            __builtin_amdgcn_fence(__ATOMIC_RELEASE, "agent");
            asm volatile("s_waitcnt vmcnt(0)" ::: "memory");
            const unsigned og = xb_add(&bar[XB_TOP], 1u);
            const unsigned tg = og / nx;
            if (og + 1u == (tg + 1u) * nx) xb_add(&bar[XB_TOPGEN], 1u);
            else XB_SPIN(xb_ld(&bar[XB_TOPGEN]) == tg, bar);
            __builtin_amdgcn_fence(__ATOMIC_ACQUIRE, "agent");
            xb_add(&bar[XB_XGEN(b.x)], 1u);
            asm volatile("s_waitcnt vmcnt(0)" ::: "memory");
        } else {
            XB_SPIN(xb_ld(&bar[XB_XGEN(b.x)]) == gen, bar);
            __builtin_amdgcn_fence(__ATOMIC_ACQUIRE, "agent");
            asm volatile("s_waitcnt vmcnt(0)" ::: "memory");
        }
    }
    __syncthreads();
}


#define QUEUE_LOOP(ctr, NITEMS, BODY) do { \
    volatile LAS unsigned* _mb = (volatile LAS unsigned*)(shm + LDS_CTL + 8); \
    int it = bid; \
    while (it < (NITEMS)) { \
        unsigned _nx = 0u; if (tidx() == 0) _nx = xb_add((ctr), 1u) + (unsigned)G; \
        BODY; \
        __syncthreads(); \
        if (tidx() == 0) _mb[0] = _nx; \
        __syncthreads(); \
        it = (int)_mb[0]; \
    } } while (0)

__global__ __launch_bounds__(512) void mega(Params p) {
    extern __shared__ __attribute__((aligned(16))) unsigned char shm[];
    cg::grid_group grid = cg::this_grid();
    const int G = (int)gridDim.x, bid = (int)blockIdx.x;
    if (tidx() < 4) ((volatile LAS unsigned*)(shm + LDS_CTL))[tidx()] = 0u;
    __syncthreads();
    unsigned* qctr = (unsigned*)(p.ws + OFF_BAR) + 3584;
    const XcdBarrier xb = xcd_barrier_post((unsigned*)(p.ws + OFF_BAR), (volatile LAS unsigned*)(shm + LDS_CTL));
    for (int rep = 0; rep < 1 + DUP_P0; ++rep) phase0(p, shm, G);
    grid.sync();
#pragma unroll 1
    for (int l = 0; l < 4; ++l) {
        for (int rep = 0; rep < 1 + DUP_NORM; ++rep) norm_phase(p, l, G);
        xcd_barrier(xb);
        {
            pg8::Gemm g{WS_U(p), WS_WTIN(p) + (size_t)l * 7424 * 2048, NTOK, 7168, 2048};
            pg8::Order S; S.init(72, 28, G, bid, 0);
            EpiG1 E{WS_P(p)};
            for (int rep = 0; rep < 1 + DUP_G1; ++rep) pg8::gemm_phase<EpiG1, pg8::Order>((PG8_LAS unsigned char*)shm, g, S, E);
            {
                const int tq = tidx(), wave = tq >> 6, lane = tq & 63, fr = lane & 15, fq = lane >> 4;
                for (int wu = bid * 8 + wave; wu < NTOK / 16; wu += G * 8) {
                    const bf16_t* ap = WS_U(p) + (size_t)(wu * 16 + fr) * 2048 + 8 * fq;
                    const bf16_t* bp = WS_WTIN(p) + ((size_t)l * 7424 + 7168 + fr) * 2048 + 8 * fq;
                    f32x4 acc = (f32x4){0.f, 0.f, 0.f, 0.f};
#pragma unroll 8
                    for (int kk = 0; kk < 64; ++kk) { const bf16x8 a = *(const bf16x8*)(ap + kk * 32), bq = *(const bf16x8*)(bp + kk * 32); acc = __builtin_amdgcn_mfma_f32_16x16x32_bf16(a, bq, acc, 0, 0, 0); }
#pragma unroll
                    for (int r = 0; r < 4; ++r) WS_DTP(p)[(size_t)(wu * 16 + fq * 4 + r) * 16 + fr] = acc[r];
                }
            }
        }
        for (int rep = 0; rep < 1 + DUP_SYNC; ++rep) xcd_barrier(xb);
        for (int rep = 0; rep < 1 + DUP_E1; ++rep) {
            if (rep == 0 || E1SEL == 0 || E1SEL == 1) for (int it = bid; it < 144; it += G) prep_dt_item(p, l, it);
            if (rep == 0 || E1SEL == 0 || E1SEL == 2) { __syncthreads(); prep_tiles(p, l, bid, G, shm); }
            if (rep == 0 || E1SEL == 0 || E1SEL == 3) prep_elem(p, l, G);
        }
        { const int tq = tidx(), wave = tq >> 6, lane = tq & 63; for (int row = bid * 8 + wave; row < NTOK; row += G * 8) qkprep_row<0>(p, l, row, lane);
#if DUP_QK
          for (int row = bid * 8 + wave; row < NTOK; row += G * 8) qkprep_row<1>(p, l, row, lane);
#endif
        }
        xcd_barrier(xb);
        QUEUE_LOOP(qctr + (l * 3 + 0) * 64, 128 + 576, { if (it < 128) lru_sweep_item<0>(p, l, it, shm); else ssd_states_item(p, l, it - 128, shm); });
#if DUP_X1Q
        __syncthreads(); QUEUE_LOOP(qctr + (12 + l * 3 + 0) * 64, 128 + 576, { if (it < 128) lru_sweep_item<0>(p, l, it, shm); else ssd_states_item(p, l, it - 128, shm); });
#endif
#if DUP_SWEEP
        __syncthreads(); for (int it = bid; it < 128; it += G) lru_sweep_item<0>(p, l, it, shm);
#endif
#if DUP_STATES
        __syncthreads(); for (int it = bid; it < 256; it += G) ssd_states_item(p, l, it, shm);
#endif
        xcd_barrier(xb);
        QUEUE_LOOP(qctr + (l * 3 + 1) * 64, 256 + 576, { if (it < 256) ssd_recur_item(p, it); else attn_item<0>(p, l, it - 256, shm); });
#if DUP_ATTQ
        __syncthreads(); QUEUE_LOOP(qctr + (12 + l * 3 + 1) * 64, 576, { attn_item<AMODE>(p, l, it, shm); });
#endif
        xcd_barrier(xb);
        QUEUE_LOOP(qctr + (l * 3 + 2) * 64, 128 + 576, { if (it < 128) lru_sweep_item<1>(p, l, it, shm); else ssd_final_item<0>(p, l, it - 128, shm); });
#if DUP_FINAL
        __syncthreads(); for (int it = bid; it < 256; it += G) ssd_final_item<FMODE>(p, l, it, shm);
#endif
#if DUP_SWEEP1
        __syncthreads(); for (int it = bid; it < 128; it += G) lru_sweep_item<1, 1>(p, l, it, shm);
#endif
        xcd_barrier(xb);
#ifndef SK_X4
        ssd_norm_phase(p, l, G);
#endif
        xcd_barrier(xb);
        {
            pg8::Gemm g{WS_MIX(p), WS_WTOUT(p) + (size_t)l * 2048 * 3072, NTOK, 2048, 3072};
            pg8::Order S; S.init(l == 3 ? 64 : 72, 8, G, bid, l == 3 ? 1 : 0);
            EpiG2 E{p, l, 0};
#if DUP_G2
            { EpiG2 E2{p, l, 1}; pg8::gemm_phase<EpiG2, pg8::Order>((PG8_LAS unsigned char*)shm, g, S, E2); }
#endif
#ifndef SK_G2
            pg8::gemm_phase<EpiG2, pg8::Order>((PG8_LAS unsigned char*)shm, g, S, E);
#endif
        }
        if (l < 3) xcd_barrier(xb);
    }
}

extern "C" void kernel_launch(void* const* d_in, const int* in_sizes, int n_in, void* d_out, int out_size, void* d_ws, size_t ws_size, hipStream_t stream) {
    static int grid = 0;
    if (grid == 0) {
        if (n_in != 25 || ws_size < WS_END) { fprintf(stderr, "kernel_launch: need 25 inputs and %zu bytes of workspace (got %d, %zu)\n", (size_t)WS_END, n_in, ws_size); grid = -1; return; }
        int dev = 0, cus = 0, per_cu = 0;
        hipGetDevice(&dev);
        hipDeviceGetAttribute(&cus, hipDeviceAttributeMultiprocessorCount, dev);
        if (hipFuncSetAttribute((const void*)mega, hipFuncAttributeMaxDynamicSharedMemorySize, LDS_BYTES) != hipSuccess) { fprintf(stderr, "kernel_launch: hipFuncSetAttribute failed\n"); grid = -1; return; }
        if (hipOccupancyMaxActiveBlocksPerMultiprocessor(&per_cu, (const void*)mega, 512, LDS_BYTES) != hipSuccess || per_cu < 1) { fprintf(stderr, "kernel_launch: occupancy query gave %d\n", per_cu); per_cu = 1; }
        (void)hipGetLastError();
        grid = cus * 1;
        if (grid <= 0) grid = 256;
    }
    if (grid < 0) return;
    Params p{};
    const float** pf = (const float**)&p;
    for (int i = 0; i < 25; ++i) pf[i] = (const float*)d_in[i];
    p.out = (float*)d_out; p.ws = (unsigned char*)d_ws;
    if (hipMemsetAsync((char*)d_ws + OFF_BAR, 0, 32768, stream) != hipSuccess) { fprintf(stderr, "kernel_launch: memset of barrier words failed\n"); return; }
    void* args[] = {&p};
    hipError_t e = hipLaunchCooperativeKernel((const void*)mega, dim3(grid), dim3(512), args, LDS_BYTES, stream);
    if (e != hipSuccess) fprintf(stderr, "cooperative launch failed: %s (grid %d)\n", hipGetErrorString(e), grid);
}
```

```cpp
#include <hip/hip_runtime.h>
#include <hip/hip_cooperative_groups.h>
#include <cstdio>
#include <cstdint>
namespace cg = cooperative_groups;
#define DUP_X1A 0
#define DUP_X1B 0
#define DUP_ATT 0
#define DUP_X3A 0
#define DUP_X3B 0
#define DUP_G1 0
#define DUP_P0 0
#define DUP_NORM 0
#define DUP_SYNC 0
#define DUP_E1 0
#define DUP_SWEEP1 0
#define DUP_G2 0
#define DUP_QK 0
#define E1SEL 0
#define DUP_SWEEP 0
#define DUP_STATES 0
#define DUP_FINAL 0
#define AMODE 0
#define FMODE 0
#define DUP_X1Q 0
#define DUP_ATTQ 0
#define DUP_X3Q 0

__device__ __forceinline__ int tidx() { int t = (int)threadIdx.x; asm volatile("" : "+v"(t)); return t; }

namespace pg8 {
#define PG8_LAS __attribute__((address_space(3)))
typedef unsigned short bf16_t;
typedef short bf16x8 __attribute__((ext_vector_type(8)));
typedef float f32x4 __attribute__((ext_vector_type(4)));
typedef unsigned u32x4 __attribute__((ext_vector_type(4)));
constexpr int BM = 256, BK = 64, HALF = 128, HTB = HALF * BK * 2  , STAGE_BYTES = 8 * HTB, NXCD = 8, WGM = 8;

__host__ __device__ __forceinline__ int lds_byte(int r, int c) { const int st = (r >> 4) * 2 + (c >> 5), rr = r & 15, cc = c & 31, ob = rr * 64 + cc * 2; return st * 1024 + (ob ^ (((ob >> 9) & 1) << 5)); }
__host__ __device__ __forceinline__ void stage_rc(int b, int& R, int& C) { const int st = b / 1024, sb = b % 1024, swz = sb ^ (((sb >> 9) & 1) << 5); R = (st >> 1) * 16 + swz / 64; C = (st & 1) * 32 + (swz % 64) / 2; }
__host__ __device__ __forceinline__ int perm32(int rho) { const int n = rho >> 4, i = rho & 15; return 8 * (i >> 2) + 4 * n + (i & 3); }

struct Unit { int pm, pn; };
struct Gemm { const bf16_t* A; const bf16_t* Bt; int M, N, K; };

struct Order {
    int nM, nN, nwg, G, c, skipctx;
    __device__ void init(int nM_, int nN_, int G_, int c_, int skip_) { nM = nM_; nN = nN_; nwg = nM * nN; G = G_; c = c_; skipctx = skip_; }
    __device__ bool next(int i, Unit& u) const {
        const long L = (long)i * G + c; if (L >= nwg) return false;
        int wgid = (int)L; { const int q = nwg / NXCD, r = nwg % NXCD, xcd = wgid % NXCD, off = wgid / NXCD; wgid = (xcd < r ? xcd * (q + 1) : r * (q + 1) + (xcd - r) * q) + off; }
        const int nig = WGM * nN, gid = wgid / nig, fm = gid * WGM, gsz = (nM - fm) < WGM ? (nM - fm) : WGM;
        int pm = fm + ((wgid % nig) % gsz); u.pn = (wgid % nig) / gsz;
        if (skipctx) pm = (pm >> 3) * 9 + 1 + (pm & 7);
        u.pm = pm; return true;
    }
    __device__ __forceinline__ void a_ready(const Unit&) const {}
    __device__ __forceinline__ void done(const Unit&) const {}
};
typedef __bf16 bf16x2_t __attribute__((ext_vector_type(2)));
typedef float f32x2_t __attribute__((ext_vector_type(2)));
__device__ __forceinline__ unsigned cvt_pk_bf16(float lo, float hi) { f32x2_t v = {lo, hi}; bf16x2_t b = __builtin_convertvector(v, bf16x2_t); return __builtin_bit_cast(unsigned, b); }

template <class Epi, class Sched>
__device__ __forceinline__ void gemm_phase(PG8_LAS unsigned char* lds, const Gemm g, const Sched& S, const Epi& E) {
    const int tid = tidx(), wid = __builtin_amdgcn_readfirstlane(tid >> 6), lane = tid & 63, wr = wid >> 2, wc = wid & 3, fr = lane & 15, fq = lane >> 4;
    const int K = g.K, nt = K / BK;
    unsigned voffA[2], voffB[2];
#pragma unroll
    for (int i = 0; i < 2; ++i) { int R, C; stage_rc(tid * 16 + i * 8192, R, C); const int Rb = Epi::PERM ? ((R & ~31) + perm32(R & 31)) : R;
        voffA[i] = (unsigned)(R * K + C) * 2u; voffB[i] = (unsigned)(Rb * K + C) * 2u; }
    const size_t kstep = (size_t)(BK * 2);
    const size_t hstep = (size_t)HALF * K * 2;
    const size_t tstep = 2 * hstep;
    const unsigned ldsw = (unsigned)wid * 1024u;
    const int aoff = lds_byte(wr * 64 + fr, fq * 8), boff = lds_byte(wc * 32 + fr, fq * 8);
#define PG8_SA(b, h) (((b) * 2 + (h)) * HTB)
#define PG8_SB(b, h) ((4 + (b) * 2 + (h)) * HTB)
#define PG8_STAGE(bufoff, gbase, voff) do { _Pragma("unroll") for (int _i = 0; _i < 2; ++_i) \
        __builtin_amdgcn_global_load_lds((const unsigned*)((const char*)(gbase) + (voff)[_i]), (PG8_LAS unsigned*)(lds + (bufoff) + ldsw + _i * 8192), 16, 0, 0); } while (0)
#define PG8_LDA(dst, b, h) do { _Pragma("unroll") for (int m = 0; m < 4; ++m) _Pragma("unroll") for (int k = 0; k < 2; ++k) dst[m][k] = *(const PG8_LAS bf16x8*)(lds + PG8_SA(b, h) + aoff + m * 2048 + k * 1024); } while (0)
#define PG8_LDB(dst, b, h) do { _Pragma("unroll") for (int n = 0; n < 2; ++n) _Pragma("unroll") for (int k = 0; k < 2; ++k) dst[n][k] = *(const PG8_LAS bf16x8*)(lds + PG8_SB(b, h) + boff + n * 2048 + k * 1024); } while (0)
#define PG8_MMA(ai, bj, At, Bt) do { __builtin_amdgcn_s_setprio(1); _Pragma("unroll") for (int m = 0; m < 4; ++m) _Pragma("unroll") for (int n = 0; n < 2; ++n) _Pragma("unroll") for (int k = 0; k < 2; ++k) \
        acc[ai][bj][m][n] = __builtin_amdgcn_mfma_f32_16x16x32_bf16(Bt[n][k], At[m][k], acc[ai][bj][m][n], 0, 0, 0); __builtin_amdgcn_s_setprio(0); } while (0)
#define PG8_WAIT_V(n) asm volatile("s_waitcnt vmcnt(" #n ")" ::: "memory")
#define PG8_WAIT_L(n) asm volatile("s_waitcnt lgkmcnt(" #n ")" ::: "memory")
#define PG8_BAR __builtin_amdgcn_s_barrier()
#define PG8_SCHED __builtin_amdgcn_sched_barrier(0)
    Unit cur, nxt; int ui = 0;
    if (!S.next(0, cur)) return;
    f32x4 acc[2][2][4][2];
#pragma unroll
    for (int a = 0; a < 2; ++a)
#pragma unroll
        for (int b = 0; b < 2; ++b)
#pragma unroll
            for (int m = 0; m < 4; ++m)
#pragma unroll
                for (int n = 0; n < 2; ++n) acc[a][b][m][n] = (f32x4){0.f, 0.f, 0.f, 0.f};
    bf16x8 At[4][2], B0[2][2], B1[2][2];
    const char* cA = (const char*)g.A + (size_t)cur.pm * tstep; const char* cB = (const char*)g.Bt + (size_t)cur.pn * tstep;
    S.a_ready(cur);
    PG8_STAGE(PG8_SB(0, 0), cB, voffB); PG8_STAGE(PG8_SA(0, 0), cA, voffA); PG8_STAGE(PG8_SB(0, 1), cB + hstep, voffB); PG8_STAGE(PG8_SA(0, 1), cA + hstep, voffA);
    if (wr == 1) PG8_BAR;
    PG8_WAIT_V(4); PG8_BAR;
    PG8_STAGE(PG8_SB(1, 0), cB + kstep, voffB); PG8_STAGE(PG8_SA(1, 0), cA + kstep, voffA); PG8_STAGE(PG8_SB(1, 1), cB + hstep + kstep, voffB);
    PG8_WAIT_V(6); PG8_BAR;
    for (;;) {
        const bool has_next = S.next(ui + 1, nxt);
        const char* nA = has_next ? (const char*)g.A + (size_t)nxt.pm * tstep : cA; const char* nB = has_next ? (const char*)g.Bt + (size_t)nxt.pn * tstep : cB;
        for (int t = 0; t < nt; t += 2) {
            const bool last = (t == nt - 2);
            const char* a1 = cA + (size_t)(t + 1) * kstep;
            const char* a2 = last ? nA : cA + (size_t)(t + 2) * kstep; const char* b2 = last ? nB : cB + (size_t)(t + 2) * kstep;
            const char* a3 = a2 + kstep; const char* b3 = b2 + kstep;
            if (last && has_next) S.a_ready(nxt);
            PG8_LDB(B0, 0, 0); PG8_SCHED; PG8_LDA(At, 0, 0); PG8_STAGE(PG8_SA(1, 1), a1 + hstep, voffA);
            PG8_WAIT_L(8); PG8_BAR; PG8_WAIT_L(0); PG8_MMA(0, 0, At, B0); PG8_BAR; PG8_SCHED;
            PG8_LDB(B1, 0, 1); PG8_STAGE(PG8_SB(0, 0), b2, voffB);
            PG8_BAR; PG8_WAIT_L(0); PG8_MMA(0, 1, At, B1); PG8_BAR;
            PG8_LDA(At, 0, 1); PG8_STAGE(PG8_SA(0, 0), a2, voffA);
            PG8_BAR; PG8_WAIT_L(0); PG8_MMA(1, 0, At, B0); PG8_BAR; PG8_SCHED;
            PG8_STAGE(PG8_SB(0, 1), b2 + hstep, voffB);
            PG8_WAIT_V(6); PG8_BAR; PG8_MMA(1, 1, At, B1); PG8_BAR;
            PG8_LDB(B0, 1, 0); PG8_SCHED; PG8_LDA(At, 1, 0); PG8_STAGE(PG8_SA(0, 1), a2 + hstep, voffA);
            PG8_WAIT_L(8); PG8_BAR; PG8_WAIT_L(0); PG8_MMA(0, 0, At, B0); PG8_BAR; PG8_SCHED;
            PG8_LDB(B1, 1, 1); PG8_STAGE(PG8_SB(1, 0), b3, voffB);
            PG8_BAR; PG8_WAIT_L(0); PG8_MMA(0, 1, At, B1); PG8_BAR;
            PG8_LDA(At, 1, 1); PG8_STAGE(PG8_SA(1, 0), a3, voffA);
            PG8_BAR; PG8_WAIT_L(0); PG8_MMA(1, 0, At, B0); PG8_BAR; PG8_SCHED;
            PG8_STAGE(PG8_SB(1, 1), b3 + hstep, voffB);
            PG8_WAIT_V(6); PG8_BAR; PG8_MMA(1, 1, At, B1); PG8_BAR;
        }
        if constexpr (!Epi::AFTER_DRAIN) { E(acc, cur, wr, wc, fr, fq); S.done(cur); }
        if (!has_next) break;
#pragma unroll
        for (int a = 0; a < 2; ++a)
#pragma unroll
            for (int b = 0; b < 2; ++b)
#pragma unroll
                for (int m = 0; m < 4; ++m)
#pragma unroll
                    for (int n = 0; n < 2; ++n) acc[a][b][m][n] = (f32x4){0.f, 0.f, 0.f, 0.f};
        cur = nxt; cA = nA; cB = nB; ++ui;
    }
    PG8_WAIT_V(0);
    if (wr == 0) PG8_BAR;
    PG8_BAR;
    if constexpr (Epi::AFTER_DRAIN) { E.fused(acc, cur, wr, wc, fr, fq, lds, wid, lane); S.done(cur); }
#undef PG8_SA
#undef PG8_SB
#undef PG8_STAGE
#undef PG8_LDA
#undef PG8_LDB
#undef PG8_MMA
#undef PG8_WAIT_V
#undef PG8_WAIT_L
#undef PG8_BAR
#undef PG8_SCHED
}
}

using pg8::bf16_t; using pg8::bf16x8; using pg8::f32x4; using pg8::cvt_pk_bf16;
typedef float f32x16 __attribute__((ext_vector_type(16)));
typedef float f32x8 __attribute__((ext_vector_type(8)));
typedef unsigned u32x2 __attribute__((ext_vector_type(2)));
typedef unsigned u32x4 __attribute__((ext_vector_type(4)));

constexpr int DM = 2048, TPB = 2304, NTOK = 18432, LDP = 7424, MIXW = 3072, NCH = 18;
constexpr int C_LX = 0, C_LG = 1024, C_Q = 2048, C_K = 3072, C_V = 3328, C_AG = 3584, C_XBC = 4608, C_Z = 6144, C_DT = 7168;
constexpr size_t SZ_WTIN = (size_t)4 * 7424 * 2048 * 2, SZ_WTOUT = (size_t)4 * 2048 * 3072 * 2, SZ_MOD = (size_t)4 * 9 * 6144 * 4, SZ_U = (size_t)NTOK * 2048 * 2,
                 SZ_P = (size_t)NTOK * LDP * 2, SZ_MIX = (size_t)NTOK * MIXW * 2, SZ_XB = (size_t)NTOK * 2048 * 4, SZ_ST = (size_t)8 * 2 * 18 * 16 * 8192 * 2,
                 SZ_AL = (size_t)8 * 2 * 18 * 16 * 4, SZ_SUM = (size_t)8 * 2 * 18 * 1024 * 4;
constexpr size_t OFF_WTIN = 0, OFF_WTOUT = OFF_WTIN + SZ_WTIN, OFF_MOD = OFF_WTOUT + SZ_WTOUT, OFF_U = OFF_MOD + SZ_MOD, OFF_P = OFF_U + SZ_U, OFF_MIX = OFF_P + SZ_P,
                 OFF_XB = OFF_MIX + SZ_MIX, OFF_ST = OFF_XB + SZ_XB, OFF_AL = OFF_ST + SZ_ST, OFF_SUMA = OFF_AL + SZ_AL, OFF_SUMB = OFF_SUMA + SZ_SUM, OFF_BAR = OFF_SUMB + SZ_SUM, OFF_SBC = OFF_BAR + 32768, OFF_SBT = OFF_SBC + (size_t)NTOK * 512 * 2, OFF_DTA = OFF_SBT + (size_t)8 * 18 * 2 * 16384 * 2,
                 OFF_ACS = OFF_DTA + (size_t)NTOK * 32 * 4, OFF_HINL = OFF_ACS + (size_t)NTOK * 32 * 4, OFF_GW = OFF_HINL + SZ_SUM, OFF_DTP = OFF_GW + (size_t)4 * 16 * 16384 * 2, OFF_VT = OFF_DTP + (size_t)NTOK * 16 * 4, WS_END = OFF_VT + (size_t)8 * 18 * 2 * 16384 * 2;
constexpr size_t OFF_LXC = OFF_U, OFF_SXT = OFF_U + (size_t)NTOK * 1024 * 2;
constexpr int LDS_CTL = 147456;
constexpr int LDS_BYTES = LDS_CTL + 16;

struct Params {
    const float *x, *c, *ctx, *c_ctx, *norm_w, *ada_w, *ada_b, *w_in, *lru_conv_w, *lru_conv_b, *lru_ga_w, *lru_ga_b, *lru_gx_w, *lru_gx_b, *lru_lambda,
        *att_q_norm, *att_k_norm, *att_sink, *ssd_conv_w, *ssd_conv_b, *ssd_dt_bias, *ssd_A_log, *ssd_D, *ssd_norm_w, *w_out;
    float* out;
    unsigned char* ws;
};
#define WS_WTIN(p) ((bf16_t*)((p).ws + OFF_WTIN))
#define WS_WTOUT(p) ((bf16_t*)((p).ws + OFF_WTOUT))
#define WS_MOD(p) ((float*)((p).ws + OFF_MOD))
#define WS_U(p) ((bf16_t*)((p).ws + OFF_U))
#define WS_P(p) ((bf16_t*)((p).ws + OFF_P))
#define WS_MIX(p) ((bf16_t*)((p).ws + OFF_MIX))
#define WS_XB(p) ((float*)((p).ws + OFF_XB))
#define WS_ST(p) ((bf16_t*)((p).ws + OFF_ST))
#define WS_AL(p) ((float*)((p).ws + OFF_AL))
#define WS_SUMA(p) ((float*)((p).ws + OFF_SUMA))
#define WS_SUMB(p) ((float*)((p).ws + OFF_SUMB))
#define WS_LXC(p) ((bf16_t*)((p).ws + OFF_LXC))
#define WS_SXT(p) ((bf16_t*)((p).ws + OFF_SXT))
#define WS_SBC(p) ((bf16_t*)((p).ws + OFF_SBC))
#define WS_SBT(p) ((bf16_t*)((p).ws + OFF_SBT))
#define WS_DTA(p) ((float*)((p).ws + OFF_DTA))
#define WS_ACS(p) ((float*)((p).ws + OFF_ACS))
#define WS_HINL(p) ((float*)((p).ws + OFF_HINL))
#define WS_GW(p) ((bf16_t*)((p).ws + OFF_GW))
#define WS_DTP(p) ((float*)((p).ws + OFF_DTP))
#define WS_VT(p) ((bf16_t*)((p).ws + OFF_VT))

__device__ __forceinline__ float bf2f(bf16_t v) { return __uint_as_float(((unsigned)v) << 16); }
__device__ __forceinline__ bf16_t f2bf(float f) { return (bf16_t)(cvt_pk_bf16(f, 0.f) & 0xffffu); }
__device__ __forceinline__ float siluf(float v) { return v * __builtin_amdgcn_rcpf(1.f + __expf(-v)); }
__device__ __forceinline__ float sigmf(float v) { return __builtin_amdgcn_rcpf(1.f + __expf(-v)); }
__device__ __forceinline__ float softplusf(float v) { return v > 20.f ? v : log1pf(__expf(v)); }
__device__ __forceinline__ float wave_sum(float v) {
#pragma unroll
    for (int o = 1; o < 64; o <<= 1) v += __shfl_xor(v, o);
    return v;
}
__device__ __forceinline__ f32x8 unpack8(const u32x4 w) {
    f32x8 f;
    f[0] = __uint_as_float(w.x << 16); f[1] = __uint_as_float(w.x & 0xffff0000u); f[2] = __uint_as_float(w.y << 16); f[3] = __uint_as_float(w.y & 0xffff0000u);
    f[4] = __uint_as_float(w.z << 16); f[5] = __uint_as_float(w.z & 0xffff0000u); f[6] = __uint_as_float(w.w << 16); f[7] = __uint_as_float(w.w & 0xffff0000u);
    return f;
}
__device__ __forceinline__ u32x4 pack8(const f32x8 f) { u32x4 w; w.x = cvt_pk_bf16(f[0], f[1]); w.y = cvt_pk_bf16(f[2], f[3]); w.z = cvt_pk_bf16(f[4], f[5]); w.w = cvt_pk_bf16(f[6], f[7]); return w; }
__device__ __forceinline__ void lds_barrier() { asm volatile("s_waitcnt lgkmcnt(0)" ::: "memory"); __builtin_amdgcn_s_barrier(); asm volatile("" ::: "memory"); }
__device__ __forceinline__ float dpp_f(float v, int ctrl_sel) {
    const int x = __builtin_bit_cast(int, v); int r;
    if (ctrl_sel == 0) r = __builtin_amdgcn_update_dpp(x, x, 0xB1, 0xF, 0xF, false);
    else if (ctrl_sel == 1) r = __builtin_amdgcn_update_dpp(x, x, 0x4E, 0xF, 0xF, false);
    else if (ctrl_sel == 2) r = __builtin_amdgcn_update_dpp(x, x, 0x141, 0xF, 0xF, false);
    else r = __builtin_amdgcn_update_dpp(x, x, 0x140, 0xF, 0xF, false);
    return __builtin_bit_cast(float, r);
}
__device__ __forceinline__ float row16_max(float v) { v = fmaxf(v, dpp_f(v, 0)); v = fmaxf(v, dpp_f(v, 1)); v = fmaxf(v, dpp_f(v, 2)); v = fmaxf(v, dpp_f(v, 3)); return v; }
__device__ __forceinline__ float row16_sum(float v) { v += dpp_f(v, 0); v += dpp_f(v, 1); v += dpp_f(v, 2); v += dpp_f(v, 3); return v; }
__device__ __forceinline__ int chunk_at(int d, int pos) { return d == 0 ? pos : (pos < 2 ? 1 - pos : 19 - pos); }
__device__ __forceinline__ int pos_of(int d, int c) { return d == 0 ? c : (c < 2 ? 1 - c : 19 - c); }
__device__ __forceinline__ int rowmap32(int reg, int lane) { return (reg & 3) + 8 * (reg >> 2) + 4 * (lane >> 5); }

template <int K> __device__ __forceinline__ void mm32(f32x16& acc, const bf16_t* A, int lda, const bf16_t* B, int ldb, int lane) {
    const bf16_t* pa = A + (lane & 31) * lda + 8 * (lane >> 5);
    const bf16_t* pb = B + (lane & 31) * ldb + 8 * (lane >> 5);
#pragma unroll
    for (int k = 0; k < K; k += 16) {
        const bf16x8 a = *(const bf16x8*)(pa + k);
        const bf16x8 b = *(const bf16x8*)(pb + k);
        acc = __builtin_amdgcn_mfma_f32_32x32x16_bf16(a, b, acc, 0, 0, 0);
    }
}

template <int NC, bool SILU, bool TRANS>
__device__ __forceinline__ void stage_conv_tile(bf16_t* dst, int ld, const bf16_t* Pb, int t0, int col0, const float* cw, int CS, const float* cb, int tid) {
    constexpr int CG = NC / 8;
    const int lo = t0 < 256 ? 0 : 256, hi = t0 < 256 ? 256 : TPB;
    for (int idx = tid; idx < 128 * CG; idx += 512) {
        int cgi, tl;
        if (TRANS) { tl = idx & 127; cgi = idx >> 7; } else { cgi = idx % CG; tl = idx / CG; }
        const int t = t0 + tl;
        const f32x4 b0 = *(const f32x4*)(cb + cgi * 8), b1 = *(const f32x4*)(cb + cgi * 8 + 4);
        f32x8 acc; acc[0] = b0.x; acc[1] = b0.y; acc[2] = b0.z; acc[3] = b0.w; acc[4] = b1.x; acc[5] = b1.y; acc[6] = b1.z; acc[7] = b1.w;
#pragma unroll
        for (int k = 0; k < 4; ++k) {
            const int tt = t - 2 + k;
            if (tt >= lo && tt < hi) {
                const f32x8 v = unpack8(*(const u32x4*)(Pb + (size_t)tt * LDP + col0 + cgi * 8));
                const f32x4 w0 = *(const f32x4*)(cw + k * CS + cgi * 8), w1 = *(const f32x4*)(cw + k * CS + cgi * 8 + 4);
                acc[0] += w0.x * v[0]; acc[1] += w0.y * v[1]; acc[2] += w0.z * v[2]; acc[3] += w0.w * v[3];
                acc[4] += w1.x * v[4]; acc[5] += w1.y * v[5]; acc[6] += w1.z * v[6]; acc[7] += w1.w * v[7];
            }
        }
        if (SILU) {
#pragma unroll
            for (int e = 0; e < 8; ++e) acc[e] = siluf(acc[e]);
        }
        if (TRANS) {
#pragma unroll
            for (int e = 0; e < 8; ++e) dst[(cgi * 8 + e) * ld + tl] = f2bf(acc[e]);
        } else {
            *(u32x4*)(dst + tl * ld + cgi * 8) = pack8(acc);
        }
    }
}

__device__ __forceinline__ void transpose_item(const float* W, int K, int N, int nblk, bf16_t* WT, float* scr, int item, int lane) {
    const int kb = item / nblk, nb = item % nblk, k0 = 64 * kb, n0 = 32 * nb;
    const int c4 = lane & 7, r8 = lane >> 3, n = n0 + c4 * 4;
    f32x4 tv[8];
#pragma unroll
    for (int i = 0; i < 8; ++i) tv[i] = (n < N) ? *(const f32x4*)(W + (size_t)(k0 + i * 8 + r8) * N + n) : (f32x4){0.f, 0.f, 0.f, 0.f};
#pragma unroll
    for (int i = 0; i < 8; ++i) { float* d = scr + (i * 8 + r8) * 33 + c4 * 4; d[0] = tv[i].x; d[1] = tv[i].y; d[2] = tv[i].z; d[3] = tv[i].w; }
    asm volatile("s_waitcnt lgkmcnt(0)" ::: "memory");
    const int c = lane & 7;
#pragma unroll
    for (int j = 0; j < 4; ++j) {
        const int nn = (lane >> 3) + 8 * j; const float* s = scr + (8 * c) * 33 + nn;
        u32x4 o; o.x = cvt_pk_bf16(s[0 * 33], s[1 * 33]); o.y = cvt_pk_bf16(s[2 * 33], s[3 * 33]); o.z = cvt_pk_bf16(s[4 * 33], s[5 * 33]); o.w = cvt_pk_bf16(s[6 * 33], s[7 * 33]);
        *(u32x4*)(WT + (size_t)(n0 + nn) * K + k0 + 8 * c) = o;
    }
    asm volatile("s_waitcnt lgkmcnt(0)" ::: "memory");
}

__device__ __forceinline__ void phase0(const Params& p, unsigned char* shm, int G) {
    const int tid = tidx(), lane = tid & 63, wave = tid >> 6;
    float* sf = (float*)shm;
    float* MOD = WS_MOD(p);
    for (int item = blockIdx.x; item < 96; item += G) {
        const int l = item / 24, cgp = item % 24;
        __syncthreads();
        for (int idx = tid; idx < 9 * 2048; idx += 512) { const int r = idx >> 11, k = idx & 2047; const float v = r < 8 ? p.c[r * 2048 + k] : p.c_ctx[k]; sf[idx] = siluf(v); }
        __syncthreads();
        f32x4 acc[9];
#pragma unroll
        for (int r = 0; r < 9; ++r) acc[r] = (f32x4){0.f, 0.f, 0.f, 0.f};
        const float* wp = p.ada_w + ((size_t)l * 2048 + wave * 256) * 6144 + cgp * 256 + lane * 4;
#pragma unroll 16
        for (int kk = 0; kk < 256; ++kk) {
            const f32x4 wv = *(const f32x4*)(wp + (size_t)kk * 6144);
            const int k = wave * 256 + kk;
#pragma unroll
            for (int r = 0; r < 9; ++r) { const float s = sf[r * 2048 + k]; acc[r] += wv * s; }
        }
        __syncthreads();
#pragma unroll
        for (int r = 0; r < 9; ++r) *(f32x4*)(sf + (wave * 9 + r) * 256 + lane * 4) = acc[r];
        __syncthreads();
        for (int idx = tid; idx < 9 * 256; idx += 512) {
            const int r = idx >> 8, col = idx & 255; float s = p.ada_b[l * 6144 + cgp * 256 + col];
#pragma unroll
            for (int w = 0; w < 8; ++w) s += sf[(w * 9 + r) * 256 + col];
            MOD[(size_t)(l * 9 + r) * 6144 + cgp * 256 + col] = s;
        }
    }
    __syncthreads();
    float* scr = sf + wave * (64 * 33);
    const int gw = blockIdx.x * 8 + wave, NGW = G * 8;
    constexpr int I_IN = 32 * 232, I_OUT = 48 * 64;
    for (int it = gw; it < 4 * (I_IN + I_OUT); it += NGW) {
        if (it < 4 * I_IN) { const int l = it / I_IN, r = it % I_IN; transpose_item(p.w_in + (size_t)l * 2048 * 7184, 2048, 7184, 232, WS_WTIN(p) + (size_t)l * 7424 * 2048, scr, r, lane); }
        else { const int it2 = it - 4 * I_IN, l = it2 / I_OUT, r = it2 % I_OUT; transpose_item(p.w_out + (size_t)l * 3072 * 2048, 3072, 2048, 64, WS_WTOUT(p) + (size_t)l * 2048 * 3072, scr, r, lane); }
    }
    for (int idx = (int)blockIdx.x * 512 + tid; idx < 4 * 16 * 16384; idx += G * 512) {
        const int i = idx & 63, o = (idx >> 6) & 63, gate = (idx >> 12) & 1, d = (idx >> 13) & 1, j = (idx >> 14) & 15, l = idx >> 18;
        const float* w = gate ? p.lru_gx_w : p.lru_ga_w;
        WS_GW(p)[idx] = f2bf(w[(size_t)((l * 2 + d) * 16 + j) * 4096 + i * 64 + o]);
    }
}

__device__ __forceinline__ const float* xrow_src(const Params& p, int l, int row) {
    const int b = row / TPB, t = row % TPB;
    if (l == 0) return t < 256 ? p.ctx + ((size_t)b * 256 + t) * DM : p.x + ((size_t)b * 2048 + (t - 256)) * DM;
    return WS_XB(p) + (size_t)row * DM;
}
__device__ __forceinline__ void norm_phase(const Params& p, int l, int G) {
    const int lane = tidx() & 63, wave = tidx() >> 6;
    bf16_t* U = WS_U(p);
    const int gw = (int)blockIdx.x * 8 + wave, NW = G * 8;
    constexpr int R = 2;
#pragma unroll 1
    for (int base = gw; base < NTOK; base += NW * R) {
        f32x4 v[R][8];
#pragma unroll
        for (int u = 0; u < R; ++u) {
            const int row = base + u * NW;
            if (row < NTOK) {
                const float* src = xrow_src(p, l, row);
#pragma unroll
                for (int j = 0; j < 8; ++j) v[u][j] = *(const f32x4*)(src + 4 * lane + 256 * j);
            }
        }
#pragma unroll
        for (int u = 0; u < R; ++u) {
            const int row = base + u * NW;
            if (row < NTOK) {
                const int b = row / TPB, t = row % TPB;
                const float* md = WS_MOD(p) + (size_t)(l * 9 + (t < 256 ? 8 : b)) * 6144;
                float ss = 0.f;
#pragma unroll
                for (int j = 0; j < 8; ++j) ss += v[u][j].x * v[u][j].x + v[u][j].y * v[u][j].y + v[u][j].z * v[u][j].z + v[u][j].w * v[u][j].w;
                ss = wave_sum(ss);
                const float rstd = rsqrtf(ss * (1.f / 2048.f) + 1e-6f);
#pragma unroll
                for (int j = 0; j < 8; ++j) {
                    const int col = 4 * lane + 256 * j;
                    const f32x4 nw = *(const f32x4*)(p.norm_w + l * 2048 + col), sh = *(const f32x4*)(md + col), sc = *(const f32x4*)(md + 2048 + col);
                    const f32x4 y = v[u][j] * rstd * nw * (sc + 1.f) + sh;
                    u32x2 w; w.x = cvt_pk_bf16(y.x, y.y); w.y = cvt_pk_bf16(y.z, y.w);
                    *(u32x2*)(U + (size_t)row * DM + col) = w;
                }
            }
        }
    }
}

struct EpiG1 {
    static constexpr bool PERM = true, AFTER_DRAIN = false;
    bf16_t* P;
    __device__ __forceinline__ void operator()(const f32x4 (&acc)[2][2][4][2], const pg8::Unit& u, int wr, int wc, int fr, int fq) const {
        const int row0 = u.pm * 256 + wr * 64 + fr, col0 = u.pn * 256 + wc * 32 + 8 * fq;
#pragma unroll
        for (int ai = 0; ai < 2; ++ai)
#pragma unroll
            for (int m = 0; m < 4; ++m) { bf16_t* rowp = P + (size_t)(row0 + ai * 128 + m * 16) * LDP + col0;
#pragma unroll
                for (int bj = 0; bj < 2; ++bj) { const f32x4 v0 = acc[ai][bj][m][0], v1 = acc[ai][bj][m][1];
                    u32x4 w; w.x = cvt_pk_bf16(v0.x, v0.y); w.y = cvt_pk_bf16(v0.z, v0.w); w.z = cvt_pk_bf16(v1.x, v1.y); w.w = cvt_pk_bf16(v1.z, v1.w);
                    *(u32x4*)(rowp + bj * 128) = w; } }
    }
};
struct EpiG2 {
    static constexpr bool PERM = true, AFTER_DRAIN = false;
    Params p; int l; int scr;
    __device__ __forceinline__ void operator()(const f32x4 (&acc)[2][2][4][2], const pg8::Unit& u, int wr, int wc, int fr, int fq) const {
        const int row0 = u.pm * 256 + wr * 64 + fr, col0 = u.pn * 256 + wc * 32 + 8 * fq;
#pragma unroll
        for (int ai = 0; ai < 2; ++ai)
#pragma unroll
            for (int m = 0; m < 4; ++m) {
                const int row = row0 + ai * 128 + m * 16, b = row / TPB, t = row % TPB;
                if (l == 3 && t < 256) continue;
                const float* xo = xrow_src(p, l, row);
                float* dst = scr ? (float*)WS_P(p) + (size_t)row * DM : (l == 3) ? p.out + ((size_t)b * 2048 + (t - 256)) * DM : WS_XB(p) + (size_t)row * DM;
                const float* gt = WS_MOD(p) + (size_t)(l * 9 + (t < 256 ? 8 : b)) * 6144 + 4096;
                f32x4 xv[4], gv[4];
#pragma unroll
                for (int q = 0; q < 4; ++q) { const int col = col0 + (q >> 1) * 128 + (q & 1) * 4; xv[q] = *(const f32x4*)(xo + col); gv[q] = *(const f32x4*)(gt + col); }
#pragma unroll
                for (int q = 0; q < 4; ++q) { const int col = col0 + (q >> 1) * 128 + (q & 1) * 4; *(f32x4*)(dst + col) = xv[q] + gv[q] * acc[ai][q >> 1][m][q & 1]; }
            }
    }
};

template <int SCR>
__device__ __forceinline__ void qkprep_row(const Params& p, int l, int row, int lane) {
    const int t = row % TPB;
    bf16_t* rp = WS_P(p) + (size_t)row * LDP;
    float cs = 1.f, sn = 0.f;
    if (t >= 256) {
        const int s = t - 256, rr = s >> 6, cc = s & 63, f = lane & 31;
        const float inv = exp2f(-(float)f * (13.287712379549449f / 32.f));
        const float ang = (float)(lane < 32 ? rr : cc) * inv;
        cs = __cosf(ang); sn = __sinf(ang);
    }
    bf16_t r1[10], r2[10];
#pragma unroll
    for (int slot = 0; slot < 10; ++slot) { const int col = slot < 8 ? C_Q + slot * 128 : C_K + (slot - 8) * 128; r1[slot] = rp[col + lane]; r2[slot] = rp[col + 64 + lane]; }
#pragma unroll
    for (int slot = 0; slot < 10; ++slot) {
        const int col = slot < 8 ? C_Q + slot * 128 : C_K + (slot - 8) * 128;
        const float* w = slot < 8 ? p.att_q_norm + l * 128 : p.att_k_norm + l * 128;
        const float v1 = bf2f(r1[slot]), v2 = bf2f(r2[slot]);
        const float ss = wave_sum(v1 * v1 + v2 * v2);
        const float rstd = rsqrtf(ss * (1.f / 128.f) + 1e-6f);
        const float y1 = v1 * rstd * w[lane], y2 = v2 * rstd * w[64 + lane];
        float o1 = y1 * cs - y2 * sn, o2 = y1 * sn + y2 * cs;
        if (slot < 8) { o1 *= 0.08838834764831845f; o2 *= 0.08838834764831845f; }
        if (SCR) { bf16_t* sp = WS_ST(p) + (size_t)row * 1280 + slot * 128; sp[lane] = f2bf(o1); sp[64 + lane] = f2bf(o2); } else { rp[col + lane] = f2bf(o1); rp[col + 64 + lane] = f2bf(o2); }
    }
}

template <int D, int SCR = 0>
__device__ __forceinline__ void lru_sweep_item(const Params& p, int l, int item, unsigned char* shm) {
    const int tid = tidx(), lane = tid & 63, wave = tid >> 6, ch = tid & 63, seg = tid >> 6;
    const int j = item & 15, b = item >> 4;
    bf16_t* sX = (bf16_t*)shm; bf16_t* sW = (bf16_t*)(shm + 18432);
    float* sA = (float*)(shm + 36864); float* sB = (float*)(shm + 69632); float* sSA = (float*)(shm + 102400); float* sSB = (float*)(shm + 104448);
    bf16_t* sOut = (bf16_t*)(shm + 106496);
    const int mi = wave & 3, nj = wave >> 2, cl = nj * 32 + (lane & 31), cgl = j * 64 + cl;
    const float ba = p.lru_ga_b[(l * 2 + D) * 1024 + cgl], bx = p.lru_gx_b[(l * 2 + D) * 1024 + cgl], sp = softplusf(-p.lru_lambda[(l * 2 + D) * 1024 + cgl]);
    lds_barrier();
    {
        u32x4 wr2[2];
#pragma unroll
        for (int k = 0; k < 2; ++k) { const int idx = tid + k * 512; wr2[k] = *(const u32x4*)(WS_GW(p) + (size_t)(l * 16 + j) * 16384 + D * 8192 + idx * 8); }
#pragma unroll
        for (int k = 0; k < 2; ++k) { const int idx = tid + k * 512; *(u32x4*)(sW + (idx >> 3) * 72 + (idx & 7) * 8) = wr2[k]; }
    }
    u32x4 xr[2], lgr[2], hfr[2];
    {
        const size_t tok0 = (size_t)b * TPB + chunk_at(D, 0) * 128;
#pragma unroll
        for (int k = 0; k < 2; ++k) {
            const int idx = tid + k * 512;
            xr[k] = *(const u32x4*)(WS_LXC(p) + (tok0 + (idx >> 3)) * 1024 + j * 64 + (idx & 7) * 8);
            if (D == 1) { lgr[k] = *(const u32x4*)(WS_P(p) + (tok0 + (idx >> 3)) * LDP + C_LG + j * 64 + (idx & 7) * 8); hfr[k] = *(const u32x4*)(WS_MIX(p) + (tok0 + (idx >> 3)) * MIXW + j * 64 + (idx & 7) * 8); }
        }
    }
    float carry = 0.f;
#pragma unroll 1
    for (int pos = 0; pos < NCH; ++pos) {
        const size_t tok0 = (size_t)b * TPB + chunk_at(D, pos) * 128;
#pragma unroll
        for (int k = 0; k < 2; ++k) { const int idx = tid + k * 512; *(u32x4*)(sX + (idx >> 3) * 72 + (idx & 7) * 8) = xr[k]; }
        u32x4 lgc[2], hfc[2];
        if (D == 1) { lgc[0] = lgr[0]; lgc[1] = lgr[1]; hfc[0] = hfr[0]; hfc[1] = hfr[1]; }
        if (pos + 1 < NCH) {
            const size_t tokn = (size_t)b * TPB + chunk_at(D, pos + 1) * 128;
#pragma unroll
            for (int k = 0; k < 2; ++k) {
                const int idx = tid + k * 512;
                xr[k] = *(const u32x4*)(WS_LXC(p) + (tokn + (idx >> 3)) * 1024 + j * 64 + (idx & 7) * 8);
                if (D == 1) { lgr[k] = *(const u32x4*)(WS_P(p) + (tokn + (idx >> 3)) * LDP + C_LG + j * 64 + (idx & 7) * 8); hfr[k] = *(const u32x4*)(WS_MIX(p) + (tokn + (idx >> 3)) * MIXW + j * 64 + (idx & 7) * 8); }
            }
        }
        lds_barrier();
        {
            f32x16 ga, gx;
#pragma unroll
            for (int r = 0; r < 16; ++r) { ga[r] = 0.f; gx[r] = 0.f; }
            mm32<64>(ga, sX + mi * 32 * 72, 72, sW + (nj * 32) * 72, 72, lane);
            mm32<64>(gx, sX + mi * 32 * 72, 72, sW + (64 + nj * 32) * 72, 72, lane);
#pragma unroll
            for (int r = 0; r < 16; ++r) {
                const int tl = mi * 32 + rowmap32(r, lane);
                const float rg = sigmf(ga[r] + ba), ig = sigmf(gx[r] + bx);
                const float a = __expf(-8.f * rg * sp), mult = __builtin_amdgcn_sqrtf(fmaxf(1.f - a * a, 0.f));
                const float xv = bf2f(sX[tl * 72 + cl]);
                sA[tl * 64 + cl] = a; sB[tl * 64 + cl] = mult * ig * xv;
            }
        }
        lds_barrier();
        {
            float A = 1.f, Bc = 0.f;
#pragma unroll
            for (int q = 0; q < 16; ++q) { const int tl = seg * 16 + (D == 0 ? q : 15 - q); const float a = sA[tl * 64 + ch], bb = sB[tl * 64 + ch]; A = a * A; Bc = a * Bc + bb; }
            sSA[seg * 64 + ch] = A; sSB[seg * 64 + ch] = Bc;
        }
        lds_barrier();
        {
            float h = carry, cn = carry;
            const int myord = D == 0 ? seg : 7 - seg;
#pragma unroll
            for (int s = 0; s < 8; ++s) { const int sg = D == 0 ? s : 7 - s; const float a = sSA[sg * 64 + ch], bb = sSB[sg * 64 + ch]; cn = a * cn + bb; if (s < myord) h = cn; }
            carry = cn;
#pragma unroll
            for (int q = 0; q < 16; ++q) { const int tl = seg * 16 + (D == 0 ? q : 15 - q); h = sA[tl * 64 + ch] * h + sB[tl * 64 + ch]; sOut[tl * 72 + ch] = f2bf(h); }
        }
        lds_barrier();
#pragma unroll
        for (int k = 0; k < 2; ++k) {
            const int idx = tid + k * 512, rr = idx >> 3, ck = idx & 7;
            const u32x4 hv = *(const u32x4*)(sOut + rr * 72 + ck * 8);
            bf16_t* dst = SCR ? WS_P(p) + (tok0 + rr) * LDP + j * 64 + ck * 8 : WS_MIX(p) + (tok0 + rr) * MIXW + j * 64 + ck * 8;
            if (D == 0) *(u32x4*)dst = hv;
            else {
                const f32x8 a = unpack8(hv), f = unpack8(hfc[k]), g = unpack8(lgc[k]);
                f32x8 o;
#pragma unroll
                for (int e = 0; e < 8; ++e) o[e] = (a[e] + f[e]) * siluf(g[e]);
                *(u32x4*)dst = pack8(o);
            }
        }
    }
}

__device__ __forceinline__ void prep_elem(const Params& p, int l, int G) {
    const int gt = (int)blockIdx.x * 512 + tidx(), NT = G * 512;
    constexpr int NI = (NTOK / 4) * 192;
#pragma unroll 1
    for (int idx = gt; idx < NI; idx += NT) {
        const int tok = (idx / 192) * 4, cgi = idx % 192, b = tok / TPB, t = tok % TPB;
        const int lo = t < 256 ? 0 : 256, hi = t < 256 ? 256 : TPB;
        int col, CS, rs; const float *cw, *cb; bf16_t* dst; bool act;
        if (cgi < 128) { col = C_LX + cgi * 8; cw = p.lru_conv_w + l * 4096 + cgi * 8; CS = 1024; cb = p.lru_conv_b + l * 1024 + cgi * 8; act = false; dst = WS_LXC(p) + (size_t)tok * 1024 + cgi * 8; rs = 1024; }
        else { const int c2 = (cgi - 128) * 8; col = C_XBC + 1024 + c2; cw = p.ssd_conv_w + l * 6144 + 1024 + c2; CS = 1536; cb = p.ssd_conv_b + l * 1536 + 1024 + c2; act = true; dst = WS_SBC(p) + (size_t)tok * 512 + c2; rs = 512; }
        const bf16_t* src = WS_P(p) + (size_t)b * TPB * LDP + col;
        u32x4 raw[7];
#pragma unroll
        for (int r = 0; r < 7; ++r) { const int tt = t - 2 + r; raw[r] = (tt >= lo && tt < hi) ? *(const u32x4*)(src + (size_t)tt * LDP) : (u32x4){0u, 0u, 0u, 0u}; }
        const f32x4 b0 = *(const f32x4*)cb, b1 = *(const f32x4*)(cb + 4);
        f32x8 acc[4];
#pragma unroll
        for (int o = 0; o < 4; ++o) { acc[o][0] = b0.x; acc[o][1] = b0.y; acc[o][2] = b0.z; acc[o][3] = b0.w; acc[o][4] = b1.x; acc[o][5] = b1.y; acc[o][6] = b1.z; acc[o][7] = b1.w; }
#pragma unroll
        for (int k = 0; k < 4; ++k) {
            const f32x4 w0 = *(const f32x4*)(cw + k * CS), w1 = *(const f32x4*)(cw + k * CS + 4);
#pragma unroll
            for (int o = 0; o < 4; ++o) {
                const f32x8 v = unpack8(raw[o + k]);
                acc[o][0] += w0.x * v[0]; acc[o][1] += w0.y * v[1]; acc[o][2] += w0.z * v[2]; acc[o][3] += w0.w * v[3];
                acc[o][4] += w1.x * v[4]; acc[o][5] += w1.y * v[5]; acc[o][6] += w1.z * v[6]; acc[o][7] += w1.w * v[7];
            }
        }
#pragma unroll
        for (int o = 0; o < 4; ++o) {
            if (act) {
#pragma unroll
                for (int e = 0; e < 8; ++e) acc[o][e] = siluf(acc[o][e]);
            }
            *(u32x4*)(dst + (size_t)o * rs) = pack8(acc[o]);
        }
    }
}
struct PrepTile { int col0, ch0, t0, lo, hi, conv; const bf16_t* Pb; bf16_t* dst; };
__device__ __forceinline__ PrepTile prep_tile_decode(const Params& p, int item) {
    PrepTile T;
    const int t24 = item % 24, bc = item / 24, c = bc % NCH, b = bc / NCH;
    T.t0 = c * 128; T.Pb = WS_P(p) + (size_t)b * TPB * LDP; T.ch0 = 0; T.conv = t24 < 20;
    if (t24 < 16) { T.ch0 = t24 * 64; T.col0 = C_XBC + T.ch0; T.dst = WS_SXT(p) + ((size_t)((b * 18 + c) * 16 + t24)) * 8192; }
    else if (t24 < 20) { const int q = t24 - 16, g = q >> 1, nh = q & 1; T.ch0 = 1024 + g * 128 + nh * 64; T.col0 = C_XBC + T.ch0; T.dst = WS_SBT(p) + ((size_t)((b * 18 + c) * 2 + g)) * 16384 + (size_t)nh * 64 * 128; }
    else { const int q = t24 - 20, kh = q >> 1, dh = q & 1; T.col0 = C_V + kh * 128 + dh * 64; T.dst = WS_VT(p) + ((size_t)((b * 18 + c) * 2 + kh)) * 16384 + (size_t)dh * 64 * 128; }
    T.lo = T.t0 < 256 ? 0 : 256; T.hi = T.t0 < 256 ? 256 : TPB;
    return T;
}
__device__ __forceinline__ void prep_tile_load(const PrepTile& T, int tid, u32x4 (&raw)[2][4]) {
#pragma unroll
    for (int k = 0; k < 2; ++k) {
        const int idx = tid + k * 512, cgi = idx & 7, t = T.t0 + (idx >> 3);
#pragma unroll
        for (int q = 0; q < 4; ++q) {
            const int tt = T.conv ? t - 2 + q : t;
            const bool ok = T.conv ? (tt >= T.lo && tt < T.hi) : (q == 2);
            raw[k][q] = ok ? *(const u32x4*)(T.Pb + (size_t)tt * LDP + T.col0 + cgi * 8) : (u32x4){0u, 0u, 0u, 0u};
        }
    }
}
__device__ __forceinline__ void prep_tile_finish(const Params& p, int l, const PrepTile& T, int tid, const u32x4 (&raw)[2][4], unsigned char* shm) {
    bf16_t* sT = (bf16_t*)shm;
    const float* cw = p.ssd_conv_w + l * 6144 + T.ch0; const float* cb = p.ssd_conv_b + l * 1536 + T.ch0;
    lds_barrier();
#pragma unroll
    for (int k = 0; k < 2; ++k) {
        const int idx = tid + k * 512, cgi = idx & 7, tl = idx >> 3;
        f32x8 acc;
        if (T.conv) {
            const f32x4 b0 = *(const f32x4*)(cb + cgi * 8), b1 = *(const f32x4*)(cb + cgi * 8 + 4);
            acc[0] = b0.x; acc[1] = b0.y; acc[2] = b0.z; acc[3] = b0.w; acc[4] = b1.x; acc[5] = b1.y; acc[6] = b1.z; acc[7] = b1.w;
#pragma unroll
            for (int q = 0; q < 4; ++q) {
                const f32x8 v = unpack8(raw[k][q]);
                const f32x4 w0 = *(const f32x4*)(cw + q * 1536 + cgi * 8), w1 = *(const f32x4*)(cw + q * 1536 + cgi * 8 + 4);
                acc[0] += w0.x * v[0]; acc[1] += w0.y * v[1]; acc[2] += w0.z * v[2]; acc[3] += w0.w * v[3];
                acc[4] += w1.x * v[4]; acc[5] += w1.y * v[5]; acc[6] += w1.z * v[6]; acc[7] += w1.w * v[7];
            }
#pragma unroll
            for (int e = 0; e < 8; ++e) acc[e] = siluf(acc[e]);
        } else acc = unpack8(raw[k][2]);
#pragma unroll
        for (int e = 0; e < 8; ++e) sT[(cgi * 8 + e) * 130 + tl] = f2bf(acc[e]);
    }
    lds_barrier();
#pragma unroll
    for (int k = 0; k < 2; ++k) {
        const int idx = tid + k * 512, r = idx >> 4, ck = idx & 15;
        const unsigned* sp = (const unsigned*)(sT + r * 130 + ck * 8);
        u32x4 o; o.x = sp[0]; o.y = sp[1]; o.z = sp[2]; o.w = sp[3];
        *(u32x4*)(T.dst + r * 128 + ck * 8) = o;
    }
}
__device__ __forceinline__ void prep_tiles(const Params& p, int l, int bid, int G, unsigned char* shm) {
    const int tid = tidx();
    if (bid >= 3456) return;
    u32x4 raw[2][4], nraw[2][4];
    { const PrepTile T0 = prep_tile_decode(p, bid); prep_tile_load(T0, tid, raw); }
#pragma unroll 1
    for (int it = bid; it < 3456; it += G) {
        const bool more = it + G < 3456;
        if (more) { const PrepTile Tn = prep_tile_decode(p, it + G); prep_tile_load(Tn, tid, nraw); }
        { const PrepTile T = prep_tile_decode(p, it); prep_tile_finish(p, l, T, tid, raw, shm); }
        if (more) {
#pragma unroll
            for (int k = 0; k < 2; ++k)
#pragma unroll
                for (int q = 0; q < 4; ++q) raw[k][q] = nraw[k][q];
        }
    }
}
__device__ __forceinline__ void prep_dt_item(const Params& p, int l, int item) {
    const int tid = tidx();
    const int c = item % NCH, b = item / NCH;
    const int col32 = tid >> 4, h = col32 >> 1, d = col32 & 1, lane16 = tid & 15, seg = d == 0 ? lane16 : 15 - lane16;
    const float A = -__expf(p.ssd_A_log[(l * 2 + d) * 16 + h]), bias = p.ssd_dt_bias[(l * 2 + d) * 16 + h];
    const float* src = WS_DTP(p) + ((size_t)b * TPB + c * 128) * 16 + h;
    float dtv[8], cs[8], run = 0.f;
    float rawv[8];
#pragma unroll
    for (int q = 0; q < 8; ++q) { const int j = seg * 8 + (d == 0 ? q : 7 - q); rawv[q] = src[j * 16]; }
#pragma unroll
    for (int q = 0; q < 8; ++q) { dtv[q] = softplusf(rawv[q] + bias); run += dtv[q] * A; cs[q] = run; }
    float incl = run;
#pragma unroll
    for (int off = 1; off < 16; off <<= 1) { const float v = __shfl_up(incl, off, 16); if (lane16 >= off) incl += v; }
    const float excl = incl - run;
    float* dta = WS_DTA(p) + ((size_t)(b * 18 + c) * 128) * 32 + col32;
    float* acs = WS_ACS(p) + ((size_t)(b * 18 + c) * 128) * 32 + col32;
#pragma unroll
    for (int q = 0; q < 8; ++q) { const int j = seg * 8 + (d == 0 ? q : 7 - q); dta[j * 32] = dtv[q]; acs[j * 32] = cs[q] + excl; }
    if (lane16 == 15) WS_AL(p)[((b * 2 + d) * 18 + c) * 16 + h] = incl;
}
__device__ __forceinline__ void ssd_states_item(const Params& p, int l, int item, unsigned char* shm) {
    const int tid = tidx(), lane = tid & 63, wave = tid >> 6;
    const int g = item & 1, hh0 = ((item >> 1) & 1) * 4, bc = item >> 2, c = bc % NCH, b = bc / NCH;
    bf16_t* sBT = (bf16_t*)shm; bf16_t* sXw = (bf16_t*)(shm + 34816);
    float* sDt = (float*)(shm + 69632); float* sAcs = (float*)(shm + 77824); bf16_t* sO = (bf16_t*)(shm + 86016); float* sWg = (float*)(shm + 120832);
    const bf16_t* xt = WS_SXT(p) + ((size_t)((b * 18 + c) * 16 + g * 8)) * 8192;
    const bf16_t* btp = WS_SBT(p) + ((size_t)((b * 18 + c) * 2 + g)) * 16384;
    lds_barrier();
    {
        const size_t o = ((size_t)(b * 18 + c) * 128 + (tid >> 2)) * 32 + g * 16 + (tid & 3) * 4;
        const f32x4 vdt = *(const f32x4*)(WS_DTA(p) + o), vac = *(const f32x4*)(WS_ACS(p) + o);
        u32x4 bt[4];
#pragma unroll
        for (int k = 0; k < 4; ++k) { const int idx = tid + k * 512; bt[k] = *(const u32x4*)(btp + (idx >> 4) * 128 + (idx & 15) * 8); }
        *(f32x4*)(sDt + (tid >> 2) * 16 + (tid & 3) * 4) = vdt; *(f32x4*)(sAcs + (tid >> 2) * 16 + (tid & 3) * 4) = vac;
#pragma unroll
        for (int k = 0; k < 4; ++k) { const int idx = tid + k * 512; *(u32x4*)(sBT + (idx >> 4) * 136 + (idx & 15) * 8) = bt[k]; }
    }
    u32x4 xr[2];
#pragma unroll
    for (int k = 0; k < 2; ++k) { const int idx = tid + k * 512; xr[k] = *(const u32x4*)(xt + (size_t)hh0 * 8192 + (idx >> 4) * 128 + (idx & 15) * 8); }
    lds_barrier();
#pragma unroll
    for (int k = 0; k < 4; ++k) { const int idx = tid + k * 512, jj = idx >> 4, col = idx & 15; const float al = (col & 1) == 0 ? sAcs[127 * 16 + col] : sAcs[col]; sWg[col * 128 + jj] = __expf(al - sAcs[jj * 16 + col]) * sDt[jj * 16 + col]; }
#pragma unroll 1
    for (int hh = hh0; hh < hh0 + 4; ++hh) {
        const int h = g * 8 + hh;
        u32x4 xn[2] = {xr[0], xr[1]};
        if (hh < hh0 + 3) {
#pragma unroll
            for (int k = 0; k < 2; ++k) { const int idx = tid + k * 512; xn[k] = *(const u32x4*)(xt + (size_t)(hh + 1) * 8192 + (idx >> 4) * 128 + (idx & 15) * 8); }
        }
        lds_barrier();
#pragma unroll
        for (int k = 0; k < 2; ++k) {
            const int idx = tid + k * 512, pp = idx >> 4, j8 = (idx & 15) * 8;
            const f32x8 xv = unpack8(xr[k]);
#pragma unroll
            for (int d = 0; d < 2; ++d) {
                const f32x4 w0 = *(const f32x4*)(sWg + (hh * 2 + d) * 128 + j8), w1 = *(const f32x4*)(sWg + (hh * 2 + d) * 128 + j8 + 4);
                f32x8 o;
                o[0] = xv[0] * w0.x; o[1] = xv[1] * w0.y; o[2] = xv[2] * w0.z; o[3] = xv[3] * w0.w; o[4] = xv[4] * w1.x; o[5] = xv[5] * w1.y; o[6] = xv[6] * w1.z; o[7] = xv[7] * w1.w;
                *(u32x4*)(sXw + d * 8704 + pp * 136 + j8) = pack8(o);
            }
        }
        lds_barrier();
        const int mi = wave & 1, nj = wave >> 1;
#pragma unroll
        for (int d = 0; d < 2; ++d) {
            f32x16 acc;
#pragma unroll
            for (int r = 0; r < 16; ++r) acc[r] = 0.f;
            mm32<128>(acc, sXw + d * 8704 + mi * 32 * 136, 136, sBT + nj * 32 * 136, 136, lane);
#pragma unroll
            for (int r = 0; r < 16; ++r) sO[d * 8704 + (mi * 32 + rowmap32(r, lane)) * 136 + nj * 32 + (lane & 31)] = f2bf(acc[r]);
        }
        lds_barrier();
#pragma unroll
        for (int d = 0; d < 2; ++d) {
            bf16_t* base = WS_ST(p) + ((size_t)((b * 2 + d) * 18 + c) * 16 + h) * 8192;
#pragma unroll
            for (int k = 0; k < 2; ++k) { const int idx = tid + k * 512; *(u32x4*)(base + idx * 8) = *(const u32x4*)(sO + d * 8704 + (idx >> 4) * 136 + (idx & 15) * 8); }
        }
        xr[0] = xn[0]; xr[1] = xn[1];
    }
}
__device__ __forceinline__ void ssd_recur_item(const Params& p, int item) {
    const int tid = tidx();
    const int d = item & 1, h = (item >> 1) & 15, b = item >> 5;
    u32x4 s0[NCH], s1[NCH]; float ev[NCH];
#pragma unroll
    for (int pos = 0; pos < NCH; ++pos) {
        const int c = chunk_at(d, pos);
        const bf16_t* ptr = WS_ST(p) + ((size_t)((b * 2 + d) * 18 + c) * 16 + h) * 8192 + tid * 16;
        s0[pos] = *(const u32x4*)ptr; s1[pos] = *(const u32x4*)(ptr + 8);
        ev[pos] = WS_AL(p)[((b * 2 + d) * 18 + c) * 16 + h];
    }
    f32x8 h0, h1;
#pragma unroll
    for (int e = 0; e < 8; ++e) { h0[e] = 0.f; h1[e] = 0.f; }
#pragma unroll
    for (int pos = 0; pos < NCH; ++pos) {
        const int c = chunk_at(d, pos);
        bf16_t* ptr = WS_ST(p) + ((size_t)((b * 2 + d) * 18 + c) * 16 + h) * 8192 + tid * 16;
        *(u32x4*)ptr = pack8(h0); *(u32x4*)(ptr + 8) = pack8(h1);
        const float e = __expf(ev[pos]);
        h0 = h0 * e + unpack8(s0[pos]); h1 = h1 * e + unpack8(s1[pos]);
    }
}
template <int MODE>
__device__ __forceinline__ void ssd_final_item(const Params& p, int l, int item, unsigned char* shm) {
    const int tid = tidx(), lane = tid & 63, wave = tid >> 6;
    const int g = item & 1, hh0 = ((item >> 1) & 1) * 4, bc = item >> 2, c = bc % NCH, b = bc / NCH, t0 = c * 128;
    const size_t tok0 = (size_t)b * TPB + t0;
    bf16_t* sC = (bf16_t*)shm; bf16_t* sBW = (bf16_t*)(shm + 34816); bf16_t* sXT = (bf16_t*)(shm + 69632); bf16_t* sH = (bf16_t*)(shm + 87040);
    float* sDt = (float*)(shm + 104448); float* sAcs = (float*)(shm + 112640);
    bf16_t* sY = sBW;
    const bf16_t* xt = WS_SXT(p) + ((size_t)((b * 18 + c) * 16 + g * 8)) * 8192;
    const bf16_t* zt = WS_P(p) + tok0 * LDP + C_Z + g * 512;
    const bf16_t* hin0 = WS_ST(p) + ((size_t)((b * 2 + 0) * 18 + c) * 16 + g * 8) * 8192;
    const bf16_t* hin1 = WS_ST(p) + ((size_t)((b * 2 + 1) * 18 + c) * 16 + g * 8) * 8192;
    lds_barrier();
    u32x4 xr[2], zr[2], h0r[2];
    {
        const size_t o = ((size_t)(b * 18 + c) * 128 + (tid >> 2)) * 32 + g * 16 + (tid & 3) * 4;
        const f32x4 vdt = *(const f32x4*)(WS_DTA(p) + o), vac = *(const f32x4*)(WS_ACS(p) + o);
        u32x4 cr[4], br[4];
#pragma unroll
        for (int k = 0; k < 4; ++k) { const int idx = tid + k * 512; const bf16_t* s = WS_SBC(p) + (tok0 + (idx >> 4)) * 512 + g * 128 + (idx & 15) * 8; br[k] = *(const u32x4*)s; cr[k] = *(const u32x4*)(s + 256); }
#pragma unroll
        for (int k = 0; k < 2; ++k) {
            const int idx = tid + k * 512;
            xr[k] = *(const u32x4*)(xt + (size_t)hh0 * 8192 + (idx >> 4) * 128 + (idx & 15) * 8);
            zr[k] = *(const u32x4*)(zt + (size_t)(idx >> 3) * LDP + hh0 * 64 + (idx & 7) * 8);
            h0r[k] = *(const u32x4*)(hin0 + (size_t)hh0 * 8192 + idx * 8);
        }
        *(f32x4*)(sDt + (tid >> 2) * 16 + (tid & 3) * 4) = vdt; *(f32x4*)(sAcs + (tid >> 2) * 16 + (tid & 3) * 4) = vac;
#pragma unroll
        for (int k = 0; k < 4; ++k) { const int idx = tid + k * 512; *(u32x4*)(sC + (idx >> 4) * 136 + (idx & 15) * 8) = cr[k]; *(u32x4*)(sBW + (idx >> 4) * 136 + (idx & 15) * 8) = br[k]; }
    }
    lds_barrier();
    const int cmi = wave >> 1, cnj0 = (wave & 1) * 2;
    f32x16 cb0, cb1;
#pragma unroll
    for (int r = 0; r < 16; ++r) { cb0[r] = 0.f; cb1[r] = 0.f; }
    mm32<128>(cb0, sC + cmi * 32 * 136, 136, sBW + cnj0 * 32 * 136, 136, lane);
    mm32<128>(cb1, sC + cmi * 32 * 136, 136, sBW + (cnj0 + 1) * 32 * 136, 136, lane);
    const int ymi = wave & 3, ynj = wave >> 2;
#pragma unroll 1
    for (int hh = hh0; hh < hh0 + 4; ++hh) {
        const int h = g * 8 + hh;
        lds_barrier();
#pragma unroll
        for (int k = 0; k < 2; ++k) { const int idx = tid + k * 512; *(u32x4*)(sXT + (idx >> 4) * 136 + (idx & 15) * 8) = xr[k]; *(u32x4*)(sH + (idx >> 4) * 136 + (idx & 15) * 8) = h0r[k]; }
        u32x4 h1r[2];
#pragma unroll
        for (int k = 0; k < 2; ++k) h1r[k] = *(const u32x4*)(hin1 + (size_t)hh * 8192 + (tid + k * 512) * 8);
        f32x16 yacc;
#pragma unroll
        for (int r = 0; r < 16; ++r) yacc[r] = 0.f;
#pragma unroll 1
        for (int d = 0; d < 2; ++d) {
            const int col = hh * 2 + d;
            if (d == 1) {
                lds_barrier();
#pragma unroll
                for (int k = 0; k < 2; ++k) { const int idx = tid + k * 512; *(u32x4*)(sH + (idx >> 4) * 136 + (idx & 15) * 8) = h1r[k]; }
            }
            if (MODE < 2) {
                float aci[16];
#pragma unroll
                for (int r = 0; r < 16; ++r) aci[r] = sAcs[(cmi * 32 + rowmap32(r, lane)) * 16 + col];
#pragma unroll
                for (int tt = 0; tt < 2; ++tt) {
                    const int jg = (cnj0 + tt) * 32 + (lane & 31);
                    const float acj = sAcs[jg * 16 + col], dtj = sDt[jg * 16 + col];
                    const int dj0 = jg - cmi * 32 - 4 * (lane >> 5), dj = d == 0 ? dj0 : -dj0;
#pragma unroll
                    for (int r = 0; r < 16; ++r) {
                        const int ro = (r & 3) + 8 * (r >> 2);
                        const int sd = d == 0 ? dj - ro : dj + ro;
                        float arg = aci[r] - acj; arg = sd <= 0 ? arg : -INFINITY;
                        const float cbv = tt == 0 ? cb0[r] : cb1[r];
                        sBW[(cmi * 32 + rowmap32(r, lane)) * 136 + jg] = f2bf(cbv * __expf(arg) * dtj);
                    }
                }
            }
            lds_barrier();
            f32x16 ad, ao;
#pragma unroll
            for (int r = 0; r < 16; ++r) { ad[r] = 0.f; ao[r] = 0.f; }
            if (MODE < 3) { mm32<128>(ad, sBW + ymi * 32 * 136, 136, sXT + ynj * 32 * 136, 136, lane);
            mm32<128>(ao, sC + ymi * 32 * 136, 136, sH + ynj * 32 * 136, 136, lane); }
#pragma unroll
            for (int r = 0; r < 16; ++r) { const int ig = ymi * 32 + rowmap32(r, lane); yacc[r] += ad[r] + __expf(sAcs[ig * 16 + col]) * ao[r]; }
            if (d == 0 && hh < hh0 + 3) {
#pragma unroll
                for (int k = 0; k < 2; ++k) {
                    const int idx = tid + k * 512;
                    xr[k] = *(const u32x4*)(xt + (size_t)(hh + 1) * 8192 + (idx >> 4) * 128 + (idx & 15) * 8);
                    h0r[k] = *(const u32x4*)(hin0 + (size_t)(hh + 1) * 8192 + idx * 8);
                }
            }
        }
        const float Dh = p.ssd_D[l * 16 + h];
        const int pl = ynj * 32 + (lane & 31);
#pragma unroll
        for (int r = 0; r < 16; ++r) { const int ig = ymi * 32 + rowmap32(r, lane); yacc[r] += Dh * bf2f(sXT[pl * 136 + ig]); }
        lds_barrier();
#pragma unroll
        for (int r = 0; r < 16; ++r) { const int ig = ymi * 32 + rowmap32(r, lane); sY[ig * 72 + pl] = f2bf(yacc[r]); }
        lds_barrier();
#pragma unroll
        for (int k = 0; k < 2; ++k) {
            const int idx = tid + k * 512, rr = idx >> 3, pk = idx & 7;
            const f32x8 yv = unpack8(*(const u32x4*)(sY + rr * 72 + pk * 8)), zv = unpack8(zr[k]);
            f32x8 o;
#pragma unroll
            for (int e = 0; e < 8; ++e) o[e] = yv[e] * siluf(zv[e]);
            if (MODE < 1) *(u32x4*)(WS_MIX(p) + (tok0 + rr) * MIXW + 2048 + h * 64 + pk * 8) = pack8(o); else asm volatile("" :: "v"(o[0]), "v"(o[7]));
        }
        if (hh < hh0 + 3) {
#pragma unroll
            for (int k = 0; k < 2; ++k) { const int idx = tid + k * 512; zr[k] = *(const u32x4*)(zt + (size_t)(idx >> 3) * LDP + (hh + 1) * 64 + (idx & 7) * 8); }
        }
    }
}
__device__ __forceinline__ void ssd_norm_phase(const Params& p, int l, int G) {
    const int lane = tidx() & 63, wave = tidx() >> 6;
    for (int row = blockIdx.x * 8 + wave; row < NTOK; row += G * 8) {
        bf16_t* rp = WS_MIX(p) + (size_t)row * MIXW + 2048;
        f32x8 v0 = unpack8(*(const u32x4*)(rp + lane * 8)), v1 = unpack8(*(const u32x4*)(rp + 512 + lane * 8));
        float ss = 0.f;
#pragma unroll
        for (int e = 0; e < 8; ++e) ss += v0[e] * v0[e] + v1[e] * v1[e];
        ss = wave_sum(ss);
        const float rstd = rsqrtf(ss * (1.f / 1024.f) + 1e-6f);
        const float* nw = p.ssd_norm_w + l * 1024;
#pragma unroll
        for (int e = 0; e < 8; ++e) { v0[e] = v0[e] * rstd * nw[lane * 8 + e]; v1[e] = v1[e] * rstd * nw[512 + lane * 8 + e]; }
        *(u32x4*)(rp + lane * 8) = pack8(v0); *(u32x4*)(rp + 512 + lane * 8) = pack8(v1);
    }
}

template <int MODE>
__device__ __forceinline__ void attn_item(const Params& p, int l, int item, unsigned char* shm) {
    const int tid = tidx(), lane = tid & 63, wave = tid >> 6, fr = lane & 15, fq = lane >> 4;
    const int hp = item & 3, bq = item >> 2, qblk = bq % NCH, b = bq / NCH, kh = hp >> 1;
    const bf16_t* P = WS_P(p);
    bf16_t* sK = (bf16_t*)shm; bf16_t* sVT = (bf16_t*)(shm + 34816); bf16_t* sPw = (bf16_t*)(shm + 69632) + wave * (2 * 16 * 136);
    const size_t tokq0 = (size_t)b * TPB + qblk * 128;
    bf16x8 aq[2][4];
#pragma unroll
    for (int hd = 0; hd < 2; ++hd)
#pragma unroll
        for (int kk = 0; kk < 4; ++kk) aq[hd][kk] = *(const bf16x8*)(P + (tokq0 + wave * 16 + fr) * LDP + C_Q + (hp * 2 + hd) * 128 + kk * 32 + 8 * fq);
    float m[2][4], ls[2][4]; f32x4 O[2][8];
#pragma unroll
    for (int hd = 0; hd < 2; ++hd) {
        const float sink = p.att_sink[l * 8 + hp * 2 + hd];
#pragma unroll
        for (int r = 0; r < 4; ++r) { m[hd][r] = sink; ls[hd][r] = 1.f; }
#pragma unroll
        for (int nd = 0; nd < 8; ++nd) O[hd][nd] = (f32x4){0.f, 0.f, 0.f, 0.f};
    }
    const int nlat = qblk - 2;
    const int kb_lo = nlat - 1 < 0 ? 0 : nlat - 1, kb_hi = nlat + 1 > 15 ? 15 : nlat + 1;
    const int ntl = qblk < 2 ? 2 : 2 + (kb_hi - kb_lo + 1);
    u32x4 kr[4], vr[4];
    const bf16_t* vtb = WS_VT(p) + ((size_t)(b * 18) * 2 + kh) * 16384;
    {
        const bf16_t* kbase = P + ((size_t)b * TPB) * LDP + C_K + kh * 128;
#pragma unroll
        for (int k = 0; k < 4; ++k) { const int idx = tid + k * 512; kr[k] = *(const u32x4*)(kbase + (size_t)(idx >> 4) * LDP + (idx & 15) * 8); vr[k] = *(const u32x4*)(vtb + idx * 8); }
    }
#pragma unroll 1
    for (int ti = 0; ti < ntl; ++ti) {
        const bool masked = ti >= 2; const int kb = kb_lo + (ti - 2);
        lds_barrier();
#pragma unroll
        for (int k = 0; k < 4; ++k) {
            const int idx = tid + k * 512;
            *(u32x4*)(sK + (idx >> 4) * 136 + (idx & 15) * 8) = kr[k];
            *(u32x4*)(sVT + (idx >> 4) * 136 + (idx & 15) * 8) = vr[k];
        }
        if (ti + 1 < ntl) {
            const int tn = ti + 1, t0n = tn < 2 ? tn * 128 : 256 + (kb_lo + (tn - 2)) * 128;
            const bf16_t* kbase = P + ((size_t)b * TPB + t0n) * LDP + C_K + kh * 128;
            const bf16_t* vtn = vtb + (size_t)(t0n >> 7) * 32768;
#pragma unroll
            for (int k = 0; k < 4; ++k) { const int idx = tid + k * 512; kr[k] = *(const u32x4*)(kbase + (size_t)(idx >> 4) * LDP + (idx & 15) * 8); vr[k] = *(const u32x4*)(vtn + idx * 8); }
        }
        lds_barrier();
#pragma unroll 1
        for (int hf = 0; hf < 2; ++hf) {
            f32x4 s[2][4];
#pragma unroll
            for (int nt = 0; nt < 4; ++nt) {
                s[0][nt] = (f32x4){0.f, 0.f, 0.f, 0.f}; s[1][nt] = (f32x4){0.f, 0.f, 0.f, 0.f};
#pragma unroll
                for (int kk = 0; kk < 4; ++kk) {
                    const bf16x8 bk = *(const bf16x8*)(sK + ((hf * 4 + nt) * 16 + fr) * 136 + kk * 32 + 8 * fq);
                    s[0][nt] = __builtin_amdgcn_mfma_f32_16x16x32_bf16(aq[0][kk], bk, s[0][nt], 0, 0, 0);
                    s[1][nt] = __builtin_amdgcn_mfma_f32_16x16x32_bf16(aq[1][kk], bk, s[1][nt], 0, 0, 0);
                }
                __builtin_amdgcn_sched_barrier(0);
            }
            if (masked) {
#pragma unroll
                for (int nt = 0; nt < 4; ++nt)
#pragma unroll
                    for (int r = 0; r < 4; ++r) { const int rel = (nlat * 128 + wave * 16 + fq * 4 + r) - (kb * 128 + (hf * 4 + nt) * 16 + fr); if (rel > 128 || rel < -128) { s[0][nt][r] = -INFINITY; s[1][nt][r] = -INFINITY; } }
            }
#pragma unroll
            for (int hd = 0; hd < 2; ++hd) {
                float alpha[4];
#pragma unroll
                for (int r = 0; r < 4; ++r) {
                    float mx = fmaxf(fmaxf(s[hd][0][r], s[hd][1][r]), fmaxf(s[hd][2][r], s[hd][3][r]));
                    mx = row16_max(mx);
                    const float mn = fmaxf(m[hd][r], mx);
                    alpha[r] = __expf(m[hd][r] - mn); m[hd][r] = mn;
                    float rs = 0.f;
#pragma unroll
                    for (int nt = 0; nt < 4; ++nt) { const float pv = __expf(s[hd][nt][r] - mn); s[hd][nt][r] = pv; rs += pv; }
                    rs = row16_sum(rs);
                    ls[hd][r] = ls[hd][r] * alpha[r] + rs;
                }
#pragma unroll
                for (int nd = 0; nd < 8; ++nd) { O[hd][nd].x *= alpha[0]; O[hd][nd].y *= alpha[1]; O[hd][nd].z *= alpha[2]; O[hd][nd].w *= alpha[3]; }
#pragma unroll
                for (int nt = 0; nt < 4; ++nt)
#pragma unroll
                    for (int r = 0; r < 4; ++r) sPw[hd * (16 * 136) + (fq * 4 + r) * 136 + nt * 16 + fr] = f2bf(s[hd][nt][r]);
            }
            asm volatile("s_waitcnt lgkmcnt(0)" ::: "memory");
#pragma unroll
            for (int kk = 0; kk < 2; ++kk) {
                const bf16x8 ap0 = *(const bf16x8*)(sPw + fr * 136 + kk * 32 + 8 * fq);
                const bf16x8 ap1 = *(const bf16x8*)(sPw + 16 * 136 + fr * 136 + kk * 32 + 8 * fq);
#pragma unroll
                for (int nd = 0; nd < 8; ++nd) {
                    const bf16x8 bv = *(const bf16x8*)(sVT + (nd * 16 + fr) * 136 + hf * 64 + kk * 32 + 8 * fq);
                    O[0][nd] = __builtin_amdgcn_mfma_f32_16x16x32_bf16(ap0, bv, O[0][nd], 0, 0, 0);
                    O[1][nd] = __builtin_amdgcn_mfma_f32_16x16x32_bf16(ap1, bv, O[1][nd], 0, 0, 0);
                    if (nd == 3) __builtin_amdgcn_sched_barrier(0);
                }
                __builtin_amdgcn_sched_barrier(0);
            }
            asm volatile("s_waitcnt lgkmcnt(0)" ::: "memory");
        }
    }
#pragma unroll
    for (int hd = 0; hd < 2; ++hd) {
        const int hq = hp * 2 + hd;
        u32x4 agr[4];
#pragma unroll
        for (int k = 0; k < 4; ++k) { const int idx = tid + k * 512; agr[k] = *(const u32x4*)(P + (tokq0 + (idx >> 4)) * LDP + C_AG + hq * 128 + (idx & 15) * 8); }
        lds_barrier();
#pragma unroll
        for (int r = 0; r < 4; ++r) {
            const float il = __builtin_amdgcn_rcpf(ls[hd][r]);
#pragma unroll
            for (int nd = 0; nd < 8; ++nd) sK[(wave * 16 + fq * 4 + r) * 136 + nd * 16 + fr] = f2bf(O[hd][nd][r] * il);
        }
        lds_barrier();
#pragma unroll
        for (int k = 0; k < 4; ++k) {
            const int idx = tid + k * 512, rr = idx >> 4, ck = idx & 15;
            const f32x8 ov = unpack8(*(const u32x4*)(sK + rr * 136 + ck * 8)), gv = unpack8(agr[k]);
            f32x8 o;
#pragma unroll
            for (int e = 0; e < 8; ++e) o[e] = ov[e] * siluf(gv[e]);
            *(u32x4*)(WS_MIX(p) + (tokq0 + rr) * MIXW + 1024 + hq * 128 + ck * 8) = pack8(o);
        }
    }
}

#define XB_TMO      128
#define XB_XCNT(j)  (256  + 64 * (j))
#define XB_XSUB(j)  (1280 + 64 * (j))
#define XB_XGEN(j)  (2304 + 64 * (j))
#define XB_TOP      3328
#define XB_TOPGEN   3392
#define XCD_BAR_WORDS 3456
#define XB_SPIN_CAP (1u << 18)
#define LAS __attribute__((address_space(3)))
__device__ __forceinline__ unsigned xb_ld(unsigned* p)              { return __hip_atomic_load(p, __ATOMIC_RELAXED, __HIP_MEMORY_SCOPE_AGENT); }
__device__ __forceinline__ unsigned xb_add(unsigned* p, unsigned v) { return __hip_atomic_fetch_add(p, v, __ATOMIC_RELAXED, __HIP_MEMORY_SCOPE_AGENT); }
__device__ __forceinline__ unsigned xb_xcc_id() { return (unsigned)__builtin_amdgcn_s_getreg((3 << 11) | 20) & 0xFu; }
#define XB_SPIN(cond, bar) do { unsigned _sp = 0; while (cond) { __builtin_amdgcn_s_sleep(1); \
    if ((++_sp & 255u) == 0u) { if (xb_ld(&(bar)[XB_TMO])) break; if (_sp > XB_SPIN_CAP) { atomicAdd(&(bar)[XB_TMO], 1u); break; } } } } while (0)
struct XcdBarrier { unsigned* bar; unsigned x; volatile LAS unsigned* st; };
__device__ __forceinline__ XcdBarrier xcd_barrier_post(unsigned* bar, volatile LAS unsigned* st) {
    XcdBarrier b; b.bar = bar; b.x = xb_xcc_id(); b.st = st;
    if (tidx() == 0) (void)xb_add(&bar[XB_XCNT(b.x)], 1u);
    return b;
}
__device__ __forceinline__ void xcd_barrier_complete(unsigned* bar, unsigned x, unsigned& nloc, unsigned& nx) {
    const unsigned G = gridDim.x * gridDim.y * gridDim.z;
    unsigned sum, cnt, mine, sp = 0u;
    for (;;) {
        sum = 0u; cnt = 0u; mine = 0u;
#pragma unroll
        for (unsigned j = 0; j < 16; ++j) { const unsigned c = xb_ld(&bar[XB_XCNT(j)]); sum += c; cnt += (c > 0u) ? 1u : 0u; mine = (j == x) ? c : mine; }
        if (sum == G) break;
        __builtin_amdgcn_s_sleep(1);
        if ((++sp & 255u) == 0u) { if (xb_ld(&bar[XB_TMO])) break; if (sp > XB_SPIN_CAP) { atomicAdd(&bar[XB_TMO], 1u); break; } }
    }
    nloc = mine > 0u ? mine : 1u; nx = cnt > 0u ? cnt : 1u;
}
__device__ __forceinline__ void xcd_barrier(const XcdBarrier& b) {
    asm volatile("s_waitcnt vmcnt(0)" ::: "memory");
    __syncthreads();
    if (tidx() == 0) {
        unsigned* bar = b.bar;
        __builtin_amdgcn_s_waitcnt(0);
        unsigned nloc = b.st[0], nx = b.st[1];
        if (nloc == 0u) { xcd_barrier_complete(bar, b.x, nloc, nx); b.st[0] = nloc; b.st[1] = nx; }
        const unsigned old = xb_add(&bar[XB_XSUB(b.x)], 1u);
        const unsigned gen = old / nloc;
        if (old + 1u == (gen + 1u) * nloc) {
            __builtin_amdgcn_fence(__ATOMIC_RELEASE, "agent");
            asm volatile("s_waitcnt vmcnt(0)" ::: "memory");
            const unsigned og = xb_add(&bar[XB_TOP], 1u);
            const unsigned tg = og / nx;
            if (og + 1u == (tg + 1u) * nx) xb_add(&bar[XB_TOPGEN], 1u);
            else XB_SPIN(xb_ld(&bar[XB_TOPGEN]) == tg, bar);
            __builtin_amdgcn_fence(__ATOMIC_ACQUIRE, "agent");
            xb_add(&bar[XB_XGEN(b.x)], 1u);
            asm volatile("s_waitcnt vmcnt(0)" ::: "memory");
        } else {
            XB_SPIN(xb_ld(&bar[XB_XGEN(b.x)]) == gen, bar);
            __builtin_amdgcn_fence(__ATOMIC_ACQUIRE, "agent");
            asm volatile("s_waitcnt vmcnt(0)" ::: "memory");
        }
    }
    __syncthreads();
}


#define QUEUE_LOOP(ctr, NITEMS, BODY) do { \
    volatile LAS unsigned* _mb = (volatile LAS unsigned*)(shm + LDS_CTL + 8); \
    int it = bid; \
    while (it < (NITEMS)) { \
        unsigned _nx = 0u; if (tidx() == 0) _nx = xb_add((ctr), 1u) + (unsigned)G; \
        BODY; \
        __syncthreads(); \
        if (tidx() == 0) _mb[0] = _nx; \
        __syncthreads(); \
        it = (int)_mb[0]; \
    } } while (0)

__global__ __launch_bounds__(512) void mega(Params p) {
    extern __shared__ __attribute__((aligned(16))) unsigned char shm[];
    cg::grid_group grid = cg::this_grid();
    const int G = (int)gridDim.x, bid = (int)blockIdx.x;
    if (tidx() < 4) ((volatile LAS unsigned*)(shm + LDS_CTL))[tidx()] = 0u;
    __syncthreads();
    unsigned* qctr = (unsigned*)(p.ws + OFF_BAR) + 3584;
    const XcdBarrier xb = xcd_barrier_post((unsigned*)(p.ws + OFF_BAR), (volatile LAS unsigned*)(shm + LDS_CTL));
    for (int rep = 0; rep < 1 + DUP_P0; ++rep) phase0(p, shm, G);
    grid.sync();
#pragma unroll 1
    for (int l = 0; l < 4; ++l) {
        for (int rep = 0; rep < 1 + DUP_NORM; ++rep) norm_phase(p, l, G);
        xcd_barrier(xb);
        {
            pg8::Gemm g{WS_U(p), WS_WTIN(p) + (size_t)l * 7424 * 2048, NTOK, 7168, 2048};
            pg8::Order S; S.init(72, 28, G, bid, 0);
            EpiG1 E{WS_P(p)};
            for (int rep = 0; rep < 1 + DUP_G1; ++rep) pg8::gemm_phase<EpiG1, pg8::Order>((PG8_LAS unsigned char*)shm, g, S, E);
            {
                const int tq = tidx(), wave = tq >> 6, lane = tq & 63, fr = lane & 15, fq = lane >> 4;
                for (int wu = bid * 8 + wave; wu < NTOK / 16; wu += G * 8) {
                    const bf16_t* ap = WS_U(p) + (size_t)(wu * 16 + fr) * 2048 + 8 * fq;
                    const bf16_t* bp = WS_WTIN(p) + ((size_t)l * 7424 + 7168 + fr) * 2048 + 8 * fq;
                    f32x4 acc = (f32x4){0.f, 0.f, 0.f, 0.f};
#pragma unroll 8
                    for (int kk = 0; kk < 64; ++kk) { const bf16x8 a = *(const bf16x8*)(ap + kk * 32), bq = *(const bf16x8*)(bp + kk * 32); acc = __builtin_amdgcn_mfma_f32_16x16x32_bf16(a, bq, acc, 0, 0, 0); }
#pragma unroll
                    for (int r = 0; r < 4; ++r) WS_DTP(p)[(size_t)(wu * 16 + fq * 4 + r) * 16 + fr] = acc[r];
                }
            }
        }
        for (int rep = 0; rep < 1 + DUP_SYNC; ++rep) xcd_barrier(xb);
        for (int rep = 0; rep < 1 + DUP_E1; ++rep) {
            if (rep == 0 || E1SEL == 0 || E1SEL == 1) for (int it = bid; it < 144; it += G) prep_dt_item(p, l, it);
            if (rep == 0 || E1SEL == 0 || E1SEL == 2) { __syncthreads(); prep_tiles(p, l, bid, G, shm); }
            if (rep == 0 || E1SEL == 0 || E1SEL == 3) prep_elem(p, l, G);
        }
        { const int tq = tidx(), wave = tq >> 6, lane = tq & 63; for (int row = bid * 8 + wave; row < NTOK; row += G * 8) qkprep_row<0>(p, l, row, lane);
#if DUP_QK
          for (int row = bid * 8 + wave; row < NTOK; row += G * 8) qkprep_row<1>(p, l, row, lane);
#endif
        }
        xcd_barrier(xb);
        QUEUE_LOOP(qctr + (l * 3 + 0) * 64, 128 + 576, { if (it < 128) lru_sweep_item<0>(p, l, it, shm); else ssd_states_item(p, l, it - 128, shm); });
#if DUP_X1Q
        __syncthreads(); QUEUE_LOOP(qctr + (12 + l * 3 + 0) * 64, 128 + 576, { if (it < 128) lru_sweep_item<0>(p, l, it, shm); else ssd_states_item(p, l, it - 128, shm); });
#endif
#if DUP_SWEEP
        __syncthreads(); for (int it = bid; it < 128; it += G) lru_sweep_item<0>(p, l, it, shm);
#endif
#if DUP_STATES
        __syncthreads(); for (int it = bid; it < 256; it += G) ssd_states_item(p, l, it, shm);
#endif
        xcd_barrier(xb);
        QUEUE_LOOP(qctr + (l * 3 + 1) * 64, 256 + 576, { if (it < 256) ssd_recur_item(p, it); else attn_item<0>(p, l, it - 256, shm); });
#if DUP_ATTQ
        __syncthreads(); QUEUE_LOOP(qctr + (12 + l * 3 + 1) * 64, 576, { attn_item<AMODE>(p, l, it, shm); });
#endif
        xcd_barrier(xb);
        QUEUE_LOOP(qctr + (l * 3 + 2) * 64, 128 + 576, { if (it < 128) lru_sweep_item<1>(p, l, it, shm); else ssd_final_item<0>(p, l, it - 128, shm); });
#if DUP_FINAL
        __syncthreads(); for (int it = bid; it < 256; it += G) ssd_final_item<FMODE>(p, l, it, shm);
#endif
#if DUP_SWEEP1
        __syncthreads(); for (int it = bid; it < 128; it += G) lru_sweep_item<1, 1>(p, l, it, shm);
#endif
        xcd_barrier(xb);
#ifndef SK_X4
        ssd_norm_phase(p, l, G);
#endif
        xcd_barrier(xb);
        {
            pg8::Gemm g{WS_MIX(p), WS_WTOUT(p) + (size_t)l * 2048 * 3072, NTOK, 2048, 3072};
            pg8::Order S; S.init(l == 3 ? 64 : 72, 8, G, bid, l == 3 ? 1 : 0);
            EpiG2 E{p, l, 0};
#if DUP_G2
            { EpiG2 E2{p, l, 1}; pg8::gemm_phase<EpiG2, pg8::Order>((PG8_LAS unsigned char*)shm, g, S, E2); }
#endif
#ifndef SK_G2
            pg8::gemm_phase<EpiG2, pg8::Order>((PG8_LAS unsigned char*)shm, g, S, E);
#endif
        }
        if (l < 3) xcd_barrier(xb);
    }
}

extern "C" void kernel_launch(void* const* d_in, const int* in_sizes, int n_in, void* d_out, int out_size, void* d_ws, size_t ws_size, hipStream_t stream) {
    static int grid = 0;
    if (grid == 0) {
        if (n_in != 25 || ws_size < WS_END) { fprintf(stderr, "kernel_launch: need 25 inputs and %zu bytes of workspace (got %d, %zu)\n", (size_t)WS_END, n_in, ws_size); grid = -1; return; }
        int dev = 0, cus = 0, per_cu = 0;
        hipGetDevice(&dev);
        hipDeviceGetAttribute(&cus, hipDeviceAttributeMultiprocessorCount, dev);
        if (hipFuncSetAttribute((const void*)mega, hipFuncAttributeMaxDynamicSharedMemorySize, LDS_BYTES) != hipSuccess) { fprintf(stderr, "kernel_launch: hipFuncSetAttribute failed\n"); grid = -1; return; }
        if (hipOccupancyMaxActiveBlocksPerMultiprocessor(&per_cu, (const void*)mega, 512, LDS_BYTES) != hipSuccess || per_cu < 1) { fprintf(stderr, "kernel_launch: occupancy query gave %d\n", per_cu); per_cu = 1; }
        (void)hipGetLastError();
        grid = cus * 1;
        if (grid <= 0) grid = 256;
    }
    if (grid < 0) return;
    Params p{};
    const float** pf = (const float**)&p;
    for (int i = 0; i < 25; ++i) pf[i] = (const float*)d_in[i];
    p.out = (float*)d_out; p.ws = (unsigned char*)d_ws;
    if (hipMemsetAsync((char*)d_ws + OFF_BAR, 0, 32768, stream) != hipSuccess) { fprintf(stderr, "kernel_launch: memset of barrier words failed\n"); return; }
    void* args[] = {&p};
    hipError_t e = hipLaunchCooperativeKernel((const void*)mega, dim3(grid), dim3(512), args, LDS_BYTES, stream);
    if (e != hipSuccess) fprintf(stderr, "cooperative launch failed: %s (grid %d)\n", hipGetErrorString(e), grid);
}
```

```cpp
#include <hip/hip_runtime.h>
#include <hip/hip_cooperative_groups.h>
#include <cstdio>
#include <cstdint>
namespace cg = cooperative_groups;
#define DUP_X1A 0
#define DUP_X1B 0
#define DUP_ATT 0
#define DUP_X3A 0
#define DUP_X3B 0
#define DUP_G1 0
#define DUP_P0 0
#define DUP_NORM 0
#define DUP_SYNC 0
#define DUP_E1 0
#define DUP_SWEEP1 0
#define DUP_G2 0
#define DUP_QK 0
#define E1SEL 0
#define DUP_SWEEP 0
#define DUP_STATES 0
#define DUP_FINAL 0
#define AMODE 0
#define FMODE 0
#define DUP_X1Q 0
#define DUP_ATTQ 0
#define DUP_X3Q 0

__device__ __forceinline__ int tidx() { int t = (int)threadIdx.x; asm volatile("" : "+v"(t)); return t; }

namespace pg8 {
#define PG8_LAS __attribute__((address_space(3)))
typedef unsigned short bf16_t;
typedef short bf16x8 __attribute__((ext_vector_type(8)));
typedef float f32x4 __attribute__((ext_vector_type(4)));
typedef unsigned u32x4 __attribute__((ext_vector_type(4)));
constexpr int BM = 256, BK = 64, HALF = 128, HTB = HALF * BK * 2  , STAGE_BYTES = 8 * HTB, NXCD = 8, WGM = 8;

__host__ __device__ __forceinline__ int lds_byte(int r, int c) { const int st = (r >> 4) * 2 + (c >> 5), rr = r & 15, cc = c & 31, ob = rr * 64 + cc * 2; return st * 1024 + (ob ^ (((ob >> 9) & 1) << 5)); }
__host__ __device__ __forceinline__ void stage_rc(int b, int& R, int& C) { const int st = b / 1024, sb = b % 1024, swz = sb ^ (((sb >> 9) & 1) << 5); R = (st >> 1) * 16 + swz / 64; C = (st & 1) * 32 + (swz % 64) / 2; }
__host__ __device__ __forceinline__ int perm32(int rho) { const int n = rho >> 4, i = rho & 15; return 8 * (i >> 2) + 4 * n + (i & 3); }

struct Unit { int pm, pn; };
struct Gemm { const bf16_t* A; const bf16_t* Bt; int M, N, K; };

struct Order {
    int nM, nN, nwg, G, c, skipctx;
    __device__ void init(int nM_, int nN_, int G_, int c_, int skip_) { nM = nM_; nN = nN_; nwg = nM * nN; G = G_; c = c_; skipctx = skip_; }
    __device__ bool next(int i, Unit& u) const {
        const long L = (long)i * G + c; if (L >= nwg) return false;
        int wgid = (int)L; { const int q = nwg / NXCD, r = nwg % NXCD, xcd = wgid % NXCD, off = wgid / NXCD; wgid = (xcd < r ? xcd * (q + 1) : r * (q + 1) + (xcd - r) * q) + off; }
        const int nig = WGM * nN, gid = wgid / nig, fm = gid * WGM, gsz = (nM - fm) < WGM ? (nM - fm) : WGM;
        int pm = fm + ((wgid % nig) % gsz); u.pn = (wgid % nig) / gsz;
        if (skipctx) pm = (pm >> 3) * 9 + 1 + (pm & 7);
        u.pm = pm; return true;
    }
    __device__ __forceinline__ void a_ready(const Unit&) const {}
    __device__ __forceinline__ void done(const Unit&) const {}
};
typedef __bf16 bf16x2_t __attribute__((ext_vector_type(2)));
typedef float f32x2_t __attribute__((ext_vector_type(2)));
__device__ __forceinline__ unsigned cvt_pk_bf16(float lo, float hi) { f32x2_t v = {lo, hi}; bf16x2_t b = __builtin_convertvector(v, bf16x2_t); return __builtin_bit_cast(unsigned, b); }

template <class Epi, class Sched>
__device__ __forceinline__ void gemm_phase(PG8_LAS unsigned char* lds, const Gemm g, const Sched& S, const Epi& E) {
    const int tid = tidx(), wid = __builtin_amdgcn_readfirstlane(tid >> 6), lane = tid & 63, wr = wid >> 2, wc = wid & 3, fr = lane & 15, fq = lane >> 4;
    const int K = g.K, nt = K / BK;
    unsigned voffA[2], voffB[2];
#pragma unroll
    for (int i = 0; i < 2; ++i) { int R, C; stage_rc(tid * 16 + i * 8192, R, C); const int Rb = Epi::PERM ? ((R & ~31) + perm32(R & 31)) : R;
        voffA[i] = (unsigned)(R * K + C) * 2u; voffB[i] = (unsigned)(Rb * K + C) * 2u; }
    const size_t kstep = (size_t)(BK * 2);
    const size_t hstep = (size_t)HALF * K * 2;
    const size_t tstep = 2 * hstep;
    const unsigned ldsw = (unsigned)wid * 1024u;
    const int aoff = lds_byte(wr * 64 + fr, fq * 8), boff = lds_byte(wc * 32 + fr, fq * 8);
#define PG8_SA(b, h) (((b) * 2 + (h)) * HTB)
#define PG8_SB(b, h) ((4 + (b) * 2 + (h)) * HTB)
#define PG8_STAGE(bufoff, gbase, voff) do { _Pragma("unroll") for (int _i = 0; _i < 2; ++_i) \
        __builtin_amdgcn_global_load_lds((const unsigned*)((const char*)(gbase) + (voff)[_i]), (PG8_LAS unsigned*)(lds + (bufoff) + ldsw + _i * 8192), 16, 0, 0); } while (0)
#define PG8_LDA(dst, b, h) do { _Pragma("unroll") for (int m = 0; m < 4; ++m) _Pragma("unroll") for (int k = 0; k < 2; ++k) dst[m][k] = *(const PG8_LAS bf16x8*)(lds + PG8_SA(b, h) + aoff + m * 2048 + k * 1024); } while (0)
#define PG8_LDB(dst, b, h) do { _Pragma("unroll") for (int n = 0; n < 2; ++n) _Pragma("unroll") for (int k = 0; k < 2; ++k) dst[n][k] = *(const PG8_LAS bf16x8*)(lds + PG8_SB(b, h) + boff + n * 2048 + k * 1024); } while (0)
#define PG8_MMA(ai, bj, At, Bt) do { __builtin_amdgcn_s_setprio(1); _Pragma("unroll") for (int m = 0; m < 4; ++m) _Pragma("unroll") for (int n = 0; n < 2; ++n) _Pragma("unroll") for (int k = 0; k < 2; ++k) \
        acc[ai][bj][m][n] = __builtin_amdgcn_mfma_f32_16x16x32_bf16(Bt[n][k], At[m][k], acc[ai][bj][m][n], 0, 0, 0); __builtin_amdgcn_s_setprio(0); } while (0)
#define PG8_WAIT_V(n) asm volatile("s_waitcnt vmcnt(" #n ")" ::: "memory")
#define PG8_WAIT_L(n) asm volatile("s_waitcnt lgkmcnt(" #n ")" ::: "memory")
#define PG8_BAR __builtin_amdgcn_s_barrier()
#define PG8_SCHED __builtin_amdgcn_sched_barrier(0)
    Unit cur, nxt; int ui = 0;
    if (!S.next(0, cur)) return;
    f32x4 acc[2][2][4][2];
#pragma unroll
    for (int a = 0; a < 2; ++a)
#pragma unroll
        for (int b = 0; b < 2; ++b)
#pragma unroll
            for (int m = 0; m < 4; ++m)
#pragma unroll
                for (int n = 0; n < 2; ++n) acc[a][b][m][n] = (f32x4){0.f, 0.f, 0.f, 0.f};
    bf16x8 At[4][2], B0[2][2], B1[2][2];
    const char* cA = (const char*)g.A + (size_t)cur.pm * tstep; const char* cB = (const char*)g.Bt + (size_t)cur.pn * tstep;
    S.a_ready(cur);
    PG8_STAGE(PG8_SB(0, 0), cB, voffB); PG8_STAGE(PG8_SA(0, 0), cA, voffA); PG8_STAGE(PG8_SB(0, 1), cB + hstep, voffB); PG8_STAGE(PG8_SA(0, 1), cA + hstep, voffA);
    if (wr == 1) PG8_BAR;
    PG8_WAIT_V(4); PG8_BAR;
    PG8_STAGE(PG8_SB(1, 0), cB + kstep, voffB); PG8_STAGE(PG8_SA(1, 0), cA + kstep, voffA); PG8_STAGE(PG8_SB(1, 1), cB + hstep + kstep, voffB);
    PG8_WAIT_V(6); PG8_BAR;
    for (;;) {
        const bool has_next = S.next(ui + 1, nxt);
        const char* nA = has_next ? (const char*)g.A + (size_t)nxt.pm * tstep : cA; const char* nB = has_next ? (const char*)g.Bt + (size_t)nxt.pn * tstep : cB;
        for (int t = 0; t < nt; t += 2) {
            const bool last = (t == nt - 2);
            const char* a1 = cA + (size_t)(t + 1) * kstep;
            const char* a2 = last ? nA : cA + (size_t)(t + 2) * kstep; const char* b2 = last ? nB : cB + (size_t)(t + 2) * kstep;
            const char* a3 = a2 + kstep; const char* b3 = b2 + kstep;
            if (last && has_next) S.a_ready(nxt);
            PG8_LDB(B0, 0, 0); PG8_SCHED; PG8_LDA(At, 0, 0); PG8_STAGE(PG8_SA(1, 1), a1 + hstep, voffA);
            PG8_WAIT_L(8); PG8_BAR; PG8_WAIT_L(0); PG8_MMA(0, 0, At, B0); PG8_BAR; PG8_SCHED;
            PG8_LDB(B1, 0, 1); PG8_STAGE(PG8_SB(0, 0), b2, voffB);
            PG8_BAR; PG8_WAIT_L(0); PG8_MMA(0, 1, At, B1); PG8_BAR;
            PG8_LDA(At, 0, 1); PG8_STAGE(PG8_SA(0, 0), a2, voffA);
            PG8_BAR; PG8_WAIT_L(0); PG8_MMA(1, 0, At, B0); PG8_BAR; PG8_SCHED;
            PG8_STAGE(PG8_SB(0, 1), b2 + hstep, voffB);
            PG8_WAIT_V(6); PG8_BAR; PG8_MMA(1, 1, At, B1); PG8_BAR;
            PG8_LDB(B0, 1, 0); PG8_SCHED; PG8_LDA(At, 1, 0); PG8_STAGE(PG8_SA(0, 1), a2 + hstep, voffA);
            PG8_WAIT_L(8); PG8_BAR; PG8_WAIT_L(0); PG8_MMA(0, 0, At, B0); PG8_BAR; PG8_SCHED;
            PG8_LDB(B1, 1, 1); PG8_STAGE(PG8_SB(1, 0), b3, voffB);
            PG8_BAR; PG8_WAIT_L(0); PG8_MMA(0, 1, At, B1); PG8_BAR;
            PG8_LDA(At, 1, 1); PG8_STAGE(PG8_SA(1, 0), a3, voffA);
            PG8_BAR; PG8_WAIT_L(0); PG8_MMA(1, 0, At, B0); PG8_BAR; PG8_SCHED;
            PG8_STAGE(PG8_SB(1, 1), b3 + hstep, voffB);
            PG8_WAIT_V(6); PG8_BAR; PG8_MMA(1, 1, At, B1); PG8_BAR;
        }
        if constexpr (!Epi::AFTER_DRAIN) { E(acc, cur, wr, wc, fr, fq); S.done(cur); }
        if (!has_next) break;
#pragma unroll
        for (int a = 0; a < 2; ++a)
#pragma unroll
            for (int b = 0; b < 2; ++b)
#pragma unroll
                for (int m = 0; m < 4; ++m)
#pragma unroll
                    for (int n = 0; n < 2; ++n) acc[a][b][m][n] = (f32x4){0.f, 0.f, 0.f, 0.f};
        cur = nxt; cA = nA; cB = nB; ++ui;
    }
    PG8_WAIT_V(0);
    if (wr == 0) PG8_BAR;
    PG8_BAR;
    if constexpr (Epi::AFTER_DRAIN) { E.fused(acc, cur, wr, wc, fr, fq, lds, wid, lane); S.done(cur); }
#undef PG8_SA
#undef PG8_SB
#undef PG8_STAGE
#undef PG8_LDA
#undef PG8_LDB
#undef PG8_MMA
#undef PG8_WAIT_V
#undef PG8_WAIT_L
#undef PG8_BAR
#undef PG8_SCHED
}
}

using pg8::bf16_t; using pg8::bf16x8; using pg8::f32x4; using pg8::cvt_pk_bf16;
typedef float f32x16 __attribute__((ext_vector_type(16)));
typedef float f32x8 __attribute__((ext_vector_type(8)));
typedef unsigned u32x2 __attribute__((ext_vector_type(2)));
typedef unsigned u32x4 __attribute__((ext_vector_type(4)));

constexpr int DM = 2048, TPB = 2304, NTOK = 18432, LDP = 7424, MIXW = 3072, NCH = 18;
constexpr int C_LX = 0, C_LG = 1024, C_Q = 2048, C_K = 3072, C_V = 3328, C_AG = 3584, C_XBC = 4608, C_Z = 6144, C_DT = 7168;
constexpr size_t SZ_WTIN = (size_t)4 * 7424 * 2048 * 2, SZ_WTOUT = (size_t)4 * 2048 * 3072 * 2, SZ_MOD = (size_t)4 * 9 * 6144 * 4, SZ_U = (size_t)NTOK * 2048 * 2,
                 SZ_P = (size_t)NTOK * LDP * 2, SZ_MIX = (size_t)NTOK * MIXW * 2, SZ_XB = (size_t)NTOK * 2048 * 4, SZ_ST = (size_t)8 * 2 * 18 * 16 * 8192 * 2,
                 SZ_AL = (size_t)8 * 2 * 18 * 16 * 4, SZ_SUM = (size_t)8 * 2 * 18 * 1024 * 4;
constexpr size_t OFF_WTIN = 0, OFF_WTOUT = OFF_WTIN + SZ_WTIN, OFF_MOD = OFF_WTOUT + SZ_WTOUT, OFF_U = OFF_MOD + SZ_MOD, OFF_P = OFF_U + SZ_U, OFF_MIX = OFF_P + SZ_P,
                 OFF_XB = OFF_MIX + SZ_MIX, OFF_ST = OFF_XB + SZ_XB, OFF_AL = OFF_ST + SZ_ST, OFF_SUMA = OFF_AL + SZ_AL, OFF_SUMB = OFF_SUMA + SZ_SUM, OFF_BAR = OFF_SUMB + SZ_SUM, OFF_SBC = OFF_BAR + 32768, OFF_SBT = OFF_SBC + (size_t)NTOK * 512 * 2, OFF_DTA = OFF_SBT + (size_t)8 * 18 * 2 * 16384 * 2,
                 OFF_ACS = OFF_DTA + (size_t)NTOK * 32 * 4, OFF_HINL = OFF_ACS + (size_t)NTOK * 32 * 4, OFF_GW = OFF_HINL + SZ_SUM, OFF_DTP = OFF_GW + (size_t)4 * 16 * 16384 * 2, OFF_VT = OFF_DTP + (size_t)NTOK * 16 * 4, WS_END = OFF_VT + (size_t)8 * 18 * 2 * 16384 * 2;
constexpr size_t OFF_LXC = OFF_U, OFF_SXT = OFF_U + (size_t)NTOK * 1024 * 2;
constexpr int LDS_CTL = 147456;
constexpr int LDS_BYTES = LDS_CTL + 16;

struct Params {
    const float *x, *c, *ctx, *c_ctx, *norm_w, *ada_w, *ada_b, *w_in, *lru_conv_w, *lru_conv_b, *lru_ga_w, *lru_ga_b, *lru_gx_w, *lru_gx_b, *lru_lambda,
        *att_q_norm, *att_k_norm, *att_sink, *ssd_conv_w, *ssd_conv_b, *ssd_dt_bias, *ssd_A_log, *ssd_D, *ssd_norm_w, *w_out;
    float* out;
    unsigned char* ws;
};
#define WS_WTIN(p) ((bf16_t*)((p).ws + OFF_WTIN))
#define WS_WTOUT(p) ((bf16_t*)((p).ws + OFF_WTOUT))
#define WS_MOD(p) ((float*)((p).ws + OFF_MOD))
#define WS_U(p) ((bf16_t*)((p).ws + OFF_U))
#define WS_P(p) ((bf16_t*)((p).ws + OFF_P))
#define WS_MIX(p) ((bf16_t*)((p).ws + OFF_MIX))
#define WS_XB(p) ((float*)((p).ws + OFF_XB))
#define WS_ST(p) ((bf16_t*)((p).ws + OFF_ST))
#define WS_AL(p) ((float*)((p).ws + OFF_AL))
#define WS_SUMA(p) ((float*)((p).ws + OFF_SUMA))
#define WS_SUMB(p) ((float*)((p).ws + OFF_SUMB))
#define WS_LXC(p) ((bf16_t*)((p).ws + OFF_LXC))
#define WS_SXT(p) ((bf16_t*)((p).ws + OFF_SXT))
#define WS_SBC(p) ((bf16_t*)((p).ws + OFF_SBC))
#define WS_SBT(p) ((bf16_t*)((p).ws + OFF_SBT))
#define WS_DTA(p) ((float*)((p).ws + OFF_DTA))
#define WS_ACS(p) ((float*)((p).ws + OFF_ACS))
#define WS_HINL(p) ((float*)((p).ws + OFF_HINL))
#define WS_GW(p) ((bf16_t*)((p).ws + OFF_GW))
#define WS_DTP(p) ((float*)((p).ws + OFF_DTP))
#define WS_VT(p) ((bf16_t*)((p).ws + OFF_VT))

__device__ __forceinline__ float bf2f(bf16_t v) { return __uint_as_float(((unsigned)v) << 16); }
__device__ __forceinline__ bf16_t f2bf(float f) { return (bf16_t)(cvt_pk_bf16(f, 0.f) & 0xffffu); }
__device__ __forceinline__ float siluf(float v) { return v * __builtin_amdgcn_rcpf(1.f + __expf(-v)); }
__device__ __forceinline__ float sigmf(float v) { return __builtin_amdgcn_rcpf(1.f + __expf(-v)); }
__device__ __forceinline__ float softplusf(float v) { return v > 20.f ? v : log1pf(__expf(v)); }
__device__ __forceinline__ float wave_sum(float v) {
#pragma unroll
    for (int o = 1; o < 64; o <<= 1) v += __shfl_xor(v, o);
    return v;
}
__device__ __forceinline__ f32x8 unpack8(const u32x4 w) {
    f32x8 f;
    f[0] = __uint_as_float(w.x << 16); f[1] = __uint_as_float(w.x & 0xffff0000u); f[2] = __uint_as_float(w.y << 16); f[3] = __uint_as_float(w.y & 0xffff0000u);
    f[4] = __uint_as_float(w.z << 16); f[5] = __uint_as_float(w.z & 0xffff0000u); f[6] = __uint_as_float(w.w << 16); f[7] = __uint_as_float(w.w & 0xffff0000u);
    return f;
}
__device__ __forceinline__ u32x4 pack8(const f32x8 f) { u32x4 w; w.x = cvt_pk_bf16(f[0], f[1]); w.y = cvt_pk_bf16(f[2], f[3]); w.z = cvt_pk_bf16(f[4], f[5]); w.w = cvt_pk_bf16(f[6], f[7]); return w; }
__device__ __forceinline__ void lds_barrier() { asm volatile("s_waitcnt lgkmcnt(0)" ::: "memory"); __builtin_amdgcn_s_barrier(); asm volatile("" ::: "memory"); }
__device__ __forceinline__ float dpp_f(float v, int ctrl_sel) {
    const int x = __builtin_bit_cast(int, v); int r;
    if (ctrl_sel == 0) r = __builtin_amdgcn_update_dpp(x, x, 0xB1, 0xF, 0xF, false);
    else if (ctrl_sel == 1) r = __builtin_amdgcn_update_dpp(x, x, 0x4E, 0xF, 0xF, false);
    else if (ctrl_sel == 2) r = __builtin_amdgcn_update_dpp(x, x, 0x141, 0xF, 0xF, false);
    else r = __builtin_amdgcn_update_dpp(x, x, 0x140, 0xF, 0xF, false);
    return __builtin_bit_cast(float, r);
}
__device__ __forceinline__ float row16_max(float v) { v = fmaxf(v, dpp_f(v, 0)); v = fmaxf(v, dpp_f(v, 1)); v = fmaxf(v, dpp_f(v, 2)); v = fmaxf(v, dpp_f(v, 3)); return v; }
__device__ __forceinline__ float row16_sum(float v) { v += dpp_f(v, 0); v += dpp_f(v, 1); v += dpp_f(v, 2); v += dpp_f(v, 3); return v; }
__device__ __forceinline__ int chunk_at(int d, int pos) { return d == 0 ? pos : (pos < 2 ? 1 - pos : 19 - pos); }
__device__ __forceinline__ int pos_of(int d, int c) { return d == 0 ? c : (c < 2 ? 1 - c : 19 - c); }
__device__ __forceinline__ int rowmap32(int reg, int lane) { return (reg & 3) + 8 * (reg >> 2) + 4 * (lane >> 5); }

template <int K> __device__ __forceinline__ void mm32(f32x16& acc, const bf16_t* A, int lda, const bf16_t* B, int ldb, int lane) {
    const bf16_t* pa = A + (lane & 31) * lda + 8 * (lane >> 5);
    const bf16_t* pb = B + (lane & 31) * ldb + 8 * (lane >> 5);
#pragma unroll
    for (int k = 0; k < K; k += 16) {
        const bf16x8 a = *(const bf16x8*)(pa + k);
        const bf16x8 b = *(const bf16x8*)(pb + k);
        acc = __builtin_amdgcn_mfma_f32_32x32x16_bf16(a, b, acc, 0, 0, 0);
    }
}

template <int NC, bool SILU, bool TRANS>
__device__ __forceinline__ void stage_conv_tile(bf16_t* dst, int ld, const bf16_t* Pb, int t0, int col0, const float* cw, int CS, const float* cb, int tid) {
    constexpr int CG = NC / 8;
    const int lo = t0 < 256 ? 0 : 256, hi = t0 < 256 ? 256 : TPB;
    for (int idx = tid; idx < 128 * CG; idx += 512) {
        int cgi, tl;
        if (TRANS) { tl = idx & 127; cgi = idx >> 7; } else { cgi = idx % CG; tl = idx / CG; }
        const int t = t0 + tl;
        const f32x4 b0 = *(const f32x4*)(cb + cgi * 8), b1 = *(const f32x4*)(cb + cgi * 8 + 4);
        f32x8 acc; acc[0] = b0.x; acc[1] = b0.y; acc[2] = b0.z; acc[3] = b0.w; acc[4] = b1.x; acc[5] = b1.y; acc[6] = b1.z; acc[7] = b1.w;
#pragma unroll
        for (int k = 0; k < 4; ++k) {
            const int tt = t - 2 + k;
            if (tt >= lo && tt < hi) {
                const f32x8 v = unpack8(*(const u32x4*)(Pb + (size_t)tt * LDP + col0 + cgi * 8));
                const f32x4 w0 = *(const f32x4*)(cw + k * CS + cgi * 8), w1 = *(const f32x4*)(cw + k * CS + cgi * 8 + 4);
                acc[0] += w0.x * v[0]; acc[1] += w0.y * v[1]; acc[2] += w0.z * v[2]; acc[3] += w0.w * v[3];
                acc[4] += w1.x * v[4]; acc[5] += w1.y * v[5]; acc[6] += w1.z * v[6]; acc[7] += w1.w * v[7];
            }
        }
        if (SILU) {
#pragma unroll
            for (int e = 0; e < 8; ++e) acc[e] = siluf(acc[e]);
        }
        if (TRANS) {
#pragma unroll
            for (int e = 0; e < 8; ++e) dst[(cgi * 8 + e) * ld + tl] = f2bf(acc[e]);
        } else {
            *(u32x4*)(dst + tl * ld + cgi * 8) = pack8(acc);
        }
    }
}

__device__ __forceinline__ void transpose_item(const float* W, int K, int N, int nblk, bf16_t* WT, float* scr, int item, int lane) {
    const int kb = item / nblk, nb = item % nblk, k0 = 64 * kb, n0 = 32 * nb;
    const int c4 = lane & 7, r8 = lane >> 3, n = n0 + c4 * 4;
    f32x4 tv[8];
#pragma unroll
    for (int i = 0; i < 8; ++i) tv[i] = (n < N) ? *(const f32x4*)(W + (size_t)(k0 + i * 8 + r8) * N + n) : (f32x4){0.f, 0.f, 0.f, 0.f};
#pragma unroll
    for (int i = 0; i < 8; ++i) { float* d = scr + (i * 8 + r8) * 33 + c4 * 4; d[0] = tv[i].x; d[1] = tv[i].y; d[2] = tv[i].z; d[3] = tv[i].w; }
    asm volatile("s_waitcnt lgkmcnt(0)" ::: "memory");
    const int c = lane & 7;
#pragma unroll
    for (int j = 0; j < 4; ++j) {
        const int nn = (lane >> 3) + 8 * j; const float* s = scr + (8 * c) * 33 + nn;
        u32x4 o; o.x = cvt_pk_bf16(s[0 * 33], s[1 * 33]); o.y = cvt_pk_bf16(s[2 * 33], s[3 * 33]); o.z = cvt_pk_bf16(s[4 * 33], s[5 * 33]); o.w = cvt_pk_bf16(s[6 * 33], s[7 * 33]);
        *(u32x4*)(WT + (size_t)(n0 + nn) * K + k0 + 8 * c) = o;
    }
    asm volatile("s_waitcnt lgkmcnt(0)" ::: "memory");
}

__device__ __forceinline__ void phase0(const Params& p, unsigned char* shm, int G) {
    const int tid = tidx(), lane = tid & 63, wave = tid >> 6;
    float* sf = (float*)shm;
    float* MOD = WS_MOD(p);
    for (int item = blockIdx.x; item < 96; item += G) {
        const int l = item / 24, cgp = item % 24;
        __syncthreads();
        for (int idx = tid; idx < 9 * 2048; idx += 512) { const int r = idx >> 11, k = idx & 2047; const float v = r < 8 ? p.c[r * 2048 + k] : p.c_ctx[k]; sf[idx] = siluf(v); }
        __syncthreads();
        f32x4 acc[9];
#pragma unroll
        for (int r = 0; r < 9; ++r) acc[r] = (f32x4){0.f, 0.f, 0.f, 0.f};
        const float* wp = p.ada_w + ((size_t)l * 2048 + wave * 256) * 6144 + cgp * 256 + lane * 4;
#pragma unroll 16
        for (int kk = 0; kk < 256; ++kk) {
            const f32x4 wv = *(const f32x4*)(wp + (size_t)kk * 6144);
            const int k = wave * 256 + kk;
#pragma unroll
            for (int r = 0; r < 9; ++r) { const float s = sf[r * 2048 + k]; acc[r] += wv * s; }
        }
        __syncthreads();
#pragma unroll
        for (int r = 0; r < 9; ++r) *(f32x4*)(sf + (wave * 9 + r) * 256 + lane * 4) = acc[r];
        __syncthreads();
        for (int idx = tid; idx < 9 * 256; idx += 512) {
            const int r = idx >> 8, col = idx & 255; float s = p.ada_b[l * 6144 + cgp * 256 + col];
#pragma unroll
            for (int w = 0; w < 8; ++w) s += sf[(w * 9 + r) * 256 + col];
            MOD[(size_t)(l * 9 + r) * 6144 + cgp * 256 + col] = s;
        }
    }
    __syncthreads();
    float* scr = sf + wave * (64 * 33);
    const int gw = blockIdx.x * 8 + wave, NGW = G * 8;
    constexpr int I_IN = 32 * 232, I_OUT = 48 * 64;
    for (int it = gw; it < 4 * (I_IN + I_OUT); it += NGW) {
        if (it < 4 * I_IN) { const int l = it / I_IN, r = it % I_IN; transpose_item(p.w_in + (size_t)l * 2048 * 7184, 2048, 7184, 232, WS_WTIN(p) + (size_t)l * 7424 * 2048, scr, r, lane); }
        else { const int it2 = it - 4 * I_IN, l = it2 / I_OUT, r = it2 % I_OUT; transpose_item(p.w_out + (size_t)l * 3072 * 2048, 3072, 2048, 64, WS_WTOUT(p) + (size_t)l * 2048 * 3072, scr, r, lane); }
    }
    for (int idx = (int)blockIdx.x * 512 + tid; idx < 4 * 16 * 16384; idx += G * 512) {
        const int i = idx & 63, o = (idx >> 6) & 63, gate = (idx >> 12) & 1, d = (idx >> 13) & 1, j = (idx >> 14) & 15, l = idx >> 18;
        const float* w = gate ? p.lru_gx_w : p.lru_ga_w;
        WS_GW(p)[idx] = f2bf(w[(size_t)((l * 2 + d) * 16 + j) * 4096 + i * 64 + o]);
    }
}

__device__ __forceinline__ const float* xrow_src(const Params& p, int l, int row) {
    const int b = row / TPB, t = row % TPB;
    if (l == 0) return t < 256 ? p.ctx + ((size_t)b * 256 + t) * DM : p.x + ((size_t)b * 2048 + (t - 256)) * DM;
    return WS_XB(p) + (size_t)row * DM;
}
__device__ __forceinline__ void norm_phase(const Params& p, int l, int G) {
    const int lane = tidx() & 63, wave = tidx() >> 6;
    bf16_t* U = WS_U(p);
    const int gw = (int)blockIdx.x * 8 + wave, NW = G * 8;
    constexpr int R = 2;
#pragma unroll 1
    for (int base = gw; base < NTOK; base += NW * R) {
        f32x4 v[R][8];
#pragma unroll
        for (int u = 0; u < R; ++u) {
            const int row = base + u * NW;
            if (row < NTOK) {
                const float* src = xrow_src(p, l, row);
#pragma unroll
                for (int j = 0; j < 8; ++j) v[u][j] = *(const f32x4*)(src + 4 * lane + 256 * j);
            }
        }
#pragma unroll
        for (int u = 0; u < R; ++u) {
            const int row = base + u * NW;
            if (row < NTOK) {
                const int b = row / TPB, t = row % TPB;
                const float* md = WS_MOD(p) + (size_t)(l * 9 + (t < 256 ? 8 : b)) * 6144;
                float ss = 0.f;
#pragma unroll
                for (int j = 0; j < 8; ++j) ss += v[u][j].x * v[u][j].x + v[u][j].y * v[u][j].y + v[u][j].z * v[u][j].z + v[u][j].w * v[u][j].w;
                ss = wave_sum(ss);
                const float rstd = rsqrtf(ss * (1.f / 2048.f) + 1e-6f);
#pragma unroll
                for (int j = 0; j < 8; ++j) {
                    const int col = 4 * lane + 256 * j;
                    const f32x4 nw = *(const f32x4*)(p.norm_w + l * 2048 + col), sh = *(const f32x4*)(md + col), sc = *(const f32x4*)(md + 2048 + col);
                    const f32x4 y = v[u][j] * rstd * nw * (sc + 1.f) + sh;
                    u32x2 w; w.x = cvt_pk_bf16(y.x, y.y); w.y = cvt_pk_bf16(y.z, y.w);
                    *(u32x2*)(U + (size_t)row * DM + col) = w;
                }
            }
        }
    }
}

struct EpiG1 {
    static constexpr bool PERM = true, AFTER_DRAIN = false;
    bf16_t* P;
    __device__ __forceinline__ void operator()(const f32x4 (&acc)[2][2][4][2], const pg8::Unit& u, int wr, int wc, int fr, int fq) const {
        const int row0 = u.pm * 256 + wr * 64 + fr, col0 = u.pn * 256 + wc * 32 + 8 * fq;
#pragma unroll
        for (int ai = 0; ai < 2; ++ai)
#pragma unroll
            for (int m = 0; m < 4; ++m) { bf16_t* rowp = P + (size_t)(row0 + ai * 128 + m * 16) * LDP + col0;
#pragma unroll
                for (int bj = 0; bj < 2; ++bj) { const f32x4 v0 = acc[ai][bj][m][0], v1 = acc[ai][bj][m][1];
                    u32x4 w; w.x = cvt_pk_bf16(v0.x, v0.y); w.y = cvt_pk_bf16(v0.z, v0.w); w.z = cvt_pk_bf16(v1.x, v1.y); w.w = cvt_pk_bf16(v1.z, v1.w);
                    *(u32x4*)(rowp + bj * 128) = w; } }
    }
};
struct EpiG2 {
    static constexpr bool PERM = true, AFTER_DRAIN = false;
    Params p; int l; int scr;
    __device__ __forceinline__ void operator()(const f32x4 (&acc)[2][2][4][2], const pg8::Unit& u, int wr, int wc, int fr, int fq) const {
        const int row0 = u.pm * 256 + wr * 64 + fr, col0 = u.pn * 256 + wc * 32 + 8 * fq;
#pragma unroll
        for (int ai = 0; ai < 2; ++ai)
#pragma unroll
            for (int m = 0; m < 4; ++m) {
                const int row = row0 + ai * 128 + m * 16, b = row / TPB, t = row % TPB;
                if (l == 3 && t < 256) continue;
                const float* xo = xrow_src(p, l, row);
                float* dst = scr ? (float*)WS_P(p) + (size_t)row * DM : (l == 3) ? p.out + ((size_t)b * 2048 + (t - 256)) * DM : WS_XB(p) + (size_t)row * DM;
                const float* gt = WS_MOD(p) + (size_t)(l * 9 + (t < 256 ? 8 : b)) * 6144 + 4096;
                f32x4 xv[4], gv[4];
#pragma unroll
                for (int q = 0; q < 4; ++q) { const int col = col0 + (q >> 1) * 128 + (q & 1) * 4; xv[q] = *(const f32x4*)(xo + col); gv[q] = *(const f32x4*)(gt + col); }
#pragma unroll
                for (int q = 0; q < 4; ++q) { const int col = col0 + (q >> 1) * 128 + (q & 1) * 4; *(f32x4*)(dst + col) = xv[q] + gv[q] * acc[ai][q >> 1][m][q & 1]; }
            }
    }
};

template <int SCR>
__device__ __forceinline__ void qkprep_row(const Params& p, int l, int row, int lane) {
    const int t = row % TPB;
    bf16_t* rp = WS_P(p) + (size_t)row * LDP;
    float cs = 1.f, sn = 0.f;
    if (t >= 256) {
        const int s = t - 256, rr = s >> 6, cc = s & 63, f = lane & 31;
        const float inv = exp2f(-(float)f * (13.287712379549449f / 32.f));
        const float ang = (float)(lane < 32 ? rr : cc) * inv;
        cs = __cosf(ang); sn = __sinf(ang);
    }
    bf16_t r1[10], r2[10];
#pragma unroll
    for (int slot = 0; slot < 10; ++slot) { const int col = slot < 8 ? C_Q + slot * 128 : C_K + (slot - 8) * 128; r1[slot] = rp[col + lane]; r2[slot] = rp[col + 64 + lane]; }
#pragma unroll
    for (int slot = 0; slot < 10; ++slot) {
        const int col = slot < 8 ? C_Q + slot * 128 : C_K + (slot - 8) * 128;
        const float* w = slot < 8 ? p.att_q_norm + l * 128 : p.att_k_norm + l * 128;
        const float v1 = bf2f(r1[slot]), v2 = bf2f(r2[slot]);
        const float ss = wave_sum(v1 * v1 + v2 * v2);
        const float rstd = rsqrtf(ss * (1.f / 128.f) + 1e-6f);
        const float y1 = v1 * rstd * w[lane], y2 = v2 * rstd * w[64 + lane];
        float o1 = y1 * cs - y2 * sn, o2 = y1 * sn + y2 * cs;
        if (slot < 8) { o1 *= 0.08838834764831845f; o2 *= 0.08838834764831845f; }
        if (SCR) { bf16_t* sp = WS_ST(p) + (size_t)row * 1280 + slot * 128; sp[lane] = f2bf(o1); sp[64 + lane] = f2bf(o2); } else { rp[col + lane] = f2bf(o1); rp[col + 64 + lane] = f2bf(o2); }
    }
}

template <int D, int SCR = 0>
__device__ __forceinline__ void lru_sweep_item(const Params& p, int l, int item, unsigned char* shm) {
    const int tid = tidx(), lane = tid & 63, wave = tid >> 6, ch = tid & 63, seg = tid >> 6;
    const int j = item & 15, b = item >> 4;
    bf16_t* sX = (bf16_t*)shm; bf16_t* sW = (bf16_t*)(shm + 18432);
    float* sA = (float*)(shm + 36864); float* sB = (float*)(shm + 69632); float* sSA = (float*)(shm + 102400); float* sSB = (float*)(shm + 104448);
    bf16_t* sOut = (bf16_t*)(shm + 106496);
    const int mi = wave & 3, nj = wave >> 2, cl = nj * 32 + (lane & 31), cgl = j * 64 + cl;
    const float ba = p.lru_ga_b[(l * 2 + D) * 1024 + cgl], bx = p.lru_gx_b[(l * 2 + D) * 1024 + cgl], sp = softplusf(-p.lru_lambda[(l * 2 + D) * 1024 + cgl]);
    lds_barrier();
    {
        u32x4 wr2[2];
#pragma unroll
        for (int k = 0; k < 2; ++k) { const int idx = tid + k * 512; wr2[k] = *(const u32x4*)(WS_GW(p) + (size_t)(l * 16 + j) * 16384 + D * 8192 + idx * 8); }
#pragma unroll
        for (int k = 0; k < 2; ++k) { const int idx = tid + k * 512; *(u32x4*)(sW + (idx >> 3) * 72 + (idx & 7) * 8) = wr2[k]; }
    }
    u32x4 xr[2], lgr[2], hfr[2];
    {
        const size_t tok0 = (size_t)b * TPB + chunk_at(D, 0) * 128;
#pragma unroll
        for (int k = 0; k < 2; ++k) {
            const int idx = tid + k * 512;
            xr[k] = *(const u32x4*)(WS_LXC(p) + (tok0 + (idx >> 3)) * 1024 + j * 64 + (idx & 7) * 8);
            if (D == 1) { lgr[k] = *(const u32x4*)(WS_P(p) + (tok0 + (idx >> 3)) * LDP + C_LG + j * 64 + (idx & 7) * 8); hfr[k] = *(const u32x4*)(WS_MIX(p) + (tok0 + (idx >> 3)) * MIXW + j * 64 + (idx & 7) * 8); }
        }
    }
    float carry = 0.f;
#pragma unroll 1
    for (int pos = 0; pos < NCH; ++pos) {
        const size_t tok0 = (size_t)b * TPB + chunk_at(D, pos) * 128;
#pragma unroll
        for (int k = 0; k < 2; ++k) { const int idx = tid + k * 512; *(u32x4*)(sX + (idx >> 3) * 72 + (idx & 7) * 8) = xr[k]; }
        u32x4 lgc[2], hfc[2];
        if (D == 1) { lgc[0] = lgr[0]; lgc[1] = lgr[1]; hfc[0] = hfr[0]; hfc[1] = hfr[1]; }
        if (pos + 1 < NCH) {
            const size_t tokn = (size_t)b * TPB + chunk_at(D, pos + 1) * 128;
#pragma unroll
            for (int k = 0; k < 2; ++k) {
                const int idx = tid + k * 512;
                xr[k] = *(const u32x4*)(WS_LXC(p) + (tokn + (idx >> 3)) * 1024 + j * 64 + (idx & 7) * 8);
                if (D == 1) { lgr[k] = *(const u32x4*)(WS_P(p) + (tokn + (idx >> 3)) * LDP + C_LG + j * 64 + (idx & 7) * 8); hfr[k] = *(const u32x4*)(WS_MIX(p) + (tokn + (idx >> 3)) * MIXW + j * 64 + (idx & 7) * 8); }
            }
        }
        lds_barrier();
        {
            f32x16 ga, gx;
#pragma unroll
            for (int r = 0; r < 16; ++r) { ga[r] = 0.f; gx[r] = 0.f; }
            mm32<64>(ga, sX + mi * 32 * 72, 72, sW + (nj * 32) * 72, 72, lane);
            mm32<64>(gx, sX + mi * 32 * 72, 72, sW + (64 + nj * 32) * 72, 72, lane);
#pragma unroll
            for (int r = 0; r < 16; ++r) {
                const int tl = mi * 32 + rowmap32(r, lane);
                const float rg = sigmf(ga[r] + ba), ig = sigmf(gx[r] + bx);
                const float a = __expf(-8.f * rg * sp), mult = __builtin_amdgcn_sqrtf(fmaxf(1.f - a * a, 0.f));
                const float xv = bf2f(sX[tl * 72 + cl]);
                sA[tl * 64 + cl] = a; sB[tl * 64 + cl] = mult * ig * xv;
            }
        }
        lds_barrier();
        {
            float A = 1.f, Bc = 0.f;
#pragma unroll
            for (int q = 0; q < 16; ++q) { const int tl = seg * 16 + (D == 0 ? q : 15 - q); const float a = sA[tl * 64 + ch], bb = sB[tl * 64 + ch]; A = a * A; Bc = a * Bc + bb; }
            sSA[seg * 64 + ch] = A; sSB[seg * 64 + ch] = Bc;
        }
        lds_barrier();
        {
            float h = carry, cn = carry;
            const int myord = D == 0 ? seg : 7 - seg;
#pragma unroll
            for (int s = 0; s < 8; ++s) { const int sg = D == 0 ? s : 7 - s; const float a = sSA[sg * 64 + ch], bb = sSB[sg * 64 + ch]; cn = a * cn + bb; if (s < myord) h = cn; }
            carry = cn;
#pragma unroll
            for (int q = 0; q < 16; ++q) { const int tl = seg * 16 + (D == 0 ? q : 15 - q); h = sA[tl * 64 + ch] * h + sB[tl * 64 + ch]; sOut[tl * 72 + ch] = f2bf(h); }
        }
        lds_barrier();
#pragma unroll
        for (int k = 0; k < 2; ++k) {
            const int idx = tid + k * 512, rr = idx >> 3, ck = idx & 7;
            const u32x4 hv = *(const u32x4*)(sOut + rr * 72 + ck * 8);
            bf16_t* dst = SCR ? WS_P(p) + (tok0 + rr) * LDP + j * 64 + ck * 8 : WS_MIX(p) + (tok0 + rr) * MIXW + j * 64 + ck * 8;
            if (D == 0) *(u32x4*)dst = hv;
            else {
                const f32x8 a = unpack8(hv), f = unpack8(hfc[k]), g = unpack8(lgc[k]);
                f32x8 o;
#pragma unroll
                for (int e = 0; e < 8; ++e) o[e] = (a[e] + f[e]) * siluf(g[e]);
                *(u32x4*)dst = pack8(o);
            }
        }
    }
}

__device__ __forceinline__ void prep_elem(const Params& p, int l, int G) {
    const int gt = (int)blockIdx.x * 512 + tidx(), NT = G * 512;
    constexpr int NI = (NTOK / 4) * 192;
#pragma unroll 1
    for (int idx = gt; idx < NI; idx += NT) {
        const int tok = (idx / 192) * 4, cgi = idx % 192, b = tok / TPB, t = tok % TPB;
        const int lo = t < 256 ? 0 : 256, hi = t < 256 ? 256 : TPB;
        int col, CS, rs; const float *cw, *cb; bf16_t* dst; bool act;
        if (cgi < 128) { col = C_LX + cgi * 8; cw = p.lru_conv_w + l * 4096 + cgi * 8; CS = 1024; cb = p.lru_conv_b + l * 1024 + cgi * 8; act = false; dst = WS_LXC(p) + (size_t)tok * 1024 + cgi * 8; rs = 1024; }
        else { const int c2 = (cgi - 128) * 8; col = C_XBC + 1024 + c2; cw = p.ssd_conv_w + l * 6144 + 1024 + c2; CS = 1536; cb = p.ssd_conv_b + l * 1536 + 1024 + c2; act = true; dst = WS_SBC(p) + (size_t)tok * 512 + c2; rs = 512; }
        const bf16_t* src = WS_P(p) + (size_t)b * TPB * LDP + col;
        u32x4 raw[7];
#pragma unroll
        for (int r = 0; r < 7; ++r) { const int tt = t - 2 + r; raw[r] = (tt >= lo && tt < hi) ? *(const u32x4*)(src + (size_t)tt * LDP) : (u32x4){0u, 0u, 0u, 0u}; }
        const f32x4 b0 = *(const f32x4*)cb, b1 = *(const f32x4*)(cb + 4);
        f32x8 acc[4];
#pragma unroll
        for (int o = 0; o < 4; ++o) { acc[o][0] = b0.x; acc[o][1] = b0.y; acc[o][2] = b0.z; acc[o][3] = b0.w; acc[o][4] = b1.x; acc[o][5] = b1.y; acc[o][6] = b1.z; acc[o][7] = b1.w; }
#pragma unroll
        for (int k = 0; k < 4; ++k) {
            const f32x4 w0 = *(const f32x4*)(cw + k * CS), w1 = *(const f32x4*)(cw + k * CS + 4);
#pragma unroll
            for (int o = 0; o < 4; ++o) {
                const f32x8 v = unpack8(raw[o + k]);
                acc[o][0] += w0.x * v[0]; acc[o][1] += w0.y * v[1]; acc[o][2] += w0.z * v[2]; acc[o][3] += w0.w * v[3];
                acc[o][4] += w1.x * v[4]; acc[o][5] += w1.y * v[5]; acc[o][6] += w1.z * v[6]; acc[o][7] += w1.w * v[7];
            }
        }
#pragma unroll
        for (int o = 0; o < 4; ++o) {
            if (act) {
#pragma unroll
                for (int e = 0; e < 8; ++e) acc[o][e] = siluf(acc[o][e]);
            }
            *(u32x4*)(dst + (size_t)o * rs) = pack8(acc[o]);
        }
    }
}
struct PrepTile { int col0, ch0, t0, lo, hi, conv; const bf16_t* Pb; bf16_t* dst; };
__device__ __forceinline__ PrepTile prep_tile_decode(const Params& p, int item) {
    PrepTile T;
    const int t24 = item % 24, bc = item / 24, c = bc % NCH, b = bc / NCH;
    T.t0 = c * 128; T.Pb = WS_P(p) + (size_t)b * TPB * LDP; T.ch0 = 0; T.conv = t24 < 20;
    if (t24 < 16) { T.ch0 = t24 * 64; T.col0 = C_XBC + T.ch0; T.dst = WS_SXT(p) + ((size_t)((b * 18 + c) * 16 + t24)) * 8192; }
    else if (t24 < 20) { const int q = t24 - 16, g = q >> 1, nh = q & 1; T.ch0 = 1024 + g * 128 + nh * 64; T.col0 = C_XBC + T.ch0; T.dst = WS_SBT(p) + ((size_t)((b * 18 + c) * 2 + g)) * 16384 + (size_t)nh * 64 * 128; }
    else { const int q = t24 - 20, kh = q >> 1, dh = q & 1; T.col0 = C_V + kh * 128 + dh * 64; T.dst = WS_VT(p) + ((size_t)((b * 18 + c) * 2 + kh)) * 16384 + (size_t)dh * 64 * 128; }
    T.lo = T.t0 < 256 ? 0 : 256; T.hi = T.t0 < 256 ? 256 : TPB;
    return T;
}
__device__ __forceinline__ void prep_tile_load(const PrepTile& T, int tid, u32x4 (&raw)[2][4]) {
#pragma unroll
    for (int k = 0; k < 2; ++k) {
        const int idx = tid + k * 512, cgi = idx & 7, t = T.t0 + (idx >> 3);
#pragma unroll
        for (int q = 0; q < 4; ++q) {
            const int tt = T.conv ? t - 2 + q : t;
            const bool ok = T.conv ? (tt >= T.lo && tt < T.hi) : (q == 2);
            raw[k][q] = ok ? *(const u32x4*)(T.Pb + (size_t)tt * LDP + T.col0 + cgi * 8) : (u32x4){0u, 0u, 0u, 0u};
        }
    }
}
__device__ __forceinline__ void prep_tile_finish(const Params& p, int l, const PrepTile& T, int tid, const u32x4 (&raw)[2][4], unsigned char* shm) {
    bf16_t* sT = (bf16_t*)shm;
    const float* cw = p.ssd_conv_w + l * 6144 + T.ch0; const float* cb = p.ssd_conv_b + l * 1536 + T.ch0;
    lds_barrier();
#pragma unroll
    for (int k = 0; k < 2; ++k) {
        const int idx = tid + k * 512, cgi = idx & 7, tl = idx >> 3;
        f32x8 acc;
        if (T.conv) {
            const f32x4 b0 = *(const f32x4*)(cb + cgi * 8), b1 = *(const f32x4*)(cb + cgi * 8 + 4);
            acc[0] = b0.x; acc[1] = b0.y; acc[2] = b0.z; acc[3] = b0.w; acc[4] = b1.x; acc[5] = b1.y; acc[6] = b1.z; acc[7] = b1.w;
#pragma unroll
            for (int q = 0; q < 4; ++q) {
                const f32x8 v = unpack8(raw[k][q]);
                const f32x4 w0 = *(const f32x4*)(cw + q * 1536 + cgi * 8), w1 = *(const f32x4*)(cw + q * 1536 + cgi * 8 + 4);
                acc[0] += w0.x * v[0]; acc[1] += w0.y * v[1]; acc[2] += w0.z * v[2]; acc[3] += w0.w * v[3];
                acc[4] += w1.x * v[4]; acc[5] += w1.y * v[5]; acc[6] += w1.z * v[6]; acc[7] += w1.w * v[7];
            }
#pragma unroll
            for (int e = 0; e < 8; ++e) acc[e] = siluf(acc[e]);
        } else acc = unpack8(raw[k][2]);
#pragma unroll
        for (int e = 0; e < 8; ++e) sT[(cgi * 8 + e) * 130 + tl] = f2bf(acc[e]);
    }
    lds_barrier();
#pragma unroll
    for (int k = 0; k < 2; ++k) {
        const int idx = tid + k * 512, r = idx >> 4, ck = idx & 15;
        const unsigned* sp = (const unsigned*)(sT + r * 130 + ck * 8);
        u32x4 o; o.x = sp[0]; o.y = sp[1]; o.z = sp[2]; o.w = sp[3];
        *(u32x4*)(T.dst + r * 128 + ck * 8) = o;
    }
}
__device__ __forceinline__ void prep_tiles(const Params& p, int l, int bid, int G, unsigned char* shm) {
    const int tid = tidx();
    if (bid >= 3456) return;
    u32x4 raw[2][4], nraw[2][4];
    { const PrepTile T0 = prep_tile_decode(p, bid); prep_tile_load(T0, tid, raw); }
#pragma unroll 1
    for (int it = bid; it < 3456; it += G) {
        const bool more = it + G < 3456;
        if (more) { const PrepTile Tn = prep_tile_decode(p, it + G); prep_tile_load(Tn, tid, nraw); }
        { const PrepTile T = prep_tile_decode(p, it); prep_tile_finish(p, l, T, tid, raw, shm); }
        if (more) {
#pragma unroll
            for (int k = 0; k < 2; ++k)
#pragma unroll
                for (int q = 0; q < 4; ++q) raw[k][q] = nraw[k][q];
        }
    }
}
__device__ __forceinline__ void prep_dt_item(const Params& p, int l, int item) {
    const int tid = tidx();
    const int c = item % NCH, b = item / NCH;
    const int col32 = tid >> 4, h = col32 >> 1, d = col32 & 1, lane16 = tid & 15, seg = d == 0 ? lane16 : 15 - lane16;
    const float A = -__expf(p.ssd_A_log[(l * 2 + d) * 16 + h]), bias = p.ssd_dt_bias[(l * 2 + d) * 16 + h];
    const float* src = WS_DTP(p) + ((size_t)b * TPB + c * 128) * 16 + h;
    float dtv[8], cs[8], run = 0.f;
    float rawv[8];
#pragma unroll
    for (int q = 0; q < 8; ++q) { const int j = seg * 8 + (d == 0 ? q : 7 - q); rawv[q] = src[j * 16]; }
#pragma unroll
    for (int q = 0; q < 8; ++q) { dtv[q] = softplusf(rawv[q] + bias); run += dtv[q] * A; cs[q] = run; }
    float incl = run;
#pragma unroll
    for (int off = 1; off < 16; off <<= 1) { const float v = __shfl_up(incl, off, 16); if (lane16 >= off) incl += v; }
    const float excl = incl - run;
    float* dta = WS_DTA(p) + ((size_t)(b * 18 + c) * 128) * 32 + col32;
    float* acs = WS_ACS(p) + ((size_t)(b * 18 + c) * 128) * 32 + col32;
#pragma unroll
    for (int q = 0; q < 8; ++q) { const int j = seg * 8 + (d == 0 ? q : 7 - q); dta[j * 32] = dtv[q]; acs[j * 32] = cs[q] + excl; }
    if (lane16 == 15) WS_AL(p)[((b * 2 + d) * 18 + c) * 16 + h] = incl;
}
__device__ __forceinline__ void ssd_states_item(const Params& p, int l, int item, unsigned char* shm) {
    const int tid = tidx(), lane = tid & 63, wave = tid >> 6;
    const int g = item & 1, hh0 = ((item >> 1) & 1) * 4, bc = item >> 2, c = bc % NCH, b = bc / NCH;
    bf16_t* sBT = (bf16_t*)shm; bf16_t* sXw = (bf16_t*)(shm + 34816);
    float* sDt = (float*)(shm + 69632); float* sAcs = (float*)(shm + 77824); bf16_t* sO = (bf16_t*)(shm + 86016); float* sWg = (float*)(shm + 120832);
    const bf16_t* xt = WS_SXT(p) + ((size_t)((b * 18 + c) * 16 + g * 8)) * 8192;
    const bf16_t* btp = WS_SBT(p) + ((size_t)((b * 18 + c) * 2 + g)) * 16384;
    lds_barrier();
    {
        const size_t o = ((size_t)(b * 18 + c) * 128 + (tid >> 2)) * 32 + g * 16 + (tid & 3) * 4;
        const f32x4 vdt = *(const f32x4*)(WS_DTA(p) + o), vac = *(const f32x4*)(WS_ACS(p) + o);
        u32x4 bt[4];
#pragma unroll
        for (int k = 0; k < 4; ++k) { const int idx = tid + k * 512; bt[k] = *(const u32x4*)(btp + (idx >> 4) * 128 + (idx & 15) * 8); }
        *(f32x4*)(sDt + (tid >> 2) * 16 + (tid & 3) * 4) = vdt; *(f32x4*)(sAcs + (tid >> 2) * 16 + (tid & 3) * 4) = vac;
#pragma unroll
        for (int k = 0; k < 4; ++k) { const int idx = tid + k * 512; *(u32x4*)(sBT + (idx >> 4) * 136 + (idx & 15) * 8) = bt[k]; }
    }
    u32x4 xr[2];
#pragma unroll
    for (int k = 0; k < 2; ++k) { const int idx = tid + k * 512; xr[k] = *(const u32x4*)(xt + (size_t)hh0 * 8192 + (idx >> 4) * 128 + (idx & 15) * 8); }
    lds_barrier();
#pragma unroll
    for (int k = 0; k < 4; ++k) { const int idx = tid + k * 512, jj = idx >> 4, col = idx & 15; const float al = (col & 1) == 0 ? sAcs[127 * 16 + col] : sAcs[col]; sWg[col * 128 + jj] = __expf(al - sAcs[jj * 16 + col]) * sDt[jj * 16 + col]; }
#pragma unroll 1
    for (int hh = hh0; hh < hh0 + 4; ++hh) {
        const int h = g * 8 + hh;
        u32x4 xn[2] = {xr[0], xr[1]};
        if (hh < hh0 + 3) {
#pragma unroll
            for (int k = 0; k < 2; ++k) { const int idx = tid + k * 512; xn[k] = *(const u32x4*)(xt + (size_t)(hh + 1) * 8192 + (idx >> 4) * 128 + (idx & 15) * 8); }
        }
        lds_barrier();
#pragma unroll
        for (int k = 0; k < 2; ++k) {
            const int idx = tid + k * 512, pp = idx >> 4, j8 = (idx & 15) * 8;
            const f32x8 xv = unpack8(xr[k]);
#pragma unroll
            for (int d = 0; d < 2; ++d) {
                const f32x4 w0 = *(const f32x4*)(sWg + (hh * 2 + d) * 128 + j8), w1 = *(const f32x4*)(sWg + (hh * 2 + d) * 128 + j8 + 4);
                f32x8 o;
                o[0] = xv[0] * w0.x; o[1] = xv[1] * w0.y; o[2] = xv[2] * w0.z; o[3] = xv[3] * w0.w; o[4] = xv[4] * w1.x; o[5] = xv[5] * w1.y; o[6] = xv[6] * w1.z; o[7] = xv[7] * w1.w;
                *(u32x4*)(sXw + d * 8704 + pp * 136 + j8) = pack8(o);
            }
        }
        lds_barrier();
        const int mi = wave & 1, nj = wave >> 1;
#pragma unroll
        for (int d = 0; d < 2; ++d) {
            f32x16 acc;
#pragma unroll
            for (int r = 0; r < 16; ++r) acc[r] = 0.f;
            mm32<128>(acc, sXw + d * 8704 + mi * 32 * 136, 136, sBT + nj * 32 * 136, 136, lane);
#pragma unroll
            for (int r = 0; r < 16; ++r) sO[d * 8704 + (mi * 32 + rowmap32(r, lane)) * 136 + nj * 32 + (lane & 31)] = f2bf(acc[r]);
        }
        lds_barrier();
#pragma unroll
        for (int d = 0; d < 2; ++d) {
            bf16_t* base = WS_ST(p) + ((size_t)((b * 2 + d) * 18 + c) * 16 + h) * 8192;
#pragma unroll
            for (int k = 0; k < 2; ++k) { const int idx = tid + k * 512; *(u32x4*)(base + idx * 8) = *(const u32x4*)(sO + d * 8704 + (idx >> 4) * 136 + (idx & 15) * 8); }
        }
        xr[0] = xn[0]; xr[1] = xn[1];
    }
}
__device__ __forceinline__ void ssd_recur_item(const Params& p, int item) {
    const int tid = tidx();
    const int d = item & 1, h = (item >> 1) & 15, b = item >> 5;
    u32x4 s0[NCH], s1[NCH]; float ev[NCH];
#pragma unroll
    for (int pos = 0; pos < NCH; ++pos) {
        const int c = chunk_at(d, pos);
        const bf16_t* ptr = WS_ST(p) + ((size_t)((b * 2 + d) * 18 + c) * 16 + h) * 8192 + tid * 16;
        s0[pos] = *(const u32x4*)ptr; s1[pos] = *(const u32x4*)(ptr + 8);
        ev[pos] = WS_AL(p)[((b * 2 + d) * 18 + c) * 16 + h];
    }
    f32x8 h0, h1;
#pragma unroll
    for (int e = 0; e < 8; ++e) { h0[e] = 0.f; h1[e] = 0.f; }
#pragma unroll
    for (int pos = 0; pos < NCH; ++pos) {
        const int c = chunk_at(d, pos);
        bf16_t* ptr = WS_ST(p) + ((size_t)((b * 2 + d) * 18 + c) * 16 + h) * 8192 + tid * 16;
        *(u32x4*)ptr = pack8(h0); *(u32x4*)(ptr + 8) = pack8(h1);
        const float e = __expf(ev[pos]);
        h0 = h0 * e + unpack8(s0[pos]); h1 = h1 * e + unpack8(s1[pos]);
    }
}
template <int MODE>
__device__ __forceinline__ void ssd_final_item(const Params& p, int l, int item, unsigned char* shm) {
    const int tid = tidx(), lane = tid & 63, wave = tid >> 6;
    const int g = item & 1, hh0 = ((item >> 1) & 1) * 4, bc = item >> 2, c = bc % NCH, b = bc / NCH, t0 = c * 128;
    const size_t tok0 = (size_t)b * TPB + t0;
    bf16_t* sC = (bf16_t*)shm; bf16_t* sBW = (bf16_t*)(shm + 34816); bf16_t* sXT = (bf16_t*)(shm + 69632); bf16_t* sH = (bf16_t*)(shm + 87040);
    float* sDt = (float*)(shm + 104448); float* sAcs = (float*)(shm + 112640);
    bf16_t* sY = sBW;
    const bf16_t* xt = WS_SXT(p) + ((size_t)((b * 18 + c) * 16 + g * 8)) * 8192;
    const bf16_t* zt = WS_P(p) + tok0 * LDP + C_Z + g * 512;
    const bf16_t* hin0 = WS_ST(p) + ((size_t)((b * 2 + 0) * 18 + c) * 16 + g * 8) * 8192;
    const bf16_t* hin1 = WS_ST(p) + ((size_t)((b * 2 + 1) * 18 + c) * 16 + g * 8) * 8192;
    lds_barrier();
    u32x4 xr[2], zr[2], h0r[2];
    {
        const size_t o = ((size_t)(b * 18 + c) * 128 + (tid >> 2)) * 32 + g * 16 + (tid & 3) * 4;
        const f32x4 vdt = *(const f32x4*)(WS_DTA(p) + o), vac = *(const f32x4*)(WS_ACS(p) + o);
        u32x4 cr[4], br[4];
#pragma unroll
        for (int k = 0; k < 4; ++k) { const int idx = tid + k * 512; const bf16_t* s = WS_SBC(p) + (tok0 + (idx >> 4)) * 512 + g * 128 + (idx & 15) * 8; br[k] = *(const u32x4*)s; cr[k] = *(const u32x4*)(s + 256); }
#pragma unroll
        for (int k = 0; k < 2; ++k) {
            const int idx = tid + k * 512;
            xr[k] = *(const u32x4*)(xt + (size_t)hh0 * 8192 + (idx >> 4) * 128 + (idx & 15) * 8);
            zr[k] = *(const u32x4*)(zt + (size_t)(idx >> 3) * LDP + hh0 * 64 + (idx & 7) * 8);
            h0r[k] = *(const u32x4*)(hin0 + (size_t)hh0 * 8192 + idx * 8);
        }
        *(f32x4*)(sDt + (tid >> 2) * 16 + (tid & 3) * 4) = vdt; *(f32x4*)(sAcs + (tid >> 2) * 16 + (tid & 3) * 4) = vac;
#pragma unroll
        for (int k = 0; k < 4; ++k) { const int idx = tid + k * 512; *(u32x4*)(sC + (idx >> 4) * 136 + (idx & 15) * 8) = cr[k]; *(u32x4*)(sBW + (idx >> 4) * 136 + (idx & 15) * 8) = br[k]; }
    }
    lds_barrier();
    const int cmi = wave >> 1, cnj0 = (wave & 1) * 2;
    f32x16 cb0, cb1;
#pragma unroll
    for (int r = 0; r < 16; ++r) { cb0[r] = 0.f; cb1[r] = 0.f; }
    mm32<128>(cb0, sC + cmi * 32 * 136, 136, sBW + cnj0 * 32 * 136, 136, lane);
    mm32<128>(cb1, sC + cmi * 32 * 136, 136, sBW + (cnj0 + 1) * 32 * 136, 136, lane);
    const int ymi = wave & 3, ynj = wave >> 2;
#pragma unroll 1
    for (int hh = hh0; hh < hh0 + 4; ++hh) {
        const int h = g * 8 + hh;
        lds_barrier();
#pragma unroll
        for (int k = 0; k < 2; ++k) { const int idx = tid + k * 512; *(u32x4*)(sXT + (idx >> 4) * 136 + (idx & 15) * 8) = xr[k]; *(u32x4*)(sH + (idx >> 4) * 136 + (idx & 15) * 8) = h0r[k]; }
        u32x4 h1r[2];
#pragma unroll
        for (int k = 0; k < 2; ++k) h1r[k] = *(const u32x4*)(hin1 + (size_t)hh * 8192 + (tid + k * 512) * 8);
        f32x16 yacc;
        const int colf = hh * 2, colr = hh * 2 + 1;
        if (MODE < 2) {
            float acif[16], acir[16];
#pragma unroll
            for (int r = 0; r < 16; ++r) { const int ig = cmi * 32 + rowmap32(r, lane); acif[r] = sAcs[ig * 16 + colf]; acir[r] = sAcs[ig * 16 + colr]; }
#pragma unroll
            for (int tt = 0; tt < 2; ++tt) {
                const int jg = (cnj0 + tt) * 32 + (lane & 31);
                const float acjf = sAcs[jg * 16 + colf], dtjf = sDt[jg * 16 + colf], acjr = sAcs[jg * 16 + colr], dtjr = sDt[jg * 16 + colr];
                const int dj0 = jg - cmi * 32 - 4 * (lane >> 5);
#pragma unroll
                for (int r = 0; r < 16; ++r) {
                    const int sd = dj0 - ((r & 3) + 8 * (r >> 2));
                    const bool fwd = sd <= 0;
                    const float arg = fwd ? acif[r] - acjf : acir[r] - acjr, sc = fwd ? dtjf : dtjr;
                    const float cbv = tt == 0 ? cb0[r] : cb1[r];
                    float val = cbv * __expf(arg) * sc;
                    val += sd == 0 ? cbv * dtjr : 0.f;
                    sBW[(cmi * 32 + rowmap32(r, lane)) * 136 + jg] = f2bf(val);
                }
            }
        }
        lds_barrier();
        {
            f32x16 ad, ao;
#pragma unroll
            for (int r = 0; r < 16; ++r) { ad[r] = 0.f; ao[r] = 0.f; }
            if (MODE < 3) { mm32<128>(ad, sBW + ymi * 32 * 136, 136, sXT + ynj * 32 * 136, 136, lane);
            mm32<128>(ao, sC + ymi * 32 * 136, 136, sH + ynj * 32 * 136, 136, lane); }
#pragma unroll
            for (int r = 0; r < 16; ++r) { const int ig = ymi * 32 + rowmap32(r, lane); yacc[r] = ad[r] + __expf(sAcs[ig * 16 + colf]) * ao[r]; }
        }
        if (hh < hh0 + 3) {
#pragma unroll
            for (int k = 0; k < 2; ++k) {
                const int idx = tid + k * 512;
                xr[k] = *(const u32x4*)(xt + (size_t)(hh + 1) * 8192 + (idx >> 4) * 128 + (idx & 15) * 8);
                h0r[k] = *(const u32x4*)(hin0 + (size_t)(hh + 1) * 8192 + idx * 8);
            }
        }
        lds_barrier();
#pragma unroll
        for (int k = 0; k < 2; ++k) { const int idx = tid + k * 512; *(u32x4*)(sH + (idx >> 4) * 136 + (idx & 15) * 8) = h1r[k]; }
        lds_barrier();
        {
            f32x16 ao;
#pragma unroll
            for (int r = 0; r < 16; ++r) ao[r] = 0.f;
            if (MODE < 3) mm32<128>(ao, sC + ymi * 32 * 136, 136, sH + ynj * 32 * 136, 136, lane);
#pragma unroll
            for (int r = 0; r < 16; ++r) { const int ig = ymi * 32 + rowmap32(r, lane); yacc[r] += __expf(sAcs[ig * 16 + colr]) * ao[r]; }
        }
        const float Dh = p.ssd_D[l * 16 + h];
        const int pl = ynj * 32 + (lane & 31);
#pragma unroll
        for (int r = 0; r < 16; ++r) { const int ig = ymi * 32 + rowmap32(r, lane); yacc[r] += Dh * bf2f(sXT[pl * 136 + ig]); }
        lds_barrier();
#pragma unroll
        for (int r = 0; r < 16; ++r) { const int ig = ymi * 32 + rowmap32(r, lane); sY[ig * 72 + pl] = f2bf(yacc[r]); }
        lds_barrier();
#pragma unroll
        for (int k = 0; k < 2; ++k) {
            const int idx = tid + k * 512, rr = idx >> 3, pk = idx & 7;
            const f32x8 yv = unpack8(*(const u32x4*)(sY + rr * 72 + pk * 8)), zv = unpack8(zr[k]);
            f32x8 o;
#pragma unroll
            for (int e = 0; e < 8; ++e) o[e] = yv[e] * siluf(zv[e]);
            if (MODE < 1) *(u32x4*)(WS_MIX(p) + (tok0 + rr) * MIXW + 2048 + h * 64 + pk * 8) = pack8(o); else asm volatile("" :: "v"(o[0]), "v"(o[7]));
        }
        if (hh < hh0 + 3) {
#pragma unroll
            for (int k = 0; k < 2; ++k) { const int idx = tid + k * 512; zr[k] = *(const u32x4*)(zt + (size_t)(idx >> 3) * LDP + (hh + 1) * 64 + (idx & 7) * 8); }
        }
    }
}
__device__ __forceinline__ void ssd_norm_phase(const Params& p, int l, int G) {
    const int lane = tidx() & 63, wave = tidx() >> 6;
    for (int row = blockIdx.x * 8 + wave; row < NTOK; row += G * 8) {
        bf16_t* rp = WS_MIX(p) + (size_t)row * MIXW + 2048;
        f32x8 v0 = unpack8(*(const u32x4*)(rp + lane * 8)), v1 = unpack8(*(const u32x4*)(rp + 512 + lane * 8));
        float ss = 0.f;
#pragma unroll
        for (int e = 0; e < 8; ++e) ss += v0[e] * v0[e] + v1[e] * v1[e];
        ss = wave_sum(ss);
        const float rstd = rsqrtf(ss * (1.f / 1024.f) + 1e-6f);
        const float* nw = p.ssd_norm_w + l * 1024;
#pragma unroll
        for (int e = 0; e < 8; ++e) { v0[e] = v0[e] * rstd * nw[lane * 8 + e]; v1[e] = v1[e] * rstd * nw[512 + lane * 8 + e]; }
        *(u32x4*)(rp + lane * 8) = pack8(v0); *(u32x4*)(rp + 512 + lane * 8) = pack8(v1);
    }
}

template <int MODE>
__device__ __forceinline__ void attn_item(const Params& p, int l, int item, unsigned char* shm) {
    const int tid = tidx(), lane = tid & 63, wave = tid >> 6, fr = lane & 15, fq = lane >> 4;
    const int hp = item & 3, bq = item >> 2, qblk = bq % NCH, b = bq / NCH, kh = hp >> 1;
    const bf16_t* P = WS_P(p);
    bf16_t* sK = (bf16_t*)shm; bf16_t* sVT = (bf16_t*)(shm + 34816); bf16_t* sPw = (bf16_t*)(shm + 69632) + wave * (2 * 16 * 136);
    const size_t tokq0 = (size_t)b * TPB + qblk * 128;
    bf16x8 aq[2][4];
#pragma unroll
    for (int hd = 0; hd < 2; ++hd)
#pragma unroll
        for (int kk = 0; kk < 4; ++kk) aq[hd][kk] = *(const bf16x8*)(P + (tokq0 + wave * 16 + fr) * LDP + C_Q + (hp * 2 + hd) * 128 + kk * 32 + 8 * fq);
    float m[2][4], ls[2][4]; f32x4 O[2][8];
#pragma unroll
    for (int hd = 0; hd < 2; ++hd) {
        const float sink = p.att_sink[l * 8 + hp * 2 + hd];
#pragma unroll
        for (int r = 0; r < 4; ++r) { m[hd][r] = sink; ls[hd][r] = 1.f; }
#pragma unroll
        for (int nd = 0; nd < 8; ++nd) O[hd][nd] = (f32x4){0.f, 0.f, 0.f, 0.f};
    }
    const int nlat = qblk - 2;
    const int kb_lo = nlat - 1 < 0 ? 0 : nlat - 1, kb_hi = nlat + 1 > 15 ? 15 : nlat + 1;
    const int ntl = qblk < 2 ? 2 : 2 + (kb_hi - kb_lo + 1);
    u32x4 kr[4], vr[4];
    const bf16_t* vtb = WS_VT(p) + ((size_t)(b * 18) * 2 + kh) * 16384;
    {
        const bf16_t* kbase = P + ((size_t)b * TPB) * LDP + C_K + kh * 128;
#pragma unroll
        for (int k = 0; k < 4; ++k) { const int idx = tid + k * 512; kr[k] = *(const u32x4*)(kbase + (size_t)(idx >> 4) * LDP + (idx & 15) * 8); vr[k] = *(const u32x4*)(vtb + idx * 8); }
    }
#pragma unroll 1
    for (int ti = 0; ti < ntl; ++ti) {
        const bool masked = ti >= 2; const int kb = kb_lo + (ti - 2);
        lds_barrier();
#pragma unroll
        for (int k = 0; k < 4; ++k) {
            const int idx = tid + k * 512;
            *(u32x4*)(sK + (idx >> 4) * 136 + (idx & 15) * 8) = kr[k];
            *(u32x4*)(sVT + (idx >> 4) * 136 + (idx & 15) * 8) = vr[k];
        }
        if (ti + 1 < ntl) {
            const int tn = ti + 1, t0n = tn < 2 ? tn * 128 : 256 + (kb_lo + (tn - 2)) * 128;
            const bf16_t* kbase = P + ((size_t)b * TPB + t0n) * LDP + C_K + kh * 128;
            const bf16_t* vtn = vtb + (size_t)(t0n >> 7) * 32768;
#pragma unroll
            for (int k = 0; k < 4; ++k) { const int idx = tid + k * 512; kr[k] = *(const u32x4*)(kbase + (size_t)(idx >> 4) * LDP + (idx & 15) * 8); vr[k] = *(const u32x4*)(vtn + idx * 8); }
        }
        lds_barrier();
#pragma unroll 1
        for (int hf = 0; hf < 2; ++hf) {
            f32x4 s[2][4];
#pragma unroll
            for (int nt = 0; nt < 4; ++nt) {
                s[0][nt] = (f32x4){0.f, 0.f, 0.f, 0.f}; s[1][nt] = (f32x4){0.f, 0.f, 0.f, 0.f};
#pragma unroll
                for (int kk = 0; kk < 4; ++kk) {
                    const bf16x8 bk = *(const bf16x8*)(sK + ((hf * 4 + nt) * 16 + fr) * 136 + kk * 32 + 8 * fq);
                    s[0][nt] = __builtin_amdgcn_mfma_f32_16x16x32_bf16(aq[0][kk], bk, s[0][nt], 0, 0, 0);
                    s[1][nt] = __builtin_amdgcn_mfma_f32_16x16x32_bf16(aq[1][kk], bk, s[1][nt], 0, 0, 0);
                }
                __builtin_amdgcn_sched_barrier(0);
            }
            if (masked) {
#pragma unroll
                for (int nt = 0; nt < 4; ++nt)
#pragma unroll
                    for (int r = 0; r < 4; ++r) { const int rel = (nlat * 128 + wave * 16 + fq * 4 + r) - (kb * 128 + (hf * 4 + nt) * 16 + fr); if (rel > 128 || rel < -128) { s[0][nt][r] = -INFINITY; s[1][nt][r] = -INFINITY; } }
            }
#pragma unroll
            for (int hd = 0; hd < 2; ++hd) {
                float alpha[4];
#pragma unroll
                for (int r = 0; r < 4; ++r) {
                    float mx = fmaxf(fmaxf(s[hd][0][r], s[hd][1][r]), fmaxf(s[hd][2][r], s[hd][3][r]));
                    mx = row16_max(mx);
                    const float mn = fmaxf(m[hd][r], mx);
                    alpha[r] = __expf(m[hd][r] - mn); m[hd][r] = mn;
                    float rs = 0.f;
#pragma unroll
                    for (int nt = 0; nt < 4; ++nt) { const float pv = __expf(s[hd][nt][r] - mn); s[hd][nt][r] = pv; rs += pv; }
                    rs = row16_sum(rs);
                    ls[hd][r] = ls[hd][r] * alpha[r] + rs;
                }
#pragma unroll
                for (int nd = 0; nd < 8; ++nd) { O[hd][nd].x *= alpha[0]; O[hd][nd].y *= alpha[1]; O[hd][nd].z *= alpha[2]; O[hd][nd].w *= alpha[3]; }
#pragma unroll
                for (int nt = 0; nt < 4; ++nt)
#pragma unroll
                    for (int r = 0; r < 4; ++r) sPw[hd * (16 * 136) + (fq * 4 + r) * 136 + nt * 16 + fr] = f2bf(s[hd][nt][r]);
            }
            asm volatile("s_waitcnt lgkmcnt(0)" ::: "memory");
#pragma unroll
            for (int kk = 0; kk < 2; ++kk) {
                const bf16x8 ap0 = *(const bf16x8*)(sPw + fr * 136 + kk * 32 + 8 * fq);
                const bf16x8 ap1 = *(const bf16x8*)(sPw + 16 * 136 + fr * 136 + kk * 32 + 8 * fq);
#pragma unroll
                for (int nd = 0; nd < 8; ++nd) {
                    const bf16x8 bv = *(const bf16x8*)(sVT + (nd * 16 + fr) * 136 + hf * 64 + kk * 32 + 8 * fq);
                    O[0][nd] = __builtin_amdgcn_mfma_f32_16x16x32_bf16(ap0, bv, O[0][nd], 0, 0, 0);
                    O[1][nd] = __builtin_amdgcn_mfma_f32_16x16x32_bf16(ap1, bv, O[1][nd], 0, 0, 0);
                    if (nd == 3) __builtin_amdgcn_sched_barrier(0);
                }
                __builtin_amdgcn_sched_barrier(0);
            }
            asm volatile("s_waitcnt lgkmcnt(0)" ::: "memory");
        }
    }
#pragma unroll
    for (int hd = 0; hd < 2; ++hd) {
        const int hq = hp * 2 + hd;
        u32x4 agr[4];
#pragma unroll
        for (int k = 0; k < 4; ++k) { const int idx = tid + k * 512; agr[k] = *(const u32x4*)(P + (tokq0 + (idx >> 4)) * LDP + C_AG + hq * 128 + (idx & 15) * 8); }
        lds_barrier();
#pragma unroll
        for (int r = 0; r < 4; ++r) {
            const float il = __builtin_amdgcn_rcpf(ls[hd][r]);
#pragma unroll
            for (int nd = 0; nd < 8; ++nd) sK[(wave * 16 + fq * 4 + r) * 136 + nd * 16 + fr] = f2bf(O[hd][nd][r] * il);
        }
        lds_barrier();
#pragma unroll
        for (int k = 0; k < 4; ++k) {
            const int idx = tid + k * 512, rr = idx >> 4, ck = idx & 15;
            const f32x8 ov = unpack8(*(const u32x4*)(sK + rr * 136 + ck * 8)), gv = unpack8(agr[k]);
            f32x8 o;
#pragma unroll
            for (int e = 0; e < 8; ++e) o[e] = ov[e] * siluf(gv[e]);
            *(u32x4*)(WS_MIX(p) + (tokq0 + rr) * MIXW + 1024 + hq * 128 + ck * 8) = pack8(o);
        }
    }
}

#define XB_TMO      128
#define XB_XCNT(j)  (256  + 64 * (j))
#define XB_XSUB(j)  (1280 + 64 * (j))
#define XB_XGEN(j)  (2304 + 64 * (j))
#define XB_TOP      3328
#define XB_TOPGEN   3392
#define XCD_BAR_WORDS 3456
#define XB_SPIN_CAP (1u << 18)
#define LAS __attribute__((address_space(3)))
__device__ __forceinline__ unsigned xb_ld(unsigned* p)              { return __hip_atomic_load(p, __ATOMIC_RELAXED, __HIP_MEMORY_SCOPE_AGENT); }
__device__ __forceinline__ unsigned xb_add(unsigned* p, unsigned v) { return __hip_atomic_fetch_add(p, v, __ATOMIC_RELAXED, __HIP_MEMORY_SCOPE_AGENT); }
__device__ __forceinline__ unsigned xb_xcc_id() { return (unsigned)__builtin_amdgcn_s_getreg((3 << 11) | 20) & 0xFu; }
#define XB_SPIN(cond, bar) do { unsigned _sp = 0; while (cond) { __builtin_amdgcn_s_sleep(1); \
    if ((++_sp & 255u) == 0u) { if (xb_ld(&(bar)[XB_TMO])) break; if (_sp > XB_SPIN_CAP) { atomicAdd(&(bar)[XB_TMO], 1u); break; } } } } while (0)
struct XcdBarrier { unsigned* bar; unsigned x; volatile LAS unsigned* st; };
__device__ __forceinline__ XcdBarrier xcd_barrier_post(unsigned* bar, volatile LAS unsigned* st) {
    XcdBarrier b; b.bar = bar; b.x = xb_xcc_id(); b.st = st;
    if (tidx() == 0) (void)xb_add(&bar[XB_XCNT(b.x)], 1u);
    return b;
}
__device__ __forceinline__ void xcd_barrier_complete(unsigned* bar, unsigned x, unsigned& nloc, unsigned& nx) {
    const unsigned G = gridDim.x * gridDim.y * gridDim.z;
    unsigned sum, cnt, mine, sp = 0u;
    for (;;) {
        sum = 0u; cnt = 0u; mine = 0u;
#pragma unroll
        for (unsigned j = 0; j < 16; ++j) { const unsigned c = xb_ld(&bar[XB_XCNT(j)]); sum += c; cnt += (c > 0u) ? 1u : 0u; mine = (j == x) ? c : mine; }
        if (sum == G) break;
        __builtin_amdgcn_s_sleep(1);
        if ((++sp & 255u) == 0u) { if (xb_ld(&bar[XB_TMO])) break; if (sp > XB_SPIN_CAP) { atomicAdd(&bar[XB_TMO], 1u); break; } }
    }
    nloc = mine > 0u ? mine : 1u; nx = cnt > 0u ? cnt : 1u;
}
__device__ __forceinline__ void xcd_barrier(const XcdBarrier& b) {
    asm volatile("s_waitcnt vmcnt(0)" ::: "memory");
    __syncthreads();
    if (tidx() == 0) {
        unsigned* bar = b.bar;
        __builtin_amdgcn_s_waitcnt(0);
        unsigned nloc = b.st[0], nx = b.st[1];
        if (nloc == 0u) { xcd_barrier_complete(bar, b.x, nloc, nx); b.st[0] = nloc; b.st[1] = nx; }
        const unsigned old = xb_add(&bar[XB_XSUB(b.x)], 1u);
        const unsigned gen = old / nloc;
        if (old + 1u == (gen + 1u) * nloc) {
            __builtin_amdgcn_fence(__ATOMIC_RELEASE, "agent");
            asm volatile("s_waitcnt vmcnt(0)" ::: "memory");
            const unsigned og = xb_add(&bar[XB_TOP], 1u);
            const unsigned tg = og / nx;
            if (og + 1u == (tg + 1u) * nx) xb_add(&bar[XB_TOPGEN], 1u);
            else XB_SPIN(xb_ld(&bar[XB_TOPGEN]) == tg, bar);
            __builtin_amdgcn_fence(__ATOMIC_ACQUIRE, "agent");
            xb_add(&bar[XB_XGEN(b.x)], 1u);
            asm volatile("s_waitcnt vmcnt(0)" ::: "memory");
        } else {
            XB_SPIN(xb_ld(&bar[XB_XGEN(b.x)]) == gen, bar);
            __builtin_amdgcn_fence(__ATOMIC_ACQUIRE, "agent");
            asm volatile("s_waitcnt vmcnt(0)" ::: "memory");
        }
    }
    __syncthreads();
}


#define QUEUE_LOOP(ctr, NITEMS, BODY) do { \
    volatile LAS unsigned* _mb = (volatile LAS unsigned*)(shm + LDS_CTL + 8); \
    int it = bid; \
    while (it < (NITEMS)) { \
        unsigned _nx = 0u; if (tidx() == 0) _nx = xb_add((ctr), 1u) + (unsigned)G; \
        BODY; \
        __syncthreads(); \
        if (tidx() == 0) _mb[0] = _nx; \
        __syncthreads(); \
        it = (int)_mb[0]; \
    } } while (0)

__global__ __launch_bounds__(512) void mega(Params p) {
    extern __shared__ __attribute__((aligned(16))) unsigned char shm[];
    cg::grid_group grid = cg::this_grid();
    const int G = (int)gridDim.x, bid = (int)blockIdx.x;
    if (tidx() < 4) ((volatile LAS unsigned*)(shm + LDS_CTL))[tidx()] = 0u;
    __syncthreads();
    unsigned* qctr = (unsigned*)(p.ws + OFF_BAR) + 3584;
    const XcdBarrier xb = xcd_barrier_post((unsigned*)(p.ws + OFF_BAR), (volatile LAS unsigned*)(shm + LDS_CTL));
    for (int rep = 0; rep < 1 + DUP_P0; ++rep) phase0(p, shm, G);
    grid.sync();
#pragma unroll 1
    for (int l = 0; l < 4; ++l) {
        for (int rep = 0; rep < 1 + DUP_NORM; ++rep) norm_phase(p, l, G);
        xcd_barrier(xb);
        {
            pg8::Gemm g{WS_U(p), WS_WTIN(p) + (size_t)l * 7424 * 2048, NTOK, 7168, 2048};
            pg8::Order S; S.init(72, 28, G, bid, 0);
            EpiG1 E{WS_P(p)};
            for (int rep = 0; rep < 1 + DUP_G1; ++rep) pg8::gemm_phase<EpiG1, pg8::Order>((PG8_LAS unsigned char*)shm, g, S, E);
            {
                const int tq = tidx(), wave = tq >> 6, lane = tq & 63, fr = lane & 15, fq = lane >> 4;
                for (int wu = bid * 8 + wave; wu < NTOK / 16; wu += G * 8) {
                    const bf16_t* ap = WS_U(p) + (size_t)(wu * 16 + fr) * 2048 + 8 * fq;
                    const bf16_t* bp = WS_WTIN(p) + ((size_t)l * 7424 + 7168 + fr) * 2048 + 8 * fq;
                    f32x4 acc = (f32x4){0.f, 0.f, 0.f, 0.f};
#pragma unroll 8
                    for (int kk = 0; kk < 64; ++kk) { const bf16x8 a = *(const bf16x8*)(ap + kk * 32), bq = *(const bf16x8*)(bp + kk * 32); acc = __builtin_amdgcn_mfma_f32_16x16x32_bf16(a, bq, acc, 0, 0, 0); }
#pragma unroll
                    for (int r = 0; r < 4; ++r) WS_DTP(p)[(size_t)(wu * 16 + fq * 4 + r) * 16 + fr] = acc[r];
                }
            }
        }
        for (int rep = 0; rep < 1 + DUP_SYNC; ++rep) xcd_barrier(xb);
        for (int rep = 0; rep < 1 + DUP_E1; ++rep) {
            if (rep == 0 || E1SEL == 0 || E1SEL == 1) for (int it = bid; it < 144; it += G) prep_dt_item(p, l, it);
            if (rep == 0 || E1SEL == 0 || E1SEL == 2) { __syncthreads(); prep_tiles(p, l, bid, G, shm); }
            if (rep == 0 || E1SEL == 0 || E1SEL == 3) prep_elem(p, l, G);
        }
        { const int tq = tidx(), wave = tq >> 6, lane = tq & 63; for (int row = bid * 8 + wave; row < NTOK; row += G * 8) qkprep_row<0>(p, l, row, lane);
#if DUP_QK
          for (int row = bid * 8 + wave; row < NTOK; row += G * 8) qkprep_row<1>(p, l, row, lane);
#endif
        }
        xcd_barrier(xb);
        QUEUE_LOOP(qctr + (l * 3 + 0) * 64, 128 + 576, { if (it < 128) lru_sweep_item<0>(p, l, it, shm); else ssd_states_item(p, l, it - 128, shm); });
#if DUP_X1Q
        __syncthreads(); QUEUE_LOOP(qctr + (12 + l * 3 + 0) * 64, 128 + 576, { if (it < 128) lru_sweep_item<0>(p, l, it, shm); else ssd_states_item(p, l, it - 128, shm); });
#endif
#if DUP_SWEEP
        __syncthreads(); for (int it = bid; it < 128; it += G) lru_sweep_item<0>(p, l, it, shm);
#endif
#if DUP_STATES
        __syncthreads(); for (int it = bid; it < 256; it += G) ssd_states_item(p, l, it, shm);
#endif
        xcd_barrier(xb);
        QUEUE_LOOP(qctr + (l * 3 + 1) * 64, 256 + 576, { if (it < 256) ssd_recur_item(p, it); else attn_item<0>(p, l, it - 256, shm); });
#if DUP_ATTQ
        __syncthreads(); QUEUE_LOOP(qctr + (12 + l * 3 + 1) * 64, 576, { attn_item<AMODE>(p, l, it, shm); });
#endif
        xcd_barrier(xb);
        QUEUE_LOOP(qctr + (l * 3 + 2) * 64, 128 + 576, { if (it < 128) lru_sweep_item<1>(p, l, it, shm); else ssd_final_item<0>(p, l, it - 128, shm); });
#if DUP_FINAL
        __syncthreads(); for (int it = bid; it < 256; it += G) ssd_final_item<FMODE>(p, l, it, shm);
#endif
#if DUP_SWEEP1
        __syncthreads(); for (int it = bid; it < 128; it += G) lru_sweep_item<1, 1>(p, l, it, shm);
#endif
        xcd_barrier(xb);
#ifndef SK_X4
        ssd_norm_phase(p, l, G);
#endif
        xcd_barrier(xb);
        {
            pg8::Gemm g{WS_MIX(p), WS_WTOUT(p) + (size_t)l * 2048 * 3072, NTOK, 2048, 3072};
            pg8::Order S; S.init(l == 3 ? 64 : 72, 8, G, bid, l == 3 ? 1 : 0);
            EpiG2 E{p, l, 0};
#if DUP_G2
            { EpiG2 E2{p, l, 1}; pg8::gemm_phase<EpiG2, pg8::Order>((PG8_LAS unsigned char*)shm, g, S, E2); }
#endif
#ifndef SK_G2
            pg8::gemm_phase<EpiG2, pg8::Order>((PG8_LAS unsigned char*)shm, g, S, E);
#endif
        }
        if (l < 3) xcd_barrier(xb);
    }
}

extern "C" void kernel_launch(void* const* d_in, const int* in_sizes, int n_in, void* d_out, int out_size, void* d_ws, size_t ws_size, hipStream_t stream) {
    static int grid = 0;
    if (grid == 0) {
        if (n_in != 25 || ws_size < WS_END) { fprintf(stderr, "kernel_launch: need 25 inputs and %zu bytes of workspace (got %d, %zu)\n", (size_t)WS_END, n_in, ws_size); grid = -1; return; }
        int dev = 0, cus = 0, per_cu = 0;
        hipGetDevice(&dev);
        hipDeviceGetAttribute(&cus, hipDeviceAttributeMultiprocessorCount, dev);
        if (hipFuncSetAttribute((const void*)mega, hipFuncAttributeMaxDynamicSharedMemorySize, LDS_BYTES) != hipSuccess) { fprintf(stderr, "kernel_launch: hipFuncSetAttribute failed\n"); grid = -1; return; }
        if (hipOccupancyMaxActiveBlocksPerMultiprocessor(&per_cu, (const void*)mega, 512, LDS_BYTES) != hipSuccess || per_cu < 1) { fprintf(stderr, "kernel_launch: occupancy query gave %d\n", per_cu); per_cu = 1; }
        (void)hipGetLastError();
        grid = cus * 1;
        if (grid <= 0) grid = 256;
    }
    if (grid < 0) return;
    Params p{};
    const float** pf = (const float**)&p;
    for (int i = 0; i < 25; ++i) pf[i] = (const float*)d_in[i];
    p.out = (float*)d_out; p.ws = (unsigned char*)d_ws;
    if (hipMemsetAsync((char*)d_ws + OFF_BAR, 0, 32768, stream) != hipSuccess) { fprintf(stderr, "kernel_launch: memset of barrier words failed\n"); return; }
    void* args[] = {&p};
    hipError_t e = hipLaunchCooperativeKernel((const void*)mega, dim3(grid), dim3(512), args, LDS_BYTES, stream);
    if (e != hipSuccess) fprintf(stderr, "cooperative launch failed: %s (grid %d)\n", hipGetErrorString(e), grid);
}
```

```cpp
#include <hip/hip_runtime.h>
#include <hip/hip_cooperative_groups.h>
#include <cstdio>
#include <cstdint>
namespace cg = cooperative_groups;
#define DUP_X1A 0
#define DUP_X1B 0
#define DUP_ATT 0
#define DUP_X3A 0
#define DUP_X3B 0
#define DUP_G1 0
#define DUP_P0 0
#define DUP_NORM 0
#define DUP_SYNC 0
#define DUP_E1 0
#define DUP_SWEEP1 0
#define DUP_G2 0
#define DUP_QK 0
#define E1SEL 0
#define DUP_SWEEP 0
#define DUP_STATES 0
#define DUP_FINAL 0
#define AMODE 0
#define FMODE 0
#define DUP_X1Q 0
#define DUP_ATTQ 0
#define DUP_X3Q 0

__device__ __forceinline__ int tidx() { int t = (int)threadIdx.x; asm volatile("" : "+v"(t)); return t; }

namespace pg8 {
#define PG8_LAS __attribute__((address_space(3)))
typedef unsigned short bf16_t;
typedef short bf16x8 __attribute__((ext_vector_type(8)));
typedef float f32x4 __attribute__((ext_vector_type(4)));
typedef unsigned u32x4 __attribute__((ext_vector_type(4)));
constexpr int BM = 256, BK = 64, HALF = 128, HTB = HALF * BK * 2  , STAGE_BYTES = 8 * HTB, NXCD = 8, WGM = 8;

__host__ __device__ __forceinline__ int lds_byte(int r, int c) { const int st = (r >> 4) * 2 + (c >> 5), rr = r & 15, cc = c & 31, ob = rr * 64 + cc * 2; return st * 1024 + (ob ^ (((ob >> 9) & 1) << 5)); }
__host__ __device__ __forceinline__ void stage_rc(int b, int& R, int& C) { const int st = b / 1024, sb = b % 1024, swz = sb ^ (((sb >> 9) & 1) << 5); R = (st >> 1) * 16 + swz / 64; C = (st & 1) * 32 + (swz % 64) / 2; }
__host__ __device__ __forceinline__ int perm32(int rho) { const int n = rho >> 4, i = rho & 15; return 8 * (i >> 2) + 4 * n + (i & 3); }

struct Unit { int pm, pn, ks; };
struct Gemm { const bf16_t* A; const bf16_t* Bt; int M, N, K, ld; };

struct Order {
    int nM, nN, nwg, G, c, skipctx;
    __device__ void init(int nM_, int nN_, int G_, int c_, int skip_) { nM = nM_; nN = nN_; nwg = nM * nN; G = G_; c = c_; skipctx = skip_; }
    __device__ bool next(int i, Unit& u) const {
        const long L = (long)i * G + c; if (L >= nwg) return false;
        int wgid = (int)L; { const int q = nwg / NXCD, r = nwg % NXCD, xcd = wgid % NXCD, off = wgid / NXCD; wgid = (xcd < r ? xcd * (q + 1) : r * (q + 1) + (xcd - r) * q) + off; }
        const int nig = WGM * nN, gid = wgid / nig, fm = gid * WGM, gsz = (nM - fm) < WGM ? (nM - fm) : WGM;
        int pm = fm + ((wgid % nig) % gsz); u.pn = (wgid % nig) / gsz;
        if (skipctx) pm = (pm >> 3) * 9 + 1 + (pm & 7);
        u.pm = pm; u.ks = 0; return true;
    }
    __device__ __forceinline__ void a_ready(const Unit&) const {}
    __device__ __forceinline__ void done(const Unit&) const {}
};
typedef __bf16 bf16x2_t __attribute__((ext_vector_type(2)));
typedef float f32x2_t __attribute__((ext_vector_type(2)));
struct TailOrder {
    int c, G;
    __device__ bool next(int i, Unit& u) const { const int L = i * G + c; if (L >= 256) return false; u.pm = 64 + (L >> 5); u.pn = (L >> 2) & 7; u.ks = L & 3; return true; }
    __device__ __forceinline__ void a_ready(const Unit&) const {}
    __device__ __forceinline__ void done(const Unit&) const {}
};
__device__ __forceinline__ unsigned cvt_pk_bf16(float lo, float hi) { f32x2_t v = {lo, hi}; bf16x2_t b = __builtin_convertvector(v, bf16x2_t); return __builtin_bit_cast(unsigned, b); }

template <class Epi, class Sched>
__device__ __forceinline__ void gemm_phase(PG8_LAS unsigned char* lds, const Gemm g, const Sched& S, const Epi& E) {
    const int tid = tidx(), wid = __builtin_amdgcn_readfirstlane(tid >> 6), lane = tid & 63, wr = wid >> 2, wc = wid & 3, fr = lane & 15, fq = lane >> 4;
    const int K = g.K, LD = g.ld, nt = K / BK;
    unsigned voffA[2], voffB[2];
#pragma unroll
    for (int i = 0; i < 2; ++i) { int R, C; stage_rc(tid * 16 + i * 8192, R, C); const int Rb = Epi::PERM ? ((R & ~31) + perm32(R & 31)) : R;
        voffA[i] = (unsigned)(R * LD + C) * 2u; voffB[i] = (unsigned)(Rb * LD + C) * 2u; }
    const size_t kstep = (size_t)(BK * 2);
    const size_t hstep = (size_t)HALF * LD * 2;
    const size_t tstep = 2 * hstep;
    const unsigned ldsw = (unsigned)wid * 1024u;
    const int aoff = lds_byte(wr * 64 + fr, fq * 8), boff = lds_byte(wc * 32 + fr, fq * 8);
#define PG8_SA(b, h) (((b) * 2 + (h)) * HTB)
#define PG8_SB(b, h) ((4 + (b) * 2 + (h)) * HTB)
#define PG8_STAGE(bufoff, gbase, voff) do { _Pragma("unroll") for (int _i = 0; _i < 2; ++_i) \
        __builtin_amdgcn_global_load_lds((const unsigned*)((const char*)(gbase) + (voff)[_i]), (PG8_LAS unsigned*)(lds + (bufoff) + ldsw + _i * 8192), 16, 0, 0); } while (0)
#define PG8_LDA(dst, b, h) do { _Pragma("unroll") for (int m = 0; m < 4; ++m) _Pragma("unroll") for (int k = 0; k < 2; ++k) dst[m][k] = *(const PG8_LAS bf16x8*)(lds + PG8_SA(b, h) + aoff + m * 2048 + k * 1024); } while (0)
#define PG8_LDB(dst, b, h) do { _Pragma("unroll") for (int n = 0; n < 2; ++n) _Pragma("unroll") for (int k = 0; k < 2; ++k) dst[n][k] = *(const PG8_LAS bf16x8*)(lds + PG8_SB(b, h) + boff + n * 2048 + k * 1024); } while (0)
#define PG8_MMA(ai, bj, At, Bt) do { __builtin_amdgcn_s_setprio(1); _Pragma("unroll") for (int m = 0; m < 4; ++m) _Pragma("unroll") for (int n = 0; n < 2; ++n) _Pragma("unroll") for (int k = 0; k < 2; ++k) \
        acc[ai][bj][m][n] = __builtin_amdgcn_mfma_f32_16x16x32_bf16(Bt[n][k], At[m][k], acc[ai][bj][m][n], 0, 0, 0); __builtin_amdgcn_s_setprio(0); } while (0)
#define PG8_WAIT_V(n) asm volatile("s_waitcnt vmcnt(" #n ")" ::: "memory")
#define PG8_WAIT_L(n) asm volatile("s_waitcnt lgkmcnt(" #n ")" ::: "memory")
#define PG8_BAR __builtin_amdgcn_s_barrier()
#define PG8_SCHED __builtin_amdgcn_sched_barrier(0)
    Unit cur, nxt; int ui = 0;
    if (!S.next(0, cur)) return;
    f32x4 acc[2][2][4][2];
#pragma unroll
    for (int a = 0; a < 2; ++a)
#pragma unroll
        for (int b = 0; b < 2; ++b)
#pragma unroll
            for (int m = 0; m < 4; ++m)
#pragma unroll
                for (int n = 0; n < 2; ++n) acc[a][b][m][n] = (f32x4){0.f, 0.f, 0.f, 0.f};
    bf16x8 At[4][2], B0[2][2], B1[2][2];
    const char* cA = (const char*)g.A + (size_t)cur.pm * tstep + (size_t)cur.ks * K * 2; const char* cB = (const char*)g.Bt + (size_t)cur.pn * tstep + (size_t)cur.ks * K * 2;
    S.a_ready(cur);
    PG8_STAGE(PG8_SB(0, 0), cB, voffB); PG8_STAGE(PG8_SA(0, 0), cA, voffA); PG8_STAGE(PG8_SB(0, 1), cB + hstep, voffB); PG8_STAGE(PG8_SA(0, 1), cA + hstep, voffA);
    if (wr == 1) PG8_BAR;
    PG8_WAIT_V(4); PG8_BAR;
    PG8_STAGE(PG8_SB(1, 0), cB + kstep, voffB); PG8_STAGE(PG8_SA(1, 0), cA + kstep, voffA); PG8_STAGE(PG8_SB(1, 1), cB + hstep + kstep, voffB);
    PG8_WAIT_V(6); PG8_BAR;
    for (;;) {
        const bool has_next = S.next(ui + 1, nxt);
        const char* nA = has_next ? (const char*)g.A + (size_t)nxt.pm * tstep + (size_t)nxt.ks * K * 2 : cA; const char* nB = has_next ? (const char*)g.Bt + (size_t)nxt.pn * tstep + (size_t)nxt.ks * K * 2 : cB;
        for (int t = 0; t < nt; t += 2) {
            const bool last = (t == nt - 2);
            const char* a1 = cA + (size_t)(t + 1) * kstep;
            const char* a2 = last ? nA : cA + (size_t)(t + 2) * kstep; const char* b2 = last ? nB : cB + (size_t)(t + 2) * kstep;
            const char* a3 = a2 + kstep; const char* b3 = b2 + kstep;
            if (last && has_next) S.a_ready(nxt);
            PG8_LDB(B0, 0, 0); PG8_SCHED; PG8_LDA(At, 0, 0); PG8_STAGE(PG8_SA(1, 1), a1 + hstep, voffA);
            PG8_WAIT_L(8); PG8_BAR; PG8_WAIT_L(0); PG8_MMA(0, 0, At, B0); PG8_BAR; PG8_SCHED;
            PG8_LDB(B1, 0, 1); PG8_STAGE(PG8_SB(0, 0), b2, voffB);
            PG8_BAR; PG8_WAIT_L(0); PG8_MMA(0, 1, At, B1); PG8_BAR;
            PG8_LDA(At, 0, 1); PG8_STAGE(PG8_SA(0, 0), a2, voffA);
            PG8_BAR; PG8_WAIT_L(0); PG8_MMA(1, 0, At, B0); PG8_BAR; PG8_SCHED;
            PG8_STAGE(PG8_SB(0, 1), b2 + hstep, voffB);
            PG8_WAIT_V(6); PG8_BAR; PG8_MMA(1, 1, At, B1); PG8_BAR;
            PG8_LDB(B0, 1, 0); PG8_SCHED; PG8_LDA(At, 1, 0); PG8_STAGE(PG8_SA(0, 1), a2 + hstep, voffA);
            PG8_WAIT_L(8); PG8_BAR; PG8_WAIT_L(0); PG8_MMA(0, 0, At, B0); PG8_BAR; PG8_SCHED;
            PG8_LDB(B1, 1, 1); PG8_STAGE(PG8_SB(1, 0), b3, voffB);
            PG8_BAR; PG8_WAIT_L(0); PG8_MMA(0, 1, At, B1); PG8_BAR;
            PG8_LDA(At, 1, 1); PG8_STAGE(PG8_SA(1, 0), a3, voffA);
            PG8_BAR; PG8_WAIT_L(0); PG8_MMA(1, 0, At, B0); PG8_BAR; PG8_SCHED;
            PG8_STAGE(PG8_SB(1, 1), b3 + hstep, voffB);
            PG8_WAIT_V(6); PG8_BAR; PG8_MMA(1, 1, At, B1); PG8_BAR;
        }
        if constexpr (!Epi::AFTER_DRAIN) { E(acc, cur, wr, wc, fr, fq); S.done(cur); }
        if (!has_next) break;
#pragma unroll
        for (int a = 0; a < 2; ++a)
#pragma unroll
            for (int b = 0; b < 2; ++b)
#pragma unroll
                for (int m = 0; m < 4; ++m)
#pragma unroll
                    for (int n = 0; n < 2; ++n) acc[a][b][m][n] = (f32x4){0.f, 0.f, 0.f, 0.f};
        cur = nxt; cA = nA; cB = nB; ++ui;
    }
    PG8_WAIT_V(0);
    if (wr == 0) PG8_BAR;
    PG8_BAR;
    if constexpr (Epi::AFTER_DRAIN) { E.fused(acc, cur, wr, wc, fr, fq, lds, wid, lane); S.done(cur); }
#undef PG8_SA
#undef PG8_SB
#undef PG8_STAGE
#undef PG8_LDA
#undef PG8_LDB
#undef PG8_MMA
#undef PG8_WAIT_V
#undef PG8_WAIT_L
#undef PG8_BAR
#undef PG8_SCHED
}
}

using pg8::bf16_t; using pg8::bf16x8; using pg8::f32x4; using pg8::cvt_pk_bf16;
typedef float f32x16 __attribute__((ext_vector_type(16)));
typedef float f32x8 __attribute__((ext_vector_type(8)));
typedef unsigned u32x2 __attribute__((ext_vector_type(2)));
typedef unsigned u32x4 __attribute__((ext_vector_type(4)));

constexpr int DM = 2048, TPB = 2304, NTOK = 18432, LDP = 7424, MIXW = 3072, NCH = 18;
constexpr int C_LX = 0, C_LG = 1024, C_Q = 2048, C_K = 3072, C_V = 3328, C_AG = 3584, C_XBC = 4608, C_Z = 6144, C_DT = 7168;
constexpr size_t SZ_WTIN = (size_t)4 * 7424 * 2048 * 2, SZ_WTOUT = (size_t)4 * 2048 * 3072 * 2, SZ_MOD = (size_t)4 * 9 * 6144 * 4, SZ_U = (size_t)NTOK * 2048 * 2,
                 SZ_P = (size_t)NTOK * LDP * 2, SZ_MIX = (size_t)NTOK * MIXW * 2, SZ_XB = (size_t)NTOK * 2048 * 4, SZ_ST = (size_t)8 * 2 * 18 * 16 * 8192 * 2,
                 SZ_AL = (size_t)8 * 2 * 18 * 16 * 4, SZ_SUM = (size_t)8 * 2 * 18 * 1024 * 4;
constexpr size_t OFF_WTIN = 0, OFF_WTOUT = OFF_WTIN + SZ_WTIN, OFF_MOD = OFF_WTOUT + SZ_WTOUT, OFF_U = OFF_MOD + SZ_MOD, OFF_P = OFF_U + SZ_U, OFF_MIX = OFF_P + SZ_P,
                 OFF_XB = OFF_MIX + SZ_MIX, OFF_ST = OFF_XB + SZ_XB, OFF_AL = OFF_ST + SZ_ST, OFF_SUMA = OFF_AL + SZ_AL, OFF_SUMB = OFF_SUMA + SZ_SUM, OFF_BAR = OFF_SUMB + SZ_SUM, OFF_SBC = OFF_BAR + 32768, OFF_SBT = OFF_SBC + (size_t)NTOK * 512 * 2, OFF_DTA = OFF_SBT + (size_t)8 * 18 * 2 * 16384 * 2,
                 OFF_ACS = OFF_DTA + (size_t)NTOK * 32 * 4, OFF_HINL = OFF_ACS + (size_t)NTOK * 32 * 4, OFF_GW = OFF_HINL + SZ_SUM, OFF_DTP = OFF_GW + (size_t)4 * 16 * 16384 * 2, OFF_VT = OFF_DTP + (size_t)NTOK * 16 * 4, WS_END = OFF_VT + (size_t)8 * 18 * 2 * 16384 * 2;
constexpr size_t OFF_LXC = OFF_U, OFF_SXT = OFF_U + (size_t)NTOK * 1024 * 2;
constexpr int LDS_CTL = 147456;
constexpr int LDS_BYTES = LDS_CTL + 16;

struct Params {
    const float *x, *c, *ctx, *c_ctx, *norm_w, *ada_w, *ada_b, *w_in, *lru_conv_w, *lru_conv_b, *lru_ga_w, *lru_ga_b, *lru_gx_w, *lru_gx_b, *lru_lambda,
        *att_q_norm, *att_k_norm, *att_sink, *ssd_conv_w, *ssd_conv_b, *ssd_dt_bias, *ssd_A_log, *ssd_D, *ssd_norm_w, *w_out;
    float* out;
    unsigned char* ws;
};
#define WS_WTIN(p) ((bf16_t*)((p).ws + OFF_WTIN))
#define WS_WTOUT(p) ((bf16_t*)((p).ws + OFF_WTOUT))
#define WS_MOD(p) ((float*)((p).ws + OFF_MOD))
#define WS_U(p) ((bf16_t*)((p).ws + OFF_U))
#define WS_P(p) ((bf16_t*)((p).ws + OFF_P))
#define WS_MIX(p) ((bf16_t*)((p).ws + OFF_MIX))
#define WS_XB(p) ((float*)((p).ws + OFF_XB))
#define WS_ST(p) ((bf16_t*)((p).ws + OFF_ST))
#define WS_AL(p) ((float*)((p).ws + OFF_AL))
#define WS_SUMA(p) ((float*)((p).ws + OFF_SUMA))
#define WS_SUMB(p) ((float*)((p).ws + OFF_SUMB))
#define WS_LXC(p) ((bf16_t*)((p).ws + OFF_LXC))
#define WS_SXT(p) ((bf16_t*)((p).ws + OFF_SXT))
#define WS_SBC(p) ((bf16_t*)((p).ws + OFF_SBC))
#define WS_SBT(p) ((bf16_t*)((p).ws + OFF_SBT))
#define WS_DTA(p) ((float*)((p).ws + OFF_DTA))
#define WS_ACS(p) ((float*)((p).ws + OFF_ACS))
#define WS_HINL(p) ((float*)((p).ws + OFF_HINL))
#define WS_GW(p) ((bf16_t*)((p).ws + OFF_GW))
#define WS_DTP(p) ((float*)((p).ws + OFF_DTP))
#define WS_VT(p) ((bf16_t*)((p).ws + OFF_VT))

__device__ __forceinline__ float bf2f(bf16_t v) { return __uint_as_float(((unsigned)v) << 16); }
__device__ __forceinline__ bf16_t f2bf(float f) { return (bf16_t)(cvt_pk_bf16(f, 0.f) & 0xffffu); }
__device__ __forceinline__ float siluf(float v) { return v * __builtin_amdgcn_rcpf(1.f + __expf(-v)); }
__device__ __forceinline__ float sigmf(float v) { return __builtin_amdgcn_rcpf(1.f + __expf(-v)); }
__device__ __forceinline__ float softplusf(float v) { return v > 20.f ? v : log1pf(__expf(v)); }
__device__ __forceinline__ float wave_sum(float v) {
#pragma unroll
    for (int o = 1; o < 64; o <<= 1) v += __shfl_xor(v, o);
    return v;
}
__device__ __forceinline__ f32x8 unpack8(const u32x4 w) {
    f32x8 f;
    f[0] = __uint_as_float(w.x << 16); f[1] = __uint_as_float(w.x & 0xffff0000u); f[2] = __uint_as_float(w.y << 16); f[3] = __uint_as_float(w.y & 0xffff0000u);
    f[4] = __uint_as_float(w.z << 16); f[5] = __uint_as_float(w.z & 0xffff0000u); f[6] = __uint_as_float(w.w << 16); f[7] = __uint_as_float(w.w & 0xffff0000u);
    return f;
}
__device__ __forceinline__ u32x4 pack8(const f32x8 f) { u32x4 w; w.x = cvt_pk_bf16(f[0], f[1]); w.y = cvt_pk_bf16(f[2], f[3]); w.z = cvt_pk_bf16(f[4], f[5]); w.w = cvt_pk_bf16(f[6], f[7]); return w; }
__device__ __forceinline__ void lds_barrier() { asm volatile("s_waitcnt lgkmcnt(0)" ::: "memory"); __builtin_amdgcn_s_barrier(); asm volatile("" ::: "memory"); }
__device__ __forceinline__ float dpp_f(float v, int ctrl_sel) {
    const int x = __builtin_bit_cast(int, v); int r;
    if (ctrl_sel == 0) r = __builtin_amdgcn_update_dpp(x, x, 0xB1, 0xF, 0xF, false);
    else if (ctrl_sel == 1) r = __builtin_amdgcn_update_dpp(x, x, 0x4E, 0xF, 0xF, false);
    else if (ctrl_sel == 2) r = __builtin_amdgcn_update_dpp(x, x, 0x141, 0xF, 0xF, false);
    else r = __builtin_amdgcn_update_dpp(x, x, 0x140, 0xF, 0xF, false);
    return __builtin_bit_cast(float, r);
}
__device__ __forceinline__ float row16_max(float v) { v = fmaxf(v, dpp_f(v, 0)); v = fmaxf(v, dpp_f(v, 1)); v = fmaxf(v, dpp_f(v, 2)); v = fmaxf(v, dpp_f(v, 3)); return v; }
__device__ __forceinline__ float row16_sum(float v) { v += dpp_f(v, 0); v += dpp_f(v, 1); v += dpp_f(v, 2); v += dpp_f(v, 3); return v; }
__device__ __forceinline__ int chunk_at(int d, int pos) { return d == 0 ? pos : (pos < 2 ? 1 - pos : 19 - pos); }
__device__ __forceinline__ int pos_of(int d, int c) { return d == 0 ? c : (c < 2 ? 1 - c : 19 - c); }
__device__ __forceinline__ int rowmap32(int reg, int lane) { return (reg & 3) + 8 * (reg >> 2) + 4 * (lane >> 5); }

template <int K> __device__ __forceinline__ void mm32(f32x16& acc, const bf16_t* A, int lda, const bf16_t* B, int ldb, int lane) {
    const bf16_t* pa = A + (lane & 31) * lda + 8 * (lane >> 5);
    const bf16_t* pb = B + (lane & 31) * ldb + 8 * (lane >> 5);
#pragma unroll
    for (int k = 0; k < K; k += 16) {
        const bf16x8 a = *(const bf16x8*)(pa + k);
        const bf16x8 b = *(const bf16x8*)(pb + k);
        acc = __builtin_amdgcn_mfma_f32_32x32x16_bf16(a, b, acc, 0, 0, 0);
    }
}

template <int NC, bool SILU, bool TRANS>
__device__ __forceinline__ void stage_conv_tile(bf16_t* dst, int ld, const bf16_t* Pb, int t0, int col0, const float* cw, int CS, const float* cb, int tid) {
    constexpr int CG = NC / 8;
    const int lo = t0 < 256 ? 0 : 256, hi = t0 < 256 ? 256 : TPB;
    for (int idx = tid; idx < 128 * CG; idx += 512) {
        int cgi, tl;
        if (TRANS) { tl = idx & 127; cgi = idx >> 7; } else { cgi = idx % CG; tl = idx / CG; }
        const int t = t0 + tl;
        const f32x4 b0 = *(const f32x4*)(cb + cgi * 8), b1 = *(const f32x4*)(cb + cgi * 8 + 4);
        f32x8 acc; acc[0] = b0.x; acc[1] = b0.y; acc[2] = b0.z; acc[3] = b0.w; acc[4] = b1.x; acc[5] = b1.y; acc[6] = b1.z; acc[7] = b1.w;
#pragma unroll
        for (int k = 0; k < 4; ++k) {
            const int tt = t - 2 + k;
            if (tt >= lo && tt < hi) {
                const f32x8 v = unpack8(*(const u32x4*)(Pb + (size_t)tt * LDP + col0 + cgi * 8));
                const f32x4 w0 = *(const f32x4*)(cw + k * CS + cgi * 8), w1 = *(const f32x4*)(cw + k * CS + cgi * 8 + 4);
                acc[0] += w0.x * v[0]; acc[1] += w0.y * v[1]; acc[2] += w0.z * v[2]; acc[3] += w0.w * v[3];
                acc[4] += w1.x * v[4]; acc[5] += w1.y * v[5]; acc[6] += w1.z * v[6]; acc[7] += w1.w * v[7];
            }
        }
        if (SILU) {
#pragma unroll
            for (int e = 0; e < 8; ++e) acc[e] = siluf(acc[e]);
        }
        if (TRANS) {
#pragma unroll
            for (int e = 0; e < 8; ++e) dst[(cgi * 8 + e) * ld + tl] = f2bf(acc[e]);
        } else {
            *(u32x4*)(dst + tl * ld + cgi * 8) = pack8(acc);
        }
    }
}

__device__ __forceinline__ void transpose_item(const float* W, int K, int N, int nblk, bf16_t* WT, float* scr, int item, int lane) {
    const int kb = item / nblk, nb = item % nblk, k0 = 64 * kb, n0 = 32 * nb;
    const int c4 = lane & 7, r8 = lane >> 3, n = n0 + c4 * 4;
    f32x4 tv[8];
#pragma unroll
    for (int i = 0; i < 8; ++i) tv[i] = (n < N) ? *(const f32x4*)(W + (size_t)(k0 + i * 8 + r8) * N + n) : (f32x4){0.f, 0.f, 0.f, 0.f};
#pragma unroll
    for (int i = 0; i < 8; ++i) { float* d = scr + (i * 8 + r8) * 33 + c4 * 4; d[0] = tv[i].x; d[1] = tv[i].y; d[2] = tv[i].z; d[3] = tv[i].w; }
    asm volatile("s_waitcnt lgkmcnt(0)" ::: "memory");
    const int c = lane & 7;
#pragma unroll
    for (int j = 0; j < 4; ++j) {
        const int nn = (lane >> 3) + 8 * j; const float* s = scr + (8 * c) * 33 + nn;
        u32x4 o; o.x = cvt_pk_bf16(s[0 * 33], s[1 * 33]); o.y = cvt_pk_bf16(s[2 * 33], s[3 * 33]); o.z = cvt_pk_bf16(s[4 * 33], s[5 * 33]); o.w = cvt_pk_bf16(s[6 * 33], s[7 * 33]);
        *(u32x4*)(WT + (size_t)(n0 + nn) * K + k0 + 8 * c) = o;
    }
    asm volatile("s_waitcnt lgkmcnt(0)" ::: "memory");
}

__device__ __forceinline__ void phase0(const Params& p, unsigned char* shm, int G) {
    const int tid = tidx(), lane = tid & 63, wave = tid >> 6;
    float* sf = (float*)shm;
    float* MOD = WS_MOD(p);
    for (int item = blockIdx.x; item < 96; item += G) {
        const int l = item / 24, cgp = item % 24;
        __syncthreads();
        for (int idx = tid; idx < 9 * 2048; idx += 512) { const int r = idx >> 11, k = idx & 2047; const float v = r < 8 ? p.c[r * 2048 + k] : p.c_ctx[k]; sf[idx] = siluf(v); }
        __syncthreads();
        f32x4 acc[9];
#pragma unroll
        for (int r = 0; r < 9; ++r) acc[r] = (f32x4){0.f, 0.f, 0.f, 0.f};
        const float* wp = p.ada_w + ((size_t)l * 2048 + wave * 256) * 6144 + cgp * 256 + lane * 4;
#pragma unroll 16
        for (int kk = 0; kk < 256; ++kk) {
            const f32x4 wv = *(const f32x4*)(wp + (size_t)kk * 6144);
            const int k = wave * 256 + kk;
#pragma unroll
            for (int r = 0; r < 9; ++r) { const float s = sf[r * 2048 + k]; acc[r] += wv * s; }
        }
        __syncthreads();
#pragma unroll
        for (int r = 0; r < 9; ++r) *(f32x4*)(sf + (wave * 9 + r) * 256 + lane * 4) = acc[r];
        __syncthreads();
        for (int idx = tid; idx < 9 * 256; idx += 512) {
            const int r = idx >> 8, col = idx & 255; float s = p.ada_b[l * 6144 + cgp * 256 + col];
#pragma unroll
            for (int w = 0; w < 8; ++w) s += sf[(w * 9 + r) * 256 + col];
            MOD[(size_t)(l * 9 + r) * 6144 + cgp * 256 + col] = s;
        }
    }
    __syncthreads();
    float* scr = sf + wave * (64 * 33);
    const int gw = blockIdx.x * 8 + wave, NGW = G * 8;
    constexpr int I_IN = 32 * 232, I_OUT = 48 * 64;
    for (int it = gw; it < 4 * (I_IN + I_OUT); it += NGW) {
        if (it < 4 * I_IN) { const int l = it / I_IN, r = it % I_IN; transpose_item(p.w_in + (size_t)l * 2048 * 7184, 2048, 7184, 232, WS_WTIN(p) + (size_t)l * 7424 * 2048, scr, r, lane); }
        else { const int it2 = it - 4 * I_IN, l = it2 / I_OUT, r = it2 % I_OUT; transpose_item(p.w_out + (size_t)l * 3072 * 2048, 3072, 2048, 64, WS_WTOUT(p) + (size_t)l * 2048 * 3072, scr, r, lane); }
    }
    for (int idx = (int)blockIdx.x * 512 + tid; idx < 4 * 16 * 16384; idx += G * 512) {
        const int i = idx & 63, o = (idx >> 6) & 63, gate = (idx >> 12) & 1, d = (idx >> 13) & 1, j = (idx >> 14) & 15, l = idx >> 18;
        const float* w = gate ? p.lru_gx_w : p.lru_ga_w;
        WS_GW(p)[idx] = f2bf(w[(size_t)((l * 2 + d) * 16 + j) * 4096 + i * 64 + o]);
    }
}

__device__ __forceinline__ const float* xrow_src(const Params& p, int l, int row) {
    const int b = row / TPB, t = row % TPB;
    if (l == 0) return t < 256 ? p.ctx + ((size_t)b * 256 + t) * DM : p.x + ((size_t)b * 2048 + (t - 256)) * DM;
    return WS_XB(p) + (size_t)row * DM;
}
__device__ __forceinline__ void norm_phase(const Params& p, int l, int G) {
    const int lane = tidx() & 63, wave = tidx() >> 6;
    bf16_t* U = WS_U(p);
    const int gw = (int)blockIdx.x * 8 + wave, NW = G * 8;
    constexpr int R = 2;
#pragma unroll 1
    for (int base = gw; base < NTOK; base += NW * R) {
        f32x4 v[R][8];
#pragma unroll
        for (int u = 0; u < R; ++u) {
            const int row = base + u * NW;
            if (row < NTOK) {
                if (l >= 1 && row >= 16384) {
                    const float* xo = xrow_src(p, l - 1, row);
                    const float* gt = WS_MOD(p) + (size_t)((l - 1) * 9 + 7) * 6144 + 4096;
                    const float* pp = (const float*)WS_P(p) + (size_t)(row - 16384) * 2048;
                    float* xn = WS_XB(p) + (size_t)row * DM;
#pragma unroll
                    for (int j = 0; j < 8; ++j) {
                        const int col = 4 * lane + 256 * j;
                        const f32x4 s = (*(const f32x4*)(pp + col) + *(const f32x4*)(pp + (size_t)2048 * 2048 + col)) + (*(const f32x4*)(pp + (size_t)2 * 2048 * 2048 + col) + *(const f32x4*)(pp + (size_t)3 * 2048 * 2048 + col));
                        v[u][j] = *(const f32x4*)(xo + col) + *(const f32x4*)(gt + col) * s;
                        *(f32x4*)(xn + col) = v[u][j];
                    }
                } else {
                const float* src = xrow_src(p, l, row);
#pragma unroll
                for (int j = 0; j < 8; ++j) v[u][j] = *(const f32x4*)(src + 4 * lane + 256 * j);
                }
            }
        }
#pragma unroll
        for (int u = 0; u < R; ++u) {
            const int row = base + u * NW;
            if (row < NTOK) {
                const int b = row / TPB, t = row % TPB;
                const float* md = WS_MOD(p) + (size_t)(l * 9 + (t < 256 ? 8 : b)) * 6144;
                float ss = 0.f;
#pragma unroll
                for (int j = 0; j < 8; ++j) ss += v[u][j].x * v[u][j].x + v[u][j].y * v[u][j].y + v[u][j].z * v[u][j].z + v[u][j].w * v[u][j].w;
                ss = wave_sum(ss);
                const float rstd = rsqrtf(ss * (1.f / 2048.f) + 1e-6f);
#pragma unroll
                for (int j = 0; j < 8; ++j) {
                    const int col = 4 * lane + 256 * j;
                    const f32x4 nw = *(const f32x4*)(p.norm_w + l * 2048 + col), sh = *(const f32x4*)(md + col), sc = *(const f32x4*)(md + 2048 + col);
                    const f32x4 y = v[u][j] * rstd * nw * (sc + 1.f) + sh;
                    u32x2 w; w.x = cvt_pk_bf16(y.x, y.y); w.y = cvt_pk_bf16(y.z, y.w);
                    *(u32x2*)(U + (size_t)row * DM + col) = w;
                }
            }
        }
    }
}

struct EpiG1 {
    static constexpr bool PERM = true, AFTER_DRAIN = false;
    bf16_t* P;
    __device__ __forceinline__ void operator()(const f32x4 (&acc)[2][2][4][2], const pg8::Unit& u, int wr, int wc, int fr, int fq) const {
        const int row0 = u.pm * 256 + wr * 64 + fr, col0 = u.pn * 256 + wc * 32 + 8 * fq;
#pragma unroll
        for (int ai = 0; ai < 2; ++ai)
#pragma unroll
            for (int m = 0; m < 4; ++m) { bf16_t* rowp = P + (size_t)(row0 + ai * 128 + m * 16) * LDP + col0;
#pragma unroll
                for (int bj = 0; bj < 2; ++bj) { const f32x4 v0 = acc[ai][bj][m][0], v1 = acc[ai][bj][m][1];
                    u32x4 w; w.x = cvt_pk_bf16(v0.x, v0.y); w.y = cvt_pk_bf16(v0.z, v0.w); w.z = cvt_pk_bf16(v1.x, v1.y); w.w = cvt_pk_bf16(v1.z, v1.w);
                    *(u32x4*)(rowp + bj * 128) = w; } }
    }
};
struct EpiG2 {
    static constexpr bool PERM = true, AFTER_DRAIN = false;
    Params p; int l; int scr;
    __device__ __forceinline__ void operator()(const f32x4 (&acc)[2][2][4][2], const pg8::Unit& u, int wr, int wc, int fr, int fq) const {
        const int row0 = u.pm * 256 + wr * 64 + fr, col0 = u.pn * 256 + wc * 32 + 8 * fq;
#pragma unroll
        for (int ai = 0; ai < 2; ++ai)
#pragma unroll
            for (int m = 0; m < 4; ++m) {
                const int row = row0 + ai * 128 + m * 16, b = row / TPB, t = row % TPB;
                if (l == 3 && t < 256) continue;
                const float* xo = xrow_src(p, l, row);
                float* dst = scr ? (float*)WS_P(p) + (size_t)row * DM : (l == 3) ? p.out + ((size_t)b * 2048 + (t - 256)) * DM : WS_XB(p) + (size_t)row * DM;
                const float* gt = WS_MOD(p) + (size_t)(l * 9 + (t < 256 ? 8 : b)) * 6144 + 4096;
                f32x4 xv[4], gv[4];
#pragma unroll
                for (int q = 0; q < 4; ++q) { const int col = col0 + (q >> 1) * 128 + (q & 1) * 4; xv[q] = *(const f32x4*)(xo + col); gv[q] = *(const f32x4*)(gt + col); }
#pragma unroll
                for (int q = 0; q < 4; ++q) { const int col = col0 + (q >> 1) * 128 + (q & 1) * 4; *(f32x4*)(dst + col) = xv[q] + gv[q] * acc[ai][q >> 1][m][q & 1]; }
            }
    }
};

struct EpiPart {
    static constexpr bool PERM = true, AFTER_DRAIN = false;
    float* part;
    __device__ __forceinline__ void operator()(const f32x4 (&acc)[2][2][4][2], const pg8::Unit& u, int wr, int wc, int fr, int fq) const {
        const int row0 = (u.pm - 64) * 256 + wr * 64 + fr, col0 = u.pn * 256 + wc * 32 + 8 * fq;
        float* base = part + (size_t)u.ks * 2048 * 2048;
#pragma unroll
        for (int ai = 0; ai < 2; ++ai)
#pragma unroll
            for (int m = 0; m < 4; ++m) { float* rowp = base + (size_t)(row0 + ai * 128 + m * 16) * 2048 + col0;
#pragma unroll
                for (int bj = 0; bj < 2; ++bj) { *(f32x4*)(rowp + bj * 128) = acc[ai][bj][m][0]; *(f32x4*)(rowp + bj * 128 + 4) = acc[ai][bj][m][1]; } }
    }
};

template <int SCR>
__device__ __forceinline__ void qkprep_row(const Params& p, int l, int row, int lane) {
    const int t = row % TPB;
    bf16_t* rp = WS_P(p) + (size_t)row * LDP;
    float cs = 1.f, sn = 0.f;
    if (t >= 256) {
        const int s = t - 256, rr = s >> 6, cc = s & 63, f = lane & 31;
        const float inv = exp2f(-(float)f * (13.287712379549449f / 32.f));
        const float ang = (float)(lane < 32 ? rr : cc) * inv;
        cs = __cosf(ang); sn = __sinf(ang);
    }
    bf16_t r1[10], r2[10];
#pragma unroll
    for (int slot = 0; slot < 10; ++slot) { const int col = slot < 8 ? C_Q + slot * 128 : C_K + (slot - 8) * 128; r1[slot] = rp[col + lane]; r2[slot] = rp[col + 64 + lane]; }
#pragma unroll
    for (int slot = 0; slot < 10; ++slot) {
        const int col = slot < 8 ? C_Q + slot * 128 : C_K + (slot - 8) * 128;
        const float* w = slot < 8 ? p.att_q_norm + l * 128 : p.att_k_norm + l * 128;
        const float v1 = bf2f(r1[slot]), v2 = bf2f(r2[slot]);
        const float ss = wave_sum(v1 * v1 + v2 * v2);
        const float rstd = rsqrtf(ss * (1.f / 128.f) + 1e-6f);
        const float y1 = v1 * rstd * w[lane], y2 = v2 * rstd * w[64 + lane];
        float o1 = y1 * cs - y2 * sn, o2 = y1 * sn + y2 * cs;
        if (slot < 8) { o1 *= 0.08838834764831845f; o2 *= 0.08838834764831845f; }
        if (SCR) { bf16_t* sp = WS_ST(p) + (size_t)row * 1280 + slot * 128; sp[lane] = f2bf(o1); sp[64 + lane] = f2bf(o2); } else { rp[col + lane] = f2bf(o1); rp[col + 64 + lane] = f2bf(o2); }
    }
}

template <int D, int SCR = 0>
__device__ __forceinline__ void lru_sweep_item(const Params& p, int l, int item, unsigned char* shm) {
    const int tid = tidx(), lane = tid & 63, wave = tid >> 6, ch = tid & 63, seg = tid >> 6;
    const int j = item & 15, b = item >> 4;
    bf16_t* sX = (bf16_t*)shm; bf16_t* sW = (bf16_t*)(shm + 18432);
    float* sA = (float*)(shm + 36864); float* sB = (float*)(shm + 69632); float* sSA = (float*)(shm + 102400); float* sSB = (float*)(shm + 104448);
    bf16_t* sOut = (bf16_t*)(shm + 106496);
    const int mi = wave & 3, nj = wave >> 2, cl = nj * 32 + (lane & 31), cgl = j * 64 + cl;
    const float ba = p.lru_ga_b[(l * 2 + D) * 1024 + cgl], bx = p.lru_gx_b[(l * 2 + D) * 1024 + cgl], sp = softplusf(-p.lru_lambda[(l * 2 + D) * 1024 + cgl]);
    lds_barrier();
    {
        u32x4 wr2[2];
#pragma unroll
        for (int k = 0; k < 2; ++k) { const int idx = tid + k * 512; wr2[k] = *(const u32x4*)(WS_GW(p) + (size_t)(l * 16 + j) * 16384 + D * 8192 + idx * 8); }
#pragma unroll
        for (int k = 0; k < 2; ++k) { const int idx = tid + k * 512; *(u32x4*)(sW + (idx >> 3) * 72 + (idx & 7) * 8) = wr2[k]; }
    }
    u32x4 xr[2], lgr[2], hfr[2];
    {
        const size_t tok0 = (size_t)b * TPB + chunk_at(D, 0) * 128;
#pragma unroll
        for (int k = 0; k < 2; ++k) {
            const int idx = tid + k * 512;
            xr[k] = *(const u32x4*)(WS_LXC(p) + (tok0 + (idx >> 3)) * 1024 + j * 64 + (idx & 7) * 8);
            if (D == 1) { lgr[k] = *(const u32x4*)(WS_P(p) + (tok0 + (idx >> 3)) * LDP + C_LG + j * 64 + (idx & 7) * 8); hfr[k] = *(const u32x4*)(WS_MIX(p) + (tok0 + (idx >> 3)) * MIXW + j * 64 + (idx & 7) * 8); }
        }
    }
    float carry = 0.f;
#pragma unroll 1
    for (int pos = 0; pos < NCH; ++pos) {
        const size_t tok0 = (size_t)b * TPB + chunk_at(D, pos) * 128;
#pragma unroll
        for (int k = 0; k < 2; ++k) { const int idx = tid + k * 512; *(u32x4*)(sX + (idx >> 3) * 72 + (idx & 7) * 8) = xr[k]; }
        u32x4 lgc[2], hfc[2];
        if (D == 1) { lgc[0] = lgr[0]; lgc[1] = lgr[1]; hfc[0] = hfr[0]; hfc[1] = hfr[1]; }
        if (pos + 1 < NCH) {
            const size_t tokn = (size_t)b * TPB + chunk_at(D, pos + 1) * 128;
#pragma unroll
            for (int k = 0; k < 2; ++k) {
                const int idx = tid + k * 512;
                xr[k] = *(const u32x4*)(WS_LXC(p) + (tokn + (idx >> 3)) * 1024 + j * 64 + (idx & 7) * 8);
                if (D == 1) { lgr[k] = *(const u32x4*)(WS_P(p) + (tokn + (idx >> 3)) * LDP + C_LG + j * 64 + (idx & 7) * 8); hfr[k] = *(const u32x4*)(WS_MIX(p) + (tokn + (idx >> 3)) * MIXW + j * 64 + (idx & 7) * 8); }
            }
        }
        lds_barrier();
        {
            f32x16 ga, gx;
#pragma unroll
            for (int r = 0; r < 16; ++r) { ga[r] = 0.f; gx[r] = 0.f; }
            mm32<64>(ga, sX + mi * 32 * 72, 72, sW + (nj * 32) * 72, 72, lane);
            mm32<64>(gx, sX + mi * 32 * 72, 72, sW + (64 + nj * 32) * 72, 72, lane);
#pragma unroll
            for (int r = 0; r < 16; ++r) {
                const int tl = mi * 32 + rowmap32(r, lane);
                const float rg = sigmf(ga[r] + ba), ig = sigmf(gx[r] + bx);
                const float a = __expf(-8.f * rg * sp), mult = __builtin_amdgcn_sqrtf(fmaxf(1.f - a * a, 0.f));
                const float xv = bf2f(sX[tl * 72 + cl]);
                sA[tl * 64 + cl] = a; sB[tl * 64 + cl] = mult * ig * xv;
            }
        }
        lds_barrier();
        {
            float A = 1.f, Bc = 0.f;
#pragma unroll
            for (int q = 0; q < 16; ++q) { const int tl = seg * 16 + (D == 0 ? q : 15 - q); const float a = sA[tl * 64 + ch], bb = sB[tl * 64 + ch]; A = a * A; Bc = a * Bc + bb; }
            sSA[seg * 64 + ch] = A; sSB[seg * 64 + ch] = Bc;
        }
        lds_barrier();
        {
            float h = carry, cn = carry;
            const int myord = D == 0 ? seg : 7 - seg;
#pragma unroll
            for (int s = 0; s < 8; ++s) { const int sg = D == 0 ? s : 7 - s; const float a = sSA[sg * 64 + ch], bb = sSB[sg * 64 + ch]; cn = a * cn + bb; if (s < myord) h = cn; }
            carry = cn;
#pragma unroll
            for (int q = 0; q < 16; ++q) { const int tl = seg * 16 + (D == 0 ? q : 15 - q); h = sA[tl * 64 + ch] * h + sB[tl * 64 + ch]; sOut[tl * 72 + ch] = f2bf(h); }
        }
        lds_barrier();
#pragma unroll
        for (int k = 0; k < 2; ++k) {
            const int idx = tid + k * 512, rr = idx >> 3, ck = idx & 7;
            const u32x4 hv = *(const u32x4*)(sOut + rr * 72 + ck * 8);
            bf16_t* dst = SCR ? WS_P(p) + (tok0 + rr) * LDP + j * 64 + ck * 8 : WS_MIX(p) + (tok0 + rr) * MIXW + j * 64 + ck * 8;
            if (D == 0) *(u32x4*)dst = hv;
            else {
                const f32x8 a = unpack8(hv), f = unpack8(hfc[k]), g = unpack8(lgc[k]);
                f32x8 o;
#pragma unroll
                for (int e = 0; e < 8; ++e) o[e] = (a[e] + f[e]) * siluf(g[e]);
                *(u32x4*)dst = pack8(o);
            }
        }
    }
}

__device__ __forceinline__ void prep_elem(const Params& p, int l, int G) {
    const int gt = (int)blockIdx.x * 512 + tidx(), NT = G * 512;
    constexpr int NI = (NTOK / 4) * 192;
#pragma unroll 1
    for (int idx = gt; idx < NI; idx += NT) {
        const int tok = (idx / 192) * 4, cgi = idx % 192, b = tok / TPB, t = tok % TPB;
        const int lo = t < 256 ? 0 : 256, hi = t < 256 ? 256 : TPB;
        int col, CS, rs; const float *cw, *cb; bf16_t* dst; bool act;
        if (cgi < 128) { col = C_LX + cgi * 8; cw = p.lru_conv_w + l * 4096 + cgi * 8; CS = 1024; cb = p.lru_conv_b + l * 1024 + cgi * 8; act = false; dst = WS_LXC(p) + (size_t)tok * 1024 + cgi * 8; rs = 1024; }
        else { const int c2 = (cgi - 128) * 8; col = C_XBC + 1024 + c2; cw = p.ssd_conv_w + l * 6144 + 1024 + c2; CS = 1536; cb = p.ssd_conv_b + l * 1536 + 1024 + c2; act = true; dst = WS_SBC(p) + (size_t)tok * 512 + c2; rs = 512; }
        const bf16_t* src = WS_P(p) + (size_t)b * TPB * LDP + col;
        u32x4 raw[7];
#pragma unroll
        for (int r = 0; r < 7; ++r) { const int tt = t - 2 + r; raw[r] = (tt >= lo && tt < hi) ? *(const u32x4*)(src + (size_t)tt * LDP) : (u32x4){0u, 0u, 0u, 0u}; }
        const f32x4 b0 = *(const f32x4*)cb, b1 = *(const f32x4*)(cb + 4);
        f32x8 acc[4];
#pragma unroll
        for (int o = 0; o < 4; ++o) { acc[o][0] = b0.x; acc[o][1] = b0.y; acc[o][2] = b0.z; acc[o][3] = b0.w; acc[o][4] = b1.x; acc[o][5] = b1.y; acc[o][6] = b1.z; acc[o][7] = b1.w; }
#pragma unroll
        for (int k = 0; k < 4; ++k) {
            const f32x4 w0 = *(const f32x4*)(cw + k * CS), w1 = *(const f32x4*)(cw + k * CS + 4);
#pragma unroll
            for (int o = 0; o < 4; ++o) {
                const f32x8 v = unpack8(raw[o + k]);
                acc[o][0] += w0.x * v[0]; acc[o][1] += w0.y * v[1]; acc[o][2] += w0.z * v[2]; acc[o][3] += w0.w * v[3];
                acc[o][4] += w1.x * v[4]; acc[o][5] += w1.y * v[5]; acc[o][6] += w1.z * v[6]; acc[o][7] += w1.w * v[7];
            }
        }
#pragma unroll
        for (int o = 0; o < 4; ++o) {
            if (act) {
#pragma unroll
                for (int e = 0; e < 8; ++e) acc[o][e] = siluf(acc[o][e]);
            }
            *(u32x4*)(dst + (size_t)o * rs) = pack8(acc[o]);
        }
    }
}
struct PrepTile { int col0, ch0, t0, lo, hi, conv; const bf16_t* Pb; bf16_t* dst; };
__device__ __forceinline__ PrepTile prep_tile_decode(const Params& p, int item) {
    PrepTile T;
    const int t24 = item % 24, bc = item / 24, c = bc % NCH, b = bc / NCH;
    T.t0 = c * 128; T.Pb = WS_P(p) + (size_t)b * TPB * LDP; T.ch0 = 0; T.conv = t24 < 20;
    if (t24 < 16) { T.ch0 = t24 * 64; T.col0 = C_XBC + T.ch0; T.dst = WS_SXT(p) + ((size_t)((b * 18 + c) * 16 + t24)) * 8192; }
    else if (t24 < 20) { const int q = t24 - 16, g = q >> 1, nh = q & 1; T.ch0 = 1024 + g * 128 + nh * 64; T.col0 = C_XBC + T.ch0; T.dst = WS_SBT(p) + ((size_t)((b * 18 + c) * 2 + g)) * 16384 + (size_t)nh * 64 * 128; }
    else { const int q = t24 - 20, kh = q >> 1, dh = q & 1; T.col0 = C_V + kh * 128 + dh * 64; T.dst = WS_VT(p) + ((size_t)((b * 18 + c) * 2 + kh)) * 16384 + (size_t)dh * 64 * 128; }
    T.lo = T.t0 < 256 ? 0 : 256; T.hi = T.t0 < 256 ? 256 : TPB;
    return T;
}
__device__ __forceinline__ void prep_tile_load(const PrepTile& T, int tid, u32x4 (&raw)[2][4]) {
#pragma unroll
    for (int k = 0; k < 2; ++k) {
        const int idx = tid + k * 512, cgi = idx & 7, t = T.t0 + (idx >> 3);
#pragma unroll
        for (int q = 0; q < 4; ++q) {
            const int tt = T.conv ? t - 2 + q : t;
            const bool ok = T.conv ? (tt >= T.lo && tt < T.hi) : (q == 2);
            raw[k][q] = ok ? *(const u32x4*)(T.Pb + (size_t)tt * LDP + T.col0 + cgi * 8) : (u32x4){0u, 0u, 0u, 0u};
        }
    }
}
__device__ __forceinline__ void prep_tile_finish(const Params& p, int l, const PrepTile& T, int tid, const u32x4 (&raw)[2][4], unsigned char* shm) {
    bf16_t* sT = (bf16_t*)shm;
    const float* cw = p.ssd_conv_w + l * 6144 + T.ch0; const float* cb = p.ssd_conv_b + l * 1536 + T.ch0;
    lds_barrier();
#pragma unroll
    for (int k = 0; k < 2; ++k) {
        const int idx = tid + k * 512, cgi = idx & 7, tl = idx >> 3;
        f32x8 acc;
        if (T.conv) {
            const f32x4 b0 = *(const f32x4*)(cb + cgi * 8), b1 = *(const f32x4*)(cb + cgi * 8 + 4);
            acc[0] = b0.x; acc[1] = b0.y; acc[2] = b0.z; acc[3] = b0.w; acc[4] = b1.x; acc[5] = b1.y; acc[6] = b1.z; acc[7] = b1.w;
#pragma unroll
            for (int q = 0; q < 4; ++q) {
                const f32x8 v = unpack8(raw[k][q]);
                const f32x4 w0 = *(const f32x4*)(cw + q * 1536 + cgi * 8), w1 = *(const f32x4*)(cw + q * 1536 + cgi * 8 + 4);
                acc[0] += w0.x * v[0]; acc[1] += w0.y * v[1]; acc[2] += w0.z * v[2]; acc[3] += w0.w * v[3];
                acc[4] += w1.x * v[4]; acc[5] += w1.y * v[5]; acc[6] += w1.z * v[6]; acc[7] += w1.w * v[7];
            }
#pragma unroll
            for (int e = 0; e < 8; ++e) acc[e] = siluf(acc[e]);
        } else acc = unpack8(raw[k][2]);
#pragma unroll
        for (int e = 0; e < 8; ++e) sT[(cgi * 8 + e) * 130 + tl] = f2bf(acc[e]);
    }
    lds_barrier();
#pragma unroll
    for (int k = 0; k < 2; ++k) {
        const int idx = tid + k * 512, r = idx >> 4, ck = idx & 15;
        const unsigned* sp = (const unsigned*)(sT + r * 130 + ck * 8);
        u32x4 o; o.x = sp[0]; o.y = sp[1]; o.z = sp[2]; o.w = sp[3];
        *(u32x4*)(T.dst + r * 128 + ck * 8) = o;
    }
}
__device__ __forceinline__ void prep_tiles(const Params& p, int l, int bid, int G, unsigned char* shm) {
    const int tid = tidx();
    if (bid >= 3456) return;
    u32x4 raw[2][4], nraw[2][4];
    { const PrepTile T0 = prep_tile_decode(p, bid); prep_tile_load(T0, tid, raw); }
#pragma unroll 1
    for (int it = bid; it < 3456; it += G) {
        const bool more = it + G < 3456;
        if (more) { const PrepTile Tn = prep_tile_decode(p, it + G); prep_tile_load(Tn, tid, nraw); }
        { const PrepTile T = prep_tile_decode(p, it); prep_tile_finish(p, l, T, tid, raw, shm); }
        if (more) {
#pragma unroll
            for (int k = 0; k < 2; ++k)
#pragma unroll
                for (int q = 0; q < 4; ++q) raw[k][q] = nraw[k][q];
        }
    }
}
__device__ __forceinline__ void prep_dt_item(const Params& p, int l, int item) {
    const int tid = tidx();
    const int c = item % NCH, b = item / NCH;
    const int col32 = tid >> 4, h = col32 >> 1, d = col32 & 1, lane16 = tid & 15, seg = d == 0 ? lane16 : 15 - lane16;
    const float A = -__expf(p.ssd_A_log[(l * 2 + d) * 16 + h]), bias = p.ssd_dt_bias[(l * 2 + d) * 16 + h];
    const float* src = WS_DTP(p) + ((size_t)b * TPB + c * 128) * 16 + h;
    float dtv[8], cs[8], run = 0.f;
    float rawv[8];
#pragma unroll
    for (int q = 0; q < 8; ++q) { const int j = seg * 8 + (d == 0 ? q : 7 - q); rawv[q] = src[j * 16]; }
#pragma unroll
    for (int q = 0; q < 8; ++q) { dtv[q] = softplusf(rawv[q] + bias); run += dtv[q] * A; cs[q] = run; }
    float incl = run;
#pragma unroll
    for (int off = 1; off < 16; off <<= 1) { const float v = __shfl_up(incl, off, 16); if (lane16 >= off) incl += v; }
    const float excl = incl - run;
    float* dta = WS_DTA(p) + ((size_t)(b * 18 + c) * 128) * 32 + col32;
    float* acs = WS_ACS(p) + ((size_t)(b * 18 + c) * 128) * 32 + col32;
#pragma unroll
    for (int q = 0; q < 8; ++q) { const int j = seg * 8 + (d == 0 ? q : 7 - q); dta[j * 32] = dtv[q]; acs[j * 32] = cs[q] + excl; }
    if (lane16 == 15) WS_AL(p)[((b * 2 + d) * 18 + c) * 16 + h] = incl;
}
__device__ __forceinline__ void ssd_states_item(const Params& p, int l, int item, unsigned char* shm) {
    const int tid = tidx(), lane = tid & 63, wave = tid >> 6;
    const int g = item & 1, hh0 = ((item >> 1) & 1) * 4, bc = item >> 2, c = bc % NCH, b = bc / NCH;
    bf16_t* sBT = (bf16_t*)shm; bf16_t* sXw = (bf16_t*)(shm + 34816);
    float* sDt = (float*)(shm + 69632); float* sAcs = (float*)(shm + 77824); bf16_t* sO = (bf16_t*)(shm + 86016); float* sWg = (float*)(shm + 120832);
    const bf16_t* xt = WS_SXT(p) + ((size_t)((b * 18 + c) * 16 + g * 8)) * 8192;
    const bf16_t* btp = WS_SBT(p) + ((size_t)((b * 18 + c) * 2 + g)) * 16384;
    lds_barrier();
    {
        const size_t o = ((size_t)(b * 18 + c) * 128 + (tid >> 2)) * 32 + g * 16 + (tid & 3) * 4;
        const f32x4 vdt = *(const f32x4*)(WS_DTA(p) + o), vac = *(const f32x4*)(WS_ACS(p) + o);
        u32x4 bt[4];
#pragma unroll
        for (int k = 0; k < 4; ++k) { const int idx = tid + k * 512; bt[k] = *(const u32x4*)(btp + (idx >> 4) * 128 + (idx & 15) * 8); }
        *(f32x4*)(sDt + (tid >> 2) * 16 + (tid & 3) * 4) = vdt; *(f32x4*)(sAcs + (tid >> 2) * 16 + (tid & 3) * 4) = vac;
#pragma unroll
        for (int k = 0; k < 4; ++k) { const int idx = tid + k * 512; *(u32x4*)(sBT + (idx >> 4) * 136 + (idx & 15) * 8) = bt[k]; }
    }
    u32x4 xr[2];
#pragma unroll
    for (int k = 0; k < 2; ++k) { const int idx = tid + k * 512; xr[k] = *(const u32x4*)(xt + (size_t)hh0 * 8192 + (idx >> 4) * 128 + (idx & 15) * 8); }
    lds_barrier();
#pragma unroll
    for (int k = 0; k < 4; ++k) { const int idx = tid + k * 512, jj = idx >> 4, col = idx & 15; const float al = (col & 1) == 0 ? sAcs[127 * 16 + col] : sAcs[col]; sWg[col * 128 + jj] = __expf(al - sAcs[jj * 16 + col]) * sDt[jj * 16 + col]; }
#pragma unroll 1
    for (int hh = hh0; hh < hh0 + 4; ++hh) {
        const int h = g * 8 + hh;
        u32x4 xn[2] = {xr[0], xr[1]};
        if (hh < hh0 + 3) {
#pragma unroll
            for (int k = 0; k < 2; ++k) { const int idx = tid + k * 512; xn[k] = *(const u32x4*)(xt + (size_t)(hh + 1) * 8192 + (idx >> 4) * 128 + (idx & 15) * 8); }
        }
        lds_barrier();
#pragma unroll
        for (int k = 0; k < 2; ++k) {
            const int idx = tid + k * 512, pp = idx >> 4, j8 = (idx & 15) * 8;
            const f32x8 xv = unpack8(xr[k]);
#pragma unroll
            for (int d = 0; d < 2; ++d) {
                const f32x4 w0 = *(const f32x4*)(sWg + (hh * 2 + d) * 128 + j8), w1 = *(const f32x4*)(sWg + (hh * 2 + d) * 128 + j8 + 4);
                f32x8 o;
                o[0] = xv[0] * w0.x; o[1] = xv[1] * w0.y; o[2] = xv[2] * w0.z; o[3] = xv[3] * w0.w; o[4] = xv[4] * w1.x; o[5] = xv[5] * w1.y; o[6] = xv[6] * w1.z; o[7] = xv[7] * w1.w;
                *(u32x4*)(sXw + d * 8704 + pp * 136 + j8) = pack8(o);
            }
        }
        lds_barrier();
        const int mi = wave & 1, nj = wave >> 1;
#pragma unroll
        for (int d = 0; d < 2; ++d) {
            f32x16 acc;
#pragma unroll
            for (int r = 0; r < 16; ++r) acc[r] = 0.f;
            mm32<128>(acc, sXw + d * 8704 + mi * 32 * 136, 136, sBT + nj * 32 * 136, 136, lane);
#pragma unroll
            for (int r = 0; r < 16; ++r) sO[d * 8704 + (mi * 32 + rowmap32(r, lane)) * 136 + nj * 32 + (lane & 31)] = f2bf(acc[r]);
        }
        lds_barrier();
#pragma unroll
        for (int d = 0; d < 2; ++d) {
            bf16_t* base = WS_ST(p) + ((size_t)((b * 2 + d) * 18 + c) * 16 + h) * 8192;
#pragma unroll
            for (int k = 0; k < 2; ++k) { const int idx = tid + k * 512; *(u32x4*)(base + idx * 8) = *(const u32x4*)(sO + d * 8704 + (idx >> 4) * 136 + (idx & 15) * 8); }
        }
        xr[0] = xn[0]; xr[1] = xn[1];
    }
}
__device__ __forceinline__ void ssd_recur_item(const Params& p, int item) {
    const int tid = tidx();
    const int d = item & 1, h = (item >> 1) & 15, b = item >> 5;
    u32x4 s0[NCH], s1[NCH]; float ev[NCH];
#pragma unroll
    for (int pos = 0; pos < NCH; ++pos) {
        const int c = chunk_at(d, pos);
        const bf16_t* ptr = WS_ST(p) + ((size_t)((b * 2 + d) * 18 + c) * 16 + h) * 8192 + tid * 16;
        s0[pos] = *(const u32x4*)ptr; s1[pos] = *(const u32x4*)(ptr + 8);
        ev[pos] = WS_AL(p)[((b * 2 + d) * 18 + c) * 16 + h];
    }
    f32x8 h0, h1;
#pragma unroll
    for (int e = 0; e < 8; ++e) { h0[e] = 0.f; h1[e] = 0.f; }
#pragma unroll
    for (int pos = 0; pos < NCH; ++pos) {
        const int c = chunk_at(d, pos);
        bf16_t* ptr = WS_ST(p) + ((size_t)((b * 2 + d) * 18 + c) * 16 + h) * 8192 + tid * 16;
        *(u32x4*)ptr = pack8(h0); *(u32x4*)(ptr + 8) = pack8(h1);
        const float e = __expf(ev[pos]);
        h0 = h0 * e + unpack8(s0[pos]); h1 = h1 * e + unpack8(s1[pos]);
    }
}
template <int MODE>
__device__ __forceinline__ void ssd_final_item(const Params& p, int l, int item, unsigned char* shm) {
    const int tid = tidx(), lane = tid & 63, wave = tid >> 6;
    const int g = item & 1, hh0 = ((item >> 1) & 1) * 4, bc = item >> 2, c = bc % NCH, b = bc / NCH, t0 = c * 128;
    const size_t tok0 = (size_t)b * TPB + t0;
    bf16_t* sC = (bf16_t*)shm; bf16_t* sBW = (bf16_t*)(shm + 34816); bf16_t* sXT = (bf16_t*)(shm + 69632); bf16_t* sH = (bf16_t*)(shm + 87040);
    float* sDt = (float*)(shm + 104448); float* sAcs = (float*)(shm + 112640);
    bf16_t* sY = sBW;
    const bf16_t* xt = WS_SXT(p) + ((size_t)((b * 18 + c) * 16 + g * 8)) * 8192;
    const bf16_t* zt = WS_P(p) + tok0 * LDP + C_Z + g * 512;
    const bf16_t* hin0 = WS_ST(p) + ((size_t)((b * 2 + 0) * 18 + c) * 16 + g * 8) * 8192;
    const bf16_t* hin1 = WS_ST(p) + ((size_t)((b * 2 + 1) * 18 + c) * 16 + g * 8) * 8192;
    lds_barrier();
    u32x4 xr[2], zr[2], h0r[2];
    {
        const size_t o = ((size_t)(b * 18 + c) * 128 + (tid >> 2)) * 32 + g * 16 + (tid & 3) * 4;
        const f32x4 vdt = *(const f32x4*)(WS_DTA(p) + o), vac = *(const f32x4*)(WS_ACS(p) + o);
        u32x4 cr[4], br[4];
#pragma unroll
        for (int k = 0; k < 4; ++k) { const int idx = tid + k * 512; const bf16_t* s = WS_SBC(p) + (tok0 + (idx >> 4)) * 512 + g * 128 + (idx & 15) * 8; br[k] = *(const u32x4*)s; cr[k] = *(const u32x4*)(s + 256); }
#pragma unroll
        for (int k = 0; k < 2; ++k) {
            const int idx = tid + k * 512;
            xr[k] = *(const u32x4*)(xt + (size_t)hh0 * 8192 + (idx >> 4) * 128 + (idx & 15) * 8);
            zr[k] = *(const u32x4*)(zt + (size_t)(idx >> 3) * LDP + hh0 * 64 + (idx & 7) * 8);
            h0r[k] = *(const u32x4*)(hin0 + (size_t)hh0 * 8192 + idx * 8);
        }
        *(f32x4*)(sDt + (tid >> 2) * 16 + (tid & 3) * 4) = vdt; *(f32x4*)(sAcs + (tid >> 2) * 16 + (tid & 3) * 4) = vac;
#pragma unroll
        for (int k = 0; k < 4; ++k) { const int idx = tid + k * 512; *(u32x4*)(sC + (idx >> 4) * 136 + (idx & 15) * 8) = cr[k]; *(u32x4*)(sBW + (idx >> 4) * 136 + (idx & 15) * 8) = br[k]; }
    }
    lds_barrier();
    const int cmi = wave >> 1, cnj0 = (wave & 1) * 2;
    f32x16 cb0, cb1;
#pragma unroll
    for (int r = 0; r < 16; ++r) { cb0[r] = 0.f; cb1[r] = 0.f; }
    mm32<128>(cb0, sC + cmi * 32 * 136, 136, sBW + cnj0 * 32 * 136, 136, lane);
    mm32<128>(cb1, sC + cmi * 32 * 136, 136, sBW + (cnj0 + 1) * 32 * 136, 136, lane);
    const int ymi = wave & 3, ynj = wave >> 2;
#pragma unroll 1
    for (int hh = hh0; hh < hh0 + 4; ++hh) {
        const int h = g * 8 + hh;
        lds_barrier();
#pragma unroll
        for (int k = 0; k < 2; ++k) { const int idx = tid + k * 512; *(u32x4*)(sXT + (idx >> 4) * 136 + (idx & 15) * 8) = xr[k]; *(u32x4*)(sH + (idx >> 4) * 136 + (idx & 15) * 8) = h0r[k]; }
        u32x4 h1r[2];
#pragma unroll
        for (int k = 0; k < 2; ++k) h1r[k] = *(const u32x4*)(hin1 + (size_t)hh * 8192 + (tid + k * 512) * 8);
        f32x16 yacc;
        const int colf = hh * 2, colr = hh * 2 + 1;
        if (MODE < 2) {
            float acif[16], acir[16];
#pragma unroll
            for (int r = 0; r < 16; ++r) { const int ig = cmi * 32 + rowmap32(r, lane); acif[r] = sAcs[ig * 16 + colf]; acir[r] = sAcs[ig * 16 + colr]; }
#pragma unroll
            for (int tt = 0; tt < 2; ++tt) {
                const int jg = (cnj0 + tt) * 32 + (lane & 31);
                const float acjf = sAcs[jg * 16 + colf], dtjf = sDt[jg * 16 + colf], acjr = sAcs[jg * 16 + colr], dtjr = sDt[jg * 16 + colr];
                const int dj0 = jg - cmi * 32 - 4 * (lane >> 5);
#pragma unroll
                for (int r = 0; r < 16; ++r) {
                    const int sd = dj0 - ((r & 3) + 8 * (r >> 2));
                    const bool fwd = sd <= 0;
                    const float arg = fwd ? acif[r] - acjf : acir[r] - acjr, sc = fwd ? dtjf : dtjr;
                    const float cbv = tt == 0 ? cb0[r] : cb1[r];
                    float val = cbv * __expf(arg) * sc;
                    val += sd == 0 ? cbv * dtjr : 0.f;
                    sBW[(cmi * 32 + rowmap32(r, lane)) * 136 + jg] = f2bf(val);
                }
            }
        }
        lds_barrier();
        {
            f32x16 ad, ao;
#pragma unroll
            for (int r = 0; r < 16; ++r) { ad[r] = 0.f; ao[r] = 0.f; }
            if (MODE < 3) { mm32<128>(ad, sBW + ymi * 32 * 136, 136, sXT + ynj * 32 * 136, 136, lane);
            mm32<128>(ao, sC + ymi * 32 * 136, 136, sH + ynj * 32 * 136, 136, lane); }
#pragma unroll
            for (int r = 0; r < 16; ++r) { const int ig = ymi * 32 + rowmap32(r, lane); yacc[r] = ad[r] + __expf(sAcs[ig * 16 + colf]) * ao[r]; }
        }
        if (hh < hh0 + 3) {
#pragma unroll
            for (int k = 0; k < 2; ++k) {
                const int idx = tid + k * 512;
                xr[k] = *(const u32x4*)(xt + (size_t)(hh + 1) * 8192 + (idx >> 4) * 128 + (idx & 15) * 8);
                h0r[k] = *(const u32x4*)(hin0 + (size_t)(hh + 1) * 8192 + idx * 8);
            }
        }
        lds_barrier();
#pragma unroll
        for (int k = 0; k < 2; ++k) { const int idx = tid + k * 512; *(u32x4*)(sH + (idx >> 4) * 136 + (idx & 15) * 8) = h1r[k]; }
        lds_barrier();
        {
            f32x16 ao;
#pragma unroll
            for (int r = 0; r < 16; ++r) ao[r] = 0.f;
            if (MODE < 3) mm32<128>(ao, sC + ymi * 32 * 136, 136, sH + ynj * 32 * 136, 136, lane);
#pragma unroll
            for (int r = 0; r < 16; ++r) { const int ig = ymi * 32 + rowmap32(r, lane); yacc[r] += __expf(sAcs[ig * 16 + colr]) * ao[r]; }
        }
        const float Dh = p.ssd_D[l * 16 + h];
        const int pl = ynj * 32 + (lane & 31);
#pragma unroll
        for (int r = 0; r < 16; ++r) { const int ig = ymi * 32 + rowmap32(r, lane); yacc[r] += Dh * bf2f(sXT[pl * 136 + ig]); }
        lds_barrier();
#pragma unroll
        for (int r = 0; r < 16; ++r) { const int ig = ymi * 32 + rowmap32(r, lane); sY[ig * 72 + pl] = f2bf(yacc[r]); }
        lds_barrier();
#pragma unroll
        for (int k = 0; k < 2; ++k) {
            const int idx = tid + k * 512, rr = idx >> 3, pk = idx & 7;
            const f32x8 yv = unpack8(*(const u32x4*)(sY + rr * 72 + pk * 8)), zv = unpack8(zr[k]);
            f32x8 o;
#pragma unroll
            for (int e = 0; e < 8; ++e) o[e] = yv[e] * siluf(zv[e]);
            if (MODE < 1) *(u32x4*)(WS_MIX(p) + (tok0 + rr) * MIXW + 2048 + h * 64 + pk * 8) = pack8(o); else asm volatile("" :: "v"(o[0]), "v"(o[7]));
        }
        if (hh < hh0 + 3) {
#pragma unroll
            for (int k = 0; k < 2; ++k) { const int idx = tid + k * 512; zr[k] = *(const u32x4*)(zt + (size_t)(idx >> 3) * LDP + (hh + 1) * 64 + (idx & 7) * 8); }
        }
    }
}
__device__ __forceinline__ void ssd_norm_phase(const Params& p, int l, int G) {
    const int lane = tidx() & 63, wave = tidx() >> 6;
    for (int row = blockIdx.x * 8 + wave; row < NTOK; row += G * 8) {
        bf16_t* rp = WS_MIX(p) + (size_t)row * MIXW + 2048;
        f32x8 v0 = unpack8(*(const u32x4*)(rp + lane * 8)), v1 = unpack8(*(const u32x4*)(rp + 512 + lane * 8));
        float ss = 0.f;
#pragma unroll
        for (int e = 0; e < 8; ++e) ss += v0[e] * v0[e] + v1[e] * v1[e];
        ss = wave_sum(ss);
        const float rstd = rsqrtf(ss * (1.f / 1024.f) + 1e-6f);
        const float* nw = p.ssd_norm_w + l * 1024;
#pragma unroll
        for (int e = 0; e < 8; ++e) { v0[e] = v0[e] * rstd * nw[lane * 8 + e]; v1[e] = v1[e] * rstd * nw[512 + lane * 8 + e]; }
        *(u32x4*)(rp + lane * 8) = pack8(v0); *(u32x4*)(rp + 512 + lane * 8) = pack8(v1);
    }
}

template <int MODE>
__device__ __forceinline__ void attn_item(const Params& p, int l, int item, unsigned char* shm) {
    const int tid = tidx(), lane = tid & 63, wave = tid >> 6, fr = lane & 15, fq = lane >> 4;
    const int hp = item & 3, bq = item >> 2, qblk = bq % NCH, b = bq / NCH, kh = hp >> 1;
    const bf16_t* P = WS_P(p);
    bf16_t* sK = (bf16_t*)shm; bf16_t* sVT = (bf16_t*)(shm + 34816); bf16_t* sPw = (bf16_t*)(shm + 69632) + wave * (2 * 16 * 136);
    const size_t tokq0 = (size_t)b * TPB + qblk * 128;
    bf16x8 aq[2][4];
#pragma unroll
    for (int hd = 0; hd < 2; ++hd)
#pragma unroll
        for (int kk = 0; kk < 4; ++kk) aq[hd][kk] = *(const bf16x8*)(P + (tokq0 + wave * 16 + fr) * LDP + C_Q + (hp * 2 + hd) * 128 + kk * 32 + 8 * fq);
    float m[2][4], ls[2][4]; f32x4 O[2][8];
#pragma unroll
    for (int hd = 0; hd < 2; ++hd) {
        const float sink = p.att_sink[l * 8 + hp * 2 + hd];
#pragma unroll
        for (int r = 0; r < 4; ++r) { m[hd][r] = sink; ls[hd][r] = 1.f; }
#pragma unroll
        for (int nd = 0; nd < 8; ++nd) O[hd][nd] = (f32x4){0.f, 0.f, 0.f, 0.f};
    }
    const int nlat = qblk - 2;
    const int kb_lo = nlat - 1 < 0 ? 0 : nlat - 1, kb_hi = nlat + 1 > 15 ? 15 : nlat + 1;
    const int ntl = qblk < 2 ? 2 : 2 + (kb_hi - kb_lo + 1);
    u32x4 kr[4], vr[4];
    const bf16_t* vtb = WS_VT(p) + ((size_t)(b * 18) * 2 + kh) * 16384;
    {
        const bf16_t* kbase = P + ((size_t)b * TPB) * LDP + C_K + kh * 128;
#pragma unroll
        for (int k = 0; k < 4; ++k) { const int idx = tid + k * 512; kr[k] = *(const u32x4*)(kbase + (size_t)(idx >> 4) * LDP + (idx & 15) * 8); vr[k] = *(const u32x4*)(vtb + idx * 8); }
    }
#pragma unroll 1
    for (int ti = 0; ti < ntl; ++ti) {
        const bool masked = ti >= 2; const int kb = kb_lo + (ti - 2);
        lds_barrier();
#pragma unroll
        for (int k = 0; k < 4; ++k) {
            const int idx = tid + k * 512;
            *(u32x4*)(sK + (idx >> 4) * 136 + (idx & 15) * 8) = kr[k];
            *(u32x4*)(sVT + (idx >> 4) * 136 + (idx & 15) * 8) = vr[k];
        }
        if (ti + 1 < ntl) {
            const int tn = ti + 1, t0n = tn < 2 ? tn * 128 : 256 + (kb_lo + (tn - 2)) * 128;
            const bf16_t* kbase = P + ((size_t)b * TPB + t0n) * LDP + C_K + kh * 128;
            const bf16_t* vtn = vtb + (size_t)(t0n >> 7) * 32768;
#pragma unroll
            for (int k = 0; k < 4; ++k) { const int idx = tid + k * 512; kr[k] = *(const u32x4*)(kbase + (size_t)(idx >> 4) * LDP + (idx & 15) * 8); vr[k] = *(const u32x4*)(vtn + idx * 8); }
        }
        lds_barrier();
#pragma unroll 1
        for (int hf = 0; hf < 2; ++hf) {
            f32x4 s[2][4];
#pragma unroll
            for (int nt = 0; nt < 4; ++nt) {
                s[0][nt] = (f32x4){0.f, 0.f, 0.f, 0.f}; s[1][nt] = (f32x4){0.f, 0.f, 0.f, 0.f};
#pragma unroll
                for (int kk = 0; kk < 4; ++kk) {
                    const bf16x8 bk = *(const bf16x8*)(sK + ((hf * 4 + nt) * 16 + fr) * 136 + kk * 32 + 8 * fq);
                    s[0][nt] = __builtin_amdgcn_mfma_f32_16x16x32_bf16(aq[0][kk], bk, s[0][nt], 0, 0, 0);
                    s[1][nt] = __builtin_amdgcn_mfma_f32_16x16x32_bf16(aq[1][kk], bk, s[1][nt], 0, 0, 0);
                }
                __builtin_amdgcn_sched_barrier(0);
            }
            if (masked) {
#pragma unroll
                for (int nt = 0; nt < 4; ++nt)
#pragma unroll
                    for (int r = 0; r < 4; ++r) { const int rel = (nlat * 128 + wave * 16 + fq * 4 + r) - (kb * 128 + (hf * 4 + nt) * 16 + fr); if (rel > 128 || rel < -128) { s[0][nt][r] = -INFINITY; s[1][nt][r] = -INFINITY; } }
            }
#pragma unroll
            for (int hd = 0; hd < 2; ++hd) {
                float alpha[4];
#pragma unroll
                for (int r = 0; r < 4; ++r) {
                    float mx = fmaxf(fmaxf(s[hd][0][r], s[hd][1][r]), fmaxf(s[hd][2][r], s[hd][3][r]));
                    mx = row16_max(mx);
                    const float mn = fmaxf(m[hd][r], mx);
                    alpha[r] = __expf(m[hd][r] - mn); m[hd][r] = mn;
                    float rs = 0.f;
#pragma unroll
                    for (int nt = 0; nt < 4; ++nt) { const float pv = __expf(s[hd][nt][r] - mn); s[hd][nt][r] = pv; rs += pv; }
                    rs = row16_sum(rs);
                    ls[hd][r] = ls[hd][r] * alpha[r] + rs;
                }
#pragma unroll
                for (int nd = 0; nd < 8; ++nd) { O[hd][nd].x *= alpha[0]; O[hd][nd].y *= alpha[1]; O[hd][nd].z *= alpha[2]; O[hd][nd].w *= alpha[3]; }
#pragma unroll
                for (int nt = 0; nt < 4; ++nt)
#pragma unroll
                    for (int r = 0; r < 4; ++r) sPw[hd * (16 * 136) + (fq * 4 + r) * 136 + nt * 16 + fr] = f2bf(s[hd][nt][r]);
            }
            asm volatile("s_waitcnt lgkmcnt(0)" ::: "memory");
#pragma unroll
            for (int kk = 0; kk < 2; ++kk) {
                const bf16x8 ap0 = *(const bf16x8*)(sPw + fr * 136 + kk * 32 + 8 * fq);
                const bf16x8 ap1 = *(const bf16x8*)(sPw + 16 * 136 + fr * 136 + kk * 32 + 8 * fq);
#pragma unroll
                for (int nd = 0; nd < 8; ++nd) {
                    const bf16x8 bv = *(const bf16x8*)(sVT + (nd * 16 + fr) * 136 + hf * 64 + kk * 32 + 8 * fq);
                    O[0][nd] = __builtin_amdgcn_mfma_f32_16x16x32_bf16(ap0, bv, O[0][nd], 0, 0, 0);
                    O[1][nd] = __builtin_amdgcn_mfma_f32_16x16x32_bf16(ap1, bv, O[1][nd], 0, 0, 0);
                    if (nd == 3) __builtin_amdgcn_sched_barrier(0);
                }
                __builtin_amdgcn_sched_barrier(0);
            }
            asm volatile("s_waitcnt lgkmcnt(0)" ::: "memory");
        }
    }
#pragma unroll
    for (int hd = 0; hd < 2; ++hd) {
        const int hq = hp * 2 + hd;
        u32x4 agr[4];
#pragma unroll
        for (int k = 0; k < 4; ++k) { const int idx = tid + k * 512; agr[k] = *(const u32x4*)(P + (tokq0 + (idx >> 4)) * LDP + C_AG + hq * 128 + (idx & 15) * 8); }
        lds_barrier();
#pragma unroll
        for (int r = 0; r < 4; ++r) {
            const float il = __builtin_amdgcn_rcpf(ls[hd][r]);
#pragma unroll
            for (int nd = 0; nd < 8; ++nd) sK[(wave * 16 + fq * 4 + r) * 136 + nd * 16 + fr] = f2bf(O[hd][nd][r] * il);
        }
        lds_barrier();
#pragma unroll
        for (int k = 0; k < 4; ++k) {
            const int idx = tid + k * 512, rr = idx >> 4, ck = idx & 15;
            const f32x8 ov = unpack8(*(const u32x4*)(sK + rr * 136 + ck * 8)), gv = unpack8(agr[k]);
            f32x8 o;
#pragma unroll
            for (int e = 0; e < 8; ++e) o[e] = ov[e] * siluf(gv[e]);
            *(u32x4*)(WS_MIX(p) + (tokq0 + rr) * MIXW + 1024 + hq * 128 + ck * 8) = pack8(o);
        }
    }
}

#define XB_TMO      128
#define XB_XCNT(j)  (256  + 64 * (j))
#define XB_XSUB(j)  (1280 + 64 * (j))
#define XB_XGEN(j)  (2304 + 64 * (j))
#define XB_TOP      3328
#define XB_TOPGEN   3392
#define XCD_BAR_WORDS 3456
#define XB_SPIN_CAP (1u << 18)
#define LAS __attribute__((address_space(3)))
__device__ __forceinline__ unsigned xb_ld(unsigned* p)              { return __hip_atomic_load(p, __ATOMIC_RELAXED, __HIP_MEMORY_SCOPE_AGENT); }
__device__ __forceinline__ unsigned xb_add(unsigned* p, unsigned v) { return __hip_atomic_fetch_add(p, v, __ATOMIC_RELAXED, __HIP_MEMORY_SCOPE_AGENT); }
__device__ __forceinline__ unsigned xb_xcc_id() { return (unsigned)__builtin_amdgcn_s_getreg((3 << 11) | 20) & 0xFu; }
#define XB_SPIN(cond, bar) do { unsigned _sp = 0; while (cond) { __builtin_amdgcn_s_sleep(1); \
    if ((++_sp & 255u) == 0u) { if (xb_ld(&(bar)[XB_TMO])) break; if (_sp > XB_SPIN_CAP) { atomicAdd(&(bar)[XB_TMO], 1u); break; } } } } while (0)
struct XcdBarrier { unsigned* bar; unsigned x; volatile LAS unsigned* st; };
__device__ __forceinline__ XcdBarrier xcd_barrier_post(unsigned* bar, volatile LAS unsigned* st) {
    XcdBarrier b; b.bar = bar; b.x = xb_xcc_id(); b.st = st;
    if (tidx() == 0) (void)xb_add(&bar[XB_XCNT(b.x)], 1u);
    return b;
}
__device__ __forceinline__ void xcd_barrier_complete(unsigned* bar, unsigned x, unsigned& nloc, unsigned& nx) {
    const unsigned G = gridDim.x * gridDim.y * gridDim.z;
    unsigned sum, cnt, mine, sp = 0u;
    for (;;) {
        sum = 0u; cnt = 0u; mine = 0u;
#pragma unroll
        for (unsigned j = 0; j < 16; ++j) { const unsigned c = xb_ld(&bar[XB_XCNT(j)]); sum += c; cnt += (c > 0u) ? 1u : 0u; mine = (j == x) ? c : mine; }
        if (sum == G) break;
        __builtin_amdgcn_s_sleep(1);
        if ((++sp & 255u) == 0u) { if (xb_ld(&bar[XB_TMO])) break; if (sp > XB_SPIN_CAP) { atomicAdd(&bar[XB_TMO], 1u); break; } }
    }
    nloc = mine > 0u ? mine : 1u; nx = cnt > 0u ? cnt : 1u;
}
__device__ __forceinline__ void xcd_barrier(const XcdBarrier& b) {
    asm volatile("s_waitcnt vmcnt(0)" ::: "memory");
    __syncthreads();
    if (tidx() == 0) {
        unsigned* bar = b.bar;
        __builtin_amdgcn_s_waitcnt(0);
        unsigned nloc = b.st[0], nx = b.st[1];
        if (nloc == 0u) { xcd_barrier_complete(bar, b.x, nloc, nx); b.st[0] = nloc; b.st[1] = nx; }
        const unsigned old = xb_add(&bar[XB_XSUB(b.x)], 1u);
        const unsigned gen = old / nloc;
        if (old + 1u == (gen + 1u) * nloc) {
            __builtin_amdgcn_fence(__ATOMIC_RELEASE, "agent");
            asm volatile("s_waitcnt vmcnt(0)" ::: "memory");
            const unsigned og = xb_add(&bar[XB_TOP], 1u);
            const unsigned tg = og / nx;
            if (og + 1u == (tg + 1u) * nx) xb_add(&bar[XB_TOPGEN], 1u);
            else XB_SPIN(xb_ld(&bar[XB_TOPGEN]) == tg, bar);
            __builtin_amdgcn_fence(__ATOMIC_ACQUIRE, "agent");
            xb_add(&bar[XB_XGEN(b.x)], 1u);
            asm volatile("s_waitcnt vmcnt(0)" ::: "memory");
        } else {
            XB_SPIN(xb_ld(&bar[XB_XGEN(b.x)]) == gen, bar);
            __builtin_amdgcn_fence(__ATOMIC_ACQUIRE, "agent");
            asm volatile("s_waitcnt vmcnt(0)" ::: "memory");
        }
    }
    __syncthreads();
}


#define QUEUE_LOOP(ctr, NITEMS, BODY) do { \
    volatile LAS unsigned* _mb = (volatile LAS unsigned*)(shm + LDS_CTL + 8); \
    int it = bid; \
    while (it < (NITEMS)) { \
        unsigned _nx = 0u; if (tidx() == 0) _nx = xb_add((ctr), 1u) + (unsigned)G; \
        BODY; \
        __syncthreads(); \
        if (tidx() == 0) _mb[0] = _nx; \
        __syncthreads(); \
        it = (int)_mb[0]; \
    } } while (0)

__global__ __launch_bounds__(512) void mega(Params p) {
    extern __shared__ __attribute__((aligned(16))) unsigned char shm[];
    cg::grid_group grid = cg::this_grid();
    const int G = (int)gridDim.x, bid = (int)blockIdx.x;
    if (tidx() < 4) ((volatile LAS unsigned*)(shm + LDS_CTL))[tidx()] = 0u;
    __syncthreads();
    unsigned* qctr = (unsigned*)(p.ws + OFF_BAR) + 3584;
    const XcdBarrier xb = xcd_barrier_post((unsigned*)(p.ws + OFF_BAR), (volatile LAS unsigned*)(shm + LDS_CTL));
    for (int rep = 0; rep < 1 + DUP_P0; ++rep) phase0(p, shm, G);
    grid.sync();
#pragma unroll 1
    for (int l = 0; l < 4; ++l) {
        for (int rep = 0; rep < 1 + DUP_NORM; ++rep) norm_phase(p, l, G);
        xcd_barrier(xb);
        {
            pg8::Gemm g{WS_U(p), WS_WTIN(p) + (size_t)l * 7424 * 2048, NTOK, 7168, 2048, 2048};
            pg8::Order S; S.init(72, 28, G, bid, 0);
            EpiG1 E{WS_P(p)};
            for (int rep = 0; rep < 1 + DUP_G1; ++rep) pg8::gemm_phase<EpiG1, pg8::Order>((PG8_LAS unsigned char*)shm, g, S, E);
            {
                const int tq = tidx(), wave = tq >> 6, lane = tq & 63, fr = lane & 15, fq = lane >> 4;
                for (int wu = bid * 8 + wave; wu < NTOK / 16; wu += G * 8) {
                    const bf16_t* ap = WS_U(p) + (size_t)(wu * 16 + fr) * 2048 + 8 * fq;
                    const bf16_t* bp = WS_WTIN(p) + ((size_t)l * 7424 + 7168 + fr) * 2048 + 8 * fq;
                    f32x4 acc = (f32x4){0.f, 0.f, 0.f, 0.f};
#pragma unroll 8
                    for (int kk = 0; kk < 64; ++kk) { const bf16x8 a = *(const bf16x8*)(ap + kk * 32), bq = *(const bf16x8*)(bp + kk * 32); acc = __builtin_amdgcn_mfma_f32_16x16x32_bf16(a, bq, acc, 0, 0, 0); }
#pragma unroll
                    for (int r = 0; r < 4; ++r) WS_DTP(p)[(size_t)(wu * 16 + fq * 4 + r) * 16 + fr] = acc[r];
                }
            }
        }
        for (int rep = 0; rep < 1 + DUP_SYNC; ++rep) xcd_barrier(xb);
        for (int rep = 0; rep < 1 + DUP_E1; ++rep) {
            if (rep == 0 || E1SEL == 0 || E1SEL == 1) for (int it = bid; it < 144; it += G) prep_dt_item(p, l, it);
            if (rep == 0 || E1SEL == 0 || E1SEL == 2) { __syncthreads(); prep_tiles(p, l, bid, G, shm); }
            if (rep == 0 || E1SEL == 0 || E1SEL == 3) prep_elem(p, l, G);
        }
        { const int tq = tidx(), wave = tq >> 6, lane = tq & 63; for (int row = bid * 8 + wave; row < NTOK; row += G * 8) qkprep_row<0>(p, l, row, lane);
#if DUP_QK
          for (int row = bid * 8 + wave; row < NTOK; row += G * 8) qkprep_row<1>(p, l, row, lane);
#endif
        }
        xcd_barrier(xb);
        QUEUE_LOOP(qctr + (l * 3 + 0) * 64, 128 + 576, { if (it < 128) lru_sweep_item<0>(p, l, it, shm); else ssd_states_item(p, l, it - 128, shm); });
#if DUP_X1Q
        __syncthreads(); QUEUE_LOOP(qctr + (12 + l * 3 + 0) * 64, 128 + 576, { if (it < 128) lru_sweep_item<0>(p, l, it, shm); else ssd_states_item(p, l, it - 128, shm); });
#endif
#if DUP_SWEEP
        __syncthreads(); for (int it = bid; it < 128; it += G) lru_sweep_item<0>(p, l, it, shm);
#endif
#if DUP_STATES
        __syncthreads(); for (int it = bid; it < 256; it += G) ssd_states_item(p, l, it, shm);
#endif
        xcd_barrier(xb);
        QUEUE_LOOP(qctr + (l * 3 + 1) * 64, 256 + 576, { if (it < 256) ssd_recur_item(p, it); else attn_item<0>(p, l, it - 256, shm); });
#if DUP_ATTQ
        __syncthreads(); QUEUE_LOOP(qctr + (12 + l * 3 + 1) * 64, 576, { attn_item<AMODE>(p, l, it, shm); });
#endif
        xcd_barrier(xb);
        QUEUE_LOOP(qctr + (l * 3 + 2) * 64, 128 + 576, { if (it < 128) lru_sweep_item<1>(p, l, it, shm); else ssd_final_item<0>(p, l, it - 128, shm); });
#if DUP_FINAL
        __syncthreads(); for (int it = bid; it < 256; it += G) ssd_final_item<FMODE>(p, l, it, shm);
#endif
#if DUP_SWEEP1
        __syncthreads(); for (int it = bid; it < 128; it += G) lru_sweep_item<1, 1>(p, l, it, shm);
#endif
        xcd_barrier(xb);
#ifndef SK_X4
        ssd_norm_phase(p, l, G);
#endif
        xcd_barrier(xb);
        {
            pg8::Gemm g{WS_MIX(p), WS_WTOUT(p) + (size_t)l * 2048 * 3072, NTOK, 2048, 3072, 3072};
            pg8::Order S; S.init(64, 8, G, bid, l == 3 ? 1 : 0);
            EpiG2 E{p, l, 0};
#if DUP_G2
            { EpiG2 E2{p, l, 1}; pg8::gemm_phase<EpiG2, pg8::Order>((PG8_LAS unsigned char*)shm, g, S, E2); }
#endif
#ifndef SK_G2
            pg8::gemm_phase<EpiG2, pg8::Order>((PG8_LAS unsigned char*)shm, g, S, E);
#endif
        }
        if (l < 3) {
            pg8::Gemm gt{WS_MIX(p), WS_WTOUT(p) + (size_t)l * 2048 * 3072, NTOK, 2048, 768, 3072};
            pg8::TailOrder St{bid, G};
            EpiPart Et{(float*)WS_P(p)};
            pg8::gemm_phase<EpiPart, pg8::TailOrder>((PG8_LAS unsigned char*)shm, gt, St, Et);
            xcd_barrier(xb);
        }
    }
}

extern "C" void kernel_launch(void* const* d_in, const int* in_sizes, int n_in, void* d_out, int out_size, void* d_ws, size_t ws_size, hipStream_t stream) {
    static int grid = 0;
    if (grid == 0) {
        if (n_in != 25 || ws_size < WS_END) { fprintf(stderr, "kernel_launch: need 25 inputs and %zu bytes of workspace (got %d, %zu)\n", (size_t)WS_END, n_in, ws_size); grid = -1; return; }
        int dev = 0, cus = 0, per_cu = 0;
        hipGetDevice(&dev);
        hipDeviceGetAttribute(&cus, hipDeviceAttributeMultiprocessorCount, dev);
        if (hipFuncSetAttribute((const void*)mega, hipFuncAttributeMaxDynamicSharedMemorySize, LDS_BYTES) != hipSuccess) { fprintf(stderr, "kernel_launch: hipFuncSetAttribute failed\n"); grid = -1; return; }
        if (hipOccupancyMaxActiveBlocksPerMultiprocessor(&per_cu, (const void*)mega, 512, LDS_BYTES) != hipSuccess || per_cu < 1) { fprintf(stderr, "kernel_launch: occupancy query gave %d\n", per_cu); per_cu = 1; }
        (void)hipGetLastError();
        grid = cus * 1;
        if (grid <= 0) grid = 256;
    }
    if (grid < 0) return;
    Params p{};
    const float** pf = (const float**)&p;
    for (int i = 0; i < 25; ++i) pf[i] = (const float*)d_in[i];
    p.out = (float*)d_out; p.ws = (unsigned char*)d_ws;
    if (hipMemsetAsync((char*)d_ws + OFF_BAR, 0, 32768, stream) != hipSuccess) { fprintf(stderr, "kernel_launch: memset of barrier words failed\n"); return; }
    void* args[] = {&p};
    hipError_t e = hipLaunchCooperativeKernel((const void*)mega, dim3(grid), dim3(512), args, LDS_BYTES, stream);
    if (e != hipSuccess) fprintf(stderr, "cooperative launch failed: %s (grid %d)\n", hipGetErrorString(e), grid);
}
```

```cpp
#include <hip/hip_runtime.h>
#include <hip/hip_cooperative_groups.h>
#include <cstdio>
#include <cstdint>
namespace cg = cooperative_groups;
#define DUP_X1A 0
#define DUP_X1B 0
#define DUP_ATT 0
#define DUP_X3A 0
#define DUP_X3B 0
#define DUP_G1 0
#define DUP_P0 0
#define DUP_NORM 0
#define DUP_SYNC 0
#define DUP_E1 0
#define DUP_SWEEP1 0
#define DUP_G2 0
#define DUP_QK 0
#define E1SEL 0
#define DUP_SWEEP 0
#define DUP_STATES 0
#define DUP_FINAL 0
#define AMODE 0
#define FMODE 0
#define DUP_X1Q 0
#define DUP_ATTQ 0
#define DUP_X3Q 0

__device__ __forceinline__ int tidx() { int t = (int)threadIdx.x; asm volatile("" : "+v"(t)); return t; }

namespace pg8 {
#define PG8_LAS __attribute__((address_space(3)))
typedef unsigned short bf16_t;
typedef short bf16x8 __attribute__((ext_vector_type(8)));
typedef float f32x4 __attribute__((ext_vector_type(4)));
typedef unsigned u32x4 __attribute__((ext_vector_type(4)));
constexpr int BM = 256, BK = 64, HALF = 128, HTB = HALF * BK * 2  , STAGE_BYTES = 8 * HTB, NXCD = 8, WGM = 8;

__host__ __device__ __forceinline__ int lds_byte(int r, int c) { const int st = (r >> 4) * 2 + (c >> 5), rr = r & 15, cc = c & 31, ob = rr * 64 + cc * 2; return st * 1024 + (ob ^ (((ob >> 9) & 1) << 5)); }
__host__ __device__ __forceinline__ void stage_rc(int b, int& R, int& C) { const int st = b / 1024, sb = b % 1024, swz = sb ^ (((sb >> 9) & 1) << 5); R = (st >> 1) * 16 + swz / 64; C = (st & 1) * 32 + (swz % 64) / 2; }
__host__ __device__ __forceinline__ int perm32(int rho) { const int n = rho >> 4, i = rho & 15; return 8 * (i >> 2) + 4 * n + (i & 3); }

struct Unit { int pm, pn, ks; };
struct Gemm { const bf16_t* A; const bf16_t* Bt; int M, N, K, ld; };

struct Order {
    int nM, nN, nwg, G, c, skipctx;
    __device__ void init(int nM_, int nN_, int G_, int c_, int skip_) { nM = nM_; nN = nN_; nwg = nM * nN; G = G_; c = c_; skipctx = skip_; }
    __device__ bool next(int i, Unit& u) const {
        const long L = (long)i * G + c; if (L >= nwg) return false;
        int wgid = (int)L; { const int q = nwg / NXCD, r = nwg % NXCD, xcd = wgid % NXCD, off = wgid / NXCD; wgid = (xcd < r ? xcd * (q + 1) : r * (q + 1) + (xcd - r) * q) + off; }
        const int nig = WGM * nN, gid = wgid / nig, fm = gid * WGM, gsz = (nM - fm) < WGM ? (nM - fm) : WGM;
        int pm = fm + ((wgid % nig) % gsz); u.pn = (wgid % nig) / gsz;
        if (skipctx) pm = (pm >> 3) * 9 + 1 + (pm & 7);
        u.pm = pm; u.ks = 0; return true;
    }
    __device__ __forceinline__ void a_ready(const Unit&) const {}
    __device__ __forceinline__ void done(const Unit&) const {}
};
typedef __bf16 bf16x2_t __attribute__((ext_vector_type(2)));
typedef float f32x2_t __attribute__((ext_vector_type(2)));
struct TailOrder {
    int c, G;
    __device__ bool next(int i, Unit& u) const { const int L = i * G + c; if (L >= 256) return false; u.pm = 64 + (L >> 5); u.pn = (L >> 2) & 7; u.ks = L & 3; return true; }
    __device__ __forceinline__ void a_ready(const Unit&) const {}
    __device__ __forceinline__ void done(const Unit&) const {}
};
__device__ __forceinline__ unsigned cvt_pk_bf16(float lo, float hi) { f32x2_t v = {lo, hi}; bf16x2_t b = __builtin_convertvector(v, bf16x2_t); return __builtin_bit_cast(unsigned, b); }

template <class Epi, class Sched>
__device__ __forceinline__ void gemm_phase(PG8_LAS unsigned char* lds, const Gemm g, const Sched& S, const Epi& E) {
    const int tid = tidx(), wid = __builtin_amdgcn_readfirstlane(tid >> 6), lane = tid & 63, wr = wid >> 2, wc = wid & 3, fr = lane & 15, fq = lane >> 4;
    const int K = g.K, LD = g.ld, nt = K / BK;
    unsigned voffA[2], voffB[2];
#pragma unroll
    for (int i = 0; i < 2; ++i) { int R, C; stage_rc(tid * 16 + i * 8192, R, C); const int Rb = Epi::PERM ? ((R & ~31) + perm32(R & 31)) : R;
        voffA[i] = (unsigned)(R * LD + C) * 2u; voffB[i] = (unsigned)(Rb * LD + C) * 2u; }
    const size_t kstep = (size_t)(BK * 2);
    const size_t hstep = (size_t)HALF * LD * 2;
    const size_t tstep = 2 * hstep;
    const unsigned ldsw = (unsigned)wid * 1024u;
    const int aoff = lds_byte(wr * 64 + fr, fq * 8), boff = lds_byte(wc * 32 + fr, fq * 8);
#define PG8_SA(b, h) (((b) * 2 + (h)) * HTB)
#define PG8_SB(b, h) ((4 + (b) * 2 + (h)) * HTB)
#define PG8_STAGE(bufoff, gbase, voff) do { _Pragma("unroll") for (int _i = 0; _i < 2; ++_i) \
        __builtin_amdgcn_global_load_lds((const unsigned*)((const char*)(gbase) + (voff)[_i]), (PG8_LAS unsigned*)(lds + (bufoff) + ldsw + _i * 8192), 16, 0, 0); } while (0)
#define PG8_LDA(dst, b, h) do { _Pragma("unroll") for (int m = 0; m < 4; ++m) _Pragma("unroll") for (int k = 0; k < 2; ++k) dst[m][k] = *(const PG8_LAS bf16x8*)(lds + PG8_SA(b, h) + aoff + m * 2048 + k * 1024); } while (0)
#define PG8_LDB(dst, b, h) do { _Pragma("unroll") for (int n = 0; n < 2; ++n) _Pragma("unroll") for (int k = 0; k < 2; ++k) dst[n][k] = *(const PG8_LAS bf16x8*)(lds + PG8_SB(b, h) + boff + n * 2048 + k * 1024); } while (0)
#define PG8_MMA(ai, bj, At, Bt) do { __builtin_amdgcn_s_setprio(1); _Pragma("unroll") for (int m = 0; m < 4; ++m) _Pragma("unroll") for (int n = 0; n < 2; ++n) _Pragma("unroll") for (int k = 0; k < 2; ++k) \
        acc[ai][bj][m][n] = __builtin_amdgcn_mfma_f32_16x16x32_bf16(Bt[n][k], At[m][k], acc[ai][bj][m][n], 0, 0, 0); __builtin_amdgcn_s_setprio(0); } while (0)
#define PG8_WAIT_V(n) asm volatile("s_waitcnt vmcnt(" #n ")" ::: "memory")
#define PG8_WAIT_L(n) asm volatile("s_waitcnt lgkmcnt(" #n ")" ::: "memory")
#define PG8_BAR __builtin_amdgcn_s_barrier()
#define PG8_SCHED __builtin_amdgcn_sched_barrier(0)
    Unit cur, nxt; int ui = 0;
    if (!S.next(0, cur)) return;
    f32x4 acc[2][2][4][2];
#pragma unroll
    for (int a = 0; a < 2; ++a)
#pragma unroll
        for (int b = 0; b < 2; ++b)
#pragma unroll
            for (int m = 0; m < 4; ++m)
#pragma unroll
                for (int n = 0; n < 2; ++n) acc[a][b][m][n] = (f32x4){0.f, 0.f, 0.f, 0.f};
    bf16x8 At[4][2], B0[2][2], B1[2][2];
    const char* cA = (const char*)g.A + (size_t)cur.pm * tstep + (size_t)cur.ks * K * 2; const char* cB = (const char*)g.Bt + (size_t)cur.pn * tstep + (size_t)cur.ks * K * 2;
    S.a_ready(cur);
    PG8_STAGE(PG8_SB(0, 0), cB, voffB); PG8_STAGE(PG8_SA(0, 0), cA, voffA); PG8_STAGE(PG8_SB(0, 1), cB + hstep, voffB); PG8_STAGE(PG8_SA(0, 1), cA + hstep, voffA);
    if (wr == 1) PG8_BAR;
    PG8_WAIT_V(4); PG8_BAR;
    PG8_STAGE(PG8_SB(1, 0), cB + kstep, voffB); PG8_STAGE(PG8_SA(1, 0), cA + kstep, voffA); PG8_STAGE(PG8_SB(1, 1), cB + hstep + kstep, voffB);
    PG8_WAIT_V(6); PG8_BAR;
    for (;;) {
        const bool has_next = S.next(ui + 1, nxt);
        const char* nA = has_next ? (const char*)g.A + (size_t)nxt.pm * tstep + (size_t)nxt.ks * K * 2 : cA; const char* nB = has_next ? (const char*)g.Bt + (size_t)nxt.pn * tstep + (size_t)nxt.ks * K * 2 : cB;
        for (int t = 0; t < nt; t += 2) {
            const bool last = (t == nt - 2);
            const char* a1 = cA + (size_t)(t + 1) * kstep;
            const char* a2 = last ? nA : cA + (size_t)(t + 2) * kstep; const char* b2 = last ? nB : cB + (size_t)(t + 2) * kstep;
            const char* a3 = a2 + kstep; const char* b3 = b2 + kstep;
            if (last && has_next) S.a_ready(nxt);
            PG8_LDB(B0, 0, 0); PG8_SCHED; PG8_LDA(At, 0, 0); PG8_STAGE(PG8_SA(1, 1), a1 + hstep, voffA);
            PG8_WAIT_L(8); PG8_BAR; PG8_WAIT_L(0); PG8_MMA(0, 0, At, B0); PG8_BAR; PG8_SCHED;
            PG8_LDB(B1, 0, 1); PG8_STAGE(PG8_SB(0, 0), b2, voffB);
            PG8_BAR; PG8_WAIT_L(0); PG8_MMA(0, 1, At, B1); PG8_BAR;
            PG8_LDA(At, 0, 1); PG8_STAGE(PG8_SA(0, 0), a2, voffA);
            PG8_BAR; PG8_WAIT_L(0); PG8_MMA(1, 0, At, B0); PG8_BAR; PG8_SCHED;
            PG8_STAGE(PG8_SB(0, 1), b2 + hstep, voffB);
            PG8_WAIT_V(6); PG8_BAR; PG8_MMA(1, 1, At, B1); PG8_BAR;
            PG8_LDB(B0, 1, 0); PG8_SCHED; PG8_LDA(At, 1, 0); PG8_STAGE(PG8_SA(0, 1), a2 + hstep, voffA);
            PG8_WAIT_L(8); PG8_BAR; PG8_WAIT_L(0); PG8_MMA(0, 0, At, B0); PG8_BAR; PG8_SCHED;
            PG8_LDB(B1, 1, 1); PG8_STAGE(PG8_SB(1, 0), b3, voffB);
            PG8_BAR; PG8_WAIT_L(0); PG8_MMA(0, 1, At, B1); PG8_BAR;
            PG8_LDA(At, 1, 1); PG8_STAGE(PG8_SA(1, 0), a3, voffA);
            PG8_BAR; PG8_WAIT_L(0); PG8_MMA(1, 0, At, B0); PG8_BAR; PG8_SCHED;
            PG8_STAGE(PG8_SB(1, 1), b3 + hstep, voffB);
            PG8_WAIT_V(6); PG8_BAR; PG8_MMA(1, 1, At, B1); PG8_BAR;
        }
        if constexpr (!Epi::AFTER_DRAIN) { E(acc, cur, wr, wc, fr, fq); S.done(cur); }
        if (!has_next) break;
#pragma unroll
        for (int a = 0; a < 2; ++a)
#pragma unroll
            for (int b = 0; b < 2; ++b)
#pragma unroll
                for (int m = 0; m < 4; ++m)
#pragma unroll
                    for (int n = 0; n < 2; ++n) acc[a][b][m][n] = (f32x4){0.f, 0.f, 0.f, 0.f};
        cur = nxt; cA = nA; cB = nB; ++ui;
    }
    PG8_WAIT_V(0);
    if (wr == 0) PG8_BAR;
    PG8_BAR;
    if constexpr (Epi::AFTER_DRAIN) { E.fused(acc, cur, wr, wc, fr, fq, lds, wid, lane); S.done(cur); }
#undef PG8_SA
#undef PG8_SB
#undef PG8_STAGE
#undef PG8_LDA
#undef PG8_LDB
#undef PG8_MMA
#undef PG8_WAIT_V
#undef PG8_WAIT_L
#undef PG8_BAR
#undef PG8_SCHED
}
}

using pg8::bf16_t; using pg8::bf16x8; using pg8::f32x4; using pg8::cvt_pk_bf16;
typedef float f32x16 __attribute__((ext_vector_type(16)));
typedef float f32x8 __attribute__((ext_vector_type(8)));
typedef unsigned u32x2 __attribute__((ext_vector_type(2)));
typedef unsigned u32x4 __attribute__((ext_vector_type(4)));

constexpr int DM = 2048, TPB = 2304, NTOK = 18432, LDP = 7424, MIXW = 3072, NCH = 18;
constexpr int C_LX = 0, C_LG = 1024, C_Q = 2048, C_K = 3072, C_V = 3328, C_AG = 3584, C_XBC = 4608, C_Z = 6144, C_DT = 7168;
constexpr size_t SZ_WTIN = (size_t)4 * 7424 * 2048 * 2, SZ_WTOUT = (size_t)4 * 2048 * 3072 * 2, SZ_MOD = (size_t)4 * 9 * 6144 * 4, SZ_U = (size_t)NTOK * 2048 * 2,
                 SZ_P = (size_t)NTOK * LDP * 2, SZ_MIX = (size_t)NTOK * MIXW * 2, SZ_XB = (size_t)NTOK * 2048 * 4, SZ_ST = (size_t)8 * 2 * 18 * 16 * 8192 * 2,
                 SZ_AL = (size_t)8 * 2 * 18 * 16 * 4, SZ_SUM = (size_t)8 * 2 * 18 * 1024 * 4;
constexpr size_t OFF_WTIN = 0, OFF_WTOUT = OFF_WTIN + SZ_WTIN, OFF_MOD = OFF_WTOUT + SZ_WTOUT, OFF_U = OFF_MOD + SZ_MOD, OFF_P = OFF_U + SZ_U, OFF_MIX = OFF_P + SZ_P,
                 OFF_XB = OFF_MIX + SZ_MIX, OFF_ST = OFF_XB + SZ_XB, OFF_AL = OFF_ST + SZ_ST, OFF_SUMA = OFF_AL + SZ_AL, OFF_SUMB = OFF_SUMA + SZ_SUM, OFF_BAR = OFF_SUMB + SZ_SUM, OFF_SBC = OFF_BAR + 32768, OFF_SBT = OFF_SBC + (size_t)NTOK * 512 * 2, OFF_DTA = OFF_SBT + (size_t)8 * 18 * 2 * 16384 * 2,
                 OFF_ACS = OFF_DTA + (size_t)NTOK * 32 * 4, OFF_HINL = OFF_ACS + (size_t)NTOK * 32 * 4, OFF_GW = OFF_HINL + SZ_SUM, OFF_DTP = OFF_GW + (size_t)4 * 16 * 16384 * 2, OFF_VT = OFF_DTP + (size_t)NTOK * 16 * 4, WS_END = OFF_VT + (size_t)8 * 18 * 2 * 16384 * 2;
constexpr size_t OFF_LXC = OFF_U, OFF_SXT = OFF_U + (size_t)NTOK * 1024 * 2;
constexpr int LDS_CTL = 147456;
constexpr int LDS_BYTES = LDS_CTL + 16;

struct Params {
    const float *x, *c, *ctx, *c_ctx, *norm_w, *ada_w, *ada_b, *w_in, *lru_conv_w, *lru_conv_b, *lru_ga_w, *lru_ga_b, *lru_gx_w, *lru_gx_b, *lru_lambda,
        *att_q_norm, *att_k_norm, *att_sink, *ssd_conv_w, *ssd_conv_b, *ssd_dt_bias, *ssd_A_log, *ssd_D, *ssd_norm_w, *w_out;
    float* out;
    unsigned char* ws;
};
#define WS_WTIN(p) ((bf16_t*)((p).ws + OFF_WTIN))
#define WS_WTOUT(p) ((bf16_t*)((p).ws + OFF_WTOUT))
#define WS_MOD(p) ((float*)((p).ws + OFF_MOD))
#define WS_U(p) ((bf16_t*)((p).ws + OFF_U))
#define WS_P(p) ((bf16_t*)((p).ws + OFF_P))
#define WS_MIX(p) ((bf16_t*)((p).ws + OFF_MIX))
#define WS_XB(p) ((float*)((p).ws + OFF_XB))
#define WS_ST(p) ((bf16_t*)((p).ws + OFF_ST))
#define WS_AL(p) ((float*)((p).ws + OFF_AL))
#define WS_SUMA(p) ((float*)((p).ws + OFF_SUMA))
#define WS_SUMB(p) ((float*)((p).ws + OFF_SUMB))
#define WS_LXC(p) ((bf16_t*)((p).ws + OFF_LXC))
#define WS_SXT(p) ((bf16_t*)((p).ws + OFF_SXT))
#define WS_SBC(p) ((bf16_t*)((p).ws + OFF_SBC))
#define WS_SBT(p) ((bf16_t*)((p).ws + OFF_SBT))
#define WS_DTA(p) ((float*)((p).ws + OFF_DTA))
#define WS_ACS(p) ((float*)((p).ws + OFF_ACS))
#define WS_HINL(p) ((float*)((p).ws + OFF_HINL))
#define WS_GW(p) ((bf16_t*)((p).ws + OFF_GW))
#define WS_DTP(p) ((float*)((p).ws + OFF_DTP))
#define WS_VT(p) ((bf16_t*)((p).ws + OFF_VT))

__device__ __forceinline__ float bf2f(bf16_t v) { return __uint_as_float(((unsigned)v) << 16); }
__device__ __forceinline__ bf16_t f2bf(float f) { return (bf16_t)(cvt_pk_bf16(f, 0.f) & 0xffffu); }
__device__ __forceinline__ float siluf(float v) { return v * __builtin_amdgcn_rcpf(1.f + __expf(-v)); }
__device__ __forceinline__ float sigmf(float v) { return __builtin_amdgcn_rcpf(1.f + __expf(-v)); }
__device__ __forceinline__ float softplusf(float v) { return v > 20.f ? v : log1pf(__expf(v)); }
__device__ __forceinline__ float wave_sum(float v) {
#pragma unroll
    for (int o = 1; o < 64; o <<= 1) v += __shfl_xor(v, o);
    return v;
}
__device__ __forceinline__ f32x8 unpack8(const u32x4 w) {
    f32x8 f;
    f[0] = __uint_as_float(w.x << 16); f[1] = __uint_as_float(w.x & 0xffff0000u); f[2] = __uint_as_float(w.y << 16); f[3] = __uint_as_float(w.y & 0xffff0000u);
    f[4] = __uint_as_float(w.z << 16); f[5] = __uint_as_float(w.z & 0xffff0000u); f[6] = __uint_as_float(w.w << 16); f[7] = __uint_as_float(w.w & 0xffff0000u);
    return f;
}
__device__ __forceinline__ u32x4 pack8(const f32x8 f) { u32x4 w; w.x = cvt_pk_bf16(f[0], f[1]); w.y = cvt_pk_bf16(f[2], f[3]); w.z = cvt_pk_bf16(f[4], f[5]); w.w = cvt_pk_bf16(f[6], f[7]); return w; }
__device__ __forceinline__ void lds_barrier() { asm volatile("s_waitcnt lgkmcnt(0)" ::: "memory"); __builtin_amdgcn_s_barrier(); asm volatile("" ::: "memory"); }
__device__ __forceinline__ float dpp_f(float v, int ctrl_sel) {
    const int x = __builtin_bit_cast(int, v); int r;
    if (ctrl_sel == 0) r = __builtin_amdgcn_update_dpp(x, x, 0xB1, 0xF, 0xF, false);
    else if (ctrl_sel == 1) r = __builtin_amdgcn_update_dpp(x, x, 0x4E, 0xF, 0xF, false);
    else if (ctrl_sel == 2) r = __builtin_amdgcn_update_dpp(x, x, 0x141, 0xF, 0xF, false);
    else r = __builtin_amdgcn_update_dpp(x, x, 0x140, 0xF, 0xF, false);
    return __builtin_bit_cast(float, r);
}
__device__ __forceinline__ float row16_max(float v) { v = fmaxf(v, dpp_f(v, 0)); v = fmaxf(v, dpp_f(v, 1)); v = fmaxf(v, dpp_f(v, 2)); v = fmaxf(v, dpp_f(v, 3)); return v; }
__device__ __forceinline__ float row16_sum(float v) { v += dpp_f(v, 0); v += dpp_f(v, 1); v += dpp_f(v, 2); v += dpp_f(v, 3); return v; }
__device__ __forceinline__ int chunk_at(int d, int pos) { return d == 0 ? pos : (pos < 2 ? 1 - pos : 19 - pos); }
__device__ __forceinline__ int pos_of(int d, int c) { return d == 0 ? c : (c < 2 ? 1 - c : 19 - c); }
__device__ __forceinline__ int rowmap32(int reg, int lane) { return (reg & 3) + 8 * (reg >> 2) + 4 * (lane >> 5); }

template <int K> __device__ __forceinline__ void mm32(f32x16& acc, const bf16_t* A, int lda, const bf16_t* B, int ldb, int lane) {
    const bf16_t* pa = A + (lane & 31) * lda + 8 * (lane >> 5);
    const bf16_t* pb = B + (lane & 31) * ldb + 8 * (lane >> 5);
#pragma unroll
    for (int k = 0; k < K; k += 16) {
        const bf16x8 a = *(const bf16x8*)(pa + k);
        const bf16x8 b = *(const bf16x8*)(pb + k);
        acc = __builtin_amdgcn_mfma_f32_32x32x16_bf16(a, b, acc, 0, 0, 0);
    }
}

template <int NC, bool SILU, bool TRANS>
__device__ __forceinline__ void stage_conv_tile(bf16_t* dst, int ld, const bf16_t* Pb, int t0, int col0, const float* cw, int CS, const float* cb, int tid) {
    constexpr int CG = NC / 8;
    const int lo = t0 < 256 ? 0 : 256, hi = t0 < 256 ? 256 : TPB;
    for (int idx = tid; idx < 128 * CG; idx += 512) {
        int cgi, tl;
        if (TRANS) { tl = idx & 127; cgi = idx >> 7; } else { cgi = idx % CG; tl = idx / CG; }
        const int t = t0 + tl;
        const f32x4 b0 = *(const f32x4*)(cb + cgi * 8), b1 = *(const f32x4*)(cb + cgi * 8 + 4);
        f32x8 acc; acc[0] = b0.x; acc[1] = b0.y; acc[2] = b0.z; acc[3] = b0.w; acc[4] = b1.x; acc[5] = b1.y; acc[6] = b1.z; acc[7] = b1.w;
#pragma unroll
        for (int k = 0; k < 4; ++k) {
            const int tt = t - 2 + k;
            if (tt >= lo && tt < hi) {
                const f32x8 v = unpack8(*(const u32x4*)(Pb + (size_t)tt * LDP + col0 + cgi * 8));
                const f32x4 w0 = *(const f32x4*)(cw + k * CS + cgi * 8), w1 = *(const f32x4*)(cw + k * CS + cgi * 8 + 4);
                acc[0] += w0.x * v[0]; acc[1] += w0.y * v[1]; acc[2] += w0.z * v[2]; acc[3] += w0.w * v[3];
                acc[4] += w1.x * v[4]; acc[5] += w1.y * v[5]; acc[6] += w1.z * v[6]; acc[7] += w1.w * v[7];
            }
        }
        if (SILU) {
#pragma unroll
            for (int e = 0; e < 8; ++e) acc[e] = siluf(acc[e]);
        }
        if (TRANS) {
#pragma unroll
            for (int e = 0; e < 8; ++e) dst[(cgi * 8 + e) * ld + tl] = f2bf(acc[e]);
        } else {
            *(u32x4*)(dst + tl * ld + cgi * 8) = pack8(acc);
        }
    }
}

__device__ __forceinline__ void transpose_item(const float* W, int K, int N, int nblk, bf16_t* WT, float* scr, int item, int lane) {
    const int kb = item / nblk, nb = item % nblk, k0 = 64 * kb, n0 = 32 * nb;
    const int c4 = lane & 7, r8 = lane >> 3, n = n0 + c4 * 4;
    f32x4 tv[8];
#pragma unroll
    for (int i = 0; i < 8; ++i) tv[i] = (n < N) ? *(const f32x4*)(W + (size_t)(k0 + i * 8 + r8) * N + n) : (f32x4){0.f, 0.f, 0.f, 0.f};
#pragma unroll
    for (int i = 0; i < 8; ++i) { float* d = scr + (i * 8 + r8) * 33 + c4 * 4; d[0] = tv[i].x; d[1] = tv[i].y; d[2] = tv[i].z; d[3] = tv[i].w; }
    asm volatile("s_waitcnt lgkmcnt(0)" ::: "memory");
    const int c = lane & 7;
#pragma unroll
    for (int j = 0; j < 4; ++j) {
        const int nn = (lane >> 3) + 8 * j; const float* s = scr + (8 * c) * 33 + nn;
        u32x4 o; o.x = cvt_pk_bf16(s[0 * 33], s[1 * 33]); o.y = cvt_pk_bf16(s[2 * 33], s[3 * 33]); o.z = cvt_pk_bf16(s[4 * 33], s[5 * 33]); o.w = cvt_pk_bf16(s[6 * 33], s[7 * 33]);
        *(u32x4*)(WT + (size_t)(n0 + nn) * K + k0 + 8 * c) = o;
    }
    asm volatile("s_waitcnt lgkmcnt(0)" ::: "memory");
}

__device__ __forceinline__ void phase0(const Params& p, unsigned char* shm, int G) {
    const int tid = tidx(), lane = tid & 63, wave = tid >> 6;
    float* sf = (float*)shm;
    float* MOD = WS_MOD(p);
    for (int item = blockIdx.x; item < 96; item += G) {
        const int l = item / 24, cgp = item % 24;
        __syncthreads();
        for (int idx = tid; idx < 9 * 2048; idx += 512) { const int r = idx >> 11, k = idx & 2047; const float v = r < 8 ? p.c[r * 2048 + k] : p.c_ctx[k]; sf[idx] = siluf(v); }
        __syncthreads();
        f32x4 acc[9];
#pragma unroll
        for (int r = 0; r < 9; ++r) acc[r] = (f32x4){0.f, 0.f, 0.f, 0.f};
        const float* wp = p.ada_w + ((size_t)l * 2048 + wave * 256) * 6144 + cgp * 256 + lane * 4;
#pragma unroll 16
        for (int kk = 0; kk < 256; ++kk) {
            const f32x4 wv = *(const f32x4*)(wp + (size_t)kk * 6144);
            const int k = wave * 256 + kk;
#pragma unroll
            for (int r = 0; r < 9; ++r) { const float s = sf[r * 2048 + k]; acc[r] += wv * s; }
        }
        __syncthreads();
#pragma unroll
        for (int r = 0; r < 9; ++r) *(f32x4*)(sf + (wave * 9 + r) * 256 + lane * 4) = acc[r];
        __syncthreads();
        for (int idx = tid; idx < 9 * 256; idx += 512) {
            const int r = idx >> 8, col = idx & 255; float s = p.ada_b[l * 6144 + cgp * 256 + col];
#pragma unroll
            for (int w = 0; w < 8; ++w) s += sf[(w * 9 + r) * 256 + col];
            MOD[(size_t)(l * 9 + r) * 6144 + cgp * 256 + col] = s;
        }
    }
    __syncthreads();
    float* scr = sf + wave * (64 * 33);
    const int gw = blockIdx.x * 8 + wave, NGW = G * 8;
    constexpr int I_IN = 32 * 232, I_OUT = 48 * 64;
    for (int it = gw; it < 4 * (I_IN + I_OUT); it += NGW) {
        if (it < 4 * I_IN) { const int l = it / I_IN, r = it % I_IN; transpose_item(p.w_in + (size_t)l * 2048 * 7184, 2048, 7184, 232, WS_WTIN(p) + (size_t)l * 7424 * 2048, scr, r, lane); }
        else { const int it2 = it - 4 * I_IN, l = it2 / I_OUT, r = it2 % I_OUT; transpose_item(p.w_out + (size_t)l * 3072 * 2048, 3072, 2048, 64, WS_WTOUT(p) + (size_t)l * 2048 * 3072, scr, r, lane); }
    }
    for (int idx = (int)blockIdx.x * 512 + tid; idx < 4 * 16 * 16384; idx += G * 512) {
        const int i = idx & 63, o = (idx >> 6) & 63, gate = (idx >> 12) & 1, d = (idx >> 13) & 1, j = (idx >> 14) & 15, l = idx >> 18;
        const float* w = gate ? p.lru_gx_w : p.lru_ga_w;
        WS_GW(p)[idx] = f2bf(w[(size_t)((l * 2 + d) * 16 + j) * 4096 + i * 64 + o]);
    }
}

__device__ __forceinline__ const float* xrow_src(const Params& p, int l, int row) {
    const int b = row / TPB, t = row % TPB;
    if (l == 0) return t < 256 ? p.ctx + ((size_t)b * 256 + t) * DM : p.x + ((size_t)b * 2048 + (t - 256)) * DM;
    return WS_XB(p) + (size_t)row * DM;
}
__device__ __forceinline__ void norm_phase(const Params& p, int l, int G) {
    const int lane = tidx() & 63, wave = tidx() >> 6;
    bf16_t* U = WS_U(p);
    const int gw = (int)blockIdx.x * 8 + wave, NW = G * 8;
    constexpr int R = 2;
#pragma unroll 1
    for (int base = gw; base < NTOK; base += NW * R) {
        f32x4 v[R][8];
#pragma unroll
        for (int u = 0; u < R; ++u) {
            const int row = base + u * NW;
            if (row < NTOK) {
                if (l >= 1 && row >= 16384) {
                    const float* xo = xrow_src(p, l - 1, row);
                    const float* gt = WS_MOD(p) + (size_t)((l - 1) * 9 + 7) * 6144 + 4096;
                    const float* pp = (const float*)WS_P(p) + (size_t)(row - 16384) * 2048;
                    float* xn = WS_XB(p) + (size_t)row * DM;
#pragma unroll
                    for (int j = 0; j < 8; ++j) {
                        const int col = 4 * lane + 256 * j;
                        const f32x4 s = (*(const f32x4*)(pp + col) + *(const f32x4*)(pp + (size_t)2048 * 2048 + col)) + (*(const f32x4*)(pp + (size_t)2 * 2048 * 2048 + col) + *(const f32x4*)(pp + (size_t)3 * 2048 * 2048 + col));
                        v[u][j] = *(const f32x4*)(xo + col) + *(const f32x4*)(gt + col) * s;
                        *(f32x4*)(xn + col) = v[u][j];
                    }
                } else {
                const float* src = xrow_src(p, l, row);
#pragma unroll
                for (int j = 0; j < 8; ++j) v[u][j] = *(const f32x4*)(src + 4 * lane + 256 * j);
                }
            }
        }
#pragma unroll
        for (int u = 0; u < R; ++u) {
            const int row = base + u * NW;
            if (row < NTOK) {
                const int b = row / TPB, t = row % TPB;
                const float* md = WS_MOD(p) + (size_t)(l * 9 + (t < 256 ? 8 : b)) * 6144;
                float ss = 0.f;
#pragma unroll
                for (int j = 0; j < 8; ++j) ss += v[u][j].x * v[u][j].x + v[u][j].y * v[u][j].y + v[u][j].z * v[u][j].z + v[u][j].w * v[u][j].w;
                ss = wave_sum(ss);
                const float rstd = rsqrtf(ss * (1.f / 2048.f) + 1e-6f);
#pragma unroll
                for (int j = 0; j < 8; ++j) {
                    const int col = 4 * lane + 256 * j;
                    const f32x4 nw = *(const f32x4*)(p.norm_w + l * 2048 + col), sh = *(const f32x4*)(md + col), sc = *(const f32x4*)(md + 2048 + col);
                    const f32x4 y = v[u][j] * rstd * nw * (sc + 1.f) + sh;
                    u32x2 w; w.x = cvt_pk_bf16(y.x, y.y); w.y = cvt_pk_bf16(y.z, y.w);
                    *(u32x2*)(U + (size_t)row * DM + col) = w;
                }
            }
        }
    }
}

struct EpiG1 {
    static constexpr bool PERM = true, AFTER_DRAIN = false;
    bf16_t* P;
    __device__ __forceinline__ void operator()(const f32x4 (&acc)[2][2][4][2], const pg8::Unit& u, int wr, int wc, int fr, int fq) const {
        const int row0 = u.pm * 256 + wr * 64 + fr, col0 = u.pn * 256 + wc * 32 + 8 * fq;
#pragma unroll
        for (int ai = 0; ai < 2; ++ai)
#pragma unroll
            for (int m = 0; m < 4; ++m) { bf16_t* rowp = P + (size_t)(row0 + ai * 128 + m * 16) * LDP + col0;
#pragma unroll
                for (int bj = 0; bj < 2; ++bj) { const f32x4 v0 = acc[ai][bj][m][0], v1 = acc[ai][bj][m][1];
                    u32x4 w; w.x = cvt_pk_bf16(v0.x, v0.y); w.y = cvt_pk_bf16(v0.z, v0.w); w.z = cvt_pk_bf16(v1.x, v1.y); w.w = cvt_pk_bf16(v1.z, v1.w);
                    *(u32x4*)(rowp + bj * 128) = w; } }
    }
};
struct EpiG2 {
    static constexpr bool PERM = true, AFTER_DRAIN = false;
    Params p; int l; int scr;
    __device__ __forceinline__ void operator()(const f32x4 (&acc)[2][2][4][2], const pg8::Unit& u, int wr, int wc, int fr, int fq) const {
        const int row0 = u.pm * 256 + wr * 64 + fr, col0 = u.pn * 256 + wc * 32 + 8 * fq;
#pragma unroll
        for (int ai = 0; ai < 2; ++ai)
#pragma unroll
            for (int m = 0; m < 4; ++m) {
                const int row = row0 + ai * 128 + m * 16, b = row / TPB, t = row % TPB;
                if (l == 3 && t < 256) continue;
                const float* xo = xrow_src(p, l, row);
                float* dst = scr ? (float*)WS_P(p) + (size_t)row * DM : (l == 3) ? p.out + ((size_t)b * 2048 + (t - 256)) * DM : WS_XB(p) + (size_t)row * DM;
                const float* gt = WS_MOD(p) + (size_t)(l * 9 + (t < 256 ? 8 : b)) * 6144 + 4096;
                f32x4 xv[4], gv[4];
#pragma unroll
                for (int q = 0; q < 4; ++q) { const int col = col0 + (q >> 1) * 128 + (q & 1) * 4; xv[q] = *(const f32x4*)(xo + col); gv[q] = *(const f32x4*)(gt + col); }
#pragma unroll
                for (int q = 0; q < 4; ++q) { const int col = col0 + (q >> 1) * 128 + (q & 1) * 4; *(f32x4*)(dst + col) = xv[q] + gv[q] * acc[ai][q >> 1][m][q & 1]; }
            }
    }
};

struct EpiPart {
    static constexpr bool PERM = true, AFTER_DRAIN = false;
    float* part;
    __device__ __forceinline__ void operator()(const f32x4 (&acc)[2][2][4][2], const pg8::Unit& u, int wr, int wc, int fr, int fq) const {
        const int row0 = (u.pm - 64) * 256 + wr * 64 + fr, col0 = u.pn * 256 + wc * 32 + 8 * fq;
        float* base = part + (size_t)u.ks * 2048 * 2048;
#pragma unroll
        for (int ai = 0; ai < 2; ++ai)
#pragma unroll
            for (int m = 0; m < 4; ++m) { float* rowp = base + (size_t)(row0 + ai * 128 + m * 16) * 2048 + col0;
#pragma unroll
                for (int bj = 0; bj < 2; ++bj) { *(f32x4*)(rowp + bj * 128) = acc[ai][bj][m][0]; *(f32x4*)(rowp + bj * 128 + 4) = acc[ai][bj][m][1]; } }
    }
};

template <int SCR>
__device__ __forceinline__ void qkprep_row(const Params& p, int l, int row, int lane) {
    const int t = row % TPB;
    bf16_t* rp = WS_P(p) + (size_t)row * LDP;
    float cs = 1.f, sn = 0.f;
    if (t >= 256) {
        const int s = t - 256, rr = s >> 6, cc = s & 63, f = lane & 31;
        const float inv = exp2f(-(float)f * (13.287712379549449f / 32.f));
        const float ang = (float)(lane < 32 ? rr : cc) * inv;
        cs = __cosf(ang); sn = __sinf(ang);
    }
    bf16_t r1[10], r2[10];
#pragma unroll
    for (int slot = 0; slot < 10; ++slot) { const int col = slot < 8 ? C_Q + slot * 128 : C_K + (slot - 8) * 128; r1[slot] = rp[col + lane]; r2[slot] = rp[col + 64 + lane]; }
#pragma unroll
    for (int slot = 0; slot < 10; ++slot) {
        const int col = slot < 8 ? C_Q + slot * 128 : C_K + (slot - 8) * 128;
        const float* w = slot < 8 ? p.att_q_norm + l * 128 : p.att_k_norm + l * 128;
        const float v1 = bf2f(r1[slot]), v2 = bf2f(r2[slot]);
        const float ss = wave_sum(v1 * v1 + v2 * v2);
        const float rstd = rsqrtf(ss * (1.f / 128.f) + 1e-6f);
        const float y1 = v1 * rstd * w[lane], y2 = v2 * rstd * w[64 + lane];
        float o1 = y1 * cs - y2 * sn, o2 = y1 * sn + y2 * cs;
        if (slot < 8) { o1 *= 0.08838834764831845f; o2 *= 0.08838834764831845f; }
        if (SCR) { bf16_t* sp = WS_ST(p) + (size_t)row * 1280 + slot * 128; sp[lane] = f2bf(o1); sp[64 + lane] = f2bf(o2); } else { rp[col + lane] = f2bf(o1); rp[col + 64 + lane] = f2bf(o2); }
    }
}

template <int D, int SCR = 0>
__device__ __forceinline__ void lru_sweep_item(const Params& p, int l, int item, unsigned char* shm) {
    const int tid = tidx(), lane = tid & 63, wave = tid >> 6, ch = tid & 63, seg = tid >> 6;
    const int j = item & 15, b = item >> 4;
    bf16_t* sX = (bf16_t*)shm; bf16_t* sW = (bf16_t*)(shm + 18432);
    float* sA = (float*)(shm + 36864); float* sB = (float*)(shm + 69632); float* sSA = (float*)(shm + 102400); float* sSB = (float*)(shm + 104448);
    bf16_t* sOut = (bf16_t*)(shm + 106496);
    const int mi = wave & 3, nj = wave >> 2, cl = nj * 32 + (lane & 31), cgl = j * 64 + cl;
    const float ba = p.lru_ga_b[(l * 2 + D) * 1024 + cgl], bx = p.lru_gx_b[(l * 2 + D) * 1024 + cgl], sp = softplusf(-p.lru_lambda[(l * 2 + D) * 1024 + cgl]);
    lds_barrier();
    {
        u32x4 wr2[2];
#pragma unroll
        for (int k = 0; k < 2; ++k) { const int idx = tid + k * 512; wr2[k] = *(const u32x4*)(WS_GW(p) + (size_t)(l * 16 + j) * 16384 + D * 8192 + idx * 8); }
#pragma unroll
        for (int k = 0; k < 2; ++k) { const int idx = tid + k * 512; *(u32x4*)(sW + (idx >> 3) * 72 + (idx & 7) * 8) = wr2[k]; }
    }
    u32x4 xr[2], lgr[2], hfr[2];
    {
        const size_t tok0 = (size_t)b * TPB + chunk_at(D, 0) * 128;
#pragma unroll
        for (int k = 0; k < 2; ++k) {
            const int idx = tid + k * 512;
            xr[k] = *(const u32x4*)(WS_LXC(p) + (tok0 + (idx >> 3)) * 1024 + j * 64 + (idx & 7) * 8);
            if (D == 1) { lgr[k] = *(const u32x4*)(WS_P(p) + (tok0 + (idx >> 3)) * LDP + C_LG + j * 64 + (idx & 7) * 8); hfr[k] = *(const u32x4*)(WS_MIX(p) + (tok0 + (idx >> 3)) * MIXW + j * 64 + (idx & 7) * 8); }
        }
    }
    float carry = 0.f;
#pragma unroll 1
    for (int pos = 0; pos < NCH; ++pos) {
        const size_t tok0 = (size_t)b * TPB + chunk_at(D, pos) * 128;
#pragma unroll
        for (int k = 0; k < 2; ++k) { const int idx = tid + k * 512; *(u32x4*)(sX + (idx >> 3) * 72 + (idx & 7) * 8) = xr[k]; }
        u32x4 lgc[2], hfc[2];
        if (D == 1) { lgc[0] = lgr[0]; lgc[1] = lgr[1]; hfc[0] = hfr[0]; hfc[1] = hfr[1]; }
        if (pos + 1 < NCH) {
            const size_t tokn = (size_t)b * TPB + chunk_at(D, pos + 1) * 128;
#pragma unroll
            for (int k = 0; k < 2; ++k) {
                const int idx = tid + k * 512;
                xr[k] = *(const u32x4*)(WS_LXC(p) + (tokn + (idx >> 3)) * 1024 + j * 64 + (idx & 7) * 8);
                if (D == 1) { lgr[k] = *(const u32x4*)(WS_P(p) + (tokn + (idx >> 3)) * LDP + C_LG + j * 64 + (idx & 7) * 8); hfr[k] = *(const u32x4*)(WS_MIX(p) + (tokn + (idx >> 3)) * MIXW + j * 64 + (idx & 7) * 8); }
            }
        }
        lds_barrier();
        {
            f32x16 ga, gx;
#pragma unroll
            for (int r = 0; r < 16; ++r) { ga[r] = 0.f; gx[r] = 0.f; }
            mm32<64>(ga, sX + mi * 32 * 72, 72, sW + (nj * 32) * 72, 72, lane);
            mm32<64>(gx, sX + mi * 32 * 72, 72, sW + (64 + nj * 32) * 72, 72, lane);
#pragma unroll
            for (int r = 0; r < 16; ++r) {
                const int tl = mi * 32 + rowmap32(r, lane);
                const float rg = sigmf(ga[r] + ba), ig = sigmf(gx[r] + bx);
                const float a = __expf(-8.f * rg * sp), mult = __builtin_amdgcn_sqrtf(fmaxf(1.f - a * a, 0.f));
                const float xv = bf2f(sX[tl * 72 + cl]);
                sA[tl * 64 + cl] = a; sB[tl * 64 + cl] = mult * ig * xv;
            }
        }
        lds_barrier();
        {
            float A = 1.f, Bc = 0.f;
#pragma unroll
            for (int q = 0; q < 16; ++q) { const int tl = seg * 16 + (D == 0 ? q : 15 - q); const float a = sA[tl * 64 + ch], bb = sB[tl * 64 + ch]; A = a * A; Bc = a * Bc + bb; }
            sSA[seg * 64 + ch] = A; sSB[seg * 64 + ch] = Bc;
        }
        lds_barrier();
        {
            float h = carry, cn = carry;
            const int myord = D == 0 ? seg : 7 - seg;
#pragma unroll
            for (int s = 0; s < 8; ++s) { const int sg = D == 0 ? s : 7 - s; const float a = sSA[sg * 64 + ch], bb = sSB[sg * 64 + ch]; cn = a * cn + bb; if (s < myord) h = cn; }
            carry = cn;
#pragma unroll
            for (int q = 0; q < 16; ++q) { const int tl = seg * 16 + (D == 0 ? q : 15 - q); h = sA[tl * 64 + ch] * h + sB[tl * 64 + ch]; sOut[tl * 72 + ch] = f2bf(h); }
        }
        lds_barrier();
#pragma unroll
        for (int k = 0; k < 2; ++k) {
            const int idx = tid + k * 512, rr = idx >> 3, ck = idx & 7;
            const u32x4 hv = *(const u32x4*)(sOut + rr * 72 + ck * 8);
            bf16_t* dst = SCR ? WS_P(p) + (tok0 + rr) * LDP + j * 64 + ck * 8 : WS_MIX(p) + (tok0 + rr) * MIXW + j * 64 + ck * 8;
            if (D == 0) *(u32x4*)dst = hv;
            else {
                const f32x8 a = unpack8(hv), f = unpack8(hfc[k]), g = unpack8(lgc[k]);
                f32x8 o;
#pragma unroll
                for (int e = 0; e < 8; ++e) o[e] = (a[e] + f[e]) * siluf(g[e]);
                *(u32x4*)dst = pack8(o);
            }
        }
    }
}

__device__ __forceinline__ void prep_elem(const Params& p, int l, int G) {
    const int gt = (int)blockIdx.x * 512 + tidx(), NT = G * 512;
    constexpr int NI = (NTOK / 4) * 192;
#pragma unroll 1
    for (int idx = gt; idx < NI; idx += NT) {
        const int tok = (idx / 192) * 4, cgi = idx % 192, b = tok / TPB, t = tok % TPB;
        const int lo = t < 256 ? 0 : 256, hi = t < 256 ? 256 : TPB;
        int col, CS, rs; const float *cw, *cb; bf16_t* dst; bool act;
        if (cgi < 128) { col = C_LX + cgi * 8; cw = p.lru_conv_w + l * 4096 + cgi * 8; CS = 1024; cb = p.lru_conv_b + l * 1024 + cgi * 8; act = false; dst = WS_LXC(p) + (size_t)tok * 1024 + cgi * 8; rs = 1024; }
        else { const int c2 = (cgi - 128) * 8; col = C_XBC + 1024 + c2; cw = p.ssd_conv_w + l * 6144 + 1024 + c2; CS = 1536; cb = p.ssd_conv_b + l * 1536 + 1024 + c2; act = true; dst = WS_SBC(p) + (size_t)tok * 512 + c2; rs = 512; }
        const bf16_t* src = WS_P(p) + (size_t)b * TPB * LDP + col;
        u32x4 raw[7];
#pragma unroll
        for (int r = 0; r < 7; ++r) { const int tt = t - 2 + r; raw[r] = (tt >= lo && tt < hi) ? *(const u32x4*)(src + (size_t)tt * LDP) : (u32x4){0u, 0u, 0u, 0u}; }
        const f32x4 b0 = *(const f32x4*)cb, b1 = *(const f32x4*)(cb + 4);
        f32x8 acc[4];
#pragma unroll
        for (int o = 0; o < 4; ++o) { acc[o][0] = b0.x; acc[o][1] = b0.y; acc[o][2] = b0.z; acc[o][3] = b0.w; acc[o][4] = b1.x; acc[o][5] = b1.y; acc[o][6] = b1.z; acc[o][7] = b1.w; }
#pragma unroll
        for (int k = 0; k < 4; ++k) {
            const f32x4 w0 = *(const f32x4*)(cw + k * CS), w1 = *(const f32x4*)(cw + k * CS + 4);
#pragma unroll
            for (int o = 0; o < 4; ++o) {
                const f32x8 v = unpack8(raw[o + k]);
                acc[o][0] += w0.x * v[0]; acc[o][1] += w0.y * v[1]; acc[o][2] += w0.z * v[2]; acc[o][3] += w0.w * v[3];
                acc[o][4] += w1.x * v[4]; acc[o][5] += w1.y * v[5]; acc[o][6] += w1.z * v[6]; acc[o][7] += w1.w * v[7];
            }
        }
#pragma unroll
        for (int o = 0; o < 4; ++o) {
            if (act) {
#pragma unroll
                for (int e = 0; e < 8; ++e) acc[o][e] = siluf(acc[o][e]);
            }
            *(u32x4*)(dst + (size_t)o * rs) = pack8(acc[o]);
        }
    }
}
struct PrepTile { int col0, ch0, t0, lo, hi, conv; const bf16_t* Pb; bf16_t* dst; };
__device__ __forceinline__ PrepTile prep_tile_decode(const Params& p, int item) {
    PrepTile T;
    const int t24 = item % 24, bc = item / 24, c = bc % NCH, b = bc / NCH;
    T.t0 = c * 128; T.Pb = WS_P(p) + (size_t)b * TPB * LDP; T.ch0 = 0; T.conv = t24 < 20;
    if (t24 < 16) { T.ch0 = t24 * 64; T.col0 = C_XBC + T.ch0; T.dst = WS_SXT(p) + ((size_t)((b * 18 + c) * 16 + t24)) * 8192; }
    else if (t24 < 20) { const int q = t24 - 16, g = q >> 1, nh = q & 1; T.ch0 = 1024 + g * 128 + nh * 64; T.col0 = C_XBC + T.ch0; T.dst = WS_SBT(p) + ((size_t)((b * 18 + c) * 2 + g)) * 16384 + (size_t)nh * 64 * 128; }
    else { const int q = t24 - 20, kh = q >> 1, dh = q & 1; T.col0 = C_V + kh * 128 + dh * 64; T.dst = WS_VT(p) + ((size_t)((b * 18 + c) * 2 + kh)) * 16384 + (size_t)dh * 64 * 128; }
    T.lo = T.t0 < 256 ? 0 : 256; T.hi = T.t0 < 256 ? 256 : TPB;
    return T;
}
__device__ __forceinline__ void prep_tile_load(const PrepTile& T, int tid, u32x4 (&raw)[2][4]) {
#pragma unroll
    for (int k = 0; k < 2; ++k) {
        const int idx = tid + k * 512, cgi = idx & 7, t = T.t0 + (idx >> 3);
#pragma unroll
        for (int q = 0; q < 4; ++q) {
            const int tt = T.conv ? t - 2 + q : t;
            const bool ok = T.conv ? (tt >= T.lo && tt < T.hi) : (q == 2);
            raw[k][q] = ok ? *(const u32x4*)(T.Pb + (size_t)tt * LDP + T.col0 + cgi * 8) : (u32x4){0u, 0u, 0u, 0u};
        }
    }
}
__device__ __forceinline__ void prep_tile_finish(const Params& p, int l, const PrepTile& T, int tid, const u32x4 (&raw)[2][4], unsigned char* shm) {
    bf16_t* sT = (bf16_t*)shm;
    const float* cw = p.ssd_conv_w + l * 6144 + T.ch0; const float* cb = p.ssd_conv_b + l * 1536 + T.ch0;
    lds_barrier();
#pragma unroll
    for (int k = 0; k < 2; ++k) {
        const int idx = tid + k * 512, cgi = idx & 7, tl = idx >> 3;
        f32x8 acc;
        if (T.conv) {
            const f32x4 b0 = *(const f32x4*)(cb + cgi * 8), b1 = *(const f32x4*)(cb + cgi * 8 + 4);
            acc[0] = b0.x; acc[1] = b0.y; acc[2] = b0.z; acc[3] = b0.w; acc[4] = b1.x; acc[5] = b1.y; acc[6] = b1.z; acc[7] = b1.w;
#pragma unroll
            for (int q = 0; q < 4; ++q) {
                const f32x8 v = unpack8(raw[k][q]);
                const f32x4 w0 = *(const f32x4*)(cw + q * 1536 + cgi * 8), w1 = *(const f32x4*)(cw + q * 1536 + cgi * 8 + 4);
                acc[0] += w0.x * v[0]; acc[1] += w0.y * v[1]; acc[2] += w0.z * v[2]; acc[3] += w0.w * v[3];
                acc[4] += w1.x * v[4]; acc[5] += w1.y * v[5]; acc[6] += w1.z * v[6]; acc[7] += w1.w * v[7];
            }
#pragma unroll
            for (int e = 0; e < 8; ++e) acc[e] = siluf(acc[e]);
        } else acc = unpack8(raw[k][2]);
#pragma unroll
        for (int e = 0; e < 8; ++e) sT[(cgi * 8 + e) * 130 + tl] = f2bf(acc[e]);
    }
    lds_barrier();
#pragma unroll
    for (int k = 0; k < 2; ++k) {
        const int idx = tid + k * 512, r = idx >> 4, ck = idx & 15;
        const unsigned* sp = (const unsigned*)(sT + r * 130 + ck * 8);
        u32x4 o; o.x = sp[0]; o.y = sp[1]; o.z = sp[2]; o.w = sp[3];
        *(u32x4*)(T.dst + r * 128 + ck * 8) = o;
    }
}
__device__ __forceinline__ void prep_tiles(const Params& p, int l, int bid, int G, unsigned char* shm) {
    const int tid = tidx();
    if (bid >= 3456) return;
    u32x4 raw[2][4], nraw[2][4];
    { const PrepTile T0 = prep_tile_decode(p, bid); prep_tile_load(T0, tid, raw); }
#pragma unroll 1
    for (int it = bid; it < 3456; it += G) {
        const bool more = it + G < 3456;
        if (more) { const PrepTile Tn = prep_tile_decode(p, it + G); prep_tile_load(Tn, tid, nraw); }
        { const PrepTile T = prep_tile_decode(p, it); prep_tile_finish(p, l, T, tid, raw, shm); }
        if (more) {
#pragma unroll
            for (int k = 0; k < 2; ++k)
#pragma unroll
                for (int q = 0; q < 4; ++q) raw[k][q] = nraw[k][q];
        }
    }
}
__device__ __forceinline__ void prep_dt_item(const Params& p, int l, int item) {
    const int tid = tidx();
    const int c = item % NCH, b = item / NCH;
    const int col32 = tid >> 4, h = col32 >> 1, d = col32 & 1, lane16 = tid & 15, seg = d == 0 ? lane16 : 15 - lane16;
    const float A = -__expf(p.ssd_A_log[(l * 2 + d) * 16 + h]), bias = p.ssd_dt_bias[(l * 2 + d) * 16 + h];
    const float* src = WS_DTP(p) + ((size_t)b * TPB + c * 128) * 16 + h;
    float dtv[8], cs[8], run = 0.f;
    float rawv[8];
#pragma unroll
    for (int q = 0; q < 8; ++q) { const int j = seg * 8 + (d == 0 ? q : 7 - q); rawv[q] = src[j * 16]; }
#pragma unroll
    for (int q = 0; q < 8; ++q) { dtv[q] = softplusf(rawv[q] + bias); run += dtv[q] * A; cs[q] = run; }
    float incl = run;
#pragma unroll
    for (int off = 1; off < 16; off <<= 1) { const float v = __shfl_up(incl, off, 16); if (lane16 >= off) incl += v; }
    const float excl = incl - run;
    float* dta = WS_DTA(p) + ((size_t)(b * 18 + c) * 128) * 32 + col32;
    float* acs = WS_ACS(p) + ((size_t)(b * 18 + c) * 128) * 32 + col32;
#pragma unroll
    for (int q = 0; q < 8; ++q) { const int j = seg * 8 + (d == 0 ? q : 7 - q); dta[j * 32] = dtv[q]; acs[j * 32] = cs[q] + excl; }
    if (lane16 == 15) WS_AL(p)[((b * 2 + d) * 18 + c) * 16 + h] = incl;
}
__device__ __forceinline__ void ssd_states_item(const Params& p, int l, int item, unsigned char* shm) {
    const int tid = tidx(), lane = tid & 63, wave = tid >> 6;
    const int g = item & 1, hh0 = ((item >> 1) & 1) * 4, bc = item >> 2, c = bc % NCH, b = bc / NCH;
    bf16_t* sBT = (bf16_t*)shm; bf16_t* sXw = (bf16_t*)(shm + 34816);
    float* sDt = (float*)(shm + 69632); float* sAcs = (float*)(shm + 77824); bf16_t* sO = (bf16_t*)(shm + 86016); float* sWg = (float*)(shm + 120832);
    const bf16_t* xt = WS_SXT(p) + ((size_t)((b * 18 + c) * 16 + g * 8)) * 8192;
    const bf16_t* btp = WS_SBT(p) + ((size_t)((b * 18 + c) * 2 + g)) * 16384;
    lds_barrier();
    {
        const size_t o = ((size_t)(b * 18 + c) * 128 + (tid >> 2)) * 32 + g * 16 + (tid & 3) * 4;
        const f32x4 vdt = *(const f32x4*)(WS_DTA(p) + o), vac = *(const f32x4*)(WS_ACS(p) + o);
        u32x4 bt[4];
#pragma unroll
        for (int k = 0; k < 4; ++k) { const int idx = tid + k * 512; bt[k] = *(const u32x4*)(btp + (idx >> 4) * 128 + (idx & 15) * 8); }
        *(f32x4*)(sDt + (tid >> 2) * 16 + (tid & 3) * 4) = vdt; *(f32x4*)(sAcs + (tid >> 2) * 16 + (tid & 3) * 4) = vac;
#pragma unroll
        for (int k = 0; k < 4; ++k) { const int idx = tid + k * 512; *(u32x4*)(sBT + (idx >> 4) * 136 + (idx & 15) * 8) = bt[k]; }
    }
    u32x4 xr[2];
#pragma unroll
    for (int k = 0; k < 2; ++k) { const int idx = tid + k * 512; xr[k] = *(const u32x4*)(xt + (size_t)hh0 * 8192 + (idx >> 4) * 128 + (idx & 15) * 8); }
    lds_barrier();
#pragma unroll
    for (int k = 0; k < 4; ++k) { const int idx = tid + k * 512, jj = idx >> 4, col = idx & 15; const float al = (col & 1) == 0 ? sAcs[127 * 16 + col] : sAcs[col]; sWg[col * 128 + jj] = __expf(al - sAcs[jj * 16 + col]) * sDt[jj * 16 + col]; }
#pragma unroll 1
    for (int hh = hh0; hh < hh0 + 4; ++hh) {
        const int h = g * 8 + hh;
        u32x4 xn[2] = {xr[0], xr[1]};
        if (hh < hh0 + 3) {
#pragma unroll
            for (int k = 0; k < 2; ++k) { const int idx = tid + k * 512; xn[k] = *(const u32x4*)(xt + (size_t)(hh + 1) * 8192 + (idx >> 4) * 128 + (idx & 15) * 8); }
        }
        lds_barrier();
#pragma unroll
        for (int k = 0; k < 2; ++k) {
            const int idx = tid + k * 512, pp = idx >> 4, j8 = (idx & 15) * 8;
            const f32x8 xv = unpack8(xr[k]);
#pragma unroll
            for (int d = 0; d < 2; ++d) {
                const f32x4 w0 = *(const f32x4*)(sWg + (hh * 2 + d) * 128 + j8), w1 = *(const f32x4*)(sWg + (hh * 2 + d) * 128 + j8 + 4);
                f32x8 o;
                o[0] = xv[0] * w0.x; o[1] = xv[1] * w0.y; o[2] = xv[2] * w0.z; o[3] = xv[3] * w0.w; o[4] = xv[4] * w1.x; o[5] = xv[5] * w1.y; o[6] = xv[6] * w1.z; o[7] = xv[7] * w1.w;
                *(u32x4*)(sXw + d * 8704 + pp * 136 + j8) = pack8(o);
            }
        }
        lds_barrier();
        const int mi = wave & 1, nj = wave >> 1;
#pragma unroll
        for (int d = 0; d < 2; ++d) {
            f32x16 acc;
#pragma unroll
            for (int r = 0; r < 16; ++r) acc[r] = 0.f;
            mm32<128>(acc, sXw + d * 8704 + mi * 32 * 136, 136, sBT + nj * 32 * 136, 136, lane);
#pragma unroll
            for (int r = 0; r < 16; ++r) sO[d * 8704 + (mi * 32 + rowmap32(r, lane)) * 136 + nj * 32 + (lane & 31)] = f2bf(acc[r]);
        }
        lds_barrier();
#pragma unroll
        for (int d = 0; d < 2; ++d) {
            bf16_t* base = WS_ST(p) + ((size_t)((b * 2 + d) * 18 + c) * 16 + h) * 8192;
#pragma unroll
            for (int k = 0; k < 2; ++k) { const int idx = tid + k * 512; *(u32x4*)(base + idx * 8) = *(const u32x4*)(sO + d * 8704 + (idx >> 4) * 136 + (idx & 15) * 8); }
        }
        xr[0] = xn[0]; xr[1] = xn[1];
    }
}
__device__ __forceinline__ void ssd_recur_item(const Params& p, int item) {
    const int tid = tidx();
    const int d = item & 1, h = (item >> 1) & 15, b = item >> 5;
    u32x4 s0[NCH], s1[NCH]; float ev[NCH];
#pragma unroll
    for (int pos = 0; pos < NCH; ++pos) {
        const int c = chunk_at(d, pos);
        const bf16_t* ptr = WS_ST(p) + ((size_t)((b * 2 + d) * 18 + c) * 16 + h) * 8192 + tid * 16;
        s0[pos] = *(const u32x4*)ptr; s1[pos] = *(const u32x4*)(ptr + 8);
        ev[pos] = WS_AL(p)[((b * 2 + d) * 18 + c) * 16 + h];
    }
    f32x8 h0, h1;
#pragma unroll
    for (int e = 0; e < 8; ++e) { h0[e] = 0.f; h1[e] = 0.f; }
#pragma unroll
    for (int pos = 0; pos < NCH; ++pos) {
        const int c = chunk_at(d, pos);
        bf16_t* ptr = WS_ST(p) + ((size_t)((b * 2 + d) * 18 + c) * 16 + h) * 8192 + tid * 16;
        *(u32x4*)ptr = pack8(h0); *(u32x4*)(ptr + 8) = pack8(h1);
        const float e = __expf(ev[pos]);
        h0 = h0 * e + unpack8(s0[pos]); h1 = h1 * e + unpack8(s1[pos]);
    }
}
template <int MODE>
__device__ __forceinline__ void ssd_final_item(const Params& p, int l, int item, unsigned char* shm) {
    const int tid = tidx(), lane = tid & 63, wave = tid >> 6;
    const int g = item & 1, hh0 = ((item >> 1) & 1) * 4, bc = item >> 2, c = bc % NCH, b = bc / NCH, t0 = c * 128;
    const size_t tok0 = (size_t)b * TPB + t0;
    bf16_t* sC = (bf16_t*)shm; bf16_t* sBW = (bf16_t*)(shm + 34816); bf16_t* sXT = (bf16_t*)(shm + 69632); bf16_t* sH = (bf16_t*)(shm + 87040);
    float* sDt = (float*)(shm + 104448); float* sAcs = (float*)(shm + 112640);
    bf16_t* sY = sBW;
    const bf16_t* xt = WS_SXT(p) + ((size_t)((b * 18 + c) * 16 + g * 8)) * 8192;
    const bf16_t* zt = WS_P(p) + tok0 * LDP + C_Z + g * 512;
    const bf16_t* hin0 = WS_ST(p) + ((size_t)((b * 2 + 0) * 18 + c) * 16 + g * 8) * 8192;
    const bf16_t* hin1 = WS_ST(p) + ((size_t)((b * 2 + 1) * 18 + c) * 16 + g * 8) * 8192;
    lds_barrier();
    u32x4 xr[2], zr[2], h0r[2];
    {
        const size_t o = ((size_t)(b * 18 + c) * 128 + (tid >> 2)) * 32 + g * 16 + (tid & 3) * 4;
        const f32x4 vdt = *(const f32x4*)(WS_DTA(p) + o), vac = *(const f32x4*)(WS_ACS(p) + o);
        u32x4 cr[4], br[4];
#pragma unroll
        for (int k = 0; k < 4; ++k) { const int idx = tid + k * 512; const bf16_t* s = WS_SBC(p) + (tok0 + (idx >> 4)) * 512 + g * 128 + (idx & 15) * 8; br[k] = *(const u32x4*)s; cr[k] = *(const u32x4*)(s + 256); }
#pragma unroll
        for (int k = 0; k < 2; ++k) {
            const int idx = tid + k * 512;
            xr[k] = *(const u32x4*)(xt + (size_t)hh0 * 8192 + (idx >> 4) * 128 + (idx & 15) * 8);
            zr[k] = *(const u32x4*)(zt + (size_t)(idx >> 3) * LDP + hh0 * 64 + (idx & 7) * 8);
            h0r[k] = *(const u32x4*)(hin0 + (size_t)hh0 * 8192 + idx * 8);
        }
        *(f32x4*)(sDt + (tid >> 2) * 16 + (tid & 3) * 4) = vdt; *(f32x4*)(sAcs + (tid >> 2) * 16 + (tid & 3) * 4) = vac;
#pragma unroll
        for (int k = 0; k < 4; ++k) { const int idx = tid + k * 512; *(u32x4*)(sC + (idx >> 4) * 136 + (idx & 15) * 8) = cr[k]; *(u32x4*)(sBW + (idx >> 4) * 136 + (idx & 15) * 8) = br[k]; }
    }
    lds_barrier();
    const int cmi = wave >> 1, cnj0 = (wave & 1) * 2;
    f32x16 cb0, cb1;
#pragma unroll
    for (int r = 0; r < 16; ++r) { cb0[r] = 0.f; cb1[r] = 0.f; }
    mm32<128>(cb0, sC + cmi * 32 * 136, 136, sBW + cnj0 * 32 * 136, 136, lane);
    mm32<128>(cb1, sC + cmi * 32 * 136, 136, sBW + (cnj0 + 1) * 32 * 136, 136, lane);
    const int ymi = wave & 3, ynj = wave >> 2;
#pragma unroll 1
    for (int hh = hh0; hh < hh0 + 4; ++hh) {
        const int h = g * 8 + hh;
        lds_barrier();
#pragma unroll
        for (int k = 0; k < 2; ++k) { const int idx = tid + k * 512; *(u32x4*)(sXT + (idx >> 4) * 136 + (idx & 15) * 8) = xr[k]; *(u32x4*)(sH + (idx >> 4) * 136 + (idx & 15) * 8) = h0r[k]; }
        u32x4 h1r[2];
#pragma unroll
        for (int k = 0; k < 2; ++k) h1r[k] = *(const u32x4*)(hin1 + (size_t)hh * 8192 + (tid + k * 512) * 8);
        f32x16 yacc;
        const int colf = hh * 2, colr = hh * 2 + 1;
        if (MODE < 2) {
            float acif[16], acir[16];
#pragma unroll
            for (int r = 0; r < 16; ++r) { const int ig = cmi * 32 + rowmap32(r, lane); acif[r] = sAcs[ig * 16 + colf]; acir[r] = sAcs[ig * 16 + colr]; }
#pragma unroll
            for (int tt = 0; tt < 2; ++tt) {
                const int jg = (cnj0 + tt) * 32 + (lane & 31);
                const float acjf = sAcs[jg * 16 + colf], dtjf = sDt[jg * 16 + colf], acjr = sAcs[jg * 16 + colr], dtjr = sDt[jg * 16 + colr];
                const int dj0 = jg - cmi * 32 - 4 * (lane >> 5);
#pragma unroll
                for (int r = 0; r < 16; ++r) {
                    const int sd = dj0 - ((r & 3) + 8 * (r >> 2));
                    const bool fwd = sd <= 0;
                    const float arg = fwd ? acif[r] - acjf : acir[r] - acjr, sc = fwd ? dtjf : dtjr;
                    const float cbv = tt == 0 ? cb0[r] : cb1[r];
                    float val = cbv * __expf(arg) * sc;
                    val += sd == 0 ? cbv * dtjr : 0.f;
                    sBW[(cmi * 32 + rowmap32(r, lane)) * 136 + jg] = f2bf(val);
                }
            }
        }
        lds_barrier();
        {
            f32x16 ad, ao;
#pragma unroll
            for (int r = 0; r < 16; ++r) { ad[r] = 0.f; ao[r] = 0.f; }
            if (MODE < 3) { mm32<128>(ad, sBW + ymi * 32 * 136, 136, sXT + ynj * 32 * 136, 136, lane);
            mm32<128>(ao, sC + ymi * 32 * 136, 136, sH + ynj * 32 * 136, 136, lane); }
#pragma unroll
            for (int r = 0; r < 16; ++r) { const int ig = ymi * 32 + rowmap32(r, lane); yacc[r] = ad[r] + __expf(sAcs[ig * 16 + colf]) * ao[r]; }
        }
        if (hh < hh0 + 3) {
#pragma unroll
            for (int k = 0; k < 2; ++k) {
                const int idx = tid + k * 512;
                xr[k] = *(const u32x4*)(xt + (size_t)(hh + 1) * 8192 + (idx >> 4) * 128 + (idx & 15) * 8);
                h0r[k] = *(const u32x4*)(hin0 + (size_t)(hh + 1) * 8192 + idx * 8);
            }
        }
        lds_barrier();
#pragma unroll
        for (int k = 0; k < 2; ++k) { const int idx = tid + k * 512; *(u32x4*)(sH + (idx >> 4) * 136 + (idx & 15) * 8) = h1r[k]; }
        lds_barrier();
        {
            f32x16 ao;
#pragma unroll
            for (int r = 0; r < 16; ++r) ao[r] = 0.f;
            if (MODE < 3) mm32<128>(ao, sC + ymi * 32 * 136, 136, sH + ynj * 32 * 136, 136, lane);
#pragma unroll
            for (int r = 0; r < 16; ++r) { const int ig = ymi * 32 + rowmap32(r, lane); yacc[r] += __expf(sAcs[ig * 16 + colr]) * ao[r]; }
        }
        const float Dh = p.ssd_D[l * 16 + h];
        const int pl = ynj * 32 + (lane & 31);
#pragma unroll
        for (int r = 0; r < 16; ++r) { const int ig = ymi * 32 + rowmap32(r, lane); yacc[r] += Dh * bf2f(sXT[pl * 136 + ig]); }
        lds_barrier();
#pragma unroll
        for (int r = 0; r < 16; ++r) { const int ig = ymi * 32 + rowmap32(r, lane); sY[ig * 72 + pl] = f2bf(yacc[r]); }
        lds_barrier();
#pragma unroll
        for (int k = 0; k < 2; ++k) {
            const int idx = tid + k * 512, rr = idx >> 3, pk = idx & 7;
            const f32x8 yv = unpack8(*(const u32x4*)(sY + rr * 72 + pk * 8)), zv = unpack8(zr[k]);
            f32x8 o;
#pragma unroll
            for (int e = 0; e < 8; ++e) o[e] = yv[e] * siluf(zv[e]);
            if (MODE < 1) *(u32x4*)(WS_MIX(p) + (tok0 + rr) * MIXW + 2048 + h * 64 + pk * 8) = pack8(o); else asm volatile("" :: "v"(o[0]), "v"(o[7]));
        }
        if (hh < hh0 + 3) {
#pragma unroll
            for (int k = 0; k < 2; ++k) { const int idx = tid + k * 512; zr[k] = *(const u32x4*)(zt + (size_t)(idx >> 3) * LDP + (hh + 1) * 64 + (idx & 7) * 8); }
        }
    }
}
__device__ __forceinline__ void ssd_norm_phase(const Params& p, int l, int G) {
    const int lane = tidx() & 63, wave = tidx() >> 6;
    for (int row = blockIdx.x * 8 + wave; row < NTOK; row += G * 8) {
        bf16_t* rp = WS_MIX(p) + (size_t)row * MIXW + 2048;
        f32x8 v0 = unpack8(*(const u32x4*)(rp + lane * 8)), v1 = unpack8(*(const u32x4*)(rp + 512 + lane * 8));
        float ss = 0.f;
#pragma unroll
        for (int e = 0; e < 8; ++e) ss += v0[e] * v0[e] + v1[e] * v1[e];
        ss = wave_sum(ss);
        const float rstd = rsqrtf(ss * (1.f / 1024.f) + 1e-6f);
        const float* nw = p.ssd_norm_w + l * 1024;
#pragma unroll
        for (int e = 0; e < 8; ++e) { v0[e] = v0[e] * rstd * nw[lane * 8 + e]; v1[e] = v1[e] * rstd * nw[512 + lane * 8 + e]; }
        *(u32x4*)(rp + lane * 8) = pack8(v0); *(u32x4*)(rp + 512 + lane * 8) = pack8(v1);
    }
}

template <int MODE>
__device__ __forceinline__ void attn_item(const Params& p, int l, int item, unsigned char* shm) {
    const int tid = tidx(), lane = tid & 63, wave = tid >> 6, fr = lane & 15, fq = lane >> 4;
    const int hp = item & 3, bq = item >> 2, qblk = bq % NCH, b = bq / NCH, kh = hp >> 1;
    const bf16_t* P = WS_P(p);
    bf16_t* sK = (bf16_t*)shm; bf16_t* sVT = (bf16_t*)(shm + 34816); bf16_t* sPw = (bf16_t*)(shm + 69632) + wave * (2 * 16 * 136);
    const size_t tokq0 = (size_t)b * TPB + qblk * 128;
    bf16x8 aq[2][4];
#pragma unroll
    for (int hd = 0; hd < 2; ++hd)
#pragma unroll
        for (int kk = 0; kk < 4; ++kk) aq[hd][kk] = *(const bf16x8*)(P + (tokq0 + wave * 16 + fr) * LDP + C_Q + (hp * 2 + hd) * 128 + kk * 32 + 8 * fq);
    float m[2][4], ls[2][4]; f32x4 O[2][8];
#pragma unroll
    for (int hd = 0; hd < 2; ++hd) {
        const float sink = p.att_sink[l * 8 + hp * 2 + hd];
#pragma unroll
        for (int r = 0; r < 4; ++r) { m[hd][r] = sink; ls[hd][r] = 1.f; }
#pragma unroll
        for (int nd = 0; nd < 8; ++nd) O[hd][nd] = (f32x4){0.f, 0.f, 0.f, 0.f};
    }
    const int nlat = qblk - 2;
    const int kb_lo = nlat - 1 < 0 ? 0 : nlat - 1, kb_hi = nlat + 1 > 15 ? 15 : nlat + 1;
    const int ntl = qblk < 2 ? 2 : 2 + (kb_hi - kb_lo + 1);
    u32x4 kr[4], vr[4];
    const bf16_t* vtb = WS_VT(p) + ((size_t)(b * 18) * 2 + kh) * 16384;
    {
        const bf16_t* kbase = P + ((size_t)b * TPB) * LDP + C_K + kh * 128;
#pragma unroll
        for (int k = 0; k < 4; ++k) { const int idx = tid + k * 512; kr[k] = *(const u32x4*)(kbase + (size_t)(idx >> 4) * LDP + (idx & 15) * 8); vr[k] = *(const u32x4*)(vtb + idx * 8); }
    }
#pragma unroll 1
    for (int ti = 0; ti < ntl; ++ti) {
        const bool masked = ti >= 2; const int kb = kb_lo + (ti - 2);
        lds_barrier();
#pragma unroll
        for (int k = 0; k < 4; ++k) {
            const int idx = tid + k * 512;
            *(u32x4*)(sK + (idx >> 4) * 136 + (idx & 15) * 8) = kr[k];
            *(u32x4*)(sVT + (idx >> 4) * 136 + (idx & 15) * 8) = vr[k];
        }
        if (ti + 1 < ntl) {
            const int tn = ti + 1, t0n = tn < 2 ? tn * 128 : 256 + (kb_lo + (tn - 2)) * 128;
            const bf16_t* kbase = P + ((size_t)b * TPB + t0n) * LDP + C_K + kh * 128;
            const bf16_t* vtn = vtb + (size_t)(t0n >> 7) * 32768;
#pragma unroll
            for (int k = 0; k < 4; ++k) { const int idx = tid + k * 512; kr[k] = *(const u32x4*)(kbase + (size_t)(idx >> 4) * LDP + (idx & 15) * 8); vr[k] = *(const u32x4*)(vtn + idx * 8); }
        }
        lds_barrier();
#pragma unroll 1
        for (int hf = 0; hf < 2; ++hf) {
            f32x4 s[2][4];
#pragma unroll
            for (int nt = 0; nt < 4; ++nt) {
                s[0][nt] = (f32x4){0.f, 0.f, 0.f, 0.f}; s[1][nt] = (f32x4){0.f, 0.f, 0.f, 0.f};
#pragma unroll
                for (int kk = 0; kk < 4; ++kk) {
                    const bf16x8 bk = *(const bf16x8*)(sK + ((hf * 4 + nt) * 16 + fr) * 136 + kk * 32 + 8 * fq);
                    s[0][nt] = __builtin_amdgcn_mfma_f32_16x16x32_bf16(aq[0][kk], bk, s[0][nt], 0, 0, 0);
                    s[1][nt] = __builtin_amdgcn_mfma_f32_16x16x32_bf16(aq[1][kk], bk, s[1][nt], 0, 0, 0);
                }
                __builtin_amdgcn_sched_barrier(0);
            }
            if (masked) {
#pragma unroll
                for (int nt = 0; nt < 4; ++nt)
#pragma unroll
                    for (int r = 0; r < 4; ++r) { const int rel = (nlat * 128 + wave * 16 + fq * 4 + r) - (kb * 128 + (hf * 4 + nt) * 16 + fr); if (rel > 128 || rel < -128) { s[0][nt][r] = -INFINITY; s[1][nt][r] = -INFINITY; } }
            }
#pragma unroll
            for (int hd = 0; hd < 2; ++hd) {
                float alpha[4];
#pragma unroll
                for (int r = 0; r < 4; ++r) {
                    float mx = fmaxf(fmaxf(s[hd][0][r], s[hd][1][r]), fmaxf(s[hd][2][r], s[hd][3][r]));
                    mx = row16_max(mx);
                    const float mn = fmaxf(m[hd][r], mx);
                    alpha[r] = __expf(m[hd][r] - mn); m[hd][r] = mn;
                    float rs = 0.f;
#pragma unroll
                    for (int nt = 0; nt < 4; ++nt) { const float pv = __expf(s[hd][nt][r] - mn); s[hd][nt][r] = pv; rs += pv; }
                    rs = row16_sum(rs);
                    ls[hd][r] = ls[hd][r] * alpha[r] + rs;
                }
#pragma unroll
                for (int nd = 0; nd < 8; ++nd) { O[hd][nd].x *= alpha[0]; O[hd][nd].y *= alpha[1]; O[hd][nd].z *= alpha[2]; O[hd][nd].w *= alpha[3]; }
#pragma unroll
                for (int nt = 0; nt < 4; ++nt)
#pragma unroll
                    for (int r = 0; r < 4; ++r) sPw[hd * (16 * 136) + (fq * 4 + r) * 136 + nt * 16 + fr] = f2bf(s[hd][nt][r]);
            }
            asm volatile("s_waitcnt lgkmcnt(0)" ::: "memory");
#pragma unroll
            for (int kk = 0; kk < 2; ++kk) {
                const bf16x8 ap0 = *(const bf16x8*)(sPw + fr * 136 + kk * 32 + 8 * fq);
                const bf16x8 ap1 = *(const bf16x8*)(sPw + 16 * 136 + fr * 136 + kk * 32 + 8 * fq);
#pragma unroll
                for (int nd = 0; nd < 8; ++nd) {
                    const bf16x8 bv = *(const bf16x8*)(sVT + (nd * 16 + fr) * 136 + hf * 64 + kk * 32 + 8 * fq);
                    O[0][nd] = __builtin_amdgcn_mfma_f32_16x16x32_bf16(ap0, bv, O[0][nd], 0, 0, 0);
                    O[1][nd] = __builtin_amdgcn_mfma_f32_16x16x32_bf16(ap1, bv, O[1][nd], 0, 0, 0);
                    if (nd == 3) __builtin_amdgcn_sched_barrier(0);
                }
                __builtin_amdgcn_sched_barrier(0);
            }
            asm volatile("s_waitcnt lgkmcnt(0)" ::: "memory");
        }
    }
#pragma unroll
    for (int hd = 0; hd < 2; ++hd) {
        const int hq = hp * 2 + hd;
        u32x4 agr[4];
#pragma unroll
        for (int k = 0; k < 4; ++k) { const int idx = tid + k * 512; agr[k] = *(const u32x4*)(P + (tokq0 + (idx >> 4)) * LDP + C_AG + hq * 128 + (idx & 15) * 8); }
        lds_barrier();
#pragma unroll
        for (int r = 0; r < 4; ++r) {
            const float il = __builtin_amdgcn_rcpf(ls[hd][r]);
#pragma unroll
            for (int nd = 0; nd < 8; ++nd) sK[(wave * 16 + fq * 4 + r) * 136 + nd * 16 + fr] = f2bf(O[hd][nd][r] * il);
        }
        lds_barrier();
#pragma unroll
        for (int k = 0; k < 4; ++k) {
            const int idx = tid + k * 512, rr = idx >> 4, ck = idx & 15;
            const f32x8 ov = unpack8(*(const u32x4*)(sK + rr * 136 + ck * 8)), gv = unpack8(agr[k]);
            f32x8 o;
#pragma unroll
            for (int e = 0; e < 8; ++e) o[e] = ov[e] * siluf(gv[e]);
            *(u32x4*)(WS_MIX(p) + (tokq0 + rr) * MIXW + 1024 + hq * 128 + ck * 8) = pack8(o);
        }
    }
}

#define XB_TMO      128
#define XB_XCNT(j)  (256  + 64 * (j))
#define XB_XSUB(j)  (1280 + 64 * (j))
#define XB_XGEN(j)  (2304 + 64 * (j))
#define XB_TOP      3328
#define XB_TOPGEN   3392
#define XCD_BAR_WORDS 3456
#define XB_SPIN_CAP (1u << 18)
#define LAS __attribute__((address_space(3)))
__device__ __forceinline__ unsigned xb_ld(unsigned* p)              { return __hip_atomic_load(p, __ATOMIC_RELAXED, __HIP_MEMORY_SCOPE_AGENT); }
__device__ __forceinline__ unsigned xb_add(unsigned* p, unsigned v) { return __hip_atomic_fetch_add(p, v, __ATOMIC_RELAXED, __HIP_MEMORY_SCOPE_AGENT); }
__device__ __forceinline__ unsigned xb_xcc_id() { return (unsigned)__builtin_amdgcn_s_getreg((3 << 11) | 20) & 0xFu; }
#define XB_SPIN(cond, bar) do { unsigned _sp = 0; while (cond) { __builtin_amdgcn_s_sleep(1); \
    if ((++_sp & 255u) == 0u) { if (xb_ld(&(bar)[XB_TMO])) break; if (_sp > XB_SPIN_CAP) { atomicAdd(&(bar)[XB_TMO], 1u); break; } } } } while (0)
struct XcdBarrier { unsigned* bar; unsigned x; volatile LAS unsigned* st; };
__device__ __forceinline__ XcdBarrier xcd_barrier_post(unsigned* bar, volatile LAS unsigned* st) {
    XcdBarrier b; b.bar = bar; b.x = xb_xcc_id(); b.st = st;
    if (tidx() == 0) (void)xb_add(&bar[XB_XCNT(b.x)], 1u);
    return b;
}
__device__ __forceinline__ void xcd_barrier_complete(unsigned* bar, unsigned x, unsigned& nloc, unsigned& nx) {
    const unsigned G = gridDim.x * gridDim.y * gridDim.z;
    unsigned sum, cnt, mine, sp = 0u;
    for (;;) {
        sum = 0u; cnt = 0u; mine = 0u;
#pragma unroll
        for (unsigned j = 0; j < 16; ++j) { const unsigned c = xb_ld(&bar[XB_XCNT(j)]); sum += c; cnt += (c > 0u) ? 1u : 0u; mine = (j == x) ? c : mine; }
        if (sum == G) break;
        __builtin_amdgcn_s_sleep(1);
        if ((++sp & 255u) == 0u) { if (xb_ld(&bar[XB_TMO])) break; if (sp > XB_SPIN_CAP) { atomicAdd(&bar[XB_TMO], 1u); break; } }
    }
    nloc = mine > 0u ? mine : 1u; nx = cnt > 0u ? cnt : 1u;
}
__device__ __forceinline__ void xcd_barrier(const XcdBarrier& b) {
    asm volatile("s_waitcnt vmcnt(0)" ::: "memory");
    __syncthreads();
    if (tidx() == 0) {
        unsigned* bar = b.bar;
        __builtin_amdgcn_s_waitcnt(0);
        unsigned nloc = b.st[0], nx = b.st[1];
        if (nloc == 0u) { xcd_barrier_complete(bar, b.x, nloc, nx); b.st[0] = nloc; b.st[1] = nx; }
        const unsigned old = xb_add(&bar[XB_XSUB(b.x)], 1u);
        const unsigned gen = old / nloc;
        if (old + 1u == (gen + 1u) * nloc) {
            __builtin_amdgcn_fence(__ATOMIC_RELEASE, "agent");
            asm volatile("s_waitcnt vmcnt(0)" ::: "memory");
            const unsigned og = xb_add(&bar[XB_TOP], 1u);
            const unsigned tg = og / nx;
            if (og + 1u == (tg + 1u) * nx) xb_add(&bar[XB_TOPGEN], 1u);
            else XB_SPIN(xb_ld(&bar[XB_TOPGEN]) == tg, bar);
            __builtin_amdgcn_fence(__ATOMIC_ACQUIRE, "agent");
            xb_add(&bar[XB_XGEN(b.x)], 1u);
            asm volatile("s_waitcnt vmcnt(0)" ::: "memory");
        } else {
            XB_SPIN(xb_ld(&bar[XB_XGEN(b.x)]) == gen, bar);
            __builtin_amdgcn_fence(__ATOMIC_ACQUIRE, "agent");
            asm volatile("s_waitcnt vmcnt(0)" ::: "memory");
        }
    }
    __syncthreads();
}


#define QUEUE_LOOP(ctr, NITEMS, BODY) do { \
    volatile LAS unsigned* _mb = (volatile LAS unsigned*)(shm + LDS_CTL + 8); \
    int it = bid; \
    while (it < (NITEMS)) { \
        unsigned _nx = 0u; if (tidx() == 0) _nx = xb_add((ctr), 1u) + (unsigned)G; \
        BODY; \
        __syncthreads(); \
        if (tidx() == 0) _mb[0] = _nx; \
        __syncthreads(); \
        it = (int)_mb[0]; \
    } } while (0)

__global__ __launch_bounds__(512) void mega(Params p) {
    extern __shared__ __attribute__((aligned(16))) unsigned char shm[];
    cg::grid_group grid = cg::this_grid();
    const int G = (int)gridDim.x, bid = (int)blockIdx.x;
    if (tidx() < 4) ((volatile LAS unsigned*)(shm + LDS_CTL))[tidx()] = 0u;
    __syncthreads();
    unsigned* qctr = (unsigned*)(p.ws + OFF_BAR) + 3584;
    const XcdBarrier xb = xcd_barrier_post((unsigned*)(p.ws + OFF_BAR), (volatile LAS unsigned*)(shm + LDS_CTL));
    for (int rep = 0; rep < 1 + DUP_P0; ++rep) phase0(p, shm, G);
    grid.sync();
#pragma unroll 1
    for (int l = 0; l < 4; ++l) {
        for (int rep = 0; rep < 1 + DUP_NORM; ++rep) norm_phase(p, l, G);
        xcd_barrier(xb);
        {
            pg8::Gemm g{WS_U(p), WS_WTIN(p) + (size_t)l * 7424 * 2048, NTOK, 7168, 2048, 2048};
            pg8::Order S; S.init(72, 28, G, bid, 0);
            EpiG1 E{WS_P(p)};
            for (int rep = 0; rep < 1 + DUP_G1; ++rep) pg8::gemm_phase<EpiG1, pg8::Order>((PG8_LAS unsigned char*)shm, g, S, E);
            {
                const int tq = tidx(), wave = tq >> 6, lane = tq & 63, fr = lane & 15, fq = lane >> 4;
                for (int wu = bid * 8 + wave; wu < NTOK / 16; wu += G * 8) {
                    const bf16_t* ap = WS_U(p) + (size_t)(wu * 16 + fr) * 2048 + 8 * fq;
                    const bf16_t* bp = WS_WTIN(p) + ((size_t)l * 7424 + 7168 + fr) * 2048 + 8 * fq;
                    f32x4 acc = (f32x4){0.f, 0.f, 0.f, 0.f};
#pragma unroll 8
                    for (int kk = 0; kk < 64; ++kk) { const bf16x8 a = *(const bf16x8*)(ap + kk * 32), bq = *(const bf16x8*)(bp + kk * 32); acc = __builtin_amdgcn_mfma_f32_16x16x32_bf16(a, bq, acc, 0, 0, 0); }
#pragma unroll
                    for (int r = 0; r < 4; ++r) WS_DTP(p)[(size_t)(wu * 16 + fq * 4 + r) * 16 + fr] = acc[r];
                }
            }
        }
        for (int rep = 0; rep < 1 + DUP_SYNC; ++rep) xcd_barrier(xb);
        for (int rep = 0; rep < 1 + DUP_E1; ++rep) {
            if (rep == 0 || E1SEL == 0 || E1SEL == 1) for (int it = bid; it < 144; it += G) prep_dt_item(p, l, it);
            if (rep == 0 || E1SEL == 0 || E1SEL == 2) { __syncthreads(); prep_tiles(p, l, bid, G, shm); }
            if (rep == 0 || E1SEL == 0 || E1SEL == 3) prep_elem(p, l, G);
        }
        { const int tq = tidx(), wave = tq >> 6, lane = tq & 63; for (int row = bid * 8 + wave; row < NTOK; row += G * 8) qkprep_row<0>(p, l, row, lane);
#if DUP_QK
          for (int row = bid * 8 + wave; row < NTOK; row += G * 8) qkprep_row<1>(p, l, row, lane);
#endif
        }
        xcd_barrier(xb);
        QUEUE_LOOP(qctr + (l * 3 + 0) * 64, 128 + 576, { if (it < 128) lru_sweep_item<0>(p, l, it, shm); else ssd_states_item(p, l, it - 128, shm); });
#if DUP_X1Q
        __syncthreads(); QUEUE_LOOP(qctr + (12 + l * 3 + 0) * 64, 128 + 576, { if (it < 128) lru_sweep_item<0>(p, l, it, shm); else ssd_states_item(p, l, it - 128, shm); });
#endif
#if DUP_SWEEP
        __syncthreads(); for (int it = bid; it < 128; it += G) lru_sweep_item<0>(p, l, it, shm);
#endif
#if DUP_STATES
        __syncthreads(); for (int it = bid; it < 256; it += G) ssd_states_item(p, l, it, shm);
#endif
        xcd_barrier(xb);
        QUEUE_LOOP(qctr + (l * 3 + 1) * 64, 576 + 256, { if (it < 576) attn_item<0>(p, l, it, shm); else ssd_recur_item(p, it - 576); });
#if DUP_ATTQ
        __syncthreads(); QUEUE_LOOP(qctr + (12 + l * 3 + 1) * 64, 576, { attn_item<AMODE>(p, l, it, shm); });
#endif
        xcd_barrier(xb);
        QUEUE_LOOP(qctr + (l * 3 + 2) * 64, 128 + 576, { if (it < 128) lru_sweep_item<1>(p, l, it, shm); else ssd_final_item<0>(p, l, it - 128, shm); });
#if DUP_FINAL
        __syncthreads(); for (int it = bid; it < 256; it += G) ssd_final_item<FMODE>(p, l, it, shm);
#endif
#if DUP_SWEEP1
        __syncthreads(); for (int it = bid; it < 128; it += G) lru_sweep_item<1, 1>(p, l, it, shm);
#endif
        xcd_barrier(xb);
#ifndef SK_X4
        ssd_norm_phase(p, l, G);
#endif
        xcd_barrier(xb);
        {
            pg8::Gemm g{WS_MIX(p), WS_WTOUT(p) + (size_t)l * 2048 * 3072, NTOK, 2048, 3072, 3072};
            pg8::Order S; S.init(64, 8, G, bid, l == 3 ? 1 : 0);
            EpiG2 E{p, l, 0};
#if DUP_G2
            { EpiG2 E2{p, l, 1}; pg8::gemm_phase<EpiG2, pg8::Order>((PG8_LAS unsigned char*)shm, g, S, E2); }
#endif
#ifndef SK_G2
            pg8::gemm_phase<EpiG2, pg8::Order>((PG8_LAS unsigned char*)shm, g, S, E);
#endif
        }
        if (l < 3) {
            pg8::Gemm gt{WS_MIX(p), WS_WTOUT(p) + (size_t)l * 2048 * 3072, NTOK, 2048, 768, 3072};
            pg8::TailOrder St{bid, G};
            EpiPart Et{(float*)WS_P(p)};
            pg8::gemm_phase<EpiPart, pg8::TailOrder>((PG8_LAS unsigned char*)shm, gt, St, Et);
            xcd_barrier(xb);
        }
    }
}

extern "C" void kernel_launch(void* const* d_in, const int* in_sizes, int n_in, void* d_out, int out_size, void* d_ws, size_t ws_size, hipStream_t stream) {
    static int grid = 0;
    if (grid == 0) {
        if (n_in != 25 || ws_size < WS_END) { fprintf(stderr, "kernel_launch: need 25 inputs and %zu bytes of workspace (got %d, %zu)\n", (size_t)WS_END, n_in, ws_size); grid = -1; return; }
        int dev = 0, cus = 0, per_cu = 0;
        hipGetDevice(&dev);
        hipDeviceGetAttribute(&cus, hipDeviceAttributeMultiprocessorCount, dev);
        if (hipFuncSetAttribute((const void*)mega, hipFuncAttributeMaxDynamicSharedMemorySize, LDS_BYTES) != hipSuccess) { fprintf(stderr, "kernel_launch: hipFuncSetAttribute failed\n"); grid = -1; return; }
        if (hipOccupancyMaxActiveBlocksPerMultiprocessor(&per_cu, (const void*)mega, 512, LDS_BYTES) != hipSuccess || per_cu < 1) { fprintf(stderr, "kernel_launch: occupancy query gave %d\n", per_cu); per_cu = 1; }
        (void)hipGetLastError();
        grid = cus * 1;
        if (grid <= 0) grid = 256;
    }
    if (grid < 0) return;
    Params p{};
    const float** pf = (const float**)&p;
    for (int i = 0; i < 25; ++i) pf[i] = (const float*)d_in[i];
    p.out = (float*)d_out; p.ws = (unsigned char*)d_ws;
    if (hipMemsetAsync((char*)d_ws + OFF_BAR, 0, 32768, stream) != hipSuccess) { fprintf(stderr, "kernel_launch: memset of barrier words failed\n"); return; }
    void* args[] = {&p};
    hipError_t e = hipLaunchCooperativeKernel((const void*)mega, dim3(grid), dim3(512), args, LDS_BYTES, stream);
    if (e != hipSuccess) fprintf(stderr, "cooperative launch failed: %s (grid %d)\n", hipGetErrorString(e), grid);
}
```

```cpp
#include <hip/hip_runtime.h>
#include <hip/hip_cooperative_groups.h>
#include <cstdio>
#include <cstdint>
namespace cg = cooperative_groups;
#define DUP_X1A 0
#define DUP_X1B 0
#define DUP_ATT 0
#define DUP_X3A 0
#define DUP_X3B 0
#define DUP_G1 0
#define DUP_P0 0
#define DUP_NORM 0
#define DUP_SYNC 0
#define DUP_E1 0
#define DUP_SWEEP1 0
#define DUP_G2 0
#define DUP_QK 0
#define E1SEL 0
#define DUP_SWEEP 0
#define DUP_STATES 0
#define DUP_FINAL 0
#define AMODE 0
#define FMODE 0
#define DUP_X1Q 0
#define DUP_ATTQ 0
#define DUP_X3Q 0

__device__ __forceinline__ int tidx() { int t = (int)threadIdx.x; asm volatile("" : "+v"(t)); return t; }

namespace pg8 {
#define PG8_LAS __attribute__((address_space(3)))
typedef unsigned short bf16_t;
typedef short bf16x8 __attribute__((ext_vector_type(8)));
typedef float f32x4 __attribute__((ext_vector_type(4)));
typedef unsigned u32x4 __attribute__((ext_vector_type(4)));
constexpr int BM = 256, BK = 64, HALF = 128, HTB = HALF * BK * 2  , STAGE_BYTES = 8 * HTB, NXCD = 8, WGM = 8;

__host__ __device__ __forceinline__ int lds_byte(int r, int c) { const int st = (r >> 4) * 2 + (c >> 5), rr = r & 15, cc = c & 31, ob = rr * 64 + cc * 2; return st * 1024 + (ob ^ (((ob >> 9) & 1) << 5)); }
__host__ __device__ __forceinline__ void stage_rc(int b, int& R, int& C) { const int st = b / 1024, sb = b % 1024, swz = sb ^ (((sb >> 9) & 1) << 5); R = (st >> 1) * 16 + swz / 64; C = (st & 1) * 32 + (swz % 64) / 2; }
__host__ __device__ __forceinline__ int perm32(int rho) { const int n = rho >> 4, i = rho & 15; return 8 * (i >> 2) + 4 * n + (i & 3); }

struct Unit { int pm, pn, ks; };
struct Gemm { const bf16_t* A; const bf16_t* Bt; int M, N, K, ld; };

struct Order {
    int nM, nN, nwg, G, c, skipctx;
    __device__ void init(int nM_, int nN_, int G_, int c_, int skip_) { nM = nM_; nN = nN_; nwg = nM * nN; G = G_; c = c_; skipctx = skip_; }
    __device__ bool next(int i, Unit& u) const {
        const long L = (long)i * G + c; if (L >= nwg) return false;
        int wgid = (int)L; { const int q = nwg / NXCD, r = nwg % NXCD, xcd = wgid % NXCD, off = wgid / NXCD; wgid = (xcd < r ? xcd * (q + 1) : r * (q + 1) + (xcd - r) * q) + off; }
        const int nig = WGM * nN, gid = wgid / nig, fm = gid * WGM, gsz = (nM - fm) < WGM ? (nM - fm) : WGM;
        int pm = fm + ((wgid % nig) % gsz); u.pn = (wgid % nig) / gsz;
        if (skipctx) pm = (pm >> 3) * 9 + 1 + (pm & 7);
        u.pm = pm; u.ks = 0; return true;
    }
    __device__ __forceinline__ void a_ready(const Unit&) const {}
    __device__ __forceinline__ void done(const Unit&) const {}
};
typedef __bf16 bf16x2_t __attribute__((ext_vector_type(2)));
typedef float f32x2_t __attribute__((ext_vector_type(2)));
struct TailOrder {
    int c, G;
    __device__ bool next(int i, Unit& u) const { const int L = i * G + c; if (L >= 256) return false; u.pm = 64 + (L >> 5); u.pn = (L >> 2) & 7; u.ks = L & 3; return true; }
    __device__ __forceinline__ void a_ready(const Unit&) const {}
    __device__ __forceinline__ void done(const Unit&) const {}
};
__device__ __forceinline__ unsigned cvt_pk_bf16(float lo, float hi) { f32x2_t v = {lo, hi}; bf16x2_t b = __builtin_convertvector(v, bf16x2_t); return __builtin_bit_cast(unsigned, b); }

template <class Epi, class Sched>
__device__ __forceinline__ void gemm_phase(PG8_LAS unsigned char* lds, const Gemm g, const Sched& S, const Epi& E) {
    const int tid = tidx(), wid = __builtin_amdgcn_readfirstlane(tid >> 6), lane = tid & 63, wr = wid >> 2, wc = wid & 3, fr = lane & 15, fq = lane >> 4;
    const int K = g.K, LD = g.ld, nt = K / BK;
    unsigned voffA[2], voffB[2];
#pragma unroll
    for (int i = 0; i < 2; ++i) { int R, C; stage_rc(tid * 16 + i * 8192, R, C); const int Rb = Epi::PERM ? ((R & ~31) + perm32(R & 31)) : R;
        voffA[i] = (unsigned)(R * LD + C) * 2u; voffB[i] = (unsigned)(Rb * LD + C) * 2u; }
    const size_t kstep = (size_t)(BK * 2);
    const size_t hstep = (size_t)HALF * LD * 2;
    const size_t tstep = 2 * hstep;
    const unsigned ldsw = (unsigned)wid * 1024u;
    const int aoff = lds_byte(wr * 64 + fr, fq * 8), boff = lds_byte(wc * 32 + fr, fq * 8);
#define PG8_SA(b, h) (((b) * 2 + (h)) * HTB)
#define PG8_SB(b, h) ((4 + (b) * 2 + (h)) * HTB)
#define PG8_STAGE(bufoff, gbase, voff) do { _Pragma("unroll") for (int _i = 0; _i < 2; ++_i) \
        __builtin_amdgcn_global_load_lds((const unsigned*)((const char*)(gbase) + (voff)[_i]), (PG8_LAS unsigned*)(lds + (bufoff) + ldsw + _i * 8192), 16, 0, 0); } while (0)
#define PG8_LDA(dst, b, h) do { _Pragma("unroll") for (int m = 0; m < 4; ++m) _Pragma("unroll") for (int k = 0; k < 2; ++k) dst[m][k] = *(const PG8_LAS bf16x8*)(lds + PG8_SA(b, h) + aoff + m * 2048 + k * 1024); } while (0)
#define PG8_LDB(dst, b, h) do { _Pragma("unroll") for (int n = 0; n < 2; ++n) _Pragma("unroll") for (int k = 0; k < 2; ++k) dst[n][k] = *(const PG8_LAS bf16x8*)(lds + PG8_SB(b, h) + boff + n * 2048 + k * 1024); } while (0)
#define PG8_MMA(ai, bj, At, Bt) do { __builtin_amdgcn_s_setprio(1); _Pragma("unroll") for (int m = 0; m < 4; ++m) _Pragma("unroll") for (int n = 0; n < 2; ++n) _Pragma("unroll") for (int k = 0; k < 2; ++k) \
        acc[ai][bj][m][n] = __builtin_amdgcn_mfma_f32_16x16x32_bf16(Bt[n][k], At[m][k], acc[ai][bj][m][n], 0, 0, 0); __builtin_amdgcn_s_setprio(0); } while (0)
#define PG8_WAIT_V(n) asm volatile("s_waitcnt vmcnt(" #n ")" ::: "memory")
#define PG8_WAIT_L(n) asm volatile("s_waitcnt lgkmcnt(" #n ")" ::: "memory")
#define PG8_BAR __builtin_amdgcn_s_barrier()
#define PG8_SCHED __builtin_amdgcn_sched_barrier(0)
    Unit cur, nxt; int ui = 0;
    if (!S.next(0, cur)) return;
    f32x4 acc[2][2][4][2];
#pragma unroll
    for (int a = 0; a < 2; ++a)
#pragma unroll
        for (int b = 0; b < 2; ++b)
#pragma unroll
            for (int m = 0; m < 4; ++m)
#pragma unroll
                for (int n = 0; n < 2; ++n) acc[a][b][m][n] = (f32x4){0.f, 0.f, 0.f, 0.f};
    bf16x8 At[4][2], B0[2][2], B1[2][2];
    const char* cA = (const char*)g.A + (size_t)cur.pm * tstep + (size_t)cur.ks * K * 2; const char* cB = (const char*)g.Bt + (size_t)cur.pn * tstep + (size_t)cur.ks * K * 2;
    S.a_ready(cur);
    PG8_STAGE(PG8_SB(0, 0), cB, voffB); PG8_STAGE(PG8_SA(0, 0), cA, voffA); PG8_STAGE(PG8_SB(0, 1), cB + hstep, voffB); PG8_STAGE(PG8_SA(0, 1), cA + hstep, voffA);
    if (wr == 1) PG8_BAR;
    PG8_WAIT_V(4); PG8_BAR;
    PG8_STAGE(PG8_SB(1, 0), cB + kstep, voffB); PG8_STAGE(PG8_SA(1, 0), cA + kstep, voffA); PG8_STAGE(PG8_SB(1, 1), cB + hstep + kstep, voffB);
    PG8_WAIT_V(6); PG8_BAR;
    for (;;) {
        const bool has_next = S.next(ui + 1, nxt);
        const char* nA = has_next ? (const char*)g.A + (size_t)nxt.pm * tstep + (size_t)nxt.ks * K * 2 : cA; const char* nB = has_next ? (const char*)g.Bt + (size_t)nxt.pn * tstep + (size_t)nxt.ks * K * 2 : cB;
        for (int t = 0; t < nt; t += 2) {
            const bool last = (t == nt - 2);
            const char* a1 = cA + (size_t)(t + 1) * kstep;
            const char* a2 = last ? nA : cA + (size_t)(t + 2) * kstep; const char* b2 = last ? nB : cB + (size_t)(t + 2) * kstep;
            const char* a3 = a2 + kstep; const char* b3 = b2 + kstep;
            if (last && has_next) S.a_ready(nxt);
            PG8_LDB(B0, 0, 0); PG8_SCHED; PG8_LDA(At, 0, 0); PG8_STAGE(PG8_SA(1, 1), a1 + hstep, voffA);
            PG8_WAIT_L(8); PG8_BAR; PG8_WAIT_L(0); PG8_MMA(0, 0, At, B0); PG8_BAR; PG8_SCHED;
            PG8_LDB(B1, 0, 1); PG8_STAGE(PG8_SB(0, 0), b2, voffB);
            PG8_BAR; PG8_WAIT_L(0); PG8_MMA(0, 1, At, B1); PG8_BAR;
            PG8_LDA(At, 0, 1); PG8_STAGE(PG8_SA(0, 0), a2, voffA);
            PG8_BAR; PG8_WAIT_L(0); PG8_MMA(1, 0, At, B0); PG8_BAR; PG8_SCHED;
            PG8_STAGE(PG8_SB(0, 1), b2 + hstep, voffB);
            PG8_WAIT_V(6); PG8_BAR; PG8_MMA(1, 1, At, B1); PG8_BAR;
            PG8_LDB(B0, 1, 0); PG8_SCHED; PG8_LDA(At, 1, 0); PG8_STAGE(PG8_SA(0, 1), a2 + hstep, voffA);
            PG8_WAIT_L(8); PG8_BAR; PG8_WAIT_L(0); PG8_MMA(0, 0, At, B0); PG8_BAR; PG8_SCHED;
            PG8_LDB(B1, 1, 1); PG8_STAGE(PG8_SB(1, 0), b3, voffB);
            PG8_BAR; PG8_WAIT_L(0); PG8_MMA(0, 1, At, B1); PG8_BAR;
            PG8_LDA(At, 1, 1); PG8_STAGE(PG8_SA(1, 0), a3, voffA);
            PG8_BAR; PG8_WAIT_L(0); PG8_MMA(1, 0, At, B0); PG8_BAR; PG8_SCHED;
            PG8_STAGE(PG8_SB(1, 1), b3 + hstep, voffB);
            PG8_WAIT_V(6); PG8_BAR; PG8_MMA(1, 1, At, B1); PG8_BAR;
        }
        if constexpr (!Epi::AFTER_DRAIN) { E(acc, cur, wr, wc, fr, fq); S.done(cur); }
        if (!has_next) break;
#pragma unroll
        for (int a = 0; a < 2; ++a)
#pragma unroll
            for (int b = 0; b < 2; ++b)
#pragma unroll
                for (int m = 0; m < 4; ++m)
#pragma unroll
                    for (int n = 0; n < 2; ++n) acc[a][b][m][n] = (f32x4){0.f, 0.f, 0.f, 0.f};
        cur = nxt; cA = nA; cB = nB; ++ui;
    }
    PG8_WAIT_V(0);
    if (wr == 0) PG8_BAR;
    PG8_BAR;
    if constexpr (Epi::AFTER_DRAIN) { E.fused(acc, cur, wr, wc, fr, fq, lds, wid, lane); S.done(cur); }
#undef PG8_SA
#undef PG8_SB
#undef PG8_STAGE
#undef PG8_LDA
#undef PG8_LDB
#undef PG8_MMA
#undef PG8_WAIT_V
#undef PG8_WAIT_L
#undef PG8_BAR
#undef PG8_SCHED
}
}

using pg8::bf16_t; using pg8::bf16x8; using pg8::f32x4; using pg8::cvt_pk_bf16;
typedef float f32x16 __attribute__((ext_vector_type(16)));
typedef float f32x8 __attribute__((ext_vector_type(8)));
typedef unsigned u32x2 __attribute__((ext_vector_type(2)));
typedef unsigned u32x4 __attribute__((ext_vector_type(4)));

constexpr int DM = 2048, TPB = 2304, NTOK = 18432, LDP = 7424, MIXW = 3072, NCH = 18;
constexpr int C_LX = 0, C_LG = 1024, C_Q = 2048, C_K = 3072, C_V = 3328, C_AG = 3584, C_XBC = 4608, C_Z = 6144, C_DT = 7168;
constexpr size_t SZ_WTIN = (size_t)4 * 7424 * 2048 * 2, SZ_WTOUT = (size_t)4 * 2048 * 3072 * 2, SZ_MOD = (size_t)4 * 9 * 6144 * 4, SZ_U = (size_t)NTOK * 2048 * 2,
                 SZ_P = (size_t)NTOK * LDP * 2, SZ_MIX = (size_t)NTOK * MIXW * 2, SZ_XB = (size_t)NTOK * 2048 * 4, SZ_ST = (size_t)8 * 2 * 18 * 16 * 8192 * 2,
                 SZ_AL = (size_t)8 * 2 * 18 * 16 * 4, SZ_SUM = (size_t)8 * 2 * 18 * 1024 * 4;
constexpr size_t OFF_WTIN = 0, OFF_WTOUT = OFF_WTIN + SZ_WTIN, OFF_MOD = OFF_WTOUT + SZ_WTOUT, OFF_U = OFF_MOD + SZ_MOD, OFF_P = OFF_U + SZ_U, OFF_MIX = OFF_P + SZ_P,
                 OFF_XB = OFF_MIX + SZ_MIX, OFF_ST = OFF_XB + SZ_XB, OFF_AL = OFF_ST + SZ_ST, OFF_SUMA = OFF_AL + SZ_AL, OFF_SUMB = OFF_SUMA + SZ_SUM, OFF_BAR = OFF_SUMB + SZ_SUM, OFF_SBC = OFF_BAR + 32768, OFF_SBT = OFF_SBC + (size_t)NTOK * 512 * 2, OFF_DTA = OFF_SBT + (size_t)8 * 18 * 2 * 16384 * 2,
                 OFF_ACS = OFF_DTA + (size_t)NTOK * 32 * 4, OFF_HINL = OFF_ACS + (size_t)NTOK * 32 * 4, OFF_GW = OFF_HINL + SZ_SUM, OFF_DTP = OFF_GW + (size_t)4 * 16 * 16384 * 2, OFF_VT = OFF_DTP + (size_t)NTOK * 16 * 4, WS_END = OFF_VT + (size_t)8 * 18 * 2 * 16384 * 2;
constexpr size_t OFF_LXC = OFF_U, OFF_SXT = OFF_U + (size_t)NTOK * 1024 * 2;
constexpr int LDS_CTL = 147456;
constexpr int LDS_BYTES = LDS_CTL + 16;

struct Params {
    const float *x, *c, *ctx, *c_ctx, *norm_w, *ada_w, *ada_b, *w_in, *lru_conv_w, *lru_conv_b, *lru_ga_w, *lru_ga_b, *lru_gx_w, *lru_gx_b, *lru_lambda,
        *att_q_norm, *att_k_norm, *att_sink, *ssd_conv_w, *ssd_conv_b, *ssd_dt_bias, *ssd_A_log, *ssd_D, *ssd_norm_w, *w_out;
    float* out;
    unsigned char* ws;
};
#define WS_WTIN(p) ((bf16_t*)((p).ws + OFF_WTIN))
#define WS_WTOUT(p) ((bf16_t*)((p).ws + OFF_WTOUT))
#define WS_MOD(p) ((float*)((p).ws + OFF_MOD))
#define WS_U(p) ((bf16_t*)((p).ws + OFF_U))
#define WS_P(p) ((bf16_t*)((p).ws + OFF_P))
#define WS_MIX(p) ((bf16_t*)((p).ws + OFF_MIX))
#define WS_XB(p) ((float*)((p).ws + OFF_XB))
#define WS_ST(p) ((bf16_t*)((p).ws + OFF_ST))
#define WS_AL(p) ((float*)((p).ws + OFF_AL))
#define WS_SUMA(p) ((float*)((p).ws + OFF_SUMA))
#define WS_SUMB(p) ((float*)((p).ws + OFF_SUMB))
#define WS_LXC(p) ((bf16_t*)((p).ws + OFF_LXC))
#define WS_SXT(p) ((bf16_t*)((p).ws + OFF_SXT))
#define WS_SBC(p) ((bf16_t*)((p).ws + OFF_SBC))
#define WS_SBT(p) ((bf16_t*)((p).ws + OFF_SBT))
#define WS_DTA(p) ((float*)((p).ws + OFF_DTA))
#define WS_ACS(p) ((float*)((p).ws + OFF_ACS))
#define WS_HINL(p) ((float*)((p).ws + OFF_HINL))
#define WS_GW(p) ((bf16_t*)((p).ws + OFF_GW))
#define WS_DTP(p) ((float*)((p).ws + OFF_DTP))
#define WS_VT(p) ((bf16_t*)((p).ws + OFF_VT))

__device__ __forceinline__ float bf2f(bf16_t v) { return __uint_as_float(((unsigned)v) << 16); }
__device__ __forceinline__ bf16_t f2bf(float f) { return (bf16_t)(cvt_pk_bf16(f, 0.f) & 0xffffu); }
__device__ __forceinline__ float siluf(float v) { return v * __builtin_amdgcn_rcpf(1.f + __expf(-v)); }
__device__ __forceinline__ float sigmf(float v) { return __builtin_amdgcn_rcpf(1.f + __expf(-v)); }
__device__ __forceinline__ float softplusf(float v) { return v > 20.f ? v : log1pf(__expf(v)); }
__device__ __forceinline__ float wave_sum(float v) {
#pragma unroll
    for (int o = 1; o < 64; o <<= 1) v += __shfl_xor(v, o);
    return v;
}
__device__ __forceinline__ f32x8 unpack8(const u32x4 w) {
    f32x8 f;
    f[0] = __uint_as_float(w.x << 16); f[1] = __uint_as_float(w.x & 0xffff0000u); f[2] = __uint_as_float(w.y << 16); f[3] = __uint_as_float(w.y & 0xffff0000u);
    f[4] = __uint_as_float(w.z << 16); f[5] = __uint_as_float(w.z & 0xffff0000u); f[6] = __uint_as_float(w.w << 16); f[7] = __uint_as_float(w.w & 0xffff0000u);
    return f;
}
__device__ __forceinline__ u32x4 pack8(const f32x8 f) { u32x4 w; w.x = cvt_pk_bf16(f[0], f[1]); w.y = cvt_pk_bf16(f[2], f[3]); w.z = cvt_pk_bf16(f[4], f[5]); w.w = cvt_pk_bf16(f[6], f[7]); return w; }
__device__ __forceinline__ void lds_barrier() { asm volatile("s_waitcnt lgkmcnt(0)" ::: "memory"); __builtin_amdgcn_s_barrier(); asm volatile("" ::: "memory"); }
__device__ __forceinline__ float dpp_f(float v, int ctrl_sel) {
    const int x = __builtin_bit_cast(int, v); int r;
    if (ctrl_sel == 0) r = __builtin_amdgcn_update_dpp(x, x, 0xB1, 0xF, 0xF, false);
    else if (ctrl_sel == 1) r = __builtin_amdgcn_update_dpp(x, x, 0x4E, 0xF, 0xF, false);
    else if (ctrl_sel == 2) r = __builtin_amdgcn_update_dpp(x, x, 0x141, 0xF, 0xF, false);
    else r = __builtin_amdgcn_update_dpp(x, x, 0x140, 0xF, 0xF, false);
    return __builtin_bit_cast(float, r);
}
__device__ __forceinline__ float row16_max(float v) { v = fmaxf(v, dpp_f(v, 0)); v = fmaxf(v, dpp_f(v, 1)); v = fmaxf(v, dpp_f(v, 2)); v = fmaxf(v, dpp_f(v, 3)); return v; }
__device__ __forceinline__ float row16_sum(float v) { v += dpp_f(v, 0); v += dpp_f(v, 1); v += dpp_f(v, 2); v += dpp_f(v, 3); return v; }
__device__ __forceinline__ int chunk_at(int d, int pos) { return d == 0 ? pos : (pos < 2 ? 1 - pos : 19 - pos); }
__device__ __forceinline__ int pos_of(int d, int c) { return d == 0 ? c : (c < 2 ? 1 - c : 19 - c); }
__device__ __forceinline__ int rowmap32(int reg, int lane) { return (reg & 3) + 8 * (reg >> 2) + 4 * (lane >> 5); }

template <int K> __device__ __forceinline__ void mm32(f32x16& acc, const bf16_t* A, int lda, const bf16_t* B, int ldb, int lane) {
    const bf16_t* pa = A + (lane & 31) * lda + 8 * (lane >> 5);
    const bf16_t* pb = B + (lane & 31) * ldb + 8 * (lane >> 5);
#pragma unroll
    for (int k = 0; k < K; k += 16) {
        const bf16x8 a = *(const bf16x8*)(pa + k);
        const bf16x8 b = *(const bf16x8*)(pb + k);
        acc = __builtin_amdgcn_mfma_f32_32x32x16_bf16(a, b, acc, 0, 0, 0);
    }
}

template <int NC, bool SILU, bool TRANS>
__device__ __forceinline__ void stage_conv_tile(bf16_t* dst, int ld, const bf16_t* Pb, int t0, int col0, const float* cw, int CS, const float* cb, int tid) {
    constexpr int CG = NC / 8;
    const int lo = t0 < 256 ? 0 : 256, hi = t0 < 256 ? 256 : TPB;
    for (int idx = tid; idx < 128 * CG; idx += 512) {
        int cgi, tl;
        if (TRANS) { tl = idx & 127; cgi = idx >> 7; } else { cgi = idx % CG; tl = idx / CG; }
        const int t = t0 + tl;
        const f32x4 b0 = *(const f32x4*)(cb + cgi * 8), b1 = *(const f32x4*)(cb + cgi * 8 + 4);
        f32x8 acc; acc[0] = b0.x; acc[1] = b0.y; acc[2] = b0.z; acc[3] = b0.w; acc[4] = b1.x; acc[5] = b1.y; acc[6] = b1.z; acc[7] = b1.w;
#pragma unroll
        for (int k = 0; k < 4; ++k) {
            const int tt = t - 2 + k;
            if (tt >= lo && tt < hi) {
                const f32x8 v = unpack8(*(const u32x4*)(Pb + (size_t)tt * LDP + col0 + cgi * 8));
                const f32x4 w0 = *(const f32x4*)(cw + k * CS + cgi * 8), w1 = *(const f32x4*)(cw + k * CS + cgi * 8 + 4);
                acc[0] += w0.x * v[0]; acc[1] += w0.y * v[1]; acc[2] += w0.z * v[2]; acc[3] += w0.w * v[3];
                acc[4] += w1.x * v[4]; acc[5] += w1.y * v[5]; acc[6] += w1.z * v[6]; acc[7] += w1.w * v[7];
            }
        }
        if (SILU) {
#pragma unroll
            for (int e = 0; e < 8; ++e) acc[e] = siluf(acc[e]);
        }
        if (TRANS) {
#pragma unroll
            for (int e = 0; e < 8; ++e) dst[(cgi * 8 + e) * ld + tl] = f2bf(acc[e]);
        } else {
            *(u32x4*)(dst + tl * ld + cgi * 8) = pack8(acc);
        }
    }
}

__device__ __forceinline__ void transpose_item(const float* W, int K, int N, int nblk, bf16_t* WT, float* scr, int item, int lane) {
    const int kb = item / nblk, nb = item % nblk, k0 = 64 * kb, n0 = 32 * nb;
    const int c4 = lane & 7, r8 = lane >> 3, n = n0 + c4 * 4;
    f32x4 tv[8];
#pragma unroll
    for (int i = 0; i < 8; ++i) tv[i] = (n < N) ? *(const f32x4*)(W + (size_t)(k0 + i * 8 + r8) * N + n) : (f32x4){0.f, 0.f, 0.f, 0.f};
#pragma unroll
    for (int i = 0; i < 8; ++i) { float* d = scr + (i * 8 + r8) * 33 + c4 * 4; d[0] = tv[i].x; d[1] = tv[i].y; d[2] = tv[i].z; d[3] = tv[i].w; }
    asm volatile("s_waitcnt lgkmcnt(0)" ::: "memory");
    const int c = lane & 7;
#pragma unroll
    for (int j = 0; j < 4; ++j) {
        const int nn = (lane >> 3) + 8 * j; const float* s = scr + (8 * c) * 33 + nn;
        u32x4 o; o.x = cvt_pk_bf16(s[0 * 33], s[1 * 33]); o.y = cvt_pk_bf16(s[2 * 33], s[3 * 33]); o.z = cvt_pk_bf16(s[4 * 33], s[5 * 33]); o.w = cvt_pk_bf16(s[6 * 33], s[7 * 33]);
        *(u32x4*)(WT + (size_t)(n0 + nn) * K + k0 + 8 * c) = o;
    }
    asm volatile("s_waitcnt lgkmcnt(0)" ::: "memory");
}

__device__ __forceinline__ void phase0(const Params& p, unsigned char* shm, int G) {
    const int tid = tidx(), lane = tid & 63, wave = tid >> 6;
    float* sf = (float*)shm;
    float* MOD = WS_MOD(p);
    for (int item = blockIdx.x; item < 96; item += G) {
        const int l = item / 24, cgp = item % 24;
        __syncthreads();
        for (int idx = tid; idx < 9 * 2048; idx += 512) { const int r = idx >> 11, k = idx & 2047; const float v = r < 8 ? p.c[r * 2048 + k] : p.c_ctx[k]; sf[idx] = siluf(v); }
        __syncthreads();
        f32x4 acc[9];
#pragma unroll
        for (int r = 0; r < 9; ++r) acc[r] = (f32x4){0.f, 0.f, 0.f, 0.f};
        const float* wp = p.ada_w + ((size_t)l * 2048 + wave * 256) * 6144 + cgp * 256 + lane * 4;
#pragma unroll 16
        for (int kk = 0; kk < 256; ++kk) {
            const f32x4 wv = *(const f32x4*)(wp + (size_t)kk * 6144);
            const int k = wave * 256 + kk;
#pragma unroll
            for (int r = 0; r < 9; ++r) { const float s = sf[r * 2048 + k]; acc[r] += wv * s; }
        }
        __syncthreads();
#pragma unroll
        for (int r = 0; r < 9; ++r) *(f32x4*)(sf + (wave * 9 + r) * 256 + lane * 4) = acc[r];
        __syncthreads();
        for (int idx = tid; idx < 9 * 256; idx += 512) {
            const int r = idx >> 8, col = idx & 255; float s = p.ada_b[l * 6144 + cgp * 256 + col];
#pragma unroll
            for (int w = 0; w < 8; ++w) s += sf[(w * 9 + r) * 256 + col];
            MOD[(size_t)(l * 9 + r) * 6144 + cgp * 256 + col] = s;
        }
    }
    __syncthreads();
    float* scr = sf + wave * (64 * 33);
    const int gw = blockIdx.x * 8 + wave, NGW = G * 8;
    constexpr int I_IN = 32 * 232, I_OUT = 48 * 64;
    for (int it = gw; it < 4 * (I_IN + I_OUT); it += NGW) {
        if (it < 4 * I_IN) { const int l = it / I_IN, r = it % I_IN; transpose_item(p.w_in + (size_t)l * 2048 * 7184, 2048, 7184, 232, WS_WTIN(p) + (size_t)l * 7424 * 2048, scr, r, lane); }
        else { const int it2 = it - 4 * I_IN, l = it2 / I_OUT, r = it2 % I_OUT; transpose_item(p.w_out + (size_t)l * 3072 * 2048, 3072, 2048, 64, WS_WTOUT(p) + (size_t)l * 2048 * 3072, scr, r, lane); }
    }
    for (int idx = (int)blockIdx.x * 512 + tid; idx < 4 * 16 * 16384; idx += G * 512) {
        const int i = idx & 63, o = (idx >> 6) & 63, gate = (idx >> 12) & 1, d = (idx >> 13) & 1, j = (idx >> 14) & 15, l = idx >> 18;
        const float* w = gate ? p.lru_gx_w : p.lru_ga_w;
        WS_GW(p)[idx] = f2bf(w[(size_t)((l * 2 + d) * 16 + j) * 4096 + i * 64 + o]);
    }
}

__device__ __forceinline__ const float* xrow_src(const Params& p, int l, int row) {
    const int b = row / TPB, t = row % TPB;
    if (l == 0) return t < 256 ? p.ctx + ((size_t)b * 256 + t) * DM : p.x + ((size_t)b * 2048 + (t - 256)) * DM;
    return WS_XB(p) + (size_t)row * DM;
}
__device__ __forceinline__ void norm_phase(const Params& p, int l, int G) {
    const int lane = tidx() & 63, wave = tidx() >> 6;
    bf16_t* U = WS_U(p);
    const int gw = (int)blockIdx.x * 8 + wave, NW = G * 8;
    constexpr int R = 2;
#pragma unroll 1
    for (int base = gw; base < NTOK; base += NW * R) {
        f32x4 v[R][8];
#pragma unroll
        for (int u = 0; u < R; ++u) {
            const int row = base + u * NW;
            if (row < NTOK) {
                if (l >= 1 && row >= 16384) {
                    const float* xo = xrow_src(p, l - 1, row);
                    const float* gt = WS_MOD(p) + (size_t)((l - 1) * 9 + 7) * 6144 + 4096;
                    const float* pp = (const float*)WS_P(p) + (size_t)(row - 16384) * 2048;
                    float* xn = WS_XB(p) + (size_t)row * DM;
#pragma unroll
                    for (int j = 0; j < 8; ++j) {
                        const int col = 4 * lane + 256 * j;
                        const f32x4 s = (*(const f32x4*)(pp + col) + *(const f32x4*)(pp + (size_t)2048 * 2048 + col)) + (*(const f32x4*)(pp + (size_t)2 * 2048 * 2048 + col) + *(const f32x4*)(pp + (size_t)3 * 2048 * 2048 + col));
                        v[u][j] = *(const f32x4*)(xo + col) + *(const f32x4*)(gt + col) * s;
                        *(f32x4*)(xn + col) = v[u][j];
                    }
                } else {
                const float* src = xrow_src(p, l, row);
#pragma unroll
                for (int j = 0; j < 8; ++j) v[u][j] = *(const f32x4*)(src + 4 * lane + 256 * j);
                }
            }
        }
#pragma unroll
        for (int u = 0; u < R; ++u) {
            const int row = base + u * NW;
            if (row < NTOK) {
                const int b = row / TPB, t = row % TPB;
                const float* md = WS_MOD(p) + (size_t)(l * 9 + (t < 256 ? 8 : b)) * 6144;
                float ss = 0.f;
#pragma unroll
                for (int j = 0; j < 8; ++j) ss += v[u][j].x * v[u][j].x + v[u][j].y * v[u][j].y + v[u][j].z * v[u][j].z + v[u][j].w * v[u][j].w;
                ss = wave_sum(ss);
                const float rstd = rsqrtf(ss * (1.f / 2048.f) + 1e-6f);
#pragma unroll
                for (int j = 0; j < 8; ++j) {
                    const int col = 4 * lane + 256 * j;
                    const f32x4 nw = *(const f32x4*)(p.norm_w + l * 2048 + col), sh = *(const f32x4*)(md + col), sc = *(const f32x4*)(md + 2048 + col);
                    const f32x4 y = v[u][j] * rstd * nw * (sc + 1.f) + sh;
                    u32x2 w; w.x = cvt_pk_bf16(y.x, y.y); w.y = cvt_pk_bf16(y.z, y.w);
                    *(u32x2*)(U + (size_t)row * DM + col) = w;
                }
            }
        }
    }
}

struct EpiG1 {
    static constexpr bool PERM = true, AFTER_DRAIN = false;
    bf16_t* P;
    __device__ __forceinline__ void operator()(const f32x4 (&acc)[2][2][4][2], const pg8::Unit& u, int wr, int wc, int fr, int fq) const {
        const int row0 = u.pm * 256 + wr * 64 + fr, col0 = u.pn * 256 + wc * 32 + 8 * fq;
#pragma unroll
        for (int ai = 0; ai < 2; ++ai)
#pragma unroll
            for (int m = 0; m < 4; ++m) { bf16_t* rowp = P + (size_t)(row0 + ai * 128 + m * 16) * LDP + col0;
#pragma unroll
                for (int bj = 0; bj < 2; ++bj) { const f32x4 v0 = acc[ai][bj][m][0], v1 = acc[ai][bj][m][1];
                    u32x4 w; w.x = cvt_pk_bf16(v0.x, v0.y); w.y = cvt_pk_bf16(v0.z, v0.w); w.z = cvt_pk_bf16(v1.x, v1.y); w.w = cvt_pk_bf16(v1.z, v1.w);
                    *(u32x4*)(rowp + bj * 128) = w; } }
    }
};
struct EpiG2 {
    static constexpr bool PERM = true, AFTER_DRAIN = false;
    Params p; int l; int scr;
    __device__ __forceinline__ void operator()(const f32x4 (&acc)[2][2][4][2], const pg8::Unit& u, int wr, int wc, int fr, int fq) const {
        const int row0 = u.pm * 256 + wr * 64 + fr, col0 = u.pn * 256 + wc * 32 + 8 * fq;
        const int tb = (u.pm * 256) / TPB, tt0 = (u.pm * 256) % TPB;
        if (l == 3 && tt0 < 256) return;
        const float* gt = WS_MOD(p) + (size_t)(l * 9 + (tt0 < 256 ? 8 : tb)) * 6144 + 4096;
        f32x4 gv[4];
#pragma unroll
        for (int q = 0; q < 4; ++q) gv[q] = *(const f32x4*)(gt + col0 + (q >> 1) * 128 + (q & 1) * 4);
#pragma unroll
        for (int ai = 0; ai < 2; ++ai)
#pragma unroll
            for (int mp = 0; mp < 2; ++mp) {
                const float* xo[2]; float* dst[2];
#pragma unroll
                for (int h = 0; h < 2; ++h) {
                    const int row = row0 + ai * 128 + (2 * mp + h) * 16, t = row % TPB;
                    xo[h] = xrow_src(p, l, row);
                    dst[h] = scr ? (float*)WS_P(p) + (size_t)row * DM : (l == 3) ? p.out + ((size_t)tb * 2048 + (t - 256)) * DM : WS_XB(p) + (size_t)row * DM;
                }
                f32x4 xv[2][4];
#pragma unroll
                for (int h = 0; h < 2; ++h)
#pragma unroll
                    for (int q = 0; q < 4; ++q) xv[h][q] = *(const f32x4*)(xo[h] + col0 + (q >> 1) * 128 + (q & 1) * 4);
#pragma unroll
                for (int h = 0; h < 2; ++h)
#pragma unroll
                    for (int q = 0; q < 4; ++q) *(f32x4*)(dst[h] + col0 + (q >> 1) * 128 + (q & 1) * 4) = xv[h][q] + gv[q] * acc[ai][q >> 1][2 * mp + h][q & 1];
            }
    }
};

struct EpiPart {
    static constexpr bool PERM = true, AFTER_DRAIN = false;
    float* part;
    __device__ __forceinline__ void operator()(const f32x4 (&acc)[2][2][4][2], const pg8::Unit& u, int wr, int wc, int fr, int fq) const {
        const int row0 = (u.pm - 64) * 256 + wr * 64 + fr, col0 = u.pn * 256 + wc * 32 + 8 * fq;
        float* base = part + (size_t)u.ks * 2048 * 2048;
#pragma unroll
        for (int ai = 0; ai < 2; ++ai)
#pragma unroll
            for (int m = 0; m < 4; ++m) { float* rowp = base + (size_t)(row0 + ai * 128 + m * 16) * 2048 + col0;
#pragma unroll
                for (int bj = 0; bj < 2; ++bj) { *(f32x4*)(rowp + bj * 128) = acc[ai][bj][m][0]; *(f32x4*)(rowp + bj * 128 + 4) = acc[ai][bj][m][1]; } }
    }
};

template <int SCR>
__device__ __forceinline__ void qkprep_row(const Params& p, int l, int row, int lane) {
    const int t = row % TPB;
    bf16_t* rp = WS_P(p) + (size_t)row * LDP;
    float cs = 1.f, sn = 0.f;
    if (t >= 256) {
        const int s = t - 256, rr = s >> 6, cc = s & 63, f = lane & 31;
        const float inv = exp2f(-(float)f * (13.287712379549449f / 32.f));
        const float ang = (float)(lane < 32 ? rr : cc) * inv;
        cs = __cosf(ang); sn = __sinf(ang);
    }
    bf16_t r1[10], r2[10];
#pragma unroll
    for (int slot = 0; slot < 10; ++slot) { const int col = slot < 8 ? C_Q + slot * 128 : C_K + (slot - 8) * 128; r1[slot] = rp[col + lane]; r2[slot] = rp[col + 64 + lane]; }
#pragma unroll
    for (int slot = 0; slot < 10; ++slot) {
        const int col = slot < 8 ? C_Q + slot * 128 : C_K + (slot - 8) * 128;
        const float* w = slot < 8 ? p.att_q_norm + l * 128 : p.att_k_norm + l * 128;
        const float v1 = bf2f(r1[slot]), v2 = bf2f(r2[slot]);
        const float ss = wave_sum(v1 * v1 + v2 * v2);
        const float rstd = rsqrtf(ss * (1.f / 128.f) + 1e-6f);
        const float y1 = v1 * rstd * w[lane], y2 = v2 * rstd * w[64 + lane];
        float o1 = y1 * cs - y2 * sn, o2 = y1 * sn + y2 * cs;
        if (slot < 8) { o1 *= 0.08838834764831845f; o2 *= 0.08838834764831845f; }
        if (SCR) { bf16_t* sp = WS_ST(p) + (size_t)row * 1280 + slot * 128; sp[lane] = f2bf(o1); sp[64 + lane] = f2bf(o2); } else { rp[col + lane] = f2bf(o1); rp[col + 64 + lane] = f2bf(o2); }
    }
}

template <int D, int SCR = 0>
__device__ __forceinline__ void lru_sweep_item(const Params& p, int l, int item, unsigned char* shm) {
    const int tid = tidx(), lane = tid & 63, wave = tid >> 6, ch = tid & 63, seg = tid >> 6;
    const int j = item & 15, b = item >> 4;
    bf16_t* sX = (bf16_t*)shm; bf16_t* sW = (bf16_t*)(shm + 18432);
    float* sA = (float*)(shm + 36864); float* sB = (float*)(shm + 69632); float* sSA = (float*)(shm + 102400); float* sSB = (float*)(shm + 104448);
    bf16_t* sOut = (bf16_t*)(shm + 106496);
    const int mi = wave & 3, nj = wave >> 2, cl = nj * 32 + (lane & 31), cgl = j * 64 + cl;
    const float ba = p.lru_ga_b[(l * 2 + D) * 1024 + cgl], bx = p.lru_gx_b[(l * 2 + D) * 1024 + cgl], sp = softplusf(-p.lru_lambda[(l * 2 + D) * 1024 + cgl]);
    lds_barrier();
    {
        u32x4 wr2[2];
#pragma unroll
        for (int k = 0; k < 2; ++k) { const int idx = tid + k * 512; wr2[k] = *(const u32x4*)(WS_GW(p) + (size_t)(l * 16 + j) * 16384 + D * 8192 + idx * 8); }
#pragma unroll
        for (int k = 0; k < 2; ++k) { const int idx = tid + k * 512; *(u32x4*)(sW + (idx >> 3) * 72 + (idx & 7) * 8) = wr2[k]; }
    }
    u32x4 xr[2], lgr[2], hfr[2];
    {
        const size_t tok0 = (size_t)b * TPB + chunk_at(D, 0) * 128;
#pragma unroll
        for (int k = 0; k < 2; ++k) {
            const int idx = tid + k * 512;
            xr[k] = *(const u32x4*)(WS_LXC(p) + (tok0 + (idx >> 3)) * 1024 + j * 64 + (idx & 7) * 8);
            if (D == 1) { lgr[k] = *(const u32x4*)(WS_P(p) + (tok0 + (idx >> 3)) * LDP + C_LG + j * 64 + (idx & 7) * 8); hfr[k] = *(const u32x4*)(WS_MIX(p) + (tok0 + (idx >> 3)) * MIXW + j * 64 + (idx & 7) * 8); }
        }
    }
    float carry = 0.f;
#pragma unroll 1
    for (int pos = 0; pos < NCH; ++pos) {
        const size_t tok0 = (size_t)b * TPB + chunk_at(D, pos) * 128;
#pragma unroll
        for (int k = 0; k < 2; ++k) { const int idx = tid + k * 512; *(u32x4*)(sX + (idx >> 3) * 72 + (idx & 7) * 8) = xr[k]; }
        u32x4 lgc[2], hfc[2];
        if (D == 1) { lgc[0] = lgr[0]; lgc[1] = lgr[1]; hfc[0] = hfr[0]; hfc[1] = hfr[1]; }
        if (pos + 1 < NCH) {
            const size_t tokn = (size_t)b * TPB + chunk_at(D, pos + 1) * 128;
#pragma unroll
            for (int k = 0; k < 2; ++k) {
                const int idx = tid + k * 512;
                xr[k] = *(const u32x4*)(WS_LXC(p) + (tokn + (idx >> 3)) * 1024 + j * 64 + (idx & 7) * 8);
                if (D == 1) { lgr[k] = *(const u32x4*)(WS_P(p) + (tokn + (idx >> 3)) * LDP + C_LG + j * 64 + (idx & 7) * 8); hfr[k] = *(const u32x4*)(WS_MIX(p) + (tokn + (idx >> 3)) * MIXW + j * 64 + (idx & 7) * 8); }
            }
        }
        lds_barrier();
        {
            f32x16 ga, gx;
#pragma unroll
            for (int r = 0; r < 16; ++r) { ga[r] = 0.f; gx[r] = 0.f; }
            mm32<64>(ga, sX + mi * 32 * 72, 72, sW + (nj * 32) * 72, 72, lane);
            mm32<64>(gx, sX + mi * 32 * 72, 72, sW + (64 + nj * 32) * 72, 72, lane);
#pragma unroll
            for (int r = 0; r < 16; ++r) {
                const int tl = mi * 32 + rowmap32(r, lane);
                const float rg = sigmf(ga[r] + ba), ig = sigmf(gx[r] + bx);
                const float a = __expf(-8.f * rg * sp), mult = __builtin_amdgcn_sqrtf(fmaxf(1.f - a * a, 0.f));
                const float xv = bf2f(sX[tl * 72 + cl]);
                sA[tl * 64 + cl] = a; sB[tl * 64 + cl] = mult * ig * xv;
            }
        }
        lds_barrier();
        {
            float A = 1.f, Bc = 0.f;
#pragma unroll
            for (int q = 0; q < 16; ++q) { const int tl = seg * 16 + (D == 0 ? q : 15 - q); const float a = sA[tl * 64 + ch], bb = sB[tl * 64 + ch]; A = a * A; Bc = a * Bc + bb; }
            sSA[seg * 64 + ch] = A; sSB[seg * 64 + ch] = Bc;
        }
        lds_barrier();
        {
            float h = carry, cn = carry;
            const int myord = D == 0 ? seg : 7 - seg;
#pragma unroll
            for (int s = 0; s < 8; ++s) { const int sg = D == 0 ? s : 7 - s; const float a = sSA[sg * 64 + ch], bb = sSB[sg * 64 + ch]; cn = a * cn + bb; if (s < myord) h = cn; }
            carry = cn;
#pragma unroll
            for (int q = 0; q < 16; ++q) { const int tl = seg * 16 + (D == 0 ? q : 15 - q); h = sA[tl * 64 + ch] * h + sB[tl * 64 + ch]; sOut[tl * 72 + ch] = f2bf(h); }
        }
        lds_barrier();
#pragma unroll
        for (int k = 0; k < 2; ++k) {
            const int idx = tid + k * 512, rr = idx >> 3, ck = idx & 7;
            const u32x4 hv = *(const u32x4*)(sOut + rr * 72 + ck * 8);
            bf16_t* dst = SCR ? WS_P(p) + (tok0 + rr) * LDP + j * 64 + ck * 8 : WS_MIX(p) + (tok0 + rr) * MIXW + j * 64 + ck * 8;
            if (D == 0) *(u32x4*)dst = hv;
            else {
                const f32x8 a = unpack8(hv), f = unpack8(hfc[k]), g = unpack8(lgc[k]);
                f32x8 o;
#pragma unroll
                for (int e = 0; e < 8; ++e) o[e] = (a[e] + f[e]) * siluf(g[e]);
                *(u32x4*)dst = pack8(o);
            }
        }
    }
}

__device__ __forceinline__ void prep_elem(const Params& p, int l, int G) {
    const int gt = (int)blockIdx.x * 512 + tidx(), NT = G * 512;
    constexpr int NI = (NTOK / 4) * 192;
#pragma unroll 1
    for (int idx = gt; idx < NI; idx += NT) {
        const int tok = (idx / 192) * 4, cgi = idx % 192, b = tok / TPB, t = tok % TPB;
        const int lo = t < 256 ? 0 : 256, hi = t < 256 ? 256 : TPB;
        int col, CS, rs; const float *cw, *cb; bf16_t* dst; bool act;
        if (cgi < 128) { col = C_LX + cgi * 8; cw = p.lru_conv_w + l * 4096 + cgi * 8; CS = 1024; cb = p.lru_conv_b + l * 1024 + cgi * 8; act = false; dst = WS_LXC(p) + (size_t)tok * 1024 + cgi * 8; rs = 1024; }
        else { const int c2 = (cgi - 128) * 8; col = C_XBC + 1024 + c2; cw = p.ssd_conv_w + l * 6144 + 1024 + c2; CS = 1536; cb = p.ssd_conv_b + l * 1536 + 1024 + c2; act = true; dst = WS_SBC(p) + (size_t)tok * 512 + c2; rs = 512; }
        const bf16_t* src = WS_P(p) + (size_t)b * TPB * LDP + col;
        u32x4 raw[7];
#pragma unroll
        for (int r = 0; r < 7; ++r) { const int tt = t - 2 + r; raw[r] = (tt >= lo && tt < hi) ? *(const u32x4*)(src + (size_t)tt * LDP) : (u32x4){0u, 0u, 0u, 0u}; }
        const f32x4 b0 = *(const f32x4*)cb, b1 = *(const f32x4*)(cb + 4);
        f32x8 acc[4];
#pragma unroll
        for (int o = 0; o < 4; ++o) { acc[o][0] = b0.x; acc[o][1] = b0.y; acc[o][2] = b0.z; acc[o][3] = b0.w; acc[o][4] = b1.x; acc[o][5] = b1.y; acc[o][6] = b1.z; acc[o][7] = b1.w; }
#pragma unroll
        for (int k = 0; k < 4; ++k) {
            const f32x4 w0 = *(const f32x4*)(cw + k * CS), w1 = *(const f32x4*)(cw + k * CS + 4);
#pragma unroll
            for (int o = 0; o < 4; ++o) {
                const f32x8 v = unpack8(raw[o + k]);
                acc[o][0] += w0.x * v[0]; acc[o][1] += w0.y * v[1]; acc[o][2] += w0.z * v[2]; acc[o][3] += w0.w * v[3];
                acc[o][4] += w1.x * v[4]; acc[o][5] += w1.y * v[5]; acc[o][6] += w1.z * v[6]; acc[o][7] += w1.w * v[7];
            }
        }
#pragma unroll
        for (int o = 0; o < 4; ++o) {
            if (act) {
#pragma unroll
                for (int e = 0; e < 8; ++e) acc[o][e] = siluf(acc[o][e]);
            }
            *(u32x4*)(dst + (size_t)o * rs) = pack8(acc[o]);
        }
    }
}
struct PrepTile { int col0, ch0, t0, lo, hi, conv; const bf16_t* Pb; bf16_t* dst; };
__device__ __forceinline__ PrepTile prep_tile_decode(const Params& p, int item) {
    PrepTile T;
    const int t24 = item % 24, bc = item / 24, c = bc % NCH, b = bc / NCH;
    T.t0 = c * 128; T.Pb = WS_P(p) + (size_t)b * TPB * LDP; T.ch0 = 0; T.conv = t24 < 20;
    if (t24 < 16) { T.ch0 = t24 * 64; T.col0 = C_XBC + T.ch0; T.dst = WS_SXT(p) + ((size_t)((b * 18 + c) * 16 + t24)) * 8192; }
    else if (t24 < 20) { const int q = t24 - 16, g = q >> 1, nh = q & 1; T.ch0 = 1024 + g * 128 + nh * 64; T.col0 = C_XBC + T.ch0; T.dst = WS_SBT(p) + ((size_t)((b * 18 + c) * 2 + g)) * 16384 + (size_t)nh * 64 * 128; }
    else { const int q = t24 - 20, kh = q >> 1, dh = q & 1; T.col0 = C_V + kh * 128 + dh * 64; T.dst = WS_VT(p) + ((size_t)((b * 18 + c) * 2 + kh)) * 16384 + (size_t)dh * 64 * 128; }
    T.lo = T.t0 < 256 ? 0 : 256; T.hi = T.t0 < 256 ? 256 : TPB;
    return T;
}
__device__ __forceinline__ void prep_tile_load(const PrepTile& T, int tid, u32x4 (&raw)[2][4]) {
#pragma unroll
    for (int k = 0; k < 2; ++k) {
        const int idx = tid + k * 512, cgi = idx & 7, t = T.t0 + (idx >> 3);
#pragma unroll
        for (int q = 0; q < 4; ++q) {
            const int tt = T.conv ? t - 2 + q : t;
            const bool ok = T.conv ? (tt >= T.lo && tt < T.hi) : (q == 2);
            raw[k][q] = ok ? *(const u32x4*)(T.Pb + (size_t)tt * LDP + T.col0 + cgi * 8) : (u32x4){0u, 0u, 0u, 0u};
        }
    }
}
__device__ __forceinline__ void prep_tile_finish(const Params& p, int l, const PrepTile& T, int tid, const u32x4 (&raw)[2][4], unsigned char* shm) {
    bf16_t* sT = (bf16_t*)shm;
    const float* cw = p.ssd_conv_w + l * 6144 + T.ch0; const float* cb = p.ssd_conv_b + l * 1536 + T.ch0;
    lds_barrier();
#pragma unroll
    for (int k = 0; k < 2; ++k) {
        const int idx = tid + k * 512, cgi = idx & 7, tl = idx >> 3;
        f32x8 acc;
        if (T.conv) {
            const f32x4 b0 = *(const f32x4*)(cb + cgi * 8), b1 = *(const f32x4*)(cb + cgi * 8 + 4);
            acc[0] = b0.x; acc[1] = b0.y; acc[2] = b0.z; acc[3] = b0.w; acc[4] = b1.x; acc[5] = b1.y; acc[6] = b1.z; acc[7] = b1.w;
#pragma unroll
            for (int q = 0; q < 4; ++q) {
                const f32x8 v = unpack8(raw[k][q]);
                const f32x4 w0 = *(const f32x4*)(cw + q * 1536 + cgi * 8), w1 = *(const f32x4*)(cw + q * 1536 + cgi * 8 + 4);
                acc[0] += w0.x * v[0]; acc[1] += w0.y * v[1]; acc[2] += w0.z * v[2]; acc[3] += w0.w * v[3];
                acc[4] += w1.x * v[4]; acc[5] += w1.y * v[5]; acc[6] += w1.z * v[6]; acc[7] += w1.w * v[7];
            }
#pragma unroll
            for (int e = 0; e < 8; ++e) acc[e] = siluf(acc[e]);
        } else acc = unpack8(raw[k][2]);
#pragma unroll
        for (int e = 0; e < 8; ++e) sT[(cgi * 8 + e) * 130 + tl] = f2bf(acc[e]);
    }
    lds_barrier();
#pragma unroll
    for (int k = 0; k < 2; ++k) {
        const int idx = tid + k * 512, r = idx >> 4, ck = idx & 15;
        const unsigned* sp = (const unsigned*)(sT + r * 130 + ck * 8);
        u32x4 o; o.x = sp[0]; o.y = sp[1]; o.z = sp[2]; o.w = sp[3];
        *(u32x4*)(T.dst + r * 128 + ck * 8) = o;
    }
}
__device__ __forceinline__ void prep_tiles(const Params& p, int l, int bid, int G, unsigned char* shm) {
    const int tid = tidx();
    if (bid >= 3456) return;
    u32x4 raw[2][4], nraw[2][4];
    { const PrepTile T0 = prep_tile_decode(p, bid); prep_tile_load(T0, tid, raw); }
#pragma unroll 1
    for (int it = bid; it < 3456; it += G) {
        const bool more = it + G < 3456;
        if (more) { const PrepTile Tn = prep_tile_decode(p, it + G); prep_tile_load(Tn, tid, nraw); }
        { const PrepTile T = prep_tile_decode(p, it); prep_tile_finish(p, l, T, tid, raw, shm); }
        if (more) {
#pragma unroll
            for (int k = 0; k < 2; ++k)
#pragma unroll
                for (int q = 0; q < 4; ++q) raw[k][q] = nraw[k][q];
        }
    }
}
__device__ __forceinline__ void prep_dt_item(const Params& p, int l, int item) {
    const int tid = tidx();
    const int c = item % NCH, b = item / NCH;
    const int col32 = tid >> 4, h = col32 >> 1, d = col32 & 1, lane16 = tid & 15, seg = d == 0 ? lane16 : 15 - lane16;
    const float A = -__expf(p.ssd_A_log[(l * 2 + d) * 16 + h]), bias = p.ssd_dt_bias[(l * 2 + d) * 16 + h];
    const float* src = WS_DTP(p) + ((size_t)b * TPB + c * 128) * 16 + h;
    float dtv[8], cs[8], run = 0.f;
    float rawv[8];
#pragma unroll
    for (int q = 0; q < 8; ++q) { const int j = seg * 8 + (d == 0 ? q : 7 - q); rawv[q] = src[j * 16]; }
#pragma unroll
    for (int q = 0; q < 8; ++q) { dtv[q] = softplusf(rawv[q] + bias); run += dtv[q] * A; cs[q] = run; }
    float incl = run;
#pragma unroll
    for (int off = 1; off < 16; off <<= 1) { const float v = __shfl_up(incl, off, 16); if (lane16 >= off) incl += v; }
    const float excl = incl - run;
    float* dta = WS_DTA(p) + ((size_t)(b * 18 + c) * 128) * 32 + col32;
    float* acs = WS_ACS(p) + ((size_t)(b * 18 + c) * 128) * 32 + col32;
#pragma unroll
    for (int q = 0; q < 8; ++q) { const int j = seg * 8 + (d == 0 ? q : 7 - q); dta[j * 32] = dtv[q]; acs[j * 32] = cs[q] + excl; }
    if (lane16 == 15) WS_AL(p)[((b * 2 + d) * 18 + c) * 16 + h] = incl;
}
__device__ __forceinline__ void ssd_states_item(const Params& p, int l, int item, unsigned char* shm) {
    const int tid = tidx(), lane = tid & 63, wave = tid >> 6;
    const int g = item & 1, hh0 = ((item >> 1) & 1) * 4, bc = item >> 2, c = bc % NCH, b = bc / NCH;
    bf16_t* sBT = (bf16_t*)shm; bf16_t* sXw = (bf16_t*)(shm + 34816);
    float* sDt = (float*)(shm + 69632); float* sAcs = (float*)(shm + 77824); bf16_t* sO = (bf16_t*)(shm + 86016); float* sWg = (float*)(shm + 120832);
    const bf16_t* xt = WS_SXT(p) + ((size_t)((b * 18 + c) * 16 + g * 8)) * 8192;
    const bf16_t* btp = WS_SBT(p) + ((size_t)((b * 18 + c) * 2 + g)) * 16384;
    lds_barrier();
    {
        const size_t o = ((size_t)(b * 18 + c) * 128 + (tid >> 2)) * 32 + g * 16 + (tid & 3) * 4;
        const f32x4 vdt = *(const f32x4*)(WS_DTA(p) + o), vac = *(const f32x4*)(WS_ACS(p) + o);
        u32x4 bt[4];
#pragma unroll
        for (int k = 0; k < 4; ++k) { const int idx = tid + k * 512; bt[k] = *(const u32x4*)(btp + (idx >> 4) * 128 + (idx & 15) * 8); }
        *(f32x4*)(sDt + (tid >> 2) * 16 + (tid & 3) * 4) = vdt; *(f32x4*)(sAcs + (tid >> 2) * 16 + (tid & 3) * 4) = vac;
#pragma unroll
        for (int k = 0; k < 4; ++k) { const int idx = tid + k * 512; *(u32x4*)(sBT + (idx >> 4) * 136 + (idx & 15) * 8) = bt[k]; }
    }
    u32x4 xr[2];
#pragma unroll
    for (int k = 0; k < 2; ++k) { const int idx = tid + k * 512; xr[k] = *(const u32x4*)(xt + (size_t)hh0 * 8192 + (idx >> 4) * 128 + (idx & 15) * 8); }
    lds_barrier();
#pragma unroll
    for (int k = 0; k < 4; ++k) { const int idx = tid + k * 512, jj = idx >> 4, col = idx & 15; const float al = (col & 1) == 0 ? sAcs[127 * 16 + col] : sAcs[col]; sWg[col * 128 + jj] = __expf(al - sAcs[jj * 16 + col]) * sDt[jj * 16 + col]; }
#pragma unroll 1
    for (int hh = hh0; hh < hh0 + 4; ++hh) {
        const int h = g * 8 + hh;
        u32x4 xn[2] = {xr[0], xr[1]};
        if (hh < hh0 + 3) {
#pragma unroll
            for (int k = 0; k < 2; ++k) { const int idx = tid + k * 512; xn[k] = *(const u32x4*)(xt + (size_t)(hh + 1) * 8192 + (idx >> 4) * 128 + (idx & 15) * 8); }
        }
        lds_barrier();
#pragma unroll
        for (int k = 0; k < 2; ++k) {
            const int idx = tid + k * 512, pp = idx >> 4, j8 = (idx & 15) * 8;
            const f32x8 xv = unpack8(xr[k]);
#pragma unroll
            for (int d = 0; d < 2; ++d) {
                const f32x4 w0 = *(const f32x4*)(sWg + (hh * 2 + d) * 128 + j8), w1 = *(const f32x4*)(sWg + (hh * 2 + d) * 128 + j8 + 4);
                f32x8 o;
                o[0] = xv[0] * w0.x; o[1] = xv[1] * w0.y; o[2] = xv[2] * w0.z; o[3] = xv[3] * w0.w; o[4] = xv[4] * w1.x; o[5] = xv[5] * w1.y; o[6] = xv[6] * w1.z; o[7] = xv[7] * w1.w;
                *(u32x4*)(sXw + d * 8704 + pp * 136 + j8) = pack8(o);
            }
        }
        lds_barrier();
        const int mi = wave & 1, nj = wave >> 1;
#pragma unroll
        for (int d = 0; d < 2; ++d) {
            f32x16 acc;
#pragma unroll
            for (int r = 0; r < 16; ++r) acc[r] = 0.f;
            mm32<128>(acc, sXw + d * 8704 + mi * 32 * 136, 136, sBT + nj * 32 * 136, 136, lane);
#pragma unroll
            for (int r = 0; r < 16; ++r) sO[d * 8704 + (mi * 32 + rowmap32(r, lane)) * 136 + nj * 32 + (lane & 31)] = f2bf(acc[r]);
        }
        lds_barrier();
#pragma unroll
        for (int d = 0; d < 2; ++d) {
            bf16_t* base = WS_ST(p) + ((size_t)((b * 2 + d) * 18 + c) * 16 + h) * 8192;
#pragma unroll
            for (int k = 0; k < 2; ++k) { const int idx = tid + k * 512; *(u32x4*)(base + idx * 8) = *(const u32x4*)(sO + d * 8704 + (idx >> 4) * 136 + (idx & 15) * 8); }
        }
        xr[0] = xn[0]; xr[1] = xn[1];
    }
}
__device__ __forceinline__ void ssd_recur_item(const Params& p, int item) {
    const int tid = tidx();
    const int d = item & 1, h = (item >> 1) & 15, b = item >> 5;
    u32x4 s0[NCH], s1[NCH]; float ev[NCH];
#pragma unroll
    for (int pos = 0; pos < NCH; ++pos) {
        const int c = chunk_at(d, pos);
        const bf16_t* ptr = WS_ST(p) + ((size_t)((b * 2 + d) * 18 + c) * 16 + h) * 8192 + tid * 16;
        s0[pos] = *(const u32x4*)ptr; s1[pos] = *(const u32x4*)(ptr + 8);
        ev[pos] = WS_AL(p)[((b * 2 + d) * 18 + c) * 16 + h];
    }
    f32x8 h0, h1;
#pragma unroll
    for (int e = 0; e < 8; ++e) { h0[e] = 0.f; h1[e] = 0.f; }
#pragma unroll
    for (int pos = 0; pos < NCH; ++pos) {
        const int c = chunk_at(d, pos);
        bf16_t* ptr = WS_ST(p) + ((size_t)((b * 2 + d) * 18 + c) * 16 + h) * 8192 + tid * 16;
        *(u32x4*)ptr = pack8(h0); *(u32x4*)(ptr + 8) = pack8(h1);
        const float e = __expf(ev[pos]);
        h0 = h0 * e + unpack8(s0[pos]); h1 = h1 * e + unpack8(s1[pos]);
    }
}
template <int MODE>
__device__ __forceinline__ void ssd_final_item(const Params& p, int l, int item, unsigned char* shm) {
    const int tid = tidx(), lane = tid & 63, wave = tid >> 6;
    const int g = item & 1, hh0 = ((item >> 1) & 1) * 4, bc = item >> 2, c = bc % NCH, b = bc / NCH, t0 = c * 128;
    if (l == 3 && c < 2) return;
    const size_t tok0 = (size_t)b * TPB + t0;
    bf16_t* sC = (bf16_t*)shm; bf16_t* sBW = (bf16_t*)(shm + 34816); bf16_t* sXT = (bf16_t*)(shm + 69632); bf16_t* sH = (bf16_t*)(shm + 87040);
    float* sDt = (float*)(shm + 104448); float* sAcs = (float*)(shm + 112640);
    bf16_t* sY = sBW;
    const bf16_t* xt = WS_SXT(p) + ((size_t)((b * 18 + c) * 16 + g * 8)) * 8192;
    const bf16_t* zt = WS_P(p) + tok0 * LDP + C_Z + g * 512;
    const bf16_t* hin0 = WS_ST(p) + ((size_t)((b * 2 + 0) * 18 + c) * 16 + g * 8) * 8192;
    const bf16_t* hin1 = WS_ST(p) + ((size_t)((b * 2 + 1) * 18 + c) * 16 + g * 8) * 8192;
    lds_barrier();
    u32x4 xr[2], zr[2], h0r[2];
    {
        const size_t o = ((size_t)(b * 18 + c) * 128 + (tid >> 2)) * 32 + g * 16 + (tid & 3) * 4;
        const f32x4 vdt = *(const f32x4*)(WS_DTA(p) + o), vac = *(const f32x4*)(WS_ACS(p) + o);
        u32x4 cr[4], br[4];
#pragma unroll
        for (int k = 0; k < 4; ++k) { const int idx = tid + k * 512; const bf16_t* s = WS_SBC(p) + (tok0 + (idx >> 4)) * 512 + g * 128 + (idx & 15) * 8; br[k] = *(const u32x4*)s; cr[k] = *(const u32x4*)(s + 256); }
#pragma unroll
        for (int k = 0; k < 2; ++k) {
            const int idx = tid + k * 512;
            xr[k] = *(const u32x4*)(xt + (size_t)hh0 * 8192 + (idx >> 4) * 128 + (idx & 15) * 8);
            zr[k] = *(const u32x4*)(zt + (size_t)(idx >> 3) * LDP + hh0 * 64 + (idx & 7) * 8);
            h0r[k] = *(const u32x4*)(hin0 + (size_t)hh0 * 8192 + idx * 8);
        }
        *(f32x4*)(sDt + (tid >> 2) * 16 + (tid & 3) * 4) = vdt; *(f32x4*)(sAcs + (tid >> 2) * 16 + (tid & 3) * 4) = vac;
#pragma unroll
        for (int k = 0; k < 4; ++k) { const int idx = tid + k * 512; *(u32x4*)(sC + (idx >> 4) * 136 + (idx & 15) * 8) = cr[k]; *(u32x4*)(sBW + (idx >> 4) * 136 + (idx & 15) * 8) = br[k]; }
    }
    lds_barrier();
    const int cmi = wave >> 1, cnj0 = (wave & 1) * 2;
    f32x16 cb0, cb1;
#pragma unroll
    for (int r = 0; r < 16; ++r) { cb0[r] = 0.f; cb1[r] = 0.f; }
    mm32<128>(cb0, sC + cmi * 32 * 136, 136, sBW + cnj0 * 32 * 136, 136, lane);
    mm32<128>(cb1, sC + cmi * 32 * 136, 136, sBW + (cnj0 + 1) * 32 * 136, 136, lane);
    const int ymi = wave & 3, ynj = wave >> 2;
#pragma unroll 1
    for (int hh = hh0; hh < hh0 + 4; ++hh) {
        const int h = g * 8 + hh;
        lds_barrier();
#pragma unroll
        for (int k = 0; k < 2; ++k) { const int idx = tid + k * 512; *(u32x4*)(sXT + (idx >> 4) * 136 + (idx & 15) * 8) = xr[k]; *(u32x4*)(sH + (idx >> 4) * 136 + (idx & 15) * 8) = h0r[k]; }
        u32x4 h1r[2];
#pragma unroll
        for (int k = 0; k < 2; ++k) h1r[k] = *(const u32x4*)(hin1 + (size_t)hh * 8192 + (tid + k * 512) * 8);
        f32x16 yacc;
        const int colf = hh * 2, colr = hh * 2 + 1;
        if (MODE < 2) {
            float acif[16], acir[16];
#pragma unroll
            for (int r = 0; r < 16; ++r) { const int ig = cmi * 32 + rowmap32(r, lane); acif[r] = sAcs[ig * 16 + colf]; acir[r] = sAcs[ig * 16 + colr]; }
#pragma unroll
            for (int tt = 0; tt < 2; ++tt) {
                const int jg = (cnj0 + tt) * 32 + (lane & 31);
                const float acjf = sAcs[jg * 16 + colf], dtjf = sDt[jg * 16 + colf], acjr = sAcs[jg * 16 + colr], dtjr = sDt[jg * 16 + colr];
                const int dj0 = jg - cmi * 32 - 4 * (lane >> 5);
#pragma unroll
                for (int r = 0; r < 16; ++r) {
                    const int sd = dj0 - ((r & 3) + 8 * (r >> 2));
                    const bool fwd = sd <= 0;
                    const float arg = fwd ? acif[r] - acjf : acir[r] - acjr, sc = fwd ? dtjf : dtjr;
                    const float cbv = tt == 0 ? cb0[r] : cb1[r];
                    float val = cbv * __expf(arg) * sc;
                    val += sd == 0 ? cbv * dtjr : 0.f;
                    sBW[(cmi * 32 + rowmap32(r, lane)) * 136 + jg] = f2bf(val);
                }
            }
        }
        lds_barrier();
        {
            f32x16 ad, ao;
#pragma unroll
            for (int r = 0; r < 16; ++r) { ad[r] = 0.f; ao[r] = 0.f; }
            if (MODE < 3) { mm32<128>(ad, sBW + ymi * 32 * 136, 136, sXT + ynj * 32 * 136, 136, lane);
            mm32<128>(ao, sC + ymi * 32 * 136, 136, sH + ynj * 32 * 136, 136, lane); }
#pragma unroll
            for (int r = 0; r < 16; ++r) { const int ig = ymi * 32 + rowmap32(r, lane); yacc[r] = ad[r] + __expf(sAcs[ig * 16 + colf]) * ao[r]; }
        }
        if (hh < hh0 + 3) {
#pragma unroll
            for (int k = 0; k < 2; ++k) {
                const int idx = tid + k * 512;
                xr[k] = *(const u32x4*)(xt + (size_t)(hh + 1) * 8192 + (idx >> 4) * 128 + (idx & 15) * 8);
                h0r[k] = *(const u32x4*)(hin0 + (size_t)(hh + 1) * 8192 + idx * 8);
            }
        }
        lds_barrier();
#pragma unroll
        for (int k = 0; k < 2; ++k) { const int idx = tid + k * 512; *(u32x4*)(sH + (idx >> 4) * 136 + (idx & 15) * 8) = h1r[k]; }
        lds_barrier();
        {
            f32x16 ao;
#pragma unroll
            for (int r = 0; r < 16; ++r) ao[r] = 0.f;
            if (MODE < 3) mm32<128>(ao, sC + ymi * 32 * 136, 136, sH + ynj * 32 * 136, 136, lane);
#pragma unroll
            for (int r = 0; r < 16; ++r) { const int ig = ymi * 32 + rowmap32(r, lane); yacc[r] += __expf(sAcs[ig * 16 + colr]) * ao[r]; }
        }
        const float Dh = p.ssd_D[l * 16 + h];
        const int pl = ynj * 32 + (lane & 31);
#pragma unroll
        for (int r = 0; r < 16; ++r) { const int ig = ymi * 32 + rowmap32(r, lane); yacc[r] += Dh * bf2f(sXT[pl * 136 + ig]); }
        lds_barrier();
#pragma unroll
        for (int r = 0; r < 16; ++r) { const int ig = ymi * 32 + rowmap32(r, lane); sY[ig * 72 + pl] = f2bf(yacc[r]); }
        lds_barrier();
#pragma unroll
        for (int k = 0; k < 2; ++k) {
            const int idx = tid + k * 512, rr = idx >> 3, pk = idx & 7;
            const f32x8 yv = unpack8(*(const u32x4*)(sY + rr * 72 + pk * 8)), zv = unpack8(zr[k]);
            f32x8 o;
#pragma unroll
            for (int e = 0; e < 8; ++e) o[e] = yv[e] * siluf(zv[e]);
            if (MODE < 1) *(u32x4*)(WS_MIX(p) + (tok0 + rr) * MIXW + 2048 + h * 64 + pk * 8) = pack8(o); else asm volatile("" :: "v"(o[0]), "v"(o[7]));
        }
        if (hh < hh0 + 3) {
#pragma unroll
            for (int k = 0; k < 2; ++k) { const int idx = tid + k * 512; zr[k] = *(const u32x4*)(zt + (size_t)(idx >> 3) * LDP + (hh + 1) * 64 + (idx & 7) * 8); }
        }
    }
}
__device__ __forceinline__ void ssd_norm_phase(const Params& p, int l, int G) {
    const int lane = tidx() & 63, wave = tidx() >> 6;
    for (int row = blockIdx.x * 8 + wave; row < NTOK; row += G * 8) {
        bf16_t* rp = WS_MIX(p) + (size_t)row * MIXW + 2048;
        f32x8 v0 = unpack8(*(const u32x4*)(rp + lane * 8)), v1 = unpack8(*(const u32x4*)(rp + 512 + lane * 8));
        float ss = 0.f;
#pragma unroll
        for (int e = 0; e < 8; ++e) ss += v0[e] * v0[e] + v1[e] * v1[e];
        ss = wave_sum(ss);
        const float rstd = rsqrtf(ss * (1.f / 1024.f) + 1e-6f);
        const float* nw = p.ssd_norm_w + l * 1024;
#pragma unroll
        for (int e = 0; e < 8; ++e) { v0[e] = v0[e] * rstd * nw[lane * 8 + e]; v1[e] = v1[e] * rstd * nw[512 + lane * 8 + e]; }
        *(u32x4*)(rp + lane * 8) = pack8(v0); *(u32x4*)(rp + 512 + lane * 8) = pack8(v1);
    }
}

template <int MODE>
__device__ __forceinline__ void attn_item(const Params& p, int l, int item, unsigned char* shm) {
    const int tid = tidx(), lane = tid & 63, wave = tid >> 6, fr = lane & 15, fq = lane >> 4;
    const int hp = item & 3, bq = item >> 2, qblk = bq % NCH, b = bq / NCH, kh = hp >> 1;
    if (l == 3 && qblk < 2) return;
    const bf16_t* P = WS_P(p);
    bf16_t* sK = (bf16_t*)shm; bf16_t* sVT = (bf16_t*)(shm + 34816); bf16_t* sPw = (bf16_t*)(shm + 69632) + wave * (2 * 16 * 136);
    const size_t tokq0 = (size_t)b * TPB + qblk * 128;
    bf16x8 aq[2][4];
#pragma unroll
    for (int hd = 0; hd < 2; ++hd)
#pragma unroll
        for (int kk = 0; kk < 4; ++kk) aq[hd][kk] = *(const bf16x8*)(P + (tokq0 + wave * 16 + fr) * LDP + C_Q + (hp * 2 + hd) * 128 + kk * 32 + 8 * fq);
    float m[2][4], ls[2][4]; f32x4 O[2][8];
#pragma unroll
    for (int hd = 0; hd < 2; ++hd) {
        const float sink = p.att_sink[l * 8 + hp * 2 + hd];
#pragma unroll
        for (int r = 0; r < 4; ++r) { m[hd][r] = sink; ls[hd][r] = 1.f; }
#pragma unroll
        for (int nd = 0; nd < 8; ++nd) O[hd][nd] = (f32x4){0.f, 0.f, 0.f, 0.f};
    }
    const int nlat = qblk - 2;
    const int kb_lo = nlat - 1 < 0 ? 0 : nlat - 1, kb_hi = nlat + 1 > 15 ? 15 : nlat + 1;
    const int ntl = qblk < 2 ? 2 : 2 + (kb_hi - kb_lo + 1);
    u32x4 kr[4], vr[4];
    const bf16_t* vtb = WS_VT(p) + ((size_t)(b * 18) * 2 + kh) * 16384;
    {
        const bf16_t* kbase = P + ((size_t)b * TPB) * LDP + C_K + kh * 128;
#pragma unroll
        for (int k = 0; k < 4; ++k) { const int idx = tid + k * 512; kr[k] = *(const u32x4*)(kbase + (size_t)(idx >> 4) * LDP + (idx & 15) * 8); vr[k] = *(const u32x4*)(vtb + idx * 8); }
    }
#pragma unroll 1
    for (int ti = 0; ti < ntl; ++ti) {
        const bool masked = ti >= 2; const int kb = kb_lo + (ti - 2);
        lds_barrier();
#pragma unroll
        for (int k = 0; k < 4; ++k) {
            const int idx = tid + k * 512;
            *(u32x4*)(sK + (idx >> 4) * 136 + (idx & 15) * 8) = kr[k];
            *(u32x4*)(sVT + (idx >> 4) * 136 + (idx & 15) * 8) = vr[k];
        }
        if (ti + 1 < ntl) {
            const int tn = ti + 1, t0n = tn < 2 ? tn * 128 : 256 + (kb_lo + (tn - 2)) * 128;
            const bf16_t* kbase = P + ((size_t)b * TPB + t0n) * LDP + C_K + kh * 128;
            const bf16_t* vtn = vtb + (size_t)(t0n >> 7) * 32768;
#pragma unroll
            for (int k = 0; k < 4; ++k) { const int idx = tid + k * 512; kr[k] = *(const u32x4*)(kbase + (size_t)(idx >> 4) * LDP + (idx & 15) * 8); vr[k] = *(const u32x4*)(vtn + idx * 8); }
        }
        lds_barrier();
#pragma unroll 1
        for (int hf = 0; hf < 2; ++hf) {
            f32x4 s[2][4];
#pragma unroll
            for (int nt = 0; nt < 4; ++nt) {
                s[0][nt] = (f32x4){0.f, 0.f, 0.f, 0.f}; s[1][nt] = (f32x4){0.f, 0.f, 0.f, 0.f};
#pragma unroll
                for (int kk = 0; kk < 4; ++kk) {
                    const bf16x8 bk = *(const bf16x8*)(sK + ((hf * 4 + nt) * 16 + fr) * 136 + kk * 32 + 8 * fq);
                    s[0][nt] = __builtin_amdgcn_mfma_f32_16x16x32_bf16(aq[0][kk], bk, s[0][nt], 0, 0, 0);
                    s[1][nt] = __builtin_amdgcn_mfma_f32_16x16x32_bf16(aq[1][kk], bk, s[1][nt], 0, 0, 0);
                }
                __builtin_amdgcn_sched_barrier(0);
            }
            if (masked) {
#pragma unroll
                for (int nt = 0; nt < 4; ++nt)
#pragma unroll
                    for (int r = 0; r < 4; ++r) { const int rel = (nlat * 128 + wave * 16 + fq * 4 + r) - (kb * 128 + (hf * 4 + nt) * 16 + fr); if (rel > 128 || rel < -128) { s[0][nt][r] = -INFINITY; s[1][nt][r] = -INFINITY; } }
            }
#pragma unroll
            for (int hd = 0; hd < 2; ++hd) {
                float alpha[4];
#pragma unroll
                for (int r = 0; r < 4; ++r) {
                    float mx = fmaxf(fmaxf(s[hd][0][r], s[hd][1][r]), fmaxf(s[hd][2][r], s[hd][3][r]));
                    mx = row16_max(mx);
                    const float mn = fmaxf(m[hd][r], mx);
                    alpha[r] = __expf(m[hd][r] - mn); m[hd][r] = mn;
                    float rs = 0.f;
#pragma unroll
                    for (int nt = 0; nt < 4; ++nt) { const float pv = __expf(s[hd][nt][r] - mn); s[hd][nt][r] = pv; rs += pv; }
                    rs = row16_sum(rs);
                    ls[hd][r] = ls[hd][r] * alpha[r] + rs;
                }
#pragma unroll
                for (int nd = 0; nd < 8; ++nd) { O[hd][nd].x *= alpha[0]; O[hd][nd].y *= alpha[1]; O[hd][nd].z *= alpha[2]; O[hd][nd].w *= alpha[3]; }
#pragma unroll
                for (int nt = 0; nt < 4; ++nt)
#pragma unroll
                    for (int r = 0; r < 4; ++r) sPw[hd * (16 * 136) + (fq * 4 + r) * 136 + nt * 16 + fr] = f2bf(s[hd][nt][r]);
            }
            asm volatile("s_waitcnt lgkmcnt(0)" ::: "memory");
#pragma unroll
            for (int kk = 0; kk < 2; ++kk) {
                const bf16x8 ap0 = *(const bf16x8*)(sPw + fr * 136 + kk * 32 + 8 * fq);
                const bf16x8 ap1 = *(const bf16x8*)(sPw + 16 * 136 + fr * 136 + kk * 32 + 8 * fq);
#pragma unroll
                for (int nd = 0; nd < 8; ++nd) {
                    const bf16x8 bv = *(const bf16x8*)(sVT + (nd * 16 + fr) * 136 + hf * 64 + kk * 32 + 8 * fq);
                    O[0][nd] = __builtin_amdgcn_mfma_f32_16x16x32_bf16(ap0, bv, O[0][nd], 0, 0, 0);
                    O[1][nd] = __builtin_amdgcn_mfma_f32_16x16x32_bf16(ap1, bv, O[1][nd], 0, 0, 0);
                    if (nd == 3) __builtin_amdgcn_sched_barrier(0);
                }
                __builtin_amdgcn_sched_barrier(0);
            }
            asm volatile("s_waitcnt lgkmcnt(0)" ::: "memory");
        }
    }
#pragma unroll
    for (int hd = 0; hd < 2; ++hd) {
        const int hq = hp * 2 + hd;
        u32x4 agr[4];
#pragma unroll
        for (int k = 0; k < 4; ++k) { const int idx = tid + k * 512; agr[k] = *(const u32x4*)(P + (tokq0 + (idx >> 4)) * LDP + C_AG + hq * 128 + (idx & 15) * 8); }
        lds_barrier();
#pragma unroll
        for (int r = 0; r < 4; ++r) {
            const float il = __builtin_amdgcn_rcpf(ls[hd][r]);
#pragma unroll
            for (int nd = 0; nd < 8; ++nd) sK[(wave * 16 + fq * 4 + r) * 136 + nd * 16 + fr] = f2bf(O[hd][nd][r] * il);
        }
        lds_barrier();
#pragma unroll
        for (int k = 0; k < 4; ++k) {
            const int idx = tid + k * 512, rr = idx >> 4, ck = idx & 15;
            const f32x8 ov = unpack8(*(const u32x4*)(sK + rr * 136 + ck * 8)), gv = unpack8(agr[k]);
            f32x8 o;
#pragma unroll
            for (int e = 0; e < 8; ++e) o[e] = ov[e] * siluf(gv[e]);
            *(u32x4*)(WS_MIX(p) + (tokq0 + rr) * MIXW + 1024 + hq * 128 + ck * 8) = pack8(o);
        }
    }
}

#define XB_TMO      128
#define XB_XCNT(j)  (256  + 64 * (j))
#define XB_XSUB(j)  (1280 + 64 * (j))
#define XB_XGEN(j)  (2304 + 64 * (j))
#define XB_TOP      3328
#define XB_TOPGEN   3392
#define XCD_BAR_WORDS 3456
#define XB_SPIN_CAP (1u << 18)
#define LAS __attribute__((address_space(3)))
__device__ __forceinline__ unsigned xb_ld(unsigned* p)              { return __hip_atomic_load(p, __ATOMIC_RELAXED, __HIP_MEMORY_SCOPE_AGENT); }
__device__ __forceinline__ unsigned xb_add(unsigned* p, unsigned v) { return __hip_atomic_fetch_add(p, v, __ATOMIC_RELAXED, __HIP_MEMORY_SCOPE_AGENT); }
__device__ __forceinline__ unsigned xb_xcc_id() { return (unsigned)__builtin_amdgcn_s_getreg((3 << 11) | 20) & 0xFu; }
#define XB_SPIN(cond, bar) do { unsigned _sp = 0; while (cond) { __builtin_amdgcn_s_sleep(1); \
    if ((++_sp & 255u) == 0u) { if (xb_ld(&(bar)[XB_TMO])) break; if (_sp > XB_SPIN_CAP) { atomicAdd(&(bar)[XB_TMO], 1u); break; } } } } while (0)
struct XcdBarrier { unsigned* bar; unsigned x; volatile LAS unsigned* st; };
__device__ __forceinline__ XcdBarrier xcd_barrier_post(unsigned* bar, volatile LAS unsigned* st) {
    XcdBarrier b; b.bar = bar; b.x = xb_xcc_id(); b.st = st;
    if (tidx() == 0) (void)xb_add(&bar[XB_XCNT(b.x)], 1u);
    return b;
}
__device__ __forceinline__ void xcd_barrier_complete(unsigned* bar, unsigned x, unsigned& nloc, unsigned& nx) {
    const unsigned G = gridDim.x * gridDim.y * gridDim.z;
    unsigned sum, cnt, mine, sp = 0u;
    for (;;) {
        sum = 0u; cnt = 0u; mine = 0u;
#pragma unroll
        for (unsigned j = 0; j < 16; ++j) { const unsigned c = xb_ld(&bar[XB_XCNT(j)]); sum += c; cnt += (c > 0u) ? 1u : 0u; mine = (j == x) ? c : mine; }
        if (sum == G) break;
        __builtin_amdgcn_s_sleep(1);
        if ((++sp & 255u) == 0u) { if (xb_ld(&bar[XB_TMO])) break; if (sp > XB_SPIN_CAP) { atomicAdd(&bar[XB_TMO], 1u); break; } }
    }
    nloc = mine > 0u ? mine : 1u; nx = cnt > 0u ? cnt : 1u;
}
__device__ __forceinline__ void xcd_barrier(const XcdBarrier& b) {
    asm volatile("s_waitcnt vmcnt(0)" ::: "memory");
    __syncthreads();
    if (tidx() == 0) {
        unsigned* bar = b.bar;
        __builtin_amdgcn_s_waitcnt(0);
        unsigned nloc = b.st[0], nx = b.st[1];
        if (nloc == 0u) { xcd_barrier_complete(bar, b.x, nloc, nx); b.st[0] = nloc; b.st[1] = nx; }
        const unsigned old = xb_add(&bar[XB_XSUB(b.x)], 1u);
        const unsigned gen = old / nloc;
        if (old + 1u == (gen + 1u) * nloc) {
            __builtin_amdgcn_fence(__ATOMIC_RELEASE, "agent");
            asm volatile("s_waitcnt vmcnt(0)" ::: "memory");
            const unsigned og = xb_add(&bar[XB_TOP], 1u);
            const unsigned tg = og / nx;
            if (og + 1u == (tg + 1u) * nx) xb_add(&bar[XB_TOPGEN], 1u);
            else XB_SPIN(xb_ld(&bar[XB_TOPGEN]) == tg, bar);
            __builtin_amdgcn_fence(__ATOMIC_ACQUIRE, "agent");
            xb_add(&bar[XB_XGEN(b.x)], 1u);
            asm volatile("s_waitcnt vmcnt(0)" ::: "memory");
        } else {
            XB_SPIN(xb_ld(&bar[XB_XGEN(b.x)]) == gen, bar);
            __builtin_amdgcn_fence(__ATOMIC_ACQUIRE, "agent");
            asm volatile("s_waitcnt vmcnt(0)" ::: "memory");
        }
    }
    __syncthreads();
}


#define QUEUE_LOOP(ctr, NITEMS, BODY) do { \
    volatile LAS unsigned* _mb = (volatile LAS unsigned*)(shm + LDS_CTL + 8); \
    int it = bid; \
    while (it < (NITEMS)) { \
        unsigned _nx = 0u; if (tidx() == 0) _nx = xb_add((ctr), 1u) + (unsigned)G; \
        BODY; \
        __syncthreads(); \
        if (tidx() == 0) _mb[0] = _nx; \
        __syncthreads(); \
        it = (int)_mb[0]; \
    } } while (0)

__global__ __launch_bounds__(512) void mega(Params p) {
    extern __shared__ __attribute__((aligned(16))) unsigned char shm[];
    cg::grid_group grid = cg::this_grid();
    const int G = (int)gridDim.x, bid = (int)blockIdx.x;
    if (tidx() < 4) ((volatile LAS unsigned*)(shm + LDS_CTL))[tidx()] = 0u;
    __syncthreads();
    unsigned* qctr = (unsigned*)(p.ws + OFF_BAR) + 3584;
    const XcdBarrier xb = xcd_barrier_post((unsigned*)(p.ws + OFF_BAR), (volatile LAS unsigned*)(shm + LDS_CTL));
    for (int rep = 0; rep < 1 + DUP_P0; ++rep) phase0(p, shm, G);
    grid.sync();
#pragma unroll 1
    for (int l = 0; l < 4; ++l) {
        for (int rep = 0; rep < 1 + DUP_NORM; ++rep) norm_phase(p, l, G);
        xcd_barrier(xb);
        {
            pg8::Gemm g{WS_U(p), WS_WTIN(p) + (size_t)l * 7424 * 2048, NTOK, 7168, 2048, 2048};
            pg8::Order S; S.init(72, 28, G, bid, 0);
            EpiG1 E{WS_P(p)};
            for (int rep = 0; rep < 1 + DUP_G1; ++rep) pg8::gemm_phase<EpiG1, pg8::Order>((PG8_LAS unsigned char*)shm, g, S, E);
            {
                const int tq = tidx(), wave = tq >> 6, lane = tq & 63, fr = lane & 15, fq = lane >> 4;
                for (int wu = bid * 8 + wave; wu < NTOK / 16; wu += G * 8) {
                    const bf16_t* ap = WS_U(p) + (size_t)(wu * 16 + fr) * 2048 + 8 * fq;
                    const bf16_t* bp = WS_WTIN(p) + ((size_t)l * 7424 + 7168 + fr) * 2048 + 8 * fq;
                    f32x4 acc = (f32x4){0.f, 0.f, 0.f, 0.f};
#pragma unroll 8
                    for (int kk = 0; kk < 64; ++kk) { const bf16x8 a = *(const bf16x8*)(ap + kk * 32), bq = *(const bf16x8*)(bp + kk * 32); acc = __builtin_amdgcn_mfma_f32_16x16x32_bf16(a, bq, acc, 0, 0, 0); }
#pragma unroll
                    for (int r = 0; r < 4; ++r) WS_DTP(p)[(size_t)(wu * 16 + fq * 4 + r) * 16 + fr] = acc[r];
                }
            }
        }
        for (int rep = 0; rep < 1 + DUP_SYNC; ++rep) xcd_barrier(xb);
        for (int rep = 0; rep < 1 + DUP_E1; ++rep) {
            if (rep == 0 || E1SEL == 0 || E1SEL == 1) for (int it = bid; it < 144; it += G) prep_dt_item(p, l, it);
            if (rep == 0 || E1SEL == 0 || E1SEL == 2) { __syncthreads(); prep_tiles(p, l, bid, G, shm); }
            if (rep == 0 || E1SEL == 0 || E1SEL == 3) prep_elem(p, l, G);
        }
        { const int tq = tidx(), wave = tq >> 6, lane = tq & 63; for (int row = bid * 8 + wave; row < NTOK; row += G * 8) qkprep_row<0>(p, l, row, lane);
#if DUP_QK
          for (int row = bid * 8 + wave; row < NTOK; row += G * 8) qkprep_row<1>(p, l, row, lane);
#endif
        }
        xcd_barrier(xb);
        QUEUE_LOOP(qctr + (l * 3 + 0) * 64, 128 + 576, { if (it < 128) lru_sweep_item<0>(p, l, it, shm); else ssd_states_item(p, l, it - 128, shm); });
#if DUP_X1Q
        __syncthreads(); QUEUE_LOOP(qctr + (12 + l * 3 + 0) * 64, 128 + 576, { if (it < 128) lru_sweep_item<0>(p, l, it, shm); else ssd_states_item(p, l, it - 128, shm); });
#endif
#if DUP_SWEEP
        __syncthreads(); for (int it = bid; it < 128; it += G) lru_sweep_item<0>(p, l, it, shm);
#endif
#if DUP_STATES
        __syncthreads(); for (int it = bid; it < 256; it += G) ssd_states_item(p, l, it, shm);
#endif
        xcd_barrier(xb);
        QUEUE_LOOP(qctr + (l * 3 + 1) * 64, 576 + 256, { if (it < 576) attn_item<0>(p, l, it, shm); else ssd_recur_item(p, it - 576); });
#if DUP_ATTQ
        __syncthreads(); QUEUE_LOOP(qctr + (12 + l * 3 + 1) * 64, 576, { attn_item<AMODE>(p, l, it, shm); });
#endif
        xcd_barrier(xb);
        QUEUE_LOOP(qctr + (l * 3 + 2) * 64, 128 + 576, { if (it < 128) lru_sweep_item<1>(p, l, it, shm); else ssd_final_item<0>(p, l, it - 128, shm); });
#if DUP_FINAL
        __syncthreads(); for (int it = bid; it < 256; it += G) ssd_final_item<FMODE>(p, l, it, shm);
#endif
#if DUP_SWEEP1
        __syncthreads(); for (int it = bid; it < 128; it += G) lru_sweep_item<1, 1>(p, l, it, shm);
#endif
        xcd_barrier(xb);
#ifndef SK_X4
        ssd_norm_phase(p, l, G);
#endif
        xcd_barrier(xb);
        {
            pg8::Gemm g{WS_MIX(p), WS_WTOUT(p) + (size_t)l * 2048 * 3072, NTOK, 2048, 3072, 3072};
            pg8::Order S; S.init(64, 8, G, bid, l == 3 ? 1 : 0);
            EpiG2 E{p, l, 0};
#if DUP_G2
            { EpiG2 E2{p, l, 1}; pg8::gemm_phase<EpiG2, pg8::Order>((PG8_LAS unsigned char*)shm, g, S, E2); }
#endif
#ifndef SK_G2
            pg8::gemm_phase<EpiG2, pg8::Order>((PG8_LAS unsigned char*)shm, g, S, E);
#endif
        }
        if (l < 3) {
            pg8::Gemm gt{WS_MIX(p), WS_WTOUT(p) + (size_t)l * 2048 * 3072, NTOK, 2048, 768, 3072};
            pg8::TailOrder St{bid, G};
            EpiPart Et{(float*)WS_P(p)};
            pg8::gemm_phase<EpiPart, pg8::TailOrder>((PG8_LAS unsigned char*)shm, gt, St, Et);
            xcd_barrier(xb);
        }
    }
}

extern "C" void kernel_launch(void* const* d_in, const int* in_sizes, int n_in, void* d_out, int out_size, void* d_ws, size_t ws_size, hipStream_t stream) {
    static int grid = 0;
    if (grid == 0) {
        if (n_in != 25 || ws_size < WS_END) { fprintf(stderr, "kernel_launch: need 25 inputs and %zu bytes of workspace (got %d, %zu)\n", (size_t)WS_END, n_in, ws_size); grid = -1; return; }
        int dev = 0, cus = 0, per_cu = 0;
        hipGetDevice(&dev);
        hipDeviceGetAttribute(&cus, hipDeviceAttributeMultiprocessorCount, dev);
        if (hipFuncSetAttribute((const void*)mega, hipFuncAttributeMaxDynamicSharedMemorySize, LDS_BYTES) != hipSuccess) { fprintf(stderr, "kernel_launch: hipFuncSetAttribute failed\n"); grid = -1; return; }
        if (hipOccupancyMaxActiveBlocksPerMultiprocessor(&per_cu, (const void*)mega, 512, LDS_BYTES) != hipSuccess || per_cu < 1) { fprintf(stderr, "kernel_launch: occupancy query gave %d\n", per_cu); per_cu = 1; }
        (void)hipGetLastError();
        grid = cus * 1;
        if (grid <= 0) grid = 256;
    }
    if (grid < 0) return;
    Params p{};
    const float** pf = (const float**)&p;
    for (int i = 0; i < 25; ++i) pf[i] = (const float*)d_in[i];
    p.out = (float*)d_out; p.ws = (unsigned char*)d_ws;
    if (hipMemsetAsync((char*)d_ws + OFF_BAR, 0, 32768, stream) != hipSuccess) { fprintf(stderr, "kernel_launch: memset of barrier words failed\n"); return; }
    void* args[] = {&p};
    hipError_t e = hipLaunchCooperativeKernel((const void*)mega, dim3(grid), dim3(512), args, LDS_BYTES, stream);
    if (e != hipSuccess) fprintf(stderr, "cooperative launch failed: %s (grid %d)\n", hipGetErrorString(e), grid);
}
```

```cpp
#include <hip/hip_runtime.h>
#include <hip/hip_cooperative_groups.h>
#include <cstdio>
#include <cstdint>
namespace cg = cooperative_groups;
#define DUP_X1A 0
#define DUP_X1B 0
#define DUP_ATT 0
#define DUP_X3A 0
#define DUP_X3B 0
#define DUP_G1 0
#define DUP_P0 0
#define DUP_NORM 0
#define DUP_SYNC 0
#define DUP_E1 0
#define DUP_SWEEP1 0
#define DUP_G2 0
#define DUP_QK 0
#define E1SEL 0
#define DUP_SWEEP 0
#define DUP_STATES 0
#define DUP_FINAL 0
#define AMODE 0
#define FMODE 0
#define DUP_X1Q 0
#define DUP_ATTQ 0
#define DUP_X3Q 0

__device__ __forceinline__ int tidx() { int t = (int)threadIdx.x; asm volatile("" : "+v"(t)); return t; }

namespace pg8 {
#define PG8_LAS __attribute__((address_space(3)))
typedef unsigned short bf16_t;
typedef short bf16x8 __attribute__((ext_vector_type(8)));
typedef float f32x4 __attribute__((ext_vector_type(4)));
typedef unsigned u32x4 __attribute__((ext_vector_type(4)));
constexpr int BM = 256, BK = 64, HALF = 128, HTB = HALF * BK * 2  , STAGE_BYTES = 8 * HTB, NXCD = 8, WGM = 8;

__host__ __device__ __forceinline__ int lds_byte(int r, int c) { const int st = (r >> 4) * 2 + (c >> 5), rr = r & 15, cc = c & 31, ob = rr * 64 + cc * 2; return st * 1024 + (ob ^ (((ob >> 9) & 1) << 5)); }
__host__ __device__ __forceinline__ void stage_rc(int b, int& R, int& C) { const int st = b / 1024, sb = b % 1024, swz = sb ^ (((sb >> 9) & 1) << 5); R = (st >> 1) * 16 + swz / 64; C = (st & 1) * 32 + (swz % 64) / 2; }
__host__ __device__ __forceinline__ int perm32(int rho) { const int n = rho >> 4, i = rho & 15; return 8 * (i >> 2) + 4 * n + (i & 3); }

struct Unit { int pm, pn, ks; };
struct Gemm { const bf16_t* A; const bf16_t* Bt; int M, N, K, ld; };

struct Order {
    int nM, nN, nwg, G, c, skipctx;
    __device__ void init(int nM_, int nN_, int G_, int c_, int skip_) { nM = nM_; nN = nN_; nwg = nM * nN; G = G_; c = c_; skipctx = skip_; }
    __device__ bool next(int i, Unit& u) const {
        const long L = (long)i * G + c; if (L >= nwg) return false;
        int wgid = (int)L; { const int q = nwg / NXCD, r = nwg % NXCD, xcd = wgid % NXCD, off = wgid / NXCD; wgid = (xcd < r ? xcd * (q + 1) : r * (q + 1) + (xcd - r) * q) + off; }
        const int nig = WGM * nN, gid = wgid / nig, fm = gid * WGM, gsz = (nM - fm) < WGM ? (nM - fm) : WGM;
        int pm = fm + ((wgid % nig) % gsz); u.pn = (wgid % nig) / gsz;
        if (skipctx) pm = (pm >> 3) * 9 + 1 + (pm & 7);
        u.pm = pm; u.ks = 0; return true;
    }
    __device__ __forceinline__ void a_ready(const Unit&) const {}
    __device__ __forceinline__ void done(const Unit&) const {}
};
typedef __bf16 bf16x2_t __attribute__((ext_vector_type(2)));
typedef float f32x2_t __attribute__((ext_vector_type(2)));
struct TailOrder {
    int c, G;
    __device__ bool next(int i, Unit& u) const { const int L = i * G + c; if (L >= 256) return false; u.pm = 64 + (L >> 5); u.pn = (L >> 2) & 7; u.ks = L & 3; return true; }
    __device__ __forceinline__ void a_ready(const Unit&) const {}
    __device__ __forceinline__ void done(const Unit&) const {}
};
__device__ __forceinline__ unsigned cvt_pk_bf16(float lo, float hi) { f32x2_t v = {lo, hi}; bf16x2_t b = __builtin_convertvector(v, bf16x2_t); return __builtin_bit_cast(unsigned, b); }

template <class Epi, class Sched>
__device__ __forceinline__ void gemm_phase(PG8_LAS unsigned char* lds, const Gemm g, const Sched& S, const Epi& E) {
    const int tid = tidx(), wid = __builtin_amdgcn_readfirstlane(tid >> 6), lane = tid & 63, wr = wid >> 2, wc = wid & 3, fr = lane & 15, fq = lane >> 4;
    const int K = g.K, LD = g.ld, nt = K / BK;
    unsigned voffA[2], voffB[2];
#pragma unroll
    for (int i = 0; i < 2; ++i) { int R, C; stage_rc(tid * 16 + i * 8192, R, C); const int Rb = Epi::PERM ? ((R & ~31) + perm32(R & 31)) : R;
        voffA[i] = (unsigned)(R * LD + C) * 2u; voffB[i] = (unsigned)(Rb * LD + C) * 2u; }
    const size_t kstep = (size_t)(BK * 2);
    const size_t hstep = (size_t)HALF * LD * 2;
    const size_t tstep = 2 * hstep;
    const unsigned ldsw = (unsigned)wid * 1024u;
    const int aoff = lds_byte(wr * 64 + fr, fq * 8), boff = lds_byte(wc * 32 + fr, fq * 8);
#define PG8_SA(b, h) (((b) * 2 + (h)) * HTB)
#define PG8_SB(b, h) ((4 + (b) * 2 + (h)) * HTB)
#define PG8_STAGE(bufoff, gbase, voff) do { _Pragma("unroll") for (int _i = 0; _i < 2; ++_i) \
        __builtin_amdgcn_global_load_lds((const unsigned*)((const char*)(gbase) + (voff)[_i]), (PG8_LAS unsigned*)(lds + (bufoff) + ldsw + _i * 8192), 16, 0, 0); } while (0)
#define PG8_LDA(dst, b, h) do { _Pragma("unroll") for (int m = 0; m < 4; ++m) _Pragma("unroll") for (int k = 0; k < 2; ++k) dst[m][k] = *(const PG8_LAS bf16x8*)(lds + PG8_SA(b, h) + aoff + m * 2048 + k * 1024); } while (0)
#define PG8_LDB(dst, b, h) do { _Pragma("unroll") for (int n = 0; n < 2; ++n) _Pragma("unroll") for (int k = 0; k < 2; ++k) dst[n][k] = *(const PG8_LAS bf16x8*)(lds + PG8_SB(b, h) + boff + n * 2048 + k * 1024); } while (0)
#define PG8_MMA(ai, bj, At, Bt) do { __builtin_amdgcn_s_setprio(1); _Pragma("unroll") for (int m = 0; m < 4; ++m) _Pragma("unroll") for (int n = 0; n < 2; ++n) _Pragma("unroll") for (int k = 0; k < 2; ++k) \
        acc[ai][bj][m][n] = __builtin_amdgcn_mfma_f32_16x16x32_bf16(Bt[n][k], At[m][k], acc[ai][bj][m][n], 0, 0, 0); __builtin_amdgcn_s_setprio(0); } while (0)
#define PG8_WAIT_V(n) asm volatile("s_waitcnt vmcnt(" #n ")" ::: "memory")
#define PG8_WAIT_L(n) asm volatile("s_waitcnt lgkmcnt(" #n ")" ::: "memory")
#define PG8_BAR __builtin_amdgcn_s_barrier()
#define PG8_SCHED __builtin_amdgcn_sched_barrier(0)
    Unit cur, nxt; int ui = 0;
    if (!S.next(0, cur)) return;
    f32x4 acc[2][2][4][2];
#pragma unroll
    for (int a = 0; a < 2; ++a)
#pragma unroll
        for (int b = 0; b < 2; ++b)
#pragma unroll
            for (int m = 0; m < 4; ++m)
#pragma unroll
                for (int n = 0; n < 2; ++n) acc[a][b][m][n] = (f32x4){0.f, 0.f, 0.f, 0.f};
    bf16x8 At[4][2], B0[2][2], B1[2][2];
    const char* cA = (const char*)g.A + (size_t)cur.pm * tstep + (size_t)cur.ks * K * 2; const char* cB = (const char*)g.Bt + (size_t)cur.pn * tstep + (size_t)cur.ks * K * 2;
    S.a_ready(cur);
    PG8_STAGE(PG8_SB(0, 0), cB, voffB); PG8_STAGE(PG8_SA(0, 0), cA, voffA); PG8_STAGE(PG8_SB(0, 1), cB + hstep, voffB); PG8_STAGE(PG8_SA(0, 1), cA + hstep, voffA);
    if (wr == 1) PG8_BAR;
    PG8_WAIT_V(4); PG8_BAR;
    PG8_STAGE(PG8_SB(1, 0), cB + kstep, voffB); PG8_STAGE(PG8_SA(1, 0), cA + kstep, voffA); PG8_STAGE(PG8_SB(1, 1), cB + hstep + kstep, voffB);
    PG8_WAIT_V(6); PG8_BAR;
    for (;;) {
        const bool has_next = S.next(ui + 1, nxt);
        const char* nA = has_next ? (const char*)g.A + (size_t)nxt.pm * tstep + (size_t)nxt.ks * K * 2 : cA; const char* nB = has_next ? (const char*)g.Bt + (size_t)nxt.pn * tstep + (size_t)nxt.ks * K * 2 : cB;
        for (int t = 0; t < nt; t += 2) {
            const bool last = (t == nt - 2);
            const char* a1 = cA + (size_t)(t + 1) * kstep;
            const char* a2 = last ? nA : cA + (size_t)(t + 2) * kstep; const char* b2 = last ? nB : cB + (size_t)(t + 2) * kstep;
            const char* a3 = a2 + kstep; const char* b3 = b2 + kstep;
            if (last && has_next) S.a_ready(nxt);
            PG8_LDB(B0, 0, 0); PG8_SCHED; PG8_LDA(At, 0, 0); PG8_STAGE(PG8_SA(1, 1), a1 + hstep, voffA);
            PG8_WAIT_L(8); PG8_BAR; PG8_WAIT_L(0); PG8_MMA(0, 0, At, B0); PG8_BAR; PG8_SCHED;
            PG8_LDB(B1, 0, 1); PG8_STAGE(PG8_SB(0, 0), b2, voffB);
            PG8_BAR; PG8_WAIT_L(0); PG8_MMA(0, 1, At, B1); PG8_BAR;
            PG8_LDA(At, 0, 1); PG8_STAGE(PG8_SA(0, 0), a2, voffA);
            PG8_BAR; PG8_WAIT_L(0); PG8_MMA(1, 0, At, B0); PG8_BAR; PG8_SCHED;
            PG8_STAGE(PG8_SB(0, 1), b2 + hstep, voffB);
            PG8_WAIT_V(6); PG8_BAR; PG8_MMA(1, 1, At, B1); PG8_BAR;
            PG8_LDB(B0, 1, 0); PG8_SCHED; PG8_LDA(At, 1, 0); PG8_STAGE(PG8_SA(0, 1), a2 + hstep, voffA);
            PG8_WAIT_L(8); PG8_BAR; PG8_WAIT_L(0); PG8_MMA(0, 0, At, B0); PG8_BAR; PG8_SCHED;
            PG8_LDB(B1, 1, 1); PG8_STAGE(PG8_SB(1, 0), b3, voffB);
            PG8_BAR; PG8_WAIT_L(0); PG8_MMA(0, 1, At, B1); PG8_BAR;
            PG8_LDA(At, 1, 1); PG8_STAGE(PG8_SA(1, 0), a3, voffA);
            PG8_BAR; PG8_WAIT_L(0); PG8_MMA(1, 0, At, B0); PG8_BAR; PG8_SCHED;
            PG8_STAGE(PG8_SB(1, 1), b3 + hstep, voffB);
            PG8_WAIT_V(6); PG8_BAR; PG8_MMA(1, 1, At, B1); PG8_BAR;
        }
        if constexpr (!Epi::AFTER_DRAIN) { E(acc, cur, wr, wc, fr, fq); S.done(cur); }
        if (!has_next) break;
#pragma unroll
        for (int a = 0; a < 2; ++a)
#pragma unroll
            for (int b = 0; b < 2; ++b)
#pragma unroll
                for (int m = 0; m < 4; ++m)
#pragma unroll
                    for (int n = 0; n < 2; ++n) acc[a][b][m][n] = (f32x4){0.f, 0.f, 0.f, 0.f};
        cur = nxt; cA = nA; cB = nB; ++ui;
    }
    PG8_WAIT_V(0);
    if (wr == 0) PG8_BAR;
    PG8_BAR;
    if constexpr (Epi::AFTER_DRAIN) { E.fused(acc, cur, wr, wc, fr, fq, lds, wid, lane); S.done(cur); }
#undef PG8_SA
#undef PG8_SB
#undef PG8_STAGE
#undef PG8_LDA
#undef PG8_LDB
#undef PG8_MMA
#undef PG8_WAIT_V
#undef PG8_WAIT_L
#undef PG8_BAR
#undef PG8_SCHED
}
}

using pg8::bf16_t; using pg8::bf16x8; using pg8::f32x4; using pg8::cvt_pk_bf16;
typedef float f32x16 __attribute__((ext_vector_type(16)));
typedef float f32x8 __attribute__((ext_vector_type(8)));
typedef unsigned u32x2 __attribute__((ext_vector_type(2)));
typedef unsigned u32x4 __attribute__((ext_vector_type(4)));

constexpr int DM = 2048, TPB = 2304, NTOK = 18432, LDP = 7424, MIXW = 3072, NCH = 18;
constexpr int C_LX = 0, C_LG = 1024, C_Q = 2048, C_K = 3072, C_V = 3328, C_AG = 3584, C_XBC = 4608, C_Z = 6144, C_DT = 7168;
constexpr size_t SZ_WTIN = (size_t)4 * 7424 * 2048 * 2, SZ_WTOUT = (size_t)4 * 2048 * 3072 * 2, SZ_MOD = (size_t)4 * 9 * 6144 * 4, SZ_U = (size_t)NTOK * 2048 * 2,
                 SZ_P = (size_t)NTOK * LDP * 2, SZ_MIX = (size_t)NTOK * MIXW * 2, SZ_XB = (size_t)NTOK * 2048 * 4, SZ_ST = (size_t)8 * 2 * 18 * 16 * 8192 * 2,
                 SZ_AL = (size_t)8 * 2 * 18 * 16 * 4, SZ_SUM = (size_t)8 * 2 * 18 * 1024 * 4;
constexpr size_t OFF_WTIN = 0, OFF_WTOUT = OFF_WTIN + SZ_WTIN, OFF_MOD = OFF_WTOUT + SZ_WTOUT, OFF_U = OFF_MOD + SZ_MOD, OFF_P = OFF_U + SZ_U, OFF_MIX = OFF_P + SZ_P,
                 OFF_XB = OFF_MIX + SZ_MIX, OFF_ST = OFF_XB + SZ_XB, OFF_AL = OFF_ST + SZ_ST, OFF_SUMA = OFF_AL + SZ_AL, OFF_SUMB = OFF_SUMA + SZ_SUM, OFF_BAR = OFF_SUMB + SZ_SUM, OFF_SBC = OFF_BAR + 32768, OFF_SBT = OFF_SBC + (size_t)NTOK * 512 * 2, OFF_DTA = OFF_SBT + (size_t)8 * 18 * 2 * 16384 * 2,
                 OFF_ACS = OFF_DTA + (size_t)NTOK * 32 * 4, OFF_HINL = OFF_ACS + (size_t)NTOK * 32 * 4, OFF_GW = OFF_HINL + SZ_SUM, OFF_DTP = OFF_GW + (size_t)4 * 16 * 16384 * 2, OFF_VT = OFF_DTP + (size_t)NTOK * 16 * 4, WS_END = OFF_VT + (size_t)8 * 18 * 2 * 16384 * 2;
constexpr size_t OFF_LXC = OFF_U, OFF_SXT = OFF_U + (size_t)NTOK * 1024 * 2;
constexpr int LDS_CTL = 147456;
constexpr int LDS_BYTES = LDS_CTL + 16;

struct Params {
    const float *x, *c, *ctx, *c_ctx, *norm_w, *ada_w, *ada_b, *w_in, *lru_conv_w, *lru_conv_b, *lru_ga_w, *lru_ga_b, *lru_gx_w, *lru_gx_b, *lru_lambda,
        *att_q_norm, *att_k_norm, *att_sink, *ssd_conv_w, *ssd_conv_b, *ssd_dt_bias, *ssd_A_log, *ssd_D, *ssd_norm_w, *w_out;
    float* out;
    unsigned char* ws;
};
#define WS_WTIN(p) ((bf16_t*)((p).ws + OFF_WTIN))
#define WS_WTOUT(p) ((bf16_t*)((p).ws + OFF_WTOUT))
#define WS_MOD(p) ((float*)((p).ws + OFF_MOD))
#define WS_U(p) ((bf16_t*)((p).ws + OFF_U))
#define WS_P(p) ((bf16_t*)((p).ws + OFF_P))
#define WS_MIX(p) ((bf16_t*)((p).ws + OFF_MIX))
#define WS_XB(p) ((float*)((p).ws + OFF_XB))
#define WS_ST(p) ((bf16_t*)((p).ws + OFF_ST))
#define WS_AL(p) ((float*)((p).ws + OFF_AL))
#define WS_SUMA(p) ((float*)((p).ws + OFF_SUMA))
#define WS_SUMB(p) ((float*)((p).ws + OFF_SUMB))
#define WS_LXC(p) ((bf16_t*)((p).ws + OFF_LXC))
#define WS_SXT(p) ((bf16_t*)((p).ws + OFF_SXT))
#define WS_SBC(p) ((bf16_t*)((p).ws + OFF_SBC))
#define WS_SBT(p) ((bf16_t*)((p).ws + OFF_SBT))
#define WS_DTA(p) ((float*)((p).ws + OFF_DTA))
#define WS_ACS(p) ((float*)((p).ws + OFF_ACS))
#define WS_HINL(p) ((float*)((p).ws + OFF_HINL))
#define WS_GW(p) ((bf16_t*)((p).ws + OFF_GW))
#define WS_DTP(p) ((float*)((p).ws + OFF_DTP))
#define WS_VT(p) ((bf16_t*)((p).ws + OFF_VT))

__device__ __forceinline__ float bf2f(bf16_t v) { return __uint_as_float(((unsigned)v) << 16); }
__device__ __forceinline__ bf16_t f2bf(float f) { return (bf16_t)(cvt_pk_bf16(f, 0.f) & 0xffffu); }
__device__ __forceinline__ float siluf(float v) { return v * __builtin_amdgcn_rcpf(1.f + __expf(-v)); }
__device__ __forceinline__ float sigmf(float v) { return __builtin_amdgcn_rcpf(1.f + __expf(-v)); }
__device__ __forceinline__ float softplusf(float v) { return v > 20.f ? v : log1pf(__expf(v)); }
__device__ __forceinline__ float wave_sum(float v) {
#pragma unroll
    for (int o = 1; o < 64; o <<= 1) v += __shfl_xor(v, o);
    return v;
}
__device__ __forceinline__ f32x8 unpack8(const u32x4 w) {
    f32x8 f;
    f[0] = __uint_as_float(w.x << 16); f[1] = __uint_as_float(w.x & 0xffff0000u); f[2] = __uint_as_float(w.y << 16); f[3] = __uint_as_float(w.y & 0xffff0000u);
    f[4] = __uint_as_float(w.z << 16); f[5] = __uint_as_float(w.z & 0xffff0000u); f[6] = __uint_as_float(w.w << 16); f[7] = __uint_as_float(w.w & 0xffff0000u);
    return f;
}
__device__ __forceinline__ u32x4 pack8(const f32x8 f) { u32x4 w; w.x = cvt_pk_bf16(f[0], f[1]); w.y = cvt_pk_bf16(f[2], f[3]); w.z = cvt_pk_bf16(f[4], f[5]); w.w = cvt_pk_bf16(f[6], f[7]); return w; }
__device__ __forceinline__ void lds_barrier() { asm volatile("s_waitcnt lgkmcnt(0)" ::: "memory"); __builtin_amdgcn_s_barrier(); asm volatile("" ::: "memory"); }
__device__ __forceinline__ float dpp_f(float v, int ctrl_sel) {
    const int x = __builtin_bit_cast(int, v); int r;
    if (ctrl_sel == 0) r = __builtin_amdgcn_update_dpp(x, x, 0xB1, 0xF, 0xF, false);
    else if (ctrl_sel == 1) r = __builtin_amdgcn_update_dpp(x, x, 0x4E, 0xF, 0xF, false);
    else if (ctrl_sel == 2) r = __builtin_amdgcn_update_dpp(x, x, 0x141, 0xF, 0xF, false);
    else r = __builtin_amdgcn_update_dpp(x, x, 0x140, 0xF, 0xF, false);
    return __builtin_bit_cast(float, r);
}
__device__ __forceinline__ float row16_max(float v) { v = fmaxf(v, dpp_f(v, 0)); v = fmaxf(v, dpp_f(v, 1)); v = fmaxf(v, dpp_f(v, 2)); v = fmaxf(v, dpp_f(v, 3)); return v; }
__device__ __forceinline__ float row16_sum(float v) { v += dpp_f(v, 0); v += dpp_f(v, 1); v += dpp_f(v, 2); v += dpp_f(v, 3); return v; }
__device__ __forceinline__ int chunk_at(int d, int pos) { return d == 0 ? pos : (pos < 2 ? 1 - pos : 19 - pos); }
__device__ __forceinline__ int pos_of(int d, int c) { return d == 0 ? c : (c < 2 ? 1 - c : 19 - c); }
__device__ __forceinline__ int rowmap32(int reg, int lane) { return (reg & 3) + 8 * (reg >> 2) + 4 * (lane >> 5); }

template <int K> __device__ __forceinline__ void mm32(f32x16& acc, const bf16_t* A, int lda, const bf16_t* B, int ldb, int lane) {
    const bf16_t* pa = A + (lane & 31) * lda + 8 * (lane >> 5);
    const bf16_t* pb = B + (lane & 31) * ldb + 8 * (lane >> 5);
#pragma unroll
    for (int k = 0; k < K; k += 16) {
        const bf16x8 a = *(const bf16x8*)(pa + k);
        const bf16x8 b = *(const bf16x8*)(pb + k);
        acc = __builtin_amdgcn_mfma_f32_32x32x16_bf16(a, b, acc, 0, 0, 0);
    }
}

template <int NC, bool SILU, bool TRANS>
__device__ __forceinline__ void stage_conv_tile(bf16_t* dst, int ld, const bf16_t* Pb, int t0, int col0, const float* cw, int CS, const float* cb, int tid) {
    constexpr int CG = NC / 8;
    const int lo = t0 < 256 ? 0 : 256, hi = t0 < 256 ? 256 : TPB;
    for (int idx = tid; idx < 128 * CG; idx += 512) {
        int cgi, tl;
        if (TRANS) { tl = idx & 127; cgi = idx >> 7; } else { cgi = idx % CG; tl = idx / CG; }
        const int t = t0 + tl;
        const f32x4 b0 = *(const f32x4*)(cb + cgi * 8), b1 = *(const f32x4*)(cb + cgi * 8 + 4);
        f32x8 acc; acc[0] = b0.x; acc[1] = b0.y; acc[2] = b0.z; acc[3] = b0.w; acc[4] = b1.x; acc[5] = b1.y; acc[6] = b1.z; acc[7] = b1.w;
#pragma unroll
        for (int k = 0; k < 4; ++k) {
            const int tt = t - 2 + k;
            if (tt >= lo && tt < hi) {
                const f32x8 v = unpack8(*(const u32x4*)(Pb + (size_t)tt * LDP + col0 + cgi * 8));
                const f32x4 w0 = *(const f32x4*)(cw + k * CS + cgi * 8), w1 = *(const f32x4*)(cw + k * CS + cgi * 8 + 4);
                acc[0] += w0.x * v[0]; acc[1] += w0.y * v[1]; acc[2] += w0.z * v[2]; acc[3] += w0.w * v[3];
                acc[4] += w1.x * v[4]; acc[5] += w1.y * v[5]; acc[6] += w1.z * v[6]; acc[7] += w1.w * v[7];
            }
        }
        if (SILU) {
#pragma unroll
            for (int e = 0; e < 8; ++e) acc[e] = siluf(acc[e]);
        }
        if (TRANS) {
#pragma unroll
            for (int e = 0; e < 8; ++e) dst[(cgi * 8 + e) * ld + tl] = f2bf(acc[e]);
        } else {
            *(u32x4*)(dst + tl * ld + cgi * 8) = pack8(acc);
        }
    }
}

__device__ __forceinline__ void transpose_item(const float* W, int K, int N, int nblk, bf16_t* WT, float* scr, int item, int lane) {
    const int kb = item / nblk, nb = item % nblk, k0 = 64 * kb, n0 = 32 * nb;
    const int c4 = lane & 7, r8 = lane >> 3, n = n0 + c4 * 4;
    f32x4 tv[8];
#pragma unroll
    for (int i = 0; i < 8; ++i) tv[i] = (n < N) ? *(const f32x4*)(W + (size_t)(k0 + i * 8 + r8) * N + n) : (f32x4){0.f, 0.f, 0.f, 0.f};
#pragma unroll
    for (int i = 0; i < 8; ++i) { float* d = scr + (i * 8 + r8) * 33 + c4 * 4; d[0] = tv[i].x; d[1] = tv[i].y; d[2] = tv[i].z; d[3] = tv[i].w; }
    asm volatile("s_waitcnt lgkmcnt(0)" ::: "memory");
    const int c = lane & 7;
#pragma unroll
    for (int j = 0; j < 4; ++j) {
        const int nn = (lane >> 3) + 8 * j; const float* s = scr + (8 * c) * 33 + nn;
        u32x4 o; o.x = cvt_pk_bf16(s[0 * 33], s[1 * 33]); o.y = cvt_pk_bf16(s[2 * 33], s[3 * 33]); o.z = cvt_pk_bf16(s[4 * 33], s[5 * 33]); o.w = cvt_pk_bf16(s[6 * 33], s[7 * 33]);
        *(u32x4*)(WT + (size_t)(n0 + nn) * K + k0 + 8 * c) = o;
    }
    asm volatile("s_waitcnt lgkmcnt(0)" ::: "memory");
}

__device__ __forceinline__ void phase0(const Params& p, unsigned char* shm, int G) {
    const int tid = tidx(), lane = tid & 63, wave = tid >> 6;
    float* sf = (float*)shm;
    float* MOD = WS_MOD(p);
    typedef float f32x2m __attribute__((ext_vector_type(2)));
    for (int item = blockIdx.x; item < 192; item += G) {
        const int l = item / 48, cgp = item % 48;
        __syncthreads();
        for (int idx = tid; idx < 9 * 2048; idx += 512) { const int r = idx >> 11, k = idx & 2047; const float v = r < 8 ? p.c[r * 2048 + k] : p.c_ctx[k]; sf[idx] = siluf(v); }
        __syncthreads();
        f32x2m acc[9];
#pragma unroll
        for (int r = 0; r < 9; ++r) acc[r] = (f32x2m){0.f, 0.f};
        const float* wp = p.ada_w + ((size_t)l * 2048 + wave * 256) * 6144 + cgp * 128 + lane * 2;
#pragma unroll 8
        for (int kk = 0; kk < 256; ++kk) {
            const f32x2m wv = *(const f32x2m*)(wp + (size_t)kk * 6144);
            const int k = wave * 256 + kk;
#pragma unroll
            for (int r = 0; r < 9; ++r) { const float s = sf[r * 2048 + k]; acc[r] += wv * s; }
        }
        __syncthreads();
#pragma unroll
        for (int r = 0; r < 9; ++r) *(f32x2m*)(sf + (wave * 9 + r) * 128 + lane * 2) = acc[r];
        __syncthreads();
        for (int idx = tid; idx < 9 * 128; idx += 512) {
            const int r = idx >> 7, col = idx & 127; float s = p.ada_b[l * 6144 + cgp * 128 + col];
#pragma unroll
            for (int w = 0; w < 8; ++w) s += sf[(w * 9 + r) * 128 + col];
            MOD[(size_t)(l * 9 + r) * 6144 + cgp * 128 + col] = s;
        }
    }
    __syncthreads();
    float* scr = sf + wave * (64 * 33);
    const int gw = blockIdx.x * 8 + wave, NGW = G * 8;
    constexpr int I_IN = 32 * 232, I_OUT = 48 * 64;
    for (int it = gw; it < 4 * (I_IN + I_OUT); it += NGW) {
        if (it < 4 * I_IN) { const int l = it / I_IN, r = it % I_IN; transpose_item(p.w_in + (size_t)l * 2048 * 7184, 2048, 7184, 232, WS_WTIN(p) + (size_t)l * 7424 * 2048, scr, r, lane); }
        else { const int it2 = it - 4 * I_IN, l = it2 / I_OUT, r = it2 % I_OUT; transpose_item(p.w_out + (size_t)l * 3072 * 2048, 3072, 2048, 64, WS_WTOUT(p) + (size_t)l * 2048 * 3072, scr, r, lane); }
    }
    for (int idx = (int)blockIdx.x * 512 + tid; idx < 4 * 16 * 16384; idx += G * 512) {
        const int i = idx & 63, o = (idx >> 6) & 63, gate = (idx >> 12) & 1, d = (idx >> 13) & 1, j = (idx >> 14) & 15, l = idx >> 18;
        const float* w = gate ? p.lru_gx_w : p.lru_ga_w;
        WS_GW(p)[idx] = f2bf(w[(size_t)((l * 2 + d) * 16 + j) * 4096 + i * 64 + o]);
    }
}

__device__ __forceinline__ const float* xrow_src(const Params& p, int l, int row) {
    const int b = row / TPB, t = row % TPB;
    if (l == 0) return t < 256 ? p.ctx + ((size_t)b * 256 + t) * DM : p.x + ((size_t)b * 2048 + (t - 256)) * DM;
    return WS_XB(p) + (size_t)row * DM;
}
__device__ __forceinline__ void norm_phase(const Params& p, int l, int G) {
    const int lane = tidx() & 63, wave = tidx() >> 6;
    bf16_t* U = WS_U(p);
    const int gw = (int)blockIdx.x * 8 + wave, NW = G * 8;
    constexpr int R = 2;
#pragma unroll 1
    for (int base = gw; base < NTOK; base += NW * R) {
        f32x4 v[R][8];
#pragma unroll
        for (int u = 0; u < R; ++u) {
            const int row = base + u * NW;
            if (row < NTOK) {
                if (l >= 1 && row >= 16384) {
                    const float* xo = xrow_src(p, l - 1, row);
                    const float* gt = WS_MOD(p) + (size_t)((l - 1) * 9 + 7) * 6144 + 4096;
                    const float* pp = (const float*)WS_P(p) + (size_t)(row - 16384) * 2048;
                    float* xn = WS_XB(p) + (size_t)row * DM;
#pragma unroll
                    for (int j = 0; j < 8; ++j) {
                        const int col = 4 * lane + 256 * j;
                        const f32x4 s = (*(const f32x4*)(pp + col) + *(const f32x4*)(pp + (size_t)2048 * 2048 + col)) + (*(const f32x4*)(pp + (size_t)2 * 2048 * 2048 + col) + *(const f32x4*)(pp + (size_t)3 * 2048 * 2048 + col));
                        v[u][j] = *(const f32x4*)(xo + col) + *(const f32x4*)(gt + col) * s;
                        *(f32x4*)(xn + col) = v[u][j];
                    }
                } else {
                const float* src = xrow_src(p, l, row);
#pragma unroll
                for (int j = 0; j < 8; ++j) v[u][j] = *(const f32x4*)(src + 4 * lane + 256 * j);
                }
            }
        }
#pragma unroll
        for (int u = 0; u < R; ++u) {
            const int row = base + u * NW;
            if (row < NTOK) {
                const int b = row / TPB, t = row % TPB;
                const float* md = WS_MOD(p) + (size_t)(l * 9 + (t < 256 ? 8 : b)) * 6144;
                float ss = 0.f;
#pragma unroll
                for (int j = 0; j < 8; ++j) ss += v[u][j].x * v[u][j].x + v[u][j].y * v[u][j].y + v[u][j].z * v[u][j].z + v[u][j].w * v[u][j].w;
                ss = wave_sum(ss);
                const float rstd = rsqrtf(ss * (1.f / 2048.f) + 1e-6f);
#pragma unroll
                for (int j = 0; j < 8; ++j) {
                    const int col = 4 * lane + 256 * j;
                    const f32x4 nw = *(const f32x4*)(p.norm_w + l * 2048 + col), sh = *(const f32x4*)(md + col), sc = *(const f32x4*)(md + 2048 + col);
                    const f32x4 y = v[u][j] * rstd * nw * (sc + 1.f) + sh;
                    u32x2 w; w.x = cvt_pk_bf16(y.x, y.y); w.y = cvt_pk_bf16(y.z, y.w);
                    *(u32x2*)(U + (size_t)row * DM + col) = w;
                }
            }
        }
    }
}

struct EpiG1 {
    static constexpr bool PERM = true, AFTER_DRAIN = false;
    bf16_t* P;
    __device__ __forceinline__ void operator()(const f32x4 (&acc)[2][2][4][2], const pg8::Unit& u, int wr, int wc, int fr, int fq) const {
        const int row0 = u.pm * 256 + wr * 64 + fr, col0 = u.pn * 256 + wc * 32 + 8 * fq;
#pragma unroll
        for (int ai = 0; ai < 2; ++ai)
#pragma unroll
            for (int m = 0; m < 4; ++m) { bf16_t* rowp = P + (size_t)(row0 + ai * 128 + m * 16) * LDP + col0;
#pragma unroll
                for (int bj = 0; bj < 2; ++bj) { const f32x4 v0 = acc[ai][bj][m][0], v1 = acc[ai][bj][m][1];
                    u32x4 w; w.x = cvt_pk_bf16(v0.x, v0.y); w.y = cvt_pk_bf16(v0.z, v0.w); w.z = cvt_pk_bf16(v1.x, v1.y); w.w = cvt_pk_bf16(v1.z, v1.w);
                    *(u32x4*)(rowp + bj * 128) = w; } }
    }
};
struct EpiG2 {
    static constexpr bool PERM = true, AFTER_DRAIN = false;
    Params p; int l; int scr;
    __device__ __forceinline__ void operator()(const f32x4 (&acc)[2][2][4][2], const pg8::Unit& u, int wr, int wc, int fr, int fq) const {
        const int row0 = u.pm * 256 + wr * 64 + fr, col0 = u.pn * 256 + wc * 32 + 8 * fq;
        const int tb = (u.pm * 256) / TPB, tt0 = (u.pm * 256) % TPB;
        if (l == 3 && tt0 < 256) return;
        const float* gt = WS_MOD(p) + (size_t)(l * 9 + (tt0 < 256 ? 8 : tb)) * 6144 + 4096;
        f32x4 gv[4];
#pragma unroll
        for (int q = 0; q < 4; ++q) gv[q] = *(const f32x4*)(gt + col0 + (q >> 1) * 128 + (q & 1) * 4);
#pragma unroll
        for (int ai = 0; ai < 2; ++ai)
#pragma unroll
            for (int mp = 0; mp < 2; ++mp) {
                const float* xo[2]; float* dst[2];
#pragma unroll
                for (int h = 0; h < 2; ++h) {
                    const int row = row0 + ai * 128 + (2 * mp + h) * 16, t = row % TPB;
                    xo[h] = xrow_src(p, l, row);
                    dst[h] = scr ? (float*)WS_P(p) + (size_t)row * DM : (l == 3) ? p.out + ((size_t)tb * 2048 + (t - 256)) * DM : WS_XB(p) + (size_t)row * DM;
                }
                f32x4 xv[2][4];
#pragma unroll
                for (int h = 0; h < 2; ++h)
#pragma unroll
                    for (int q = 0; q < 4; ++q) xv[h][q] = *(const f32x4*)(xo[h] + col0 + (q >> 1) * 128 + (q & 1) * 4);
#pragma unroll
                for (int h = 0; h < 2; ++h)
#pragma unroll
                    for (int q = 0; q < 4; ++q) *(f32x4*)(dst[h] + col0 + (q >> 1) * 128 + (q & 1) * 4) = xv[h][q] + gv[q] * acc[ai][q >> 1][2 * mp + h][q & 1];
            }
    }
};

struct EpiPart {
    static constexpr bool PERM = true, AFTER_DRAIN = false;
    float* part;
    __device__ __forceinline__ void operator()(const f32x4 (&acc)[2][2][4][2], const pg8::Unit& u, int wr, int wc, int fr, int fq) const {
        const int row0 = (u.pm - 64) * 256 + wr * 64 + fr, col0 = u.pn * 256 + wc * 32 + 8 * fq;
        float* base = part + (size_t)u.ks * 2048 * 2048;
#pragma unroll
        for (int ai = 0; ai < 2; ++ai)
#pragma unroll
            for (int m = 0; m < 4; ++m) { float* rowp = base + (size_t)(row0 + ai * 128 + m * 16) * 2048 + col0;
#pragma unroll
                for (int bj = 0; bj < 2; ++bj) { *(f32x4*)(rowp + bj * 128) = acc[ai][bj][m][0]; *(f32x4*)(rowp + bj * 128 + 4) = acc[ai][bj][m][1]; } }
    }
};

template <int SCR>
__device__ __forceinline__ void qkprep_row(const Params& p, int l, int row, int lane) {
    const int t = row % TPB;
    bf16_t* rp = WS_P(p) + (size_t)row * LDP;
    float cs = 1.f, sn = 0.f;
    if (t >= 256) {
        const int s = t - 256, rr = s >> 6, cc = s & 63, f = lane & 31;
        const float inv = exp2f(-(float)f * (13.287712379549449f / 32.f));
        const float ang = (float)(lane < 32 ? rr : cc) * inv;
        cs = __cosf(ang); sn = __sinf(ang);
    }
    bf16_t r1[10], r2[10];
#pragma unroll
    for (int slot = 0; slot < 10; ++slot) { const int col = slot < 8 ? C_Q + slot * 128 : C_K + (slot - 8) * 128; r1[slot] = rp[col + lane]; r2[slot] = rp[col + 64 + lane]; }
#pragma unroll
    for (int slot = 0; slot < 10; ++slot) {
        const int col = slot < 8 ? C_Q + slot * 128 : C_K + (slot - 8) * 128;
        const float* w = slot < 8 ? p.att_q_norm + l * 128 : p.att_k_norm + l * 128;
        const float v1 = bf2f(r1[slot]), v2 = bf2f(r2[slot]);
        const float ss = wave_sum(v1 * v1 + v2 * v2);
        const float rstd = rsqrtf(ss * (1.f / 128.f) + 1e-6f);
        const float y1 = v1 * rstd * w[lane], y2 = v2 * rstd * w[64 + lane];
        float o1 = y1 * cs - y2 * sn, o2 = y1 * sn + y2 * cs;
        if (slot < 8) { o1 *= 0.08838834764831845f; o2 *= 0.08838834764831845f; }
        if (SCR) { bf16_t* sp = WS_ST(p) + (size_t)row * 1280 + slot * 128; sp[lane] = f2bf(o1); sp[64 + lane] = f2bf(o2); } else { rp[col + lane] = f2bf(o1); rp[col + 64 + lane] = f2bf(o2); }
    }
}

template <int D, int SCR = 0>
__device__ __forceinline__ void lru_sweep_item(const Params& p, int l, int item, unsigned char* shm) {
    const int tid = tidx(), lane = tid & 63, wave = tid >> 6, ch = tid & 63, seg = tid >> 6;
    const int j = item & 15, b = item >> 4;
    bf16_t* sX = (bf16_t*)shm; bf16_t* sW = (bf16_t*)(shm + 18432);
    float* sA = (float*)(shm + 36864); float* sB = (float*)(shm + 69632); float* sSA = (float*)(shm + 102400); float* sSB = (float*)(shm + 104448);
    bf16_t* sOut = (bf16_t*)(shm + 106496);
    const int mi = wave & 3, nj = wave >> 2, cl = nj * 32 + (lane & 31), cgl = j * 64 + cl;
    const float ba = p.lru_ga_b[(l * 2 + D) * 1024 + cgl], bx = p.lru_gx_b[(l * 2 + D) * 1024 + cgl], sp = softplusf(-p.lru_lambda[(l * 2 + D) * 1024 + cgl]);
    lds_barrier();
    {
        u32x4 wr2[2];
#pragma unroll
        for (int k = 0; k < 2; ++k) { const int idx = tid + k * 512; wr2[k] = *(const u32x4*)(WS_GW(p) + (size_t)(l * 16 + j) * 16384 + D * 8192 + idx * 8); }
#pragma unroll
        for (int k = 0; k < 2; ++k) { const int idx = tid + k * 512; *(u32x4*)(sW + (idx >> 3) * 72 + (idx & 7) * 8) = wr2[k]; }
    }
    u32x4 xr[2], lgr[2], hfr[2];
    {
        const size_t tok0 = (size_t)b * TPB + chunk_at(D, 0) * 128;
#pragma unroll
        for (int k = 0; k < 2; ++k) {
            const int idx = tid + k * 512;
            xr[k] = *(const u32x4*)(WS_LXC(p) + (tok0 + (idx >> 3)) * 1024 + j * 64 + (idx & 7) * 8);
            if (D == 1) { lgr[k] = *(const u32x4*)(WS_P(p) + (tok0 + (idx >> 3)) * LDP + C_LG + j * 64 + (idx & 7) * 8); hfr[k] = *(const u32x4*)(WS_MIX(p) + (tok0 + (idx >> 3)) * MIXW + j * 64 + (idx & 7) * 8); }
        }
    }
    float carry = 0.f;
#pragma unroll 1
    for (int pos = 0; pos < NCH; ++pos) {
        const size_t tok0 = (size_t)b * TPB + chunk_at(D, pos) * 128;
#pragma unroll
        for (int k = 0; k < 2; ++k) { const int idx = tid + k * 512; *(u32x4*)(sX + (idx >> 3) * 72 + (idx & 7) * 8) = xr[k]; }
        u32x4 lgc[2], hfc[2];
        if (D == 1) { lgc[0] = lgr[0]; lgc[1] = lgr[1]; hfc[0] = hfr[0]; hfc[1] = hfr[1]; }
        if (pos + 1 < NCH) {
            const size_t tokn = (size_t)b * TPB + chunk_at(D, pos + 1) * 128;
#pragma unroll
            for (int k = 0; k < 2; ++k) {
                const int idx = tid + k * 512;
                xr[k] = *(const u32x4*)(WS_LXC(p) + (tokn + (idx >> 3)) * 1024 + j * 64 + (idx & 7) * 8);
                if (D == 1) { lgr[k] = *(const u32x4*)(WS_P(p) + (tokn + (idx >> 3)) * LDP + C_LG + j * 64 + (idx & 7) * 8); hfr[k] = *(const u32x4*)(WS_MIX(p) + (tokn + (idx >> 3)) * MIXW + j * 64 + (idx & 7) * 8); }
            }
        }
        lds_barrier();
        {
            f32x16 ga, gx;
#pragma unroll
            for (int r = 0; r < 16; ++r) { ga[r] = 0.f; gx[r] = 0.f; }
            mm32<64>(ga, sX + mi * 32 * 72, 72, sW + (nj * 32) * 72, 72, lane);
            mm32<64>(gx, sX + mi * 32 * 72, 72, sW + (64 + nj * 32) * 72, 72, lane);
#pragma unroll
            for (int r = 0; r < 16; ++r) {
                const int tl = mi * 32 + rowmap32(r, lane);
                const float rg = sigmf(ga[r] + ba), ig = sigmf(gx[r] + bx);
                const float a = __expf(-8.f * rg * sp), mult = __builtin_amdgcn_sqrtf(fmaxf(1.f - a * a, 0.f));
                const float xv = bf2f(sX[tl * 72 + cl]);
                sA[tl * 64 + cl] = a; sB[tl * 64 + cl] = mult * ig * xv;
            }
        }
        lds_barrier();
        {
            float A = 1.f, Bc = 0.f;
#pragma unroll
            for (int q = 0; q < 16; ++q) { const int tl = seg * 16 + (D == 0 ? q : 15 - q); const float a = sA[tl * 64 + ch], bb = sB[tl * 64 + ch]; A = a * A; Bc = a * Bc + bb; }
            sSA[seg * 64 + ch] = A; sSB[seg * 64 + ch] = Bc;
        }
        lds_barrier();
        {
            float h = carry, cn = carry;
            const int myord = D == 0 ? seg : 7 - seg;
#pragma unroll
            for (int s = 0; s < 8; ++s) { const int sg = D == 0 ? s : 7 - s; const float a = sSA[sg * 64 + ch], bb = sSB[sg * 64 + ch]; cn = a * cn + bb; if (s < myord) h = cn; }
            carry = cn;
#pragma unroll
            for (int q = 0; q < 16; ++q) { const int tl = seg * 16 + (D == 0 ? q : 15 - q); h = sA[tl * 64 + ch] * h + sB[tl * 64 + ch]; sOut[tl * 72 + ch] = f2bf(h); }
        }
        lds_barrier();
#pragma unroll
        for (int k = 0; k < 2; ++k) {
            const int idx = tid + k * 512, rr = idx >> 3, ck = idx & 7;
            const u32x4 hv = *(const u32x4*)(sOut + rr * 72 + ck * 8);
            bf16_t* dst = SCR ? WS_P(p) + (tok0 + rr) * LDP + j * 64 + ck * 8 : WS_MIX(p) + (tok0 + rr) * MIXW + j * 64 + ck * 8;
            if (D == 0) *(u32x4*)dst = hv;
            else {
                const f32x8 a = unpack8(hv), f = unpack8(hfc[k]), g = unpack8(lgc[k]);
                f32x8 o;
#pragma unroll
                for (int e = 0; e < 8; ++e) o[e] = (a[e] + f[e]) * siluf(g[e]);
                *(u32x4*)dst = pack8(o);
            }
        }
    }
}

__device__ __forceinline__ void prep_elem(const Params& p, int l, int G) {
    const int gt = (int)blockIdx.x * 512 + tidx(), NT = G * 512;
    constexpr int NI = (NTOK / 4) * 192;
#pragma unroll 1
    for (int idx = gt; idx < NI; idx += NT) {
        const int tok = (idx / 192) * 4, cgi = idx % 192, b = tok / TPB, t = tok % TPB;
        const int lo = t < 256 ? 0 : 256, hi = t < 256 ? 256 : TPB;
        int col, CS, rs; const float *cw, *cb; bf16_t* dst; bool act;
        if (cgi < 128) { col = C_LX + cgi * 8; cw = p.lru_conv_w + l * 4096 + cgi * 8; CS = 1024; cb = p.lru_conv_b + l * 1024 + cgi * 8; act = false; dst = WS_LXC(p) + (size_t)tok * 1024 + cgi * 8; rs = 1024; }
        else { const int c2 = (cgi - 128) * 8; col = C_XBC + 1024 + c2; cw = p.ssd_conv_w + l * 6144 + 1024 + c2; CS = 1536; cb = p.ssd_conv_b + l * 1536 + 1024 + c2; act = true; dst = WS_SBC(p) + (size_t)tok * 512 + c2; rs = 512; }
        const bf16_t* src = WS_P(p) + (size_t)b * TPB * LDP + col;
        u32x4 raw[7];
#pragma unroll
        for (int r = 0; r < 7; ++r) { const int tt = t - 2 + r; raw[r] = (tt >= lo && tt < hi) ? *(const u32x4*)(src + (size_t)tt * LDP) : (u32x4){0u, 0u, 0u, 0u}; }
        const f32x4 b0 = *(const f32x4*)cb, b1 = *(const f32x4*)(cb + 4);
        f32x8 acc[4];
#pragma unroll
        for (int o = 0; o < 4; ++o) { acc[o][0] = b0.x; acc[o][1] = b0.y; acc[o][2] = b0.z; acc[o][3] = b0.w; acc[o][4] = b1.x; acc[o][5] = b1.y; acc[o][6] = b1.z; acc[o][7] = b1.w; }
#pragma unroll
        for (int k = 0; k < 4; ++k) {
            const f32x4 w0 = *(const f32x4*)(cw + k * CS), w1 = *(const f32x4*)(cw + k * CS + 4);
#pragma unroll
            for (int o = 0; o < 4; ++o) {
                const f32x8 v = unpack8(raw[o + k]);
                acc[o][0] += w0.x * v[0]; acc[o][1] += w0.y * v[1]; acc[o][2] += w0.z * v[2]; acc[o][3] += w0.w * v[3];
                acc[o][4] += w1.x * v[4]; acc[o][5] += w1.y * v[5]; acc[o][6] += w1.z * v[6]; acc[o][7] += w1.w * v[7];
            }
        }
#pragma unroll
        for (int o = 0; o < 4; ++o) {
            if (act) {
#pragma unroll
                for (int e = 0; e < 8; ++e) acc[o][e] = siluf(acc[o][e]);
            }
            *(u32x4*)(dst + (size_t)o * rs) = pack8(acc[o]);
        }
    }
}
struct PrepTile { int col0, ch0, t0, lo, hi, conv; const bf16_t* Pb; bf16_t* dst; };
__device__ __forceinline__ PrepTile prep_tile_decode(const Params& p, int item) {
    PrepTile T;
    const int t24 = item % 24, bc = item / 24, c = bc % NCH, b = bc / NCH;
    T.t0 = c * 128; T.Pb = WS_P(p) + (size_t)b * TPB * LDP; T.ch0 = 0; T.conv = t24 < 20;
    if (t24 < 16) { T.ch0 = t24 * 64; T.col0 = C_XBC + T.ch0; T.dst = WS_SXT(p) + ((size_t)((b * 18 + c) * 16 + t24)) * 8192; }
    else if (t24 < 20) { const int q = t24 - 16, g = q >> 1, nh = q & 1; T.ch0 = 1024 + g * 128 + nh * 64; T.col0 = C_XBC + T.ch0; T.dst = WS_SBT(p) + ((size_t)((b * 18 + c) * 2 + g)) * 16384 + (size_t)nh * 64 * 128; }
    else { const int q = t24 - 20, kh = q >> 1, dh = q & 1; T.col0 = C_V + kh * 128 + dh * 64; T.dst = WS_VT(p) + ((size_t)((b * 18 + c) * 2 + kh)) * 16384 + (size_t)dh * 64 * 128; }
    T.lo = T.t0 < 256 ? 0 : 256; T.hi = T.t0 < 256 ? 256 : TPB;
    return T;
}
__device__ __forceinline__ void prep_tile_load(const PrepTile& T, int tid, u32x4 (&raw)[2][4]) {
#pragma unroll
    for (int k = 0; k < 2; ++k) {
        const int idx = tid + k * 512, cgi = idx & 7, t = T.t0 + (idx >> 3);
#pragma unroll
        for (int q = 0; q < 4; ++q) {
            const int tt = T.conv ? t - 2 + q : t;
            const bool ok = T.conv ? (tt >= T.lo && tt < T.hi) : (q == 2);
            raw[k][q] = ok ? *(const u32x4*)(T.Pb + (size_t)tt * LDP + T.col0 + cgi * 8) : (u32x4){0u, 0u, 0u, 0u};
        }
    }
}
__device__ __forceinline__ void prep_tile_finish(const Params& p, int l, const PrepTile& T, int tid, const u32x4 (&raw)[2][4], unsigned char* shm) {
    bf16_t* sT = (bf16_t*)shm;
    const float* cw = p.ssd_conv_w + l * 6144 + T.ch0; const float* cb = p.ssd_conv_b + l * 1536 + T.ch0;
    lds_barrier();
#pragma unroll
    for (int k = 0; k < 2; ++k) {
        const int idx = tid + k * 512, cgi = idx & 7, tl = idx >> 3;
        f32x8 acc;
        if (T.conv) {
            const f32x4 b0 = *(const f32x4*)(cb + cgi * 8), b1 = *(const f32x4*)(cb + cgi * 8 + 4);
            acc[0] = b0.x; acc[1] = b0.y; acc[2] = b0.z; acc[3] = b0.w; acc[4] = b1.x; acc[5] = b1.y; acc[6] = b1.z; acc[7] = b1.w;
#pragma unroll
            for (int q = 0; q < 4; ++q) {
                const f32x8 v = unpack8(raw[k][q]);
                const f32x4 w0 = *(const f32x4*)(cw + q * 1536 + cgi * 8), w1 = *(const f32x4*)(cw + q * 1536 + cgi * 8 + 4);
                acc[0] += w0.x * v[0]; acc[1] += w0.y * v[1]; acc[2] += w0.z * v[2]; acc[3] += w0.w * v[3];
                acc[4] += w1.x * v[4]; acc[5] += w1.y * v[5]; acc[6] += w1.z * v[6]; acc[7] += w1.w * v[7];
            }
#pragma unroll
            for (int e = 0; e < 8; ++e) acc[e] = siluf(acc[e]);
        } else acc = unpack8(raw[k][2]);
#pragma unroll
        for (int e = 0; e < 8; ++e) sT[(cgi * 8 + e) * 130 + tl] = f2bf(acc[e]);
    }
    lds_barrier();
#pragma unroll
    for (int k = 0; k < 2; ++k) {
        const int idx = tid + k * 512, r = idx >> 4, ck = idx & 15;
        const unsigned* sp = (const unsigned*)(sT + r * 130 + ck * 8);
        u32x4 o; o.x = sp[0]; o.y = sp[1]; o.z = sp[2]; o.w = sp[3];
        *(u32x4*)(T.dst + r * 128 + ck * 8) = o;
    }
}
__device__ __forceinline__ void prep_tiles(const Params& p, int l, int bid, int G, unsigned char* shm) {
    const int tid = tidx();
    if (bid >= 3456) return;
    u32x4 raw[2][4], nraw[2][4];
    { const PrepTile T0 = prep_tile_decode(p, bid); prep_tile_load(T0, tid, raw); }
#pragma unroll 1
    for (int it = bid; it < 3456; it += G) {
        const bool more = it + G < 3456;
        if (more) { const PrepTile Tn = prep_tile_decode(p, it + G); prep_tile_load(Tn, tid, nraw); }
        { const PrepTile T = prep_tile_decode(p, it); prep_tile_finish(p, l, T, tid, raw, shm); }
        if (more) {
#pragma unroll
            for (int k = 0; k < 2; ++k)
#pragma unroll
                for (int q = 0; q < 4; ++q) raw[k][q] = nraw[k][q];
        }
    }
}
__device__ __forceinline__ void prep_dt_item(const Params& p, int l, int item) {
    const int tid = tidx();
    const int c = item % NCH, b = item / NCH;
    const int col32 = tid >> 4, h = col32 >> 1, d = col32 & 1, lane16 = tid & 15, seg = d == 0 ? lane16 : 15 - lane16;
    const float A = -__expf(p.ssd_A_log[(l * 2 + d) * 16 + h]), bias = p.ssd_dt_bias[(l * 2 + d) * 16 + h];
    const float* src = WS_DTP(p) + ((size_t)b * TPB + c * 128) * 16 + h;
    float dtv[8], cs[8], run = 0.f;
    float rawv[8];
#pragma unroll
    for (int q = 0; q < 8; ++q) { const int j = seg * 8 + (d == 0 ? q : 7 - q); rawv[q] = src[j * 16]; }
#pragma unroll
    for (int q = 0; q < 8; ++q) { dtv[q] = softplusf(rawv[q] + bias); run += dtv[q] * A; cs[q] = run; }
    float incl = run;
#pragma unroll
    for (int off = 1; off < 16; off <<= 1) { const float v = __shfl_up(incl, off, 16); if (lane16 >= off) incl += v; }
    const float excl = incl - run;
    float* dta = WS_DTA(p) + ((size_t)(b * 18 + c) * 128) * 32 + col32;
    float* acs = WS_ACS(p) + ((size_t)(b * 18 + c) * 128) * 32 + col32;
#pragma unroll
    for (int q = 0; q < 8; ++q) { const int j = seg * 8 + (d == 0 ? q : 7 - q); dta[j * 32] = dtv[q]; acs[j * 32] = cs[q] + excl; }
    if (lane16 == 15) WS_AL(p)[((b * 2 + d) * 18 + c) * 16 + h] = incl;
}
__device__ __forceinline__ void ssd_states_item(const Params& p, int l, int item, unsigned char* shm) {
    const int tid = tidx(), lane = tid & 63, wave = tid >> 6;
    const int g = item & 1, hh0 = ((item >> 1) & 1) * 4, bc = item >> 2, c = bc % NCH, b = bc / NCH;
    bf16_t* sBT = (bf16_t*)shm; bf16_t* sXw = (bf16_t*)(shm + 34816);
    float* sDt = (float*)(shm + 69632); float* sAcs = (float*)(shm + 77824); bf16_t* sO = (bf16_t*)(shm + 86016); float* sWg = (float*)(shm + 120832);
    const bf16_t* xt = WS_SXT(p) + ((size_t)((b * 18 + c) * 16 + g * 8)) * 8192;
    const bf16_t* btp = WS_SBT(p) + ((size_t)((b * 18 + c) * 2 + g)) * 16384;
    lds_barrier();
    {
        const size_t o = ((size_t)(b * 18 + c) * 128 + (tid >> 2)) * 32 + g * 16 + (tid & 3) * 4;
        const f32x4 vdt = *(const f32x4*)(WS_DTA(p) + o), vac = *(const f32x4*)(WS_ACS(p) + o);
        u32x4 bt[4];
#pragma unroll
        for (int k = 0; k < 4; ++k) { const int idx = tid + k * 512; bt[k] = *(const u32x4*)(btp + (idx >> 4) * 128 + (idx & 15) * 8); }
        *(f32x4*)(sDt + (tid >> 2) * 16 + (tid & 3) * 4) = vdt; *(f32x4*)(sAcs + (tid >> 2) * 16 + (tid & 3) * 4) = vac;
#pragma unroll
        for (int k = 0; k < 4; ++k) { const int idx = tid + k * 512; *(u32x4*)(sBT + (idx >> 4) * 136 + (idx & 15) * 8) = bt[k]; }
    }
    u32x4 xr[2];
#pragma unroll
    for (int k = 0; k < 2; ++k) { const int idx = tid + k * 512; xr[k] = *(const u32x4*)(xt + (size_t)hh0 * 8192 + (idx >> 4) * 128 + (idx & 15) * 8); }
    lds_barrier();
#pragma unroll
    for (int k = 0; k < 4; ++k) { const int idx = tid + k * 512, jj = idx >> 4, col = idx & 15; const float al = (col & 1) == 0 ? sAcs[127 * 16 + col] : sAcs[col]; sWg[col * 128 + jj] = __expf(al - sAcs[jj * 16 + col]) * sDt[jj * 16 + col]; }
#pragma unroll 1
    for (int hh = hh0; hh < hh0 + 4; ++hh) {
        const int h = g * 8 + hh;
        u32x4 xn[2] = {xr[0], xr[1]};
        if (hh < hh0 + 3) {
#pragma unroll
            for (int k = 0; k < 2; ++k) { const int idx = tid + k * 512; xn[k] = *(const u32x4*)(xt + (size_t)(hh + 1) * 8192 + (idx >> 4) * 128 + (idx & 15) * 8); }
        }
        lds_barrier();
#pragma unroll
        for (int k = 0; k < 2; ++k) {
            const int idx = tid + k * 512, pp = idx >> 4, j8 = (idx & 15) * 8;
            const f32x8 xv = unpack8(xr[k]);
#pragma unroll
            for (int d = 0; d < 2; ++d) {
                const f32x4 w0 = *(const f32x4*)(sWg + (hh * 2 + d) * 128 + j8), w1 = *(const f32x4*)(sWg + (hh * 2 + d) * 128 + j8 + 4);
                f32x8 o;
                o[0] = xv[0] * w0.x; o[1] = xv[1] * w0.y; o[2] = xv[2] * w0.z; o[3] = xv[3] * w0.w; o[4] = xv[4] * w1.x; o[5] = xv[5] * w1.y; o[6] = xv[6] * w1.z; o[7] = xv[7] * w1.w;
                *(u32x4*)(sXw + d * 8704 + pp * 136 + j8) = pack8(o);
            }
        }
        lds_barrier();
        const int mi = wave & 1, nj = wave >> 1;
#pragma unroll
        for (int d = 0; d < 2; ++d) {
            f32x16 acc;
#pragma unroll
            for (int r = 0; r < 16; ++r) acc[r] = 0.f;
            mm32<128>(acc, sXw + d * 8704 + mi * 32 * 136, 136, sBT + nj * 32 * 136, 136, lane);
#pragma unroll
            for (int r = 0; r < 16; ++r) sO[d * 8704 + (mi * 32 + rowmap32(r, lane)) * 136 + nj * 32 + (lane & 31)] = f2bf(acc[r]);
        }
        lds_barrier();
#pragma unroll
        for (int d = 0; d < 2; ++d) {
            bf16_t* base = WS_ST(p) + ((size_t)((b * 2 + d) * 18 + c) * 16 + h) * 8192;
#pragma unroll
            for (int k = 0; k < 2; ++k) { const int idx = tid + k * 512; *(u32x4*)(base + idx * 8) = *(const u32x4*)(sO + d * 8704 + (idx >> 4) * 136 + (idx & 15) * 8); }
        }
        xr[0] = xn[0]; xr[1] = xn[1];
    }
}
__device__ __forceinline__ void ssd_recur_item(const Params& p, int item) {
    const int tid = tidx();
    const int d = item & 1, h = (item >> 1) & 15, b = item >> 5;
    u32x4 s0[NCH], s1[NCH]; float ev[NCH];
#pragma unroll
    for (int pos = 0; pos < NCH; ++pos) {
        const int c = chunk_at(d, pos);
        const bf16_t* ptr = WS_ST(p) + ((size_t)((b * 2 + d) * 18 + c) * 16 + h) * 8192 + tid * 16;
        s0[pos] = *(const u32x4*)ptr; s1[pos] = *(const u32x4*)(ptr + 8);
        ev[pos] = WS_AL(p)[((b * 2 + d) * 18 + c) * 16 + h];
    }
    f32x8 h0, h1;
#pragma unroll
    for (int e = 0; e < 8; ++e) { h0[e] = 0.f; h1[e] = 0.f; }
#pragma unroll
    for (int pos = 0; pos < NCH; ++pos) {
        const int c = chunk_at(d, pos);
        bf16_t* ptr = WS_ST(p) + ((size_t)((b * 2 + d) * 18 + c) * 16 + h) * 8192 + tid * 16;
        *(u32x4*)ptr = pack8(h0); *(u32x4*)(ptr + 8) = pack8(h1);
        const float e = __expf(ev[pos]);
        h0 = h0 * e + unpack8(s0[pos]); h1 = h1 * e + unpack8(s1[pos]);
    }
}
template <int MODE>
__device__ __forceinline__ void ssd_final_item(const Params& p, int l, int item, unsigned char* shm) {
    const int tid = tidx(), lane = tid & 63, wave = tid >> 6;
    const int g = item & 1, hh0 = ((item >> 1) & 1) * 4, bc = item >> 2, c = bc % NCH, b = bc / NCH, t0 = c * 128;
    if (l == 3 && c < 2) return;
    const size_t tok0 = (size_t)b * TPB + t0;
    bf16_t* sC = (bf16_t*)shm; bf16_t* sBW = (bf16_t*)(shm + 34816); bf16_t* sXT = (bf16_t*)(shm + 69632); bf16_t* sH = (bf16_t*)(shm + 87040);
    float* sDt = (float*)(shm + 104448); float* sAcs = (float*)(shm + 112640);
    bf16_t* sY = sBW;
    const bf16_t* xt = WS_SXT(p) + ((size_t)((b * 18 + c) * 16 + g * 8)) * 8192;
    const bf16_t* zt = WS_P(p) + tok0 * LDP + C_Z + g * 512;
    const bf16_t* hin0 = WS_ST(p) + ((size_t)((b * 2 + 0) * 18 + c) * 16 + g * 8) * 8192;
    const bf16_t* hin1 = WS_ST(p) + ((size_t)((b * 2 + 1) * 18 + c) * 16 + g * 8) * 8192;
    lds_barrier();
    u32x4 xr[2], zr[2], h0r[2];
    {
        const size_t o = ((size_t)(b * 18 + c) * 128 + (tid >> 2)) * 32 + g * 16 + (tid & 3) * 4;
        const f32x4 vdt = *(const f32x4*)(WS_DTA(p) + o), vac = *(const f32x4*)(WS_ACS(p) + o);
        u32x4 cr[4], br[4];
#pragma unroll
        for (int k = 0; k < 4; ++k) { const int idx = tid + k * 512; const bf16_t* s = WS_SBC(p) + (tok0 + (idx >> 4)) * 512 + g * 128 + (idx & 15) * 8; br[k] = *(const u32x4*)s; cr[k] = *(const u32x4*)(s + 256); }
#pragma unroll
        for (int k = 0; k < 2; ++k) {
            const int idx = tid + k * 512;
            xr[k] = *(const u32x4*)(xt + (size_t)hh0 * 8192 + (idx >> 4) * 128 + (idx & 15) * 8);
            zr[k] = *(const u32x4*)(zt + (size_t)(idx >> 3) * LDP + hh0 * 64 + (idx & 7) * 8);
            h0r[k] = *(const u32x4*)(hin0 + (size_t)hh0 * 8192 + idx * 8);
        }
        *(f32x4*)(sDt + (tid >> 2) * 16 + (tid & 3) * 4) = vdt; *(f32x4*)(sAcs + (tid >> 2) * 16 + (tid & 3) * 4) = vac;
#pragma unroll
        for (int k = 0; k < 4; ++k) { const int idx = tid + k * 512; *(u32x4*)(sC + (idx >> 4) * 136 + (idx & 15) * 8) = cr[k]; *(u32x4*)(sBW + (idx >> 4) * 136 + (idx & 15) * 8) = br[k]; }
    }
    lds_barrier();
    const int cmi = wave >> 1, cnj0 = (wave & 1) * 2;
    f32x16 cb0, cb1;
#pragma unroll
    for (int r = 0; r < 16; ++r) { cb0[r] = 0.f; cb1[r] = 0.f; }
    mm32<128>(cb0, sC + cmi * 32 * 136, 136, sBW + cnj0 * 32 * 136, 136, lane);
    mm32<128>(cb1, sC + cmi * 32 * 136, 136, sBW + (cnj0 + 1) * 32 * 136, 136, lane);
    const int ymi = wave & 3, ynj = wave >> 2;
#pragma unroll 1
    for (int hh = hh0; hh < hh0 + 4; ++hh) {
        const int h = g * 8 + hh;
        lds_barrier();
#pragma unroll
        for (int k = 0; k < 2; ++k) { const int idx = tid + k * 512; *(u32x4*)(sXT + (idx >> 4) * 136 + (idx & 15) * 8) = xr[k]; *(u32x4*)(sH + (idx >> 4) * 136 + (idx & 15) * 8) = h0r[k]; }
        u32x4 h1r[2];
#pragma unroll
        for (int k = 0; k < 2; ++k) h1r[k] = *(const u32x4*)(hin1 + (size_t)hh * 8192 + (tid + k * 512) * 8);
        f32x16 yacc;
        const int colf = hh * 2, colr = hh * 2 + 1;
        if (MODE < 2) {
            float acif[16], acir[16];
#pragma unroll
            for (int r = 0; r < 16; ++r) { const int ig = cmi * 32 + rowmap32(r, lane); acif[r] = sAcs[ig * 16 + colf]; acir[r] = sAcs[ig * 16 + colr]; }
#pragma unroll
            for (int tt = 0; tt < 2; ++tt) {
                const int jg = (cnj0 + tt) * 32 + (lane & 31);
                const float acjf = sAcs[jg * 16 + colf], dtjf = sDt[jg * 16 + colf], acjr = sAcs[jg * 16 + colr], dtjr = sDt[jg * 16 + colr];
                const int dj0 = jg - cmi * 32 - 4 * (lane >> 5);
#pragma unroll
                for (int r = 0; r < 16; ++r) {
                    const int sd = dj0 - ((r & 3) + 8 * (r >> 2));
                    const bool fwd = sd <= 0;
                    const float arg = fwd ? acif[r] - acjf : acir[r] - acjr, sc = fwd ? dtjf : dtjr;
                    const float cbv = tt == 0 ? cb0[r] : cb1[r];
                    float val = cbv * __expf(arg) * sc;
                    val += sd == 0 ? cbv * dtjr : 0.f;
                    sBW[(cmi * 32 + rowmap32(r, lane)) * 136 + jg] = f2bf(val);
                }
            }
        }
        lds_barrier();
        {
            f32x16 ad, ao;
#pragma unroll
            for (int r = 0; r < 16; ++r) { ad[r] = 0.f; ao[r] = 0.f; }
            if (MODE < 3) { mm32<128>(ad, sBW + ymi * 32 * 136, 136, sXT + ynj * 32 * 136, 136, lane);
            mm32<128>(ao, sC + ymi * 32 * 136, 136, sH + ynj * 32 * 136, 136, lane); }
#pragma unroll
            for (int r = 0; r < 16; ++r) { const int ig = ymi * 32 + rowmap32(r, lane); yacc[r] = ad[r] + __expf(sAcs[ig * 16 + colf]) * ao[r]; }
        }
        if (hh < hh0 + 3) {
#pragma unroll
            for (int k = 0; k < 2; ++k) {
                const int idx = tid + k * 512;
                xr[k] = *(const u32x4*)(xt + (size_t)(hh + 1) * 8192 + (idx >> 4) * 128 + (idx & 15) * 8);
                h0r[k] = *(const u32x4*)(hin0 + (size_t)(hh + 1) * 8192 + idx * 8);
            }
        }
        lds_barrier();
#pragma unroll
        for (int k = 0; k < 2; ++k) { const int idx = tid + k * 512; *(u32x4*)(sH + (idx >> 4) * 136 + (idx & 15) * 8) = h1r[k]; }
        lds_barrier();
        {
            f32x16 ao;
#pragma unroll
            for (int r = 0; r < 16; ++r) ao[r] = 0.f;
            if (MODE < 3) mm32<128>(ao, sC + ymi * 32 * 136, 136, sH + ynj * 32 * 136, 136, lane);
#pragma unroll
            for (int r = 0; r < 16; ++r) { const int ig = ymi * 32 + rowmap32(r, lane); yacc[r] += __expf(sAcs[ig * 16 + colr]) * ao[r]; }
        }
        const float Dh = p.ssd_D[l * 16 + h];
        const int pl = ynj * 32 + (lane & 31);
#pragma unroll
        for (int r = 0; r < 16; ++r) { const int ig = ymi * 32 + rowmap32(r, lane); yacc[r] += Dh * bf2f(sXT[pl * 136 + ig]); }
        lds_barrier();
#pragma unroll
        for (int r = 0; r < 16; ++r) { const int ig = ymi * 32 + rowmap32(r, lane); sY[ig * 72 + pl] = f2bf(yacc[r]); }
        lds_barrier();
#pragma unroll
        for (int k = 0; k < 2; ++k) {
            const int idx = tid + k * 512, rr = idx >> 3, pk = idx & 7;
            const f32x8 yv = unpack8(*(const u32x4*)(sY + rr * 72 + pk * 8)), zv = unpack8(zr[k]);
            f32x8 o;
#pragma unroll
            for (int e = 0; e < 8; ++e) o[e] = yv[e] * siluf(zv[e]);
            if (MODE < 1) *(u32x4*)(WS_MIX(p) + (tok0 + rr) * MIXW + 2048 + h * 64 + pk * 8) = pack8(o); else asm volatile("" :: "v"(o[0]), "v"(o[7]));
        }
        if (hh < hh0 + 3) {
#pragma unroll
            for (int k = 0; k < 2; ++k) { const int idx = tid + k * 512; zr[k] = *(const u32x4*)(zt + (size_t)(idx >> 3) * LDP + (hh + 1) * 64 + (idx & 7) * 8); }
        }
    }
}
__device__ __forceinline__ void ssd_norm_phase(const Params& p, int l, int G) {
    const int lane = tidx() & 63, wave = tidx() >> 6;
    for (int row = blockIdx.x * 8 + wave; row < NTOK; row += G * 8) {
        bf16_t* rp = WS_MIX(p) + (size_t)row * MIXW + 2048;
        f32x8 v0 = unpack8(*(const u32x4*)(rp + lane * 8)), v1 = unpack8(*(const u32x4*)(rp + 512 + lane * 8));
        float ss = 0.f;
#pragma unroll
        for (int e = 0; e < 8; ++e) ss += v0[e] * v0[e] + v1[e] * v1[e];
        ss = wave_sum(ss);
        const float rstd = rsqrtf(ss * (1.f / 1024.f) + 1e-6f);
        const float* nw = p.ssd_norm_w + l * 1024;
#pragma unroll
        for (int e = 0; e < 8; ++e) { v0[e] = v0[e] * rstd * nw[lane * 8 + e]; v1[e] = v1[e] * rstd * nw[512 + lane * 8 + e]; }
        *(u32x4*)(rp + lane * 8) = pack8(v0); *(u32x4*)(rp + 512 + lane * 8) = pack8(v1);
    }
}

template <int MODE>
__device__ __forceinline__ void attn_item(const Params& p, int l, int item, unsigned char* shm) {
    const int tid = tidx(), lane = tid & 63, wave = tid >> 6, fr = lane & 15, fq = lane >> 4;
    const int hp = item & 3, bq = item >> 2, qblk = bq % NCH, b = bq / NCH, kh = hp >> 1;
    if (l == 3 && qblk < 2) return;
    const bf16_t* P = WS_P(p);
    bf16_t* sK = (bf16_t*)shm; bf16_t* sVT = (bf16_t*)(shm + 34816); bf16_t* sPw = (bf16_t*)(shm + 69632) + wave * (2 * 16 * 136);
    const size_t tokq0 = (size_t)b * TPB + qblk * 128;
    bf16x8 aq[2][4];
#pragma unroll
    for (int hd = 0; hd < 2; ++hd)
#pragma unroll
        for (int kk = 0; kk < 4; ++kk) aq[hd][kk] = *(const bf16x8*)(P + (tokq0 + wave * 16 + fr) * LDP + C_Q + (hp * 2 + hd) * 128 + kk * 32 + 8 * fq);
    float m[2][4], ls[2][4]; f32x4 O[2][8];
#pragma unroll
    for (int hd = 0; hd < 2; ++hd) {
        const float sink = p.att_sink[l * 8 + hp * 2 + hd];
#pragma unroll
        for (int r = 0; r < 4; ++r) { m[hd][r] = sink; ls[hd][r] = 1.f; }
#pragma unroll
        for (int nd = 0; nd < 8; ++nd) O[hd][nd] = (f32x4){0.f, 0.f, 0.f, 0.f};
    }
    const int nlat = qblk - 2;
    const int kb_lo = nlat - 1 < 0 ? 0 : nlat - 1, kb_hi = nlat + 1 > 15 ? 15 : nlat + 1;
    const int ntl = qblk < 2 ? 2 : 2 + (kb_hi - kb_lo + 1);
    u32x4 kr[4], vr[4];
    const bf16_t* vtb = WS_VT(p) + ((size_t)(b * 18) * 2 + kh) * 16384;
    {
        const bf16_t* kbase = P + ((size_t)b * TPB) * LDP + C_K + kh * 128;
#pragma unroll
        for (int k = 0; k < 4; ++k) { const int idx = tid + k * 512; kr[k] = *(const u32x4*)(kbase + (size_t)(idx >> 4) * LDP + (idx & 15) * 8); vr[k] = *(const u32x4*)(vtb + idx * 8); }
    }
#pragma unroll 1
    for (int ti = 0; ti < ntl; ++ti) {
        const bool masked = ti >= 2; const int kb = kb_lo + (ti - 2);
        lds_barrier();
#pragma unroll
        for (int k = 0; k < 4; ++k) {
            const int idx = tid + k * 512;
            *(u32x4*)(sK + (idx >> 4) * 136 + (idx & 15) * 8) = kr[k];
            *(u32x4*)(sVT + (idx >> 4) * 136 + (idx & 15) * 8) = vr[k];
        }
        if (ti + 1 < ntl) {
            const int tn = ti + 1, t0n = tn < 2 ? tn * 128 : 256 + (kb_lo + (tn - 2)) * 128;
            const bf16_t* kbase = P + ((size_t)b * TPB + t0n) * LDP + C_K + kh * 128;
            const bf16_t* vtn = vtb + (size_t)(t0n >> 7) * 32768;
#pragma unroll
            for (int k = 0; k < 4; ++k) { const int idx = tid + k * 512; kr[k] = *(const u32x4*)(kbase + (size_t)(idx >> 4) * LDP + (idx & 15) * 8); vr[k] = *(const u32x4*)(vtn + idx * 8); }
        }
        lds_barrier();
#pragma unroll 1
        for (int hf = 0; hf < 2; ++hf) {
            f32x4 s[2][4];
#pragma unroll
            for (int nt = 0; nt < 4; ++nt) {
                s[0][nt] = (f32x4){0.f, 0.f, 0.f, 0.f}; s[1][nt] = (f32x4){0.f, 0.f, 0.f, 0.f};
#pragma unroll
                for (int kk = 0; kk < 4; ++kk) {
                    const bf16x8 bk = *(const bf16x8*)(sK + ((hf * 4 + nt) * 16 + fr) * 136 + kk * 32 + 8 * fq);
                    s[0][nt] = __builtin_amdgcn_mfma_f32_16x16x32_bf16(aq[0][kk], bk, s[0][nt], 0, 0, 0);
                    s[1][nt] = __builtin_amdgcn_mfma_f32_16x16x32_bf16(aq[1][kk], bk, s[1][nt], 0, 0, 0);
                }
                __builtin_amdgcn_sched_barrier(0);
            }
            if (masked) {
#pragma unroll
                for (int nt = 0; nt < 4; ++nt)
#pragma unroll
                    for (int r = 0; r < 4; ++r) { const int rel = (nlat * 128 + wave * 16 + fq * 4 + r) - (kb * 128 + (hf * 4 + nt) * 16 + fr); if (rel > 128 || rel < -128) { s[0][nt][r] = -INFINITY; s[1][nt][r] = -INFINITY; } }
            }
#pragma unroll
            for (int hd = 0; hd < 2; ++hd) {
                float alpha[4];
#pragma unroll
                for (int r = 0; r < 4; ++r) {
                    float mx = fmaxf(fmaxf(s[hd][0][r], s[hd][1][r]), fmaxf(s[hd][2][r], s[hd][3][r]));
                    mx = row16_max(mx);
                    const float mn = fmaxf(m[hd][r], mx);
                    alpha[r] = __expf(m[hd][r] - mn); m[hd][r] = mn;
                    float rs = 0.f;
#pragma unroll
                    for (int nt = 0; nt < 4; ++nt) { const float pv = __expf(s[hd][nt][r] - mn); s[hd][nt][r] = pv; rs += pv; }
                    rs = row16_sum(rs);
                    ls[hd][r] = ls[hd][r] * alpha[r] + rs;
                }
#pragma unroll
                for (int nd = 0; nd < 8; ++nd) { O[hd][nd].x *= alpha[0]; O[hd][nd].y *= alpha[1]; O[hd][nd].z *= alpha[2]; O[hd][nd].w *= alpha[3]; }
#pragma unroll
                for (int nt = 0; nt < 4; ++nt)
#pragma unroll
                    for (int r = 0; r < 4; ++r) sPw[hd * (16 * 136) + (fq * 4 + r) * 136 + nt * 16 + fr] = f2bf(s[hd][nt][r]);
            }
            asm volatile("s_waitcnt lgkmcnt(0)" ::: "memory");
#pragma unroll
            for (int kk = 0; kk < 2; ++kk) {
                const bf16x8 ap0 = *(const bf16x8*)(sPw + fr * 136 + kk * 32 + 8 * fq);
                const bf16x8 ap1 = *(const bf16x8*)(sPw + 16 * 136 + fr * 136 + kk * 32 + 8 * fq);
#pragma unroll
                for (int nd = 0; nd < 8; ++nd) {
                    const bf16x8 bv = *(const bf16x8*)(sVT + (nd * 16 + fr) * 136 + hf * 64 + kk * 32 + 8 * fq);
                    O[0][nd] = __builtin_amdgcn_mfma_f32_16x16x32_bf16(ap0, bv, O[0][nd], 0, 0, 0);
                    O[1][nd] = __builtin_amdgcn_mfma_f32_16x16x32_bf16(ap1, bv, O[1][nd], 0, 0, 0);
                    if (nd == 3) __builtin_amdgcn_sched_barrier(0);
                }
                __builtin_amdgcn_sched_barrier(0);
            }
            asm volatile("s_waitcnt lgkmcnt(0)" ::: "memory");
        }
    }
#pragma unroll
    for (int hd = 0; hd < 2; ++hd) {
        const int hq = hp * 2 + hd;
        u32x4 agr[4];
#pragma unroll
        for (int k = 0; k < 4; ++k) { const int idx = tid + k * 512; agr[k] = *(const u32x4*)(P + (tokq0 + (idx >> 4)) * LDP + C_AG + hq * 128 + (idx & 15) * 8); }
        lds_barrier();
#pragma unroll
        for (int r = 0; r < 4; ++r) {
            const float il = __builtin_amdgcn_rcpf(ls[hd][r]);
#pragma unroll
            for (int nd = 0; nd < 8; ++nd) sK[(wave * 16 + fq * 4 + r) * 136 + nd * 16 + fr] = f2bf(O[hd][nd][r] * il);
        }
        lds_barrier();
#pragma unroll
        for (int k = 0; k < 4; ++k) {
            const int idx = tid + k * 512, rr = idx >> 4, ck = idx & 15;
            const f32x8 ov = unpack8(*(const u32x4*)(sK + rr * 136 + ck * 8)), gv = unpack8(agr[k]);
            f32x8 o;
#pragma unroll
            for (int e = 0; e < 8; ++e) o[e] = ov[e] * siluf(gv[e]);
            *(u32x4*)(WS_MIX(p) + (tokq0 + rr) * MIXW + 1024 + hq * 128 + ck * 8) = pack8(o);
        }
    }
}

#define XB_TMO      128
#define XB_XCNT(j)  (256  + 64 * (j))
#define XB_XSUB(j)  (1280 + 64 * (j))
#define XB_XGEN(j)  (2304 + 64 * (j))
#define XB_TOP      3328
#define XB_TOPGEN   3392
#define XCD_BAR_WORDS 3456
#define XB_SPIN_CAP (1u << 18)
#define LAS __attribute__((address_space(3)))
__device__ __forceinline__ unsigned xb_ld(unsigned* p)              { return __hip_atomic_load(p, __ATOMIC_RELAXED, __HIP_MEMORY_SCOPE_AGENT); }
__device__ __forceinline__ unsigned xb_add(unsigned* p, unsigned v) { return __hip_atomic_fetch_add(p, v, __ATOMIC_RELAXED, __HIP_MEMORY_SCOPE_AGENT); }
__device__ __forceinline__ unsigned xb_xcc_id() { return (unsigned)__builtin_amdgcn_s_getreg((3 << 11) | 20) & 0xFu; }
#define XB_SPIN(cond, bar) do { unsigned _sp = 0; while (cond) { __builtin_amdgcn_s_sleep(1); \
    if ((++_sp & 255u) == 0u) { if (xb_ld(&(bar)[XB_TMO])) break; if (_sp > XB_SPIN_CAP) { atomicAdd(&(bar)[XB_TMO], 1u); break; } } } } while (0)
struct XcdBarrier { unsigned* bar; unsigned x; volatile LAS unsigned* st; };
__device__ __forceinline__ XcdBarrier xcd_barrier_post(unsigned* bar, volatile LAS unsigned* st) {
    XcdBarrier b; b.bar = bar; b.x = xb_xcc_id(); b.st = st;
    if (tidx() == 0) (void)xb_add(&bar[XB_XCNT(b.x)], 1u);
    return b;
}
__device__ __forceinline__ void xcd_barrier_complete(unsigned* bar, unsigned x, unsigned& nloc, unsigned& nx) {
    const unsigned G = gridDim.x * gridDim.y * gridDim.z;
    unsigned sum, cnt, mine, sp = 0u;
    for (;;) {
        sum = 0u; cnt = 0u; mine = 0u;
#pragma unroll
        for (unsigned j = 0; j < 16; ++j) { const unsigned c = xb_ld(&bar[XB_XCNT(j)]); sum += c; cnt += (c > 0u) ? 1u : 0u; mine = (j == x) ? c : mine; }
        if (sum == G) break;
        __builtin_amdgcn_s_sleep(1);
        if ((++sp & 255u) == 0u) { if (xb_ld(&bar[XB_TMO])) break; if (sp > XB_SPIN_CAP) { atomicAdd(&bar[XB_TMO], 1u); break; } }
    }
    nloc = mine > 0u ? mine : 1u; nx = cnt > 0u ? cnt : 1u;
}
__device__ __forceinline__ void xcd_barrier(const XcdBarrier& b) {
    asm volatile("s_waitcnt vmcnt(0)" ::: "memory");
    __syncthreads();
    if (tidx() == 0) {
        unsigned* bar = b.bar;
        __builtin_amdgcn_s_waitcnt(0);
        unsigned nloc = b.st[0], nx = b.st[1];
        if (nloc == 0u) { xcd_barrier_complete(bar, b.x, nloc, nx); b.st[0] = nloc; b.st[1] = nx; }
        const unsigned old = xb_add(&bar[XB_XSUB(b.x)], 1u);
        const unsigned gen = old / nloc;
        if (old + 1u == (gen + 1u) * nloc) {
            __builtin_amdgcn_fence(__ATOMIC_RELEASE, "agent");
            asm volatile("s_waitcnt vmcnt(0)" ::: "memory");
            const unsigned og = xb_add(&bar[XB_TOP], 1u);
            const unsigned tg = og / nx;
            if (og + 1u == (tg + 1u) * nx) xb_add(&bar[XB_TOPGEN], 1u);
            else XB_SPIN(xb_ld(&bar[XB_TOPGEN]) == tg, bar);
            __builtin_amdgcn_fence(__ATOMIC_ACQUIRE, "agent");
            xb_add(&bar[XB_XGEN(b.x)], 1u);
            asm volatile("s_waitcnt vmcnt(0)" ::: "memory");
        } else {
            XB_SPIN(xb_ld(&bar[XB_XGEN(b.x)]) == gen, bar);
            __builtin_amdgcn_fence(__ATOMIC_ACQUIRE, "agent");
            asm volatile("s_waitcnt vmcnt(0)" ::: "memory");
        }
    }
    __syncthreads();
}


#define QUEUE_LOOP(ctr, NITEMS, BODY) do { \
    volatile LAS unsigned* _mb = (volatile LAS unsigned*)(shm + LDS_CTL + 8); \
    int it = bid; \
    while (it < (NITEMS)) { \
        unsigned _nx = 0u; if (tidx() == 0) _nx = xb_add((ctr), 1u) + (unsigned)G; \
        BODY; \
        __syncthreads(); \
        if (tidx() == 0) _mb[0] = _nx; \
        __syncthreads(); \
        it = (int)_mb[0]; \
    } } while (0)

__global__ __launch_bounds__(512) void mega(Params p) {
    extern __shared__ __attribute__((aligned(16))) unsigned char shm[];
    cg::grid_group grid = cg::this_grid();
    const int G = (int)gridDim.x, bid = (int)blockIdx.x;
    if (tidx() < 4) ((volatile LAS unsigned*)(shm + LDS_CTL))[tidx()] = 0u;
    __syncthreads();
    unsigned* qctr = (unsigned*)(p.ws + OFF_BAR) + 3584;
    const XcdBarrier xb = xcd_barrier_post((unsigned*)(p.ws + OFF_BAR), (volatile LAS unsigned*)(shm + LDS_CTL));
    for (int rep = 0; rep < 1 + DUP_P0; ++rep) phase0(p, shm, G);
    grid.sync();
#pragma unroll 1
    for (int l = 0; l < 4; ++l) {
        for (int rep = 0; rep < 1 + DUP_NORM; ++rep) norm_phase(p, l, G);
        xcd_barrier(xb);
        {
            pg8::Gemm g{WS_U(p), WS_WTIN(p) + (size_t)l * 7424 * 2048, NTOK, 7168, 2048, 2048};
            pg8::Order S; S.init(72, 28, G, bid, 0);
            EpiG1 E{WS_P(p)};
            for (int rep = 0; rep < 1 + DUP_G1; ++rep) pg8::gemm_phase<EpiG1, pg8::Order>((PG8_LAS unsigned char*)shm, g, S, E);
            {
                const int tq = tidx(), wave = tq >> 6, lane = tq & 63, fr = lane & 15, fq = lane >> 4;
                for (int wu = bid * 8 + wave; wu < NTOK / 16; wu += G * 8) {
                    const bf16_t* ap = WS_U(p) + (size_t)(wu * 16 + fr) * 2048 + 8 * fq;
                    const bf16_t* bp = WS_WTIN(p) + ((size_t)l * 7424 + 7168 + fr) * 2048 + 8 * fq;
                    f32x4 acc = (f32x4){0.f, 0.f, 0.f, 0.f};
#pragma unroll 8
                    for (int kk = 0; kk < 64; ++kk) { const bf16x8 a = *(const bf16x8*)(ap + kk * 32), bq = *(const bf16x8*)(bp + kk * 32); acc = __builtin_amdgcn_mfma_f32_16x16x32_bf16(a, bq, acc, 0, 0, 0); }
#pragma unroll
                    for (int r = 0; r < 4; ++r) WS_DTP(p)[(size_t)(wu * 16 + fq * 4 + r) * 16 + fr] = acc[r];
                }
            }
        }
        for (int rep = 0; rep < 1 + DUP_SYNC; ++rep) xcd_barrier(xb);
        for (int rep = 0; rep < 1 + DUP_E1; ++rep) {
            if (rep == 0 || E1SEL == 0 || E1SEL == 1) for (int it = bid; it < 144; it += G) prep_dt_item(p, l, it);
            if (rep == 0 || E1SEL == 0 || E1SEL == 2) { __syncthreads(); prep_tiles(p, l, bid, G, shm); }
            if (rep == 0 || E1SEL == 0 || E1SEL == 3) prep_elem(p, l, G);
        }
        { const int tq = tidx(), wave = tq >> 6, lane = tq & 63; for (int row = bid * 8 + wave; row < NTOK; row += G * 8) qkprep_row<0>(p, l, row, lane);
#if DUP_QK
          for (int row = bid * 8 + wave; row < NTOK; row += G * 8) qkprep_row<1>(p, l, row, lane);
#endif
        }
        xcd_barrier(xb);
        QUEUE_LOOP(qctr + (l * 3 + 0) * 64, 128 + 576, { if (it < 128) lru_sweep_item<0>(p, l, it, shm); else ssd_states_item(p, l, it - 128, shm); });
#if DUP_X1Q
        __syncthreads(); QUEUE_LOOP(qctr + (12 + l * 3 + 0) * 64, 128 + 576, { if (it < 128) lru_sweep_item<0>(p, l, it, shm); else ssd_states_item(p, l, it - 128, shm); });
#endif
#if DUP_SWEEP
        __syncthreads(); for (int it = bid; it < 128; it += G) lru_sweep_item<0>(p, l, it, shm);
#endif
#if DUP_STATES
        __syncthreads(); for (int it = bid; it < 256; it += G) ssd_states_item(p, l, it, shm);
#endif
        xcd_barrier(xb);
        QUEUE_LOOP(qctr + (l * 3 + 1) * 64, 576 + 256, { if (it < 576) attn_item<0>(p, l, it, shm); else ssd_recur_item(p, it - 576); });
#if DUP_ATTQ
        __syncthreads(); QUEUE_LOOP(qctr + (12 + l * 3 + 1) * 64, 576, { attn_item<AMODE>(p, l, it, shm); });
#endif
        xcd_barrier(xb);
        QUEUE_LOOP(qctr + (l * 3 + 2) * 64, 128 + 576, { if (it < 128) lru_sweep_item<1>(p, l, it, shm); else ssd_final_item<0>(p, l, it - 128, shm); });
#if DUP_FINAL
        __syncthreads(); for (int it = bid; it < 256; it += G) ssd_final_item<FMODE>(p, l, it, shm);
#endif
#if DUP_SWEEP1
        __syncthreads(); for (int it = bid; it < 128; it += G) lru_sweep_item<1, 1>(p, l, it, shm);
#endif
        xcd_barrier(xb);
#ifndef SK_X4
        ssd_norm_phase(p, l, G);
#endif
        xcd_barrier(xb);
        {
            pg8::Gemm g{WS_MIX(p), WS_WTOUT(p) + (size_t)l * 2048 * 3072, NTOK, 2048, 3072, 3072};
            pg8::Order S; S.init(64, 8, G, bid, l == 3 ? 1 : 0);
            EpiG2 E{p, l, 0};
#if DUP_G2
            { EpiG2 E2{p, l, 1}; pg8::gemm_phase<EpiG2, pg8::Order>((PG8_LAS unsigned char*)shm, g, S, E2); }
#endif
#ifndef SK_G2
            pg8::gemm_phase<EpiG2, pg8::Order>((PG8_LAS unsigned char*)shm, g, S, E);
#endif
        }
        if (l < 3) {
            pg8::Gemm gt{WS_MIX(p), WS_WTOUT(p) + (size_t)l * 2048 * 3072, NTOK, 2048, 768, 3072};
            pg8::TailOrder St{bid, G};
            EpiPart Et{(float*)WS_P(p)};
            pg8::gemm_phase<EpiPart, pg8::TailOrder>((PG8_LAS unsigned char*)shm, gt, St, Et);
            xcd_barrier(xb);
        }
    }
}

extern "C" void kernel_launch(void* const* d_in, const int* in_sizes, int n_in, void* d_out, int out_size, void* d_ws, size_t ws_size, hipStream_t stream) {
    static int grid = 0;
    if (grid == 0) {
        if (n_in != 25 || ws_size < WS_END) { fprintf(stderr, "kernel_launch: need 25 inputs and %zu bytes of workspace (got %d, %zu)\n", (size_t)WS_END, n_in, ws_size); grid = -1; return; }
        int dev = 0, cus = 0, per_cu = 0;
        hipGetDevice(&dev);
        hipDeviceGetAttribute(&cus, hipDeviceAttributeMultiprocessorCount, dev);
        if (hipFuncSetAttribute((const void*)mega, hipFuncAttributeMaxDynamicSharedMemorySize, LDS_BYTES) != hipSuccess) { fprintf(stderr, "kernel_launch: hipFuncSetAttribute failed\n"); grid = -1; return; }
        if (hipOccupancyMaxActiveBlocksPerMultiprocessor(&per_cu, (const void*)mega, 512, LDS_BYTES) != hipSuccess || per_cu < 1) { fprintf(stderr, "kernel_launch: occupancy query gave %d\n", per_cu); per_cu = 1; }
        (void)hipGetLastError();
        grid = cus * 1;
        if (grid <= 0) grid = 256;
    }
    if (grid < 0) return;
    Params p{};
    const float** pf = (const float**)&p;
    for (int i = 0; i < 25; ++i) pf[i] = (const float*)d_in[i];
    p.out = (float*)d_out; p.ws = (unsigned char*)d_ws;
    if (hipMemsetAsync((char*)d_ws + OFF_BAR, 0, 32768, stream) != hipSuccess) { fprintf(stderr, "kernel_launch: memset of barrier words failed\n"); return; }
    void* args[] = {&p};
    hipError_t e = hipLaunchCooperativeKernel((const void*)mega, dim3(grid), dim3(512), args, LDS_BYTES, stream);
    if (e != hipSuccess) fprintf(stderr, "cooperative launch failed: %s (grid %d)\n", hipGetErrorString(e), grid);
}
```

```cpp
#include <hip/hip_runtime.h>
#include <hip/hip_cooperative_groups.h>
#include <cstdio>
#include <cstdint>
namespace cg = cooperative_groups;
#define DUP_X1A 0
#define DUP_X1B 0
#define DUP_ATT 0
#define DUP_X3A 0
#define DUP_X3B 0
#define DUP_G1 0
#define DUP_P0 0
#define DUP_NORM 0
#define DUP_SYNC 0
#define DUP_E1 0
#define DUP_SWEEP1 0
#define DUP_G2 0
#define DUP_QK 0
#define E1SEL 0
#define DUP_SWEEP 0
#define DUP_STATES 0
#define DUP_FINAL 0
#define AMODE 0
#define FMODE 0
#define DUP_X1Q 0
#define DUP_ATTQ 0
#define DUP_X3Q 0

__device__ __forceinline__ int tidx() { int t = (int)threadIdx.x; asm volatile("" : "+v"(t)); return t; }

namespace pg8 {
#define PG8_LAS __attribute__((address_space(3)))
typedef unsigned short bf16_t;
typedef short bf16x8 __attribute__((ext_vector_type(8)));
typedef float f32x4 __attribute__((ext_vector_type(4)));
typedef unsigned u32x4 __attribute__((ext_vector_type(4)));
constexpr int BM = 256, BK = 64, HALF = 128, HTB = HALF * BK * 2  , STAGE_BYTES = 8 * HTB, NXCD = 8, WGM = 8;

__host__ __device__ __forceinline__ int lds_byte(int r, int c) { const int st = (r >> 4) * 2 + (c >> 5), rr = r & 15, cc = c & 31, ob = rr * 64 + cc * 2; return st * 1024 + (ob ^ (((ob >> 9) & 1) << 5)); }
__host__ __device__ __forceinline__ void stage_rc(int b, int& R, int& C) { const int st = b / 1024, sb = b % 1024, swz = sb ^ (((sb >> 9) & 1) << 5); R = (st >> 1) * 16 + swz / 64; C = (st & 1) * 32 + (swz % 64) / 2; }
__host__ __device__ __forceinline__ int perm32(int rho) { const int n = rho >> 4, i = rho & 15; return 8 * (i >> 2) + 4 * n + (i & 3); }

struct Unit { int pm, pn, ks; };
struct Gemm { const bf16_t* A; const bf16_t* Bt; int M, N, K, ld; };

struct Order {
    int nM, nN, nwg, G, c, skipctx;
    __device__ void init(int nM_, int nN_, int G_, int c_, int skip_) { nM = nM_; nN = nN_; nwg = nM * nN; G = G_; c = c_; skipctx = skip_; }
    __device__ bool next(int i, Unit& u) const {
        const long L = (long)i * G + c; if (L >= nwg) return false;
        int wgid = (int)L; { const int q = nwg / NXCD, r = nwg % NXCD, xcd = wgid % NXCD, off = wgid / NXCD; wgid = (xcd < r ? xcd * (q + 1) : r * (q + 1) + (xcd - r) * q) + off; }
        const int nig = WGM * nN, gid = wgid / nig, fm = gid * WGM, gsz = (nM - fm) < WGM ? (nM - fm) : WGM;
        int pm = fm + ((wgid % nig) % gsz); u.pn = (wgid % nig) / gsz;
        if (skipctx) pm = (pm >> 3) * 9 + 1 + (pm & 7);
        u.pm = pm; u.ks = 0; return true;
    }
    __device__ __forceinline__ void a_ready(const Unit&) const {}
    __device__ __forceinline__ void done(const Unit&) const {}
};
typedef __bf16 bf16x2_t __attribute__((ext_vector_type(2)));
typedef float f32x2_t __attribute__((ext_vector_type(2)));
struct TailOrder {
    int c, G;
    __device__ bool next(int i, Unit& u) const { const int L = i * G + c; if (L >= 256) return false; u.pm = 64 + (L >> 5); u.pn = (L >> 2) & 7; u.ks = L & 3; return true; }
    __device__ __forceinline__ void a_ready(const Unit&) const {}
    __device__ __forceinline__ void done(const Unit&) const {}
};
__device__ __forceinline__ unsigned cvt_pk_bf16(float lo, float hi) { f32x2_t v = {lo, hi}; bf16x2_t b = __builtin_convertvector(v, bf16x2_t); return __builtin_bit_cast(unsigned, b); }

template <class Epi, class Sched>
__device__ __forceinline__ void gemm_phase(PG8_LAS unsigned char* lds, const Gemm g, const Sched& S, const Epi& E) {
    const int tid = tidx(), wid = __builtin_amdgcn_readfirstlane(tid >> 6), lane = tid & 63, wr = wid >> 2, wc = wid & 3, fr = lane & 15, fq = lane >> 4;
    const int K = g.K, LD = g.ld, nt = K / BK;
    unsigned voffA[2], voffB[2];
#pragma unroll
    for (int i = 0; i < 2; ++i) { int R, C; stage_rc(tid * 16 + i * 8192, R, C); const int Rb = Epi::PERM ? ((R & ~31) + perm32(R & 31)) : R;
        voffA[i] = (unsigned)(R * LD + C) * 2u; voffB[i] = (unsigned)(Rb * LD + C) * 2u; }
    const size_t kstep = (size_t)(BK * 2);
    const size_t hstep = (size_t)HALF * LD * 2;
    const size_t tstep = 2 * hstep;
    const unsigned ldsw = (unsigned)wid * 1024u;
    const int aoff = lds_byte(wr * 64 + fr, fq * 8), boff = lds_byte(wc * 32 + fr, fq * 8);
#define PG8_SA(b, h) (((b) * 2 + (h)) * HTB)
#define PG8_SB(b, h) ((4 + (b) * 2 + (h)) * HTB)
#define PG8_STAGE(bufoff, gbase, voff) do { _Pragma("unroll") for (int _i = 0; _i < 2; ++_i) \
        __builtin_amdgcn_global_load_lds((const unsigned*)((const char*)(gbase) + (voff)[_i]), (PG8_LAS unsigned*)(lds + (bufoff) + ldsw + _i * 8192), 16, 0, 0); } while (0)
#define PG8_LDA(dst, b, h) do { _Pragma("unroll") for (int m = 0; m < 4; ++m) _Pragma("unroll") for (int k = 0; k < 2; ++k) dst[m][k] = *(const PG8_LAS bf16x8*)(lds + PG8_SA(b, h) + aoff + m * 2048 + k * 1024); } while (0)
#define PG8_LDB(dst, b, h) do { _Pragma("unroll") for (int n = 0; n < 2; ++n) _Pragma("unroll") for (int k = 0; k < 2; ++k) dst[n][k] = *(const PG8_LAS bf16x8*)(lds + PG8_SB(b, h) + boff + n * 2048 + k * 1024); } while (0)
#define PG8_MMA(ai, bj, At, Bt) do { __builtin_amdgcn_s_setprio(1); _Pragma("unroll") for (int m = 0; m < 4; ++m) _Pragma("unroll") for (int n = 0; n < 2; ++n) _Pragma("unroll") for (int k = 0; k < 2; ++k) \
        acc[ai][bj][m][n] = __builtin_amdgcn_mfma_f32_16x16x32_bf16(Bt[n][k], At[m][k], acc[ai][bj][m][n], 0, 0, 0); __builtin_amdgcn_s_setprio(0); } while (0)
#define PG8_WAIT_V(n) asm volatile("s_waitcnt vmcnt(" #n ")" ::: "memory")
#define PG8_WAIT_L(n) asm volatile("s_waitcnt lgkmcnt(" #n ")" ::: "memory")
#define PG8_BAR __builtin_amdgcn_s_barrier()
#define PG8_SCHED __builtin_amdgcn_sched_barrier(0)
    Unit cur, nxt; int ui = 0;
    if (!S.next(0, cur)) return;
    f32x4 acc[2][2][4][2];
#pragma unroll
    for (int a = 0; a < 2; ++a)
#pragma unroll
        for (int b = 0; b < 2; ++b)
#pragma unroll
            for (int m = 0; m < 4; ++m)
#pragma unroll
                for (int n = 0; n < 2; ++n) acc[a][b][m][n] = (f32x4){0.f, 0.f, 0.f, 0.f};
    bf16x8 At[4][2], B0[2][2], B1[2][2];
    const char* cA = (const char*)g.A + (size_t)cur.pm * tstep + (size_t)cur.ks * K * 2; const char* cB = (const char*)g.Bt + (size_t)cur.pn * tstep + (size_t)cur.ks * K * 2;
    S.a_ready(cur);
    PG8_STAGE(PG8_SB(0, 0), cB, voffB); PG8_STAGE(PG8_SA(0, 0), cA, voffA); PG8_STAGE(PG8_SB(0, 1), cB + hstep, voffB); PG8_STAGE(PG8_SA(0, 1), cA + hstep, voffA);
    if (wr == 1) PG8_BAR;
    PG8_WAIT_V(4); PG8_BAR;
    PG8_STAGE(PG8_SB(1, 0), cB + kstep, voffB); PG8_STAGE(PG8_SA(1, 0), cA + kstep, voffA); PG8_STAGE(PG8_SB(1, 1), cB + hstep + kstep, voffB);
    PG8_WAIT_V(6); PG8_BAR;
    for (;;) {
        const bool has_next = S.next(ui + 1, nxt);
        const char* nA = has_next ? (const char*)g.A + (size_t)nxt.pm * tstep + (size_t)nxt.ks * K * 2 : cA; const char* nB = has_next ? (const char*)g.Bt + (size_t)nxt.pn * tstep + (size_t)nxt.ks * K * 2 : cB;
        for (int t = 0; t < nt; t += 2) {
            const bool last = (t == nt - 2);
            const char* a1 = cA + (size_t)(t + 1) * kstep;
            const char* a2 = last ? nA : cA + (size_t)(t + 2) * kstep; const char* b2 = last ? nB : cB + (size_t)(t + 2) * kstep;
            const char* a3 = a2 + kstep; const char* b3 = b2 + kstep;
            if (last && has_next) S.a_ready(nxt);
            PG8_LDB(B0, 0, 0); PG8_SCHED; PG8_LDA(At, 0, 0); PG8_STAGE(PG8_SA(1, 1), a1 + hstep, voffA);
            PG8_WAIT_L(8); PG8_BAR; PG8_WAIT_L(0); PG8_MMA(0, 0, At, B0); PG8_BAR; PG8_SCHED;
            PG8_LDB(B1, 0, 1); PG8_STAGE(PG8_SB(0, 0), b2, voffB);
            PG8_BAR; PG8_WAIT_L(0); PG8_MMA(0, 1, At, B1); PG8_BAR;
            PG8_LDA(At, 0, 1); PG8_STAGE(PG8_SA(0, 0), a2, voffA);
            PG8_BAR; PG8_WAIT_L(0); PG8_MMA(1, 0, At, B0); PG8_BAR; PG8_SCHED;
            PG8_STAGE(PG8_SB(0, 1), b2 + hstep, voffB);
            PG8_WAIT_V(6); PG8_BAR; PG8_MMA(1, 1, At, B1); PG8_BAR;
            PG8_LDB(B0, 1, 0); PG8_SCHED; PG8_LDA(At, 1, 0); PG8_STAGE(PG8_SA(0, 1), a2 + hstep, voffA);
            PG8_WAIT_L(8); PG8_BAR; PG8_WAIT_L(0); PG8_MMA(0, 0, At, B0); PG8_BAR; PG8_SCHED;
            PG8_LDB(B1, 1, 1); PG8_STAGE(PG8_SB(1, 0), b3, voffB);
            PG8_BAR; PG8_WAIT_L(0); PG8_MMA(0, 1, At, B1); PG8_BAR;
            PG8_LDA(At, 1, 1); PG8_STAGE(PG8_SA(1, 0), a3, voffA);
            PG8_BAR; PG8_WAIT_L(0); PG8_MMA(1, 0, At, B0); PG8_BAR; PG8_SCHED;
            PG8_STAGE(PG8_SB(1, 1), b3 + hstep, voffB);
            PG8_WAIT_V(6); PG8_BAR; PG8_MMA(1, 1, At, B1); PG8_BAR;
        }
        if constexpr (!Epi::AFTER_DRAIN) { E(acc, cur, wr, wc, fr, fq); S.done(cur); }
        if (!has_next) break;
#pragma unroll
        for (int a = 0; a < 2; ++a)
#pragma unroll
            for (int b = 0; b < 2; ++b)
#pragma unroll
                for (int m = 0; m < 4; ++m)
#pragma unroll
                    for (int n = 0; n < 2; ++n) acc[a][b][m][n] = (f32x4){0.f, 0.f, 0.f, 0.f};
        cur = nxt; cA = nA; cB = nB; ++ui;
    }
    PG8_WAIT_V(0);
    if (wr == 0) PG8_BAR;
    PG8_BAR;
    if constexpr (Epi::AFTER_DRAIN) { E.fused(acc, cur, wr, wc, fr, fq, lds, wid, lane); S.done(cur); }
#undef PG8_SA
#undef PG8_SB
#undef PG8_STAGE
#undef PG8_LDA
#undef PG8_LDB
#undef PG8_MMA
#undef PG8_WAIT_V
#undef PG8_WAIT_L
#undef PG8_BAR
#undef PG8_SCHED
}
}

using pg8::bf16_t; using pg8::bf16x8; using pg8::f32x4; using pg8::cvt_pk_bf16;
typedef float f32x16 __attribute__((ext_vector_type(16)));
typedef float f32x8 __attribute__((ext_vector_type(8)));
typedef unsigned u32x2 __attribute__((ext_vector_type(2)));
typedef unsigned u32x4 __attribute__((ext_vector_type(4)));

constexpr int DM = 2048, TPB = 2304, NTOK = 18432, LDP = 7424, MIXW = 3072, NCH = 18;
constexpr int C_LX = 0, C_LG = 1024, C_Q = 2048, C_K = 3072, C_V = 3328, C_AG = 3584, C_XBC = 4608, C_Z = 6144, C_DT = 7168;
constexpr size_t SZ_WTIN = (size_t)4 * 7424 * 2048 * 2, SZ_WTOUT = (size_t)4 * 2048 * 3072 * 2, SZ_MOD = (size_t)4 * 9 * 6144 * 4, SZ_U = (size_t)NTOK * 2048 * 2,
                 SZ_P = (size_t)NTOK * LDP * 2, SZ_MIX = (size_t)NTOK * MIXW * 2, SZ_XB = (size_t)NTOK * 2048 * 4, SZ_ST = (size_t)8 * 2 * 18 * 16 * 8192 * 2,
                 SZ_AL = (size_t)8 * 2 * 18 * 16 * 4, SZ_SUM = (size_t)8 * 2 * 18 * 1024 * 4;
constexpr size_t OFF_WTIN = 0, OFF_WTOUT = OFF_WTIN + SZ_WTIN, OFF_MOD = OFF_WTOUT + SZ_WTOUT, OFF_U = OFF_MOD + SZ_MOD, OFF_P = OFF_U + SZ_U, OFF_MIX = OFF_P + SZ_P,
                 OFF_XB = OFF_MIX + SZ_MIX, OFF_ST = OFF_XB + SZ_XB, OFF_AL = OFF_ST + SZ_ST, OFF_SUMA = OFF_AL + SZ_AL, OFF_SUMB = OFF_SUMA + SZ_SUM, OFF_BAR = OFF_SUMB + SZ_SUM, OFF_SBC = OFF_BAR + 32768, OFF_SBT = OFF_SBC + (size_t)NTOK * 512 * 2, OFF_DTA = OFF_SBT + (size_t)8 * 18 * 2 * 16384 * 2,
                 OFF_ACS = OFF_DTA + (size_t)NTOK * 32 * 4, OFF_HINL = OFF_ACS + (size_t)NTOK * 32 * 4, OFF_GW = OFF_HINL + SZ_SUM, OFF_DTP = OFF_GW + (size_t)4 * 16 * 16384 * 2, OFF_VT = OFF_DTP + (size_t)NTOK * 16 * 4, WS_END = OFF_VT + (size_t)8 * 18 * 2 * 16384 * 2;
constexpr size_t OFF_LXC = OFF_U, OFF_SXT = OFF_U + (size_t)NTOK * 1024 * 2;
constexpr int LDS_CTL = 147456;
constexpr int LDS_BYTES = LDS_CTL + 16;

struct Params {
    const float *x, *c, *ctx, *c_ctx, *norm_w, *ada_w, *ada_b, *w_in, *lru_conv_w, *lru_conv_b, *lru_ga_w, *lru_ga_b, *lru_gx_w, *lru_gx_b, *lru_lambda,
        *att_q_norm, *att_k_norm, *att_sink, *ssd_conv_w, *ssd_conv_b, *ssd_dt_bias, *ssd_A_log, *ssd_D, *ssd_norm_w, *w_out;
    float* out;
    unsigned char* ws;
};
#define WS_WTIN(p) ((bf16_t*)((p).ws + OFF_WTIN))
#define WS_WTOUT(p) ((bf16_t*)((p).ws + OFF_WTOUT))
#define WS_MOD(p) ((float*)((p).ws + OFF_MOD))
#define WS_U(p) ((bf16_t*)((p).ws + OFF_U))
#define WS_P(p) ((bf16_t*)((p).ws + OFF_P))
#define WS_MIX(p) ((bf16_t*)((p).ws + OFF_MIX))
#define WS_XB(p) ((float*)((p).ws + OFF_XB))
#define WS_ST(p) ((bf16_t*)((p).ws + OFF_ST))
#define WS_AL(p) ((float*)((p).ws + OFF_AL))
#define WS_SUMA(p) ((float*)((p).ws + OFF_SUMA))
#define WS_SUMB(p) ((float*)((p).ws + OFF_SUMB))
#define WS_LXC(p) ((bf16_t*)((p).ws + OFF_LXC))
#define WS_SXT(p) ((bf16_t*)((p).ws + OFF_SXT))
#define WS_SBC(p) ((bf16_t*)((p).ws + OFF_SBC))
#define WS_SBT(p) ((bf16_t*)((p).ws + OFF_SBT))
#define WS_DTA(p) ((float*)((p).ws + OFF_DTA))
#define WS_ACS(p) ((float*)((p).ws + OFF_ACS))
#define WS_HINL(p) ((float*)((p).ws + OFF_HINL))
#define WS_GW(p) ((bf16_t*)((p).ws + OFF_GW))
#define WS_DTP(p) ((float*)((p).ws + OFF_DTP))
#define WS_VT(p) ((bf16_t*)((p).ws + OFF_VT))

__device__ __forceinline__ float bf2f(bf16_t v) { return __uint_as_float(((unsigned)v) << 16); }
__device__ __forceinline__ bf16_t f2bf(float f) { return (bf16_t)(cvt_pk_bf16(f, 0.f) & 0xffffu); }
__device__ __forceinline__ float siluf(float v) { return v * __builtin_amdgcn_rcpf(1.f + __expf(-v)); }
__device__ __forceinline__ float sigmf(float v) { return __builtin_amdgcn_rcpf(1.f + __expf(-v)); }
__device__ __forceinline__ float softplusf(float v) { return v > 20.f ? v : log1pf(__expf(v)); }
__device__ __forceinline__ float wave_sum(float v) {
#pragma unroll
    for (int o = 1; o < 64; o <<= 1) v += __shfl_xor(v, o);
    return v;
}
__device__ __forceinline__ f32x8 unpack8(const u32x4 w) {
    f32x8 f;
    f[0] = __uint_as_float(w.x << 16); f[1] = __uint_as_float(w.x & 0xffff0000u); f[2] = __uint_as_float(w.y << 16); f[3] = __uint_as_float(w.y & 0xffff0000u);
    f[4] = __uint_as_float(w.z << 16); f[5] = __uint_as_float(w.z & 0xffff0000u); f[6] = __uint_as_float(w.w << 16); f[7] = __uint_as_float(w.w & 0xffff0000u);
    return f;
}
__device__ __forceinline__ u32x4 pack8(const f32x8 f) { u32x4 w; w.x = cvt_pk_bf16(f[0], f[1]); w.y = cvt_pk_bf16(f[2], f[3]); w.z = cvt_pk_bf16(f[4], f[5]); w.w = cvt_pk_bf16(f[6], f[7]); return w; }
__device__ __forceinline__ void lds_barrier() { asm volatile("s_waitcnt lgkmcnt(0)" ::: "memory"); __builtin_amdgcn_s_barrier(); asm volatile("" ::: "memory"); }
__device__ __forceinline__ float dpp_f(float v, int ctrl_sel) {
    const int x = __builtin_bit_cast(int, v); int r;
    if (ctrl_sel == 0) r = __builtin_amdgcn_update_dpp(x, x, 0xB1, 0xF, 0xF, false);
    else if (ctrl_sel == 1) r = __builtin_amdgcn_update_dpp(x, x, 0x4E, 0xF, 0xF, false);
    else if (ctrl_sel == 2) r = __builtin_amdgcn_update_dpp(x, x, 0x141, 0xF, 0xF, false);
    else r = __builtin_amdgcn_update_dpp(x, x, 0x140, 0xF, 0xF, false);
    return __builtin_bit_cast(float, r);
}
__device__ __forceinline__ float row16_max(float v) { v = fmaxf(v, dpp_f(v, 0)); v = fmaxf(v, dpp_f(v, 1)); v = fmaxf(v, dpp_f(v, 2)); v = fmaxf(v, dpp_f(v, 3)); return v; }
__device__ __forceinline__ float row16_sum(float v) { v += dpp_f(v, 0); v += dpp_f(v, 1); v += dpp_f(v, 2); v += dpp_f(v, 3); return v; }
__device__ __forceinline__ int chunk_at(int d, int pos) { return d == 0 ? pos : (pos < 2 ? 1 - pos : 19 - pos); }
__device__ __forceinline__ int pos_of(int d, int c) { return d == 0 ? c : (c < 2 ? 1 - c : 19 - c); }
__device__ __forceinline__ int rowmap32(int reg, int lane) { return (reg & 3) + 8 * (reg >> 2) + 4 * (lane >> 5); }

template <int K> __device__ __forceinline__ void mm32(f32x16& acc, const bf16_t* A, int lda, const bf16_t* B, int ldb, int lane) {
    const bf16_t* pa = A + (lane & 31) * lda + 8 * (lane >> 5);
    const bf16_t* pb = B + (lane & 31) * ldb + 8 * (lane >> 5);
#pragma unroll
    for (int k = 0; k < K; k += 16) {
        const bf16x8 a = *(const bf16x8*)(pa + k);
        const bf16x8 b = *(const bf16x8*)(pb + k);
        acc = __builtin_amdgcn_mfma_f32_32x32x16_bf16(a, b, acc, 0, 0, 0);
    }
}

template <int NC, bool SILU, bool TRANS>
__device__ __forceinline__ void stage_conv_tile(bf16_t* dst, int ld, const bf16_t* Pb, int t0, int col0, const float* cw, int CS, const float* cb, int tid) {
    constexpr int CG = NC / 8;
    const int lo = t0 < 256 ? 0 : 256, hi = t0 < 256 ? 256 : TPB;
    for (int idx = tid; idx < 128 * CG; idx += 512) {
        int cgi, tl;
        if (TRANS) { tl = idx & 127; cgi = idx >> 7; } else { cgi = idx % CG; tl = idx / CG; }
        const int t = t0 + tl;
        const f32x4 b0 = *(const f32x4*)(cb + cgi * 8), b1 = *(const f32x4*)(cb + cgi * 8 + 4);
        f32x8 acc; acc[0] = b0.x; acc[1] = b0.y; acc[2] = b0.z; acc[3] = b0.w; acc[4] = b1.x; acc[5] = b1.y; acc[6] = b1.z; acc[7] = b1.w;
#pragma unroll
        for (int k = 0; k < 4; ++k) {
            const int tt = t - 2 + k;
            if (tt >= lo && tt < hi) {
                const f32x8 v = unpack8(*(const u32x4*)(Pb + (size_t)tt * LDP + col0 + cgi * 8));
                const f32x4 w0 = *(const f32x4*)(cw + k * CS + cgi * 8), w1 = *(const f32x4*)(cw + k * CS + cgi * 8 + 4);
                acc[0] += w0.x * v[0]; acc[1] += w0.y * v[1]; acc[2] += w0.z * v[2]; acc[3] += w0.w * v[3];
                acc[4] += w1.x * v[4]; acc[5] += w1.y * v[5]; acc[6] += w1.z * v[6]; acc[7] += w1.w * v[7];
            }
        }
        if (SILU) {
#pragma unroll
            for (int e = 0; e < 8; ++e) acc[e] = siluf(acc[e]);
        }
        if (TRANS) {
#pragma unroll
            for (int e = 0; e < 8; ++e) dst[(cgi * 8 + e) * ld + tl] = f2bf(acc[e]);
        } else {
            *(u32x4*)(dst + tl * ld + cgi * 8) = pack8(acc);
        }
    }
}

__device__ __forceinline__ void transpose_item(const float* W, int K, int N, int nblk, bf16_t* WT, float* scr, int item, int lane) {
    const int kb = item / nblk, nb = item % nblk, k0 = 64 * kb, n0 = 32 * nb;
    const int c4 = lane & 7, r8 = lane >> 3, n = n0 + c4 * 4;
    f32x4 tv[8];
#pragma unroll
    for (int i = 0; i < 8; ++i) tv[i] = (n < N) ? *(const f32x4*)(W + (size_t)(k0 + i * 8 + r8) * N + n) : (f32x4){0.f, 0.f, 0.f, 0.f};
#pragma unroll
    for (int i = 0; i < 8; ++i) { float* d = scr + (i * 8 + r8) * 33 + c4 * 4; d[0] = tv[i].x; d[1] = tv[i].y; d[2] = tv[i].z; d[3] = tv[i].w; }
    asm volatile("s_waitcnt lgkmcnt(0)" ::: "memory");
    const int c = lane & 7;
#pragma unroll
    for (int j = 0; j < 4; ++j) {
        const int nn = (lane >> 3) + 8 * j; const float* s = scr + (8 * c) * 33 + nn;
        u32x4 o; o.x = cvt_pk_bf16(s[0 * 33], s[1 * 33]); o.y = cvt_pk_bf16(s[2 * 33], s[3 * 33]); o.z = cvt_pk_bf16(s[4 * 33], s[5 * 33]); o.w = cvt_pk_bf16(s[6 * 33], s[7 * 33]);
        *(u32x4*)(WT + (size_t)(n0 + nn) * K + k0 + 8 * c) = o;
    }
    asm volatile("s_waitcnt lgkmcnt(0)" ::: "memory");
}

__device__ __forceinline__ void phase0(const Params& p, unsigned char* shm, int G) {
    const int tid = tidx(), lane = tid & 63, wave = tid >> 6;
    float* sf = (float*)shm;
    float* MOD = WS_MOD(p);
    typedef float f32x2m __attribute__((ext_vector_type(2)));
    for (int item = blockIdx.x; item < 192; item += G) {
        const int l = item / 48, cgp = item % 48;
        __syncthreads();
        for (int idx = tid; idx < 9 * 2048; idx += 512) { const int r = idx >> 11, k = idx & 2047; const float v = r < 8 ? p.c[r * 2048 + k] : p.c_ctx[k]; sf[idx] = siluf(v); }
        __syncthreads();
        f32x2m acc[9];
#pragma unroll
        for (int r = 0; r < 9; ++r) acc[r] = (f32x2m){0.f, 0.f};
        const float* wp = p.ada_w + ((size_t)l * 2048 + wave * 256) * 6144 + cgp * 128 + lane * 2;
#pragma unroll 8
        for (int kk = 0; kk < 256; ++kk) {
            const f32x2m wv = *(const f32x2m*)(wp + (size_t)kk * 6144);
            const int k = wave * 256 + kk;
#pragma unroll
            for (int r = 0; r < 9; ++r) { const float s = sf[r * 2048 + k]; acc[r] += wv * s; }
        }
        __syncthreads();
#pragma unroll
        for (int r = 0; r < 9; ++r) *(f32x2m*)(sf + (wave * 9 + r) * 128 + lane * 2) = acc[r];
        __syncthreads();
        for (int idx = tid; idx < 9 * 128; idx += 512) {
            const int r = idx >> 7, col = idx & 127; float s = p.ada_b[l * 6144 + cgp * 128 + col];
#pragma unroll
            for (int w = 0; w < 8; ++w) s += sf[(w * 9 + r) * 128 + col];
            MOD[(size_t)(l * 9 + r) * 6144 + cgp * 128 + col] = s;
        }
    }
    __syncthreads();
    float* scr = sf + wave * (64 * 33);
    const int gw = blockIdx.x * 8 + wave, NGW = G * 8;
    constexpr int I_IN = 32 * 232, I_OUT = 48 * 64;
    for (int it = gw; it < 4 * (I_IN + I_OUT); it += NGW) {
        if (it < 4 * I_IN) { const int l = it / I_IN, r = it % I_IN; transpose_item(p.w_in + (size_t)l * 2048 * 7184, 2048, 7184, 232, WS_WTIN(p) + (size_t)l * 7424 * 2048, scr, r, lane); }
        else { const int it2 = it - 4 * I_IN, l = it2 / I_OUT, r = it2 % I_OUT; transpose_item(p.w_out + (size_t)l * 3072 * 2048, 3072, 2048, 64, WS_WTOUT(p) + (size_t)l * 2048 * 3072, scr, r, lane); }
    }
    for (int idx = (int)blockIdx.x * 512 + tid; idx < 4 * 16 * 16384; idx += G * 512) {
        const int i = idx & 63, o = (idx >> 6) & 63, gate = (idx >> 12) & 1, d = (idx >> 13) & 1, j = (idx >> 14) & 15, l = idx >> 18;
        const float* w = gate ? p.lru_gx_w : p.lru_ga_w;
        WS_GW(p)[idx] = f2bf(w[(size_t)((l * 2 + d) * 16 + j) * 4096 + i * 64 + o]);
    }
}

__device__ __forceinline__ const float* xrow_src(const Params& p, int l, int row) {
    const int b = row / TPB, t = row % TPB;
    if (l == 0) return t < 256 ? p.ctx + ((size_t)b * 256 + t) * DM : p.x + ((size_t)b * 2048 + (t - 256)) * DM;
    return WS_XB(p) + (size_t)row * DM;
}
__device__ __forceinline__ void norm_phase(const Params& p, int l, int G) {
    const int lane = tidx() & 63, wave = tidx() >> 6;
    bf16_t* U = WS_U(p);
    const int gw = (int)blockIdx.x * 8 + wave, NW = G * 8;
    constexpr int R = 2;
#pragma unroll 1
    for (int base = gw; base < NTOK; base += NW * R) {
        f32x4 v[R][8];
#pragma unroll
        for (int u = 0; u < R; ++u) {
            const int row = base + u * NW;
            if (row < NTOK) {
                if (l >= 1 && row >= 16384) {
                    const float* xo = xrow_src(p, l - 1, row);
                    const float* gt = WS_MOD(p) + (size_t)((l - 1) * 9 + 7) * 6144 + 4096;
                    const float* pp = (const float*)WS_P(p) + (size_t)(row - 16384) * 2048;
                    float* xn = WS_XB(p) + (size_t)row * DM;
#pragma unroll
                    for (int j = 0; j < 8; ++j) {
                        const int col = 4 * lane + 256 * j;
                        const f32x4 s = (*(const f32x4*)(pp + col) + *(const f32x4*)(pp + (size_t)2048 * 2048 + col)) + (*(const f32x4*)(pp + (size_t)2 * 2048 * 2048 + col) + *(const f32x4*)(pp + (size_t)3 * 2048 * 2048 + col));
                        v[u][j] = *(const f32x4*)(xo + col) + *(const f32x4*)(gt + col) * s;
                        *(f32x4*)(xn + col) = v[u][j];
                    }
                } else {
                const float* src = xrow_src(p, l, row);
#pragma unroll
                for (int j = 0; j < 8; ++j) v[u][j] = *(const f32x4*)(src + 4 * lane + 256 * j);
                }
            }
        }
#pragma unroll
        for (int u = 0; u < R; ++u) {
            const int row = base + u * NW;
            if (row < NTOK) {
                const int b = row / TPB, t = row % TPB;
                const float* md = WS_MOD(p) + (size_t)(l * 9 + (t < 256 ? 8 : b)) * 6144;
                float ss = 0.f;
#pragma unroll
                for (int j = 0; j < 8; ++j) ss += v[u][j].x * v[u][j].x + v[u][j].y * v[u][j].y + v[u][j].z * v[u][j].z + v[u][j].w * v[u][j].w;
                ss = wave_sum(ss);
                const float rstd = rsqrtf(ss * (1.f / 2048.f) + 1e-6f);
#pragma unroll
                for (int j = 0; j < 8; ++j) {
                    const int col = 4 * lane + 256 * j;
                    const f32x4 nw = *(const f32x4*)(p.norm_w + l * 2048 + col), sh = *(const f32x4*)(md + col), sc = *(const f32x4*)(md + 2048 + col);
                    const f32x4 y = v[u][j] * rstd * nw * (sc + 1.f) + sh;
                    u32x2 w; w.x = cvt_pk_bf16(y.x, y.y); w.y = cvt_pk_bf16(y.z, y.w);
                    *(u32x2*)(U + (size_t)row * DM + col) = w;
                }
            }
        }
    }
}

struct EpiG1 {
    static constexpr bool PERM = true, AFTER_DRAIN = false;
    bf16_t* P;
    __device__ __forceinline__ void operator()(const f32x4 (&acc)[2][2][4][2], const pg8::Unit& u, int wr, int wc, int fr, int fq) const {
        const int row0 = u.pm * 256 + wr * 64 + fr, col0 = u.pn * 256 + wc * 32 + 8 * fq;
#pragma unroll
        for (int ai = 0; ai < 2; ++ai)
#pragma unroll
            for (int m = 0; m < 4; ++m) { bf16_t* rowp = P + (size_t)(row0 + ai * 128 + m * 16) * LDP + col0;
#pragma unroll
                for (int bj = 0; bj < 2; ++bj) { const f32x4 v0 = acc[ai][bj][m][0], v1 = acc[ai][bj][m][1];
                    u32x4 w; w.x = cvt_pk_bf16(v0.x, v0.y); w.y = cvt_pk_bf16(v0.z, v0.w); w.z = cvt_pk_bf16(v1.x, v1.y); w.w = cvt_pk_bf16(v1.z, v1.w);
                    __builtin_nontemporal_store(w, (u32x4*)(rowp + bj * 128)); } }
    }
};
struct EpiG2 {
    static constexpr bool PERM = true, AFTER_DRAIN = false;
    Params p; int l; int scr;
    __device__ __forceinline__ void operator()(const f32x4 (&acc)[2][2][4][2], const pg8::Unit& u, int wr, int wc, int fr, int fq) const {
        const int row0 = u.pm * 256 + wr * 64 + fr, col0 = u.pn * 256 + wc * 32 + 8 * fq;
        const int tb = (u.pm * 256) / TPB, tt0 = (u.pm * 256) % TPB;
        if (l == 3 && tt0 < 256) return;
        const float* gt = WS_MOD(p) + (size_t)(l * 9 + (tt0 < 256 ? 8 : tb)) * 6144 + 4096;
        f32x4 gv[4];
#pragma unroll
        for (int q = 0; q < 4; ++q) gv[q] = *(const f32x4*)(gt + col0 + (q >> 1) * 128 + (q & 1) * 4);
#pragma unroll
        for (int ai = 0; ai < 2; ++ai)
#pragma unroll
            for (int mp = 0; mp < 2; ++mp) {
                const float* xo[2]; float* dst[2];
#pragma unroll
                for (int h = 0; h < 2; ++h) {
                    const int row = row0 + ai * 128 + (2 * mp + h) * 16, t = row % TPB;
                    xo[h] = xrow_src(p, l, row);
                    dst[h] = scr ? (float*)WS_P(p) + (size_t)row * DM : (l == 3) ? p.out + ((size_t)tb * 2048 + (t - 256)) * DM : WS_XB(p) + (size_t)row * DM;
                }
                f32x4 xv[2][4];
#pragma unroll
                for (int h = 0; h < 2; ++h)
#pragma unroll
                    for (int q = 0; q < 4; ++q) xv[h][q] = *(const f32x4*)(xo[h] + col0 + (q >> 1) * 128 + (q & 1) * 4);
#pragma unroll
                for (int h = 0; h < 2; ++h)
#pragma unroll
                    for (int q = 0; q < 4; ++q) *(f32x4*)(dst[h] + col0 + (q >> 1) * 128 + (q & 1) * 4) = xv[h][q] + gv[q] * acc[ai][q >> 1][2 * mp + h][q & 1];
            }
    }
};

struct EpiPart {
    static constexpr bool PERM = true, AFTER_DRAIN = false;
    float* part;
    __device__ __forceinline__ void operator()(const f32x4 (&acc)[2][2][4][2], const pg8::Unit& u, int wr, int wc, int fr, int fq) const {
        const int row0 = (u.pm - 64) * 256 + wr * 64 + fr, col0 = u.pn * 256 + wc * 32 + 8 * fq;
        float* base = part + (size_t)u.ks * 2048 * 2048;
#pragma unroll
        for (int ai = 0; ai < 2; ++ai)
#pragma unroll
            for (int m = 0; m < 4; ++m) { float* rowp = base + (size_t)(row0 + ai * 128 + m * 16) * 2048 + col0;
#pragma unroll
                for (int bj = 0; bj < 2; ++bj) { *(f32x4*)(rowp + bj * 128) = acc[ai][bj][m][0]; *(f32x4*)(rowp + bj * 128 + 4) = acc[ai][bj][m][1]; } }
    }
};

template <int SCR>
__device__ __forceinline__ void qkprep_row(const Params& p, int l, int row, int lane) {
    const int t = row % TPB;
    bf16_t* rp = WS_P(p) + (size_t)row * LDP;
    float cs = 1.f, sn = 0.f;
    if (t >= 256) {
        const int s = t - 256, rr = s >> 6, cc = s & 63, f = lane & 31;
        const float inv = exp2f(-(float)f * (13.287712379549449f / 32.f));
        const float ang = (float)(lane < 32 ? rr : cc) * inv;
        cs = __cosf(ang); sn = __sinf(ang);
    }
    bf16_t r1[10], r2[10];
#pragma unroll
    for (int slot = 0; slot < 10; ++slot) { const int col = slot < 8 ? C_Q + slot * 128 : C_K + (slot - 8) * 128; r1[slot] = rp[col + lane]; r2[slot] = rp[col + 64 + lane]; }
#pragma unroll
    for (int slot = 0; slot < 10; ++slot) {
        const int col = slot < 8 ? C_Q + slot * 128 : C_K + (slot - 8) * 128;
        const float* w = slot < 8 ? p.att_q_norm + l * 128 : p.att_k_norm + l * 128;
        const float v1 = bf2f(r1[slot]), v2 = bf2f(r2[slot]);
        const float ss = wave_sum(v1 * v1 + v2 * v2);
        const float rstd = rsqrtf(ss * (1.f / 128.f) + 1e-6f);
        const float y1 = v1 * rstd * w[lane], y2 = v2 * rstd * w[64 + lane];
        float o1 = y1 * cs - y2 * sn, o2 = y1 * sn + y2 * cs;
        if (slot < 8) { o1 *= 0.08838834764831845f; o2 *= 0.08838834764831845f; }
        if (SCR) { bf16_t* sp = WS_ST(p) + (size_t)row * 1280 + slot * 128; sp[lane] = f2bf(o1); sp[64 + lane] = f2bf(o2); } else { rp[col + lane] = f2bf(o1); rp[col + 64 + lane] = f2bf(o2); }
    }
}

template <int D, int SCR = 0>
__device__ __forceinline__ void lru_sweep_item(const Params& p, int l, int item, unsigned char* shm) {
    const int tid = tidx(), lane = tid & 63, wave = tid >> 6, ch = tid & 63, seg = tid >> 6;
    const int j = item & 15, b = item >> 4;
    bf16_t* sX = (bf16_t*)shm; bf16_t* sW = (bf16_t*)(shm + 18432);
    float* sA = (float*)(shm + 36864); float* sB = (float*)(shm + 69632); float* sSA = (float*)(shm + 102400); float* sSB = (float*)(shm + 104448);
    bf16_t* sOut = (bf16_t*)(shm + 106496);
    const int mi = wave & 3, nj = wave >> 2, cl = nj * 32 + (lane & 31), cgl = j * 64 + cl;
    const float ba = p.lru_ga_b[(l * 2 + D) * 1024 + cgl], bx = p.lru_gx_b[(l * 2 + D) * 1024 + cgl], sp = softplusf(-p.lru_lambda[(l * 2 + D) * 1024 + cgl]);
    lds_barrier();
    {
        u32x4 wr2[2];
#pragma unroll
        for (int k = 0; k < 2; ++k) { const int idx = tid + k * 512; wr2[k] = *(const u32x4*)(WS_GW(p) + (size_t)(l * 16 + j) * 16384 + D * 8192 + idx * 8); }
#pragma unroll
        for (int k = 0; k < 2; ++k) { const int idx = tid + k * 512; *(u32x4*)(sW + (idx >> 3) * 72 + (idx & 7) * 8) = wr2[k]; }
    }
    u32x4 xr[2], lgr[2], hfr[2];
    {
        const size_t tok0 = (size_t)b * TPB + chunk_at(D, 0) * 128;
#pragma unroll
        for (int k = 0; k < 2; ++k) {
            const int idx = tid + k * 512;
            xr[k] = *(const u32x4*)(WS_LXC(p) + (tok0 + (idx >> 3)) * 1024 + j * 64 + (idx & 7) * 8);
            if (D == 1) { lgr[k] = *(const u32x4*)(WS_P(p) + (tok0 + (idx >> 3)) * LDP + C_LG + j * 64 + (idx & 7) * 8); hfr[k] = *(const u32x4*)(WS_MIX(p) + (tok0 + (idx >> 3)) * MIXW + j * 64 + (idx & 7) * 8); }
        }
    }
    float carry = 0.f;
#pragma unroll 1
    for (int pos = 0; pos < NCH; ++pos) {
        const size_t tok0 = (size_t)b * TPB + chunk_at(D, pos) * 128;
#pragma unroll
        for (int k = 0; k < 2; ++k) { const int idx = tid + k * 512; *(u32x4*)(sX + (idx >> 3) * 72 + (idx & 7) * 8) = xr[k]; }
        u32x4 lgc[2], hfc[2];
        if (D == 1) { lgc[0] = lgr[0]; lgc[1] = lgr[1]; hfc[0] = hfr[0]; hfc[1] = hfr[1]; }
        if (pos + 1 < NCH) {
            const size_t tokn = (size_t)b * TPB + chunk_at(D, pos + 1) * 128;
#pragma unroll
            for (int k = 0; k < 2; ++k) {
                const int idx = tid + k * 512;
                xr[k] = *(const u32x4*)(WS_LXC(p) + (tokn + (idx >> 3)) * 1024 + j * 64 + (idx & 7) * 8);
                if (D == 1) { lgr[k] = *(const u32x4*)(WS_P(p) + (tokn + (idx >> 3)) * LDP + C_LG + j * 64 + (idx & 7) * 8); hfr[k] = *(const u32x4*)(WS_MIX(p) + (tokn + (idx >> 3)) * MIXW + j * 64 + (idx & 7) * 8); }
            }
        }
        lds_barrier();
        {
            f32x16 ga, gx;
#pragma unroll
            for (int r = 0; r < 16; ++r) { ga[r] = 0.f; gx[r] = 0.f; }
            mm32<64>(ga, sX + mi * 32 * 72, 72, sW + (nj * 32) * 72, 72, lane);
            mm32<64>(gx, sX + mi * 32 * 72, 72, sW + (64 + nj * 32) * 72, 72, lane);
#pragma unroll
            for (int r = 0; r < 16; ++r) {
                const int tl = mi * 32 + rowmap32(r, lane);
                const float rg = sigmf(ga[r] + ba), ig = sigmf(gx[r] + bx);
                const float a = __expf(-8.f * rg * sp), mult = __builtin_amdgcn_sqrtf(fmaxf(1.f - a * a, 0.f));
                const float xv = bf2f(sX[tl * 72 + cl]);
                sA[tl * 64 + cl] = a; sB[tl * 64 + cl] = mult * ig * xv;
            }
        }
        lds_barrier();
        {
            float A = 1.f, Bc = 0.f;
#pragma unroll
            for (int q = 0; q < 16; ++q) { const int tl = seg * 16 + (D == 0 ? q : 15 - q); const float a = sA[tl * 64 + ch], bb = sB[tl * 64 + ch]; A = a * A; Bc = a * Bc + bb; }
            sSA[seg * 64 + ch] = A; sSB[seg * 64 + ch] = Bc;
        }
        lds_barrier();
        {
            float h = carry, cn = carry;
            const int myord = D == 0 ? seg : 7 - seg;
#pragma unroll
            for (int s = 0; s < 8; ++s) { const int sg = D == 0 ? s : 7 - s; const float a = sSA[sg * 64 + ch], bb = sSB[sg * 64 + ch]; cn = a * cn + bb; if (s < myord) h = cn; }
            carry = cn;
#pragma unroll
            for (int q = 0; q < 16; ++q) { const int tl = seg * 16 + (D == 0 ? q : 15 - q); h = sA[tl * 64 + ch] * h + sB[tl * 64 + ch]; sOut[tl * 72 + ch] = f2bf(h); }
        }
        lds_barrier();
#pragma unroll
        for (int k = 0; k < 2; ++k) {
            const int idx = tid + k * 512, rr = idx >> 3, ck = idx & 7;
            const u32x4 hv = *(const u32x4*)(sOut + rr * 72 + ck * 8);
            bf16_t* dst = SCR ? WS_P(p) + (tok0 + rr) * LDP + j * 64 + ck * 8 : WS_MIX(p) + (tok0 + rr) * MIXW + j * 64 + ck * 8;
            if (D == 0) *(u32x4*)dst = hv;
            else {
                const f32x8 a = unpack8(hv), f = unpack8(hfc[k]), g = unpack8(lgc[k]);
                f32x8 o;
#pragma unroll
                for (int e = 0; e < 8; ++e) o[e] = (a[e] + f[e]) * siluf(g[e]);
                *(u32x4*)dst = pack8(o);
            }
        }
    }
}

__device__ __forceinline__ void prep_elem(const Params& p, int l, int G) {
    const int gt = (int)blockIdx.x * 512 + tidx(), NT = G * 512;
    constexpr int NI = (NTOK / 4) * 192;
#pragma unroll 1
    for (int idx = gt; idx < NI; idx += NT) {
        const int tok = (idx / 192) * 4, cgi = idx % 192, b = tok / TPB, t = tok % TPB;
        const int lo = t < 256 ? 0 : 256, hi = t < 256 ? 256 : TPB;
        int col, CS, rs; const float *cw, *cb; bf16_t* dst; bool act;
        if (cgi < 128) { col = C_LX + cgi * 8; cw = p.lru_conv_w + l * 4096 + cgi * 8; CS = 1024; cb = p.lru_conv_b + l * 1024 + cgi * 8; act = false; dst = WS_LXC(p) + (size_t)tok * 1024 + cgi * 8; rs = 1024; }
        else { const int c2 = (cgi - 128) * 8; col = C_XBC + 1024 + c2; cw = p.ssd_conv_w + l * 6144 + 1024 + c2; CS = 1536; cb = p.ssd_conv_b + l * 1536 + 1024 + c2; act = true; dst = WS_SBC(p) + (size_t)tok * 512 + c2; rs = 512; }
        const bf16_t* src = WS_P(p) + (size_t)b * TPB * LDP + col;
        u32x4 raw[7];
#pragma unroll
        for (int r = 0; r < 7; ++r) { const int tt = t - 2 + r; raw[r] = (tt >= lo && tt < hi) ? *(const u32x4*)(src + (size_t)tt * LDP) : (u32x4){0u, 0u, 0u, 0u}; }
        const f32x4 b0 = *(const f32x4*)cb, b1 = *(const f32x4*)(cb + 4);
        f32x8 acc[4];
#pragma unroll
        for (int o = 0; o < 4; ++o) { acc[o][0] = b0.x; acc[o][1] = b0.y; acc[o][2] = b0.z; acc[o][3] = b0.w; acc[o][4] = b1.x; acc[o][5] = b1.y; acc[o][6] = b1.z; acc[o][7] = b1.w; }
#pragma unroll
        for (int k = 0; k < 4; ++k) {
            const f32x4 w0 = *(const f32x4*)(cw + k * CS), w1 = *(const f32x4*)(cw + k * CS + 4);
#pragma unroll
            for (int o = 0; o < 4; ++o) {
                const f32x8 v = unpack8(raw[o + k]);
                acc[o][0] += w0.x * v[0]; acc[o][1] += w0.y * v[1]; acc[o][2] += w0.z * v[2]; acc[o][3] += w0.w * v[3];
                acc[o][4] += w1.x * v[4]; acc[o][5] += w1.y * v[5]; acc[o][6] += w1.z * v[6]; acc[o][7] += w1.w * v[7];
            }
        }
#pragma unroll
        for (int o = 0; o < 4; ++o) {
            if (act) {
#pragma unroll
                for (int e = 0; e < 8; ++e) acc[o][e] = siluf(acc[o][e]);
            }
            *(u32x4*)(dst + (size_t)o * rs) = pack8(acc[o]);
        }
    }
}
struct PrepTile { int col0, ch0, t0, lo, hi, conv; const bf16_t* Pb; bf16_t* dst; };
__device__ __forceinline__ PrepTile prep_tile_decode(const Params& p, int item) {
    PrepTile T;
    const int t24 = item % 24, bc = item / 24, c = bc % NCH, b = bc / NCH;
    T.t0 = c * 128; T.Pb = WS_P(p) + (size_t)b * TPB * LDP; T.ch0 = 0; T.conv = t24 < 20;
    if (t24 < 16) { T.ch0 = t24 * 64; T.col0 = C_XBC + T.ch0; T.dst = WS_SXT(p) + ((size_t)((b * 18 + c) * 16 + t24)) * 8192; }
    else if (t24 < 20) { const int q = t24 - 16, g = q >> 1, nh = q & 1; T.ch0 = 1024 + g * 128 + nh * 64; T.col0 = C_XBC + T.ch0; T.dst = WS_SBT(p) + ((size_t)((b * 18 + c) * 2 + g)) * 16384 + (size_t)nh * 64 * 128; }
    else { const int q = t24 - 20, kh = q >> 1, dh = q & 1; T.col0 = C_V + kh * 128 + dh * 64; T.dst = WS_VT(p) + ((size_t)((b * 18 + c) * 2 + kh)) * 16384 + (size_t)dh * 64 * 128; }
    T.lo = T.t0 < 256 ? 0 : 256; T.hi = T.t0 < 256 ? 256 : TPB;
    return T;
}
__device__ __forceinline__ void prep_tile_load(const PrepTile& T, int tid, u32x4 (&raw)[2][4]) {
#pragma unroll
    for (int k = 0; k < 2; ++k) {
        const int idx = tid + k * 512, cgi = idx & 7, t = T.t0 + (idx >> 3);
#pragma unroll
        for (int q = 0; q < 4; ++q) {
            const int tt = T.conv ? t - 2 + q : t;
            const bool ok = T.conv ? (tt >= T.lo && tt < T.hi) : (q == 2);
            raw[k][q] = ok ? *(const u32x4*)(T.Pb + (size_t)tt * LDP + T.col0 + cgi * 8) : (u32x4){0u, 0u, 0u, 0u};
        }
    }
}
__device__ __forceinline__ void prep_tile_finish(const Params& p, int l, const PrepTile& T, int tid, const u32x4 (&raw)[2][4], unsigned char* shm) {
    bf16_t* sT = (bf16_t*)shm;
    const float* cw = p.ssd_conv_w + l * 6144 + T.ch0; const float* cb = p.ssd_conv_b + l * 1536 + T.ch0;
    lds_barrier();
#pragma unroll
    for (int k = 0; k < 2; ++k) {
        const int idx = tid + k * 512, cgi = idx & 7, tl = idx >> 3;
        f32x8 acc;
        if (T.conv) {
            const f32x4 b0 = *(const f32x4*)(cb + cgi * 8), b1 = *(const f32x4*)(cb + cgi * 8 + 4);
            acc[0] = b0.x; acc[1] = b0.y; acc[2] = b0.z; acc[3] = b0.w; acc[4] = b1.x; acc[5] = b1.y; acc[6] = b1.z; acc[7] = b1.w;
#pragma unroll
            for (int q = 0; q < 4; ++q) {
                const f32x8 v = unpack8(raw[k][q]);
                const f32x4 w0 = *(const f32x4*)(cw + q * 1536 + cgi * 8), w1 = *(const f32x4*)(cw + q * 1536 + cgi * 8 + 4);
                acc[0] += w0.x * v[0]; acc[1] += w0.y * v[1]; acc[2] += w0.z * v[2]; acc[3] += w0.w * v[3];
                acc[4] += w1.x * v[4]; acc[5] += w1.y * v[5]; acc[6] += w1.z * v[6]; acc[7] += w1.w * v[7];
            }
#pragma unroll
            for (int e = 0; e < 8; ++e) acc[e] = siluf(acc[e]);
        } else acc = unpack8(raw[k][2]);
#pragma unroll
        for (int e = 0; e < 8; ++e) sT[(cgi * 8 + e) * 130 + tl] = f2bf(acc[e]);
    }
    lds_barrier();
#pragma unroll
    for (int k = 0; k < 2; ++k) {
        const int idx = tid + k * 512, r = idx >> 4, ck = idx & 15;
        const unsigned* sp = (const unsigned*)(sT + r * 130 + ck * 8);
        u32x4 o; o.x = sp[0]; o.y = sp[1]; o.z = sp[2]; o.w = sp[3];
        *(u32x4*)(T.dst + r * 128 + ck * 8) = o;
    }
}
__device__ __forceinline__ void prep_tiles(const Params& p, int l, int bid, int G, unsigned char* shm) {
    const int tid = tidx();
    if (bid >= 3456) return;
    u32x4 raw[2][4], nraw[2][4];
    { const PrepTile T0 = prep_tile_decode(p, bid); prep_tile_load(T0, tid, raw); }
#pragma unroll 1
    for (int it = bid; it < 3456; it += G) {
        const bool more = it + G < 3456;
        if (more) { const PrepTile Tn = prep_tile_decode(p, it + G); prep_tile_load(Tn, tid, nraw); }
        { const PrepTile T = prep_tile_decode(p, it); prep_tile_finish(p, l, T, tid, raw, shm); }
        if (more) {
#pragma unroll
            for (int k = 0; k < 2; ++k)
#pragma unroll
                for (int q = 0; q < 4; ++q) raw[k][q] = nraw[k][q];
        }
    }
}
__device__ __forceinline__ void prep_dt_item(const Params& p, int l, int item) {
    const int tid = tidx();
    const int c = item % NCH, b = item / NCH;
    const int col32 = tid >> 4, h = col32 >> 1, d = col32 & 1, lane16 = tid & 15, seg = d == 0 ? lane16 : 15 - lane16;
    const float A = -__expf(p.ssd_A_log[(l * 2 + d) * 16 + h]), bias = p.ssd_dt_bias[(l * 2 + d) * 16 + h];
    const float* src = WS_DTP(p) + ((size_t)b * TPB + c * 128) * 16 + h;
    float dtv[8], cs[8], run = 0.f;
    float rawv[8];
#pragma unroll
    for (int q = 0; q < 8; ++q) { const int j = seg * 8 + (d == 0 ? q : 7 - q); rawv[q] = src[j * 16]; }
#pragma unroll
    for (int q = 0; q < 8; ++q) { dtv[q] = softplusf(rawv[q] + bias); run += dtv[q] * A; cs[q] = run; }
    float incl = run;
#pragma unroll
    for (int off = 1; off < 16; off <<= 1) { const float v = __shfl_up(incl, off, 16); if (lane16 >= off) incl += v; }
    const float excl = incl - run;
    float* dta = WS_DTA(p) + ((size_t)(b * 18 + c) * 128) * 32 + col32;
    float* acs = WS_ACS(p) + ((size_t)(b * 18 + c) * 128) * 32 + col32;
#pragma unroll
    for (int q = 0; q < 8; ++q) { const int j = seg * 8 + (d == 0 ? q : 7 - q); dta[j * 32] = dtv[q]; acs[j * 32] = cs[q] + excl; }
    if (lane16 == 15) WS_AL(p)[((b * 2 + d) * 18 + c) * 16 + h] = incl;
}
__device__ __forceinline__ void ssd_states_item(const Params& p, int l, int item, unsigned char* shm) {
    const int tid = tidx(), lane = tid & 63, wave = tid >> 6;
    const int g = item & 1, hh0 = ((item >> 1) & 1) * 4, bc = item >> 2, c = bc % NCH, b = bc / NCH;
    bf16_t* sBT = (bf16_t*)shm; bf16_t* sXw = (bf16_t*)(shm + 34816);
    float* sDt = (float*)(shm + 69632); float* sAcs = (float*)(shm + 77824); bf16_t* sO = (bf16_t*)(shm + 86016); float* sWg = (float*)(shm + 120832);
    const bf16_t* xt = WS_SXT(p) + ((size_t)((b * 18 + c) * 16 + g * 8)) * 8192;
    const bf16_t* btp = WS_SBT(p) + ((size_t)((b * 18 + c) * 2 + g)) * 16384;
    lds_barrier();
    {
        const size_t o = ((size_t)(b * 18 + c) * 128 + (tid >> 2)) * 32 + g * 16 + (tid & 3) * 4;
        const f32x4 vdt = *(const f32x4*)(WS_DTA(p) + o), vac = *(const f32x4*)(WS_ACS(p) + o);
        u32x4 bt[4];
#pragma unroll
        for (int k = 0; k < 4; ++k) { const int idx = tid + k * 512; bt[k] = *(const u32x4*)(btp + (idx >> 4) * 128 + (idx & 15) * 8); }
        *(f32x4*)(sDt + (tid >> 2) * 16 + (tid & 3) * 4) = vdt; *(f32x4*)(sAcs + (tid >> 2) * 16 + (tid & 3) * 4) = vac;
#pragma unroll
        for (int k = 0; k < 4; ++k) { const int idx = tid + k * 512; *(u32x4*)(sBT + (idx >> 4) * 136 + (idx & 15) * 8) = bt[k]; }
    }
    u32x4 xr[2];
#pragma unroll
    for (int k = 0; k < 2; ++k) { const int idx = tid + k * 512; xr[k] = *(const u32x4*)(xt + (size_t)hh0 * 8192 + (idx >> 4) * 128 + (idx & 15) * 8); }
    lds_barrier();
#pragma unroll
    for (int k = 0; k < 4; ++k) { const int idx = tid + k * 512, jj = idx >> 4, col = idx & 15; const float al = (col & 1) == 0 ? sAcs[127 * 16 + col] : sAcs[col]; sWg[col * 128 + jj] = __expf(al - sAcs[jj * 16 + col]) * sDt[jj * 16 + col]; }
#pragma unroll 1
    for (int hh = hh0; hh < hh0 + 4; ++hh) {
        const int h = g * 8 + hh;
        u32x4 xn[2] = {xr[0], xr[1]};
        if (hh < hh0 + 3) {
#pragma unroll
            for (int k = 0; k < 2; ++k) { const int idx = tid + k * 512; xn[k] = *(const u32x4*)(xt + (size_t)(hh + 1) * 8192 + (idx >> 4) * 128 + (idx & 15) * 8); }
        }
        lds_barrier();
#pragma unroll
        for (int k = 0; k < 2; ++k) {
            const int idx = tid + k * 512, pp = idx >> 4, j8 = (idx & 15) * 8;
            const f32x8 xv = unpack8(xr[k]);
#pragma unroll
            for (int d = 0; d < 2; ++d) {
                const f32x4 w0 = *(const f32x4*)(sWg + (hh * 2 + d) * 128 + j8), w1 = *(const f32x4*)(sWg + (hh * 2 + d) * 128 + j8 + 4);
                f32x8 o;
                o[0] = xv[0] * w0.x; o[1] = xv[1] * w0.y; o[2] = xv[2] * w0.z; o[3] = xv[3] * w0.w; o[4] = xv[4] * w1.x; o[5] = xv[5] * w1.y; o[6] = xv[6] * w1.z; o[7] = xv[7] * w1.w;
                *(u32x4*)(sXw + d * 8704 + pp * 136 + j8) = pack8(o);
            }
        }
        lds_barrier();
        const int mi = wave & 1, nj = wave >> 1;
#pragma unroll
        for (int d = 0; d < 2; ++d) {
            f32x16 acc;
#pragma unroll
            for (int r = 0; r < 16; ++r) acc[r] = 0.f;
            mm32<128>(acc, sXw + d * 8704 + mi * 32 * 136, 136, sBT + nj * 32 * 136, 136, lane);
#pragma unroll
            for (int r = 0; r < 16; ++r) sO[d * 8704 + (mi * 32 + rowmap32(r, lane)) * 136 + nj * 32 + (lane & 31)] = f2bf(acc[r]);
        }
        lds_barrier();
#pragma unroll
        for (int d = 0; d < 2; ++d) {
            bf16_t* base = WS_ST(p) + ((size_t)((b * 2 + d) * 18 + c) * 16 + h) * 8192;
#pragma unroll
            for (int k = 0; k < 2; ++k) { const int idx = tid + k * 512; *(u32x4*)(base + idx * 8) = *(const u32x4*)(sO + d * 8704 + (idx >> 4) * 136 + (idx & 15) * 8); }
        }
        xr[0] = xn[0]; xr[1] = xn[1];
    }
}
__device__ __forceinline__ void ssd_recur_item(const Params& p, int item) {
    const int tid = tidx();
    const int d = item & 1, h = (item >> 1) & 15, b = item >> 5;
    u32x4 s0[NCH], s1[NCH]; float ev[NCH];
#pragma unroll
    for (int pos = 0; pos < NCH; ++pos) {
        const int c = chunk_at(d, pos);
        const bf16_t* ptr = WS_ST(p) + ((size_t)((b * 2 + d) * 18 + c) * 16 + h) * 8192 + tid * 16;
        s0[pos] = *(const u32x4*)ptr; s1[pos] = *(const u32x4*)(ptr + 8);
        ev[pos] = WS_AL(p)[((b * 2 + d) * 18 + c) * 16 + h];
    }
    f32x8 h0, h1;
#pragma unroll
    for (int e = 0; e < 8; ++e) { h0[e] = 0.f; h1[e] = 0.f; }
#pragma unroll
    for (int pos = 0; pos < NCH; ++pos) {
        const int c = chunk_at(d, pos);
        bf16_t* ptr = WS_ST(p) + ((size_t)((b * 2 + d) * 18 + c) * 16 + h) * 8192 + tid * 16;
        *(u32x4*)ptr = pack8(h0); *(u32x4*)(ptr + 8) = pack8(h1);
        const float e = __expf(ev[pos]);
        h0 = h0 * e + unpack8(s0[pos]); h1 = h1 * e + unpack8(s1[pos]);
    }
}
template <int MODE>
__device__ __forceinline__ void ssd_final_item(const Params& p, int l, int item, unsigned char* shm) {
    const int tid = tidx(), lane = tid & 63, wave = tid >> 6;
    const int g = item & 1, hh0 = ((item >> 1) & 1) * 4, bc = item >> 2, c = bc % NCH, b = bc / NCH, t0 = c * 128;
    if (l == 3 && c < 2) return;
    const size_t tok0 = (size_t)b * TPB + t0;
    bf16_t* sC = (bf16_t*)shm; bf16_t* sBW = (bf16_t*)(shm + 34816); bf16_t* sXT = (bf16_t*)(shm + 69632); bf16_t* sH = (bf16_t*)(shm + 87040);
    float* sDt = (float*)(shm + 104448); float* sAcs = (float*)(shm + 112640);
    bf16_t* sY = sBW;
    const bf16_t* xt = WS_SXT(p) + ((size_t)((b * 18 + c) * 16 + g * 8)) * 8192;
    const bf16_t* zt = WS_P(p) + tok0 * LDP + C_Z + g * 512;
    const bf16_t* hin0 = WS_ST(p) + ((size_t)((b * 2 + 0) * 18 + c) * 16 + g * 8) * 8192;
    const bf16_t* hin1 = WS_ST(p) + ((size_t)((b * 2 + 1) * 18 + c) * 16 + g * 8) * 8192;
    lds_barrier();
    u32x4 xr[2], zr[2], h0r[2];
    {
        const size_t o = ((size_t)(b * 18 + c) * 128 + (tid >> 2)) * 32 + g * 16 + (tid & 3) * 4;
        const f32x4 vdt = *(const f32x4*)(WS_DTA(p) + o), vac = *(const f32x4*)(WS_ACS(p) + o);
        u32x4 cr[4], br[4];
#pragma unroll
        for (int k = 0; k < 4; ++k) { const int idx = tid + k * 512; const bf16_t* s = WS_SBC(p) + (tok0 + (idx >> 4)) * 512 + g * 128 + (idx & 15) * 8; br[k] = *(const u32x4*)s; cr[k] = *(const u32x4*)(s + 256); }
#pragma unroll
        for (int k = 0; k < 2; ++k) {
            const int idx = tid + k * 512;
            xr[k] = *(const u32x4*)(xt + (size_t)hh0 * 8192 + (idx >> 4) * 128 + (idx & 15) * 8);
            zr[k] = *(const u32x4*)(zt + (size_t)(idx >> 3) * LDP + hh0 * 64 + (idx & 7) * 8);
            h0r[k] = *(const u32x4*)(hin0 + (size_t)hh0 * 8192 + idx * 8);
        }
        *(f32x4*)(sDt + (tid >> 2) * 16 + (tid & 3) * 4) = vdt; *(f32x4*)(sAcs + (tid >> 2) * 16 + (tid & 3) * 4) = vac;
#pragma unroll
        for (int k = 0; k < 4; ++k) { const int idx = tid + k * 512; *(u32x4*)(sC + (idx >> 4) * 136 + (idx & 15) * 8) = cr[k]; *(u32x4*)(sBW + (idx >> 4) * 136 + (idx & 15) * 8) = br[k]; }
    }
    lds_barrier();
    const int cmi = wave >> 1, cnj0 = (wave & 1) * 2;
    f32x16 cb0, cb1;
#pragma unroll
    for (int r = 0; r < 16; ++r) { cb0[r] = 0.f; cb1[r] = 0.f; }
    mm32<128>(cb0, sC + cmi * 32 * 136, 136, sBW + cnj0 * 32 * 136, 136, lane);
    mm32<128>(cb1, sC + cmi * 32 * 136, 136, sBW + (cnj0 + 1) * 32 * 136, 136, lane);
    const int ymi = wave & 3, ynj = wave >> 2;
#pragma unroll 1
    for (int hh = hh0; hh < hh0 + 4; ++hh) {
        const int h = g * 8 + hh;
        lds_barrier();
#pragma unroll
        for (int k = 0; k < 2; ++k) { const int idx = tid + k * 512; *(u32x4*)(sXT + (idx >> 4) * 136 + (idx & 15) * 8) = xr[k]; *(u32x4*)(sH + (idx >> 4) * 136 + (idx & 15) * 8) = h0r[k]; }
        u32x4 h1r[2];
#pragma unroll
        for (int k = 0; k < 2; ++k) h1r[k] = *(const u32x4*)(hin1 + (size_t)hh * 8192 + (tid + k * 512) * 8);
        f32x16 yacc;
        const int colf = hh * 2, colr = hh * 2 + 1;
        if (MODE < 2) {
            float acif[16], acir[16];
#pragma unroll
            for (int r = 0; r < 16; ++r) { const int ig = cmi * 32 + rowmap32(r, lane); acif[r] = sAcs[ig * 16 + colf]; acir[r] = sAcs[ig * 16 + colr]; }
#pragma unroll
            for (int tt = 0; tt < 2; ++tt) {
                const int jg = (cnj0 + tt) * 32 + (lane & 31);
                const float acjf = sAcs[jg * 16 + colf], dtjf = sDt[jg * 16 + colf], acjr = sAcs[jg * 16 + colr], dtjr = sDt[jg * 16 + colr];
                const int dj0 = jg - cmi * 32 - 4 * (lane >> 5);
#pragma unroll
                for (int r = 0; r < 16; ++r) {
                    const int sd = dj0 - ((r & 3) + 8 * (r >> 2));
                    const bool fwd = sd <= 0;
                    const float arg = fwd ? acif[r] - acjf : acir[r] - acjr, sc = fwd ? dtjf : dtjr;
                    const float cbv = tt == 0 ? cb0[r] : cb1[r];
                    float val = cbv * __expf(arg) * sc;
                    val += sd == 0 ? cbv * dtjr : 0.f;
                    sBW[(cmi * 32 + rowmap32(r, lane)) * 136 + jg] = f2bf(val);
                }
            }
        }
        lds_barrier();
        {
            f32x16 ad, ao;
#pragma unroll
            for (int r = 0; r < 16; ++r) { ad[r] = 0.f; ao[r] = 0.f; }
            if (MODE < 3) { mm32<128>(ad, sBW + ymi * 32 * 136, 136, sXT + ynj * 32 * 136, 136, lane);
            mm32<128>(ao, sC + ymi * 32 * 136, 136, sH + ynj * 32 * 136, 136, lane); }
#pragma unroll
            for (int r = 0; r < 16; ++r) { const int ig = ymi * 32 + rowmap32(r, lane); yacc[r] = ad[r] + __expf(sAcs[ig * 16 + colf]) * ao[r]; }
        }
        if (hh < hh0 + 3) {
#pragma unroll
            for (int k = 0; k < 2; ++k) {
                const int idx = tid + k * 512;
                xr[k] = *(const u32x4*)(xt + (size_t)(hh + 1) * 8192 + (idx >> 4) * 128 + (idx & 15) * 8);
                h0r[k] = *(const u32x4*)(hin0 + (size_t)(hh + 1) * 8192 + idx * 8);
            }
        }
        lds_barrier();
#pragma unroll
        for (int k = 0; k < 2; ++k) { const int idx = tid + k * 512; *(u32x4*)(sH + (idx >> 4) * 136 + (idx & 15) * 8) = h1r[k]; }
        lds_barrier();
        {
            f32x16 ao;
#pragma unroll
            for (int r = 0; r < 16; ++r) ao[r] = 0.f;
            if (MODE < 3) mm32<128>(ao, sC + ymi * 32 * 136, 136, sH + ynj * 32 * 136, 136, lane);
#pragma unroll
            for (int r = 0; r < 16; ++r) { const int ig = ymi * 32 + rowmap32(r, lane); yacc[r] += __expf(sAcs[ig * 16 + colr]) * ao[r]; }
        }
        const float Dh = p.ssd_D[l * 16 + h];
        const int pl = ynj * 32 + (lane & 31);
#pragma unroll
        for (int r = 0; r < 16; ++r) { const int ig = ymi * 32 + rowmap32(r, lane); yacc[r] += Dh * bf2f(sXT[pl * 136 + ig]); }
        lds_barrier();
#pragma unroll
        for (int r = 0; r < 16; ++r) { const int ig = ymi * 32 + rowmap32(r, lane); sY[ig * 72 + pl] = f2bf(yacc[r]); }
        lds_barrier();
#pragma unroll
        for (int k = 0; k < 2; ++k) {
            const int idx = tid + k * 512, rr = idx >> 3, pk = idx & 7;
            const f32x8 yv = unpack8(*(const u32x4*)(sY + rr * 72 + pk * 8)), zv = unpack8(zr[k]);
            f32x8 o;
#pragma unroll
            for (int e = 0; e < 8; ++e) o[e] = yv[e] * siluf(zv[e]);
            if (MODE < 1) *(u32x4*)(WS_MIX(p) + (tok0 + rr) * MIXW + 2048 + h * 64 + pk * 8) = pack8(o); else asm volatile("" :: "v"(o[0]), "v"(o[7]));
        }
        if (hh < hh0 + 3) {
#pragma unroll
            for (int k = 0; k < 2; ++k) { const int idx = tid + k * 512; zr[k] = *(const u32x4*)(zt + (size_t)(idx >> 3) * LDP + (hh + 1) * 64 + (idx & 7) * 8); }
        }
    }
}
__device__ __forceinline__ void ssd_norm_phase(const Params& p, int l, int G) {
    const int lane = tidx() & 63, wave = tidx() >> 6;
    for (int row = blockIdx.x * 8 + wave; row < NTOK; row += G * 8) {
        bf16_t* rp = WS_MIX(p) + (size_t)row * MIXW + 2048;
        f32x8 v0 = unpack8(*(const u32x4*)(rp + lane * 8)), v1 = unpack8(*(const u32x4*)(rp + 512 + lane * 8));
        float ss = 0.f;
#pragma unroll
        for (int e = 0; e < 8; ++e) ss += v0[e] * v0[e] + v1[e] * v1[e];
        ss = wave_sum(ss);
        const float rstd = rsqrtf(ss * (1.f / 1024.f) + 1e-6f);
        const float* nw = p.ssd_norm_w + l * 1024;
#pragma unroll
        for (int e = 0; e < 8; ++e) { v0[e] = v0[e] * rstd * nw[lane * 8 + e]; v1[e] = v1[e] * rstd * nw[512 + lane * 8 + e]; }
        *(u32x4*)(rp + lane * 8) = pack8(v0); *(u32x4*)(rp + 512 + lane * 8) = pack8(v1);
    }
}

template <int MODE>
__device__ __forceinline__ void attn_item(const Params& p, int l, int item, unsigned char* shm) {
    const int tid = tidx(), lane = tid & 63, wave = tid >> 6, fr = lane & 15, fq = lane >> 4;
    const int hp = item & 3, bq = item >> 2, qblk = bq % NCH, b = bq / NCH, kh = hp >> 1;
    if (l == 3 && qblk < 2) return;
    const bf16_t* P = WS_P(p);
    bf16_t* sK = (bf16_t*)shm; bf16_t* sVT = (bf16_t*)(shm + 34816); bf16_t* sPw = (bf16_t*)(shm + 69632) + wave * (2 * 16 * 136);
    const size_t tokq0 = (size_t)b * TPB + qblk * 128;
    bf16x8 aq[2][4];
#pragma unroll
    for (int hd = 0; hd < 2; ++hd)
#pragma unroll
        for (int kk = 0; kk < 4; ++kk) aq[hd][kk] = *(const bf16x8*)(P + (tokq0 + wave * 16 + fr) * LDP + C_Q + (hp * 2 + hd) * 128 + kk * 32 + 8 * fq);
    float m[2][4], ls[2][4]; f32x4 O[2][8];
#pragma unroll
    for (int hd = 0; hd < 2; ++hd) {
        const float sink = p.att_sink[l * 8 + hp * 2 + hd];
#pragma unroll
        for (int r = 0; r < 4; ++r) { m[hd][r] = sink; ls[hd][r] = 1.f; }
#pragma unroll
        for (int nd = 0; nd < 8; ++nd) O[hd][nd] = (f32x4){0.f, 0.f, 0.f, 0.f};
    }
    const int nlat = qblk - 2;
    const int kb_lo = nlat - 1 < 0 ? 0 : nlat - 1, kb_hi = nlat + 1 > 15 ? 15 : nlat + 1;
    const int ntl = qblk < 2 ? 2 : 2 + (kb_hi - kb_lo + 1);
    u32x4 kr[4], vr[4];
    const bf16_t* vtb = WS_VT(p) + ((size_t)(b * 18) * 2 + kh) * 16384;
    {
        const bf16_t* kbase = P + ((size_t)b * TPB) * LDP + C_K + kh * 128;
#pragma unroll
        for (int k = 0; k < 4; ++k) { const int idx = tid + k * 512; kr[k] = *(const u32x4*)(kbase + (size_t)(idx >> 4) * LDP + (idx & 15) * 8); vr[k] = *(const u32x4*)(vtb + idx * 8); }
    }
#pragma unroll 1
    for (int ti = 0; ti < ntl; ++ti) {
        const bool masked = ti >= 2; const int kb = kb_lo + (ti - 2);
        lds_barrier();
#pragma unroll
        for (int k = 0; k < 4; ++k) {
            const int idx = tid + k * 512;
            *(u32x4*)(sK + (idx >> 4) * 136 + (idx & 15) * 8) = kr[k];
            *(u32x4*)(sVT + (idx >> 4) * 136 + (idx & 15) * 8) = vr[k];
        }
        if (ti + 1 < ntl) {
            const int tn = ti + 1, t0n = tn < 2 ? tn * 128 : 256 + (kb_lo + (tn - 2)) * 128;
            const bf16_t* kbase = P + ((size_t)b * TPB + t0n) * LDP + C_K + kh * 128;
            const bf16_t* vtn = vtb + (size_t)(t0n >> 7) * 32768;
#pragma unroll
            for (int k = 0; k < 4; ++k) { const int idx = tid + k * 512; kr[k] = *(const u32x4*)(kbase + (size_t)(idx >> 4) * LDP + (idx & 15) * 8); vr[k] = *(const u32x4*)(vtn + idx * 8); }
        }
        lds_barrier();
#pragma unroll 1
        for (int hf = 0; hf < 2; ++hf) {
            f32x4 s[2][4];
#pragma unroll
            for (int nt = 0; nt < 4; ++nt) {
                s[0][nt] = (f32x4){0.f, 0.f, 0.f, 0.f}; s[1][nt] = (f32x4){0.f, 0.f, 0.f, 0.f};
#pragma unroll
                for (int kk = 0; kk < 4; ++kk) {
                    const bf16x8 bk = *(const bf16x8*)(sK + ((hf * 4 + nt) * 16 + fr) * 136 + kk * 32 + 8 * fq);
                    s[0][nt] = __builtin_amdgcn_mfma_f32_16x16x32_bf16(aq[0][kk], bk, s[0][nt], 0, 0, 0);
                    s[1][nt] = __builtin_amdgcn_mfma_f32_16x16x32_bf16(aq[1][kk], bk, s[1][nt], 0, 0, 0);
                }
                __builtin_amdgcn_sched_barrier(0);
            }
            if (masked) {
#pragma unroll
                for (int nt = 0; nt < 4; ++nt)
#pragma unroll
                    for (int r = 0; r < 4; ++r) { const int rel = (nlat * 128 + wave * 16 + fq * 4 + r) - (kb * 128 + (hf * 4 + nt) * 16 + fr); if (rel > 128 || rel < -128) { s[0][nt][r] = -INFINITY; s[1][nt][r] = -INFINITY; } }
            }
#pragma unroll
            for (int hd = 0; hd < 2; ++hd) {
                float alpha[4];
#pragma unroll
                for (int r = 0; r < 4; ++r) {
                    float mx = fmaxf(fmaxf(s[hd][0][r], s[hd][1][r]), fmaxf(s[hd][2][r], s[hd][3][r]));
                    mx = row16_max(mx);
                    const float mn = fmaxf(m[hd][r], mx);
                    alpha[r] = __expf(m[hd][r] - mn); m[hd][r] = mn;
                    float rs = 0.f;
#pragma unroll
                    for (int nt = 0; nt < 4; ++nt) { const float pv = __expf(s[hd][nt][r] - mn); s[hd][nt][r] = pv; rs += pv; }
                    rs = row16_sum(rs);
                    ls[hd][r] = ls[hd][r] * alpha[r] + rs;
                }
#pragma unroll
                for (int nd = 0; nd < 8; ++nd) { O[hd][nd].x *= alpha[0]; O[hd][nd].y *= alpha[1]; O[hd][nd].z *= alpha[2]; O[hd][nd].w *= alpha[3]; }
#pragma unroll
                for (int nt = 0; nt < 4; ++nt)
#pragma unroll
                    for (int r = 0; r < 4; ++r) sPw[hd * (16 * 136) + (fq * 4 + r) * 136 + nt * 16 + fr] = f2bf(s[hd][nt][r]);
            }
            asm volatile("s_waitcnt lgkmcnt(0)" ::: "memory");
#pragma unroll
            for (int kk = 0; kk < 2; ++kk) {
                const bf16x8 ap0 = *(const bf16x8*)(sPw + fr * 136 + kk * 32 + 8 * fq);
                const bf16x8 ap1 = *(const bf16x8*)(sPw + 16 * 136 + fr * 136 + kk * 32 + 8 * fq);
#pragma unroll
                for (int nd = 0; nd < 8; ++nd) {
                    const bf16x8 bv = *(const bf16x8*)(sVT + (nd * 16 + fr) * 136 + hf * 64 + kk * 32 + 8 * fq);
                    O[0][nd] = __builtin_amdgcn_mfma_f32_16x16x32_bf16(ap0, bv, O[0][nd], 0, 0, 0);
                    O[1][nd] = __builtin_amdgcn_mfma_f32_16x16x32_bf16(ap1, bv, O[1][nd], 0, 0, 0);
                    if (nd == 3) __builtin_amdgcn_sched_barrier(0);
                }
                __builtin_amdgcn_sched_barrier(0);
            }
            asm volatile("s_waitcnt lgkmcnt(0)" ::: "memory");
        }
    }
#pragma unroll
    for (int hd = 0; hd < 2; ++hd) {
        const int hq = hp * 2 + hd;
        u32x4 agr[4];
#pragma unroll
        for (int k = 0; k < 4; ++k) { const int idx = tid + k * 512; agr[k] = *(const u32x4*)(P + (tokq0 + (idx >> 4)) * LDP + C_AG + hq * 128 + (idx & 15) * 8); }
        lds_barrier();
#pragma unroll
        for (int r = 0; r < 4; ++r) {
            const float il = __builtin_amdgcn_rcpf(ls[hd][r]);
#pragma unroll
            for (int nd = 0; nd < 8; ++nd) sK[(wave * 16 + fq * 4 + r) * 136 + nd * 16 + fr] = f2bf(O[hd][nd][r] * il);
        }
        lds_barrier();
#pragma unroll
        for (int k = 0; k < 4; ++k) {
            const int idx = tid + k * 512, rr = idx >> 4, ck = idx & 15;
            const f32x8 ov = unpack8(*(const u32x4*)(sK + rr * 136 + ck * 8)), gv = unpack8(agr[k]);
            f32x8 o;
#pragma unroll
            for (int e = 0; e < 8; ++e) o[e] = ov[e] * siluf(gv[e]);
            *(u32x4*)(WS_MIX(p) + (tokq0 + rr) * MIXW + 1024 + hq * 128 + ck * 8) = pack8(o);
        }
    }
}

#define XB_TMO      128
#define XB_XCNT(j)  (256  + 64 * (j))
#define XB_XSUB(j)  (1280 + 64 * (j))
#define XB_XGEN(j)  (2304 + 64 * (j))
#define XB_TOP      3328
#define XB_TOPGEN   3392
#define XCD_BAR_WORDS 3456
#define XB_SPIN_CAP (1u << 18)
#define LAS __attribute__((address_space(3)))
__device__ __forceinline__ unsigned xb_ld(unsigned* p)              { return __hip_atomic_load(p, __ATOMIC_RELAXED, __HIP_MEMORY_SCOPE_AGENT); }
__device__ __forceinline__ unsigned xb_add(unsigned* p, unsigned v) { return __hip_atomic_fetch_add(p, v, __ATOMIC_RELAXED, __HIP_MEMORY_SCOPE_AGENT); }
__device__ __forceinline__ unsigned xb_xcc_id() { return (unsigned)__builtin_amdgcn_s_getreg((3 << 11) | 20) & 0xFu; }
#define XB_SPIN(cond, bar) do { unsigned _sp = 0; while (cond) { __builtin_amdgcn_s_sleep(1); \
    if ((++_sp & 255u) == 0u) { if (xb_ld(&(bar)[XB_TMO])) break; if (_sp > XB_SPIN_CAP) { atomicAdd(&(bar)[XB_TMO], 1u); break; } } } } while (0)
struct XcdBarrier { unsigned* bar; unsigned x; volatile LAS unsigned* st; };
__device__ __forceinline__ XcdBarrier xcd_barrier_post(unsigned* bar, volatile LAS unsigned* st) {
    XcdBarrier b; b.bar = bar; b.x = xb_xcc_id(); b.st = st;
    if (tidx() == 0) (void)xb_add(&bar[XB_XCNT(b.x)], 1u);
    return b;
}
__device__ __forceinline__ void xcd_barrier_complete(unsigned* bar, unsigned x, unsigned& nloc, unsigned& nx) {
    const unsigned G = gridDim.x * gridDim.y * gridDim.z;
    unsigned sum, cnt, mine, sp = 0u;
    for (;;) {
        sum = 0u; cnt = 0u; mine = 0u;
#pragma unroll
        for (unsigned j = 0; j < 16; ++j) { const unsigned c = xb_ld(&bar[XB_XCNT(j)]); sum += c; cnt += (c > 0u) ? 1u : 0u; mine = (j == x) ? c : mine; }
        if (sum == G) break;
        __builtin_amdgcn_s_sleep(1);
        if ((++sp & 255u) == 0u) { if (xb_ld(&bar[XB_TMO])) break; if (sp > XB_SPIN_CAP) { atomicAdd(&bar[XB_TMO], 1u); break; } }
    }
    nloc = mine > 0u ? mine : 1u; nx = cnt > 0u ? cnt : 1u;
}
__device__ __forceinline__ void xcd_barrier(const XcdBarrier& b) {
    asm volatile("s_waitcnt vmcnt(0)" ::: "memory");
    __syncthreads();
    if (tidx() == 0) {
        unsigned* bar = b.bar;
        __builtin_amdgcn_s_waitcnt(0);
        unsigned nloc = b.st[0], nx = b.st[1];
        if (nloc == 0u) { xcd_barrier_complete(bar, b.x, nloc, nx); b.st[0] = nloc; b.st[1] = nx; }
        const unsigned old = xb_add(&bar[XB_XSUB(b.x)], 1u);
        const unsigned gen = old / nloc;
        if (old + 1u == (gen + 1u) * nloc) {
            __builtin_amdgcn_fence(__ATOMIC_RELEASE, "agent");
            asm volatile("s_waitcnt vmcnt(0)" ::: "memory");
            const unsigned og = xb_add(&bar[XB_TOP], 1u);
            const unsigned tg = og / nx;
            if (og + 1u == (tg + 1u) * nx) xb_add(&bar[XB_TOPGEN], 1u);
            else XB_SPIN(xb_ld(&bar[XB_TOPGEN]) == tg, bar);
            __builtin_amdgcn_fence(__ATOMIC_ACQUIRE, "agent");
            xb_add(&bar[XB_XGEN(b.x)], 1u);
            asm volatile("s_waitcnt vmcnt(0)" ::: "memory");
        } else {
            XB_SPIN(xb_ld(&bar[XB_XGEN(b.x)]) == gen, bar);
            __builtin_amdgcn_fence(__ATOMIC_ACQUIRE, "agent");
            asm volatile("s_waitcnt vmcnt(0)" ::: "memory");
        }
    }
    __syncthreads();
}


#define QUEUE_LOOP(ctr, NITEMS, BODY) do { \
    volatile LAS unsigned* _mb = (volatile LAS unsigned*)(shm + LDS_CTL + 8); \
    int it = bid; \
    while (it < (NITEMS)) { \
        unsigned _nx = 0u; if (tidx() == 0) _nx = xb_add((ctr), 1u) + (unsigned)G; \
        BODY; \
        __syncthreads(); \
        if (tidx() == 0) _mb[0] = _nx; \
        __syncthreads(); \
        it = (int)_mb[0]; \
    } } while (0)

__global__ __launch_bounds__(512) void mega(Params p) {
    extern __shared__ __attribute__((aligned(16))) unsigned char shm[];
    cg::grid_group grid = cg::this_grid();
    const int G = (int)gridDim.x, bid = (int)blockIdx.x;
    if (tidx() < 4) ((volatile LAS unsigned*)(shm + LDS_CTL))[tidx()] = 0u;
    __syncthreads();
    unsigned* qctr = (unsigned*)(p.ws + OFF_BAR) + 3584;
    const XcdBarrier xb = xcd_barrier_post((unsigned*)(p.ws + OFF_BAR), (volatile LAS unsigned*)(shm + LDS_CTL));
    for (int rep = 0; rep < 1 + DUP_P0; ++rep) phase0(p, shm, G);
    grid.sync();
#pragma unroll 1
    for (int l = 0; l < 4; ++l) {
        for (int rep = 0; rep < 1 + DUP_NORM; ++rep) norm_phase(p, l, G);
        xcd_barrier(xb);
        {
            pg8::Gemm g{WS_U(p), WS_WTIN(p) + (size_t)l * 7424 * 2048, NTOK, 7168, 2048, 2048};
            pg8::Order S; S.init(72, 28, G, bid, 0);
            EpiG1 E{WS_P(p)};
            for (int rep = 0; rep < 1 + DUP_G1; ++rep) pg8::gemm_phase<EpiG1, pg8::Order>((PG8_LAS unsigned char*)shm, g, S, E);
            {
                const int tq = tidx(), wave = tq >> 6, lane = tq & 63, fr = lane & 15, fq = lane >> 4;
                for (int wu = bid * 8 + wave; wu < NTOK / 16; wu += G * 8) {
                    const bf16_t* ap = WS_U(p) + (size_t)(wu * 16 + fr) * 2048 + 8 * fq;
                    const bf16_t* bp = WS_WTIN(p) + ((size_t)l * 7424 + 7168 + fr) * 2048 + 8 * fq;
                    f32x4 acc = (f32x4){0.f, 0.f, 0.f, 0.f};
#pragma unroll 8
                    for (int kk = 0; kk < 64; ++kk) { const bf16x8 a = *(const bf16x8*)(ap + kk * 32), bq = *(const bf16x8*)(bp + kk * 32); acc = __builtin_amdgcn_mfma_f32_16x16x32_bf16(a, bq, acc, 0, 0, 0); }
#pragma unroll
                    for (int r = 0; r < 4; ++r) WS_DTP(p)[(size_t)(wu * 16 + fq * 4 + r) * 16 + fr] = acc[r];
                }
            }
        }
        for (int rep = 0; rep < 1 + DUP_SYNC; ++rep) xcd_barrier(xb);
        for (int rep = 0; rep < 1 + DUP_E1; ++rep) {
            if (rep == 0 || E1SEL == 0 || E1SEL == 1) for (int it = bid; it < 144; it += G) prep_dt_item(p, l, it);
            if (rep == 0 || E1SEL == 0 || E1SEL == 2) { __syncthreads(); prep_tiles(p, l, bid, G, shm); }
            if (rep == 0 || E1SEL == 0 || E1SEL == 3) prep_elem(p, l, G);
        }
        { const int tq = tidx(), wave = tq >> 6, lane = tq & 63; for (int row = bid * 8 + wave; row < NTOK; row += G * 8) qkprep_row<0>(p, l, row, lane);
#if DUP_QK
          for (int row = bid * 8 + wave; row < NTOK; row += G * 8) qkprep_row<1>(p, l, row, lane);
#endif
        }
        xcd_barrier(xb);
        QUEUE_LOOP(qctr + (l * 3 + 0) * 64, 128 + 576, { if (it < 128) lru_sweep_item<0>(p, l, it, shm); else ssd_states_item(p, l, it - 128, shm); });
#if DUP_X1Q
        __syncthreads(); QUEUE_LOOP(qctr + (12 + l * 3 + 0) * 64, 128 + 576, { if (it < 128) lru_sweep_item<0>(p, l, it, shm); else ssd_states_item(p, l, it - 128, shm); });
#endif
#if DUP_SWEEP
        __syncthreads(); for (int it = bid; it < 128; it += G) lru_sweep_item<0>(p, l, it, shm);
#endif
#if DUP_STATES
        __syncthreads(); for (int it = bid; it < 256; it += G) ssd_states_item(p, l, it, shm);
#endif
        xcd_barrier(xb);
        QUEUE_LOOP(qctr + (l * 3 + 1) * 64, 576 + 256, { if (it < 576) attn_item<0>(p, l, it, shm); else ssd_recur_item(p, it - 576); });
#if DUP_ATTQ
        __syncthreads(); QUEUE_LOOP(qctr + (12 + l * 3 + 1) * 64, 576, { attn_item<AMODE>(p, l, it, shm); });
#endif
        xcd_barrier(xb);
        QUEUE_LOOP(qctr + (l * 3 + 2) * 64, 128 + 576, { if (it < 128) lru_sweep_item<1>(p, l, it, shm); else ssd_final_item<0>(p, l, it - 128, shm); });
#if DUP_FINAL
        __syncthreads(); for (int it = bid; it < 256; it += G) ssd_final_item<FMODE>(p, l, it, shm);
#endif
#if DUP_SWEEP1
        __syncthreads(); for (int it = bid; it < 128; it += G) lru_sweep_item<1, 1>(p, l, it, shm);
#endif
        xcd_barrier(xb);
#ifndef SK_X4
        ssd_norm_phase(p, l, G);
#endif
        xcd_barrier(xb);
        {
            pg8::Gemm g{WS_MIX(p), WS_WTOUT(p) + (size_t)l * 2048 * 3072, NTOK, 2048, 3072, 3072};
            pg8::Order S; S.init(64, 8, G, bid, l == 3 ? 1 : 0);
            EpiG2 E{p, l, 0};
#if DUP_G2
            { EpiG2 E2{p, l, 1}; pg8::gemm_phase<EpiG2, pg8::Order>((PG8_LAS unsigned char*)shm, g, S, E2); }
#endif
#ifndef SK_G2
            pg8::gemm_phase<EpiG2, pg8::Order>((PG8_LAS unsigned char*)shm, g, S, E);
#endif
        }
        if (l < 3) {
            pg8::Gemm gt{WS_MIX(p), WS_WTOUT(p) + (size_t)l * 2048 * 3072, NTOK, 2048, 768, 3072};
            pg8::TailOrder St{bid, G};
            EpiPart Et{(float*)WS_P(p)};
            pg8::gemm_phase<EpiPart, pg8::TailOrder>((PG8_LAS unsigned char*)shm, gt, St, Et);
            xcd_barrier(xb);
        }
    }
}

extern "C" void kernel_launch(void* const* d_in, const int* in_sizes, int n_in, void* d_out, int out_size, void* d_ws, size_t ws_size, hipStream_t stream) {
    static int grid = 0;
    if (grid == 0) {
        if (n_in != 25 || ws_size < WS_END) { fprintf(stderr, "kernel_launch: need 25 inputs and %zu bytes of workspace (got %d, %zu)\n", (size_t)WS_END, n_in, ws_size); grid = -1; return; }
        int dev = 0, cus = 0, per_cu = 0;
        hipGetDevice(&dev);
        hipDeviceGetAttribute(&cus, hipDeviceAttributeMultiprocessorCount, dev);
        if (hipFuncSetAttribute((const void*)mega, hipFuncAttributeMaxDynamicSharedMemorySize, LDS_BYTES) != hipSuccess) { fprintf(stderr, "kernel_launch: hipFuncSetAttribute failed\n"); grid = -1; return; }
        if (hipOccupancyMaxActiveBlocksPerMultiprocessor(&per_cu, (const void*)mega, 512, LDS_BYTES) != hipSuccess || per_cu < 1) { fprintf(stderr, "kernel_launch: occupancy query gave %d\n", per_cu); per_cu = 1; }
        (void)hipGetLastError();
        grid = cus * 1;
        if (grid <= 0) grid = 256;
    }
    if (grid < 0) return;
    Params p{};
    const float** pf = (const float**)&p;
    for (int i = 0; i < 25; ++i) pf[i] = (const float*)d_in[i];
    p.out = (float*)d_out; p.ws = (unsigned char*)d_ws;
    if (hipMemsetAsync((char*)d_ws + OFF_BAR, 0, 32768, stream) != hipSuccess) { fprintf(stderr, "kernel_launch: memset of barrier words failed\n"); return; }
    void* args[] = {&p};
    hipError_t e = hipLaunchCooperativeKernel((const void*)mega, dim3(grid), dim3(512), args, LDS_BYTES, stream);
    if (e != hipSuccess) fprintf(stderr, "cooperative launch failed: %s (grid %d)\n", hipGetErrorString(e), grid);
}
```
